# Optimizing an MI355X kernel written in HIP

```python
import math
import jax, jax.numpy as jnp
from jax import lax
import numpy as np

D_MODEL = 4096
BATCH = 1
SEQ = 16384
DEPTH = 4

N_EVEN = (DEPTH + 1) // 2
N_ODD = DEPTH // 2
N_MOD = 6
CONV_CH = D_MODEL // 2
CONV_K = 3
ATTN_HEAD_DIM = 128
ATTN_HEADS = (D_MODEL // 2) // (2 * ATTN_HEAD_DIM)
ATTN_WIDTH = ATTN_HEADS * 2 * ATTN_HEAD_DIM
MIX_WIDTH = CONV_CH + ATTN_WIDTH
IN_PROJ_WIDTH = 3 * CONV_CH + 3 * ATTN_WIDTH
Q_BLOCK = 128
S5_GROUP = 16
S5_STATE = 64
S5_GROUPS = D_MODEL // S5_GROUP
S5_CHUNK = 128
DT_MIN = 0.001
DT_MAX = 0.1
FFN_HIDDEN = -(-8 * D_MODEL // (3 * 256)) * 256
NORM_EPS = 1e-6
SUBLN_EPS = 1e-5

kernel_name = 'hybrid_conv_diffattn_s5_adaln_trunk'


def rmsnorm(x, g, eps=NORM_EPS):
    xf = x.astype(jnp.float32)
    y = xf * lax.rsqrt(jnp.mean(xf * xf, axis=-1, keepdims=True) + eps)
    return (y * g.astype(jnp.float32)).astype(x.dtype)


def modulate(h, shift, scale):
    return h * (1 + scale[:, None, :]) + shift[:, None, :]


def causal_depthwise_conv(u, w):
    k_width, ch = w.shape
    return lax.conv_general_dilated(
        u, w[:, None, :].astype(u.dtype), window_strides=(1,),
        padding=[(k_width - 1, 0)], dimension_numbers=('NWC', 'WIO', 'NWC'),
        feature_group_count=ch)


def diff_attention(q, k, v, lam, lam_init, subln_g):
    bsz, seq = q.shape[0], q.shape[1]
    nb = seq // Q_BLOCK
    q = q * jnp.asarray(ATTN_HEAD_DIM ** -0.5, q.dtype)
    q_blocks = jnp.moveaxis(q.reshape(bsz, nb, Q_BLOCK, *q.shape[2:]), 1, 0)
    key_pos = jnp.arange(seq)

    def block(args):
        q_blk, blk = args
        s = jnp.einsum('bqhmd,bkhmd->bhmqk', q_blk, k).astype(jnp.float32)
        q_pos = blk * Q_BLOCK + jnp.arange(Q_BLOCK)
        s = jnp.where(key_pos[None, :] <= q_pos[:, None], s, -jnp.inf)
        p = jax.nn.softmax(s, axis=-1)
        w = p[:, :, 0] - lam * p[:, :, 1]
        return jnp.einsum('bhqk,bkhe->bqhe', w.astype(v.dtype), v)

    o = lax.map(block, (q_blocks, jnp.arange(nb)))
    o = jnp.moveaxis(o, 0, 1).reshape(bsz, seq, ATTN_HEADS, 2 * ATTN_HEAD_DIM)
    o = rmsnorm(o, subln_g, SUBLN_EPS) * (1.0 - lam_init)
    return o.reshape(bsz, seq, ATTN_WIDTH)


def conv_diffattn_mixer(h, w_in, conv_w, lq1, lk1, lq2, lk2, subln_g, w_out, lam_init):
    bsz, seq, _ = h.shape
    z = h @ w_in
    splits = [CONV_CH, 2 * CONV_CH, 3 * CONV_CH,
              3 * CONV_CH + ATTN_WIDTH, 3 * CONV_CH + 2 * ATTN_WIDTH]
    gate_b, gate_c, x_in, q, k, v = jnp.split(z, splits, axis=-1)
    y_conv = gate_b * causal_depthwise_conv(gate_c * x_in, conv_w)
    f32 = jnp.float32
    lam = (jnp.exp(jnp.sum(lq1.astype(f32) * lk1.astype(f32)))
           - jnp.exp(jnp.sum(lq2.astype(f32) * lk2.astype(f32))) + lam_init)
    q = q.reshape(bsz, seq, ATTN_HEADS, 2, ATTN_HEAD_DIM)
    k = k.reshape(bsz, seq, ATTN_HEADS, 2, ATTN_HEAD_DIM)
    v = v.reshape(bsz, seq, ATTN_HEADS, 2 * ATTN_HEAD_DIM)
    y_attn = diff_attention(q, k, v, lam, lam_init, subln_g)
    return jnp.concatenate([y_conv, y_attn.astype(y_conv.dtype)], axis=-1) @ w_out


def s5_ssm(u, a_re, a_im, log_dt, b_re, b_im, c_re, c_im, d_skip):
    f32 = jnp.float32
    bsz, seq, _ = u.shape
    lam_re = jnp.minimum(a_re.astype(f32), -1e-4)
    lam_im = a_im.astype(f32)
    dt = jnp.exp(log_dt.astype(f32))[:, None]
    mag = jnp.exp(lam_re * dt)
    ab_re = mag * jnp.cos(lam_im * dt)
    ab_im = mag * jnp.sin(lam_im * dt)
    den = lam_re * lam_re + lam_im * lam_im
    nr, ni = ab_re - 1.0, ab_im
    f_re = (nr * lam_re + ni * lam_im) / den
    f_im = (ni * lam_re - nr * lam_im) / den
    b_re, b_im = b_re.astype(f32), b_im.astype(f32)
    bb_re = f_re[..., None] * b_re - f_im[..., None] * b_im
    bb_im = f_re[..., None] * b_im + f_im[..., None] * b_re
    c_re, c_im = c_re.astype(f32), c_im.astype(f32)

    uf = u.astype(f32)
    nc = seq // S5_CHUNK
    ug = jnp.moveaxis(uf.reshape(bsz, nc, S5_CHUNK, S5_GROUPS, S5_GROUP), 1, 0)
    a_shape = (bsz, S5_CHUNK, S5_GROUPS, S5_STATE)
    ar = jnp.broadcast_to(ab_re, a_shape)
    ai = jnp.broadcast_to(ab_im, a_shape)

    def combine(e1, e2):
        a1r, a1i, b1r, b1i = e1
        a2r, a2i, b2r, b2i = e2
        return (a2r * a1r - a2i * a1i, a2r * a1i + a2i * a1r,
                a2r * b1r - a2i * b1i + b2r, a2r * b1i + a2i * b1r + b2i)

    def step(carry, u_blk):
        h_re, h_im = carry
        bu_re = jnp.einsum('btgh,gph->btgp', u_blk, bb_re)
        bu_im = jnp.einsum('btgh,gph->btgp', u_blk, bb_im)
        acr, aci, sr, si = lax.associative_scan(combine, (ar, ai, bu_re, bu_im), axis=1)
        sr = sr + acr * h_re[:, None] - aci * h_im[:, None]
        si = si + acr * h_im[:, None] + aci * h_re[:, None]
        y = (jnp.einsum('btgp,gop->btgo', sr, c_re)
             - jnp.einsum('btgp,gop->btgo', si, c_im))
        return (sr[:, -1], si[:, -1]), y

    zeros = jnp.zeros((bsz, S5_GROUPS, S5_STATE), f32)
    _, ys = lax.scan(step, (zeros, zeros), ug)
    y = jnp.moveaxis(ys, 0, 1).reshape(bsz, seq, D_MODEL)
    return (y + d_skip.astype(f32) * uf).astype(u.dtype)


def s5_glu_mixer(h, a_re, a_im, log_dt, b_re, b_im, c_re, c_im, d_skip, glu_w1, glu_w2):
    g = jax.nn.gelu(s5_ssm(h, a_re, a_im, log_dt, b_re, b_im, c_re, c_im, d_skip))
    return (g @ glu_w1) * jax.nn.sigmoid(g @ glu_w2)


def swiglu(h, wg, wu, wd):
    return (jax.nn.silu(h @ wg) * (h @ wu)) @ wd


def setup_inputs(seed: int = 0) -> dict:
    key = jax.random.key(seed)
    ks = jax.random.split(key, 32)
    f32 = jnp.float32

    def nrm(k, shape, s):
        return jax.random.normal(k, shape, f32) * s

    n_idx = jnp.arange(S5_STATE, dtype=f32)
    return {
        'x': nrm(ks[0], (BATCH, SEQ, D_MODEL), 1.0),
        'c': nrm(ks[1], (BATCH, D_MODEL), 1.0),
        'w_ada': nrm(ks[2], (D_MODEL, N_MOD * D_MODEL), 0.5 * D_MODEL ** -0.5),
        'b_ada': nrm(ks[3], (N_MOD * D_MODEL,), 0.02),
        'ada_table': nrm(ks[4], (DEPTH, N_MOD, D_MODEL), 0.1),
        'norm_mix': 1.0 + nrm(ks[5], (DEPTH, D_MODEL), 0.02),
        'norm_ffn': 1.0 + nrm(ks[6], (DEPTH, D_MODEL), 0.02),
        'norm_final': 1.0 + nrm(ks[7], (D_MODEL,), 0.02),
        'mix_w_in': nrm(ks[8], (N_EVEN, D_MODEL, IN_PROJ_WIDTH), D_MODEL ** -0.5),
        'conv_w': nrm(ks[9], (N_EVEN, CONV_K, CONV_CH), CONV_K ** -0.5),
        'lambda_q1': nrm(ks[10], (N_EVEN, ATTN_HEAD_DIM), 0.1),
        'lambda_k1': nrm(ks[11], (N_EVEN, ATTN_HEAD_DIM), 0.1),
        'lambda_q2': nrm(ks[12], (N_EVEN, ATTN_HEAD_DIM), 0.1),
        'lambda_k2': nrm(ks[13], (N_EVEN, ATTN_HEAD_DIM), 0.1),
        'subln_g': 1.0 + nrm(ks[14], (N_EVEN, 2 * ATTN_HEAD_DIM), 0.02),
        'mix_w_out': nrm(ks[15], (N_EVEN, MIX_WIDTH, D_MODEL), MIX_WIDTH ** -0.5),
        's5_a_re': -0.5 + nrm(ks[16], (N_ODD, S5_GROUPS, S5_STATE), 0.01),
        's5_a_im': math.pi * n_idx + nrm(ks[17], (N_ODD, S5_GROUPS, S5_STATE), 0.01),
        's5_log_dt': jax.random.uniform(ks[18], (N_ODD, S5_GROUPS), f32,
                                        math.log(DT_MIN), math.log(DT_MAX)),
        's5_b_re': nrm(ks[19], (N_ODD, S5_GROUPS, S5_STATE, S5_GROUP), (2 * S5_GROUP) ** -0.5),
        's5_b_im': nrm(ks[20], (N_ODD, S5_GROUPS, S5_STATE, S5_GROUP), (2 * S5_GROUP) ** -0.5),
        's5_c_re': nrm(ks[21], (N_ODD, S5_GROUPS, S5_GROUP, S5_STATE), S5_STATE ** -0.5),
        's5_c_im': nrm(ks[22], (N_ODD, S5_GROUPS, S5_GROUP, S5_STATE), S5_STATE ** -0.5),
        's5_d': nrm(ks[23], (N_ODD, D_MODEL), 1.0),
        'glu_w1': nrm(ks[24], (N_ODD, D_MODEL, D_MODEL), D_MODEL ** -0.5),
        'glu_w2': nrm(ks[25], (N_ODD, D_MODEL, D_MODEL), D_MODEL ** -0.5),
        'ffn_w_gate': nrm(ks[26], (DEPTH, D_MODEL, FFN_HIDDEN), D_MODEL ** -0.5),
        'ffn_w_up': nrm(ks[27], (DEPTH, D_MODEL, FFN_HIDDEN), D_MODEL ** -0.5),
        'ffn_w_down': nrm(ks[28], (DEPTH, FFN_HIDDEN, D_MODEL), FFN_HIDDEN ** -0.5),
    }


def reference(x, c, w_ada, b_ada, ada_table, norm_mix, norm_ffn, norm_final,
              mix_w_in, conv_w, lambda_q1, lambda_k1, lambda_q2, lambda_k2, subln_g, mix_w_out,
              s5_a_re, s5_a_im, s5_log_dt, s5_b_re, s5_b_im, s5_c_re, s5_c_im, s5_d,
              glu_w1, glu_w2, ffn_w_gate, ffn_w_up, ffn_w_down):
    dtype = x.dtype
    mod = (jax.nn.silu(c) @ w_ada + b_ada).reshape(c.shape[0], N_MOD, D_MODEL)
    for l in range(DEPTH):
        m = mod + ada_table[l][None]
        sh_m, sc_m, g_m, sh_f, sc_f, g_f = (m[:, 0], m[:, 1], m[:, 2],
                                            m[:, 3], m[:, 4], m[:, 5])
        h = modulate(rmsnorm(x, norm_mix[l]), sh_m, sc_m)
        if l % 2 == 0:
            e = l // 2
            lam_init = 0.8 - 0.6 * math.exp(-0.3 * l)
            y = conv_diffattn_mixer(h, mix_w_in[e], conv_w[e], lambda_q1[e], lambda_k1[e],
                                    lambda_q2[e], lambda_k2[e], subln_g[e], mix_w_out[e],
                                    lam_init)
        else:
            o = l // 2
            y = s5_glu_mixer(h, s5_a_re[o], s5_a_im[o], s5_log_dt[o], s5_b_re[o], s5_b_im[o],
                             s5_c_re[o], s5_c_im[o], s5_d[o], glu_w1[o], glu_w2[o])
        x = x + (g_m[:, None, :] * y).astype(dtype)
        h = modulate(rmsnorm(x, norm_ffn[l]), sh_f, sc_f)
        f = swiglu(h, ffn_w_gate[l], ffn_w_up[l], ffn_w_down[l])
        x = x + (g_f[:, None, :] * f).astype(dtype)
    return rmsnorm(x, norm_final)
```

```cpp
#include <hip/hip_runtime.h>
#include <hip/hip_bf16.h>
#include <cstdio>
#include <cstdint>
__device__ __forceinline__ int opaque_tid() { int t; asm volatile("v_mov_b32 %0, %1" : "=v"(t) : "v"((int)threadIdx.x)); return t; }
namespace pg8 {
#define PG8_LAS __attribute__((address_space(3)))
typedef unsigned short bf16_t;
typedef short bf16x8 __attribute__((ext_vector_type(8)));
typedef float f32x4 __attribute__((ext_vector_type(4)));
typedef unsigned u32x4 __attribute__((ext_vector_type(4)));
constexpr int BM = 256, BK = 64, HALF = 128, HTB = HALF * BK * 2  , STAGE_BYTES = 8 * HTB, NXCD = 8, WGM = 8;

__host__ __device__ __forceinline__ int lds_byte(int r, int c) { const int st = (r >> 4) * 2 + (c >> 5), rr = r & 15, cc = c & 31, ob = rr * 64 + cc * 2; return st * 1024 + (ob ^ (((ob >> 9) & 1) << 5)); }
__host__ __device__ __forceinline__ void stage_rc(int b, int& R, int& C) { const int st = b / 1024, sb = b % 1024, swz = sb ^ (((sb >> 9) & 1) << 5); R = (st >> 1) * 16 + swz / 64; C = (st & 1) * 32 + (swz % 64) / 2; }
__host__ __device__ __forceinline__ int perm32(int rho) { const int n = rho >> 4, i = rho & 15; return 8 * (i >> 2) + 4 * n + (i & 3); }

struct Unit { int pm, pn; };
struct Gemm { const bf16_t* A; const bf16_t* Bt; int M, N, K; };

struct StaticOrder {
    int nM, nN, nwg, G, c;
    __host__ __device__ void init(int M, int N, int G_, int c_) { nM = M / BM; nN = N / BM; nwg = nM * nN; G = G_; c = c_; }
    __host__ __device__ bool next(int i, Unit& u) const {
        const long L = (long)i * G + c; if (L >= nwg) return false;
        int wgid = (int)L; { const int q = nwg / NXCD, r = nwg % NXCD, xcd = wgid % NXCD, off = wgid / NXCD; wgid = (xcd < r ? xcd * (q + 1) : r * (q + 1) + (xcd - r) * q) + off; }
        const int nig = WGM * nN, gid = wgid / nig, fm = gid * WGM, gsz = (nM - fm) < WGM ? (nM - fm) : WGM;
        u.pm = fm + ((wgid % nig) % gsz); u.pn = (wgid % nig) / gsz; return true;
    }
    __device__ __forceinline__ void a_ready(const Unit&) const {}
    __device__ __forceinline__ void done(const Unit&) const {}
};

__device__ __forceinline__ unsigned cvt_pk_bf16(float lo, float hi) { unsigned r; asm volatile("v_cvt_pk_bf16_f32 %0, %1, %2" : "=v"(r) : "v"(lo), "v"(hi)); return r; }
__device__ __forceinline__ float fast_sigmoid(float x) { return __builtin_amdgcn_rcpf(1.0f + __builtin_amdgcn_exp2f(-1.4426950408889634f * x)); }

struct EpiHeadMajor {
    static constexpr bool PERM = true, AFTER_DRAIN = false;
    bf16_t* O; size_t gstride;
    __device__ __forceinline__ void operator()(const f32x4 (&acc)[2][2][4][2], const Unit& u, int wr, int wc, int fr, int fq) const {
        const int row0 = u.pm * BM + wr * 64 + fr, col0 = wc * 32 + 8 * fq;
#pragma unroll
        for (int ai = 0; ai < 2; ++ai)
#pragma unroll
            for (int m = 0; m < 4; ++m) { const size_t ro = (size_t)(row0 + ai * HALF + m * 16) * 128 + col0;
#pragma unroll
                for (int bj = 0; bj < 2; ++bj) { const f32x4 v0 = acc[ai][bj][m][0], v1 = acc[ai][bj][m][1];
                    u32x4 w; w.x = cvt_pk_bf16(v0[0], v0[1]); w.y = cvt_pk_bf16(v0[2], v0[3]); w.z = cvt_pk_bf16(v1[0], v1[1]); w.w = cvt_pk_bf16(v1[2], v1[3]);
                    *(u32x4*)(O + (size_t)(2 * u.pn + bj) * gstride + ro) = w; } }
    }
};
struct EpiResid {
    static constexpr bool PERM = false, AFTER_DRAIN = false;
    const float* base; float* out; const float* gate; int ldc;
    __device__ __forceinline__ void operator()(const f32x4 (&acc)[2][2][4][2], const Unit& u, int wr, int wc, int fr, int fq) const {
        const int row0 = u.pm * BM + wr * 64 + fr, col0 = u.pn * BM + wc * 32 + 4 * fq;
        f32x4 gv[2][2];
#pragma unroll
        for (int bj = 0; bj < 2; ++bj)
#pragma unroll
            for (int n = 0; n < 2; ++n) gv[bj][n] = *(const f32x4*)(gate + col0 + bj * HALF + n * 16);
#pragma unroll
        for (int ai = 0; ai < 2; ++ai)
#pragma unroll
            for (int m = 0; m < 4; ++m) { const size_t off = (size_t)(row0 + ai * HALF + m * 16) * ldc + col0;
#pragma unroll
                for (int bj = 0; bj < 2; ++bj)
#pragma unroll
                    for (int n = 0; n < 2; ++n) { const f32x4 b = *(const f32x4*)(base + off + bj * HALF + n * 16); *(f32x4*)(out + off + bj * HALF + n * 16) = b + gv[bj][n] * acc[ai][bj][m][n]; }
                asm volatile("" ::: "memory"); }
    }
};
struct EpiSwiGLU {
    static constexpr bool PERM = true, AFTER_DRAIN = false;
    bf16_t* O; int ldc;
    __device__ __forceinline__ void operator()(const f32x4 (&acc)[2][2][4][2], const Unit& u, int wr, int wc, int fr, int fq) const {
        const int row0 = u.pm * BM + wr * 64 + fr, col0 = u.pn * HALF + wc * 32 + 8 * fq;
#pragma unroll
        for (int ai = 0; ai < 2; ++ai)
#pragma unroll
            for (int m = 0; m < 4; ++m) { bf16_t* rowp = O + (size_t)(row0 + ai * HALF + m * 16) * ldc + col0;
                float r[8];
#pragma unroll
                for (int n = 0; n < 2; ++n)
#pragma unroll
                    for (int j = 0; j < 4; ++j) { const float g = acc[ai][0][m][n][j], up = acc[ai][1][m][n][j]; r[n * 4 + j] = g * fast_sigmoid(g) * up; }
                u32x4 w; w.x = cvt_pk_bf16(r[0], r[1]); w.y = cvt_pk_bf16(r[2], r[3]); w.z = cvt_pk_bf16(r[4], r[5]); w.w = cvt_pk_bf16(r[6], r[7]);
                *(u32x4*)rowp = w; }
    }
};
struct EpiGluResid {
    static constexpr bool PERM = false, AFTER_DRAIN = false;
    const float* base; float* out; const float* gate; int ldc;
    __device__ __forceinline__ void operator()(const f32x4 (&acc)[2][2][4][2], const Unit& u, int wr, int wc, int fr, int fq) const {
        const int row0 = u.pm * BM + wr * 64 + fr, col0 = u.pn * HALF + wc * 32 + 4 * fq;
        f32x4 gv[2];
#pragma unroll
        for (int n = 0; n < 2; ++n) gv[n] = *(const f32x4*)(gate + col0 + n * 16);
#pragma unroll
        for (int ai = 0; ai < 2; ++ai)
#pragma unroll
            for (int m = 0; m < 4; ++m) { const size_t off = (size_t)(row0 + ai * HALF + m * 16) * ldc + col0;
#pragma unroll
                for (int n = 0; n < 2; ++n) { const f32x4 b = *(const f32x4*)(base + off + n * 16); const f32x4 a = acc[ai][0][m][n], s = acc[ai][1][m][n]; f32x4 y;
#pragma unroll
                    for (int j = 0; j < 4; ++j) y[j] = a[j] * fast_sigmoid(s[j]);
                    *(f32x4*)(out + off + n * 16) = b + gv[n] * y; }
                asm volatile("" ::: "memory"); }
    }
};

template <class Epi, class Sched, bool ALIGN_EPI = false, bool SP2 = false>
__device__ __forceinline__ void gemm_phase(PG8_LAS unsigned char* lds, const Gemm g, const Sched& S, const Epi& E) {
    const int tid = opaque_tid(), wid = __builtin_amdgcn_readfirstlane(tid >> 6), lane = tid & 63, wr = wid >> 2, wc = wid & 3, fr = lane & 15, fq = lane >> 4;
    const int K = g.K, nt = K / BK;
    unsigned voffA[2], voffB[2];
#pragma unroll
    for (int i = 0; i < 2; ++i) { int R, C; stage_rc(tid * 16 + i * 8192, R, C); const int Rb = Epi::PERM ? ((R & ~31) + perm32(R & 31)) : R;
        voffA[i] = (unsigned)(R * K + C) * 2u; voffB[i] = (unsigned)(Rb * K + C) * 2u; }
    const size_t kstep = (size_t)(BK * 2);
    const size_t hstep = (size_t)HALF * K * 2;
    const size_t tstep = 2 * hstep;
    const unsigned ldsw = (unsigned)wid * 1024u;
    const int aoff = lds_byte(wr * 64 + fr, fq * 8), boff = lds_byte(wc * 32 + fr, fq * 8);
#define PG8_SA(b, h) (((b) * 2 + (h)) * HTB)
#define PG8_SB(b, h) ((4 + (b) * 2 + (h)) * HTB)
#define PG8_STAGE(bufoff, gbase, voff) do { _Pragma("unroll") for (int _i = 0; _i < 2; ++_i) \
        __builtin_amdgcn_global_load_lds((const unsigned*)((const char*)(gbase) + (voff)[_i]), (PG8_LAS unsigned*)(lds + (bufoff) + ldsw + _i * 8192), 16, 0, 0); } while (0)
#define PG8_LDA(dst, b, h) do { _Pragma("unroll") for (int m = 0; m < 4; ++m) _Pragma("unroll") for (int k = 0; k < 2; ++k) dst[m][k] = *(const PG8_LAS bf16x8*)(lds + PG8_SA(b, h) + aoff + m * 2048 + k * 1024); } while (0)
#define PG8_LDB(dst, b, h) do { _Pragma("unroll") for (int n = 0; n < 2; ++n) _Pragma("unroll") for (int k = 0; k < 2; ++k) dst[n][k] = *(const PG8_LAS bf16x8*)(lds + PG8_SB(b, h) + boff + n * 2048 + k * 1024); } while (0)
#define PG8_MMA(ai, bj, At, Bt) do { __builtin_amdgcn_s_setprio(1); _Pragma("unroll") for (int m = 0; m < 4; ++m) _Pragma("unroll") for (int n = 0; n < 2; ++n) _Pragma("unroll") for (int k = 0; k < 2; ++k) \
        acc[ai][bj][m][n] = __builtin_amdgcn_mfma_f32_16x16x32_bf16(Bt[n][k], At[m][k], acc[ai][bj][m][n], 0, 0, 0); __builtin_amdgcn_s_setprio(0); } while (0)
#define PG8_WAIT_V(n) asm volatile("s_waitcnt vmcnt(" #n ")" ::: "memory")
#define PG8_WAIT_L(n) asm volatile("s_waitcnt lgkmcnt(" #n ")" ::: "memory")
#define PG8_BAR __builtin_amdgcn_s_barrier()
#define PG8_SCHED __builtin_amdgcn_sched_barrier(0)
    Unit cur, nxt; int ui = 0;
    if (!S.next(0, cur)) return;
    f32x4 acc[2][2][4][2];
#pragma unroll
    for (int a = 0; a < 2; ++a)
#pragma unroll
        for (int b = 0; b < 2; ++b)
#pragma unroll
            for (int m = 0; m < 4; ++m)
#pragma unroll
                for (int n = 0; n < 2; ++n) acc[a][b][m][n] = (f32x4){0.f, 0.f, 0.f, 0.f};
    bf16x8 At[4][2], B0[2][2], B1[2][2];
    const char* cA = (const char*)g.A + (size_t)cur.pm * tstep; const char* cB = (const char*)g.Bt + (size_t)cur.pn * tstep;
    S.a_ready(cur);
    if constexpr (SP2) {
        PG8_STAGE(PG8_SB(0, 0), cB, voffB); PG8_STAGE(PG8_SB(0, 1), cB + hstep, voffB); PG8_STAGE(PG8_SA(0, 0), cA, voffA); PG8_STAGE(PG8_SA(0, 1), cA + hstep, voffA);
        if (wr == 1) PG8_BAR;
        PG8_WAIT_V(2); PG8_BAR;
        PG8_STAGE(PG8_SB(1, 0), cB + kstep, voffB); PG8_STAGE(PG8_SA(1, 0), cA + kstep, voffA); PG8_STAGE(PG8_SB(1, 1), cB + hstep + kstep, voffB);
        PG8_WAIT_V(6); PG8_BAR;
    } else {
        PG8_STAGE(PG8_SB(0, 0), cB, voffB); PG8_STAGE(PG8_SA(0, 0), cA, voffA); PG8_STAGE(PG8_SB(0, 1), cB + hstep, voffB); PG8_STAGE(PG8_SA(0, 1), cA + hstep, voffA);
        if (wr == 1) PG8_BAR;
        PG8_WAIT_V(4); PG8_BAR;
        PG8_STAGE(PG8_SB(1, 0), cB + kstep, voffB); PG8_STAGE(PG8_SA(1, 0), cA + kstep, voffA); PG8_STAGE(PG8_SB(1, 1), cB + hstep + kstep, voffB);
        PG8_WAIT_V(6); PG8_BAR;
    }
    for (;;) {
        const bool has_next = S.next(ui + 1, nxt);
        const char* nA = has_next ? (const char*)g.A + (size_t)nxt.pm * tstep : cA; const char* nB = has_next ? (const char*)g.Bt + (size_t)nxt.pn * tstep : cB;
        for (int t = 0; t < nt; t += 2) {
            const bool last = (t == nt - 2);
            const char* a1 = cA + (size_t)(t + 1) * kstep;
            const char* a2 = last ? nA : cA + (size_t)(t + 2) * kstep; const char* b2 = last ? nB : cB + (size_t)(t + 2) * kstep;
            const char* a3 = a2 + kstep; const char* b3 = b2 + kstep;
            if (last && has_next) S.a_ready(nxt);
            if constexpr (SP2) {
            PG8_LDB(B0, 0, 0); PG8_LDB(B1, 0, 1); PG8_SCHED; PG8_LDA(At, 0, 0); PG8_STAGE(PG8_SA(1, 1), a1 + hstep, voffA);
            PG8_WAIT_V(8); PG8_WAIT_L(0); PG8_BAR; PG8_MMA(0, 0, At, B0); PG8_MMA(0, 1, At, B1); PG8_BAR; PG8_SCHED;
            PG8_LDA(At, 0, 1); PG8_STAGE(PG8_SB(0, 0), b2, voffB); PG8_STAGE(PG8_SB(0, 1), b2 + hstep, voffB); PG8_STAGE(PG8_SA(0, 0), a2, voffA);
            PG8_WAIT_V(8); PG8_WAIT_L(0); PG8_BAR; PG8_MMA(1, 0, At, B0); PG8_MMA(1, 1, At, B1); PG8_BAR; PG8_SCHED;
            PG8_LDB(B0, 1, 0); PG8_LDB(B1, 1, 1); PG8_SCHED; PG8_LDA(At, 1, 0); PG8_STAGE(PG8_SA(0, 1), a2 + hstep, voffA);
            PG8_WAIT_V(8); PG8_WAIT_L(0); PG8_BAR; PG8_MMA(0, 0, At, B0); PG8_MMA(0, 1, At, B1); PG8_BAR; PG8_SCHED;
            PG8_LDA(At, 1, 1); PG8_STAGE(PG8_SB(1, 0), b3, voffB); PG8_STAGE(PG8_SB(1, 1), b3 + hstep, voffB); PG8_STAGE(PG8_SA(1, 0), a3, voffA);
            PG8_WAIT_V(8); PG8_WAIT_L(0); PG8_BAR; PG8_MMA(1, 0, At, B0); PG8_MMA(1, 1, At, B1); PG8_BAR; PG8_SCHED;
            } else {
            PG8_LDB(B0, 0, 0); PG8_SCHED; PG8_LDA(At, 0, 0); PG8_STAGE(PG8_SA(1, 1), a1 + hstep, voffA);
            PG8_WAIT_L(8); PG8_BAR; PG8_WAIT_L(0); PG8_MMA(0, 0, At, B0); PG8_BAR; PG8_SCHED;
            PG8_LDB(B1, 0, 1); PG8_STAGE(PG8_SB(0, 0), b2, voffB);
            PG8_BAR; PG8_WAIT_L(0); PG8_MMA(0, 1, At, B1); PG8_BAR;
            PG8_LDA(At, 0, 1); PG8_STAGE(PG8_SA(0, 0), a2, voffA);
            PG8_BAR; PG8_WAIT_L(0); PG8_MMA(1, 0, At, B0); PG8_BAR; PG8_SCHED;
            PG8_STAGE(PG8_SB(0, 1), b2 + hstep, voffB);
            PG8_WAIT_V(6); PG8_BAR; PG8_MMA(1, 1, At, B1); PG8_BAR;
            PG8_LDB(B0, 1, 0); PG8_SCHED; PG8_LDA(At, 1, 0); PG8_STAGE(PG8_SA(0, 1), a2 + hstep, voffA);
            PG8_WAIT_L(8); PG8_BAR; PG8_WAIT_L(0); PG8_MMA(0, 0, At, B0); PG8_BAR; PG8_SCHED;
            PG8_LDB(B1, 1, 1); PG8_STAGE(PG8_SB(1, 0), b3, voffB);
            PG8_BAR; PG8_WAIT_L(0); PG8_MMA(0, 1, At, B1); PG8_BAR;
            PG8_LDA(At, 1, 1); PG8_STAGE(PG8_SA(1, 0), a3, voffA);
            PG8_BAR; PG8_WAIT_L(0); PG8_MMA(1, 0, At, B0); PG8_BAR; PG8_SCHED;
            PG8_STAGE(PG8_SB(1, 1), b3 + hstep, voffB);
            PG8_WAIT_V(6); PG8_BAR; PG8_MMA(1, 1, At, B1); PG8_BAR;
            }
        }
        if constexpr (ALIGN_EPI) { if (wr == 0) PG8_BAR; }
        if constexpr (!Epi::AFTER_DRAIN) { E(acc, cur, wr, wc, fr, fq); S.done(cur); }
        if (!has_next) break;
#pragma unroll
        for (int a = 0; a < 2; ++a)
#pragma unroll
            for (int b = 0; b < 2; ++b)
#pragma unroll
                for (int m = 0; m < 4; ++m)
#pragma unroll
                    for (int n = 0; n < 2; ++n) acc[a][b][m][n] = (f32x4){0.f, 0.f, 0.f, 0.f};
        cur = nxt; cA = nA; cB = nB; ++ui;
        if constexpr (ALIGN_EPI) { if (wr == 1) PG8_BAR; }
    }
    PG8_WAIT_V(0);
    if constexpr (!ALIGN_EPI) { if (wr == 0) PG8_BAR; }
    PG8_BAR;
    if constexpr (Epi::AFTER_DRAIN) { E.fused(acc, cur, wr, wc, fr, fq, lds, wid, lane); S.done(cur); }
#undef PG8_SA
#undef PG8_SB
#undef PG8_STAGE
#undef PG8_LDA
#undef PG8_LDB
#undef PG8_MMA
#undef PG8_WAIT_V
#undef PG8_WAIT_L
#undef PG8_BAR
#undef PG8_SCHED
}
}

namespace att {
constexpr int D = 128;
constexpr float THR = 8.f;
constexpr bool WSKIP = false;
constexpr float SCALE = 0.08838834764831845f;
constexpr int NW = 8, QBLK = 32, KVBLK = 64, QB = NW * QBLK;
constexpr int SHM_V = KVBLK * D * 2, SHM_K = KVBLK * D * 2;
constexpr int LDS_BYTES = 2 * SHM_V + 2 * SHM_K + NW * 64 * 4;

using bf16 = __hip_bfloat16;
typedef short bf16x8 __attribute__((ext_vector_type(8)));
typedef short s16x4 __attribute__((ext_vector_type(4)));
typedef float f32x16 __attribute__((ext_vector_type(16)));
typedef float f32x4 __attribute__((ext_vector_type(4)));
typedef unsigned u32x4 __attribute__((ext_vector_type(4)));
template <class A, class Bt> struct same_t { static constexpr bool v = false; };
template <class A> struct same_t<A, A> { static constexpr bool v = true; };

#define KSWZ(row, colB) ((row) * 256 + ((colB) ^ (((row) & 7) << 4)))
#define SBAR() __builtin_amdgcn_sched_barrier(0)
__device__ __forceinline__ int v_st(int k, int c) { const int kk = (k & ~0xC) | ((k & 4) << 1) | ((k & 8) >> 1); return ((kk >> 3) * 4 + (c >> 5)) * 512 + ((kk & 7) * 32 + (c & 31)) * 2; }
__device__ __forceinline__ int v_rd_base(int lane) { return ((lane & 3) << 3) | (((lane >> 2) & 3) << 6) | (((lane >> 4) & 1) << 5) | (((lane >> 5) & 1) << 8); }
constexpr int v_rd_off(int d0, int ks, int half) { return d0 * 512 + ks * 4096 + half * 2048; }
__device__ __forceinline__ int crow(int r, int hi) { return (r & 3) + 8 * (r >> 2) + 4 * hi; }
__device__ __forceinline__ unsigned cvtpk(float lo, float hi) {
    unsigned r; asm volatile("v_cvt_pk_bf16_f32 %0, %1, %2" : "=v"(r) : "v"(lo), "v"(hi)); return r;
}
__device__ __forceinline__ bf16x8 pack8(f32x4 a, f32x4 b) {
    u32x4 w = {cvtpk(a[0], a[1]), cvtpk(a[2], a[3]), cvtpk(b[0], b[1]), cvtpk(b[2], b[3])};
    return *reinterpret_cast<bf16x8*>(&w);
}
template <class T> __device__ __forceinline__ bf16x8 load8(const T* p) {
    if constexpr (same_t<T, float>::v) { return pack8(*(const f32x4*)p, *(const f32x4*)(p + 4)); }
    else { return *reinterpret_cast<const bf16x8*>(p); }
}
__device__ __forceinline__ void mask_tile(f32x16& p0, f32x16& p1, int dq, unsigned W) {
    const float NEG = -__builtin_inff();
#pragma unroll
    for (int r = 0; r < 16; ++r) {
        const int c = (r & 3) + 8 * (r >> 2);
        if ((unsigned)(dq - c) >= W) p0[r] = NEG;
        if ((unsigned)(dq - c - 32) >= W) p1[r] = NEG;
    }
}
__device__ __forceinline__ void partialSM(f32x16& p0, f32x16& p1, float& m_reg, float& mn, float& alpha) {
    float pmax = p0[0]; for (int r = 1; r < 16; ++r) pmax = fmaxf(pmax, p0[r]); for (int r = 0; r < 16; ++r) pmax = fmaxf(pmax, p1[r]);
    { auto rr = __builtin_amdgcn_permlane32_swap(__float_as_uint(pmax), __float_as_uint(pmax), false, false);
      pmax = fmaxf(__uint_as_float(rr[0]), __uint_as_float(rr[1])); }
    constexpr float C2 = 1.4426950408889634f * SCALE;
    if (__builtin_expect(__all((pmax - m_reg) * SCALE <= THR), 1)) { mn = m_reg; alpha = 1.f; }
    else { mn = fmaxf(m_reg, pmax); alpha = __builtin_amdgcn_exp2f((m_reg - mn) * C2); m_reg = mn; }
    const float mnL = -mn * C2;
    for (int r = 0; r < 16; ++r) p0[r] = fmaf(p0[r], C2, mnL); for (int r = 0; r < 16; ++r) p1[r] = fmaf(p1[r], C2, mnL);
    for (int r = 0; r < 16; ++r) p0[r] = __builtin_amdgcn_exp2f(p0[r]);
}
__device__ __forceinline__ void finishSM(f32x16& p0, f32x16& p1, float alpha, float& l_reg, bf16x8& pa0, bf16x8& pa1, bf16x8& pa2, bf16x8& pa3) {
    for (int r = 0; r < 16; ++r) p1[r] = __builtin_amdgcn_exp2f(p1[r]);
    float ps = 0; for (int r = 0; r < 16; ++r) ps += p0[r]; for (int r = 0; r < 16; ++r) ps += p1[r];
    { auto rr = __builtin_amdgcn_permlane32_swap(__float_as_uint(ps), __float_as_uint(ps), false, false);
      ps = __uint_as_float(rr[0]) + __uint_as_float(rr[1]); }
    l_reg = l_reg * alpha + ps;
#define PK4(P, B_, OUT) do { unsigned a0 = cvtpk(P[B_+0], P[B_+1]), a1 = cvtpk(P[B_+2], P[B_+3]);                          \
        unsigned b0 = cvtpk(P[B_+4], P[B_+5]), b1 = cvtpk(P[B_+6], P[B_+7]);                                             \
        auto r0 = __builtin_amdgcn_permlane32_swap(a0, b0, false, false); auto r1 = __builtin_amdgcn_permlane32_swap(a1, b1, false, false); \
        u32x4 w = {r0[0], r1[0], r0[1], r1[1]}; OUT = *reinterpret_cast<bf16x8*>(&w); } while (0)
    PK4(p0, 0, pa0); PK4(p0, 8, pa1); PK4(p1, 0, pa2); PK4(p1, 8, pa3);
#undef PK4
}
template <int KB, bool SK>
__device__ __forceinline__ void qkt(f32x16& p0, f32x16& p1, const char* K_lds, int r32, int hi, const bf16x8* qr, bool act) {
    if (SK && !act) { const float NEG = -__builtin_inff();
#pragma unroll
        for (int r = 0; r < 16; ++r) { p0[r] = NEG; p1[r] = NEG; } return; }
    p0 = f32x16{}; p1 = f32x16{};
    const char* kb[4];
#pragma unroll
    for (int dd = 0; dd < 4; ++dd) kb[dd] = K_lds + KB * SHM_K + KSWZ(r32, (dd * 16 + hi * 8) * 2);
#pragma unroll
    for (int d0 = 0; d0 < 8; ++d0) { const char* a = kb[d0 & 3] + (d0 >> 2) * 128;
        bf16x8 b0 = *reinterpret_cast<const bf16x8*>(a);
        bf16x8 b1 = *reinterpret_cast<const bf16x8*>(a + 32 * 256);
        p0 = __builtin_amdgcn_mfma_f32_32x32x16_bf16(b0, qr[d0], p0, 0, 0, 0);
        p1 = __builtin_amdgcn_mfma_f32_32x32x16_bf16(b1, qr[d0], p1, 0, 0, 0); }
}
template <int VB, bool SK>
__device__ __forceinline__ void pv_tile(f32x16* o, int vb0, bf16x8 pa0, bf16x8 pa1, bf16x8 pa2, bf16x8 pa3, bool act) {
    if (SK && !act) return;
#define TRRD(dst, off) asm volatile("ds_read_b64_tr_b16 %0, %1 offset:%2" : "=&v"(dst) : "v"(vb0), "i"(off) : "memory")
#define PV_D0(d0) do { s16x4 l0, l1, l2, l3, h0, h1, h2, h3; constexpr int b_ = VB * SHM_V + v_rd_off(d0, 0, 0);     \
        TRRD(l0, b_); TRRD(h0, b_ + 2048); TRRD(l1, b_ + 4096); TRRD(h1, b_ + 6144); TRRD(l2, b_ + 8192); TRRD(h2, b_ + 10240); TRRD(l3, b_ + 12288); TRRD(h3, b_ + 14336); \
        asm volatile("s_waitcnt lgkmcnt(0)" ::: "memory"); SBAR();                 \
        o[d0] = __builtin_amdgcn_mfma_f32_32x32x16_bf16(pa0, (bf16x8){l0[0], l0[1], l0[2], l0[3], h0[0], h0[1], h0[2], h0[3]}, o[d0], 0, 0, 0);   \
        o[d0] = __builtin_amdgcn_mfma_f32_32x32x16_bf16(pa1, (bf16x8){l1[0], l1[1], l1[2], l1[3], h1[0], h1[1], h1[2], h1[3]}, o[d0], 0, 0, 0);   \
        o[d0] = __builtin_amdgcn_mfma_f32_32x32x16_bf16(pa2, (bf16x8){l2[0], l2[1], l2[2], l2[3], h2[0], h2[1], h2[2], h2[3]}, o[d0], 0, 0, 0);   \
        o[d0] = __builtin_amdgcn_mfma_f32_32x32x16_bf16(pa3, (bf16x8){l3[0], l3[1], l3[2], l3[3], h3[0], h3[1], h3[2], h3[3]}, o[d0], 0, 0, 0); } while (0)
    PV_D0(0); PV_D0(1); PV_D0(2); PV_D0(3);
#undef PV_D0
#undef TRRD
}

template <class TIn, class TOut> struct BlockRef { const TIn* Q; const TIn* K; const TIn* V; TOut* O; int P0; };
template <class TIn> struct Seam {
    bf16x8 qr[8];
    bf16x8 st_v0, st_v1, st_k0, st_k1; f32x4 sf0, sf1, sf2, sf3;
    f32x4 tq[16];
};
__device__ __forceinline__ int swa_jlo(int P0, int W) { const int lowk = P0 - W + 1; return lowk > 0 ? lowk / KVBLK : 0; }
#define ROW(p, k0, rr) ((p) + (size_t)((k0) + (rr)) * D + sc)
#define VMW() asm volatile("s_waitcnt vmcnt(0)" ::: "memory")
#define VMWN(n) asm volatile("s_waitcnt vmcnt(%0)" :: "i"(n) : "memory")
#define SLOAD_H(Kp, Vp, k0) do { S.st_v0 = load8<TIn>(ROW(Vp, k0, sr)); S.st_v1 = load8<TIn>(ROW(Vp, k0, 32 + sr));              \
                         S.st_k0 = load8<TIn>(ROW(Kp, k0, sr)); S.st_k1 = load8<TIn>(ROW(Kp, k0, 32 + sr)); } while (0)
#define SWRITE_HK(bf) do { *(bf16x8*)(K_lds + (bf) * SHM_K + kws) = S.st_k0; *(bf16x8*)(K_lds + (bf) * SHM_K + kws + 32 * 256) = S.st_k1; } while (0)
#define SWRITE_HV(bf) do { *(bf16x8*)(V_lds + (bf) * SHM_V + vst0) = S.st_v0; *(bf16x8*)(V_lds + (bf) * SHM_V + vst1) = S.st_v1; } while (0)
#define SWRITE_H(bf) do { SWRITE_HV(bf); SWRITE_HK(bf); } while (0)
#define SLOAD_F(p, k0) do { S.sf0 = *(const f32x4*)ROW(p, k0, sr); S.sf1 = *(const f32x4*)(ROW(p, k0, sr) + 4);                \
                            S.sf2 = *(const f32x4*)ROW(p, k0, 32 + sr); S.sf3 = *(const f32x4*)(ROW(p, k0, 32 + sr) + 4); } while (0)
#define SWRITE_KF(bf) do { *(bf16x8*)(K_lds + (bf) * SHM_K + kws) = pack8(S.sf0, S.sf1); *(bf16x8*)(K_lds + (bf) * SHM_K + kws + 32 * 256) = pack8(S.sf2, S.sf3); } while (0)
#define SWRITE_VF(bf) do { *(bf16x8*)(V_lds + (bf) * SHM_V + vst0) = pack8(S.sf0, S.sf1); *(bf16x8*)(V_lds + (bf) * SHM_V + vst1) = pack8(S.sf2, S.sf3); } while (0)
template <class TIn, class TOut>
__device__ __forceinline__ void causal_swa_prime(const BlockRef<TIn, TOut>& cur, int W, char* lds, Seam<TIn>& S) {
    constexpr bool F32 = same_t<TIn, float>::v;
    const int tid = opaque_tid(), wid = __builtin_amdgcn_readfirstlane(tid >> 6), lane = tid & 63, r32 = lane & 31, hi = lane >> 5;
    const int sr = tid >> 4, sc = (tid & 15) * 8, kws = KSWZ(sr, sc * 2); char* K_lds = lds + 2 * SHM_V;
    const int kb0 = swa_jlo(cur.P0, W) * KVBLK;
    for (int d0 = 0; d0 < 8; ++d0) S.qr[d0] = load8<TIn>(cur.Q + (size_t)(wid * QBLK + r32) * D + d0 * 16 + hi * 8);
    if constexpr (F32) { SLOAD_F((const float*)cur.K, kb0); VMW(); SWRITE_KF(0); SBAR(); SLOAD_F((const float*)cur.V, kb0); }
    else { SLOAD_H(cur.K, cur.V, kb0); VMW(); SWRITE_HK(0); }
    __syncthreads();
}
template <class TIn, class TOut>
__device__ __forceinline__ void causal_swa_block(const BlockRef<TIn, TOut>& cur, const BlockRef<TIn, TOut>& nxt, int skv, int W, char* lds, Seam<TIn>& S) {
    constexpr bool F32 = same_t<TIn, float>::v;
    const int tid = opaque_tid(), wid = __builtin_amdgcn_readfirstlane(tid >> 6), lane = tid & 63, r32 = lane & 31, hi = lane >> 5;
    const int j_lo = swa_jlo(cur.P0, W);
    int j_hi = (cur.P0 + QB - 1) / KVBLK + 1; if (j_hi > skv / KVBLK) j_hi = skv / KVBLK;
    const int NT = j_hi - j_lo;
    const int kbn = swa_jlo(nxt.P0, W) * KVBLK;
    const int qlo = cur.P0 + wid * QBLK, qm = qlo + r32 - 4 * hi;
    char* V_lds = lds; char* K_lds = lds + 2 * SHM_V;
    float* ws = (float*)(lds + 2 * SHM_V + 2 * SHM_K) + wid * 64; float* li_l = ws, * al_l = ws + 32;
    float m_reg = -1e30f, l_reg = 0; f32x16 o[4] = {};
    const int sr = tid >> 4, sc = (tid & 15) * 8, vst0 = v_st(sr, sc), vst1 = v_st(32 + sr, sc), kws = KSWZ(sr, sc * 2);
    const int vb0 = (int)(uintptr_t)V_lds + v_rd_base(lane);
    const TIn* Kh = cur.K; const TIn* Vh = cur.V;
#define RESC(a) do { if (__any((a) < 1.f)) { if (hi == 0) al_l[r32] = (a); asm volatile("s_waitcnt lgkmcnt(0)" ::: "memory");              \
                     for (int d_ = 0; d_ < 4; ++d_) for (int r = 0; r < 16; ++r) o[d_][r] *= al_l[crow(r, hi)]; } } while (0)
#define KBASE(t) ((j_lo + (t)) * KVBLK)
#define ACT(t) (KBASE(t) <= qlo + QBLK - 1 && KBASE(t) + KVBLK - 1 >= qlo - W + 1)
#define MASKT(P0_, P1_, t) do { const int kb_ = KBASE(t); if ((!SK || ACT(t)) && (kb_ + KVBLK - 1 > qlo || kb_ <= qlo + QBLK - 1 - W)) mask_tile(P0_, P1_, qm - kb_, (unsigned)W); } while (0)
    constexpr int NQL = F32 ? 16 : 8;
    constexpr bool SK = WSKIP && !F32;
#define SEAM_K0() do { VMWN(NQL); if constexpr (F32) { SWRITE_KF(0); SBAR(); SLOAD_F((const float*)nxt.V, kbn); } else { SWRITE_HK(0); } SBAR(); } while (0)
    f32x16 pA0, pA1, pB0, pB1; float mnA, mnB, alA, alB; bf16x8 pa0, pa1, pa2, pa3;
    if constexpr (F32) { VMW(); SWRITE_VF(0); SBAR(); } else { SWRITE_HV(0); SBAR(); }
    if (NT > 1) { if constexpr (F32) SLOAD_F((const float*)Kh, KBASE(1)); else SLOAD_H(Kh, Vh, KBASE(1)); }
    SBAR(); qkt<0, SK>(pA0, pA1, K_lds, r32, hi, S.qr, ACT(0));
    if constexpr (F32) { if (NT > 1) { VMW(); SWRITE_KF(1); SBAR(); SLOAD_F((const float*)Vh, KBASE(1)); } }
    MASKT(pA0, pA1, 0); partialSM(pA0, pA1, m_reg, mnA, alA);
    if (NT > 1) { VMW(); if constexpr (F32) { SWRITE_VF(1); SBAR(); if (NT > 2) SLOAD_F((const float*)Kh, KBASE(2)); } else SWRITE_H(1); }
    __syncthreads();
#define HALF_STEP(PX0, PX1, mnX, alX, PY0, PY1, alY, t, KB, VB, SB) do {                                                      \
        SBAR(); qkt<KB, SK>(PX0, PX1, K_lds, r32, hi, S.qr, ACT(t));                                             \
        finishSM(PY0, PY1, alY, l_reg, pa0, pa1, pa2, pa3); SBAR();                                                           \
        if ((t) + 1 < NT) { if constexpr (F32) { VMW(); SWRITE_KF(SB); SBAR(); SLOAD_F((const float*)Vh, KBASE((t) + 1)); }  \
                            else { SLOAD_H(Kh, Vh, KBASE((t) + 1)); } SBAR(); }                                               \
        pv_tile<VB, SK>(o, vb0, pa0, pa1, pa2, pa3, ACT((t) - 1)); MASKT(PX0, PX1, (t)); partialSM(PX0, PX1, m_reg, mnX, alX);                                        \
        __syncthreads();                                                                                                      \
        if ((t) + 1 < NT) { VMW(); if constexpr (F32) { SWRITE_VF(SB); SBAR(); if ((t) + 2 < NT) SLOAD_F((const float*)Kh, KBASE((t) + 2)); } \
                            else { SWRITE_H(SB); } }                                                                          \
        RESC(alX); __syncthreads(); } while (0)
    for (int t = 1; t + 1 < NT; t += 2) {
        HALF_STEP(pB0, pB1, mnB, alB, pA0, pA1, alA, t, 1, 0, 0);
        HALF_STEP(pA0, pA1, mnA, alA, pB0, pB1, alB, t + 1, 0, 1, 1);
    }
    const bool even = (NT & 1) == 0;
    if (even) { SBAR(); qkt<1, SK>(pB0, pB1, K_lds, r32, hi, S.qr, ACT(NT - 1)); SBAR(); }
#define QROW(e) (nxt.Q + (size_t)(wid * QBLK + r32) * D + ((e) >> 1) * 16 + hi * 8 + ((e) & 1) * 4)
    if constexpr (F32) { SLOAD_F((const float*)nxt.K, kbn); SBAR();
#pragma unroll
        for (int e = 0; e < 8; ++e) S.tq[e] = *(const f32x4*)QROW(e); }
    else { SLOAD_H(nxt.K, nxt.V, kbn); SBAR();
#pragma unroll
        for (int d0 = 0; d0 < 8; ++d0) S.qr[d0] = load8<TIn>(nxt.Q + (size_t)(wid * QBLK + r32) * D + d0 * 16 + hi * 8); }
    SBAR();
    finishSM(pA0, pA1, alA, l_reg, pa0, pa1, pa2, pa3); SBAR();
    if constexpr (F32) {
#pragma unroll
        for (int e = 8; e < 16; ++e) S.tq[e] = *(const f32x4*)QROW(e); SBAR(); }
#undef QROW
    pv_tile<0, SK>(o, vb0, pa0, pa1, pa2, pa3, ACT(even ? NT - 2 : NT - 1));
    if (even) { MASKT(pB0, pB1, NT - 1); partialSM(pB0, pB1, m_reg, mnB, alB); __syncthreads(); RESC(alB);
        finishSM(pB0, pB1, alB, l_reg, pa0, pa1, pa2, pa3); SBAR(); pv_tile<1, SK>(o, vb0, pa0, pa1, pa2, pa3, ACT(NT - 1)); }
    SBAR(); SEAM_K0();
    if (hi == 0) li_l[r32] = l_reg; asm volatile("s_waitcnt lgkmcnt(0)" ::: "memory");
    float rli[16];
#pragma unroll
    for (int r = 0; r < 16; ++r) rli[r] = __builtin_amdgcn_rcpf(li_l[crow(r, hi)]);
    TOut* Ow = cur.O + (size_t)(wid * QBLK) * D;
#pragma unroll
    for (int r = 0; r < 16; ++r) { const int orow = crow(r, hi);
#pragma unroll
        for (int d0 = 0; d0 < 4; ++d0) { const float v = o[d0][r] * rli[r];
            if constexpr (same_t<TOut, float>::v) { Ow[(size_t)orow * D + d0 * 32 + r32] = v; }
            else { const float vn = __shfl_xor(v, 1);
                   if ((r32 & 1) == 0) *(unsigned*)(Ow + (size_t)orow * D + d0 * 32 + r32) = cvtpk(v, vn); } } }
    if constexpr (F32) {
#pragma unroll
        for (int d0 = 0; d0 < 8; ++d0) S.qr[d0] = pack8(S.tq[2 * d0], S.tq[2 * d0 + 1]); }
    __syncthreads();
#undef RESC
#undef KBASE
#undef ACT
#undef MASKT
#undef SEAM_K0
#undef HALF_STEP
}
#undef ROW
#undef VMW
#undef VMWN
#undef SLOAD_H
#undef SWRITE_HK
#undef SWRITE_HV
#undef SWRITE_H
#undef SLOAD_F
#undef SWRITE_KF
#undef SWRITE_VF
#undef KSWZ
#undef SBAR
}

#ifndef MK_PER_PHASE
#define MK_PER_PHASE 0
#endif
constexpr int NWAVES = 8, NTHR = 512;
constexpr int SEQ = 16384, DM = 4096, FFH = 11008, DEPTH = 4, NMODV = 6 * DM;
constexpr int ZG = 96;
constexpr size_t GS = (size_t)SEQ * 128;
constexpr int S5T = 64, S5NC = SEQ / S5T;
constexpr int KSL = 16;
constexpr float NORM_EPS = 1e-6f, SUBLN_EPS = 1e-5f;
constexpr int N_PHASES = 35;

constexpr size_t MiB = 1u << 20;
constexpr size_t WS_CTL = 0, CTL_ZERO_BYTES = 64 * 1024;
constexpr size_t WS_MODP = 1 * MiB;
constexpr size_t WS_MODL = 3 * MiB;
constexpr size_t WS_LAM = 3 * MiB + 512 * 1024;
constexpr size_t WS_S5P = 4 * MiB, S5P_LAYER = 2 * MiB + 256 * 1024;
constexpr size_t S5P_ABR = 0, S5P_ABI = 64 * 1024, S5P_ATR = 128 * 1024, S5P_ATI = 192 * 1024, S5P_BBR = 256 * 1024, S5P_BBI = 256 * 1024 + MiB;
constexpr size_t W_IN_B = (size_t)12288 * 4096 * 2, W_OUT_B = (size_t)4096 * 4096 * 2, W_GLU_B = (size_t)8192 * 4096 * 2, W_GU_B = (size_t)22016 * 4096 * 2, W_DN_B = (size_t)4096 * 11008 * 2;
constexpr size_t WS_WIN = 16 * MiB, WS_WOUT = WS_WIN + 2 * W_IN_B, WS_WGLU = WS_WOUT + 2 * W_OUT_B, WS_WGU = WS_WGLU + 2 * W_GLU_B, WS_WDN = WS_WGU + 4 * W_GU_B;
constexpr size_t WS_H = WS_WDN + 4 * W_DN_B;
constexpr size_t WS_MIX = WS_H + (size_t)SEQ * DM * 2;
constexpr size_t WS_Z = WS_MIX + (size_t)SEQ * DM * 2;
constexpr size_t WS_OT = WS_Z + (size_t)ZG * GS * 2;
constexpr size_t WS_S5F = WS_OT + (size_t)32 * GS * 4;
constexpr size_t WS_S5H = WS_S5F + (size_t)S5NC * 256 * 128 * 4;
constexpr size_t WS_END = WS_S5H + (size_t)S5NC * 256 * 128 * 4;
static_assert((size_t)SEQ * FFH * 2 <= (size_t)ZG * GS * 2, "hidden overlays Z");
static_assert(WS_WIN % 256 == 0 && WS_H % 256 == 0 && WS_OT % 256 == 0 && WS_S5F % 256 == 0, "alignment");
constexpr int CW_BAR = 1024;

constexpr int RING_BYTES = 131072, MISC_OFF = RING_BYTES + 320, LDS_BYTES = 147456;

#define GAS __attribute__((address_space(1)))
#define LAS __attribute__((address_space(3)))
typedef unsigned short bf16;
typedef unsigned v4u __attribute__((ext_vector_type(4)));
typedef unsigned v2u __attribute__((ext_vector_type(2)));
typedef float f32x4 __attribute__((ext_vector_type(4)));
#define LDS_WAIT() asm volatile("s_waitcnt lgkmcnt(0)" ::: "memory")
#define VM_WAIT() asm volatile("s_waitcnt vmcnt(0)" ::: "memory")
__device__ __forceinline__ unsigned pk2(float lo, float hi) { unsigned r; asm volatile("v_cvt_pk_bf16_f32 %0, %1, %2" : "=v"(r) : "v"(lo), "v"(hi)); return r; }
__device__ __forceinline__ float bflo(unsigned w) { return __builtin_bit_cast(float, w << 16); }
__device__ __forceinline__ float bfhi(unsigned w) { return __builtin_bit_cast(float, w & 0xffff0000u); }

#define XB_TMO      128
#define XB_XCNT(j)  (256  + 64 * (j))
#define XB_XSUB(j)  (1280 + 64 * (j))
#define XB_XGEN(j)  (2304 + 64 * (j))
#define XB_TOP      3328
#define XB_TOPGEN   3392
#define XCD_BAR_WORDS 3456
#define XB_SPIN_CAP (1u << 22)

__device__ __forceinline__ unsigned xb_ld(unsigned* p)              { return __hip_atomic_load(p, __ATOMIC_RELAXED, __HIP_MEMORY_SCOPE_AGENT); }
__device__ __forceinline__ unsigned xb_add(unsigned* p, unsigned v) { return __hip_atomic_fetch_add(p, v, __ATOMIC_RELAXED, __HIP_MEMORY_SCOPE_AGENT); }
__device__ __forceinline__ unsigned xb_xcc_id() { return (unsigned)__builtin_amdgcn_s_getreg((3 << 11) | 20) & 0xFu; }
#define XB_SPIN(cond, bar) do { unsigned _sp = 0; while (cond) { __builtin_amdgcn_s_sleep(1); \
    if ((++_sp & 255u) == 0u) { if (xb_ld(&(bar)[XB_TMO])) break; if (_sp > XB_SPIN_CAP) { atomicAdd(&(bar)[XB_TMO], 1u); break; } } } } while (0)

struct XcdBarrier {
    unsigned* bar; unsigned x;
    volatile LAS unsigned* st;
};
__device__ __forceinline__ XcdBarrier xcd_barrier_post(unsigned* bar, volatile LAS unsigned* st) {
    XcdBarrier b; b.bar = bar; b.x = xb_xcc_id(); b.st = st;
    if (threadIdx.x == 0) (void)xb_add(&bar[XB_XCNT(b.x)], 1u);
    return b;
}
__device__ __forceinline__ void xcd_barrier_complete(unsigned* bar, unsigned x, unsigned& nloc, unsigned& nx) {
    const unsigned G = gridDim.x * gridDim.y * gridDim.z;
    unsigned sum, cnt, mine, sp = 0u;
    for (;;) {
        sum = 0u; cnt = 0u; mine = 0u;
#pragma unroll
        for (unsigned j = 0; j < 16; ++j) { const unsigned c = xb_ld(&bar[XB_XCNT(j)]); sum += c; cnt += (c > 0u) ? 1u : 0u; mine = (j == x) ? c : mine; }
        if (sum == G) break;
        __builtin_amdgcn_s_sleep(1);
        if ((++sp & 255u) == 0u) { if (xb_ld(&bar[XB_TMO])) break; if (sp > XB_SPIN_CAP) { atomicAdd(&bar[XB_TMO], 1u); break; } }
    }
    nloc = mine > 0u ? mine : 1u; nx = cnt > 0u ? cnt : 1u;
}
__device__ __forceinline__ void xcd_barrier(const XcdBarrier& b) {
    asm volatile("s_waitcnt vmcnt(0)" ::: "memory");
    __syncthreads();
    if (threadIdx.x == 0) {
        unsigned* bar = b.bar;
        __builtin_amdgcn_s_waitcnt(0);
        unsigned nloc = b.st[0], nx = b.st[1];
        if (nloc == 0u) { xcd_barrier_complete(bar, b.x, nloc, nx); b.st[0] = nloc; b.st[1] = nx; }
        const unsigned old = xb_add(&bar[XB_XSUB(b.x)], 1u);
        const unsigned gen = old / nloc;
        if (old + 1u == (gen + 1u) * nloc) {
            __builtin_amdgcn_fence(__ATOMIC_RELEASE, "agent");
            asm volatile("s_waitcnt vmcnt(0)" ::: "memory");
            const unsigned og = xb_add(&bar[XB_TOP], 1u);
            const unsigned tg = og / nx;
            if (og + 1u == (tg + 1u) * nx) xb_add(&bar[XB_TOPGEN], 1u);
            else XB_SPIN(xb_ld(&bar[XB_TOPGEN]) == tg, bar);
            __builtin_amdgcn_fence(__ATOMIC_ACQUIRE, "agent");
            xb_add(&bar[XB_XGEN(b.x)], 1u);
            asm volatile("s_waitcnt vmcnt(0)" ::: "memory");
        } else {
            XB_SPIN(xb_ld(&bar[XB_XGEN(b.x)]) == gen, bar);
            __builtin_amdgcn_fence(__ATOMIC_ACQUIRE, "agent");
            asm volatile("s_waitcnt vmcnt(0)" ::: "memory");
        }
    }
    __syncthreads();
}

__device__ __forceinline__ float wave_sum(float v) {
#pragma unroll
    for (int o = 1; o < 64; o <<= 1) v += __shfl_xor(v, o);
    return v;
}

__device__ __forceinline__ void transpose_item(const float* W, int K, int N, bf16* WT, int mode, LAS float* scr, int item, int lane) {
    const int nblk = N / 32, kb = item / nblk, nb = item - kb * nblk, k0 = 64 * kb, n0 = 32 * nb;
    const int drow0 = mode == 0 ? n0 : ((n0 >> 7) * 256 + (n0 & 127) + (mode == 2 ? 128 : 0));
#pragma unroll 8
    for (int i = 0; i < 32; ++i) { const int kk = 2 * i + (lane >> 5); scr[kk * 33 + (lane & 31)] = W[(size_t)(k0 + kk) * N + n0 + (lane & 31)]; }
    LDS_WAIT(); asm volatile("" ::: "memory");
    const int c = lane & 7;
#pragma unroll
    for (int j = 0; j < 4; ++j) { const int n = (lane >> 3) + 8 * j; const LAS float* s = scr + (8 * c) * 33 + n;
        v4u o; o.x = pk2(s[0 * 33], s[1 * 33]); o.y = pk2(s[2 * 33], s[3 * 33]); o.z = pk2(s[4 * 33], s[5 * 33]); o.w = pk2(s[6 * 33], s[7 * 33]);
        *(v4u*)(WT + (size_t)(drow0 + n) * K + k0 + 8 * c) = o; }
    LDS_WAIT(); asm volatile("" ::: "memory");
}
__device__ __forceinline__ void dsincos(double x, double& s, double& c) {
    const double k = rint(x * 0.63661977236758134308);
    double r = fma(-k, 1.5707963267948966192, x); r = fma(-k, 6.1232339957367658860e-17, r);
    const double r2 = r * r;
    double ps = -1.0 / 1307674368000.0; ps = fma(ps, r2, 1.0 / 6227020800.0); ps = fma(ps, r2, -1.0 / 39916800.0); ps = fma(ps, r2, 1.0 / 362880.0); ps = fma(ps, r2, -1.0 / 5040.0);
    ps = fma(ps, r2, 1.0 / 120.0); ps = fma(ps, r2, -1.0 / 6.0); ps = fma(ps, r2, 1.0); const double sn = r * ps;
    double pc = 1.0 / 20922789888000.0; pc = fma(pc, r2, -1.0 / 87178291200.0); pc = fma(pc, r2, 1.0 / 479001600.0); pc = fma(pc, r2, -1.0 / 3628800.0); pc = fma(pc, r2, 1.0 / 40320.0);
    pc = fma(pc, r2, -1.0 / 720.0); pc = fma(pc, r2, 1.0 / 24.0); pc = fma(pc, r2, -0.5); const double cs = fma(pc, r2, 1.0);
    const int q = (int)k & 3;
    s = (q == 0) ? sn : (q == 1) ? cs : (q == 2) ? -sn : -cs;
    c = (q == 0) ? cs : (q == 1) ? -sn : (q == 2) ? -cs : sn;
}
__device__ __forceinline__ double dexp(double x) {
    const double k = rint(x * 1.4426950408889634074);
    double r = fma(-k, 0.69314718055994528623, x); r = fma(-k, 2.3190468138462995584e-17, r);
    double p = 1.0 / 87178291200.0; p = fma(p, r, 1.0 / 6227020800.0); p = fma(p, r, 1.0 / 479001600.0); p = fma(p, r, 1.0 / 39916800.0); p = fma(p, r, 1.0 / 3628800.0); p = fma(p, r, 1.0 / 362880.0);
    p = fma(p, r, 1.0 / 40320.0); p = fma(p, r, 1.0 / 5040.0); p = fma(p, r, 1.0 / 720.0); p = fma(p, r, 1.0 / 120.0); p = fma(p, r, 1.0 / 24.0); p = fma(p, r, 1.0 / 6.0); p = fma(p, r, 0.5); p = fma(p, r, 1.0); p = fma(p, r, 1.0);
    const long long bits = (long long)(1023 + (int)k) << 52;
    return p * __builtin_bit_cast(double, bits);
}

struct Args { const float* in[29]; float* out; unsigned char* ws; int ph_lo, ph_hi; };

__device__ __forceinline__ void p0_prologue(const Args& A, LAS unsigned char* lds, int gw, int NGW, int wave, int lane) {
    unsigned char* ws = A.ws;
    for (int w = gw; w < 96 * KSL + 512; w += NGW) {
    if (w < 96 * KSL) {
        const int nb = w % 96, ks = w / 96;
        const float* wp = A.in[2] + (size_t)(ks * 256) * NMODV + nb * 256 + lane * 4; const float* cp = A.in[1] + ks * 256;
        f32x4 a = {0.f, 0.f, 0.f, 0.f};
#pragma unroll 8
        for (int k = 0; k < 256; ++k) { const float cv = cp[k]; const float s = cv / (1.0f + expf(-cv)); const f32x4 w = *(const f32x4*)(wp + (size_t)k * NMODV); a += s * w; }
        *(f32x4*)((float*)(ws + WS_MODP) + (size_t)ks * NMODV + nb * 256 + lane * 4) = a;
    } else {
        const int idx = (w - 96 * KSL) * 64 + lane, o = idx >> 14, gp = idx & 16383, g = gp >> 6;
        const double lr = (double)fminf(A.in[16][idx], -1e-4f), li = (double)A.in[17][idx], dt = dexp((double)A.in[18][o * 256 + g]);
        const double mag = dexp(lr * dt); double sn, cs; dsincos(li * dt, sn, cs);
        const double abr = mag * cs, abi = mag * sn, den = lr * lr + li * li, nr = abr - 1.0, ni = abi;
        const double fre = (nr * lr + ni * li) / den, fim = (ni * lr - nr * li) / den;
        double tr = abr, ti = abi;
#pragma unroll
        for (int q = 0; q < 6; ++q) { const double t2 = tr * tr - ti * ti; ti = 2.0 * tr * ti; tr = t2; }
        unsigned char* pb = ws + WS_S5P + (size_t)o * S5P_LAYER;
        ((float*)(pb + S5P_ABR))[gp] = (float)abr; ((float*)(pb + S5P_ABI))[gp] = (float)abi; ((float*)(pb + S5P_ATR))[gp] = (float)tr; ((float*)(pb + S5P_ATI))[gp] = (float)ti;
        const float* bre = A.in[19] + (size_t)idx * 16; const float* bim = A.in[20] + (size_t)idx * 16;
        float* obr = (float*)(pb + S5P_BBR) + (size_t)gp * 16; float* obi = (float*)(pb + S5P_BBI) + (size_t)gp * 16;
#pragma unroll
        for (int h4 = 0; h4 < 4; ++h4) { const f32x4 br = *(const f32x4*)(bre + 4 * h4), bi = *(const f32x4*)(bim + 4 * h4); f32x4 r, i;
#pragma unroll
            for (int j = 0; j < 4; ++j) { r[j] = (float)(fre * (double)br[j] - fim * (double)bi[j]); i[j] = (float)(fre * (double)bi[j] + fim * (double)br[j]); }
            *(f32x4*)(obr + 4 * h4) = r; *(f32x4*)(obi + 4 * h4) = i; }
    }
    }
    if (gw < 2) { const int e = gw;
        const float s1 = wave_sum(A.in[10][e * 128 + lane] * A.in[11][e * 128 + lane] + A.in[10][e * 128 + 64 + lane] * A.in[11][e * 128 + 64 + lane]);
        const float s2 = wave_sum(A.in[12][e * 128 + lane] * A.in[13][e * 128 + lane] + A.in[12][e * 128 + 64 + lane] * A.in[13][e * 128 + 64 + lane]);
        const float lam_init = e == 0 ? 0.2f : 0.4707130183435842f;
        if (lane == 0) ((float*)(ws + WS_LAM))[e] = expf(s1) - expf(s2) + lam_init; }
    LAS float* scr = (LAS float*)(lds + wave * 16384);
    constexpr int I_IN = 64 * 384, I_OUT = 64 * 128, I_GLU = 64 * 128, I_GU = 64 * 344, I_DN = 172 * 128;
    constexpr int NITEMS = 2 * I_IN + 2 * I_OUT + 4 * I_GLU + 8 * I_GU + 4 * I_DN;
    for (int it = gw; it < NITEMS; it += NGW) {
        int r = it;
        if (r < 2 * I_IN) { const int e = r / I_IN; transpose_item(A.in[8] + (size_t)e * DM * 12288, DM, 12288, (bf16*)(ws + WS_WIN + e * W_IN_B), 0, scr, r - e * I_IN, lane); continue; } r -= 2 * I_IN;
        if (r < 2 * I_OUT) { const int e = r / I_OUT; transpose_item(A.in[15] + (size_t)e * DM * DM, DM, DM, (bf16*)(ws + WS_WOUT + e * W_OUT_B), 0, scr, r - e * I_OUT, lane); continue; } r -= 2 * I_OUT;
        if (r < 4 * I_GLU) { const int q = r / I_GLU, o = q >> 1, s = q & 1; transpose_item(A.in[24 + s] + (size_t)o * DM * DM, DM, DM, (bf16*)(ws + WS_WGLU + o * W_GLU_B), 1 + s, scr, r - q * I_GLU, lane); continue; } r -= 4 * I_GLU;
        if (r < 8 * I_GU) { const int q = r / I_GU, l = q >> 1, s = q & 1; transpose_item(A.in[26 + s] + (size_t)l * DM * FFH, DM, FFH, (bf16*)(ws + WS_WGU + l * W_GU_B), 1 + s, scr, r - q * I_GU, lane); continue; } r -= 8 * I_GU;
        { const int l = r / I_DN; transpose_item(A.in[28] + (size_t)l * FFH * DM, FFH, DM, (bf16*)(ws + WS_WDN + l * W_DN_B), 0, scr, r - l * I_DN, lane); }
    }
}
__device__ __forceinline__ void p1_modvec(const Args& A, int gtid, int NGT) {
    const float* mp = (const float*)(A.ws + WS_MODP); float* ml = (float*)(A.ws + WS_MODL);
    for (int i = gtid; i < DEPTH * NMODV; i += NGT) { const int j = i % NMODV; float v = A.in[3][j] + A.in[4][i];
#pragma unroll
        for (int ks = 0; ks < KSL; ++ks) v += mp[(size_t)ks * NMODV + j];
        ml[i] = v; }
}
__device__ __forceinline__ void norm_mod_phase(const float* src, const float* nw, const float* sh, const float* sc, bf16* dst, LAS unsigned char* lds, int tid, int gw, int NGW, int lane) {
    LAS float* w1 = (LAS float*)lds; LAS float* bb = w1 + DM;
    for (int i = tid; i < DM; i += NTHR) { w1[i] = nw[i] * (1.0f + sc[i]); bb[i] = sh[i]; }
    __syncthreads();
    for (int m = gw; m < SEQ; m += NGW) {
        const f32x4* xr = (const f32x4*)(src + (size_t)m * DM) + lane;
        f32x4 v[16]; float ss = 0.f;
#pragma unroll
        for (int j = 0; j < 16; ++j) { v[j] = xr[64 * j]; ss += (v[j].x * v[j].x + v[j].y * v[j].y) + (v[j].z * v[j].z + v[j].w * v[j].w); }
        const float rstd = 1.0f / sqrtf(wave_sum(ss) * (1.0f / DM) + NORM_EPS);
        v2u* o8 = (v2u*)(dst + (size_t)m * DM) + lane;
#pragma unroll
        for (int j = 0; j < 16; ++j) { const int col = j * 256 + lane * 4; const f32x4 w = *(const LAS f32x4*)(w1 + col), b = *(const LAS f32x4*)(bb + col);
            const f32x4 y = v[j] * rstd * w + b; v2u p; p.x = pk2(y.x, y.y); p.y = pk2(y.z, y.w); o8[64 * j] = p; }
    }
    __syncthreads();
}
__device__ __forceinline__ void final_norm_phase(const float* src, const float* nw, float* dst, int gw, int NGW, int lane) {
    for (int m = gw; m < SEQ; m += NGW) {
        const f32x4* xr = (const f32x4*)(src + (size_t)m * DM) + lane;
        f32x4 v[16]; float ss = 0.f;
#pragma unroll
        for (int j = 0; j < 16; ++j) { v[j] = xr[64 * j]; ss += (v[j].x * v[j].x + v[j].y * v[j].y) + (v[j].z * v[j].z + v[j].w * v[j].w); }
        const float rstd = 1.0f / sqrtf(wave_sum(ss) * (1.0f / DM) + NORM_EPS);
        f32x4* o = (f32x4*)(dst + (size_t)m * DM) + lane; const f32x4* wv = (const f32x4*)nw + lane;
#pragma unroll
        for (int j = 0; j < 16; ++j) o[64 * j] = v[j] * rstd * wv[64 * j];
    }
}
__device__ __forceinline__ void conv_phase(const bf16* Z, const float* cw, bf16* MIX, int gtid, int NGT) {
    for (int i = gtid; i < SEQ * 256; i += NGT) {
        const int t = i >> 8, r = i & 255, gi = r >> 4, c8 = (r & 15) * 8;
        const size_t o = (size_t)t * 128 + c8;
        const v4u zero = {0u, 0u, 0u, 0u};
        const v4u vb = *(const v4u*)(Z + (size_t)gi * GS + o);
        const bf16* zc = Z + (size_t)(16 + gi) * GS + o; const bf16* zx = Z + (size_t)(32 + gi) * GS + o;
        const v4u c0 = *(const v4u*)zc, x0 = *(const v4u*)zx;
        const v4u c1 = t >= 1 ? *(const v4u*)(zc - 128) : zero, x1 = t >= 1 ? *(const v4u*)(zx - 128) : zero;
        const v4u c2 = t >= 2 ? *(const v4u*)(zc - 256) : zero, x2 = t >= 2 ? *(const v4u*)(zx - 256) : zero;
        const float* wp = cw + gi * 128 + c8;
        float y[8];
#pragma unroll
        for (int q = 0; q < 4; ++q) {
            const float u0l = bflo(c0[q]) * bflo(x0[q]), u0h = bfhi(c0[q]) * bfhi(x0[q]);
            const float u1l = bflo(c1[q]) * bflo(x1[q]), u1h = bfhi(c1[q]) * bfhi(x1[q]);
            const float u2l = bflo(c2[q]) * bflo(x2[q]), u2h = bfhi(c2[q]) * bfhi(x2[q]);
            const int j = 2 * q;
            y[j]     = bflo(vb[q]) * (wp[2 * 2048 + j] * u0l + wp[2048 + j] * u1l + wp[j] * u2l);
            y[j + 1] = bfhi(vb[q]) * (wp[2 * 2048 + j + 1] * u0h + wp[2048 + j + 1] * u1h + wp[j + 1] * u2h);
        }
        v4u w; w.x = pk2(y[0], y[1]); w.y = pk2(y[2], y[3]); w.z = pk2(y[4], y[5]); w.w = pk2(y[6], y[7]);
        *(v4u*)(MIX + (size_t)t * DM + gi * 128 + c8) = w;
    }
}
__device__ __forceinline__ void combine_phase(const float* OT, const float* lamp, const float* sg, float lam_init, bf16* MIX, int gw, int NGW, int lane) {
    const float lam = lamp[0], os = 1.0f - lam_init;
    const int j = lane >> 5, c4 = (lane & 31) * 4;
    const f32x4 gv = *(const f32x4*)(sg + 128 * j + c4);
    for (int it = gw; it < SEQ * 8; it += NGW) {
        const int t = it >> 3, h = it & 7;
        const f32x4 a = *(const f32x4*)(OT + (size_t)(h * 4 + j) * GS + (size_t)t * 128 + c4), b = *(const f32x4*)(OT + (size_t)(h * 4 + 2 + j) * GS + (size_t)t * 128 + c4);
        const f32x4 o = a - lam * b;
        const float rstd = 1.0f / sqrtf(wave_sum((o.x * o.x + o.y * o.y) + (o.z * o.z + o.w * o.w)) * (1.0f / 256.0f) + SUBLN_EPS);
        const f32x4 y = o * (rstd * os) * gv;
        v2u p; p.x = pk2(y.x, y.y); p.y = pk2(y.z, y.w);
        *(v2u*)(MIX + (size_t)t * DM + 2048 + 256 * h + 128 * j + c4) = p;
    }
}
__device__ __forceinline__ att::BlockRef<att::bf16, float> att_ref(const bf16* Z, float* OT, int item, int pass) {
    const int r = item >> 8, b = item & 255, vh = r * 8 + (b & 7), pair = b >> 3, qb = pass ? 63 - pair : pair;
    const int h = vh >> 2, m = (vh >> 1) & 1, j = vh & 1;
    att::BlockRef<att::bf16, float> R;
    R.Q = (const att::bf16*)(Z + (size_t)(48 + 2 * h + m) * GS + (size_t)qb * 256 * 128);
    R.K = (const att::bf16*)(Z + (size_t)(64 + 2 * h + m) * GS);
    R.V = (const att::bf16*)(Z + (size_t)(80 + 2 * h + j) * GS);
    R.O = OT + (size_t)vh * GS + (size_t)qb * 256 * 128; R.P0 = qb * 256;
    return R;
}
__device__ __forceinline__ void attn_phase(const bf16* Z, float* OT, char* lds, int bid, int G) {
    constexpr int TOTAL = 1024;
    int item = bid; if (item >= TOTAL) return;
    int pass = 0;
    att::BlockRef<att::bf16, float> cur = att_ref(Z, OT, item, 0);
    att::Seam<att::bf16> S;
    att::causal_swa_prime<att::bf16, float>(cur, SEQ, lds, S);
    for (;;) {
        const bool more_pass = pass == 0, more_item = item + G < TOTAL, last = !more_pass && !more_item;
        int itn = item, passn = 1;
        if (!more_pass) { passn = 0; itn = more_item ? item + G : item; }
        const att::BlockRef<att::bf16, float> nxt = last ? cur : att_ref(Z, OT, itn, passn);
        att::causal_swa_block<att::bf16, float>(cur, nxt, SEQ, SEQ, lds, S);
        if (last) break;
        cur = nxt; item = itn; pass = passn;
    }
}
__device__ __forceinline__ float gelu_tanh(float x) { const float z = 1.5957691216057308f * (x + 0.044715f * x * x * x); return x * __builtin_amdgcn_rcpf(1.0f + __builtin_amdgcn_exp2f(-1.4426950408889634f * z)); }
template <bool PASS2>
__device__ __forceinline__ void s5_pass(const bf16* Hin, const unsigned char* prm, const float* c_re, const float* c_im, const float* dsk, float* F, const float* HC, bf16* Gout,
                                        LAS unsigned char* lds, int gw, int NGW, int wave, int lane) {
    LAS float* lu = (LAS float*)(lds + wave * 4096);
    for (int item = gw; item < 256 * S5NC; item += NGW) {
        const int g = item & 255, c = item >> 8, gp = g * 64 + lane;
        { const bf16* up = Hin + (size_t)(c * S5T + lane) * DM + 16 * g; const v4u a = *(const v4u*)up, b = *(const v4u*)(up + 8);
          LAS f32x4* ur = (LAS f32x4*)(lu + lane * 16);
          ur[0] = (f32x4){bflo(a.x), bfhi(a.x), bflo(a.y), bfhi(a.y)}; ur[1] = (f32x4){bflo(a.z), bfhi(a.z), bflo(a.w), bfhi(a.w)};
          ur[2] = (f32x4){bflo(b.x), bfhi(b.x), bflo(b.y), bfhi(b.y)}; ur[3] = (f32x4){bflo(b.z), bfhi(b.z), bflo(b.w), bfhi(b.w)}; }
        f32x4 bbr[4], bbi[4];
#pragma unroll
        for (int q = 0; q < 4; ++q) { bbr[q] = *(const f32x4*)((const float*)(prm + S5P_BBR) + (size_t)gp * 16 + 4 * q); bbi[q] = *(const f32x4*)((const float*)(prm + S5P_BBI) + (size_t)gp * 16 + 4 * q); }
        const float abr = ((const float*)(prm + S5P_ABR))[gp], abi = ((const float*)(prm + S5P_ABI))[gp];
        float hr = 0.f, hi = 0.f, cr[16], ci[16], dk = 0.f;
        if (PASS2) {
#pragma unroll
            for (int o = 0; o < 16; ++o) { cr[o] = c_re[(size_t)(g * 16 + o) * 64 + lane]; ci[o] = c_im[(size_t)(g * 16 + o) * 64 + lane]; }
            hr = HC[(size_t)(c * 256 + g) * 128 + lane]; hi = HC[(size_t)(c * 256 + g) * 128 + 64 + lane]; dk = dsk[16 * g + (lane >> 2)];
        }
        LDS_WAIT(); asm volatile("" ::: "memory");
#pragma unroll 2
        for (int t = 0; t < S5T; ++t) {
            const LAS f32x4* ut = (const LAS f32x4*)(lu + t * 16);
            float bur = 0.f, bui = 0.f;
#pragma unroll
            for (int q = 0; q < 4; ++q) { const f32x4 u = ut[q];
                bur += (bbr[q].x * u.x + bbr[q].y * u.y) + (bbr[q].z * u.z + bbr[q].w * u.w); bui += (bbi[q].x * u.x + bbi[q].y * u.y) + (bbi[q].z * u.z + bbi[q].w * u.w); }
            const float nr = abr * hr - abi * hi + bur, ni = abr * hi + abi * hr + bui; hr = nr; hi = ni;
            if (PASS2) {
                float v[16];
#pragma unroll
                for (int o = 0; o < 16; ++o) v[o] = hr * cr[o] - hi * ci[o];
#pragma unroll
                for (int i = 0; i < 8; ++i) { const float send = (lane & 32) ? v[i] : v[i + 8], keep = (lane & 32) ? v[i + 8] : v[i]; v[i] = keep + __shfl_xor(send, 32); }
#pragma unroll
                for (int i = 0; i < 4; ++i) { const float send = (lane & 16) ? v[i] : v[i + 4], keep = (lane & 16) ? v[i + 4] : v[i]; v[i] = keep + __shfl_xor(send, 16); }
#pragma unroll
                for (int i = 0; i < 2; ++i) { const float send = (lane & 8) ? v[i] : v[i + 2], keep = (lane & 8) ? v[i + 2] : v[i]; v[i] = keep + __shfl_xor(send, 8); }
                { const float send = (lane & 4) ? v[0] : v[1], keep = (lane & 4) ? v[1] : v[0]; v[0] = keep + __shfl_xor(send, 4); }
                v[0] += __shfl_xor(v[0], 2); v[0] += __shfl_xor(v[0], 1);
                const float yy = v[0] + dk * lu[t * 16 + (lane >> 2)];
                const float gl = gelu_tanh(yy);
                if ((lane & 3) == 0) Gout[(size_t)(c * S5T + t) * DM + 16 * g + (lane >> 2)] = (bf16)(pk2(gl, gl) & 0xffffu);
            }
        }
        if (!PASS2) { F[(size_t)(c * 256 + g) * 128 + lane] = hr; F[(size_t)(c * 256 + g) * 128 + 64 + lane] = hi; }
        LDS_WAIT(); asm volatile("" ::: "memory");
    }
}
__device__ __forceinline__ void s5_carry(const unsigned char* prm, const float* F, float* HC, int gtid) {
    if (gtid < 256 * 64) {
        const int g = gtid >> 6, p = gtid & 63;
        const float atr = ((const float*)(prm + S5P_ATR))[gtid], ati = ((const float*)(prm + S5P_ATI))[gtid];
        float hr = 0.f, hi = 0.f;
#pragma unroll 8
        for (int c = 0; c < S5NC; ++c) { const size_t o = (size_t)(c * 256 + g) * 128 + p;
            HC[o] = hr; HC[o + 64] = hi; const float fr = F[o], fi = F[o + 64];
            const float nr = atr * hr - ati * hi + fr, ni = atr * hi + ati * hr + fi; hr = nr; hi = ni; }
    }
}

struct Ctx { int lo, hi, tid, lane, wave, gw, NGW, gtid, NGT, G, bid; };
#define IN(k) (lo <= (k) && (k) < hi)
#define SEAM(k) do { if (IN(k) && IN((k) + 1)) xcd_barrier(bar); } while (0)
#define FFN_PHASES(l, pb) do { \
    const float* ml_ = MODL + (size_t)(l) * NMODV; \
    if (IN((pb) + 5)) norm_mod_phase(XR, args.in[6] + (size_t)(l) * DM, ml_ + 3 * DM, ml_ + 4 * DM, Hb, lds, tid, gw, NGW, lane); \
    SEAM((pb) + 5); \
    if (IN((pb) + 6)) { pg8::Gemm g{Hb, (const bf16*)(ws + WS_WGU + (size_t)(l) * W_GU_B), SEQ, 2 * FFH, DM}; pg8::StaticOrder S; S.init(SEQ, 2 * FFH, G, bid); \
        pg8::EpiSwiGLU E{HID, FFH}; pg8::gemm_phase<pg8::EpiSwiGLU, pg8::StaticOrder, true, true>(lds, g, S, E); } \
    SEAM((pb) + 6); \
    if (IN((pb) + 7)) { pg8::Gemm g{HID, (const bf16*)(ws + WS_WDN + (size_t)(l) * W_DN_B), SEQ, DM, FFH}; pg8::StaticOrder S; S.init(SEQ, DM, G, bid); \
        pg8::EpiResid E{XR, XR, ml_ + 5 * DM, DM}; pg8::gemm_phase<pg8::EpiResid, pg8::StaticOrder, true, true>(lds, g, S, E); } \
    SEAM((pb) + 7); } while (0)
template <int lp>
__device__ __forceinline__ void layer_pair(const Args& args, const Ctx& C, LAS unsigned char* lds, unsigned char* lds_raw, const XcdBarrier& bar) {
    const int lo = C.lo, hi = C.hi, tid = C.tid, lane = C.lane, wave = C.wave, gw = C.gw, NGW = C.NGW, gtid = C.gtid, NGT = C.NGT, G = C.G, bid = C.bid;
    unsigned char* ws = args.ws;
    bf16* const Hb = (bf16*)(ws + WS_H); bf16* const MIX = (bf16*)(ws + WS_MIX); bf16* const Z = (bf16*)(ws + WS_Z); bf16* const HID = (bf16*)(ws + WS_Z);
    float* const OT = (float*)(ws + WS_OT); float* const XR = args.out;
    const float* const MODL = (const float*)(ws + WS_MODL);
        { const int l = 2 * lp, pb = 2 + 8 * l; const float* ml = MODL + (size_t)l * NMODV;
          const float* xin = (l == 0) ? args.in[0] : XR;
          if (IN(pb)) norm_mod_phase(xin, args.in[5] + (size_t)l * DM, ml, ml + DM, Hb, lds, tid, gw, NGW, lane);
          SEAM(pb);
          if (IN(pb + 1)) { pg8::Gemm g{Hb, (const bf16*)(ws + WS_WIN + (size_t)lp * W_IN_B), SEQ, 12288, DM}; pg8::StaticOrder S; S.init(SEQ, 12288, G, bid);
              pg8::EpiHeadMajor E{Z, GS}; pg8::gemm_phase<pg8::EpiHeadMajor, pg8::StaticOrder, true, true>(lds, g, S, E); }
          SEAM(pb + 1);
          if (IN(pb + 2)) { conv_phase(Z, args.in[9] + (size_t)lp * 3 * 2048, MIX, gtid, NGT); attn_phase(Z, OT, (char*)lds_raw, bid, G); }
          SEAM(pb + 2);
          if (IN(pb + 3)) combine_phase(OT, (const float*)(ws + WS_LAM) + lp, args.in[14] + lp * 256, lp == 0 ? 0.2f : 0.4707130183435842f, MIX, gw, NGW, lane);
          SEAM(pb + 3);
          if (IN(pb + 4)) { pg8::Gemm g{MIX, (const bf16*)(ws + WS_WOUT + (size_t)lp * W_OUT_B), SEQ, DM, DM}; pg8::StaticOrder S; S.init(SEQ, DM, G, bid);
              pg8::EpiResid E{xin, XR, ml + 2 * DM, DM}; pg8::gemm_phase<pg8::EpiResid, pg8::StaticOrder, true, true>(lds, g, S, E); }
          SEAM(pb + 4);
          FFN_PHASES(l, pb);
        }
        { const int l = 2 * lp + 1, pb = 2 + 8 * l; const float* ml = MODL + (size_t)l * NMODV;
          const unsigned char* prm = ws + WS_S5P + (size_t)lp * S5P_LAYER;
          float* const S5F = (float*)(ws + WS_S5F); float* const S5H = (float*)(ws + WS_S5H);
          if (IN(pb)) norm_mod_phase(XR, args.in[5] + (size_t)l * DM, ml, ml + DM, Hb, lds, tid, gw, NGW, lane);
          SEAM(pb);
          if (IN(pb + 1)) s5_pass<false>(Hb, prm, nullptr, nullptr, nullptr, S5F, nullptr, nullptr, lds, gw, NGW, wave, lane);
          SEAM(pb + 1);
          if (IN(pb + 2)) s5_carry(prm, S5F, S5H, gtid);
          SEAM(pb + 2);
          if (IN(pb + 3)) s5_pass<true>(Hb, prm, args.in[21] + (size_t)lp * 256 * 16 * 64, args.in[22] + (size_t)lp * 256 * 16 * 64, args.in[23] + (size_t)lp * DM, nullptr, S5H, MIX, lds, gw, NGW, wave, lane);
          SEAM(pb + 3);
          if (IN(pb + 4)) { pg8::Gemm g{MIX, (const bf16*)(ws + WS_WGLU + (size_t)lp * W_GLU_B), SEQ, 2 * DM, DM}; pg8::StaticOrder S; S.init(SEQ, 2 * DM, G, bid);
              pg8::EpiGluResid E{XR, XR, ml + 2 * DM, DM}; pg8::gemm_phase<pg8::EpiGluResid, pg8::StaticOrder, true, true>(lds, g, S, E); }
          SEAM(pb + 4);
          FFN_PHASES(l, pb);
        }
    }
#undef FFN_PHASES
#undef IN
#undef SEAM

__global__ void __launch_bounds__(NTHR, 2) trunk_fwd(Args args) {
    extern __shared__ __attribute__((aligned(16))) unsigned char lds_raw[];
    LAS unsigned char* lds = (LAS unsigned char*)lds_raw;
    volatile LAS unsigned* MISC = (volatile LAS unsigned*)(lds + MISC_OFF);
    const int tid = opaque_tid(), lane = tid & 63, wave = __builtin_amdgcn_readfirstlane(tid >> 6);
    const int G = gridDim.x, bid = blockIdx.x;
    const int vcu = (G % 8 == 0) ? (bid % 8) * (G / 8) + bid / 8 : bid;
    const int gw = vcu * NWAVES + wave, NGW = G * NWAVES, gtid = vcu * NTHR + tid, NGT = G * NTHR;
    unsigned char* ws = args.ws;
    const int lo = args.ph_lo, hi = args.ph_hi;
    for (int u = tid; u < (LDS_BYTES - RING_BYTES) / 4; u += NTHR) ((LAS unsigned*)(lds + RING_BYTES))[u] = 0u;
    __syncthreads();
    XcdBarrier bar; bar.bar = (unsigned*)(ws + WS_CTL) + CW_BAR; bar.x = 0; bar.st = MISC + 8;
    if (hi - lo > 1) bar = xcd_barrier_post((unsigned*)(ws + WS_CTL) + CW_BAR, MISC + 8);
    const Ctx C{lo, hi, tid, lane, wave, gw, NGW, gtid, NGT, G, bid};
#define IN(k) (lo <= (k) && (k) < hi)
#define SEAM(k) do { if (IN(k) && IN((k) + 1)) xcd_barrier(bar); } while (0)

    bf16* const Hb = (bf16*)(ws + WS_H); bf16* const MIX = (bf16*)(ws + WS_MIX); bf16* const Z = (bf16*)(ws + WS_Z); bf16* const HID = (bf16*)(ws + WS_Z);
    float* const OT = (float*)(ws + WS_OT); float* const XR = args.out;
    const float* const MODL = (const float*)(ws + WS_MODL);

    if (IN(0)) p0_prologue(args, lds, gw, NGW, wave, lane);
    SEAM(0);
    if (IN(1)) p1_modvec(args, gtid, NGT);
    SEAM(1);


    layer_pair<0>(args, C, lds, lds_raw, bar);
    layer_pair<1>(args, C, lds, lds_raw, bar);
    if (IN(34)) final_norm_phase(XR, args.in[7], XR, gw, NGW, lane);
#undef IN
#undef SEAM
}

extern "C" void kernel_launch(void* const* d_in, const int* in_sizes, int n_in, void* d_out, int out_size, void* d_ws, size_t ws_size, hipStream_t stream) {
    static int grid = 0;
    if (grid == 0) {
        if (n_in != 29 || in_sizes[0] != SEQ * DM || out_size != SEQ * DM || ws_size < WS_END) {
            fprintf(stderr, "kernel_launch: built for 29 inputs, x/out of %d floats, >= %zu bytes of workspace; got n_in %d, in0 %d, out %d, ws %zu; nothing launched\n", SEQ * DM, (size_t)WS_END, n_in, n_in > 0 ? in_sizes[0] : -1, out_size, ws_size); grid = -1; return; }
        int dev = 0, cus = 0, per_cu = 0;
        if (hipGetDevice(&dev) != hipSuccess || hipDeviceGetAttribute(&cus, hipDeviceAttributeMultiprocessorCount, dev) != hipSuccess) { fprintf(stderr, "kernel_launch: device query failed\n"); grid = -1; return; }
        if (hipFuncSetAttribute((const void*)trunk_fwd, hipFuncAttributeMaxDynamicSharedMemorySize, LDS_BYTES) != hipSuccess) { fprintf(stderr, "kernel_launch: hipFuncSetAttribute failed\n"); grid = -1; return; }
        if (hipOccupancyMaxActiveBlocksPerMultiprocessor(&per_cu, (const void*)trunk_fwd, NTHR, LDS_BYTES) != hipSuccess || per_cu < 1) { fprintf(stderr, "kernel_launch: occupancy query reports %d workgroups per CU\n", per_cu); }
        (void)hipGetLastError();
        grid = cus;
        fprintf(stderr, "kernel_launch: grid %d, occupancy %d, ws %zu (need %zu)\n", grid, per_cu, ws_size, (size_t)WS_END);
    }
    if (grid < 0) return;
    if (hipMemsetAsync((char*)d_ws + WS_CTL, 0, CTL_ZERO_BYTES, stream) != hipSuccess) { fprintf(stderr, "kernel_launch: memset failed\n"); return; }
    Args a{};
    for (int i = 0; i < 29; ++i) a.in[i] = (const float*)d_in[i];
    a.out = (float*)d_out; a.ws = (unsigned char*)d_ws;
#if MK_PER_PHASE
    for (int p = 0; p < N_PHASES; ++p) { a.ph_lo = p; a.ph_hi = p + 1; hipLaunchKernelGGL(trunk_fwd, dim3(grid), dim3(NTHR), LDS_BYTES, stream, a); }
#else
    a.ph_lo = 0; a.ph_hi = N_PHASES;
    hipLaunchKernelGGL(trunk_fwd, dim3(grid), dim3(NTHR), LDS_BYTES, stream, a);
#endif
    const hipError_t le = hipPeekAtLastError();
    if (le != hipSuccess) fprintf(stderr, "kernel_launch: launch failed: %s\n", hipGetErrorName(le));
}
```

```cpp
#include <hip/hip_runtime.h>
#include <hip/hip_bf16.h>
#include <cstdio>
#include <cstdint>
__device__ __forceinline__ int opaque_tid() { int t; asm volatile("v_mov_b32 %0, %1" : "=v"(t) : "v"((int)threadIdx.x)); return t; }
namespace pg8 {
#define PG8_LAS __attribute__((address_space(3)))
typedef unsigned short bf16_t;
typedef short bf16x8 __attribute__((ext_vector_type(8)));
typedef float f32x4 __attribute__((ext_vector_type(4)));
typedef unsigned u32x4 __attribute__((ext_vector_type(4)));
constexpr int BM = 256, BK = 64, HALF = 128, HTB = HALF * BK * 2  , STAGE_BYTES = 8 * HTB, NXCD = 8, WGM = 8;

__host__ __device__ __forceinline__ int lds_byte(int r, int c) { const int st = (r >> 4) * 2 + (c >> 5), rr = r & 15, cc = c & 31, ob = rr * 64 + cc * 2; return st * 1024 + (ob ^ (((ob >> 9) & 1) << 5)); }
__host__ __device__ __forceinline__ void stage_rc(int b, int& R, int& C) { const int st = b / 1024, sb = b % 1024, swz = sb ^ (((sb >> 9) & 1) << 5); R = (st >> 1) * 16 + swz / 64; C = (st & 1) * 32 + (swz % 64) / 2; }
__host__ __device__ __forceinline__ int perm32(int rho) { const int n = rho >> 4, i = rho & 15; return 8 * (i >> 2) + 4 * n + (i & 3); }

struct Unit { int pm, pn; };
struct Gemm { const bf16_t* A; const bf16_t* Bt; int M, N, K; };

struct StaticOrder {
    int nM, nN, nwg, G, c;
    __host__ __device__ void init(int M, int N, int G_, int c_) { nM = M / BM; nN = N / BM; nwg = nM * nN; G = G_; c = c_; }
    __host__ __device__ bool next(int i, Unit& u) const {
        const long L = (long)i * G + c; if (L >= nwg) return false;
        int wgid = (int)L; { const int q = nwg / NXCD, r = nwg % NXCD, xcd = wgid % NXCD, off = wgid / NXCD; wgid = (xcd < r ? xcd * (q + 1) : r * (q + 1) + (xcd - r) * q) + off; }
        const int nig = WGM * nN, gid = wgid / nig, fm = gid * WGM, gsz = (nM - fm) < WGM ? (nM - fm) : WGM;
        u.pm = fm + ((wgid % nig) % gsz); u.pn = (wgid % nig) / gsz; return true;
    }
    __device__ __forceinline__ void a_ready(const Unit&) const {}
    __device__ __forceinline__ void done(const Unit&) const {}
};

__device__ __forceinline__ unsigned cvt_pk_bf16(float lo, float hi) { unsigned r; asm volatile("v_cvt_pk_bf16_f32 %0, %1, %2" : "=v"(r) : "v"(lo), "v"(hi)); return r; }
__device__ __forceinline__ float fast_sigmoid(float x) { return __builtin_amdgcn_rcpf(1.0f + __builtin_amdgcn_exp2f(-1.4426950408889634f * x)); }

struct EpiHeadMajor {
    static constexpr bool PERM = true, AFTER_DRAIN = false;
    bf16_t* O; size_t gstride;
    __device__ __forceinline__ void operator()(const f32x4 (&acc)[2][2][4][2], const Unit& u, int wr, int wc, int fr, int fq) const {
        const int row0 = u.pm * BM + wr * 64 + fr, col0 = wc * 32 + 8 * fq;
#pragma unroll
        for (int ai = 0; ai < 2; ++ai)
#pragma unroll
            for (int m = 0; m < 4; ++m) { const size_t ro = (size_t)(row0 + ai * HALF + m * 16) * 128 + col0;
#pragma unroll
                for (int bj = 0; bj < 2; ++bj) { const f32x4 v0 = acc[ai][bj][m][0], v1 = acc[ai][bj][m][1];
                    u32x4 w; w.x = cvt_pk_bf16(v0[0], v0[1]); w.y = cvt_pk_bf16(v0[2], v0[3]); w.z = cvt_pk_bf16(v1[0], v1[1]); w.w = cvt_pk_bf16(v1[2], v1[3]);
                    *(u32x4*)(O + (size_t)(2 * u.pn + bj) * gstride + ro) = w; } }
    }
};
struct EpiResid {
    static constexpr bool PERM = false, AFTER_DRAIN = false;
    const float* base; float* out; const float* gate; int ldc;
    __device__ __forceinline__ void operator()(const f32x4 (&acc)[2][2][4][2], const Unit& u, int wr, int wc, int fr, int fq) const {
        const int row0 = u.pm * BM + wr * 64 + fr, col0 = u.pn * BM + wc * 32 + 4 * fq;
        f32x4 gv[2][2];
#pragma unroll
        for (int bj = 0; bj < 2; ++bj)
#pragma unroll
            for (int n = 0; n < 2; ++n) gv[bj][n] = *(const f32x4*)(gate + col0 + bj * HALF + n * 16);
#pragma unroll
        for (int ai = 0; ai < 2; ++ai)
#pragma unroll
            for (int m = 0; m < 4; ++m) { const size_t off = (size_t)(row0 + ai * HALF + m * 16) * ldc + col0;
#pragma unroll
                for (int bj = 0; bj < 2; ++bj)
#pragma unroll
                    for (int n = 0; n < 2; ++n) { const f32x4 b = *(const f32x4*)(base + off + bj * HALF + n * 16); *(f32x4*)(out + off + bj * HALF + n * 16) = b + gv[bj][n] * acc[ai][bj][m][n]; }
                asm volatile("" ::: "memory"); }
    }
};
struct EpiSwiGLU {
    static constexpr bool PERM = true, AFTER_DRAIN = false;
    bf16_t* O; int ldc;
    __device__ __forceinline__ void operator()(const f32x4 (&acc)[2][2][4][2], const Unit& u, int wr, int wc, int fr, int fq) const {
        const int row0 = u.pm * BM + wr * 64 + fr, col0 = u.pn * HALF + wc * 32 + 8 * fq;
#pragma unroll
        for (int ai = 0; ai < 2; ++ai)
#pragma unroll
            for (int m = 0; m < 4; ++m) { bf16_t* rowp = O + (size_t)(row0 + ai * HALF + m * 16) * ldc + col0;
                float r[8];
#pragma unroll
                for (int n = 0; n < 2; ++n)
#pragma unroll
                    for (int j = 0; j < 4; ++j) { const float g = acc[ai][0][m][n][j], up = acc[ai][1][m][n][j]; r[n * 4 + j] = g * fast_sigmoid(g) * up; }
                u32x4 w; w.x = cvt_pk_bf16(r[0], r[1]); w.y = cvt_pk_bf16(r[2], r[3]); w.z = cvt_pk_bf16(r[4], r[5]); w.w = cvt_pk_bf16(r[6], r[7]);
                *(u32x4*)rowp = w; }
    }
};
struct EpiGluResid {
    static constexpr bool PERM = false, AFTER_DRAIN = false;
    const float* base; float* out; const float* gate; int ldc;
    __device__ __forceinline__ void operator()(const f32x4 (&acc)[2][2][4][2], const Unit& u, int wr, int wc, int fr, int fq) const {
        const int row0 = u.pm * BM + wr * 64 + fr, col0 = u.pn * HALF + wc * 32 + 4 * fq;
        f32x4 gv[2];
#pragma unroll
        for (int n = 0; n < 2; ++n) gv[n] = *(const f32x4*)(gate + col0 + n * 16);
#pragma unroll
        for (int ai = 0; ai < 2; ++ai)
#pragma unroll
            for (int m = 0; m < 4; ++m) { const size_t off = (size_t)(row0 + ai * HALF + m * 16) * ldc + col0;
#pragma unroll
                for (int n = 0; n < 2; ++n) { const f32x4 b = *(const f32x4*)(base + off + n * 16); const f32x4 a = acc[ai][0][m][n], s = acc[ai][1][m][n]; f32x4 y;
#pragma unroll
                    for (int j = 0; j < 4; ++j) y[j] = a[j] * fast_sigmoid(s[j]);
                    *(f32x4*)(out + off + n * 16) = b + gv[n] * y; }
                asm volatile("" ::: "memory"); }
    }
};

template <class Epi, class Sched, bool ALIGN_EPI = false, bool SP2 = false>
__device__ __forceinline__ void gemm_phase(PG8_LAS unsigned char* lds, const Gemm g, const Sched& S, const Epi& E) {
    const int tid = opaque_tid(), wid = __builtin_amdgcn_readfirstlane(tid >> 6), lane = tid & 63, wr = wid >> 2, wc = wid & 3, fr = lane & 15, fq = lane >> 4;
    const int K = g.K, nt = K / BK;
    unsigned voffA[2], voffB[2];
#pragma unroll
    for (int i = 0; i < 2; ++i) { int R, C; stage_rc(tid * 16 + i * 8192, R, C); const int Rb = Epi::PERM ? ((R & ~31) + perm32(R & 31)) : R;
        voffA[i] = (unsigned)(R * K + C) * 2u; voffB[i] = (unsigned)(Rb * K + C) * 2u; }
    const size_t kstep = (size_t)(BK * 2);
    const size_t hstep = (size_t)HALF * K * 2;
    const size_t tstep = 2 * hstep;
    const unsigned ldsw = (unsigned)wid * 1024u;
    const int aoff = lds_byte(wr * 64 + fr, fq * 8), boff = lds_byte(wc * 32 + fr, fq * 8);
#define PG8_SA(b, h) (((b) * 2 + (h)) * HTB)
#define PG8_SB(b, h) ((4 + (b) * 2 + (h)) * HTB)
#define PG8_STAGE(bufoff, gbase, voff) do { _Pragma("unroll") for (int _i = 0; _i < 2; ++_i) \
        __builtin_amdgcn_global_load_lds((const unsigned*)((const char*)(gbase) + (voff)[_i]), (PG8_LAS unsigned*)(lds + (bufoff) + ldsw + _i * 8192), 16, 0, 0); } while (0)
#define PG8_LDA(dst, b, h) do { _Pragma("unroll") for (int m = 0; m < 4; ++m) _Pragma("unroll") for (int k = 0; k < 2; ++k) dst[m][k] = *(const PG8_LAS bf16x8*)(lds + PG8_SA(b, h) + aoff + m * 2048 + k * 1024); } while (0)
#define PG8_LDB(dst, b, h) do { _Pragma("unroll") for (int n = 0; n < 2; ++n) _Pragma("unroll") for (int k = 0; k < 2; ++k) dst[n][k] = *(const PG8_LAS bf16x8*)(lds + PG8_SB(b, h) + boff + n * 2048 + k * 1024); } while (0)
#define PG8_MMA(ai, bj, At, Bt) do { __builtin_amdgcn_s_setprio(1); _Pragma("unroll") for (int m = 0; m < 4; ++m) _Pragma("unroll") for (int n = 0; n < 2; ++n) _Pragma("unroll") for (int k = 0; k < 2; ++k) \
        acc[ai][bj][m][n] = __builtin_amdgcn_mfma_f32_16x16x32_bf16(Bt[n][k], At[m][k], acc[ai][bj][m][n], 0, 0, 0); __builtin_amdgcn_s_setprio(0); } while (0)
#define PG8_WAIT_V(n) asm volatile("s_waitcnt vmcnt(" #n ")" ::: "memory")
#define PG8_WAIT_L(n) asm volatile("s_waitcnt lgkmcnt(" #n ")" ::: "memory")
#define PG8_BAR __builtin_amdgcn_s_barrier()
#define PG8_SCHED __builtin_amdgcn_sched_barrier(0)
    Unit cur, nxt; int ui = 0;
    if (!S.next(0, cur)) return;
    f32x4 acc[2][2][4][2];
#pragma unroll
    for (int a = 0; a < 2; ++a)
#pragma unroll
        for (int b = 0; b < 2; ++b)
#pragma unroll
            for (int m = 0; m < 4; ++m)
#pragma unroll
                for (int n = 0; n < 2; ++n) acc[a][b][m][n] = (f32x4){0.f, 0.f, 0.f, 0.f};
    bf16x8 At[4][2], B0[2][2], B1[2][2];
    const char* cA = (const char*)g.A + (size_t)cur.pm * tstep; const char* cB = (const char*)g.Bt + (size_t)cur.pn * tstep;
    S.a_ready(cur);
    if constexpr (SP2) {
        PG8_STAGE(PG8_SB(0, 0), cB, voffB); PG8_STAGE(PG8_SB(0, 1), cB + hstep, voffB); PG8_STAGE(PG8_SA(0, 0), cA, voffA); PG8_STAGE(PG8_SA(0, 1), cA + hstep, voffA);
        if (wr == 1) PG8_BAR;
        PG8_WAIT_V(2); PG8_BAR;
        PG8_STAGE(PG8_SB(1, 0), cB + kstep, voffB); PG8_STAGE(PG8_SA(1, 0), cA + kstep, voffA); PG8_STAGE(PG8_SB(1, 1), cB + hstep + kstep, voffB);
        PG8_WAIT_V(6); PG8_BAR;
    } else {
        PG8_STAGE(PG8_SB(0, 0), cB, voffB); PG8_STAGE(PG8_SA(0, 0), cA, voffA); PG8_STAGE(PG8_SB(0, 1), cB + hstep, voffB); PG8_STAGE(PG8_SA(0, 1), cA + hstep, voffA);
        if (wr == 1) PG8_BAR;
        PG8_WAIT_V(4); PG8_BAR;
        PG8_STAGE(PG8_SB(1, 0), cB + kstep, voffB); PG8_STAGE(PG8_SA(1, 0), cA + kstep, voffA); PG8_STAGE(PG8_SB(1, 1), cB + hstep + kstep, voffB);
        PG8_WAIT_V(6); PG8_BAR;
    }
    for (;;) {
        const bool has_next = S.next(ui + 1, nxt);
        const char* nA = has_next ? (const char*)g.A + (size_t)nxt.pm * tstep : cA; const char* nB = has_next ? (const char*)g.Bt + (size_t)nxt.pn * tstep : cB;
        for (int t = 0; t < nt; t += 2) {
            const bool last = (t == nt - 2);
            const char* a1 = cA + (size_t)(t + 1) * kstep;
            const char* a2 = last ? nA : cA + (size_t)(t + 2) * kstep; const char* b2 = last ? nB : cB + (size_t)(t + 2) * kstep;
            const char* a3 = a2 + kstep; const char* b3 = b2 + kstep;
            if (last && has_next) S.a_ready(nxt);
            if constexpr (SP2) {
            PG8_LDB(B0, 0, 0); PG8_LDB(B1, 0, 1); PG8_SCHED; PG8_LDA(At, 0, 0); PG8_STAGE(PG8_SA(1, 1), a1 + hstep, voffA);
            PG8_WAIT_V(8); PG8_WAIT_L(0); PG8_BAR; PG8_MMA(0, 0, At, B0); PG8_MMA(0, 1, At, B1); PG8_BAR; PG8_SCHED;
            PG8_LDA(At, 0, 1); PG8_STAGE(PG8_SB(0, 0), b2, voffB); PG8_STAGE(PG8_SB(0, 1), b2 + hstep, voffB); PG8_STAGE(PG8_SA(0, 0), a2, voffA);
            PG8_WAIT_V(8); PG8_WAIT_L(0); PG8_BAR; PG8_MMA(1, 0, At, B0); PG8_MMA(1, 1, At, B1); PG8_BAR; PG8_SCHED;
            PG8_LDB(B0, 1, 0); PG8_LDB(B1, 1, 1); PG8_SCHED; PG8_LDA(At, 1, 0); PG8_STAGE(PG8_SA(0, 1), a2 + hstep, voffA);
            PG8_WAIT_V(8); PG8_WAIT_L(0); PG8_BAR; PG8_MMA(0, 0, At, B0); PG8_MMA(0, 1, At, B1); PG8_BAR; PG8_SCHED;
            PG8_LDA(At, 1, 1); PG8_STAGE(PG8_SB(1, 0), b3, voffB); PG8_STAGE(PG8_SB(1, 1), b3 + hstep, voffB); PG8_STAGE(PG8_SA(1, 0), a3, voffA);
            PG8_WAIT_V(8); PG8_WAIT_L(0); PG8_BAR; PG8_MMA(1, 0, At, B0); PG8_MMA(1, 1, At, B1); PG8_BAR; PG8_SCHED;
            } else {
            PG8_LDB(B0, 0, 0); PG8_SCHED; PG8_LDA(At, 0, 0); PG8_STAGE(PG8_SA(1, 1), a1 + hstep, voffA);
            PG8_WAIT_L(8); PG8_BAR; PG8_WAIT_L(0); PG8_MMA(0, 0, At, B0); PG8_BAR; PG8_SCHED;
            PG8_LDB(B1, 0, 1); PG8_STAGE(PG8_SB(0, 0), b2, voffB);
            PG8_BAR; PG8_WAIT_L(0); PG8_MMA(0, 1, At, B1); PG8_BAR;
            PG8_LDA(At, 0, 1); PG8_STAGE(PG8_SA(0, 0), a2, voffA);
            PG8_BAR; PG8_WAIT_L(0); PG8_MMA(1, 0, At, B0); PG8_BAR; PG8_SCHED;
            PG8_STAGE(PG8_SB(0, 1), b2 + hstep, voffB);
            PG8_WAIT_V(6); PG8_BAR; PG8_MMA(1, 1, At, B1); PG8_BAR;
            PG8_LDB(B0, 1, 0); PG8_SCHED; PG8_LDA(At, 1, 0); PG8_STAGE(PG8_SA(0, 1), a2 + hstep, voffA);
            PG8_WAIT_L(8); PG8_BAR; PG8_WAIT_L(0); PG8_MMA(0, 0, At, B0); PG8_BAR; PG8_SCHED;
            PG8_LDB(B1, 1, 1); PG8_STAGE(PG8_SB(1, 0), b3, voffB);
            PG8_BAR; PG8_WAIT_L(0); PG8_MMA(0, 1, At, B1); PG8_BAR;
            PG8_LDA(At, 1, 1); PG8_STAGE(PG8_SA(1, 0), a3, voffA);
            PG8_BAR; PG8_WAIT_L(0); PG8_MMA(1, 0, At, B0); PG8_BAR; PG8_SCHED;
            PG8_STAGE(PG8_SB(1, 1), b3 + hstep, voffB);
            PG8_WAIT_V(6); PG8_BAR; PG8_MMA(1, 1, At, B1); PG8_BAR;
            }
        }
        if constexpr (ALIGN_EPI) { if (wr == 0) PG8_BAR; }
        if constexpr (!Epi::AFTER_DRAIN) { E(acc, cur, wr, wc, fr, fq); S.done(cur); }
        if (!has_next) break;
#pragma unroll
        for (int a = 0; a < 2; ++a)
#pragma unroll
            for (int b = 0; b < 2; ++b)
#pragma unroll
                for (int m = 0; m < 4; ++m)
#pragma unroll
                    for (int n = 0; n < 2; ++n) acc[a][b][m][n] = (f32x4){0.f, 0.f, 0.f, 0.f};
        cur = nxt; cA = nA; cB = nB; ++ui;
        if constexpr (ALIGN_EPI) { if (wr == 1) PG8_BAR; }
    }
    PG8_WAIT_V(0);
    if constexpr (!ALIGN_EPI) { if (wr == 0) PG8_BAR; }
    PG8_BAR;
    if constexpr (Epi::AFTER_DRAIN) { E.fused(acc, cur, wr, wc, fr, fq, lds, wid, lane); S.done(cur); }
#undef PG8_SA
#undef PG8_SB
#undef PG8_STAGE
#undef PG8_LDA
#undef PG8_LDB
#undef PG8_MMA
#undef PG8_WAIT_V
#undef PG8_WAIT_L
#undef PG8_BAR
#undef PG8_SCHED
}
}

namespace att {
constexpr int D = 128;
constexpr float THR = 8.f;
constexpr bool WSKIP = false;
constexpr float SCALE = 0.08838834764831845f;
constexpr int NW = 8, QBLK = 32, KVBLK = 64, QB = NW * QBLK;
constexpr int SHM_V = KVBLK * D * 2, SHM_K = KVBLK * D * 2;
constexpr int LDS_BYTES = 2 * SHM_V + 2 * SHM_K + NW * 64 * 4;

using bf16 = __hip_bfloat16;
typedef short bf16x8 __attribute__((ext_vector_type(8)));
typedef short s16x4 __attribute__((ext_vector_type(4)));
typedef float f32x16 __attribute__((ext_vector_type(16)));
typedef float f32x4 __attribute__((ext_vector_type(4)));
typedef unsigned u32x4 __attribute__((ext_vector_type(4)));
template <class A, class Bt> struct same_t { static constexpr bool v = false; };
template <class A> struct same_t<A, A> { static constexpr bool v = true; };

#define KSWZ(row, colB) ((row) * 256 + ((colB) ^ (((row) & 7) << 4)))
#define SBAR() __builtin_amdgcn_sched_barrier(0)
__device__ __forceinline__ int v_st(int k, int c) { const int kk = (k & ~0xC) | ((k & 4) << 1) | ((k & 8) >> 1); return ((kk >> 3) * 4 + (c >> 5)) * 512 + ((kk & 7) * 32 + (c & 31)) * 2; }
__device__ __forceinline__ int v_rd_base(int lane) { return ((lane & 3) << 3) | (((lane >> 2) & 3) << 6) | (((lane >> 4) & 1) << 5) | (((lane >> 5) & 1) << 8); }
constexpr int v_rd_off(int d0, int ks, int half) { return d0 * 512 + ks * 4096 + half * 2048; }
__device__ __forceinline__ int crow(int r, int hi) { return (r & 3) + 8 * (r >> 2) + 4 * hi; }
__device__ __forceinline__ unsigned cvtpk(float lo, float hi) {
    unsigned r; asm volatile("v_cvt_pk_bf16_f32 %0, %1, %2" : "=v"(r) : "v"(lo), "v"(hi)); return r;
}
__device__ __forceinline__ bf16x8 pack8(f32x4 a, f32x4 b) {
    u32x4 w = {cvtpk(a[0], a[1]), cvtpk(a[2], a[3]), cvtpk(b[0], b[1]), cvtpk(b[2], b[3])};
    return *reinterpret_cast<bf16x8*>(&w);
}
template <class T> __device__ __forceinline__ bf16x8 load8(const T* p) {
    if constexpr (same_t<T, float>::v) { return pack8(*(const f32x4*)p, *(const f32x4*)(p + 4)); }
    else { return *reinterpret_cast<const bf16x8*>(p); }
}
__device__ __forceinline__ void mask_tile(f32x16& p0, f32x16& p1, int dq, unsigned W) {
    const float NEG = -__builtin_inff();
#pragma unroll
    for (int r = 0; r < 16; ++r) {
        const int c = (r & 3) + 8 * (r >> 2);
        if ((unsigned)(dq - c) >= W) p0[r] = NEG;
        if ((unsigned)(dq - c - 32) >= W) p1[r] = NEG;
    }
}
__device__ __forceinline__ void partialSM(f32x16& p0, f32x16& p1, float& m_reg, float& mn, float& alpha) {
    float pmax = p0[0]; for (int r = 1; r < 16; ++r) pmax = fmaxf(pmax, p0[r]); for (int r = 0; r < 16; ++r) pmax = fmaxf(pmax, p1[r]);
    { auto rr = __builtin_amdgcn_permlane32_swap(__float_as_uint(pmax), __float_as_uint(pmax), false, false);
      pmax = fmaxf(__uint_as_float(rr[0]), __uint_as_float(rr[1])); }
    constexpr float C2 = 1.4426950408889634f * SCALE;
    if (__builtin_expect(__all((pmax - m_reg) * SCALE <= THR), 1)) { mn = m_reg; alpha = 1.f; }
    else { mn = fmaxf(m_reg, pmax); alpha = __builtin_amdgcn_exp2f((m_reg - mn) * C2); m_reg = mn; }
    const float mnL = -mn * C2;
    for (int r = 0; r < 16; ++r) p0[r] = fmaf(p0[r], C2, mnL); for (int r = 0; r < 16; ++r) p1[r] = fmaf(p1[r], C2, mnL);
    for (int r = 0; r < 16; ++r) p0[r] = __builtin_amdgcn_exp2f(p0[r]);
}
__device__ __forceinline__ void finishSM(f32x16& p0, f32x16& p1, float alpha, float& l_reg, bf16x8& pa0, bf16x8& pa1, bf16x8& pa2, bf16x8& pa3) {
    for (int r = 0; r < 16; ++r) p1[r] = __builtin_amdgcn_exp2f(p1[r]);
    float ps = 0; for (int r = 0; r < 16; ++r) ps += p0[r]; for (int r = 0; r < 16; ++r) ps += p1[r];
    { auto rr = __builtin_amdgcn_permlane32_swap(__float_as_uint(ps), __float_as_uint(ps), false, false);
      ps = __uint_as_float(rr[0]) + __uint_as_float(rr[1]); }
    l_reg = l_reg * alpha + ps;
#define PK4(P, B_, OUT) do { unsigned a0 = cvtpk(P[B_+0], P[B_+1]), a1 = cvtpk(P[B_+2], P[B_+3]);                          \
        unsigned b0 = cvtpk(P[B_+4], P[B_+5]), b1 = cvtpk(P[B_+6], P[B_+7]);                                             \
        auto r0 = __builtin_amdgcn_permlane32_swap(a0, b0, false, false); auto r1 = __builtin_amdgcn_permlane32_swap(a1, b1, false, false); \
        u32x4 w = {r0[0], r1[0], r0[1], r1[1]}; OUT = *reinterpret_cast<bf16x8*>(&w); } while (0)
    PK4(p0, 0, pa0); PK4(p0, 8, pa1); PK4(p1, 0, pa2); PK4(p1, 8, pa3);
#undef PK4
}
template <int KB, bool SK>
__device__ __forceinline__ void qkt(f32x16& p0, f32x16& p1, const char* K_lds, int r32, int hi, const bf16x8* qr, bool act) {
    if (SK && !act) { const float NEG = -__builtin_inff();
#pragma unroll
        for (int r = 0; r < 16; ++r) { p0[r] = NEG; p1[r] = NEG; } return; }
    p0 = f32x16{}; p1 = f32x16{};
    const char* kb[4];
#pragma unroll
    for (int dd = 0; dd < 4; ++dd) kb[dd] = K_lds + KB * SHM_K + KSWZ(r32, (dd * 16 + hi * 8) * 2);
#pragma unroll
    for (int d0 = 0; d0 < 8; ++d0) { const char* a = kb[d0 & 3] + (d0 >> 2) * 128;
        bf16x8 b0 = *reinterpret_cast<const bf16x8*>(a);
        bf16x8 b1 = *reinterpret_cast<const bf16x8*>(a + 32 * 256);
        p0 = __builtin_amdgcn_mfma_f32_32x32x16_bf16(b0, qr[d0], p0, 0, 0, 0);
        p1 = __builtin_amdgcn_mfma_f32_32x32x16_bf16(b1, qr[d0], p1, 0, 0, 0); }
}
template <int VB, bool SK>
__device__ __forceinline__ void pv_tile(f32x16* o, int vb0, bf16x8 pa0, bf16x8 pa1, bf16x8 pa2, bf16x8 pa3, bool act) {
    if (SK && !act) return;
#define TRRD(dst, off) asm volatile("ds_read_b64_tr_b16 %0, %1 offset:%2" : "=&v"(dst) : "v"(vb0), "i"(off) : "memory")
#define PV_D0(d0) do { s16x4 l0, l1, l2, l3, h0, h1, h2, h3; constexpr int b_ = VB * SHM_V + v_rd_off(d0, 0, 0);     \
        TRRD(l0, b_); TRRD(h0, b_ + 2048); TRRD(l1, b_ + 4096); TRRD(h1, b_ + 6144); TRRD(l2, b_ + 8192); TRRD(h2, b_ + 10240); TRRD(l3, b_ + 12288); TRRD(h3, b_ + 14336); \
        asm volatile("s_waitcnt lgkmcnt(0)" ::: "memory"); SBAR();                 \
        o[d0] = __builtin_amdgcn_mfma_f32_32x32x16_bf16(pa0, (bf16x8){l0[0], l0[1], l0[2], l0[3], h0[0], h0[1], h0[2], h0[3]}, o[d0], 0, 0, 0);   \
        o[d0] = __builtin_amdgcn_mfma_f32_32x32x16_bf16(pa1, (bf16x8){l1[0], l1[1], l1[2], l1[3], h1[0], h1[1], h1[2], h1[3]}, o[d0], 0, 0, 0);   \
        o[d0] = __builtin_amdgcn_mfma_f32_32x32x16_bf16(pa2, (bf16x8){l2[0], l2[1], l2[2], l2[3], h2[0], h2[1], h2[2], h2[3]}, o[d0], 0, 0, 0);   \
        o[d0] = __builtin_amdgcn_mfma_f32_32x32x16_bf16(pa3, (bf16x8){l3[0], l3[1], l3[2], l3[3], h3[0], h3[1], h3[2], h3[3]}, o[d0], 0, 0, 0); } while (0)
    PV_D0(0); PV_D0(1); PV_D0(2); PV_D0(3);
#undef PV_D0
#undef TRRD
}

template <class TIn, class TOut> struct BlockRef { const TIn* Q; const TIn* K; const TIn* V; TOut* O; int P0; };
template <class TIn> struct Seam {
    bf16x8 qr[8];
    bf16x8 st_v0, st_v1, st_k0, st_k1; f32x4 sf0, sf1, sf2, sf3;
    f32x4 tq[16];
};
__device__ __forceinline__ int swa_jlo(int P0, int W) { const int lowk = P0 - W + 1; return lowk > 0 ? lowk / KVBLK : 0; }
#define ROW(p, k0, rr) ((p) + (size_t)((k0) + (rr)) * D + sc)
#define VMW() asm volatile("s_waitcnt vmcnt(0)" ::: "memory")
#define VMWN(n) asm volatile("s_waitcnt vmcnt(%0)" :: "i"(n) : "memory")
#define SLOAD_H(Kp, Vp, k0) do { S.st_v0 = load8<TIn>(ROW(Vp, k0, sr)); S.st_v1 = load8<TIn>(ROW(Vp, k0, 32 + sr));              \
                         S.st_k0 = load8<TIn>(ROW(Kp, k0, sr)); S.st_k1 = load8<TIn>(ROW(Kp, k0, 32 + sr)); } while (0)
#define SWRITE_HK(bf) do { *(bf16x8*)(K_lds + (bf) * SHM_K + kws) = S.st_k0; *(bf16x8*)(K_lds + (bf) * SHM_K + kws + 32 * 256) = S.st_k1; } while (0)
#define SWRITE_HV(bf) do { *(bf16x8*)(V_lds + (bf) * SHM_V + vst0) = S.st_v0; *(bf16x8*)(V_lds + (bf) * SHM_V + vst1) = S.st_v1; } while (0)
#define SWRITE_H(bf) do { SWRITE_HV(bf); SWRITE_HK(bf); } while (0)
#define SLOAD_F(p, k0) do { S.sf0 = *(const f32x4*)ROW(p, k0, sr); S.sf1 = *(const f32x4*)(ROW(p, k0, sr) + 4);                \
                            S.sf2 = *(const f32x4*)ROW(p, k0, 32 + sr); S.sf3 = *(const f32x4*)(ROW(p, k0, 32 + sr) + 4); } while (0)
#define SWRITE_KF(bf) do { *(bf16x8*)(K_lds + (bf) * SHM_K + kws) = pack8(S.sf0, S.sf1); *(bf16x8*)(K_lds + (bf) * SHM_K + kws + 32 * 256) = pack8(S.sf2, S.sf3); } while (0)
#define SWRITE_VF(bf) do { *(bf16x8*)(V_lds + (bf) * SHM_V + vst0) = pack8(S.sf0, S.sf1); *(bf16x8*)(V_lds + (bf) * SHM_V + vst1) = pack8(S.sf2, S.sf3); } while (0)
template <class TIn, class TOut>
__device__ __forceinline__ void causal_swa_prime(const BlockRef<TIn, TOut>& cur, int W, char* lds, Seam<TIn>& S) {
    constexpr bool F32 = same_t<TIn, float>::v;
    const int tid = opaque_tid(), wid = __builtin_amdgcn_readfirstlane(tid >> 6), lane = tid & 63, r32 = lane & 31, hi = lane >> 5;
    const int sr = tid >> 4, sc = (tid & 15) * 8, kws = KSWZ(sr, sc * 2); char* K_lds = lds + 2 * SHM_V;
    const int kb0 = swa_jlo(cur.P0, W) * KVBLK;
    for (int d0 = 0; d0 < 8; ++d0) S.qr[d0] = load8<TIn>(cur.Q + (size_t)(wid * QBLK + r32) * D + d0 * 16 + hi * 8);
    if constexpr (F32) { SLOAD_F((const float*)cur.K, kb0); VMW(); SWRITE_KF(0); SBAR(); SLOAD_F((const float*)cur.V, kb0); }
    else { SLOAD_H(cur.K, cur.V, kb0); VMW(); SWRITE_HK(0); }
    __syncthreads();
}
template <class TIn, class TOut>
__device__ __forceinline__ void causal_swa_block(const BlockRef<TIn, TOut>& cur, const BlockRef<TIn, TOut>& nxt, int skv, int W, char* lds, Seam<TIn>& S) {
    constexpr bool F32 = same_t<TIn, float>::v;
    const int tid = opaque_tid(), wid = __builtin_amdgcn_readfirstlane(tid >> 6), lane = tid & 63, r32 = lane & 31, hi = lane >> 5;
    const int j_lo = swa_jlo(cur.P0, W);
    int j_hi = (cur.P0 + QB - 1) / KVBLK + 1; if (j_hi > skv / KVBLK) j_hi = skv / KVBLK;
    const int NT = j_hi - j_lo;
    const int kbn = swa_jlo(nxt.P0, W) * KVBLK;
    const int qlo = cur.P0 + wid * QBLK, qm = qlo + r32 - 4 * hi;
    char* V_lds = lds; char* K_lds = lds + 2 * SHM_V;
    float* ws = (float*)(lds + 2 * SHM_V + 2 * SHM_K) + wid * 64; float* li_l = ws, * al_l = ws + 32;
    float m_reg = -1e30f, l_reg = 0; f32x16 o[4] = {};
    const int sr = tid >> 4, sc = (tid & 15) * 8, vst0 = v_st(sr, sc), vst1 = v_st(32 + sr, sc), kws = KSWZ(sr, sc * 2);
    const int vb0 = (int)(uintptr_t)V_lds + v_rd_base(lane);
    const TIn* Kh = cur.K; const TIn* Vh = cur.V;
#define RESC(a) do { if (__any((a) < 1.f)) { if (hi == 0) al_l[r32] = (a); asm volatile("s_waitcnt lgkmcnt(0)" ::: "memory");              \
                     for (int d_ = 0; d_ < 4; ++d_) for (int r = 0; r < 16; ++r) o[d_][r] *= al_l[crow(r, hi)]; } } while (0)
#define KBASE(t) ((j_lo + (t)) * KVBLK)
#define ACT(t) (KBASE(t) <= qlo + QBLK - 1 && KBASE(t) + KVBLK - 1 >= qlo - W + 1)
#define MASKT(P0_, P1_, t) do { const int kb_ = KBASE(t); if ((!SK || ACT(t)) && (kb_ + KVBLK - 1 > qlo || kb_ <= qlo + QBLK - 1 - W)) mask_tile(P0_, P1_, qm - kb_, (unsigned)W); } while (0)
    constexpr int NQL = F32 ? 16 : 8;
    constexpr bool SK = WSKIP && !F32;
#define SEAM_K0() do { VMWN(NQL); if constexpr (F32) { SWRITE_KF(0); SBAR(); SLOAD_F((const float*)nxt.V, kbn); } else { SWRITE_HK(0); } SBAR(); } while (0)
    f32x16 pA0, pA1, pB0, pB1; float mnA, mnB, alA, alB; bf16x8 pa0, pa1, pa2, pa3;
    if constexpr (F32) { VMW(); SWRITE_VF(0); SBAR(); } else { SWRITE_HV(0); SBAR(); }
    if (NT > 1) { if constexpr (F32) SLOAD_F((const float*)Kh, KBASE(1)); else SLOAD_H(Kh, Vh, KBASE(1)); }
    SBAR(); qkt<0, SK>(pA0, pA1, K_lds, r32, hi, S.qr, ACT(0));
    if constexpr (F32) { if (NT > 1) { VMW(); SWRITE_KF(1); SBAR(); SLOAD_F((const float*)Vh, KBASE(1)); } }
    MASKT(pA0, pA1, 0); partialSM(pA0, pA1, m_reg, mnA, alA);
    if (NT > 1) { VMW(); if constexpr (F32) { SWRITE_VF(1); SBAR(); if (NT > 2) SLOAD_F((const float*)Kh, KBASE(2)); } else SWRITE_H(1); }
    __syncthreads();
#define HALF_STEP(PX0, PX1, mnX, alX, PY0, PY1, alY, t, KB, VB, SB) do {                                                      \
        SBAR(); qkt<KB, SK>(PX0, PX1, K_lds, r32, hi, S.qr, ACT(t));                                             \
        finishSM(PY0, PY1, alY, l_reg, pa0, pa1, pa2, pa3); SBAR();                                                           \
        if ((t) + 1 < NT) { if constexpr (F32) { VMW(); SWRITE_KF(SB); SBAR(); SLOAD_F((const float*)Vh, KBASE((t) + 1)); }  \
                            else { SLOAD_H(Kh, Vh, KBASE((t) + 1)); } SBAR(); }                                               \
        pv_tile<VB, SK>(o, vb0, pa0, pa1, pa2, pa3, ACT((t) - 1)); MASKT(PX0, PX1, (t)); partialSM(PX0, PX1, m_reg, mnX, alX);                                        \
        __syncthreads();                                                                                                      \
        if ((t) + 1 < NT) { VMW(); if constexpr (F32) { SWRITE_VF(SB); SBAR(); if ((t) + 2 < NT) SLOAD_F((const float*)Kh, KBASE((t) + 2)); } \
                            else { SWRITE_H(SB); } }                                                                          \
        RESC(alX); __syncthreads(); } while (0)
    for (int t = 1; t + 1 < NT; t += 2) {
        HALF_STEP(pB0, pB1, mnB, alB, pA0, pA1, alA, t, 1, 0, 0);
        HALF_STEP(pA0, pA1, mnA, alA, pB0, pB1, alB, t + 1, 0, 1, 1);
    }
    const bool even = (NT & 1) == 0;
    if (even) { SBAR(); qkt<1, SK>(pB0, pB1, K_lds, r32, hi, S.qr, ACT(NT - 1)); SBAR(); }
#define QROW(e) (nxt.Q + (size_t)(wid * QBLK + r32) * D + ((e) >> 1) * 16 + hi * 8 + ((e) & 1) * 4)
    if constexpr (F32) { SLOAD_F((const float*)nxt.K, kbn); SBAR();
#pragma unroll
        for (int e = 0; e < 8; ++e) S.tq[e] = *(const f32x4*)QROW(e); }
    else { SLOAD_H(nxt.K, nxt.V, kbn); SBAR();
#pragma unroll
        for (int d0 = 0; d0 < 8; ++d0) S.qr[d0] = load8<TIn>(nxt.Q + (size_t)(wid * QBLK + r32) * D + d0 * 16 + hi * 8); }
    SBAR();
    finishSM(pA0, pA1, alA, l_reg, pa0, pa1, pa2, pa3); SBAR();
    if constexpr (F32) {
#pragma unroll
        for (int e = 8; e < 16; ++e) S.tq[e] = *(const f32x4*)QROW(e); SBAR(); }
#undef QROW
    pv_tile<0, SK>(o, vb0, pa0, pa1, pa2, pa3, ACT(even ? NT - 2 : NT - 1));
    if (even) { MASKT(pB0, pB1, NT - 1); partialSM(pB0, pB1, m_reg, mnB, alB); __syncthreads(); RESC(alB);
        finishSM(pB0, pB1, alB, l_reg, pa0, pa1, pa2, pa3); SBAR(); pv_tile<1, SK>(o, vb0, pa0, pa1, pa2, pa3, ACT(NT - 1)); }
    SBAR(); SEAM_K0();
    if (hi == 0) li_l[r32] = l_reg; asm volatile("s_waitcnt lgkmcnt(0)" ::: "memory");
    float rli[16];
#pragma unroll
    for (int r = 0; r < 16; ++r) rli[r] = __builtin_amdgcn_rcpf(li_l[crow(r, hi)]);
    TOut* Ow = cur.O + (size_t)(wid * QBLK) * D;
#pragma unroll
    for (int r = 0; r < 16; ++r) { const int orow = crow(r, hi);
#pragma unroll
        for (int d0 = 0; d0 < 4; ++d0) { const float v = o[d0][r] * rli[r];
            if constexpr (same_t<TOut, float>::v) { Ow[(size_t)orow * D + d0 * 32 + r32] = v; }
            else { const float vn = __shfl_xor(v, 1);
                   if ((r32 & 1) == 0) *(unsigned*)(Ow + (size_t)orow * D + d0 * 32 + r32) = cvtpk(v, vn); } } }
    if constexpr (F32) {
#pragma unroll
        for (int d0 = 0; d0 < 8; ++d0) S.qr[d0] = pack8(S.tq[2 * d0], S.tq[2 * d0 + 1]); }
    __syncthreads();
#undef RESC
#undef KBASE
#undef ACT
#undef MASKT
#undef SEAM_K0
#undef HALF_STEP
}
#undef ROW
#undef VMW
#undef VMWN
#undef SLOAD_H
#undef SWRITE_HK
#undef SWRITE_HV
#undef SWRITE_H
#undef SLOAD_F
#undef SWRITE_KF
#undef SWRITE_VF
#undef KSWZ
#undef SBAR
}

#ifndef MK_PER_PHASE
#define MK_PER_PHASE 0
#endif
constexpr int NWAVES = 8, NTHR = 512;
constexpr int SEQ = 16384, DM = 4096, FFH = 11008, DEPTH = 4, NMODV = 6 * DM;
constexpr int ZG = 96;
constexpr size_t GS = (size_t)SEQ * 128;
constexpr int S5T = 64, S5NC = SEQ / S5T;
constexpr int KSL = 16;
constexpr float NORM_EPS = 1e-6f, SUBLN_EPS = 1e-5f;
constexpr int N_PHASES = 35;

constexpr size_t MiB = 1u << 20;
constexpr size_t WS_CTL = 0, CTL_ZERO_BYTES = 64 * 1024;
constexpr size_t WS_MODP = 1 * MiB;
constexpr size_t WS_MODL = 3 * MiB;
constexpr size_t WS_LAM = 3 * MiB + 512 * 1024;
constexpr size_t WS_S5P = 4 * MiB, S5P_LAYER = 4 * MiB + 256 * 1024;
constexpr size_t S5P_ABR = 0, S5P_ABI = 64 * 1024, S5P_ATR = 128 * 1024, S5P_ATI = 192 * 1024, S5P_BBR = 256 * 1024, S5P_BBI = 256 * 1024 + MiB;
constexpr size_t S5P_BBOP = 256 * 1024 + 2 * MiB, S5P_COP = 256 * 1024 + 3 * MiB;
#ifndef S5_MFMA
#define S5_MFMA 1
#endif
constexpr size_t W_IN_B = (size_t)12288 * 4096 * 2, W_OUT_B = (size_t)4096 * 4096 * 2, W_GLU_B = (size_t)8192 * 4096 * 2, W_GU_B = (size_t)22016 * 4096 * 2, W_DN_B = (size_t)4096 * 11008 * 2;
constexpr size_t WS_WIN = 16 * MiB, WS_WOUT = WS_WIN + 2 * W_IN_B, WS_WGLU = WS_WOUT + 2 * W_OUT_B, WS_WGU = WS_WGLU + 2 * W_GLU_B, WS_WDN = WS_WGU + 4 * W_GU_B;
constexpr size_t WS_H = WS_WDN + 4 * W_DN_B;
constexpr size_t WS_MIX = WS_H + (size_t)SEQ * DM * 2;
constexpr size_t WS_Z = WS_MIX + (size_t)SEQ * DM * 2;
constexpr size_t WS_OT = WS_Z + (size_t)ZG * GS * 2;
constexpr size_t WS_S5F = WS_OT + (size_t)32 * GS * 4;
constexpr size_t WS_S5H = WS_S5F + (size_t)S5NC * 256 * 128 * 4;
constexpr size_t WS_END = WS_S5H + (size_t)S5NC * 256 * 128 * 4;
static_assert((size_t)SEQ * FFH * 2 <= (size_t)ZG * GS * 2, "hidden overlays Z");
static_assert(WS_WIN % 256 == 0 && WS_H % 256 == 0 && WS_OT % 256 == 0 && WS_S5F % 256 == 0, "alignment");
constexpr int CW_BAR = 1024;

constexpr int RING_BYTES = 131072, MISC_OFF = RING_BYTES + 320, LDS_BYTES = 147456;

#define GAS __attribute__((address_space(1)))
#define LAS __attribute__((address_space(3)))
typedef unsigned short bf16;
typedef unsigned v4u __attribute__((ext_vector_type(4)));
typedef unsigned v2u __attribute__((ext_vector_type(2)));
typedef float f32x4 __attribute__((ext_vector_type(4)));
#define LDS_WAIT() asm volatile("s_waitcnt lgkmcnt(0)" ::: "memory")
#define VM_WAIT() asm volatile("s_waitcnt vmcnt(0)" ::: "memory")
__device__ __forceinline__ unsigned pk2(float lo, float hi) { unsigned r; asm volatile("v_cvt_pk_bf16_f32 %0, %1, %2" : "=v"(r) : "v"(lo), "v"(hi)); return r; }
__device__ __forceinline__ float bflo(unsigned w) { return __builtin_bit_cast(float, w << 16); }
__device__ __forceinline__ float bfhi(unsigned w) { return __builtin_bit_cast(float, w & 0xffff0000u); }

#define XB_TMO      128
#define XB_XCNT(j)  (256  + 64 * (j))
#define XB_XSUB(j)  (1280 + 64 * (j))
#define XB_XGEN(j)  (2304 + 64 * (j))
#define XB_TOP      3328
#define XB_TOPGEN   3392
#define XCD_BAR_WORDS 3456
#define XB_SPIN_CAP (1u << 22)

__device__ __forceinline__ unsigned xb_ld(unsigned* p)              { return __hip_atomic_load(p, __ATOMIC_RELAXED, __HIP_MEMORY_SCOPE_AGENT); }
__device__ __forceinline__ unsigned xb_add(unsigned* p, unsigned v) { return __hip_atomic_fetch_add(p, v, __ATOMIC_RELAXED, __HIP_MEMORY_SCOPE_AGENT); }
__device__ __forceinline__ unsigned xb_xcc_id() { return (unsigned)__builtin_amdgcn_s_getreg((3 << 11) | 20) & 0xFu; }
#define XB_SPIN(cond, bar) do { unsigned _sp = 0; while (cond) { __builtin_amdgcn_s_sleep(1); \
    if ((++_sp & 255u) == 0u) { if (xb_ld(&(bar)[XB_TMO])) break; if (_sp > XB_SPIN_CAP) { atomicAdd(&(bar)[XB_TMO], 1u); break; } } } } while (0)

struct XcdBarrier {
    unsigned* bar; unsigned x;
    volatile LAS unsigned* st;
};
__device__ __forceinline__ XcdBarrier xcd_barrier_post(unsigned* bar, volatile LAS unsigned* st) {
    XcdBarrier b; b.bar = bar; b.x = xb_xcc_id(); b.st = st;
    if (threadIdx.x == 0) (void)xb_add(&bar[XB_XCNT(b.x)], 1u);
    return b;
}
__device__ __forceinline__ void xcd_barrier_complete(unsigned* bar, unsigned x, unsigned& nloc, unsigned& nx) {
    const unsigned G = gridDim.x * gridDim.y * gridDim.z;
    unsigned sum, cnt, mine, sp = 0u;
    for (;;) {
        sum = 0u; cnt = 0u; mine = 0u;
#pragma unroll
        for (unsigned j = 0; j < 16; ++j) { const unsigned c = xb_ld(&bar[XB_XCNT(j)]); sum += c; cnt += (c > 0u) ? 1u : 0u; mine = (j == x) ? c : mine; }
        if (sum == G) break;
        __builtin_amdgcn_s_sleep(1);
        if ((++sp & 255u) == 0u) { if (xb_ld(&bar[XB_TMO])) break; if (sp > XB_SPIN_CAP) { atomicAdd(&bar[XB_TMO], 1u); break; } }
    }
    nloc = mine > 0u ? mine : 1u; nx = cnt > 0u ? cnt : 1u;
}
__device__ __forceinline__ void xcd_barrier(const XcdBarrier& b) {
    asm volatile("s_waitcnt vmcnt(0)" ::: "memory");
    __syncthreads();
    if (threadIdx.x == 0) {
        unsigned* bar = b.bar;
        __builtin_amdgcn_s_waitcnt(0);
        unsigned nloc = b.st[0], nx = b.st[1];
        if (nloc == 0u) { xcd_barrier_complete(bar, b.x, nloc, nx); b.st[0] = nloc; b.st[1] = nx; }
        const unsigned old = xb_add(&bar[XB_XSUB(b.x)], 1u);
        const unsigned gen = old / nloc;
        if (old + 1u == (gen + 1u) * nloc) {
            __builtin_amdgcn_fence(__ATOMIC_RELEASE, "agent");
            asm volatile("s_waitcnt vmcnt(0)" ::: "memory");
            const unsigned og = xb_add(&bar[XB_TOP], 1u);
            const unsigned tg = og / nx;
            if (og + 1u == (tg + 1u) * nx) xb_add(&bar[XB_TOPGEN], 1u);
            else XB_SPIN(xb_ld(&bar[XB_TOPGEN]) == tg, bar);
            __builtin_amdgcn_fence(__ATOMIC_ACQUIRE, "agent");
            xb_add(&bar[XB_XGEN(b.x)], 1u);
            asm volatile("s_waitcnt vmcnt(0)" ::: "memory");
        } else {
            XB_SPIN(xb_ld(&bar[XB_XGEN(b.x)]) == gen, bar);
            __builtin_amdgcn_fence(__ATOMIC_ACQUIRE, "agent");
            asm volatile("s_waitcnt vmcnt(0)" ::: "memory");
        }
    }
    __syncthreads();
}

__device__ __forceinline__ float wave_sum(float v) {
#pragma unroll
    for (int o = 1; o < 64; o <<= 1) v += __shfl_xor(v, o);
    return v;
}

__device__ __forceinline__ void transpose_item(const float* W, int K, int N, bf16* WT, int mode, LAS float* scr, int item, int lane) {
    const int nblk = N / 32, kb = item / nblk, nb = item - kb * nblk, k0 = 64 * kb, n0 = 32 * nb;
    const int drow0 = mode == 0 ? n0 : ((n0 >> 7) * 256 + (n0 & 127) + (mode == 2 ? 128 : 0));
#pragma unroll 8
    for (int i = 0; i < 32; ++i) { const int kk = 2 * i + (lane >> 5); scr[kk * 33 + (lane & 31)] = W[(size_t)(k0 + kk) * N + n0 + (lane & 31)]; }
    LDS_WAIT(); asm volatile("" ::: "memory");
    const int c = lane & 7;
#pragma unroll
    for (int j = 0; j < 4; ++j) { const int n = (lane >> 3) + 8 * j; const LAS float* s = scr + (8 * c) * 33 + n;
        v4u o; o.x = pk2(s[0 * 33], s[1 * 33]); o.y = pk2(s[2 * 33], s[3 * 33]); o.z = pk2(s[4 * 33], s[5 * 33]); o.w = pk2(s[6 * 33], s[7 * 33]);
        *(v4u*)(WT + (size_t)(drow0 + n) * K + k0 + 8 * c) = o; }
    LDS_WAIT(); asm volatile("" ::: "memory");
}
__device__ __forceinline__ void dsincos(double x, double& s, double& c) {
    const double k = rint(x * 0.63661977236758134308);
    double r = fma(-k, 1.5707963267948966192, x); r = fma(-k, 6.1232339957367658860e-17, r);
    const double r2 = r * r;
    double ps = -1.0 / 1307674368000.0; ps = fma(ps, r2, 1.0 / 6227020800.0); ps = fma(ps, r2, -1.0 / 39916800.0); ps = fma(ps, r2, 1.0 / 362880.0); ps = fma(ps, r2, -1.0 / 5040.0);
    ps = fma(ps, r2, 1.0 / 120.0); ps = fma(ps, r2, -1.0 / 6.0); ps = fma(ps, r2, 1.0); const double sn = r * ps;
    double pc = 1.0 / 20922789888000.0; pc = fma(pc, r2, -1.0 / 87178291200.0); pc = fma(pc, r2, 1.0 / 479001600.0); pc = fma(pc, r2, -1.0 / 3628800.0); pc = fma(pc, r2, 1.0 / 40320.0);
    pc = fma(pc, r2, -1.0 / 720.0); pc = fma(pc, r2, 1.0 / 24.0); pc = fma(pc, r2, -0.5); const double cs = fma(pc, r2, 1.0);
    const int q = (int)k & 3;
    s = (q == 0) ? sn : (q == 1) ? cs : (q == 2) ? -sn : -cs;
    c = (q == 0) ? cs : (q == 1) ? -sn : (q == 2) ? -cs : sn;
}
__device__ __forceinline__ double dexp(double x) {
    const double k = rint(x * 1.4426950408889634074);
    double r = fma(-k, 0.69314718055994528623, x); r = fma(-k, 2.3190468138462995584e-17, r);
    double p = 1.0 / 87178291200.0; p = fma(p, r, 1.0 / 6227020800.0); p = fma(p, r, 1.0 / 479001600.0); p = fma(p, r, 1.0 / 39916800.0); p = fma(p, r, 1.0 / 3628800.0); p = fma(p, r, 1.0 / 362880.0);
    p = fma(p, r, 1.0 / 40320.0); p = fma(p, r, 1.0 / 5040.0); p = fma(p, r, 1.0 / 720.0); p = fma(p, r, 1.0 / 120.0); p = fma(p, r, 1.0 / 24.0); p = fma(p, r, 1.0 / 6.0); p = fma(p, r, 0.5); p = fma(p, r, 1.0); p = fma(p, r, 1.0);
    const long long bits = (long long)(1023 + (int)k) << 52;
    return p * __builtin_bit_cast(double, bits);
}

struct Args { const float* in[29]; float* out; unsigned char* ws; int ph_lo, ph_hi; };

__device__ __forceinline__ void p0_prologue(const Args& A, LAS unsigned char* lds, int gw, int NGW, int wave, int lane) {
    unsigned char* ws = A.ws;
    for (int w = gw; w < 96 * KSL + 512 + 2048; w += NGW) {
    if (w >= 96 * KSL + 512) {
        const int idx = (w - 96 * KSL - 512) * 64 + lane, o = idx >> 16, r = idx & 65535, g = r >> 8, mm = (r >> 6) & 3, o16 = lane & 15, kq = lane >> 4;
        const int tau = 2 * mm, p0 = 16 * (tau & 3) + 4 * kq;
        const float* cs = (tau < 4 ? A.in[21] : A.in[22]) + (size_t)o * 256 * 16 * 64 + (size_t)(g * 16 + o16) * 64 + p0; const float sg = tau < 4 ? 1.0f : -1.0f;
        const f32x4 a = *(const f32x4*)cs * sg, b = *(const f32x4*)(cs + 16) * sg;
        v4u q; q.x = pk2(a.x, a.y); q.y = pk2(a.z, a.w); q.z = pk2(b.x, b.y); q.w = pk2(b.z, b.w);
        *(v4u*)(ws + WS_S5P + (size_t)o * S5P_LAYER + S5P_COP + ((size_t)((g * 4 + mm) * 64 + lane)) * 16) = q;
    } else if (w < 96 * KSL) {
        const int nb = w % 96, ks = w / 96;
        const float* wp = A.in[2] + (size_t)(ks * 256) * NMODV + nb * 256 + lane * 4; const float* cp = A.in[1] + ks * 256;
        f32x4 a = {0.f, 0.f, 0.f, 0.f};
#pragma unroll 8
        for (int k = 0; k < 256; ++k) { const float cv = cp[k]; const float s = cv / (1.0f + expf(-cv)); const f32x4 w = *(const f32x4*)(wp + (size_t)k * NMODV); a += s * w; }
        *(f32x4*)((float*)(ws + WS_MODP) + (size_t)ks * NMODV + nb * 256 + lane * 4) = a;
    } else {
        const int idx = (w - 96 * KSL) * 64 + lane, o = idx >> 14, gp = idx & 16383, g = gp >> 6;
        const double lr = (double)fminf(A.in[16][idx], -1e-4f), li = (double)A.in[17][idx], dt = dexp((double)A.in[18][o * 256 + g]);
        const double mag = dexp(lr * dt); double sn, cs; dsincos(li * dt, sn, cs);
        const double abr = mag * cs, abi = mag * sn, den = lr * lr + li * li, nr = abr - 1.0, ni = abi;
        const double fre = (nr * lr + ni * li) / den, fim = (ni * lr - nr * li) / den;
        double tr = abr, ti = abi;
#pragma unroll
        for (int q = 0; q < 6; ++q) { const double t2 = tr * tr - ti * ti; ti = 2.0 * tr * ti; tr = t2; }
        unsigned char* pb = ws + WS_S5P + (size_t)o * S5P_LAYER;
        ((float*)(pb + S5P_ABR))[gp] = (float)abr; ((float*)(pb + S5P_ABI))[gp] = (float)abi; ((float*)(pb + S5P_ATR))[gp] = (float)tr; ((float*)(pb + S5P_ATI))[gp] = (float)ti;
        const float* bre = A.in[19] + (size_t)idx * 16; const float* bim = A.in[20] + (size_t)idx * 16;
        float* obr = (float*)(pb + S5P_BBR) + (size_t)gp * 16; float* obi = (float*)(pb + S5P_BBI) + (size_t)gp * 16;
#pragma unroll
        for (int h4 = 0; h4 < 4; ++h4) { const f32x4 br = *(const f32x4*)(bre + 4 * h4), bi = *(const f32x4*)(bim + 4 * h4); f32x4 r, i;
#pragma unroll
            for (int j = 0; j < 4; ++j) { r[j] = (float)(fre * (double)br[j] - fim * (double)bi[j]); i[j] = (float)(fre * (double)bi[j] + fim * (double)br[j]); }
            *(f32x4*)(obr + 4 * h4) = r; *(f32x4*)(obi + 4 * h4) = i; }
        { const int p = gp & 63, ti = p >> 4, i16 = p & 15;
#pragma unroll
          for (int kq = 0; kq < 4; ++kq) { const f32x4 r = *(const f32x4*)(obr + 4 * kq), i = *(const f32x4*)(obi + 4 * kq);
              v2u pr, pi; pr.x = pk2(r.x, r.y); pr.y = pk2(r.z, r.w); pi.x = pk2(i.x, i.y); pi.y = pk2(i.z, i.w);
              *(v2u*)(pb + S5P_BBOP + ((size_t)((g * 8 + ti) * 64 + kq * 16 + i16)) * 8) = pr; *(v2u*)(pb + S5P_BBOP + ((size_t)((g * 8 + 4 + ti) * 64 + kq * 16 + i16)) * 8) = pi; } }
    }
    }
    if (gw < 2) { const int e = gw;
        const float s1 = wave_sum(A.in[10][e * 128 + lane] * A.in[11][e * 128 + lane] + A.in[10][e * 128 + 64 + lane] * A.in[11][e * 128 + 64 + lane]);
        const float s2 = wave_sum(A.in[12][e * 128 + lane] * A.in[13][e * 128 + lane] + A.in[12][e * 128 + 64 + lane] * A.in[13][e * 128 + 64 + lane]);
        const float lam_init = e == 0 ? 0.2f : 0.4707130183435842f;
        if (lane == 0) ((float*)(ws + WS_LAM))[e] = expf(s1) - expf(s2) + lam_init; }
    LAS float* scr = (LAS float*)(lds + wave * 16384);
    constexpr int I_IN = 64 * 384, I_OUT = 64 * 128, I_GLU = 64 * 128, I_GU = 64 * 344, I_DN = 172 * 128;
    constexpr int NITEMS = 2 * I_IN + 2 * I_OUT + 4 * I_GLU + 8 * I_GU + 4 * I_DN;
    for (int it = gw; it < NITEMS; it += NGW) {
        int r = it;
        if (r < 2 * I_IN) { const int e = r / I_IN; transpose_item(A.in[8] + (size_t)e * DM * 12288, DM, 12288, (bf16*)(ws + WS_WIN + e * W_IN_B), 0, scr, r - e * I_IN, lane); continue; } r -= 2 * I_IN;
        if (r < 2 * I_OUT) { const int e = r / I_OUT; transpose_item(A.in[15] + (size_t)e * DM * DM, DM, DM, (bf16*)(ws + WS_WOUT + e * W_OUT_B), 0, scr, r - e * I_OUT, lane); continue; } r -= 2 * I_OUT;
        if (r < 4 * I_GLU) { const int q = r / I_GLU, o = q >> 1, s = q & 1; transpose_item(A.in[24 + s] + (size_t)o * DM * DM, DM, DM, (bf16*)(ws + WS_WGLU + o * W_GLU_B), 1 + s, scr, r - q * I_GLU, lane); continue; } r -= 4 * I_GLU;
        if (r < 8 * I_GU) { const int q = r / I_GU, l = q >> 1, s = q & 1; transpose_item(A.in[26 + s] + (size_t)l * DM * FFH, DM, FFH, (bf16*)(ws + WS_WGU + l * W_GU_B), 1 + s, scr, r - q * I_GU, lane); continue; } r -= 8 * I_GU;
        { const int l = r / I_DN; transpose_item(A.in[28] + (size_t)l * FFH * DM, FFH, DM, (bf16*)(ws + WS_WDN + l * W_DN_B), 0, scr, r - l * I_DN, lane); }
    }
}
__device__ __forceinline__ void p1_modvec(const Args& A, int gtid, int NGT) {
    const float* mp = (const float*)(A.ws + WS_MODP); float* ml = (float*)(A.ws + WS_MODL);
    for (int i = gtid; i < DEPTH * NMODV; i += NGT) { const int j = i % NMODV; float v = A.in[3][j] + A.in[4][i];
#pragma unroll
        for (int ks = 0; ks < KSL; ++ks) v += mp[(size_t)ks * NMODV + j];
        ml[i] = v; }
}
__device__ __forceinline__ void norm_mod_phase(const float* src, const float* nw, const float* sh, const float* sc, bf16* dst, LAS unsigned char* lds, int tid, int gw, int NGW, int lane) {
    LAS float* w1 = (LAS float*)lds; LAS float* bb = w1 + DM;
    for (int i = tid; i < DM; i += NTHR) { w1[i] = nw[i] * (1.0f + sc[i]); bb[i] = sh[i]; }
    __syncthreads();
    for (int m = gw; m < SEQ; m += NGW) {
        const f32x4* xr = (const f32x4*)(src + (size_t)m * DM) + lane;
        f32x4 v[16]; float ss = 0.f;
#pragma unroll
        for (int j = 0; j < 16; ++j) { v[j] = xr[64 * j]; ss += (v[j].x * v[j].x + v[j].y * v[j].y) + (v[j].z * v[j].z + v[j].w * v[j].w); }
        const float rstd = 1.0f / sqrtf(wave_sum(ss) * (1.0f / DM) + NORM_EPS);
        v2u* o8 = (v2u*)(dst + (size_t)m * DM) + lane;
#pragma unroll
        for (int j = 0; j < 16; ++j) { const int col = j * 256 + lane * 4; const f32x4 w = *(const LAS f32x4*)(w1 + col), b = *(const LAS f32x4*)(bb + col);
            const f32x4 y = v[j] * rstd * w + b; v2u p; p.x = pk2(y.x, y.y); p.y = pk2(y.z, y.w); o8[64 * j] = p; }
    }
    __syncthreads();
}
__device__ __forceinline__ void final_norm_phase(const float* src, const float* nw, float* dst, int gw, int NGW, int lane) {
    for (int m = gw; m < SEQ; m += NGW) {
        const f32x4* xr = (const f32x4*)(src + (size_t)m * DM) + lane;
        f32x4 v[16]; float ss = 0.f;
#pragma unroll
        for (int j = 0; j < 16; ++j) { v[j] = xr[64 * j]; ss += (v[j].x * v[j].x + v[j].y * v[j].y) + (v[j].z * v[j].z + v[j].w * v[j].w); }
        const float rstd = 1.0f / sqrtf(wave_sum(ss) * (1.0f / DM) + NORM_EPS);
        f32x4* o = (f32x4*)(dst + (size_t)m * DM) + lane; const f32x4* wv = (const f32x4*)nw + lane;
#pragma unroll
        for (int j = 0; j < 16; ++j) o[64 * j] = v[j] * rstd * wv[64 * j];
    }
}
__device__ __forceinline__ void conv_phase(const bf16* Z, const float* cw, bf16* MIX, int gtid, int NGT) {
    for (int i = gtid; i < SEQ * 256; i += NGT) {
        const int t = i >> 8, r = i & 255, gi = r >> 4, c8 = (r & 15) * 8;
        const size_t o = (size_t)t * 128 + c8;
        const v4u zero = {0u, 0u, 0u, 0u};
        const v4u vb = *(const v4u*)(Z + (size_t)gi * GS + o);
        const bf16* zc = Z + (size_t)(16 + gi) * GS + o; const bf16* zx = Z + (size_t)(32 + gi) * GS + o;
        const v4u c0 = *(const v4u*)zc, x0 = *(const v4u*)zx;
        const v4u c1 = t >= 1 ? *(const v4u*)(zc - 128) : zero, x1 = t >= 1 ? *(const v4u*)(zx - 128) : zero;
        const v4u c2 = t >= 2 ? *(const v4u*)(zc - 256) : zero, x2 = t >= 2 ? *(const v4u*)(zx - 256) : zero;
        const float* wp = cw + gi * 128 + c8;
        float y[8];
#pragma unroll
        for (int q = 0; q < 4; ++q) {
            const float u0l = bflo(c0[q]) * bflo(x0[q]), u0h = bfhi(c0[q]) * bfhi(x0[q]);
            const float u1l = bflo(c1[q]) * bflo(x1[q]), u1h = bfhi(c1[q]) * bfhi(x1[q]);
            const float u2l = bflo(c2[q]) * bflo(x2[q]), u2h = bfhi(c2[q]) * bfhi(x2[q]);
            const int j = 2 * q;
            y[j]     = bflo(vb[q]) * (wp[2 * 2048 + j] * u0l + wp[2048 + j] * u1l + wp[j] * u2l);
            y[j + 1] = bfhi(vb[q]) * (wp[2 * 2048 + j + 1] * u0h + wp[2048 + j + 1] * u1h + wp[j + 1] * u2h);
        }
        v4u w; w.x = pk2(y[0], y[1]); w.y = pk2(y[2], y[3]); w.z = pk2(y[4], y[5]); w.w = pk2(y[6], y[7]);
        *(v4u*)(MIX + (size_t)t * DM + gi * 128 + c8) = w;
    }
}
__device__ __forceinline__ void combine_phase(const float* OT, const float* lamp, const float* sg, float lam_init, bf16* MIX, int gw, int NGW, int lane) {
    const float lam = lamp[0], os = 1.0f - lam_init;
    const int j = lane >> 5, c4 = (lane & 31) * 4;
    const f32x4 gv = *(const f32x4*)(sg + 128 * j + c4);
    for (int it = gw; it < SEQ * 8; it += NGW) {
        const int t = it >> 3, h = it & 7;
        const f32x4 a = *(const f32x4*)(OT + (size_t)(h * 4 + j) * GS + (size_t)t * 128 + c4), b = *(const f32x4*)(OT + (size_t)(h * 4 + 2 + j) * GS + (size_t)t * 128 + c4);
        const f32x4 o = a - lam * b;
        const float rstd = 1.0f / sqrtf(wave_sum((o.x * o.x + o.y * o.y) + (o.z * o.z + o.w * o.w)) * (1.0f / 256.0f) + SUBLN_EPS);
        const f32x4 y = o * (rstd * os) * gv;
        v2u p; p.x = pk2(y.x, y.y); p.y = pk2(y.z, y.w);
        *(v2u*)(MIX + (size_t)t * DM + 2048 + 256 * h + 128 * j + c4) = p;
    }
}
__device__ __forceinline__ att::BlockRef<att::bf16, float> att_ref(const bf16* Z, float* OT, int item, int pass) {
    const int r = item >> 8, b = item & 255, vh = r * 8 + (b & 7), pair = b >> 3, qb = pass ? 63 - pair : pair;
    const int h = vh >> 2, m = (vh >> 1) & 1, j = vh & 1;
    att::BlockRef<att::bf16, float> R;
    R.Q = (const att::bf16*)(Z + (size_t)(48 + 2 * h + m) * GS + (size_t)qb * 256 * 128);
    R.K = (const att::bf16*)(Z + (size_t)(64 + 2 * h + m) * GS);
    R.V = (const att::bf16*)(Z + (size_t)(80 + 2 * h + j) * GS);
    R.O = OT + (size_t)vh * GS + (size_t)qb * 256 * 128; R.P0 = qb * 256;
    return R;
}
__device__ __forceinline__ void attn_phase(const bf16* Z, float* OT, char* lds, int bid, int G) {
    constexpr int TOTAL = 1024;
    int item = bid; if (item >= TOTAL) return;
    int pass = 0;
    att::BlockRef<att::bf16, float> cur = att_ref(Z, OT, item, 0);
    att::Seam<att::bf16> S;
    att::causal_swa_prime<att::bf16, float>(cur, SEQ, lds, S);
    for (;;) {
        const bool more_pass = pass == 0, more_item = item + G < TOTAL, last = !more_pass && !more_item;
        int itn = item, passn = 1;
        if (!more_pass) { passn = 0; itn = more_item ? item + G : item; }
        const att::BlockRef<att::bf16, float> nxt = last ? cur : att_ref(Z, OT, itn, passn);
        att::causal_swa_block<att::bf16, float>(cur, nxt, SEQ, SEQ, lds, S);
        if (last) break;
        cur = nxt; item = itn; pass = passn;
    }
}
__device__ __forceinline__ float gelu_tanh(float x) { const float z = 1.5957691216057308f * (x + 0.044715f * x * x * x); return x * __builtin_amdgcn_rcpf(1.0f + __builtin_amdgcn_exp2f(-1.4426950408889634f * z)); }
template <bool PASS2>
__device__ __forceinline__ void s5_pass(const bf16* Hin, const unsigned char* prm, const float* c_re, const float* c_im, const float* dsk, float* F, const float* HC, bf16* Gout,
                                        LAS unsigned char* lds, int gw, int NGW, int wave, int lane) {
    LAS float* lu = (LAS float*)(lds + wave * 4096);
    for (int item = gw; item < 256 * S5NC; item += NGW) {
        const int g = item & 255, c = item >> 8, gp = g * 64 + lane;
        { const bf16* up = Hin + (size_t)(c * S5T + lane) * DM + 16 * g; const v4u a = *(const v4u*)up, b = *(const v4u*)(up + 8);
          LAS f32x4* ur = (LAS f32x4*)(lu + lane * 16);
          ur[0] = (f32x4){bflo(a.x), bfhi(a.x), bflo(a.y), bfhi(a.y)}; ur[1] = (f32x4){bflo(a.z), bfhi(a.z), bflo(a.w), bfhi(a.w)};
          ur[2] = (f32x4){bflo(b.x), bfhi(b.x), bflo(b.y), bfhi(b.y)}; ur[3] = (f32x4){bflo(b.z), bfhi(b.z), bflo(b.w), bfhi(b.w)}; }
        f32x4 bbr[4], bbi[4];
#pragma unroll
        for (int q = 0; q < 4; ++q) { bbr[q] = *(const f32x4*)((const float*)(prm + S5P_BBR) + (size_t)gp * 16 + 4 * q); bbi[q] = *(const f32x4*)((const float*)(prm + S5P_BBI) + (size_t)gp * 16 + 4 * q); }
        const float abr = ((const float*)(prm + S5P_ABR))[gp], abi = ((const float*)(prm + S5P_ABI))[gp];
        float hr = 0.f, hi = 0.f, cr[16], ci[16], dk = 0.f;
        if (PASS2) {
#pragma unroll
            for (int o = 0; o < 16; ++o) { cr[o] = c_re[(size_t)(g * 16 + o) * 64 + lane]; ci[o] = c_im[(size_t)(g * 16 + o) * 64 + lane]; }
            hr = HC[(size_t)(c * 256 + g) * 128 + lane]; hi = HC[(size_t)(c * 256 + g) * 128 + 64 + lane]; dk = dsk[16 * g + (lane >> 2)];
        }
        LDS_WAIT(); asm volatile("" ::: "memory");
#pragma unroll 2
        for (int t = 0; t < S5T; ++t) {
            const LAS f32x4* ut = (const LAS f32x4*)(lu + t * 16);
            float bur = 0.f, bui = 0.f;
#pragma unroll
            for (int q = 0; q < 4; ++q) { const f32x4 u = ut[q];
                bur += (bbr[q].x * u.x + bbr[q].y * u.y) + (bbr[q].z * u.z + bbr[q].w * u.w); bui += (bbi[q].x * u.x + bbi[q].y * u.y) + (bbi[q].z * u.z + bbi[q].w * u.w); }
            const float nr = abr * hr - abi * hi + bur, ni = abr * hi + abi * hr + bui; hr = nr; hi = ni;
            if (PASS2) {
                float v[16];
#pragma unroll
                for (int o = 0; o < 16; ++o) v[o] = hr * cr[o] - hi * ci[o];
#pragma unroll
                for (int i = 0; i < 8; ++i) { const float send = (lane & 32) ? v[i] : v[i + 8], keep = (lane & 32) ? v[i + 8] : v[i]; v[i] = keep + __shfl_xor(send, 32); }
#pragma unroll
                for (int i = 0; i < 4; ++i) { const float send = (lane & 16) ? v[i] : v[i + 4], keep = (lane & 16) ? v[i + 4] : v[i]; v[i] = keep + __shfl_xor(send, 16); }
#pragma unroll
                for (int i = 0; i < 2; ++i) { const float send = (lane & 8) ? v[i] : v[i + 2], keep = (lane & 8) ? v[i + 2] : v[i]; v[i] = keep + __shfl_xor(send, 8); }
                { const float send = (lane & 4) ? v[0] : v[1], keep = (lane & 4) ? v[1] : v[0]; v[0] = keep + __shfl_xor(send, 4); }
                v[0] += __shfl_xor(v[0], 2); v[0] += __shfl_xor(v[0], 1);
                const float yy = v[0] + dk * lu[t * 16 + (lane >> 2)];
                const float gl = gelu_tanh(yy);
                if ((lane & 3) == 0) Gout[(size_t)(c * S5T + t) * DM + 16 * g + (lane >> 2)] = (bf16)(pk2(gl, gl) & 0xffffu);
            }
        }
        if (!PASS2) { F[(size_t)(c * 256 + g) * 128 + lane] = hr; F[(size_t)(c * 256 + g) * 128 + 64 + lane] = hi; }
        LDS_WAIT(); asm volatile("" ::: "memory");
    }
}

constexpr int S5TS = 8, S5SB = S5TS * 256 + 16;
typedef short s5_bf16x8 __attribute__((ext_vector_type(8)));
template <bool PASS2>
__device__ __forceinline__ void s5m_pass(const bf16* Hin, const unsigned char* prm, const float* dsk, float* F, const float* HC, bf16* Gout, LAS unsigned char* lds, int bid, int G) {
    const int tid = opaque_tid(), lane = tid & 63, w = __builtin_amdgcn_readfirstlane(tid >> 6), j = lane & 15, rq = lane >> 4;
    const int rowslot = tid >> 4, piece = tid & 15;
    constexpr int NST = S5T / S5TS, NQ = 16 * S5TS / 32;
    for (int unit = bid; unit < 32 * (S5NC / 16); unit += G) {
        const int gb = unit & 31, cs = unit >> 5, g = gb * 8 + w;
        v2u bb[8];
#pragma unroll
        for (int t8 = 0; t8 < 8; ++t8) bb[t8] = *(const v2u*)(prm + S5P_BBOP + ((size_t)((g * 8 + t8) * 64 + lane)) * 8);
        v4u cop[4];
        f32x4 ar[4], ai[4], sr[4], si[4], dk = {0.f, 0.f, 0.f, 0.f};
#pragma unroll
        for (int q = 0; q < 4; ++q) { ar[q] = *(const f32x4*)((const float*)(prm + S5P_ABR) + g * 64 + 16 * q + 4 * rq); ai[q] = *(const f32x4*)((const float*)(prm + S5P_ABI) + g * 64 + 16 * q + 4 * rq); }
        if (PASS2) {
#pragma unroll
            for (int mm = 0; mm < 4; ++mm) cop[mm] = *(const v4u*)(prm + S5P_COP + ((size_t)((g * 4 + mm) * 64 + lane)) * 16);
            const float* hc = HC + ((size_t)(cs * 16 + j) * 256 + g) * 128 + 4 * rq;
#pragma unroll
            for (int q = 0; q < 4; ++q) { sr[q] = *(const f32x4*)(hc + 16 * q); si[q] = *(const f32x4*)(hc + 64 + 16 * q); }
            dk = *(const f32x4*)(dsk + 16 * g + 4 * rq);
        } else {
#pragma unroll
            for (int q = 0; q < 4; ++q) { sr[q] = (f32x4){0.f, 0.f, 0.f, 0.f}; si[q] = (f32x4){0.f, 0.f, 0.f, 0.f}; }
        }
        const bf16* src = Hin + (size_t)(cs * 16 * S5T) * DM + gb * 128 + piece * 8;
        bf16* dstp = PASS2 ? Gout + (size_t)(cs * 16 * S5T) * DM + gb * 128 + piece * 8 : nullptr;
        v4u pre[NQ];
#pragma unroll
        for (int q = 0; q < NQ; ++q) { const int ri = q * 32 + rowslot, jj = ri / S5TS, tt = ri % S5TS; pre[q] = *(const v4u*)(src + (size_t)(jj * S5T + tt) * DM); }
        for (int s = 0; s < NST; ++s) {
#pragma unroll
            for (int q = 0; q < NQ; ++q) { const int ri = q * 32 + rowslot, jj = ri / S5TS, tt = ri % S5TS; LAS v4u* lp = (LAS v4u*)(lds + jj * S5SB + tt * 256 + piece * 16);
                if (PASS2 && s > 0) { const v4u y = *lp; *(v4u*)(dstp + (size_t)(jj * S5T + (s - 1) * S5TS + tt) * DM) = y; }
                *lp = pre[q]; }
            if (s + 1 < NST) {
#pragma unroll
                for (int q = 0; q < NQ; ++q) { const int ri = q * 32 + rowslot, jj = ri / S5TS, tt = ri % S5TS; pre[q] = *(const v4u*)(src + (size_t)(jj * S5T + (s + 1) * S5TS + tt) * DM); } }
            LDS_WAIT(); __syncthreads();
            LAS unsigned char* up = lds + j * S5SB + w * 32 + rq * 8;
            v2u uu[S5TS];
#pragma unroll
            for (int tt = 0; tt < S5TS; ++tt) uu[tt] = *(const LAS v2u*)(up + tt * 256);
#pragma unroll
            for (int tt = 0; tt < S5TS; ++tt) {
                v4u ub; ub.x = uu[tt].x; ub.y = uu[tt].y; ub.z = 0u; ub.w = 0u;
                const s5_bf16x8 U = __builtin_bit_cast(s5_bf16x8, ub);
#pragma unroll
                for (int q = 0; q < 4; ++q) {
                    const f32x4 tr = ar[q] * sr[q] - ai[q] * si[q], ti = ar[q] * si[q] + ai[q] * sr[q];
                    v4u a0; a0.x = bb[q].x; a0.y = bb[q].y; a0.z = 0u; a0.w = 0u; v4u a1; a1.x = bb[4 + q].x; a1.y = bb[4 + q].y; a1.z = 0u; a1.w = 0u;
                    sr[q] = __builtin_amdgcn_mfma_f32_16x16x32_bf16(__builtin_bit_cast(s5_bf16x8, a0), U, tr, 0, 0, 0);
                    si[q] = __builtin_amdgcn_mfma_f32_16x16x32_bf16(__builtin_bit_cast(s5_bf16x8, a1), U, ti, 0, 0, 0);
                }
                if (PASS2) {
                    f32x4 y = {0.f, 0.f, 0.f, 0.f};
#pragma unroll
                    for (int mm = 0; mm < 4; ++mm) { const f32x4 t0 = mm < 2 ? sr[2 * mm] : si[2 * mm - 4], t1 = mm < 2 ? sr[2 * mm + 1] : si[2 * mm - 3];
                        v4u sb; sb.x = pk2(t0.x, t0.y); sb.y = pk2(t0.z, t0.w); sb.z = pk2(t1.x, t1.y); sb.w = pk2(t1.z, t1.w);
                        y = __builtin_amdgcn_mfma_f32_16x16x32_bf16(__builtin_bit_cast(s5_bf16x8, cop[mm]), __builtin_bit_cast(s5_bf16x8, sb), y, 0, 0, 0); }
                    const f32x4 uf = {bflo(uu[tt].x), bfhi(uu[tt].x), bflo(uu[tt].y), bfhi(uu[tt].y)};
                    const f32x4 yy = y + dk * uf;
                    v2u o; o.x = pk2(gelu_tanh(yy.x), gelu_tanh(yy.y)); o.y = pk2(gelu_tanh(yy.z), gelu_tanh(yy.w));
                    *(LAS v2u*)(up + tt * 256) = o;
                }
            }
            LDS_WAIT(); __syncthreads();
        }
        if (PASS2) {
#pragma unroll
            for (int q = 0; q < NQ; ++q) { const int ri = q * 32 + rowslot, jj = ri / S5TS, tt = ri % S5TS; const v4u y = *(const LAS v4u*)(lds + jj * S5SB + tt * 256 + piece * 16);
                *(v4u*)(dstp + (size_t)(jj * S5T + (NST - 1) * S5TS + tt) * DM) = y; }
            LDS_WAIT();
        } else {
            float* fo = F + ((size_t)(cs * 16 + j) * 256 + g) * 128 + 4 * rq;
#pragma unroll
            for (int q = 0; q < 4; ++q) { *(f32x4*)(fo + 16 * q) = sr[q]; *(f32x4*)(fo + 64 + 16 * q) = si[q]; }
        }
    }
}
__device__ __forceinline__ void s5_carry(const unsigned char* prm, const float* F, float* HC, int gtid) {
    if (gtid < 256 * 64) {
        const int g = gtid >> 6, p = gtid & 63;
        const float atr = ((const float*)(prm + S5P_ATR))[gtid], ati = ((const float*)(prm + S5P_ATI))[gtid];
        float hr = 0.f, hi = 0.f;
#pragma unroll 8
        for (int c = 0; c < S5NC; ++c) { const size_t o = (size_t)(c * 256 + g) * 128 + p;
            HC[o] = hr; HC[o + 64] = hi; const float fr = F[o], fi = F[o + 64];
            const float nr = atr * hr - ati * hi + fr, ni = atr * hi + ati * hr + fi; hr = nr; hi = ni; }
    }
}

struct Ctx { int lo, hi, tid, lane, wave, gw, NGW, gtid, NGT, G, bid; };
#ifndef DUP_ATTN
#define DUP_ATTN 0
#endif
#ifndef DUP_S5
#define DUP_S5 0
#endif
#ifndef DUP_FFN1
#define DUP_FFN1 0
#endif
#ifndef DUP_PRO
#define DUP_PRO 0
#endif
#define IN(k) (lo <= (k) && (k) < hi)
#define SEAM(k) do { if (IN(k) && IN((k) + 1)) xcd_barrier(bar); } while (0)
#define FFN_PHASES(l, pb) do { \
    const float* ml_ = MODL + (size_t)(l) * NMODV; \
    if (IN((pb) + 5)) norm_mod_phase(XR, args.in[6] + (size_t)(l) * DM, ml_ + 3 * DM, ml_ + 4 * DM, Hb, lds, tid, gw, NGW, lane); \
    SEAM((pb) + 5); \
    if (IN((pb) + 6)) { pg8::Gemm g{Hb, (const bf16*)(ws + WS_WGU + (size_t)(l) * W_GU_B), SEQ, 2 * FFH, DM}; pg8::StaticOrder S; S.init(SEQ, 2 * FFH, G, bid); \
        pg8::EpiSwiGLU E{HID, FFH}; pg8::gemm_phase<pg8::EpiSwiGLU, pg8::StaticOrder, true, true>(lds, g, S, E); } \
    if (DUP_FFN1 && IN((pb) + 6)) { xcd_barrier(bar); pg8::Gemm g{Hb, (const bf16*)(ws + WS_WGU + (size_t)(l) * W_GU_B), SEQ, 2 * FFH, DM}; pg8::StaticOrder S; S.init(SEQ, 2 * FFH, G, bid); \
        pg8::EpiSwiGLU E{HID, FFH}; pg8::gemm_phase<pg8::EpiSwiGLU, pg8::StaticOrder, true, true>(lds, g, S, E); } \
    SEAM((pb) + 6); \
    if (IN((pb) + 7)) { pg8::Gemm g{HID, (const bf16*)(ws + WS_WDN + (size_t)(l) * W_DN_B), SEQ, DM, FFH}; pg8::StaticOrder S; S.init(SEQ, DM, G, bid); \
        pg8::EpiResid E{XR, XR, ml_ + 5 * DM, DM}; pg8::gemm_phase<pg8::EpiResid, pg8::StaticOrder, true, true>(lds, g, S, E); } \
    SEAM((pb) + 7); } while (0)
template <int lp>
__device__ __forceinline__ void layer_pair(const Args& args, const Ctx& C, LAS unsigned char* lds, unsigned char* lds_raw, const XcdBarrier& bar) {
    const int lo = C.lo, hi = C.hi, tid = C.tid, lane = C.lane, wave = C.wave, gw = C.gw, NGW = C.NGW, gtid = C.gtid, NGT = C.NGT, G = C.G, bid = C.bid;
    unsigned char* ws = args.ws;
    bf16* const Hb = (bf16*)(ws + WS_H); bf16* const MIX = (bf16*)(ws + WS_MIX); bf16* const Z = (bf16*)(ws + WS_Z); bf16* const HID = (bf16*)(ws + WS_Z);
    float* const OT = (float*)(ws + WS_OT); float* const XR = args.out;
    const float* const MODL = (const float*)(ws + WS_MODL);
        { const int l = 2 * lp, pb = 2 + 8 * l; const float* ml = MODL + (size_t)l * NMODV;
          const float* xin = (l == 0) ? args.in[0] : XR;
          if (IN(pb)) norm_mod_phase(xin, args.in[5] + (size_t)l * DM, ml, ml + DM, Hb, lds, tid, gw, NGW, lane);
          SEAM(pb);
          if (IN(pb + 1)) { pg8::Gemm g{Hb, (const bf16*)(ws + WS_WIN + (size_t)lp * W_IN_B), SEQ, 12288, DM}; pg8::StaticOrder S; S.init(SEQ, 12288, G, bid);
              pg8::EpiHeadMajor E{Z, GS}; pg8::gemm_phase<pg8::EpiHeadMajor, pg8::StaticOrder, true, true>(lds, g, S, E); }
          SEAM(pb + 1);
          if (IN(pb + 2)) { conv_phase(Z, args.in[9] + (size_t)lp * 3 * 2048, MIX, gtid, NGT); attn_phase(Z, OT, (char*)lds_raw, bid, G); if (DUP_ATTN) { xcd_barrier(bar); attn_phase(Z, OT, (char*)lds_raw, bid, G); } }
          SEAM(pb + 2);
          if (IN(pb + 3)) combine_phase(OT, (const float*)(ws + WS_LAM) + lp, args.in[14] + lp * 256, lp == 0 ? 0.2f : 0.4707130183435842f, MIX, gw, NGW, lane);
          SEAM(pb + 3);
          if (IN(pb + 4)) { pg8::Gemm g{MIX, (const bf16*)(ws + WS_WOUT + (size_t)lp * W_OUT_B), SEQ, DM, DM}; pg8::StaticOrder S; S.init(SEQ, DM, G, bid);
              pg8::EpiResid E{xin, XR, ml + 2 * DM, DM}; pg8::gemm_phase<pg8::EpiResid, pg8::StaticOrder, true, true>(lds, g, S, E); }
          SEAM(pb + 4);
          FFN_PHASES(l, pb);
        }
        { const int l = 2 * lp + 1, pb = 2 + 8 * l; const float* ml = MODL + (size_t)l * NMODV;
          const unsigned char* prm = ws + WS_S5P + (size_t)lp * S5P_LAYER;
          float* const S5F = (float*)(ws + WS_S5F); float* const S5H = (float*)(ws + WS_S5H);
          if (IN(pb)) norm_mod_phase(XR, args.in[5] + (size_t)l * DM, ml, ml + DM, Hb, lds, tid, gw, NGW, lane);
          SEAM(pb);
          if (IN(pb + 1)) { if (S5_MFMA) s5m_pass<false>(Hb, prm, nullptr, S5F, nullptr, nullptr, lds, bid, G); else s5_pass<false>(Hb, prm, nullptr, nullptr, nullptr, S5F, nullptr, nullptr, lds, gw, NGW, wave, lane); }
          SEAM(pb + 1);
          if (IN(pb + 2)) s5_carry(prm, S5F, S5H, gtid);
          SEAM(pb + 2);
          if (IN(pb + 3)) { if (S5_MFMA) s5m_pass<true>(Hb, prm, args.in[23] + (size_t)lp * DM, nullptr, S5H, MIX, lds, bid, G); else s5_pass<true>(Hb, prm, args.in[21] + (size_t)lp * 256 * 16 * 64, args.in[22] + (size_t)lp * 256 * 16 * 64, args.in[23] + (size_t)lp * DM, nullptr, S5H, MIX, lds, gw, NGW, wave, lane); }
          if (DUP_S5) { xcd_barrier(bar);
          if (IN(pb + 1)) { if (S5_MFMA) s5m_pass<false>(Hb, prm, nullptr, S5F, nullptr, nullptr, lds, bid, G); else s5_pass<false>(Hb, prm, nullptr, nullptr, nullptr, S5F, nullptr, nullptr, lds, gw, NGW, wave, lane); }
          SEAM(pb + 1);
          if (IN(pb + 2)) s5_carry(prm, S5F, S5H, gtid);
          SEAM(pb + 2);
          if (IN(pb + 3)) { if (S5_MFMA) s5m_pass<true>(Hb, prm, args.in[23] + (size_t)lp * DM, nullptr, S5H, MIX, lds, bid, G); else s5_pass<true>(Hb, prm, args.in[21] + (size_t)lp * 256 * 16 * 64, args.in[22] + (size_t)lp * 256 * 16 * 64, args.in[23] + (size_t)lp * DM, nullptr, S5H, MIX, lds, gw, NGW, wave, lane); }
          }
          SEAM(pb + 3);
          if (IN(pb + 4)) { pg8::Gemm g{MIX, (const bf16*)(ws + WS_WGLU + (size_t)lp * W_GLU_B), SEQ, 2 * DM, DM}; pg8::StaticOrder S; S.init(SEQ, 2 * DM, G, bid);
              pg8::EpiGluResid E{XR, XR, ml + 2 * DM, DM}; pg8::gemm_phase<pg8::EpiGluResid, pg8::StaticOrder, true, true>(lds, g, S, E); }
          SEAM(pb + 4);
          FFN_PHASES(l, pb);
        }
    }
#undef FFN_PHASES
#undef IN
#undef SEAM

__global__ void __launch_bounds__(NTHR, 2) trunk_fwd(Args args) {
    extern __shared__ __attribute__((aligned(16))) unsigned char lds_raw[];
    LAS unsigned char* lds = (LAS unsigned char*)lds_raw;
    volatile LAS unsigned* MISC = (volatile LAS unsigned*)(lds + MISC_OFF);
    const int tid = opaque_tid(), lane = tid & 63, wave = __builtin_amdgcn_readfirstlane(tid >> 6);
    const int G = gridDim.x, bid = blockIdx.x;
    const int vcu = (G % 8 == 0) ? (bid % 8) * (G / 8) + bid / 8 : bid;
    const int gw = vcu * NWAVES + wave, NGW = G * NWAVES, gtid = vcu * NTHR + tid, NGT = G * NTHR;
    unsigned char* ws = args.ws;
    const int lo = args.ph_lo, hi = args.ph_hi;
    for (int u = tid; u < (LDS_BYTES - RING_BYTES) / 4; u += NTHR) ((LAS unsigned*)(lds + RING_BYTES))[u] = 0u;
    __syncthreads();
    XcdBarrier bar; bar.bar = (unsigned*)(ws + WS_CTL) + CW_BAR; bar.x = 0; bar.st = MISC + 8;
    if (hi - lo > 1) bar = xcd_barrier_post((unsigned*)(ws + WS_CTL) + CW_BAR, MISC + 8);
    const Ctx C{lo, hi, tid, lane, wave, gw, NGW, gtid, NGT, G, bid};
#define IN(k) (lo <= (k) && (k) < hi)
#define SEAM(k) do { if (IN(k) && IN((k) + 1)) xcd_barrier(bar); } while (0)

    bf16* const Hb = (bf16*)(ws + WS_H); bf16* const MIX = (bf16*)(ws + WS_MIX); bf16* const Z = (bf16*)(ws + WS_Z); bf16* const HID = (bf16*)(ws + WS_Z);
    float* const OT = (float*)(ws + WS_OT); float* const XR = args.out;
    const float* const MODL = (const float*)(ws + WS_MODL);

    if (IN(0)) { p0_prologue(args, lds, gw, NGW, wave, lane); if (DUP_PRO) { xcd_barrier(bar); p0_prologue(args, lds, gw, NGW, wave, lane); } }
    SEAM(0);
    if (IN(1)) p1_modvec(args, gtid, NGT);
    SEAM(1);


    layer_pair<0>(args, C, lds, lds_raw, bar);
    layer_pair<1>(args, C, lds, lds_raw, bar);
    if (IN(34)) final_norm_phase(XR, args.in[7], XR, gw, NGW, lane);
#undef IN
#undef SEAM
}

extern "C" void kernel_launch(void* const* d_in, const int* in_sizes, int n_in, void* d_out, int out_size, void* d_ws, size_t ws_size, hipStream_t stream) {
    static int grid = 0;
    if (grid == 0) {
        if (n_in != 29 || in_sizes[0] != SEQ * DM || out_size != SEQ * DM || ws_size < WS_END) {
            fprintf(stderr, "kernel_launch: built for 29 inputs, x/out of %d floats, >= %zu bytes of workspace; got n_in %d, in0 %d, out %d, ws %zu; nothing launched\n", SEQ * DM, (size_t)WS_END, n_in, n_in > 0 ? in_sizes[0] : -1, out_size, ws_size); grid = -1; return; }
        int dev = 0, cus = 0, per_cu = 0;
        if (hipGetDevice(&dev) != hipSuccess || hipDeviceGetAttribute(&cus, hipDeviceAttributeMultiprocessorCount, dev) != hipSuccess) { fprintf(stderr, "kernel_launch: device query failed\n"); grid = -1; return; }
        if (hipFuncSetAttribute((const void*)trunk_fwd, hipFuncAttributeMaxDynamicSharedMemorySize, LDS_BYTES) != hipSuccess) { fprintf(stderr, "kernel_launch: hipFuncSetAttribute failed\n"); grid = -1; return; }
        if (hipOccupancyMaxActiveBlocksPerMultiprocessor(&per_cu, (const void*)trunk_fwd, NTHR, LDS_BYTES) != hipSuccess || per_cu < 1) { fprintf(stderr, "kernel_launch: occupancy query reports %d workgroups per CU\n", per_cu); }
        (void)hipGetLastError();
        grid = cus;
        fprintf(stderr, "kernel_launch: grid %d, occupancy %d, ws %zu (need %zu)\n", grid, per_cu, ws_size, (size_t)WS_END);
    }
    if (grid < 0) return;
    if (hipMemsetAsync((char*)d_ws + WS_CTL, 0, CTL_ZERO_BYTES, stream) != hipSuccess) { fprintf(stderr, "kernel_launch: memset failed\n"); return; }
    Args a{};
    for (int i = 0; i < 29; ++i) a.in[i] = (const float*)d_in[i];
    a.out = (float*)d_out; a.ws = (unsigned char*)d_ws;
#if MK_PER_PHASE
    for (int p = 0; p < N_PHASES; ++p) { a.ph_lo = p; a.ph_hi = p + 1; hipLaunchKernelGGL(trunk_fwd, dim3(grid), dim3(NTHR), LDS_BYTES, stream, a); }
#else
    a.ph_lo = 0; a.ph_hi = N_PHASES;
    hipLaunchKernelGGL(trunk_fwd, dim3(grid), dim3(NTHR), LDS_BYTES, stream, a);
#endif
    const hipError_t le = hipPeekAtLastError();
    if (le != hipSuccess) fprintf(stderr, "kernel_launch: launch failed: %s\n", hipGetErrorName(le));
}
```

```cpp
#include <hip/hip_runtime.h>
#include <hip/hip_bf16.h>
#include <cstdio>
#include <cstdint>
__device__ __forceinline__ int opaque_tid() { int t; asm volatile("v_mov_b32 %0, %1" : "=v"(t) : "v"((int)threadIdx.x)); return t; }
namespace pg8 {
#define PG8_LAS __attribute__((address_space(3)))
typedef unsigned short bf16_t;
typedef short bf16x8 __attribute__((ext_vector_type(8)));
typedef float f32x4 __attribute__((ext_vector_type(4)));
typedef unsigned u32x4 __attribute__((ext_vector_type(4)));
constexpr int BM = 256, BK = 64, HALF = 128, HTB = HALF * BK * 2  , STAGE_BYTES = 8 * HTB, NXCD = 8, WGM = 8;

__host__ __device__ __forceinline__ int lds_byte(int r, int c) { const int st = (r >> 4) * 2 + (c >> 5), rr = r & 15, cc = c & 31, ob = rr * 64 + cc * 2; return st * 1024 + (ob ^ (((ob >> 9) & 1) << 5)); }
__host__ __device__ __forceinline__ void stage_rc(int b, int& R, int& C) { const int st = b / 1024, sb = b % 1024, swz = sb ^ (((sb >> 9) & 1) << 5); R = (st >> 1) * 16 + swz / 64; C = (st & 1) * 32 + (swz % 64) / 2; }
__host__ __device__ __forceinline__ int perm32(int rho) { const int n = rho >> 4, i = rho & 15; return 8 * (i >> 2) + 4 * n + (i & 3); }

struct Unit { int pm, pn; };
struct Gemm { const bf16_t* A; const bf16_t* Bt; int M, N, K, lda, ldb; };

struct StaticOrder {
    int nM, nN, nwg, G, c;
    __host__ __device__ void init(int M, int N, int G_, int c_) { nM = M / BM; nN = N / BM; nwg = nM * nN; G = G_; c = c_; }
    __host__ __device__ bool next(int i, Unit& u) const {
        const long L = (long)i * G + c; if (L >= nwg) return false;
        int wgid = (int)L; { const int q = nwg / NXCD, r = nwg % NXCD, xcd = wgid % NXCD, off = wgid / NXCD; wgid = (xcd < r ? xcd * (q + 1) : r * (q + 1) + (xcd - r) * q) + off; }
        const int nig = WGM * nN, gid = wgid / nig, fm = gid * WGM, gsz = (nM - fm) < WGM ? (nM - fm) : WGM;
        u.pm = fm + ((wgid % nig) % gsz); u.pn = (wgid % nig) / gsz; return true;
    }
    __device__ __forceinline__ void a_ready(const Unit&) const {}
    __device__ __forceinline__ void done(const Unit&) const {}
};

__device__ __forceinline__ unsigned cvt_pk_bf16(float lo, float hi) { unsigned r; asm volatile("v_cvt_pk_bf16_f32 %0, %1, %2" : "=v"(r) : "v"(lo), "v"(hi)); return r; }
__device__ __forceinline__ float fast_sigmoid(float x) { return __builtin_amdgcn_rcpf(1.0f + __builtin_amdgcn_exp2f(-1.4426950408889634f * x)); }

struct EpiHeadMajor {
    static constexpr bool PERM = true, AFTER_DRAIN = false;
    bf16_t* O; size_t gstride;
    __device__ __forceinline__ void operator()(const f32x4 (&acc)[2][2][4][2], const Unit& u, int wr, int wc, int fr, int fq) const {
        const int row0 = u.pm * BM + wr * 64 + fr, col0 = wc * 32 + 8 * fq;
#pragma unroll
        for (int ai = 0; ai < 2; ++ai)
#pragma unroll
            for (int m = 0; m < 4; ++m) { const size_t ro = (size_t)(row0 + ai * HALF + m * 16) * 128 + col0;
#pragma unroll
                for (int bj = 0; bj < 2; ++bj) { const f32x4 v0 = acc[ai][bj][m][0], v1 = acc[ai][bj][m][1];
                    u32x4 w; w.x = cvt_pk_bf16(v0[0], v0[1]); w.y = cvt_pk_bf16(v0[2], v0[3]); w.z = cvt_pk_bf16(v1[0], v1[1]); w.w = cvt_pk_bf16(v1[2], v1[3]);
                    *(u32x4*)(O + (size_t)(2 * u.pn + bj) * gstride + ro) = w; } }
    }
};
struct EpiResid {
    static constexpr bool PERM = false, AFTER_DRAIN = false;
    const float* base; float* out; const float* gate; int ldc;
    __device__ __forceinline__ void operator()(const f32x4 (&acc)[2][2][4][2], const Unit& u, int wr, int wc, int fr, int fq) const {
        const int row0 = u.pm * BM + wr * 64 + fr, col0 = u.pn * BM + wc * 32 + 4 * fq;
        f32x4 gv[2][2];
#pragma unroll
        for (int bj = 0; bj < 2; ++bj)
#pragma unroll
            for (int n = 0; n < 2; ++n) gv[bj][n] = *(const f32x4*)(gate + col0 + bj * HALF + n * 16);
#pragma unroll
        for (int ai = 0; ai < 2; ++ai) {
            f32x4 b[4][2][2];
#pragma unroll
            for (int m = 0; m < 4; ++m) { const size_t off = (size_t)(row0 + ai * HALF + m * 16) * ldc + col0;
#pragma unroll
                for (int bj = 0; bj < 2; ++bj)
#pragma unroll
                    for (int n = 0; n < 2; ++n) b[m][bj][n] = *(const f32x4*)(base + off + bj * HALF + n * 16); }
            asm volatile("" ::: "memory");
#pragma unroll
            for (int m = 0; m < 4; ++m) { const size_t off = (size_t)(row0 + ai * HALF + m * 16) * ldc + col0;
#pragma unroll
                for (int bj = 0; bj < 2; ++bj)
#pragma unroll
                    for (int n = 0; n < 2; ++n) *(f32x4*)(out + off + bj * HALF + n * 16) = b[m][bj][n] + gv[bj][n] * acc[ai][bj][m][n]; }
            asm volatile("" ::: "memory"); }
    }
};
struct EpiSwiGLU {
    static constexpr bool PERM = true, AFTER_DRAIN = false;
    bf16_t* O; int ldc;
    __device__ __forceinline__ void operator()(const f32x4 (&acc)[2][2][4][2], const Unit& u, int wr, int wc, int fr, int fq) const {
        const int row0 = u.pm * BM + wr * 64 + fr, col0 = u.pn * HALF + wc * 32 + 8 * fq;
#pragma unroll
        for (int ai = 0; ai < 2; ++ai)
#pragma unroll
            for (int m = 0; m < 4; ++m) { bf16_t* rowp = O + (size_t)(row0 + ai * HALF + m * 16) * ldc + col0;
                float r[8];
#pragma unroll
                for (int n = 0; n < 2; ++n)
#pragma unroll
                    for (int j = 0; j < 4; ++j) { const float g = acc[ai][0][m][n][j], up = acc[ai][1][m][n][j]; r[n * 4 + j] = g * fast_sigmoid(g) * up; }
                u32x4 w; w.x = cvt_pk_bf16(r[0], r[1]); w.y = cvt_pk_bf16(r[2], r[3]); w.z = cvt_pk_bf16(r[4], r[5]); w.w = cvt_pk_bf16(r[6], r[7]);
                *(u32x4*)rowp = w; }
    }
};
struct EpiGluResid {
    static constexpr bool PERM = false, AFTER_DRAIN = false;
    const float* base; float* out; const float* gate; int ldc;
    __device__ __forceinline__ void operator()(const f32x4 (&acc)[2][2][4][2], const Unit& u, int wr, int wc, int fr, int fq) const {
        const int row0 = u.pm * BM + wr * 64 + fr, col0 = u.pn * HALF + wc * 32 + 4 * fq;
        f32x4 gv[2];
#pragma unroll
        for (int n = 0; n < 2; ++n) gv[n] = *(const f32x4*)(gate + col0 + n * 16);
        f32x4 b[2][4][2];
#pragma unroll
        for (int ai = 0; ai < 2; ++ai)
#pragma unroll
            for (int m = 0; m < 4; ++m) { const size_t off = (size_t)(row0 + ai * HALF + m * 16) * ldc + col0;
#pragma unroll
                for (int n = 0; n < 2; ++n) b[ai][m][n] = *(const f32x4*)(base + off + n * 16); }
        asm volatile("" ::: "memory");
#pragma unroll
        for (int ai = 0; ai < 2; ++ai)
#pragma unroll
            for (int m = 0; m < 4; ++m) { const size_t off = (size_t)(row0 + ai * HALF + m * 16) * ldc + col0;
#pragma unroll
                for (int n = 0; n < 2; ++n) { const f32x4 a = acc[ai][0][m][n], sg = acc[ai][1][m][n]; f32x4 y;
#pragma unroll
                    for (int j = 0; j < 4; ++j) y[j] = a[j] * fast_sigmoid(sg[j]);
                    *(f32x4*)(out + off + n * 16) = b[ai][m][n] + gv[n] * y; } }
        asm volatile("" ::: "memory");
    }
};

template <class Epi, class Sched, bool ALIGN_EPI = false, bool SP2 = false>
__device__ __forceinline__ void gemm_phase(PG8_LAS unsigned char* lds, const Gemm g, const Sched& S, const Epi& E) {
    const int tid = opaque_tid(), wid = __builtin_amdgcn_readfirstlane(tid >> 6), lane = tid & 63, wr = wid >> 2, wc = wid & 3, fr = lane & 15, fq = lane >> 4;
    const int K = g.K, nt = K / BK;
    unsigned voffA[2], voffB[2];
#pragma unroll
    for (int i = 0; i < 2; ++i) { int R, C; stage_rc(tid * 16 + i * 8192, R, C); const int Rb = Epi::PERM ? ((R & ~31) + perm32(R & 31)) : R;
        voffA[i] = (unsigned)(R * g.lda + C) * 2u; voffB[i] = (unsigned)(Rb * g.ldb + C) * 2u; }
    const size_t kstep = (size_t)(BK * 2);
    const size_t hstepA = (size_t)HALF * g.lda * 2, hstepB = (size_t)HALF * g.ldb * 2;
    const size_t tstepA = 2 * hstepA, tstepB = 2 * hstepB;
    const unsigned ldsw = (unsigned)wid * 1024u;
    const int aoff = lds_byte(wr * 64 + fr, fq * 8), boff = lds_byte(wc * 32 + fr, fq * 8);
#define PG8_SA(b, h) (((b) * 2 + (h)) * HTB)
#define PG8_SB(b, h) ((4 + (b) * 2 + (h)) * HTB)
#define PG8_STAGE(bufoff, gbase, voff) do { _Pragma("unroll") for (int _i = 0; _i < 2; ++_i) \
        __builtin_amdgcn_global_load_lds((const unsigned*)((const char*)(gbase) + (voff)[_i]), (PG8_LAS unsigned*)(lds + (bufoff) + ldsw + _i * 8192), 16, 0, 0); } while (0)
#define PG8_LDA(dst, b, h) do { _Pragma("unroll") for (int m = 0; m < 4; ++m) _Pragma("unroll") for (int k = 0; k < 2; ++k) dst[m][k] = *(const PG8_LAS bf16x8*)(lds + PG8_SA(b, h) + aoff + m * 2048 + k * 1024); } while (0)
#define PG8_LDB(dst, b, h) do { _Pragma("unroll") for (int n = 0; n < 2; ++n) _Pragma("unroll") for (int k = 0; k < 2; ++k) dst[n][k] = *(const PG8_LAS bf16x8*)(lds + PG8_SB(b, h) + boff + n * 2048 + k * 1024); } while (0)
#define PG8_MMA(ai, bj, At, Bt) do { __builtin_amdgcn_s_setprio(1); _Pragma("unroll") for (int m = 0; m < 4; ++m) _Pragma("unroll") for (int n = 0; n < 2; ++n) _Pragma("unroll") for (int k = 0; k < 2; ++k) \
        acc[ai][bj][m][n] = __builtin_amdgcn_mfma_f32_16x16x32_bf16(Bt[n][k], At[m][k], acc[ai][bj][m][n], 0, 0, 0); __builtin_amdgcn_s_setprio(0); } while (0)
#define PG8_WAIT_V(n) asm volatile("s_waitcnt vmcnt(" #n ")" ::: "memory")
#define PG8_WAIT_L(n) asm volatile("s_waitcnt lgkmcnt(" #n ")" ::: "memory")
#define PG8_BAR __builtin_amdgcn_s_barrier()
#define PG8_SCHED __builtin_amdgcn_sched_barrier(0)
    Unit cur, nxt; int ui = 0;
    if (!S.next(0, cur)) return;
    f32x4 acc[2][2][4][2];
#pragma unroll
    for (int a = 0; a < 2; ++a)
#pragma unroll
        for (int b = 0; b < 2; ++b)
#pragma unroll
            for (int m = 0; m < 4; ++m)
#pragma unroll
                for (int n = 0; n < 2; ++n) acc[a][b][m][n] = (f32x4){0.f, 0.f, 0.f, 0.f};
    bf16x8 At[4][2], B0[2][2], B1[2][2];
    const char* cA = (const char*)g.A + (size_t)cur.pm * tstepA; const char* cB = (const char*)g.Bt + (size_t)cur.pn * tstepB;
    S.a_ready(cur);
    if constexpr (SP2) {
        PG8_STAGE(PG8_SB(0, 0), cB, voffB); PG8_STAGE(PG8_SB(0, 1), cB + hstepB, voffB); PG8_STAGE(PG8_SA(0, 0), cA, voffA); PG8_STAGE(PG8_SA(0, 1), cA + hstepA, voffA);
        if (wr == 1) PG8_BAR;
        PG8_WAIT_V(2); PG8_BAR;
        PG8_STAGE(PG8_SB(1, 0), cB + kstep, voffB); PG8_STAGE(PG8_SA(1, 0), cA + kstep, voffA); PG8_STAGE(PG8_SB(1, 1), cB + hstepB + kstep, voffB);
        PG8_WAIT_V(6); PG8_BAR;
    } else {
        PG8_STAGE(PG8_SB(0, 0), cB, voffB); PG8_STAGE(PG8_SA(0, 0), cA, voffA); PG8_STAGE(PG8_SB(0, 1), cB + hstepB, voffB); PG8_STAGE(PG8_SA(0, 1), cA + hstepA, voffA);
        if (wr == 1) PG8_BAR;
        PG8_WAIT_V(4); PG8_BAR;
        PG8_STAGE(PG8_SB(1, 0), cB + kstep, voffB); PG8_STAGE(PG8_SA(1, 0), cA + kstep, voffA); PG8_STAGE(PG8_SB(1, 1), cB + hstepB + kstep, voffB);
        PG8_WAIT_V(6); PG8_BAR;
    }
    for (;;) {
        const bool has_next = S.next(ui + 1, nxt);
        const char* nA = has_next ? (const char*)g.A + (size_t)nxt.pm * tstepA : cA; const char* nB = has_next ? (const char*)g.Bt + (size_t)nxt.pn * tstepB : cB;
        for (int t = 0; t < nt; t += 2) {
            const bool last = (t == nt - 2);
            const char* a1 = cA + (size_t)(t + 1) * kstep;
            const char* a2 = last ? nA : cA + (size_t)(t + 2) * kstep; const char* b2 = last ? nB : cB + (size_t)(t + 2) * kstep;
            const char* a3 = a2 + kstep; const char* b3 = b2 + kstep;
            if (last && has_next) S.a_ready(nxt);
            if constexpr (SP2) {
            PG8_LDB(B0, 0, 0); PG8_LDB(B1, 0, 1); PG8_SCHED; PG8_LDA(At, 0, 0); PG8_STAGE(PG8_SA(1, 1), a1 + hstepA, voffA);
            PG8_WAIT_V(8); PG8_WAIT_L(0); PG8_BAR; PG8_MMA(0, 0, At, B0); PG8_MMA(0, 1, At, B1); PG8_BAR; PG8_SCHED;
            PG8_LDA(At, 0, 1); PG8_STAGE(PG8_SB(0, 0), b2, voffB); PG8_STAGE(PG8_SB(0, 1), b2 + hstepB, voffB); PG8_STAGE(PG8_SA(0, 0), a2, voffA);
            PG8_WAIT_V(8); PG8_WAIT_L(0); PG8_BAR; PG8_MMA(1, 0, At, B0); PG8_MMA(1, 1, At, B1); PG8_BAR; PG8_SCHED;
            PG8_LDB(B0, 1, 0); PG8_LDB(B1, 1, 1); PG8_SCHED; PG8_LDA(At, 1, 0); PG8_STAGE(PG8_SA(0, 1), a2 + hstepA, voffA);
            PG8_WAIT_V(8); PG8_WAIT_L(0); PG8_BAR; PG8_MMA(0, 0, At, B0); PG8_MMA(0, 1, At, B1); PG8_BAR; PG8_SCHED;
            PG8_LDA(At, 1, 1); PG8_STAGE(PG8_SB(1, 0), b3, voffB); PG8_STAGE(PG8_SB(1, 1), b3 + hstepB, voffB); PG8_STAGE(PG8_SA(1, 0), a3, voffA);
            PG8_WAIT_V(8); PG8_WAIT_L(0); PG8_BAR; PG8_MMA(1, 0, At, B0); PG8_MMA(1, 1, At, B1); PG8_BAR; PG8_SCHED;
            } else {
            PG8_LDB(B0, 0, 0); PG8_SCHED; PG8_LDA(At, 0, 0); PG8_STAGE(PG8_SA(1, 1), a1 + hstepA, voffA);
            PG8_WAIT_L(8); PG8_BAR; PG8_WAIT_L(0); PG8_MMA(0, 0, At, B0); PG8_BAR; PG8_SCHED;
            PG8_LDB(B1, 0, 1); PG8_STAGE(PG8_SB(0, 0), b2, voffB);
            PG8_BAR; PG8_WAIT_L(0); PG8_MMA(0, 1, At, B1); PG8_BAR;
            PG8_LDA(At, 0, 1); PG8_STAGE(PG8_SA(0, 0), a2, voffA);
            PG8_BAR; PG8_WAIT_L(0); PG8_MMA(1, 0, At, B0); PG8_BAR; PG8_SCHED;
            PG8_STAGE(PG8_SB(0, 1), b2 + hstepB, voffB);
            PG8_WAIT_V(6); PG8_BAR; PG8_MMA(1, 1, At, B1); PG8_BAR;
            PG8_LDB(B0, 1, 0); PG8_SCHED; PG8_LDA(At, 1, 0); PG8_STAGE(PG8_SA(0, 1), a2 + hstepA, voffA);
            PG8_WAIT_L(8); PG8_BAR; PG8_WAIT_L(0); PG8_MMA(0, 0, At, B0); PG8_BAR; PG8_SCHED;
            PG8_LDB(B1, 1, 1); PG8_STAGE(PG8_SB(1, 0), b3, voffB);
            PG8_BAR; PG8_WAIT_L(0); PG8_MMA(0, 1, At, B1); PG8_BAR;
            PG8_LDA(At, 1, 1); PG8_STAGE(PG8_SA(1, 0), a3, voffA);
            PG8_BAR; PG8_WAIT_L(0); PG8_MMA(1, 0, At, B0); PG8_BAR; PG8_SCHED;
            PG8_STAGE(PG8_SB(1, 1), b3 + hstepB, voffB);
            PG8_WAIT_V(6); PG8_BAR; PG8_MMA(1, 1, At, B1); PG8_BAR;
            }
        }
        if constexpr (ALIGN_EPI) { if (wr == 0) PG8_BAR; }
        if constexpr (!Epi::AFTER_DRAIN) { E(acc, cur, wr, wc, fr, fq); S.done(cur); }
        if (!has_next) break;
#pragma unroll
        for (int a = 0; a < 2; ++a)
#pragma unroll
            for (int b = 0; b < 2; ++b)
#pragma unroll
                for (int m = 0; m < 4; ++m)
#pragma unroll
                    for (int n = 0; n < 2; ++n) acc[a][b][m][n] = (f32x4){0.f, 0.f, 0.f, 0.f};
        cur = nxt; cA = nA; cB = nB; ++ui;
        if constexpr (ALIGN_EPI) { if (wr == 1) PG8_BAR; }
    }
    PG8_WAIT_V(0);
    if constexpr (!ALIGN_EPI) { if (wr == 0) PG8_BAR; }
    PG8_BAR;
    if constexpr (Epi::AFTER_DRAIN) { E.fused(acc, cur, wr, wc, fr, fq, lds, wid, lane); S.done(cur); }
#undef PG8_SA
#undef PG8_SB
#undef PG8_STAGE
#undef PG8_LDA
#undef PG8_LDB
#undef PG8_MMA
#undef PG8_WAIT_V
#undef PG8_WAIT_L
#undef PG8_BAR
#undef PG8_SCHED
}
}

namespace att {
constexpr int D = 128;
constexpr float THR = 8.f;
constexpr bool WSKIP = false;
constexpr float SCALE = 0.08838834764831845f;
constexpr int NW = 8, QBLK = 32, KVBLK = 64, QB = NW * QBLK;
constexpr int SHM_V = KVBLK * D * 2, SHM_K = KVBLK * D * 2;
constexpr int LDS_BYTES = 2 * SHM_V + 2 * SHM_K + NW * 64 * 4;

using bf16 = __hip_bfloat16;
typedef short bf16x8 __attribute__((ext_vector_type(8)));
typedef short s16x4 __attribute__((ext_vector_type(4)));
typedef float f32x16 __attribute__((ext_vector_type(16)));
typedef float f32x4 __attribute__((ext_vector_type(4)));
typedef unsigned u32x4 __attribute__((ext_vector_type(4)));
template <class A, class Bt> struct same_t { static constexpr bool v = false; };
template <class A> struct same_t<A, A> { static constexpr bool v = true; };

#define KSWZ(row, colB) ((row) * 256 + ((colB) ^ (((row) & 7) << 4)))
#define SBAR() __builtin_amdgcn_sched_barrier(0)
__device__ __forceinline__ int v_st(int k, int c) { const int kk = (k & ~0xC) | ((k & 4) << 1) | ((k & 8) >> 1); return ((kk >> 3) * 4 + (c >> 5)) * 512 + ((kk & 7) * 32 + (c & 31)) * 2; }
__device__ __forceinline__ int v_rd_base(int lane) { return ((lane & 3) << 3) | (((lane >> 2) & 3) << 6) | (((lane >> 4) & 1) << 5) | (((lane >> 5) & 1) << 8); }
constexpr int v_rd_off(int d0, int ks, int half) { return d0 * 512 + ks * 4096 + half * 2048; }
__device__ __forceinline__ int crow(int r, int hi) { return (r & 3) + 8 * (r >> 2) + 4 * hi; }
__device__ __forceinline__ unsigned cvtpk(float lo, float hi) {
    unsigned r; asm volatile("v_cvt_pk_bf16_f32 %0, %1, %2" : "=v"(r) : "v"(lo), "v"(hi)); return r;
}
__device__ __forceinline__ bf16x8 pack8(f32x4 a, f32x4 b) {
    u32x4 w = {cvtpk(a[0], a[1]), cvtpk(a[2], a[3]), cvtpk(b[0], b[1]), cvtpk(b[2], b[3])};
    return *reinterpret_cast<bf16x8*>(&w);
}
template <class T> __device__ __forceinline__ bf16x8 load8(const T* p) {
    if constexpr (same_t<T, float>::v) { return pack8(*(const f32x4*)p, *(const f32x4*)(p + 4)); }
    else { return *reinterpret_cast<const bf16x8*>(p); }
}
__device__ __forceinline__ void mask_tile(f32x16& p0, f32x16& p1, int dq, unsigned W) {
    const float NEG = -__builtin_inff();
#pragma unroll
    for (int r = 0; r < 16; ++r) {
        const int c = (r & 3) + 8 * (r >> 2);
        if ((unsigned)(dq - c) >= W) p0[r] = NEG;
        if ((unsigned)(dq - c - 32) >= W) p1[r] = NEG;
    }
}
__device__ __forceinline__ void partialSM(f32x16& p0, f32x16& p1, float& m_reg, float& mn, float& alpha) {
    float pmax = p0[0]; for (int r = 1; r < 16; ++r) pmax = fmaxf(pmax, p0[r]); for (int r = 0; r < 16; ++r) pmax = fmaxf(pmax, p1[r]);
    { auto rr = __builtin_amdgcn_permlane32_swap(__float_as_uint(pmax), __float_as_uint(pmax), false, false);
      pmax = fmaxf(__uint_as_float(rr[0]), __uint_as_float(rr[1])); }
    constexpr float C2 = 1.4426950408889634f * SCALE;
    if (__builtin_expect(__all((pmax - m_reg) * SCALE <= THR), 1)) { mn = m_reg; alpha = 1.f; }
    else { mn = fmaxf(m_reg, pmax); alpha = __builtin_amdgcn_exp2f((m_reg - mn) * C2); m_reg = mn; }
    const float mnL = -mn * C2;
    for (int r = 0; r < 16; ++r) p0[r] = fmaf(p0[r], C2, mnL); for (int r = 0; r < 16; ++r) p1[r] = fmaf(p1[r], C2, mnL);
    for (int r = 0; r < 16; ++r) p0[r] = __builtin_amdgcn_exp2f(p0[r]);
}
__device__ __forceinline__ void finishSM(f32x16& p0, f32x16& p1, float alpha, float& l_reg, bf16x8& pa0, bf16x8& pa1, bf16x8& pa2, bf16x8& pa3) {
    for (int r = 0; r < 16; ++r) p1[r] = __builtin_amdgcn_exp2f(p1[r]);
    float ps = 0; for (int r = 0; r < 16; ++r) ps += p0[r]; for (int r = 0; r < 16; ++r) ps += p1[r];
    { auto rr = __builtin_amdgcn_permlane32_swap(__float_as_uint(ps), __float_as_uint(ps), false, false);
      ps = __uint_as_float(rr[0]) + __uint_as_float(rr[1]); }
    l_reg = l_reg * alpha + ps;
#define PK4(P, B_, OUT) do { unsigned a0 = cvtpk(P[B_+0], P[B_+1]), a1 = cvtpk(P[B_+2], P[B_+3]);                          \
        unsigned b0 = cvtpk(P[B_+4], P[B_+5]), b1 = cvtpk(P[B_+6], P[B_+7]);                                             \
        auto r0 = __builtin_amdgcn_permlane32_swap(a0, b0, false, false); auto r1 = __builtin_amdgcn_permlane32_swap(a1, b1, false, false); \
        u32x4 w = {r0[0], r1[0], r0[1], r1[1]}; OUT = *reinterpret_cast<bf16x8*>(&w); } while (0)
    PK4(p0, 0, pa0); PK4(p0, 8, pa1); PK4(p1, 0, pa2); PK4(p1, 8, pa3);
#undef PK4
}
template <int KB, bool SK>
__device__ __forceinline__ void qkt(f32x16& p0, f32x16& p1, const char* K_lds, int r32, int hi, const bf16x8* qr, bool act) {
    if (SK && !act) { const float NEG = -__builtin_inff();
#pragma unroll
        for (int r = 0; r < 16; ++r) { p0[r] = NEG; p1[r] = NEG; } return; }
    p0 = f32x16{}; p1 = f32x16{};
    const char* kb[4];
#pragma unroll
    for (int dd = 0; dd < 4; ++dd) kb[dd] = K_lds + KB * SHM_K + KSWZ(r32, (dd * 16 + hi * 8) * 2);
#pragma unroll
    for (int d0 = 0; d0 < 8; ++d0) { const char* a = kb[d0 & 3] + (d0 >> 2) * 128;
        bf16x8 b0 = *reinterpret_cast<const bf16x8*>(a);
        bf16x8 b1 = *reinterpret_cast<const bf16x8*>(a + 32 * 256);
        p0 = __builtin_amdgcn_mfma_f32_32x32x16_bf16(b0, qr[d0], p0, 0, 0, 0);
        p1 = __builtin_amdgcn_mfma_f32_32x32x16_bf16(b1, qr[d0], p1, 0, 0, 0); }
}
template <int VB, bool SK>
__device__ __forceinline__ void pv_tile(f32x16* o, int vb0, bf16x8 pa0, bf16x8 pa1, bf16x8 pa2, bf16x8 pa3, bool act) {
    if (SK && !act) return;
#define TRRD(dst, off) asm volatile("ds_read_b64_tr_b16 %0, %1 offset:%2" : "=&v"(dst) : "v"(vb0), "i"(off) : "memory")
#define PV_D0(d0) do { s16x4 l0, l1, l2, l3, h0, h1, h2, h3; constexpr int b_ = VB * SHM_V + v_rd_off(d0, 0, 0);     \
        TRRD(l0, b_); TRRD(h0, b_ + 2048); TRRD(l1, b_ + 4096); TRRD(h1, b_ + 6144); TRRD(l2, b_ + 8192); TRRD(h2, b_ + 10240); TRRD(l3, b_ + 12288); TRRD(h3, b_ + 14336); \
        asm volatile("s_waitcnt lgkmcnt(0)" ::: "memory"); SBAR();                 \
        o[d0] = __builtin_amdgcn_mfma_f32_32x32x16_bf16(pa0, (bf16x8){l0[0], l0[1], l0[2], l0[3], h0[0], h0[1], h0[2], h0[3]}, o[d0], 0, 0, 0);   \
        o[d0] = __builtin_amdgcn_mfma_f32_32x32x16_bf16(pa1, (bf16x8){l1[0], l1[1], l1[2], l1[3], h1[0], h1[1], h1[2], h1[3]}, o[d0], 0, 0, 0);   \
        o[d0] = __builtin_amdgcn_mfma_f32_32x32x16_bf16(pa2, (bf16x8){l2[0], l2[1], l2[2], l2[3], h2[0], h2[1], h2[2], h2[3]}, o[d0], 0, 0, 0);   \
        o[d0] = __builtin_amdgcn_mfma_f32_32x32x16_bf16(pa3, (bf16x8){l3[0], l3[1], l3[2], l3[3], h3[0], h3[1], h3[2], h3[3]}, o[d0], 0, 0, 0); } while (0)
    PV_D0(0); PV_D0(1); PV_D0(2); PV_D0(3);
#undef PV_D0
#undef TRRD
}

template <class TIn, class TOut> struct BlockRef { const TIn* Q; const TIn* K; const TIn* V; TOut* O; int P0; };
template <class TIn> struct Seam {
    bf16x8 qr[8];
    bf16x8 st_v0, st_v1, st_k0, st_k1; f32x4 sf0, sf1, sf2, sf3;
    f32x4 tq[16];
};
__device__ __forceinline__ int swa_jlo(int P0, int W) { const int lowk = P0 - W + 1; return lowk > 0 ? lowk / KVBLK : 0; }
#define ROW(p, k0, rr) ((p) + (size_t)((k0) + (rr)) * D + sc)
#define VMW() asm volatile("s_waitcnt vmcnt(0)" ::: "memory")
#define VMWN(n) asm volatile("s_waitcnt vmcnt(%0)" :: "i"(n) : "memory")
#define SLOAD_H(Kp, Vp, k0) do { S.st_v0 = load8<TIn>(ROW(Vp, k0, sr)); S.st_v1 = load8<TIn>(ROW(Vp, k0, 32 + sr));              \
                         S.st_k0 = load8<TIn>(ROW(Kp, k0, sr)); S.st_k1 = load8<TIn>(ROW(Kp, k0, 32 + sr)); } while (0)
#define SWRITE_HK(bf) do { *(bf16x8*)(K_lds + (bf) * SHM_K + kws) = S.st_k0; *(bf16x8*)(K_lds + (bf) * SHM_K + kws + 32 * 256) = S.st_k1; } while (0)
#define SWRITE_HV(bf) do { *(bf16x8*)(V_lds + (bf) * SHM_V + vst0) = S.st_v0; *(bf16x8*)(V_lds + (bf) * SHM_V + vst1) = S.st_v1; } while (0)
#define SWRITE_H(bf) do { SWRITE_HV(bf); SWRITE_HK(bf); } while (0)
#define SLOAD_F(p, k0) do { S.sf0 = *(const f32x4*)ROW(p, k0, sr); S.sf1 = *(const f32x4*)(ROW(p, k0, sr) + 4);                \
                            S.sf2 = *(const f32x4*)ROW(p, k0, 32 + sr); S.sf3 = *(const f32x4*)(ROW(p, k0, 32 + sr) + 4); } while (0)
#define SWRITE_KF(bf) do { *(bf16x8*)(K_lds + (bf) * SHM_K + kws) = pack8(S.sf0, S.sf1); *(bf16x8*)(K_lds + (bf) * SHM_K + kws + 32 * 256) = pack8(S.sf2, S.sf3); } while (0)
#define SWRITE_VF(bf) do { *(bf16x8*)(V_lds + (bf) * SHM_V + vst0) = pack8(S.sf0, S.sf1); *(bf16x8*)(V_lds + (bf) * SHM_V + vst1) = pack8(S.sf2, S.sf3); } while (0)
template <class TIn, class TOut>
__device__ __forceinline__ void causal_swa_prime(const BlockRef<TIn, TOut>& cur, int W, char* lds, Seam<TIn>& S) {
    constexpr bool F32 = same_t<TIn, float>::v;
    const int tid = opaque_tid(), wid = __builtin_amdgcn_readfirstlane(tid >> 6), lane = tid & 63, r32 = lane & 31, hi = lane >> 5;
    const int sr = tid >> 4, sc = (tid & 15) * 8, kws = KSWZ(sr, sc * 2); char* K_lds = lds + 2 * SHM_V;
    const int kb0 = swa_jlo(cur.P0, W) * KVBLK;
    for (int d0 = 0; d0 < 8; ++d0) S.qr[d0] = load8<TIn>(cur.Q + (size_t)(wid * QBLK + r32) * D + d0 * 16 + hi * 8);
    if constexpr (F32) { SLOAD_F((const float*)cur.K, kb0); VMW(); SWRITE_KF(0); SBAR(); SLOAD_F((const float*)cur.V, kb0); }
    else { SLOAD_H(cur.K, cur.V, kb0); VMW(); SWRITE_HK(0); }
    __syncthreads();
}
template <class TIn, class TOut>
__device__ __forceinline__ void causal_swa_block(const BlockRef<TIn, TOut>& cur, const BlockRef<TIn, TOut>& nxt, int skv, int W, char* lds, Seam<TIn>& S) {
    constexpr bool F32 = same_t<TIn, float>::v;
    const int tid = opaque_tid(), wid = __builtin_amdgcn_readfirstlane(tid >> 6), lane = tid & 63, r32 = lane & 31, hi = lane >> 5;
    const int j_lo = swa_jlo(cur.P0, W);
    int j_hi = (cur.P0 + QB - 1) / KVBLK + 1; if (j_hi > skv / KVBLK) j_hi = skv / KVBLK;
    const int NT = j_hi - j_lo;
    const int kbn = swa_jlo(nxt.P0, W) * KVBLK;
    const int qlo = cur.P0 + wid * QBLK, qm = qlo + r32 - 4 * hi;
    char* V_lds = lds; char* K_lds = lds + 2 * SHM_V;
    float* ws = (float*)(lds + 2 * SHM_V + 2 * SHM_K) + wid * 64; float* li_l = ws, * al_l = ws + 32;
    float m_reg = -1e30f, l_reg = 0; f32x16 o[4] = {};
    const int sr = tid >> 4, sc = (tid & 15) * 8, vst0 = v_st(sr, sc), vst1 = v_st(32 + sr, sc), kws = KSWZ(sr, sc * 2);
    const int vb0 = (int)(uintptr_t)V_lds + v_rd_base(lane);
    const TIn* Kh = cur.K; const TIn* Vh = cur.V;
#define RESC(a) do { if (__any((a) < 1.f)) { if (hi == 0) al_l[r32] = (a); asm volatile("s_waitcnt lgkmcnt(0)" ::: "memory");              \
                     for (int d_ = 0; d_ < 4; ++d_) for (int r = 0; r < 16; ++r) o[d_][r] *= al_l[crow(r, hi)]; } } while (0)
#define KBASE(t) ((j_lo + (t)) * KVBLK)
#define ACT(t) (KBASE(t) <= qlo + QBLK - 1 && KBASE(t) + KVBLK - 1 >= qlo - W + 1)
#define MASKT(P0_, P1_, t) do { const int kb_ = KBASE(t); if ((!SK || ACT(t)) && (kb_ + KVBLK - 1 > qlo || kb_ <= qlo + QBLK - 1 - W)) mask_tile(P0_, P1_, qm - kb_, (unsigned)W); } while (0)
    constexpr int NQL = F32 ? 16 : 8;
    constexpr bool SK = WSKIP && !F32;
#define SEAM_K0() do { VMWN(NQL); if constexpr (F32) { SWRITE_KF(0); SBAR(); SLOAD_F((const float*)nxt.V, kbn); } else { SWRITE_HK(0); } SBAR(); } while (0)
    f32x16 pA0, pA1, pB0, pB1; float mnA, mnB, alA, alB; bf16x8 pa0, pa1, pa2, pa3;
    if constexpr (F32) { VMW(); SWRITE_VF(0); SBAR(); } else { SWRITE_HV(0); SBAR(); }
    if (NT > 1) { if constexpr (F32) SLOAD_F((const float*)Kh, KBASE(1)); else SLOAD_H(Kh, Vh, KBASE(1)); }
    SBAR(); qkt<0, SK>(pA0, pA1, K_lds, r32, hi, S.qr, ACT(0));
    if constexpr (F32) { if (NT > 1) { VMW(); SWRITE_KF(1); SBAR(); SLOAD_F((const float*)Vh, KBASE(1)); } }
    MASKT(pA0, pA1, 0); partialSM(pA0, pA1, m_reg, mnA, alA);
    if (NT > 1) { VMW(); if constexpr (F32) { SWRITE_VF(1); SBAR(); if (NT > 2) SLOAD_F((const float*)Kh, KBASE(2)); } else SWRITE_H(1); }
    __syncthreads();
#define HALF_STEP(PX0, PX1, mnX, alX, PY0, PY1, alY, t, KB, VB, SB) do {                                                      \
        SBAR(); qkt<KB, SK>(PX0, PX1, K_lds, r32, hi, S.qr, ACT(t));                                             \
        finishSM(PY0, PY1, alY, l_reg, pa0, pa1, pa2, pa3); SBAR();                                                           \
        if ((t) + 1 < NT) { if constexpr (F32) { VMW(); SWRITE_KF(SB); SBAR(); SLOAD_F((const float*)Vh, KBASE((t) + 1)); }  \
                            else { SLOAD_H(Kh, Vh, KBASE((t) + 1)); } SBAR(); }                                               \
        pv_tile<VB, SK>(o, vb0, pa0, pa1, pa2, pa3, ACT((t) - 1)); MASKT(PX0, PX1, (t)); partialSM(PX0, PX1, m_reg, mnX, alX);                                        \
        __syncthreads();                                                                                                      \
        if ((t) + 1 < NT) { VMW(); if constexpr (F32) { SWRITE_VF(SB); SBAR(); if ((t) + 2 < NT) SLOAD_F((const float*)Kh, KBASE((t) + 2)); } \
                            else { SWRITE_H(SB); } }                                                                          \
        RESC(alX); __syncthreads(); } while (0)
    for (int t = 1; t + 1 < NT; t += 2) {
        HALF_STEP(pB0, pB1, mnB, alB, pA0, pA1, alA, t, 1, 0, 0);
        HALF_STEP(pA0, pA1, mnA, alA, pB0, pB1, alB, t + 1, 0, 1, 1);
    }
    const bool even = (NT & 1) == 0;
    if (even) { SBAR(); qkt<1, SK>(pB0, pB1, K_lds, r32, hi, S.qr, ACT(NT - 1)); SBAR(); }
#define QROW(e) (nxt.Q + (size_t)(wid * QBLK + r32) * D + ((e) >> 1) * 16 + hi * 8 + ((e) & 1) * 4)
    if constexpr (F32) { SLOAD_F((const float*)nxt.K, kbn); SBAR();
#pragma unroll
        for (int e = 0; e < 8; ++e) S.tq[e] = *(const f32x4*)QROW(e); }
    else { SLOAD_H(nxt.K, nxt.V, kbn); SBAR();
#pragma unroll
        for (int d0 = 0; d0 < 8; ++d0) S.qr[d0] = load8<TIn>(nxt.Q + (size_t)(wid * QBLK + r32) * D + d0 * 16 + hi * 8); }
    SBAR();
    finishSM(pA0, pA1, alA, l_reg, pa0, pa1, pa2, pa3); SBAR();
    if constexpr (F32) {
#pragma unroll
        for (int e = 8; e < 16; ++e) S.tq[e] = *(const f32x4*)QROW(e); SBAR(); }
#undef QROW
    pv_tile<0, SK>(o, vb0, pa0, pa1, pa2, pa3, ACT(even ? NT - 2 : NT - 1));
    if (even) { MASKT(pB0, pB1, NT - 1); partialSM(pB0, pB1, m_reg, mnB, alB); __syncthreads(); RESC(alB);
        finishSM(pB0, pB1, alB, l_reg, pa0, pa1, pa2, pa3); SBAR(); pv_tile<1, SK>(o, vb0, pa0, pa1, pa2, pa3, ACT(NT - 1)); }
    SBAR(); SEAM_K0();
    if (hi == 0) li_l[r32] = l_reg; asm volatile("s_waitcnt lgkmcnt(0)" ::: "memory");
    float rli[16];
#pragma unroll
    for (int r = 0; r < 16; ++r) rli[r] = __builtin_amdgcn_rcpf(li_l[crow(r, hi)]);
    TOut* Ow = cur.O + (size_t)(wid * QBLK) * D;
#pragma unroll
    for (int r = 0; r < 16; ++r) { const int orow = crow(r, hi);
#pragma unroll
        for (int d0 = 0; d0 < 4; ++d0) { const float v = o[d0][r] * rli[r];
            if constexpr (same_t<TOut, float>::v) { Ow[(size_t)orow * D + d0 * 32 + r32] = v; }
            else { const float vn = __shfl_xor(v, 1);
                   if ((r32 & 1) == 0) *(unsigned*)(Ow + (size_t)orow * D + d0 * 32 + r32) = cvtpk(v, vn); } } }
    if constexpr (F32) {
#pragma unroll
        for (int d0 = 0; d0 < 8; ++d0) S.qr[d0] = pack8(S.tq[2 * d0], S.tq[2 * d0 + 1]); }
    __syncthreads();
#undef RESC
#undef KBASE
#undef ACT
#undef MASKT
#undef SEAM_K0
#undef HALF_STEP
}
#undef ROW
#undef VMW
#undef VMWN
#undef SLOAD_H
#undef SWRITE_HK
#undef SWRITE_HV
#undef SWRITE_H
#undef SLOAD_F
#undef SWRITE_KF
#undef SWRITE_VF
#undef KSWZ
#undef SBAR
}

namespace att2 {
typedef short bf16x8 __attribute__((ext_vector_type(8)));
typedef short s16x4 __attribute__((ext_vector_type(4)));
typedef float f32x16 __attribute__((ext_vector_type(16)));
typedef unsigned u32x4 __attribute__((ext_vector_type(4)));
constexpr float SCALE = 0.08838834764831845f, THR = 8.f, C2 = 1.4426950408889634f * SCALE;
constexpr int V_OFF = 0, K_OFF = 65536, PX_OFF = 98304, MX_OFF = 114688, WS_OFF = 118784, LDS_NEED = 120832;
#define A2_KSWZ(row, colB) ((row) * 256 + ((colB) ^ (((row) & 7) << 4)))
#define A2_SBAR() __builtin_amdgcn_sched_barrier(0)
template <int KB>
__device__ __forceinline__ void qkt(f32x16& p, const char* Kl, int krow, int hi, const bf16x8* qr) {
    p = f32x16{};
    const char* kbp[4];
#pragma unroll
    for (int dd = 0; dd < 4; ++dd) kbp[dd] = Kl + KB * 16384 + A2_KSWZ(krow, (dd * 16 + hi * 8) * 2);
#pragma unroll
    for (int d0 = 0; d0 < 8; ++d0) { const bf16x8 b = *reinterpret_cast<const bf16x8*>(kbp[d0 & 3] + (d0 >> 2) * 128); p = __builtin_amdgcn_mfma_f32_32x32x16_bf16(b, qr[d0], p, 0, 0, 0); }
}
template <int VOFFB>
__device__ __forceinline__ void pv(f32x16* o, int vb0, bf16x8 pa0, bf16x8 pa1, bf16x8 pa2, bf16x8 pa3) {
#define A2_TRRD(dst, off) asm volatile("ds_read_b64_tr_b16 %0, %1 offset:%2" : "=&v"(dst) : "v"(vb0), "i"(off) : "memory")
#define A2_PV_D0(d0) do { s16x4 l0, l1, l2, l3, h0, h1, h2, h3; constexpr int b_ = VOFFB + att::v_rd_off(d0, 0, 0); \
        A2_TRRD(l0, b_); A2_TRRD(h0, b_ + 2048); A2_TRRD(l1, b_ + 4096); A2_TRRD(h1, b_ + 6144); A2_TRRD(l2, b_ + 8192); A2_TRRD(h2, b_ + 10240); A2_TRRD(l3, b_ + 12288); A2_TRRD(h3, b_ + 14336); \
        asm volatile("s_waitcnt lgkmcnt(0)" ::: "memory"); A2_SBAR(); \
        o[d0] = __builtin_amdgcn_mfma_f32_32x32x16_bf16(pa0, (bf16x8){l0[0], l0[1], l0[2], l0[3], h0[0], h0[1], h0[2], h0[3]}, o[d0], 0, 0, 0); \
        o[d0] = __builtin_amdgcn_mfma_f32_32x32x16_bf16(pa1, (bf16x8){l1[0], l1[1], l1[2], l1[3], h1[0], h1[1], h1[2], h1[3]}, o[d0], 0, 0, 0); \
        o[d0] = __builtin_amdgcn_mfma_f32_32x32x16_bf16(pa2, (bf16x8){l2[0], l2[1], l2[2], l2[3], h2[0], h2[1], h2[2], h2[3]}, o[d0], 0, 0, 0); \
        o[d0] = __builtin_amdgcn_mfma_f32_32x32x16_bf16(pa3, (bf16x8){l3[0], l3[1], l3[2], l3[3], h3[0], h3[1], h3[2], h3[3]}, o[d0], 0, 0, 0); } while (0)
    A2_PV_D0(0); A2_PV_D0(1); A2_PV_D0(2); A2_PV_D0(3);
#undef A2_PV_D0
#undef A2_TRRD
}
__device__ __forceinline__ float rowmax16(const f32x16& p) {
    float pm = p[0];
#pragma unroll
    for (int r = 1; r < 16; ++r) pm = fmaxf(pm, p[r]);
    auto rr = __builtin_amdgcn_permlane32_swap(__float_as_uint(pm), __float_as_uint(pm), false, false);
    return fmaxf(__uint_as_float(rr[0]), __uint_as_float(rr[1]));
}
__device__ __forceinline__ void block(const unsigned short* Q, const unsigned short* K, const unsigned short* V0, const unsigned short* V1, float* O0, float* O1, int P0, char* lds) {
    const int tid = opaque_tid(), wid = __builtin_amdgcn_readfirstlane(tid >> 6), lane = tid & 63, r32 = lane & 31, hi = lane >> 5, rg = wid & 3, kh = wid >> 2;
    const int NT = P0 / 64 + 2, qlo = P0 + 32 * rg;
    const int sr = tid >> 4, sc = (tid & 15) * 8, kws = A2_KSWZ(sr, sc * 2), vst0 = att::v_st(sr, sc), vst1 = att::v_st(32 + sr, sc);
    char* Vl = lds + V_OFF; char* Kl = lds + K_OFF;
    const int vb0 = (int)(uintptr_t)Vl + att::v_rd_base(lane) + kh * 16384, krow = 32 * kh + r32;
    float* wsl = (float*)(lds + WS_OFF) + wid * 64; float* al_l = wsl; float* li_l = wsl + 32;
    const float* li_p = (const float*)(lds + WS_OFF) + (wid ^ 4) * 64 + 32;
    float* mxw = (float*)(lds + MX_OFF) + wid * 64 + lane; const float* mxr = (const float*)(lds + MX_OFF) + (wid ^ 4) * 64 + lane;
    char* pxw = lds + PX_OFF + ((rg * 4 + 2 * kh) * 64 + lane) * 16; const char* pxr = lds + PX_OFF + (rg * 4 * 64 + lane) * 16;
    bf16x8 qr[8];
#pragma unroll
    for (int d0 = 0; d0 < 8; ++d0) qr[d0] = *reinterpret_cast<const bf16x8*>(Q + (size_t)(32 * rg + r32) * 128 + d0 * 16 + hi * 8);
    bf16x8 sk0, sk1, sv0, sv1, sv2, sv3;
#define A2_LOADT(t) do { const size_t o0_ = (size_t)((t) * 64 + sr) * 128 + sc, o1_ = o0_ + 32 * 128; \
        sk0 = *reinterpret_cast<const bf16x8*>(K + o0_); sk1 = *reinterpret_cast<const bf16x8*>(K + o1_); \
        sv0 = *reinterpret_cast<const bf16x8*>(V0 + o0_); sv1 = *reinterpret_cast<const bf16x8*>(V0 + o1_); sv2 = *reinterpret_cast<const bf16x8*>(V1 + o0_); sv3 = *reinterpret_cast<const bf16x8*>(V1 + o1_); } while (0)
#define A2_WRITEK(b) do { *(bf16x8*)(Kl + (b) * 16384 + kws) = sk0; *(bf16x8*)(Kl + (b) * 16384 + kws + 32 * 256) = sk1; } while (0)
#define A2_WRITEV(b) do { *(bf16x8*)(Vl + (b) * 32768 + vst0) = sv0; *(bf16x8*)(Vl + (b) * 32768 + vst1) = sv1; *(bf16x8*)(Vl + (b) * 32768 + 16384 + vst0) = sv2; *(bf16x8*)(Vl + (b) * 32768 + 16384 + vst1) = sv3; } while (0)
#define A2_VMW(n) asm volatile("s_waitcnt vmcnt(%0)" :: "i"(n) : "memory")
#define A2_MASKMAX(PX, pmX, t) do { const int kb_ = (t) * 64 + 32 * kh; \
        if (kb_ + 31 > qlo) { const int dq_ = qlo + r32 - kb_ - 4 * hi; const float NEG_ = -__builtin_inff(); \
            _Pragma("unroll") for (int r = 0; r < 16; ++r) { const int c_ = (r & 3) + 8 * (r >> 2); if (dq_ - c_ < 0) PX[r] = NEG_; } } \
        pmX = rowmax16(PX); mxw[((t) & 1) * 512] = pmX; } while (0)
#define A2_FINISH(PY, pmY, alY, u) do { const float pm_ = fmaxf(pmY, mxr[((u) & 1) * 512]); float mn_; \
        if (__builtin_expect(__all((pm_ - m_reg) * SCALE <= THR), 1)) { mn_ = m_reg; alY = 1.f; } \
        else { mn_ = fmaxf(m_reg, pm_); alY = __builtin_amdgcn_exp2f((m_reg - mn_) * C2); m_reg = mn_; } \
        const float mnL_ = -mn_ * C2; \
        _Pragma("unroll") for (int r = 0; r < 16; ++r) PY[r] = __builtin_amdgcn_exp2f(fmaf(PY[r], C2, mnL_)); \
        float ps_ = 0.f; _Pragma("unroll") for (int r = 0; r < 16; ++r) ps_ += PY[r]; \
        { auto rr_ = __builtin_amdgcn_permlane32_swap(__float_as_uint(ps_), __float_as_uint(ps_), false, false); ps_ = __uint_as_float(rr_[0]) + __uint_as_float(rr_[1]); } \
        l_reg = l_reg * alY + ps_; \
        A2_PK4(PY, 0, pxw); A2_PK4(PY, 8, pxw + 1024); } while (0)
#define A2_PK4(P, B_, DST) do { unsigned a0_ = att::cvtpk(P[B_ + 0], P[B_ + 1]), a1_ = att::cvtpk(P[B_ + 2], P[B_ + 3]), b0_ = att::cvtpk(P[B_ + 4], P[B_ + 5]), b1_ = att::cvtpk(P[B_ + 6], P[B_ + 7]); \
        auto r0_ = __builtin_amdgcn_permlane32_swap(a0_, b0_, false, false); auto r1_ = __builtin_amdgcn_permlane32_swap(a1_, b1_, false, false); \
        u32x4 w_ = {r0_[0], r1_[0], r0_[1], r1_[1]}; *(u32x4*)(DST) = w_; } while (0)
#define A2_PVSTEP(alY, VOFFB) do { const bf16x8 pa0_ = *reinterpret_cast<const bf16x8*>(pxr), pa1_ = *reinterpret_cast<const bf16x8*>(pxr + 1024), pa2_ = *reinterpret_cast<const bf16x8*>(pxr + 2048), pa3_ = *reinterpret_cast<const bf16x8*>(pxr + 3072); \
        if (__any((alY) < 1.f)) { if (hi == 0) al_l[r32] = (alY); asm volatile("s_waitcnt lgkmcnt(0)" ::: "memory"); \
            _Pragma("unroll") for (int d_ = 0; d_ < 4; ++d_) _Pragma("unroll") for (int r = 0; r < 16; ++r) o[d_][r] *= al_l[att::crow(r, hi)]; } \
        pv<VOFFB>(o, vb0, pa0_, pa1_, pa2_, pa3_); } while (0)
#define A2_STEP(PX, pmX, PY, pmY, alY, t, KB) do { \
        A2_VMW(0); A2_WRITEV(KB); if ((t) + 1 < NT) A2_LOADT((t) + 1); A2_SBAR(); \
        qkt<KB>(PX, Kl, krow, hi, qr); A2_SBAR(); \
        A2_FINISH(PY, pmY, alY, (t) - 1); A2_SBAR(); \
        A2_MASKMAX(PX, pmX, t); \
        asm volatile("s_waitcnt lgkmcnt(0)" ::: "memory"); __syncthreads(); \
        A2_PVSTEP(alY, (1 - KB) * 32768); \
        if ((t) + 1 < NT) { A2_VMW(4); A2_WRITEK(1 - KB); } \
        asm volatile("s_waitcnt lgkmcnt(0)" ::: "memory"); __syncthreads(); } while (0)
    float m_reg = -1e30f, l_reg = 0.f; f32x16 o[4] = {};
    f32x16 pA, pB; float pmA, pmB, alA = 1.f, alB = 1.f;
    A2_LOADT(0); A2_VMW(0); A2_WRITEK(0);
    asm volatile("s_waitcnt lgkmcnt(0)" ::: "memory"); __syncthreads();
    A2_WRITEV(0); A2_LOADT(1); A2_SBAR();
    qkt<0>(pA, Kl, krow, hi, qr); A2_SBAR();
    A2_MASKMAX(pA, pmA, 0);
    asm volatile("s_waitcnt lgkmcnt(0)" ::: "memory"); __syncthreads();
    A2_VMW(4); A2_WRITEK(1);
    asm volatile("s_waitcnt lgkmcnt(0)" ::: "memory"); __syncthreads();
    A2_STEP(pB, pmB, pA, pmA, alA, 1, 1);
    for (int t = 2; t < NT; t += 2) {
        A2_STEP(pA, pmA, pB, pmB, alB, t, 0);
        A2_STEP(pB, pmB, pA, pmA, alA, t + 1, 1);
    }
    A2_FINISH(pB, pmB, alB, NT - 1);
    asm volatile("s_waitcnt lgkmcnt(0)" ::: "memory"); __syncthreads();
    A2_PVSTEP(alB, 32768);
    if (hi == 0) li_l[r32] = l_reg;
    asm volatile("s_waitcnt lgkmcnt(0)" ::: "memory"); __syncthreads();
    float rli[16];
#pragma unroll
    for (int r = 0; r < 16; ++r) rli[r] = __builtin_amdgcn_rcpf(li_l[att::crow(r, hi)] + li_p[att::crow(r, hi)]);
    float* Ow = (kh ? O1 : O0) + (size_t)(32 * rg) * 128;
#pragma unroll
    for (int r = 0; r < 16; ++r) { const int orow = att::crow(r, hi);
#pragma unroll
        for (int d0 = 0; d0 < 4; ++d0) Ow[(size_t)orow * 128 + d0 * 32 + r32] = o[d0][r] * rli[r]; }
    asm volatile("s_waitcnt lgkmcnt(0)" ::: "memory"); __syncthreads();
#undef A2_LOADT
#undef A2_WRITEK
#undef A2_WRITEV
#undef A2_VMW
#undef A2_MASKMAX
#undef A2_FINISH
#undef A2_PK4
#undef A2_PVSTEP
#undef A2_STEP
}
#undef A2_KSWZ
#undef A2_SBAR
}

#ifndef MK_PER_PHASE
#define MK_PER_PHASE 0
#endif
constexpr int NWAVES = 8, NTHR = 512;
constexpr int SEQ = 16384, DM = 4096, FFH = 11008, DEPTH = 4, NMODV = 6 * DM;
#ifndef PADK
#define PADK 64
#endif
constexpr int LDD = DM + PADK, LDF = FFH + PADK;
constexpr int ZG = 96;
constexpr size_t GS = (size_t)SEQ * 128;
constexpr int S5T = 64, S5NC = SEQ / S5T;
constexpr int KSL = 16;
constexpr float NORM_EPS = 1e-6f, SUBLN_EPS = 1e-5f;
constexpr int N_PHASES = 35;

constexpr size_t MiB = 1u << 20;
constexpr size_t WS_CTL = 0, CTL_ZERO_BYTES = 64 * 1024;
constexpr size_t WS_MODP = 1 * MiB;
constexpr size_t WS_MODL = 3 * MiB;
constexpr size_t WS_LAM = 3 * MiB + 512 * 1024;
constexpr size_t WS_S5P = 4 * MiB, S5P_LAYER = 4 * MiB + 256 * 1024;
constexpr size_t S5P_ABR = 0, S5P_ABI = 64 * 1024, S5P_ATR = 128 * 1024, S5P_ATI = 192 * 1024, S5P_BBR = 256 * 1024, S5P_BBI = 256 * 1024 + MiB;
constexpr size_t S5P_BBOP = 256 * 1024 + 2 * MiB, S5P_COP = 256 * 1024 + 3 * MiB;
#ifndef S5_MFMA
#define S5_MFMA 1
#endif
constexpr size_t W_IN_B = (size_t)12288 * LDD * 2, W_OUT_B = (size_t)4096 * LDD * 2, W_GLU_B = (size_t)8192 * LDD * 2, W_GU_B = (size_t)22016 * LDD * 2, W_DN_B = (size_t)4096 * LDF * 2;
constexpr size_t WS_WIN = 16 * MiB, WS_WOUT = WS_WIN + 2 * W_IN_B, WS_WGLU = WS_WOUT + 2 * W_OUT_B, WS_WGU = WS_WGLU + 2 * W_GLU_B, WS_WDN = WS_WGU + 4 * W_GU_B;
constexpr size_t WS_H = WS_WDN + 4 * W_DN_B;
constexpr size_t WS_MIX = WS_H + (size_t)SEQ * LDD * 2;
constexpr size_t WS_Z = WS_MIX + (size_t)SEQ * LDD * 2;
constexpr size_t WS_OT = WS_Z + (size_t)ZG * GS * 2;
constexpr size_t WS_S5F = WS_OT + (size_t)32 * GS * 4;
constexpr size_t WS_S5H = WS_S5F + (size_t)S5NC * 256 * 128 * 4;
constexpr size_t WS_END = WS_S5H + (size_t)S5NC * 256 * 128 * 4;
static_assert((size_t)SEQ * LDF * 2 <= (size_t)ZG * GS * 2, "hidden overlays Z");
static_assert(WS_WIN % 256 == 0 && WS_H % 256 == 0 && WS_OT % 256 == 0 && WS_S5F % 256 == 0, "alignment");
constexpr int CW_BAR = 1024;

constexpr int RING_BYTES = 131072, MISC_OFF = RING_BYTES + 320, LDS_BYTES = 147456;

#define GAS __attribute__((address_space(1)))
#define LAS __attribute__((address_space(3)))
typedef unsigned short bf16;
typedef unsigned v4u __attribute__((ext_vector_type(4)));
typedef unsigned v2u __attribute__((ext_vector_type(2)));
typedef float f32x4 __attribute__((ext_vector_type(4)));
#define LDS_WAIT() asm volatile("s_waitcnt lgkmcnt(0)" ::: "memory")
#define VM_WAIT() asm volatile("s_waitcnt vmcnt(0)" ::: "memory")
__device__ __forceinline__ unsigned pk2(float lo, float hi) { unsigned r; asm volatile("v_cvt_pk_bf16_f32 %0, %1, %2" : "=v"(r) : "v"(lo), "v"(hi)); return r; }
__device__ __forceinline__ float bflo(unsigned w) { return __builtin_bit_cast(float, w << 16); }
__device__ __forceinline__ float bfhi(unsigned w) { return __builtin_bit_cast(float, w & 0xffff0000u); }

#define XB_TMO      128
#define XB_XCNT(j)  (256  + 64 * (j))
#define XB_XSUB(j)  (1280 + 64 * (j))
#define XB_XGEN(j)  (2304 + 64 * (j))
#define XB_TOP      3328
#define XB_TOPGEN   3392
#define XCD_BAR_WORDS 3456
#define XB_SPIN_CAP (1u << 22)

__device__ __forceinline__ unsigned xb_ld(unsigned* p)              { return __hip_atomic_load(p, __ATOMIC_RELAXED, __HIP_MEMORY_SCOPE_AGENT); }
__device__ __forceinline__ unsigned xb_add(unsigned* p, unsigned v) { return __hip_atomic_fetch_add(p, v, __ATOMIC_RELAXED, __HIP_MEMORY_SCOPE_AGENT); }
__device__ __forceinline__ unsigned xb_xcc_id() { return (unsigned)__builtin_amdgcn_s_getreg((3 << 11) | 20) & 0xFu; }
#define XB_SPIN(cond, bar) do { unsigned _sp = 0; while (cond) { __builtin_amdgcn_s_sleep(1); \
    if ((++_sp & 255u) == 0u) { if (xb_ld(&(bar)[XB_TMO])) break; if (_sp > XB_SPIN_CAP) { atomicAdd(&(bar)[XB_TMO], 1u); break; } } } } while (0)

struct XcdBarrier {
    unsigned* bar; unsigned x;
    volatile LAS unsigned* st;
};
__device__ __forceinline__ XcdBarrier xcd_barrier_post(unsigned* bar, volatile LAS unsigned* st) {
    XcdBarrier b; b.bar = bar; b.x = xb_xcc_id(); b.st = st;
    if (threadIdx.x == 0) (void)xb_add(&bar[XB_XCNT(b.x)], 1u);
    return b;
}
__device__ __forceinline__ void xcd_barrier_complete(unsigned* bar, unsigned x, unsigned& nloc, unsigned& nx) {
    const unsigned G = gridDim.x * gridDim.y * gridDim.z;
    unsigned sum, cnt, mine, sp = 0u;
    for (;;) {
        sum = 0u; cnt = 0u; mine = 0u;
#pragma unroll
        for (unsigned j = 0; j < 16; ++j) { const unsigned c = xb_ld(&bar[XB_XCNT(j)]); sum += c; cnt += (c > 0u) ? 1u : 0u; mine = (j == x) ? c : mine; }
        if (sum == G) break;
        __builtin_amdgcn_s_sleep(1);
        if ((++sp & 255u) == 0u) { if (xb_ld(&bar[XB_TMO])) break; if (sp > XB_SPIN_CAP) { atomicAdd(&bar[XB_TMO], 1u); break; } }
    }
    nloc = mine > 0u ? mine : 1u; nx = cnt > 0u ? cnt : 1u;
}
__device__ __forceinline__ void xcd_barrier(const XcdBarrier& b) {
    asm volatile("s_waitcnt vmcnt(0)" ::: "memory");
    __syncthreads();
    if (threadIdx.x == 0) {
        unsigned* bar = b.bar;
        __builtin_amdgcn_s_waitcnt(0);
        unsigned nloc = b.st[0], nx = b.st[1];
        if (nloc == 0u) { xcd_barrier_complete(bar, b.x, nloc, nx); b.st[0] = nloc; b.st[1] = nx; }
        const unsigned old = xb_add(&bar[XB_XSUB(b.x)], 1u);
        const unsigned gen = old / nloc;
        if (old + 1u == (gen + 1u) * nloc) {
            __builtin_amdgcn_fence(__ATOMIC_RELEASE, "agent");
            asm volatile("s_waitcnt vmcnt(0)" ::: "memory");
            const unsigned og = xb_add(&bar[XB_TOP], 1u);
            const unsigned tg = og / nx;
            if (og + 1u == (tg + 1u) * nx) xb_add(&bar[XB_TOPGEN], 1u);
            else XB_SPIN(xb_ld(&bar[XB_TOPGEN]) == tg, bar);
            __builtin_amdgcn_fence(__ATOMIC_ACQUIRE, "agent");
            xb_add(&bar[XB_XGEN(b.x)], 1u);
            asm volatile("s_waitcnt vmcnt(0)" ::: "memory");
        } else {
            XB_SPIN(xb_ld(&bar[XB_XGEN(b.x)]) == gen, bar);
            __builtin_amdgcn_fence(__ATOMIC_ACQUIRE, "agent");
            asm volatile("s_waitcnt vmcnt(0)" ::: "memory");
        }
    }
    __syncthreads();
}

__device__ __forceinline__ float wave_sum(float v) {
#pragma unroll
    for (int o = 1; o < 64; o <<= 1) v += __shfl_xor(v, o);
    return v;
}

__device__ __forceinline__ void transpose_item(const float* W, int K, int N, bf16* WT, int ldw, int mode, LAS float* scr, int item, int lane) {
    const int nblk = N / 32, kb = item / nblk, nb = item - kb * nblk, k0 = 64 * kb, n0 = 32 * nb;
    const int drow0 = mode == 0 ? n0 : ((n0 >> 7) * 256 + (n0 & 127) + (mode == 2 ? 128 : 0));
#pragma unroll 8
    for (int i = 0; i < 32; ++i) { const int kk = 2 * i + (lane >> 5); scr[kk * 33 + (lane & 31)] = W[(size_t)(k0 + kk) * N + n0 + (lane & 31)]; }
    LDS_WAIT(); asm volatile("" ::: "memory");
    const int c = lane & 7;
#pragma unroll
    for (int j = 0; j < 4; ++j) { const int n = (lane >> 3) + 8 * j; const LAS float* s = scr + (8 * c) * 33 + n;
        v4u o; o.x = pk2(s[0 * 33], s[1 * 33]); o.y = pk2(s[2 * 33], s[3 * 33]); o.z = pk2(s[4 * 33], s[5 * 33]); o.w = pk2(s[6 * 33], s[7 * 33]);
        *(v4u*)(WT + (size_t)(drow0 + n) * ldw + k0 + 8 * c) = o; }
    LDS_WAIT(); asm volatile("" ::: "memory");
}
__device__ __forceinline__ void dsincos(double x, double& s, double& c) {
    const double k = rint(x * 0.63661977236758134308);
    double r = fma(-k, 1.5707963267948966192, x); r = fma(-k, 6.1232339957367658860e-17, r);
    const double r2 = r * r;
    double ps = -1.0 / 1307674368000.0; ps = fma(ps, r2, 1.0 / 6227020800.0); ps = fma(ps, r2, -1.0 / 39916800.0); ps = fma(ps, r2, 1.0 / 362880.0); ps = fma(ps, r2, -1.0 / 5040.0);
    ps = fma(ps, r2, 1.0 / 120.0); ps = fma(ps, r2, -1.0 / 6.0); ps = fma(ps, r2, 1.0); const double sn = r * ps;
    double pc = 1.0 / 20922789888000.0; pc = fma(pc, r2, -1.0 / 87178291200.0); pc = fma(pc, r2, 1.0 / 479001600.0); pc = fma(pc, r2, -1.0 / 3628800.0); pc = fma(pc, r2, 1.0 / 40320.0);
    pc = fma(pc, r2, -1.0 / 720.0); pc = fma(pc, r2, 1.0 / 24.0); pc = fma(pc, r2, -0.5); const double cs = fma(pc, r2, 1.0);
    const int q = (int)k & 3;
    s = (q == 0) ? sn : (q == 1) ? cs : (q == 2) ? -sn : -cs;
    c = (q == 0) ? cs : (q == 1) ? -sn : (q == 2) ? -cs : sn;
}
__device__ __forceinline__ double dexp(double x) {
    const double k = rint(x * 1.4426950408889634074);
    double r = fma(-k, 0.69314718055994528623, x); r = fma(-k, 2.3190468138462995584e-17, r);
    double p = 1.0 / 87178291200.0; p = fma(p, r, 1.0 / 6227020800.0); p = fma(p, r, 1.0 / 479001600.0); p = fma(p, r, 1.0 / 39916800.0); p = fma(p, r, 1.0 / 3628800.0); p = fma(p, r, 1.0 / 362880.0);
    p = fma(p, r, 1.0 / 40320.0); p = fma(p, r, 1.0 / 5040.0); p = fma(p, r, 1.0 / 720.0); p = fma(p, r, 1.0 / 120.0); p = fma(p, r, 1.0 / 24.0); p = fma(p, r, 1.0 / 6.0); p = fma(p, r, 0.5); p = fma(p, r, 1.0); p = fma(p, r, 1.0);
    const long long bits = (long long)(1023 + (int)k) << 52;
    return p * __builtin_bit_cast(double, bits);
}

struct Args { const float* in[29]; float* out; unsigned char* ws; int ph_lo, ph_hi; };

__device__ __forceinline__ void p0_prologue(const Args& A, LAS unsigned char* lds, int gw, int NGW, int wave, int lane) {
    unsigned char* ws = A.ws;
    for (int w = gw; w < 96 * KSL + 512 + 2048; w += NGW) {
    if (w >= 96 * KSL + 512) {
        const int idx = (w - 96 * KSL - 512) * 64 + lane, o = idx >> 16, r = idx & 65535, g = r >> 8, mm = (r >> 6) & 3, o16 = lane & 15, kq = lane >> 4;
        const int tau = 2 * mm, p0 = 16 * (tau & 3) + 4 * kq;
        const float* cs = (tau < 4 ? A.in[21] : A.in[22]) + (size_t)o * 256 * 16 * 64 + (size_t)(g * 16 + o16) * 64 + p0; const float sg = tau < 4 ? 1.0f : -1.0f;
        const f32x4 a = *(const f32x4*)cs * sg, b = *(const f32x4*)(cs + 16) * sg;
        v4u q; q.x = pk2(a.x, a.y); q.y = pk2(a.z, a.w); q.z = pk2(b.x, b.y); q.w = pk2(b.z, b.w);
        *(v4u*)(ws + WS_S5P + (size_t)o * S5P_LAYER + S5P_COP + ((size_t)((g * 4 + mm) * 64 + lane)) * 16) = q;
    } else if (w < 96 * KSL) {
        const int nb = w % 96, ks = w / 96;
        const float* wp = A.in[2] + (size_t)(ks * 256) * NMODV + nb * 256 + lane * 4; const float* cp = A.in[1] + ks * 256;
        f32x4 a = {0.f, 0.f, 0.f, 0.f};
#pragma unroll 8
        for (int k = 0; k < 256; ++k) { const float cv = cp[k]; const float s = cv / (1.0f + expf(-cv)); const f32x4 w = *(const f32x4*)(wp + (size_t)k * NMODV); a += s * w; }
        *(f32x4*)((float*)(ws + WS_MODP) + (size_t)ks * NMODV + nb * 256 + lane * 4) = a;
    } else {
        const int idx = (w - 96 * KSL) * 64 + lane, o = idx >> 14, gp = idx & 16383, g = gp >> 6;
        const double lr = (double)fminf(A.in[16][idx], -1e-4f), li = (double)A.in[17][idx], dt = dexp((double)A.in[18][o * 256 + g]);
        const double mag = dexp(lr * dt); double sn, cs; dsincos(li * dt, sn, cs);
        const double abr = mag * cs, abi = mag * sn, den = lr * lr + li * li, nr = abr - 1.0, ni = abi;
        const double fre = (nr * lr + ni * li) / den, fim = (ni * lr - nr * li) / den;
        double tr = abr, ti = abi;
#pragma unroll
        for (int q = 0; q < 6; ++q) { const double t2 = tr * tr - ti * ti; ti = 2.0 * tr * ti; tr = t2; }
        unsigned char* pb = ws + WS_S5P + (size_t)o * S5P_LAYER;
        ((float*)(pb + S5P_ABR))[gp] = (float)abr; ((float*)(pb + S5P_ABI))[gp] = (float)abi; ((float*)(pb + S5P_ATR))[gp] = (float)tr; ((float*)(pb + S5P_ATI))[gp] = (float)ti;
        const float* bre = A.in[19] + (size_t)idx * 16; const float* bim = A.in[20] + (size_t)idx * 16;
        float* obr = (float*)(pb + S5P_BBR) + (size_t)gp * 16; float* obi = (float*)(pb + S5P_BBI) + (size_t)gp * 16;
#pragma unroll
        for (int h4 = 0; h4 < 4; ++h4) { const f32x4 br = *(const f32x4*)(bre + 4 * h4), bi = *(const f32x4*)(bim + 4 * h4); f32x4 r, i;
#pragma unroll
            for (int j = 0; j < 4; ++j) { r[j] = (float)(fre * (double)br[j] - fim * (double)bi[j]); i[j] = (float)(fre * (double)bi[j] + fim * (double)br[j]); }
            *(f32x4*)(obr + 4 * h4) = r; *(f32x4*)(obi + 4 * h4) = i; }
        { const int p = gp & 63, ti = p >> 4, i16 = p & 15;
#pragma unroll
          for (int kq = 0; kq < 4; ++kq) { const f32x4 r = *(const f32x4*)(obr + 4 * kq), i = *(const f32x4*)(obi + 4 * kq);
              v2u pr, pi; pr.x = pk2(r.x, r.y); pr.y = pk2(r.z, r.w); pi.x = pk2(i.x, i.y); pi.y = pk2(i.z, i.w);
              *(v2u*)(pb + S5P_BBOP + ((size_t)((g * 8 + ti) * 64 + kq * 16 + i16)) * 8) = pr; *(v2u*)(pb + S5P_BBOP + ((size_t)((g * 8 + 4 + ti) * 64 + kq * 16 + i16)) * 8) = pi; } }
    }
    }
    if (gw < 2) { const int e = gw;
        const float s1 = wave_sum(A.in[10][e * 128 + lane] * A.in[11][e * 128 + lane] + A.in[10][e * 128 + 64 + lane] * A.in[11][e * 128 + 64 + lane]);
        const float s2 = wave_sum(A.in[12][e * 128 + lane] * A.in[13][e * 128 + lane] + A.in[12][e * 128 + 64 + lane] * A.in[13][e * 128 + 64 + lane]);
        const float lam_init = e == 0 ? 0.2f : 0.4707130183435842f;
        if (lane == 0) ((float*)(ws + WS_LAM))[e] = expf(s1) - expf(s2) + lam_init; }
    LAS float* scr = (LAS float*)(lds + wave * 16384);
    constexpr int I_IN = 64 * 384, I_OUT = 64 * 128, I_GLU = 64 * 128, I_GU = 64 * 344, I_DN = 172 * 128;
    constexpr int NITEMS = 2 * I_IN + 2 * I_OUT + 4 * I_GLU + 8 * I_GU + 4 * I_DN;
    for (int it = gw; it < NITEMS; it += NGW) {
        int r = it;
        if (r < 2 * I_IN) { const int e = r / I_IN; transpose_item(A.in[8] + (size_t)e * DM * 12288, DM, 12288, (bf16*)(ws + WS_WIN + e * W_IN_B), LDD, 0, scr, r - e * I_IN, lane); continue; } r -= 2 * I_IN;
        if (r < 2 * I_OUT) { const int e = r / I_OUT; transpose_item(A.in[15] + (size_t)e * DM * DM, DM, DM, (bf16*)(ws + WS_WOUT + e * W_OUT_B), LDD, 0, scr, r - e * I_OUT, lane); continue; } r -= 2 * I_OUT;
        if (r < 4 * I_GLU) { const int q = r / I_GLU, o = q >> 1, s = q & 1; transpose_item(A.in[24 + s] + (size_t)o * DM * DM, DM, DM, (bf16*)(ws + WS_WGLU + o * W_GLU_B), LDD, 1 + s, scr, r - q * I_GLU, lane); continue; } r -= 4 * I_GLU;
        if (r < 8 * I_GU) { const int q = r / I_GU, l = q >> 1, s = q & 1; transpose_item(A.in[26 + s] + (size_t)l * DM * FFH, DM, FFH, (bf16*)(ws + WS_WGU + l * W_GU_B), LDD, 1 + s, scr, r - q * I_GU, lane); continue; } r -= 8 * I_GU;
        { const int l = r / I_DN; transpose_item(A.in[28] + (size_t)l * FFH * DM, FFH, DM, (bf16*)(ws + WS_WDN + l * W_DN_B), LDF, 0, scr, r - l * I_DN, lane); }
    }
}
__device__ __forceinline__ void p1_modvec(const Args& A, int gtid, int NGT) {
    const float* mp = (const float*)(A.ws + WS_MODP); float* ml = (float*)(A.ws + WS_MODL);
    for (int i = gtid; i < DEPTH * NMODV; i += NGT) { const int j = i % NMODV; float v = A.in[3][j] + A.in[4][i];
#pragma unroll
        for (int ks = 0; ks < KSL; ++ks) v += mp[(size_t)ks * NMODV + j];
        ml[i] = v; }
}
__device__ __forceinline__ void norm_mod_phase(const float* src, const float* nw, const float* sh, const float* sc, bf16* dst, LAS unsigned char* lds, int tid, int gw, int NGW, int lane) {
    LAS float* w1 = (LAS float*)lds; LAS float* bb = w1 + DM;
    for (int i = tid; i < DM; i += NTHR) { w1[i] = nw[i] * (1.0f + sc[i]); bb[i] = sh[i]; }
    __syncthreads();
    for (int m = gw; m < SEQ; m += NGW) {
        const f32x4* xr = (const f32x4*)(src + (size_t)m * DM) + lane;
        f32x4 v[16]; float ss = 0.f;
#pragma unroll
        for (int j = 0; j < 16; ++j) { v[j] = xr[64 * j]; ss += (v[j].x * v[j].x + v[j].y * v[j].y) + (v[j].z * v[j].z + v[j].w * v[j].w); }
        const float rstd = 1.0f / sqrtf(wave_sum(ss) * (1.0f / DM) + NORM_EPS);
        v2u* o8 = (v2u*)(dst + (size_t)m * LDD) + lane;
#pragma unroll
        for (int j = 0; j < 16; ++j) { const int col = j * 256 + lane * 4; const f32x4 w = *(const LAS f32x4*)(w1 + col), b = *(const LAS f32x4*)(bb + col);
            const f32x4 y = v[j] * rstd * w + b; v2u p; p.x = pk2(y.x, y.y); p.y = pk2(y.z, y.w); o8[64 * j] = p; }
    }
    __syncthreads();
}
__device__ __forceinline__ void final_norm_phase(const float* src, const float* nw, float* dst, int gw, int NGW, int lane) {
    for (int m = gw; m < SEQ; m += NGW) {
        const f32x4* xr = (const f32x4*)(src + (size_t)m * DM) + lane;
        f32x4 v[16]; float ss = 0.f;
#pragma unroll
        for (int j = 0; j < 16; ++j) { v[j] = xr[64 * j]; ss += (v[j].x * v[j].x + v[j].y * v[j].y) + (v[j].z * v[j].z + v[j].w * v[j].w); }
        const float rstd = 1.0f / sqrtf(wave_sum(ss) * (1.0f / DM) + NORM_EPS);
        f32x4* o = (f32x4*)(dst + (size_t)m * DM) + lane; const f32x4* wv = (const f32x4*)nw + lane;
#pragma unroll
        for (int j = 0; j < 16; ++j) o[64 * j] = v[j] * rstd * wv[64 * j];
    }
}
__device__ __forceinline__ void conv_phase(const bf16* Z, const float* cw, bf16* MIX, int gtid, int NGT) {
    for (int i = gtid; i < SEQ * 256; i += NGT) {
        const int t = i >> 8, r = i & 255, gi = r >> 4, c8 = (r & 15) * 8;
        const size_t o = (size_t)t * 128 + c8;
        const v4u zero = {0u, 0u, 0u, 0u};
        const v4u vb = *(const v4u*)(Z + (size_t)gi * GS + o);
        const bf16* zc = Z + (size_t)(16 + gi) * GS + o; const bf16* zx = Z + (size_t)(32 + gi) * GS + o;
        const v4u c0 = *(const v4u*)zc, x0 = *(const v4u*)zx;
        const v4u c1 = t >= 1 ? *(const v4u*)(zc - 128) : zero, x1 = t >= 1 ? *(const v4u*)(zx - 128) : zero;
        const v4u c2 = t >= 2 ? *(const v4u*)(zc - 256) : zero, x2 = t >= 2 ? *(const v4u*)(zx - 256) : zero;
        const float* wp = cw + gi * 128 + c8;
        float y[8];
#pragma unroll
        for (int q = 0; q < 4; ++q) {
            const float u0l = bflo(c0[q]) * bflo(x0[q]), u0h = bfhi(c0[q]) * bfhi(x0[q]);
            const float u1l = bflo(c1[q]) * bflo(x1[q]), u1h = bfhi(c1[q]) * bfhi(x1[q]);
            const float u2l = bflo(c2[q]) * bflo(x2[q]), u2h = bfhi(c2[q]) * bfhi(x2[q]);
            const int j = 2 * q;
            y[j]     = bflo(vb[q]) * (wp[2 * 2048 + j] * u0l + wp[2048 + j] * u1l + wp[j] * u2l);
            y[j + 1] = bfhi(vb[q]) * (wp[2 * 2048 + j + 1] * u0h + wp[2048 + j + 1] * u1h + wp[j + 1] * u2h);
        }
        v4u w; w.x = pk2(y[0], y[1]); w.y = pk2(y[2], y[3]); w.z = pk2(y[4], y[5]); w.w = pk2(y[6], y[7]);
        *(v4u*)(MIX + (size_t)t * LDD + gi * 128 + c8) = w;
    }
}
__device__ __forceinline__ void combine_phase(const float* OT, const float* lamp, const float* sg, float lam_init, bf16* MIX, int gw, int NGW, int lane) {
    const float lam = lamp[0], os = 1.0f - lam_init;
    const int j = lane >> 5, c4 = (lane & 31) * 4;
    const f32x4 gv = *(const f32x4*)(sg + 128 * j + c4);
    for (int it = gw; it < SEQ * 8; it += NGW) {
        const int t = it >> 3, h = it & 7;
        const f32x4 a = *(const f32x4*)(OT + (size_t)(h * 4 + j) * GS + (size_t)t * 128 + c4), b = *(const f32x4*)(OT + (size_t)(h * 4 + 2 + j) * GS + (size_t)t * 128 + c4);
        const f32x4 o = a - lam * b;
        const float rstd = 1.0f / sqrtf(wave_sum((o.x * o.x + o.y * o.y) + (o.z * o.z + o.w * o.w)) * (1.0f / 256.0f) + SUBLN_EPS);
        const f32x4 y = o * (rstd * os) * gv;
        v2u p; p.x = pk2(y.x, y.y); p.y = pk2(y.z, y.w);
        *(v2u*)(MIX + (size_t)t * LDD + 2048 + 256 * h + 128 * j + c4) = p;
    }
}
__device__ __forceinline__ att::BlockRef<att::bf16, float> att_ref(const bf16* Z, float* OT, int item, int pass) {
    const int r = item >> 8, b = item & 255, vh = r * 8 + (b & 7), pair = b >> 3, qb = pass ? 63 - pair : pair;
    const int h = vh >> 2, m = (vh >> 1) & 1, j = vh & 1;
    att::BlockRef<att::bf16, float> R;
    R.Q = (const att::bf16*)(Z + (size_t)(48 + 2 * h + m) * GS + (size_t)qb * 256 * 128);
    R.K = (const att::bf16*)(Z + (size_t)(64 + 2 * h + m) * GS);
    R.V = (const att::bf16*)(Z + (size_t)(80 + 2 * h + j) * GS);
    R.O = OT + (size_t)vh * GS + (size_t)qb * 256 * 128; R.P0 = qb * 256;
    return R;
}
__device__ __forceinline__ void attn_phase(const bf16* Z, float* OT, char* lds, int bid, int G) {
    constexpr int TOTAL = 1024;
    int item = bid; if (item >= TOTAL) return;
    int pass = 0;
    att::BlockRef<att::bf16, float> cur = att_ref(Z, OT, item, 0);
    att::Seam<att::bf16> S;
    att::causal_swa_prime<att::bf16, float>(cur, SEQ, lds, S);
    for (;;) {
        const bool more_pass = pass == 0, more_item = item + G < TOTAL, last = !more_pass && !more_item;
        int itn = item, passn = 1;
        if (!more_pass) { passn = 0; itn = more_item ? item + G : item; }
        const att::BlockRef<att::bf16, float> nxt = last ? cur : att_ref(Z, OT, itn, passn);
        att::causal_swa_block<att::bf16, float>(cur, nxt, SEQ, SEQ, lds, S);
        if (last) break;
        cur = nxt; item = itn; pass = passn;
    }
}
#ifndef ATT2
#define ATT2 1
#endif
__device__ __forceinline__ void attn2_phase(const bf16* Z, float* OT, char* lds, int bid, int G) {
    for (int item = bid; item < 1024; item += G) {
        const int r = item >> 8, b = item & 255, hm = 2 * (b & 7) + (r >> 1), pair = (r & 1) * 32 + (b >> 3), h = hm >> 1, m = hm & 1;
        for (int pass = 0; pass < 2; ++pass) { const int qb = pass ? 127 - pair : pair;
            att2::block(Z + (size_t)(48 + 2 * h + m) * GS + (size_t)qb * 128 * 128, Z + (size_t)(64 + 2 * h + m) * GS, Z + (size_t)(80 + 2 * h) * GS, Z + (size_t)(81 + 2 * h) * GS,
                        OT + (size_t)(h * 4 + m * 2) * GS + (size_t)qb * 128 * 128, OT + (size_t)(h * 4 + m * 2 + 1) * GS + (size_t)qb * 128 * 128, qb * 128, lds); }
    }
}
__device__ __forceinline__ float gelu_tanh(float x) { const float z = 1.5957691216057308f * (x + 0.044715f * x * x * x); return x * __builtin_amdgcn_rcpf(1.0f + __builtin_amdgcn_exp2f(-1.4426950408889634f * z)); }
template <bool PASS2>
__device__ __forceinline__ void s5_pass(const bf16* Hin, const unsigned char* prm, const float* c_re, const float* c_im, const float* dsk, float* F, const float* HC, bf16* Gout,
                                        LAS unsigned char* lds, int gw, int NGW, int wave, int lane) {
    LAS float* lu = (LAS float*)(lds + wave * 4096);
    for (int item = gw; item < 256 * S5NC; item += NGW) {
        const int g = item & 255, c = item >> 8, gp = g * 64 + lane;
        { const bf16* up = Hin + (size_t)(c * S5T + lane) * LDD + 16 * g; const v4u a = *(const v4u*)up, b = *(const v4u*)(up + 8);
          LAS f32x4* ur = (LAS f32x4*)(lu + lane * 16);
          ur[0] = (f32x4){bflo(a.x), bfhi(a.x), bflo(a.y), bfhi(a.y)}; ur[1] = (f32x4){bflo(a.z), bfhi(a.z), bflo(a.w), bfhi(a.w)};
          ur[2] = (f32x4){bflo(b.x), bfhi(b.x), bflo(b.y), bfhi(b.y)}; ur[3] = (f32x4){bflo(b.z), bfhi(b.z), bflo(b.w), bfhi(b.w)}; }
        f32x4 bbr[4], bbi[4];
#pragma unroll
        for (int q = 0; q < 4; ++q) { bbr[q] = *(const f32x4*)((const float*)(prm + S5P_BBR) + (size_t)gp * 16 + 4 * q); bbi[q] = *(const f32x4*)((const float*)(prm + S5P_BBI) + (size_t)gp * 16 + 4 * q); }
        const float abr = ((const float*)(prm + S5P_ABR))[gp], abi = ((const float*)(prm + S5P_ABI))[gp];
        float hr = 0.f, hi = 0.f, cr[16], ci[16], dk = 0.f;
        if (PASS2) {
#pragma unroll
            for (int o = 0; o < 16; ++o) { cr[o] = c_re[(size_t)(g * 16 + o) * 64 + lane]; ci[o] = c_im[(size_t)(g * 16 + o) * 64 + lane]; }
            hr = HC[(size_t)(c * 256 + g) * 128 + lane]; hi = HC[(size_t)(c * 256 + g) * 128 + 64 + lane]; dk = dsk[16 * g + (lane >> 2)];
        }
        LDS_WAIT(); asm volatile("" ::: "memory");
#pragma unroll 2
        for (int t = 0; t < S5T; ++t) {
            const LAS f32x4* ut = (const LAS f32x4*)(lu + t * 16);
            float bur = 0.f, bui = 0.f;
#pragma unroll
            for (int q = 0; q < 4; ++q) { const f32x4 u = ut[q];
                bur += (bbr[q].x * u.x + bbr[q].y * u.y) + (bbr[q].z * u.z + bbr[q].w * u.w); bui += (bbi[q].x * u.x + bbi[q].y * u.y) + (bbi[q].z * u.z + bbi[q].w * u.w); }
            const float nr = abr * hr - abi * hi + bur, ni = abr * hi + abi * hr + bui; hr = nr; hi = ni;
            if (PASS2) {
                float v[16];
#pragma unroll
                for (int o = 0; o < 16; ++o) v[o] = hr * cr[o] - hi * ci[o];
#pragma unroll
                for (int i = 0; i < 8; ++i) { const float send = (lane & 32) ? v[i] : v[i + 8], keep = (lane & 32) ? v[i + 8] : v[i]; v[i] = keep + __shfl_xor(send, 32); }
#pragma unroll
                for (int i = 0; i < 4; ++i) { const float send = (lane & 16) ? v[i] : v[i + 4], keep = (lane & 16) ? v[i + 4] : v[i]; v[i] = keep + __shfl_xor(send, 16); }
#pragma unroll
                for (int i = 0; i < 2; ++i) { const float send = (lane & 8) ? v[i] : v[i + 2], keep = (lane & 8) ? v[i + 2] : v[i]; v[i] = keep + __shfl_xor(send, 8); }
                { const float send = (lane & 4) ? v[0] : v[1], keep = (lane & 4) ? v[1] : v[0]; v[0] = keep + __shfl_xor(send, 4); }
                v[0] += __shfl_xor(v[0], 2); v[0] += __shfl_xor(v[0], 1);
                const float yy = v[0] + dk * lu[t * 16 + (lane >> 2)];
                const float gl = gelu_tanh(yy);
                if ((lane & 3) == 0) Gout[(size_t)(c * S5T + t) * LDD + 16 * g + (lane >> 2)] = (bf16)(pk2(gl, gl) & 0xffffu);
            }
        }
        if (!PASS2) { F[(size_t)(c * 256 + g) * 128 + lane] = hr; F[(size_t)(c * 256 + g) * 128 + 64 + lane] = hi; }
        LDS_WAIT(); asm volatile("" ::: "memory");
    }
}

constexpr int S5TS = 8, S5SB = S5TS * 256 + 16;
typedef short s5_bf16x8 __attribute__((ext_vector_type(8)));
template <bool PASS2>
__device__ __forceinline__ void s5m_pass(const bf16* Hin, const unsigned char* prm, const float* dsk, float* F, const float* HC, bf16* Gout, LAS unsigned char* lds, int bid, int G) {
    const int tid = opaque_tid(), lane = tid & 63, w = __builtin_amdgcn_readfirstlane(tid >> 6), j = lane & 15, rq = lane >> 4;
    const int rowslot = tid >> 4, piece = tid & 15;
    constexpr int NST = S5T / S5TS, NQ = 16 * S5TS / 32;
    for (int unit = bid; unit < 32 * (S5NC / 16); unit += G) {
        const int gb = unit & 31, cs = unit >> 5, g = gb * 8 + w;
        v2u bb[8];
#pragma unroll
        for (int t8 = 0; t8 < 8; ++t8) bb[t8] = *(const v2u*)(prm + S5P_BBOP + ((size_t)((g * 8 + t8) * 64 + lane)) * 8);
        v4u cop[4];
        f32x4 ar[4], ai[4], sr[4], si[4], dk = {0.f, 0.f, 0.f, 0.f};
#pragma unroll
        for (int q = 0; q < 4; ++q) { ar[q] = *(const f32x4*)((const float*)(prm + S5P_ABR) + g * 64 + 16 * q + 4 * rq); ai[q] = *(const f32x4*)((const float*)(prm + S5P_ABI) + g * 64 + 16 * q + 4 * rq); }
        if (PASS2) {
#pragma unroll
            for (int mm = 0; mm < 4; ++mm) cop[mm] = *(const v4u*)(prm + S5P_COP + ((size_t)((g * 4 + mm) * 64 + lane)) * 16);
            const float* hc = HC + ((size_t)(cs * 16 + j) * 256 + g) * 128 + 4 * rq;
#pragma unroll
            for (int q = 0; q < 4; ++q) { sr[q] = *(const f32x4*)(hc + 16 * q); si[q] = *(const f32x4*)(hc + 64 + 16 * q); }
            dk = *(const f32x4*)(dsk + 16 * g + 4 * rq);
        } else {
#pragma unroll
            for (int q = 0; q < 4; ++q) { sr[q] = (f32x4){0.f, 0.f, 0.f, 0.f}; si[q] = (f32x4){0.f, 0.f, 0.f, 0.f}; }
        }
        const bf16* src = Hin + (size_t)(cs * 16 * S5T) * LDD + gb * 128 + piece * 8;
        bf16* dstp = PASS2 ? Gout + (size_t)(cs * 16 * S5T) * LDD + gb * 128 + piece * 8 : nullptr;
        v4u pre[NQ];
#pragma unroll
        for (int q = 0; q < NQ; ++q) { const int ri = q * 32 + rowslot, jj = ri / S5TS, tt = ri % S5TS; pre[q] = *(const v4u*)(src + (size_t)(jj * S5T + tt) * LDD); }
        for (int s = 0; s < NST; ++s) {
#pragma unroll
            for (int q = 0; q < NQ; ++q) { const int ri = q * 32 + rowslot, jj = ri / S5TS, tt = ri % S5TS; LAS v4u* lp = (LAS v4u*)(lds + jj * S5SB + tt * 256 + piece * 16);
                if (PASS2 && s > 0) { const v4u y = *lp; *(v4u*)(dstp + (size_t)(jj * S5T + (s - 1) * S5TS + tt) * LDD) = y; }
                *lp = pre[q]; }
            if (s + 1 < NST) {
#pragma unroll
                for (int q = 0; q < NQ; ++q) { const int ri = q * 32 + rowslot, jj = ri / S5TS, tt = ri % S5TS; pre[q] = *(const v4u*)(src + (size_t)(jj * S5T + (s + 1) * S5TS + tt) * LDD); } }
            LDS_WAIT(); __syncthreads();
            LAS unsigned char* up = lds + j * S5SB + w * 32 + rq * 8;
            v2u uu[S5TS];
#pragma unroll
            for (int tt = 0; tt < S5TS; ++tt) uu[tt] = *(const LAS v2u*)(up + tt * 256);
#pragma unroll
            for (int tt = 0; tt < S5TS; ++tt) {
                v4u ub; ub.x = uu[tt].x; ub.y = uu[tt].y; ub.z = 0u; ub.w = 0u;
                const s5_bf16x8 U = __builtin_bit_cast(s5_bf16x8, ub);
#pragma unroll
                for (int q = 0; q < 4; ++q) {
                    const f32x4 tr = ar[q] * sr[q] - ai[q] * si[q], ti = ar[q] * si[q] + ai[q] * sr[q];
                    v4u a0; a0.x = bb[q].x; a0.y = bb[q].y; a0.z = 0u; a0.w = 0u; v4u a1; a1.x = bb[4 + q].x; a1.y = bb[4 + q].y; a1.z = 0u; a1.w = 0u;
                    sr[q] = __builtin_amdgcn_mfma_f32_16x16x32_bf16(__builtin_bit_cast(s5_bf16x8, a0), U, tr, 0, 0, 0);
                    si[q] = __builtin_amdgcn_mfma_f32_16x16x32_bf16(__builtin_bit_cast(s5_bf16x8, a1), U, ti, 0, 0, 0);
                }
                if (PASS2) {
                    f32x4 y = {0.f, 0.f, 0.f, 0.f};
#pragma unroll
                    for (int mm = 0; mm < 4; ++mm) { const f32x4 t0 = mm < 2 ? sr[2 * mm] : si[2 * mm - 4], t1 = mm < 2 ? sr[2 * mm + 1] : si[2 * mm - 3];
                        v4u sb; sb.x = pk2(t0.x, t0.y); sb.y = pk2(t0.z, t0.w); sb.z = pk2(t1.x, t1.y); sb.w = pk2(t1.z, t1.w);
                        y = __builtin_amdgcn_mfma_f32_16x16x32_bf16(__builtin_bit_cast(s5_bf16x8, cop[mm]), __builtin_bit_cast(s5_bf16x8, sb), y, 0, 0, 0); }
                    const f32x4 uf = {bflo(uu[tt].x), bfhi(uu[tt].x), bflo(uu[tt].y), bfhi(uu[tt].y)};
                    const f32x4 yy = y + dk * uf;
                    v2u o; o.x = pk2(gelu_tanh(yy.x), gelu_tanh(yy.y)); o.y = pk2(gelu_tanh(yy.z), gelu_tanh(yy.w));
                    *(LAS v2u*)(up + tt * 256) = o;
                }
            }
            LDS_WAIT(); __syncthreads();
        }
        if (PASS2) {
#pragma unroll
            for (int q = 0; q < NQ; ++q) { const int ri = q * 32 + rowslot, jj = ri / S5TS, tt = ri % S5TS; const v4u y = *(const LAS v4u*)(lds + jj * S5SB + tt * 256 + piece * 16);
                *(v4u*)(dstp + (size_t)(jj * S5T + (NST - 1) * S5TS + tt) * LDD) = y; }
            LDS_WAIT();
        } else {
            float* fo = F + ((size_t)(cs * 16 + j) * 256 + g) * 128 + 4 * rq;
#pragma unroll
            for (int q = 0; q < 4; ++q) { *(f32x4*)(fo + 16 * q) = sr[q]; *(f32x4*)(fo + 64 + 16 * q) = si[q]; }
        }
    }
}
__device__ __forceinline__ void s5_carry(const unsigned char* prm, const float* F, float* HC, int gtid) {
    if (gtid < 256 * 64) {
        const int g = gtid >> 6, p = gtid & 63;
        const float atr = ((const float*)(prm + S5P_ATR))[gtid], ati = ((const float*)(prm + S5P_ATI))[gtid];
        float hr = 0.f, hi = 0.f;
#pragma unroll 8
        for (int c = 0; c < S5NC; ++c) { const size_t o = (size_t)(c * 256 + g) * 128 + p;
            HC[o] = hr; HC[o + 64] = hi; const float fr = F[o], fi = F[o + 64];
            const float nr = atr * hr - ati * hi + fr, ni = atr * hi + ati * hr + fi; hr = nr; hi = ni; }
    }
}

struct Ctx { int lo, hi, tid, lane, wave, gw, NGW, gtid, NGT, G, bid; };
#ifndef DUP_ATTN
#define DUP_ATTN 0
#endif
#ifndef DUP_S5
#define DUP_S5 0
#endif
#ifndef DUP_FFN1
#define DUP_FFN1 0
#endif
#ifndef DUP_FFN2
#define DUP_FFN2 0
#endif
#ifndef DUP_INP
#define DUP_INP 0
#endif
#ifndef DUP_PRO
#define DUP_PRO 0
#endif
#define IN(k) (lo <= (k) && (k) < hi)
#define SEAM(k) do { if (IN(k) && IN((k) + 1)) xcd_barrier(bar); } while (0)
#define FFN_PHASES(l, pb) do { \
    const float* ml_ = MODL + (size_t)(l) * NMODV; \
    if (IN((pb) + 5)) norm_mod_phase(XR, args.in[6] + (size_t)(l) * DM, ml_ + 3 * DM, ml_ + 4 * DM, Hb, lds, tid, gw, NGW, lane); \
    SEAM((pb) + 5); \
    if (IN((pb) + 6)) { pg8::Gemm g{Hb, (const bf16*)(ws + WS_WGU + (size_t)(l) * W_GU_B), SEQ, 2 * FFH, DM, LDD, LDD}; pg8::StaticOrder S; S.init(SEQ, 2 * FFH, G, bid); \
        pg8::EpiSwiGLU E{HID, LDF}; pg8::gemm_phase<pg8::EpiSwiGLU, pg8::StaticOrder, true, true>(lds, g, S, E); } \
    if (DUP_FFN1 && IN((pb) + 6)) { xcd_barrier(bar); pg8::Gemm g{Hb, (const bf16*)(ws + WS_WGU + (size_t)(l) * W_GU_B), SEQ, 2 * FFH, DM, LDD, LDD}; pg8::StaticOrder S; S.init(SEQ, 2 * FFH, G, bid); \
        pg8::EpiSwiGLU E{HID, LDF}; pg8::gemm_phase<pg8::EpiSwiGLU, pg8::StaticOrder, true, true>(lds, g, S, E); } \
    SEAM((pb) + 6); \
    if (DUP_FFN2 && IN((pb) + 7)) { xcd_barrier(bar); pg8::Gemm g{HID, (const bf16*)(ws + WS_WDN + (size_t)(l) * W_DN_B), SEQ, DM, FFH, LDF, LDF}; pg8::StaticOrder S; S.init(SEQ, DM, G, bid); \
        pg8::EpiResid E{XR, (float*)(ws + WS_OT), ml_ + 5 * DM, DM}; pg8::gemm_phase<pg8::EpiResid, pg8::StaticOrder, true, true>(lds, g, S, E); } \
    if (IN((pb) + 7)) { pg8::Gemm g{HID, (const bf16*)(ws + WS_WDN + (size_t)(l) * W_DN_B), SEQ, DM, FFH, LDF, LDF}; pg8::StaticOrder S; S.init(SEQ, DM, G, bid); \
        pg8::EpiResid E{XR, XR, ml_ + 5 * DM, DM}; pg8::gemm_phase<pg8::EpiResid, pg8::StaticOrder, true, true>(lds, g, S, E); } \
    SEAM((pb) + 7); } while (0)
template <int lp>
__device__ __forceinline__ void layer_pair(const Args& args, const Ctx& C, LAS unsigned char* lds, unsigned char* lds_raw, const XcdBarrier& bar) {
    const int lo = C.lo, hi = C.hi, tid = C.tid, lane = C.lane, wave = C.wave, gw = C.gw, NGW = C.NGW, gtid = C.gtid, NGT = C.NGT, G = C.G, bid = C.bid;
    unsigned char* ws = args.ws;
    bf16* const Hb = (bf16*)(ws + WS_H); bf16* const MIX = (bf16*)(ws + WS_MIX); bf16* const Z = (bf16*)(ws + WS_Z); bf16* const HID = (bf16*)(ws + WS_Z);
    float* const OT = (float*)(ws + WS_OT); float* const XR = args.out;
    const float* const MODL = (const float*)(ws + WS_MODL);
        { const int l = 2 * lp, pb = 2 + 8 * l; const float* ml = MODL + (size_t)l * NMODV;
          const float* xin = (l == 0) ? args.in[0] : XR;
          if (IN(pb)) norm_mod_phase(xin, args.in[5] + (size_t)l * DM, ml, ml + DM, Hb, lds, tid, gw, NGW, lane);
          SEAM(pb);
          if (IN(pb + 1)) { pg8::Gemm g{Hb, (const bf16*)(ws + WS_WIN + (size_t)lp * W_IN_B), SEQ, 12288, DM, LDD, LDD}; pg8::StaticOrder S; S.init(SEQ, 12288, G, bid);
              pg8::EpiHeadMajor E{Z, GS}; pg8::gemm_phase<pg8::EpiHeadMajor, pg8::StaticOrder, true, true>(lds, g, S, E); }
          if (DUP_INP && IN(pb + 1)) { xcd_barrier(bar); pg8::Gemm g{Hb, (const bf16*)(ws + WS_WIN + (size_t)lp * W_IN_B), SEQ, 12288, DM, LDD, LDD}; pg8::StaticOrder S; S.init(SEQ, 12288, G, bid);
              pg8::EpiHeadMajor E{Z, GS}; pg8::gemm_phase<pg8::EpiHeadMajor, pg8::StaticOrder, true, true>(lds, g, S, E); }
          SEAM(pb + 1);
          if (IN(pb + 2)) { conv_phase(Z, args.in[9] + (size_t)lp * 3 * 2048, MIX, gtid, NGT); if (ATT2) attn2_phase(Z, OT, (char*)lds_raw, bid, G); else attn_phase(Z, OT, (char*)lds_raw, bid, G); if (DUP_ATTN) { xcd_barrier(bar); if (ATT2) attn2_phase(Z, OT, (char*)lds_raw, bid, G); else attn_phase(Z, OT, (char*)lds_raw, bid, G); } }
          SEAM(pb + 2);
          if (IN(pb + 3)) combine_phase(OT, (const float*)(ws + WS_LAM) + lp, args.in[14] + lp * 256, lp == 0 ? 0.2f : 0.4707130183435842f, MIX, gw, NGW, lane);
          SEAM(pb + 3);
          if (IN(pb + 4)) { pg8::Gemm g{MIX, (const bf16*)(ws + WS_WOUT + (size_t)lp * W_OUT_B), SEQ, DM, DM, LDD, LDD}; pg8::StaticOrder S; S.init(SEQ, DM, G, bid);
              pg8::EpiResid E{xin, XR, ml + 2 * DM, DM}; pg8::gemm_phase<pg8::EpiResid, pg8::StaticOrder, true, true>(lds, g, S, E); }
          SEAM(pb + 4);
          FFN_PHASES(l, pb);
        }
        { const int l = 2 * lp + 1, pb = 2 + 8 * l; const float* ml = MODL + (size_t)l * NMODV;
          const unsigned char* prm = ws + WS_S5P + (size_t)lp * S5P_LAYER;
          float* const S5F = (float*)(ws + WS_S5F); float* const S5H = (float*)(ws + WS_S5H);
          if (IN(pb)) norm_mod_phase(XR, args.in[5] + (size_t)l * DM, ml, ml + DM, Hb, lds, tid, gw, NGW, lane);
          SEAM(pb);
          if (IN(pb + 1)) { if (S5_MFMA) s5m_pass<false>(Hb, prm, nullptr, S5F, nullptr, nullptr, lds, bid, G); else s5_pass<false>(Hb, prm, nullptr, nullptr, nullptr, S5F, nullptr, nullptr, lds, gw, NGW, wave, lane); }
          SEAM(pb + 1);
          if (IN(pb + 2)) s5_carry(prm, S5F, S5H, gtid);
          SEAM(pb + 2);
          if (IN(pb + 3)) { if (S5_MFMA) s5m_pass<true>(Hb, prm, args.in[23] + (size_t)lp * DM, nullptr, S5H, MIX, lds, bid, G); else s5_pass<true>(Hb, prm, args.in[21] + (size_t)lp * 256 * 16 * 64, args.in[22] + (size_t)lp * 256 * 16 * 64, args.in[23] + (size_t)lp * DM, nullptr, S5H, MIX, lds, gw, NGW, wave, lane); }
          if (DUP_S5) { xcd_barrier(bar);
          if (IN(pb + 1)) { if (S5_MFMA) s5m_pass<false>(Hb, prm, nullptr, S5F, nullptr, nullptr, lds, bid, G); else s5_pass<false>(Hb, prm, nullptr, nullptr, nullptr, S5F, nullptr, nullptr, lds, gw, NGW, wave, lane); }
          SEAM(pb + 1);
          if (IN(pb + 2)) s5_carry(prm, S5F, S5H, gtid);
          SEAM(pb + 2);
          if (IN(pb + 3)) { if (S5_MFMA) s5m_pass<true>(Hb, prm, args.in[23] + (size_t)lp * DM, nullptr, S5H, MIX, lds, bid, G); else s5_pass<true>(Hb, prm, args.in[21] + (size_t)lp * 256 * 16 * 64, args.in[22] + (size_t)lp * 256 * 16 * 64, args.in[23] + (size_t)lp * DM, nullptr, S5H, MIX, lds, gw, NGW, wave, lane); }
          }
          SEAM(pb + 3);
          if (IN(pb + 4)) { pg8::Gemm g{MIX, (const bf16*)(ws + WS_WGLU + (size_t)lp * W_GLU_B), SEQ, 2 * DM, DM, LDD, LDD}; pg8::StaticOrder S; S.init(SEQ, 2 * DM, G, bid);
              pg8::EpiGluResid E{XR, XR, ml + 2 * DM, DM}; pg8::gemm_phase<pg8::EpiGluResid, pg8::StaticOrder, true, true>(lds, g, S, E); }
          SEAM(pb + 4);
          FFN_PHASES(l, pb);
        }
    }
#undef FFN_PHASES
#undef IN
#undef SEAM

__global__ void __launch_bounds__(NTHR, 2) trunk_fwd(Args args) {
    extern __shared__ __attribute__((aligned(16))) unsigned char lds_raw[];
    LAS unsigned char* lds = (LAS unsigned char*)lds_raw;
    volatile LAS unsigned* MISC = (volatile LAS unsigned*)(lds + MISC_OFF);
    const int tid = opaque_tid(), lane = tid & 63, wave = __builtin_amdgcn_readfirstlane(tid >> 6);
    const int G = gridDim.x, bid = blockIdx.x;
    const int vcu = (G % 8 == 0) ? (bid % 8) * (G / 8) + bid / 8 : bid;
    const int gw = vcu * NWAVES + wave, NGW = G * NWAVES, gtid = vcu * NTHR + tid, NGT = G * NTHR;
    unsigned char* ws = args.ws;
    const int lo = args.ph_lo, hi = args.ph_hi;
    for (int u = tid; u < (LDS_BYTES - RING_BYTES) / 4; u += NTHR) ((LAS unsigned*)(lds + RING_BYTES))[u] = 0u;
    __syncthreads();
    XcdBarrier bar; bar.bar = (unsigned*)(ws + WS_CTL) + CW_BAR; bar.x = 0; bar.st = MISC + 8;
    if (hi - lo > 1) bar = xcd_barrier_post((unsigned*)(ws + WS_CTL) + CW_BAR, MISC + 8);
    const Ctx C{lo, hi, tid, lane, wave, gw, NGW, gtid, NGT, G, bid};
#define IN(k) (lo <= (k) && (k) < hi)
#define SEAM(k) do { if (IN(k) && IN((k) + 1)) xcd_barrier(bar); } while (0)

    bf16* const Hb = (bf16*)(ws + WS_H); bf16* const MIX = (bf16*)(ws + WS_MIX); bf16* const Z = (bf16*)(ws + WS_Z); bf16* const HID = (bf16*)(ws + WS_Z);
    float* const OT = (float*)(ws + WS_OT); float* const XR = args.out;
    const float* const MODL = (const float*)(ws + WS_MODL);

    if (IN(0)) { p0_prologue(args, lds, gw, NGW, wave, lane); if (DUP_PRO) { xcd_barrier(bar); p0_prologue(args, lds, gw, NGW, wave, lane); } }
    SEAM(0);
    if (IN(1)) p1_modvec(args, gtid, NGT);
    SEAM(1);


    layer_pair<0>(args, C, lds, lds_raw, bar);
    layer_pair<1>(args, C, lds, lds_raw, bar);
    if (IN(34)) final_norm_phase(XR, args.in[7], XR, gw, NGW, lane);
#undef IN
#undef SEAM
}

extern "C" void kernel_launch(void* const* d_in, const int* in_sizes, int n_in, void* d_out, int out_size, void* d_ws, size_t ws_size, hipStream_t stream) {
    static int grid = 0;
    if (grid == 0) {
        if (n_in != 29 || in_sizes[0] != SEQ * DM || out_size != SEQ * DM || ws_size < WS_END) {
            fprintf(stderr, "kernel_launch: built for 29 inputs, x/out of %d floats, >= %zu bytes of workspace; got n_in %d, in0 %d, out %d, ws %zu; nothing launched\n", SEQ * DM, (size_t)WS_END, n_in, n_in > 0 ? in_sizes[0] : -1, out_size, ws_size); grid = -1; return; }
        int dev = 0, cus = 0, per_cu = 0;
        if (hipGetDevice(&dev) != hipSuccess || hipDeviceGetAttribute(&cus, hipDeviceAttributeMultiprocessorCount, dev) != hipSuccess) { fprintf(stderr, "kernel_launch: device query failed\n"); grid = -1; return; }
        if (hipFuncSetAttribute((const void*)trunk_fwd, hipFuncAttributeMaxDynamicSharedMemorySize, LDS_BYTES) != hipSuccess) { fprintf(stderr, "kernel_launch: hipFuncSetAttribute failed\n"); grid = -1; return; }
        if (hipOccupancyMaxActiveBlocksPerMultiprocessor(&per_cu, (const void*)trunk_fwd, NTHR, LDS_BYTES) != hipSuccess || per_cu < 1) { fprintf(stderr, "kernel_launch: occupancy query reports %d workgroups per CU\n", per_cu); }
        (void)hipGetLastError();
        grid = cus;
        fprintf(stderr, "kernel_launch: grid %d, occupancy %d, ws %zu (need %zu)\n", grid, per_cu, ws_size, (size_t)WS_END);
    }
    if (grid < 0) return;
    if (hipMemsetAsync((char*)d_ws + WS_CTL, 0, CTL_ZERO_BYTES, stream) != hipSuccess) { fprintf(stderr, "kernel_launch: memset failed\n"); return; }
    Args a{};
    for (int i = 0; i < 29; ++i) a.in[i] = (const float*)d_in[i];
    a.out = (float*)d_out; a.ws = (unsigned char*)d_ws;
#if MK_PER_PHASE
    for (int p = 0; p < N_PHASES; ++p) { a.ph_lo = p; a.ph_hi = p + 1; hipLaunchKernelGGL(trunk_fwd, dim3(grid), dim3(NTHR), LDS_BYTES, stream, a); }
#else
    a.ph_lo = 0; a.ph_hi = N_PHASES;
    hipLaunchKernelGGL(trunk_fwd, dim3(grid), dim3(NTHR), LDS_BYTES, stream, a);
#endif
    const hipError_t le = hipPeekAtLastError();
    if (le != hipSuccess) fprintf(stderr, "kernel_launch: launch failed: %s\n", hipGetErrorName(le));
}
```

```cpp
#include <hip/hip_runtime.h>
#include <hip/hip_bf16.h>
#include <cstdio>
#include <cstdint>
__device__ __forceinline__ int opaque_tid() { int t; asm volatile("v_mov_b32 %0, %1" : "=v"(t) : "v"((int)threadIdx.x)); return t; }
namespace pg8 {
#define PG8_LAS __attribute__((address_space(3)))
typedef unsigned short bf16_t;
typedef short bf16x8 __attribute__((ext_vector_type(8)));
typedef float f32x4 __attribute__((ext_vector_type(4)));
typedef unsigned u32x4 __attribute__((ext_vector_type(4)));
constexpr int BM = 256, BK = 64, HALF = 128, HTB = HALF * BK * 2  , STAGE_BYTES = 8 * HTB, NXCD = 8, WGM = 8;

__host__ __device__ __forceinline__ int lds_byte(int r, int c) { const int st = (r >> 4) * 2 + (c >> 5), rr = r & 15, cc = c & 31, ob = rr * 64 + cc * 2; return st * 1024 + (ob ^ (((ob >> 9) & 1) << 5)); }
__host__ __device__ __forceinline__ void stage_rc(int b, int& R, int& C) { const int st = b / 1024, sb = b % 1024, swz = sb ^ (((sb >> 9) & 1) << 5); R = (st >> 1) * 16 + swz / 64; C = (st & 1) * 32 + (swz % 64) / 2; }
__host__ __device__ __forceinline__ int perm32(int rho) { const int n = rho >> 4, i = rho & 15; return 8 * (i >> 2) + 4 * n + (i & 3); }

struct Unit { int pm, pn; };
struct Gemm { const bf16_t* A; const bf16_t* Bt; int M, N, K, lda, ldb; };

struct StaticOrder {
    int nM, nN, nwg, G, c;
    __host__ __device__ void init(int M, int N, int G_, int c_) { nM = M / BM; nN = N / BM; nwg = nM * nN; G = G_; c = c_; }
    __host__ __device__ bool next(int i, Unit& u) const {
        const long L = (long)i * G + c; if (L >= nwg) return false;
        int wgid = (int)L; { const int q = nwg / NXCD, r = nwg % NXCD, xcd = wgid % NXCD, off = wgid / NXCD; wgid = (xcd < r ? xcd * (q + 1) : r * (q + 1) + (xcd - r) * q) + off; }
        const int nig = WGM * nN, gid = wgid / nig, fm = gid * WGM, gsz = (nM - fm) < WGM ? (nM - fm) : WGM;
        u.pm = fm + ((wgid % nig) % gsz); u.pn = (wgid % nig) / gsz; return true;
    }
    __device__ __forceinline__ void a_ready(const Unit&) const {}
    __device__ __forceinline__ void done(const Unit&) const {}
};

__device__ __forceinline__ unsigned cvt_pk_bf16(float lo, float hi) { unsigned r; asm volatile("v_cvt_pk_bf16_f32 %0, %1, %2" : "=v"(r) : "v"(lo), "v"(hi)); return r; }
__device__ __forceinline__ float fast_sigmoid(float x) { return __builtin_amdgcn_rcpf(1.0f + __builtin_amdgcn_exp2f(-1.4426950408889634f * x)); }

struct EpiHeadMajor {
    static constexpr bool PERM = true, AFTER_DRAIN = false;
    bf16_t* O; size_t gstride;
    __device__ __forceinline__ void operator()(const f32x4 (&acc)[2][2][4][2], const Unit& u, int wr, int wc, int fr, int fq) const {
        const int row0 = u.pm * BM + wr * 64 + fr, col0 = wc * 32 + 8 * fq;
#pragma unroll
        for (int ai = 0; ai < 2; ++ai)
#pragma unroll
            for (int m = 0; m < 4; ++m) { const size_t ro = (size_t)(row0 + ai * HALF + m * 16) * 128 + col0;
#pragma unroll
                for (int bj = 0; bj < 2; ++bj) { const f32x4 v0 = acc[ai][bj][m][0], v1 = acc[ai][bj][m][1];
                    u32x4 w; w.x = cvt_pk_bf16(v0[0], v0[1]); w.y = cvt_pk_bf16(v0[2], v0[3]); w.z = cvt_pk_bf16(v1[0], v1[1]); w.w = cvt_pk_bf16(v1[2], v1[3]);
                    *(u32x4*)(O + (size_t)(2 * u.pn + bj) * gstride + ro) = w; } }
    }
};
struct EpiResid {
    static constexpr bool PERM = false, AFTER_DRAIN = false;
    const float* base; float* out; const float* gate; int ldc;
    __device__ __forceinline__ void operator()(const f32x4 (&acc)[2][2][4][2], const Unit& u, int wr, int wc, int fr, int fq) const {
        const int row0 = u.pm * BM + wr * 64 + fr, col0 = u.pn * BM + wc * 32 + 4 * fq;
        f32x4 gv[2][2];
#pragma unroll
        for (int bj = 0; bj < 2; ++bj)
#pragma unroll
            for (int n = 0; n < 2; ++n) gv[bj][n] = *(const f32x4*)(gate + col0 + bj * HALF + n * 16);
#pragma unroll
        for (int ai = 0; ai < 2; ++ai) {
            f32x4 b[4][2][2];
#pragma unroll
            for (int m = 0; m < 4; ++m) { const size_t off = (size_t)(row0 + ai * HALF + m * 16) * ldc + col0;
#pragma unroll
                for (int bj = 0; bj < 2; ++bj)
#pragma unroll
                    for (int n = 0; n < 2; ++n) b[m][bj][n] = *(const f32x4*)(base + off + bj * HALF + n * 16); }
            asm volatile("" ::: "memory");
#pragma unroll
            for (int m = 0; m < 4; ++m) { const size_t off = (size_t)(row0 + ai * HALF + m * 16) * ldc + col0;
#pragma unroll
                for (int bj = 0; bj < 2; ++bj)
#pragma unroll
                    for (int n = 0; n < 2; ++n) *(f32x4*)(out + off + bj * HALF + n * 16) = b[m][bj][n] + gv[bj][n] * acc[ai][bj][m][n]; }
            asm volatile("" ::: "memory"); }
    }
};
struct EpiSwiGLU {
    static constexpr bool PERM = true, AFTER_DRAIN = false;
    bf16_t* O; int ldc;
    __device__ __forceinline__ void operator()(const f32x4 (&acc)[2][2][4][2], const Unit& u, int wr, int wc, int fr, int fq) const {
        const int row0 = u.pm * BM + wr * 64 + fr, col0 = u.pn * HALF + wc * 32 + 8 * fq;
#pragma unroll
        for (int ai = 0; ai < 2; ++ai)
#pragma unroll
            for (int m = 0; m < 4; ++m) { bf16_t* rowp = O + (size_t)(row0 + ai * HALF + m * 16) * ldc + col0;
                float r[8];
#pragma unroll
                for (int n = 0; n < 2; ++n)
#pragma unroll
                    for (int j = 0; j < 4; ++j) { const float g = acc[ai][0][m][n][j], up = acc[ai][1][m][n][j]; r[n * 4 + j] = g * fast_sigmoid(g) * up; }
                u32x4 w; w.x = cvt_pk_bf16(r[0], r[1]); w.y = cvt_pk_bf16(r[2], r[3]); w.z = cvt_pk_bf16(r[4], r[5]); w.w = cvt_pk_bf16(r[6], r[7]);
                *(u32x4*)rowp = w; }
    }
};
struct EpiGluResid {
    static constexpr bool PERM = false, AFTER_DRAIN = false;
    const float* base; float* out; const float* gate; int ldc;
    __device__ __forceinline__ void operator()(const f32x4 (&acc)[2][2][4][2], const Unit& u, int wr, int wc, int fr, int fq) const {
        const int row0 = u.pm * BM + wr * 64 + fr, col0 = u.pn * HALF + wc * 32 + 4 * fq;
        f32x4 gv[2];
#pragma unroll
        for (int n = 0; n < 2; ++n) gv[n] = *(const f32x4*)(gate + col0 + n * 16);
        f32x4 b[2][4][2];
#pragma unroll
        for (int ai = 0; ai < 2; ++ai)
#pragma unroll
            for (int m = 0; m < 4; ++m) { const size_t off = (size_t)(row0 + ai * HALF + m * 16) * ldc + col0;
#pragma unroll
                for (int n = 0; n < 2; ++n) b[ai][m][n] = *(const f32x4*)(base + off + n * 16); }
        asm volatile("" ::: "memory");
#pragma unroll
        for (int ai = 0; ai < 2; ++ai)
#pragma unroll
            for (int m = 0; m < 4; ++m) { const size_t off = (size_t)(row0 + ai * HALF + m * 16) * ldc + col0;
#pragma unroll
                for (int n = 0; n < 2; ++n) { const f32x4 a = acc[ai][0][m][n], sg = acc[ai][1][m][n]; f32x4 y;
#pragma unroll
                    for (int j = 0; j < 4; ++j) y[j] = a[j] * fast_sigmoid(sg[j]);
                    *(f32x4*)(out + off + n * 16) = b[ai][m][n] + gv[n] * y; } }
        asm volatile("" ::: "memory");
    }
};

template <class Epi, class Sched, bool ALIGN_EPI = false, bool SP2 = false>
__device__ __forceinline__ void gemm_phase(PG8_LAS unsigned char* lds, const Gemm g, const Sched& S, const Epi& E) {
    const int tid = opaque_tid(), wid = __builtin_amdgcn_readfirstlane(tid >> 6), lane = tid & 63, wr = wid >> 2, wc = wid & 3, fr = lane & 15, fq = lane >> 4;
    const int K = g.K, nt = K / BK;
    unsigned voffA[2], voffB[2];
#pragma unroll
    for (int i = 0; i < 2; ++i) { int R, C; stage_rc(tid * 16 + i * 8192, R, C); const int Rb = Epi::PERM ? ((R & ~31) + perm32(R & 31)) : R;
        voffA[i] = (unsigned)(R * g.lda + C) * 2u; voffB[i] = (unsigned)(Rb * g.ldb + C) * 2u; }
    const size_t kstep = (size_t)(BK * 2);
    const size_t hstepA = (size_t)HALF * g.lda * 2, hstepB = (size_t)HALF * g.ldb * 2;
    const size_t tstepA = 2 * hstepA, tstepB = 2 * hstepB;
    const unsigned ldsw = (unsigned)wid * 1024u;
    const int aoff = lds_byte(wr * 64 + fr, fq * 8), boff = lds_byte(wc * 32 + fr, fq * 8);
#define PG8_SA(b, h) (((b) * 2 + (h)) * HTB)
#define PG8_SB(b, h) ((4 + (b) * 2 + (h)) * HTB)
#define PG8_STAGE(bufoff, gbase, voff) do { _Pragma("unroll") for (int _i = 0; _i < 2; ++_i) \
        __builtin_amdgcn_global_load_lds((const unsigned*)((const char*)(gbase) + (voff)[_i]), (PG8_LAS unsigned*)(lds + (bufoff) + ldsw + _i * 8192), 16, 0, 0); } while (0)
#define PG8_LDA(dst, b, h) do { _Pragma("unroll") for (int m = 0; m < 4; ++m) _Pragma("unroll") for (int k = 0; k < 2; ++k) dst[m][k] = *(const PG8_LAS bf16x8*)(lds + PG8_SA(b, h) + aoff + m * 2048 + k * 1024); } while (0)
#define PG8_LDB(dst, b, h) do { _Pragma("unroll") for (int n = 0; n < 2; ++n) _Pragma("unroll") for (int k = 0; k < 2; ++k) dst[n][k] = *(const PG8_LAS bf16x8*)(lds + PG8_SB(b, h) + boff + n * 2048 + k * 1024); } while (0)
#define PG8_MMA(ai, bj, At, Bt) do { __builtin_amdgcn_s_setprio(1); _Pragma("unroll") for (int m = 0; m < 4; ++m) _Pragma("unroll") for (int n = 0; n < 2; ++n) _Pragma("unroll") for (int k = 0; k < 2; ++k) \
        acc[ai][bj][m][n] = __builtin_amdgcn_mfma_f32_16x16x32_bf16(Bt[n][k], At[m][k], acc[ai][bj][m][n], 0, 0, 0); __builtin_amdgcn_s_setprio(0); } while (0)
#define PG8_WAIT_V(n) asm volatile("s_waitcnt vmcnt(" #n ")" ::: "memory")
#define PG8_WAIT_L(n) asm volatile("s_waitcnt lgkmcnt(" #n ")" ::: "memory")
#define PG8_BAR __builtin_amdgcn_s_barrier()
#define PG8_SCHED __builtin_amdgcn_sched_barrier(0)
    Unit cur, nxt; int ui = 0;
    if (!S.next(0, cur)) return;
    f32x4 acc[2][2][4][2];
#pragma unroll
    for (int a = 0; a < 2; ++a)
#pragma unroll
        for (int b = 0; b < 2; ++b)
#pragma unroll
            for (int m = 0; m < 4; ++m)
#pragma unroll
                for (int n = 0; n < 2; ++n) acc[a][b][m][n] = (f32x4){0.f, 0.f, 0.f, 0.f};
    bf16x8 At[4][2], B0[2][2], B1[2][2];
    const char* cA = (const char*)g.A + (size_t)cur.pm * tstepA; const char* cB = (const char*)g.Bt + (size_t)cur.pn * tstepB;
    S.a_ready(cur);
    if constexpr (SP2) {
        PG8_STAGE(PG8_SB(0, 0), cB, voffB); PG8_STAGE(PG8_SB(0, 1), cB + hstepB, voffB); PG8_STAGE(PG8_SA(0, 0), cA, voffA); PG8_STAGE(PG8_SA(0, 1), cA + hstepA, voffA);
        if (wr == 1) PG8_BAR;
        PG8_WAIT_V(2); PG8_BAR;
        PG8_STAGE(PG8_SB(1, 0), cB + kstep, voffB); PG8_STAGE(PG8_SA(1, 0), cA + kstep, voffA); PG8_STAGE(PG8_SB(1, 1), cB + hstepB + kstep, voffB);
        PG8_WAIT_V(6); PG8_BAR;
    } else {
        PG8_STAGE(PG8_SB(0, 0), cB, voffB); PG8_STAGE(PG8_SA(0, 0), cA, voffA); PG8_STAGE(PG8_SB(0, 1), cB + hstepB, voffB); PG8_STAGE(PG8_SA(0, 1), cA + hstepA, voffA);
        if (wr == 1) PG8_BAR;
        PG8_WAIT_V(4); PG8_BAR;
        PG8_STAGE(PG8_SB(1, 0), cB + kstep, voffB); PG8_STAGE(PG8_SA(1, 0), cA + kstep, voffA); PG8_STAGE(PG8_SB(1, 1), cB + hstepB + kstep, voffB);
        PG8_WAIT_V(6); PG8_BAR;
    }
    for (;;) {
        const bool has_next = S.next(ui + 1, nxt);
        const char* nA = has_next ? (const char*)g.A + (size_t)nxt.pm * tstepA : cA; const char* nB = has_next ? (const char*)g.Bt + (size_t)nxt.pn * tstepB : cB;
        for (int t = 0; t < nt; t += 2) {
            const bool last = (t == nt - 2);
            const char* a1 = cA + (size_t)(t + 1) * kstep;
            const char* a2 = last ? nA : cA + (size_t)(t + 2) * kstep; const char* b2 = last ? nB : cB + (size_t)(t + 2) * kstep;
            const char* a3 = a2 + kstep; const char* b3 = b2 + kstep;
            if (last && has_next) S.a_ready(nxt);
            if constexpr (SP2) {
            PG8_LDB(B0, 0, 0); PG8_LDB(B1, 0, 1); PG8_SCHED; PG8_LDA(At, 0, 0); PG8_STAGE(PG8_SA(1, 1), a1 + hstepA, voffA);
            PG8_WAIT_V(8); PG8_WAIT_L(0); PG8_BAR; PG8_MMA(0, 0, At, B0); PG8_MMA(0, 1, At, B1); PG8_BAR; PG8_SCHED;
            PG8_LDA(At, 0, 1); PG8_STAGE(PG8_SB(0, 0), b2, voffB); PG8_STAGE(PG8_SB(0, 1), b2 + hstepB, voffB); PG8_STAGE(PG8_SA(0, 0), a2, voffA);
            PG8_WAIT_V(8); PG8_WAIT_L(0); PG8_BAR; PG8_MMA(1, 0, At, B0); PG8_MMA(1, 1, At, B1); PG8_BAR; PG8_SCHED;
            PG8_LDB(B0, 1, 0); PG8_LDB(B1, 1, 1); PG8_SCHED; PG8_LDA(At, 1, 0); PG8_STAGE(PG8_SA(0, 1), a2 + hstepA, voffA);
            PG8_WAIT_V(8); PG8_WAIT_L(0); PG8_BAR; PG8_MMA(0, 0, At, B0); PG8_MMA(0, 1, At, B1); PG8_BAR; PG8_SCHED;
            PG8_LDA(At, 1, 1); PG8_STAGE(PG8_SB(1, 0), b3, voffB); PG8_STAGE(PG8_SB(1, 1), b3 + hstepB, voffB); PG8_STAGE(PG8_SA(1, 0), a3, voffA);
            PG8_WAIT_V(8); PG8_WAIT_L(0); PG8_BAR; PG8_MMA(1, 0, At, B0); PG8_MMA(1, 1, At, B1); PG8_BAR; PG8_SCHED;
            } else {
            PG8_LDB(B0, 0, 0); PG8_SCHED; PG8_LDA(At, 0, 0); PG8_STAGE(PG8_SA(1, 1), a1 + hstepA, voffA);
            PG8_WAIT_L(8); PG8_BAR; PG8_WAIT_L(0); PG8_MMA(0, 0, At, B0); PG8_BAR; PG8_SCHED;
            PG8_LDB(B1, 0, 1); PG8_STAGE(PG8_SB(0, 0), b2, voffB);
            PG8_BAR; PG8_WAIT_L(0); PG8_MMA(0, 1, At, B1); PG8_BAR;
            PG8_LDA(At, 0, 1); PG8_STAGE(PG8_SA(0, 0), a2, voffA);
            PG8_BAR; PG8_WAIT_L(0); PG8_MMA(1, 0, At, B0); PG8_BAR; PG8_SCHED;
            PG8_STAGE(PG8_SB(0, 1), b2 + hstepB, voffB);
            PG8_WAIT_V(6); PG8_BAR; PG8_MMA(1, 1, At, B1); PG8_BAR;
            PG8_LDB(B0, 1, 0); PG8_SCHED; PG8_LDA(At, 1, 0); PG8_STAGE(PG8_SA(0, 1), a2 + hstepA, voffA);
            PG8_WAIT_L(8); PG8_BAR; PG8_WAIT_L(0); PG8_MMA(0, 0, At, B0); PG8_BAR; PG8_SCHED;
            PG8_LDB(B1, 1, 1); PG8_STAGE(PG8_SB(1, 0), b3, voffB);
            PG8_BAR; PG8_WAIT_L(0); PG8_MMA(0, 1, At, B1); PG8_BAR;
            PG8_LDA(At, 1, 1); PG8_STAGE(PG8_SA(1, 0), a3, voffA);
            PG8_BAR; PG8_WAIT_L(0); PG8_MMA(1, 0, At, B0); PG8_BAR; PG8_SCHED;
            PG8_STAGE(PG8_SB(1, 1), b3 + hstepB, voffB);
            PG8_WAIT_V(6); PG8_BAR; PG8_MMA(1, 1, At, B1); PG8_BAR;
            }
        }
        if constexpr (ALIGN_EPI) { if (wr == 0) PG8_BAR; }
        if constexpr (!Epi::AFTER_DRAIN) { E(acc, cur, wr, wc, fr, fq); S.done(cur); }
        if (!has_next) break;
#pragma unroll
        for (int a = 0; a < 2; ++a)
#pragma unroll
            for (int b = 0; b < 2; ++b)
#pragma unroll
                for (int m = 0; m < 4; ++m)
#pragma unroll
                    for (int n = 0; n < 2; ++n) acc[a][b][m][n] = (f32x4){0.f, 0.f, 0.f, 0.f};
        cur = nxt; cA = nA; cB = nB; ++ui;
        if constexpr (ALIGN_EPI) { if (wr == 1) PG8_BAR; }
    }
    PG8_WAIT_V(0);
    if constexpr (!ALIGN_EPI) { if (wr == 0) PG8_BAR; }
    PG8_BAR;
    if constexpr (Epi::AFTER_DRAIN) { E.fused(acc, cur, wr, wc, fr, fq, lds, wid, lane); S.done(cur); }
#undef PG8_SA
#undef PG8_SB
#undef PG8_STAGE
#undef PG8_LDA
#undef PG8_LDB
#undef PG8_MMA
#undef PG8_WAIT_V
#undef PG8_WAIT_L
#undef PG8_BAR
#undef PG8_SCHED
}
}

namespace att {
constexpr int D = 128;
constexpr float THR = 8.f;
constexpr bool WSKIP = false;
constexpr float SCALE = 0.08838834764831845f;
constexpr int NW = 8, QBLK = 32, KVBLK = 64, QB = NW * QBLK;
constexpr int SHM_V = KVBLK * D * 2, SHM_K = KVBLK * D * 2;
constexpr int LDS_BYTES = 2 * SHM_V + 2 * SHM_K + NW * 64 * 4;

using bf16 = __hip_bfloat16;
typedef short bf16x8 __attribute__((ext_vector_type(8)));
typedef short s16x4 __attribute__((ext_vector_type(4)));
typedef float f32x16 __attribute__((ext_vector_type(16)));
typedef float f32x4 __attribute__((ext_vector_type(4)));
typedef unsigned u32x4 __attribute__((ext_vector_type(4)));
template <class A, class Bt> struct same_t { static constexpr bool v = false; };
template <class A> struct same_t<A, A> { static constexpr bool v = true; };

#define KSWZ(row, colB) ((row) * 256 + ((colB) ^ (((row) & 7) << 4)))
#define SBAR() __builtin_amdgcn_sched_barrier(0)
__device__ __forceinline__ int v_st(int k, int c) { const int kk = (k & ~0xC) | ((k & 4) << 1) | ((k & 8) >> 1); return ((kk >> 3) * 4 + (c >> 5)) * 512 + ((kk & 7) * 32 + (c & 31)) * 2; }
__device__ __forceinline__ int v_rd_base(int lane) { return ((lane & 3) << 3) | (((lane >> 2) & 3) << 6) | (((lane >> 4) & 1) << 5) | (((lane >> 5) & 1) << 8); }
constexpr int v_rd_off(int d0, int ks, int half) { return d0 * 512 + ks * 4096 + half * 2048; }
__device__ __forceinline__ int crow(int r, int hi) { return (r & 3) + 8 * (r >> 2) + 4 * hi; }
__device__ __forceinline__ unsigned cvtpk(float lo, float hi) {
    unsigned r; asm volatile("v_cvt_pk_bf16_f32 %0, %1, %2" : "=v"(r) : "v"(lo), "v"(hi)); return r;
}
__device__ __forceinline__ bf16x8 pack8(f32x4 a, f32x4 b) {
    u32x4 w = {cvtpk(a[0], a[1]), cvtpk(a[2], a[3]), cvtpk(b[0], b[1]), cvtpk(b[2], b[3])};
    return *reinterpret_cast<bf16x8*>(&w);
}
template <class T> __device__ __forceinline__ bf16x8 load8(const T* p) {
    if constexpr (same_t<T, float>::v) { return pack8(*(const f32x4*)p, *(const f32x4*)(p + 4)); }
    else { return *reinterpret_cast<const bf16x8*>(p); }
}
__device__ __forceinline__ void mask_tile(f32x16& p0, f32x16& p1, int dq, unsigned W) {
    const float NEG = -__builtin_inff();
#pragma unroll
    for (int r = 0; r < 16; ++r) {
        const int c = (r & 3) + 8 * (r >> 2);
        if ((unsigned)(dq - c) >= W) p0[r] = NEG;
        if ((unsigned)(dq - c - 32) >= W) p1[r] = NEG;
    }
}
__device__ __forceinline__ void partialSM(f32x16& p0, f32x16& p1, float& m_reg, float& mn, float& alpha) {
    float pmax = p0[0]; for (int r = 1; r < 16; ++r) pmax = fmaxf(pmax, p0[r]); for (int r = 0; r < 16; ++r) pmax = fmaxf(pmax, p1[r]);
    { auto rr = __builtin_amdgcn_permlane32_swap(__float_as_uint(pmax), __float_as_uint(pmax), false, false);
      pmax = fmaxf(__uint_as_float(rr[0]), __uint_as_float(rr[1])); }
    constexpr float C2 = 1.4426950408889634f * SCALE;
    if (__builtin_expect(__all((pmax - m_reg) * SCALE <= THR), 1)) { mn = m_reg; alpha = 1.f; }
    else { mn = fmaxf(m_reg, pmax); alpha = __builtin_amdgcn_exp2f((m_reg - mn) * C2); m_reg = mn; }
    const float mnL = -mn * C2;
    for (int r = 0; r < 16; ++r) p0[r] = fmaf(p0[r], C2, mnL); for (int r = 0; r < 16; ++r) p1[r] = fmaf(p1[r], C2, mnL);
    for (int r = 0; r < 16; ++r) p0[r] = __builtin_amdgcn_exp2f(p0[r]);
}
__device__ __forceinline__ void finishSM(f32x16& p0, f32x16& p1, float alpha, float& l_reg, bf16x8& pa0, bf16x8& pa1, bf16x8& pa2, bf16x8& pa3) {
    for (int r = 0; r < 16; ++r) p1[r] = __builtin_amdgcn_exp2f(p1[r]);
    float ps = 0; for (int r = 0; r < 16; ++r) ps += p0[r]; for (int r = 0; r < 16; ++r) ps += p1[r];
    { auto rr = __builtin_amdgcn_permlane32_swap(__float_as_uint(ps), __float_as_uint(ps), false, false);
      ps = __uint_as_float(rr[0]) + __uint_as_float(rr[1]); }
    l_reg = l_reg * alpha + ps;
#define PK4(P, B_, OUT) do { unsigned a0 = cvtpk(P[B_+0], P[B_+1]), a1 = cvtpk(P[B_+2], P[B_+3]);                          \
        unsigned b0 = cvtpk(P[B_+4], P[B_+5]), b1 = cvtpk(P[B_+6], P[B_+7]);                                             \
        auto r0 = __builtin_amdgcn_permlane32_swap(a0, b0, false, false); auto r1 = __builtin_amdgcn_permlane32_swap(a1, b1, false, false); \
        u32x4 w = {r0[0], r1[0], r0[1], r1[1]}; OUT = *reinterpret_cast<bf16x8*>(&w); } while (0)
    PK4(p0, 0, pa0); PK4(p0, 8, pa1); PK4(p1, 0, pa2); PK4(p1, 8, pa3);
#undef PK4
}
template <int KB, bool SK>
__device__ __forceinline__ void qkt(f32x16& p0, f32x16& p1, const char* K_lds, int r32, int hi, const bf16x8* qr, bool act) {
    if (SK && !act) { const float NEG = -__builtin_inff();
#pragma unroll
        for (int r = 0; r < 16; ++r) { p0[r] = NEG; p1[r] = NEG; } return; }
    p0 = f32x16{}; p1 = f32x16{};
    const char* kb[4];
#pragma unroll
    for (int dd = 0; dd < 4; ++dd) kb[dd] = K_lds + KB * SHM_K + KSWZ(r32, (dd * 16 + hi * 8) * 2);
#pragma unroll
    for (int d0 = 0; d0 < 8; ++d0) { const char* a = kb[d0 & 3] + (d0 >> 2) * 128;
        bf16x8 b0 = *reinterpret_cast<const bf16x8*>(a);
        bf16x8 b1 = *reinterpret_cast<const bf16x8*>(a + 32 * 256);
        p0 = __builtin_amdgcn_mfma_f32_32x32x16_bf16(b0, qr[d0], p0, 0, 0, 0);
        p1 = __builtin_amdgcn_mfma_f32_32x32x16_bf16(b1, qr[d0], p1, 0, 0, 0); }
}
template <int VB, bool SK>
__device__ __forceinline__ void pv_tile(f32x16* o, int vb0, bf16x8 pa0, bf16x8 pa1, bf16x8 pa2, bf16x8 pa3, bool act) {
    if (SK && !act) return;
#define TRRD(dst, off) asm volatile("ds_read_b64_tr_b16 %0, %1 offset:%2" : "=&v"(dst) : "v"(vb0), "i"(off) : "memory")
#define PV_D0(d0) do { s16x4 l0, l1, l2, l3, h0, h1, h2, h3; constexpr int b_ = VB * SHM_V + v_rd_off(d0, 0, 0);     \
        TRRD(l0, b_); TRRD(h0, b_ + 2048); TRRD(l1, b_ + 4096); TRRD(h1, b_ + 6144); TRRD(l2, b_ + 8192); TRRD(h2, b_ + 10240); TRRD(l3, b_ + 12288); TRRD(h3, b_ + 14336); \
        asm volatile("s_waitcnt lgkmcnt(0)" ::: "memory"); SBAR();                 \
        o[d0] = __builtin_amdgcn_mfma_f32_32x32x16_bf16(pa0, (bf16x8){l0[0], l0[1], l0[2], l0[3], h0[0], h0[1], h0[2], h0[3]}, o[d0], 0, 0, 0);   \
        o[d0] = __builtin_amdgcn_mfma_f32_32x32x16_bf16(pa1, (bf16x8){l1[0], l1[1], l1[2], l1[3], h1[0], h1[1], h1[2], h1[3]}, o[d0], 0, 0, 0);   \
        o[d0] = __builtin_amdgcn_mfma_f32_32x32x16_bf16(pa2, (bf16x8){l2[0], l2[1], l2[2], l2[3], h2[0], h2[1], h2[2], h2[3]}, o[d0], 0, 0, 0);   \
        o[d0] = __builtin_amdgcn_mfma_f32_32x32x16_bf16(pa3, (bf16x8){l3[0], l3[1], l3[2], l3[3], h3[0], h3[1], h3[2], h3[3]}, o[d0], 0, 0, 0); } while (0)
    PV_D0(0); PV_D0(1); PV_D0(2); PV_D0(3);
#undef PV_D0
#undef TRRD
}

template <class TIn, class TOut> struct BlockRef { const TIn* Q; const TIn* K; const TIn* V; TOut* O; int P0; };
template <class TIn> struct Seam {
    bf16x8 qr[8];
    bf16x8 st_v0, st_v1, st_k0, st_k1; f32x4 sf0, sf1, sf2, sf3;
    f32x4 tq[16];
};
__device__ __forceinline__ int swa_jlo(int P0, int W) { const int lowk = P0 - W + 1; return lowk > 0 ? lowk / KVBLK : 0; }
#define ROW(p, k0, rr) ((p) + (size_t)((k0) + (rr)) * D + sc)
#define VMW() asm volatile("s_waitcnt vmcnt(0)" ::: "memory")
#define VMWN(n) asm volatile("s_waitcnt vmcnt(%0)" :: "i"(n) : "memory")
#define SLOAD_H(Kp, Vp, k0) do { S.st_v0 = load8<TIn>(ROW(Vp, k0, sr)); S.st_v1 = load8<TIn>(ROW(Vp, k0, 32 + sr));              \
                         S.st_k0 = load8<TIn>(ROW(Kp, k0, sr)); S.st_k1 = load8<TIn>(ROW(Kp, k0, 32 + sr)); } while (0)
#define SWRITE_HK(bf) do { *(bf16x8*)(K_lds + (bf) * SHM_K + kws) = S.st_k0; *(bf16x8*)(K_lds + (bf) * SHM_K + kws + 32 * 256) = S.st_k1; } while (0)
#define SWRITE_HV(bf) do { *(bf16x8*)(V_lds + (bf) * SHM_V + vst0) = S.st_v0; *(bf16x8*)(V_lds + (bf) * SHM_V + vst1) = S.st_v1; } while (0)
#define SWRITE_H(bf) do { SWRITE_HV(bf); SWRITE_HK(bf); } while (0)
#define SLOAD_F(p, k0) do { S.sf0 = *(const f32x4*)ROW(p, k0, sr); S.sf1 = *(const f32x4*)(ROW(p, k0, sr) + 4);                \
                            S.sf2 = *(const f32x4*)ROW(p, k0, 32 + sr); S.sf3 = *(const f32x4*)(ROW(p, k0, 32 + sr) + 4); } while (0)
#define SWRITE_KF(bf) do { *(bf16x8*)(K_lds + (bf) * SHM_K + kws) = pack8(S.sf0, S.sf1); *(bf16x8*)(K_lds + (bf) * SHM_K + kws + 32 * 256) = pack8(S.sf2, S.sf3); } while (0)
#define SWRITE_VF(bf) do { *(bf16x8*)(V_lds + (bf) * SHM_V + vst0) = pack8(S.sf0, S.sf1); *(bf16x8*)(V_lds + (bf) * SHM_V + vst1) = pack8(S.sf2, S.sf3); } while (0)
template <class TIn, class TOut>
__device__ __forceinline__ void causal_swa_prime(const BlockRef<TIn, TOut>& cur, int W, char* lds, Seam<TIn>& S) {
    constexpr bool F32 = same_t<TIn, float>::v;
    const int tid = opaque_tid(), wid = __builtin_amdgcn_readfirstlane(tid >> 6), lane = tid & 63, r32 = lane & 31, hi = lane >> 5;
    const int sr = tid >> 4, sc = (tid & 15) * 8, kws = KSWZ(sr, sc * 2); char* K_lds = lds + 2 * SHM_V;
    const int kb0 = swa_jlo(cur.P0, W) * KVBLK;
    for (int d0 = 0; d0 < 8; ++d0) S.qr[d0] = load8<TIn>(cur.Q + (size_t)(wid * QBLK + r32) * D + d0 * 16 + hi * 8);
    if constexpr (F32) { SLOAD_F((const float*)cur.K, kb0); VMW(); SWRITE_KF(0); SBAR(); SLOAD_F((const float*)cur.V, kb0); }
    else { SLOAD_H(cur.K, cur.V, kb0); VMW(); SWRITE_HK(0); }
    __syncthreads();
}
template <class TIn, class TOut>
__device__ __forceinline__ void causal_swa_block(const BlockRef<TIn, TOut>& cur, const BlockRef<TIn, TOut>& nxt, int skv, int W, char* lds, Seam<TIn>& S) {
    constexpr bool F32 = same_t<TIn, float>::v;
    const int tid = opaque_tid(), wid = __builtin_amdgcn_readfirstlane(tid >> 6), lane = tid & 63, r32 = lane & 31, hi = lane >> 5;
    const int j_lo = swa_jlo(cur.P0, W);
    int j_hi = (cur.P0 + QB - 1) / KVBLK + 1; if (j_hi > skv / KVBLK) j_hi = skv / KVBLK;
    const int NT = j_hi - j_lo;
    const int kbn = swa_jlo(nxt.P0, W) * KVBLK;
    const int qlo = cur.P0 + wid * QBLK, qm = qlo + r32 - 4 * hi;
    char* V_lds = lds; char* K_lds = lds + 2 * SHM_V;
    float* ws = (float*)(lds + 2 * SHM_V + 2 * SHM_K) + wid * 64; float* li_l = ws, * al_l = ws + 32;
    float m_reg = -1e30f, l_reg = 0; f32x16 o[4] = {};
    const int sr = tid >> 4, sc = (tid & 15) * 8, vst0 = v_st(sr, sc), vst1 = v_st(32 + sr, sc), kws = KSWZ(sr, sc * 2);
    const int vb0 = (int)(uintptr_t)V_lds + v_rd_base(lane);
    const TIn* Kh = cur.K; const TIn* Vh = cur.V;
#define RESC(a) do { if (__any((a) < 1.f)) { if (hi == 0) al_l[r32] = (a); asm volatile("s_waitcnt lgkmcnt(0)" ::: "memory");              \
                     for (int d_ = 0; d_ < 4; ++d_) for (int r = 0; r < 16; ++r) o[d_][r] *= al_l[crow(r, hi)]; } } while (0)
#define KBASE(t) ((j_lo + (t)) * KVBLK)
#define ACT(t) (KBASE(t) <= qlo + QBLK - 1 && KBASE(t) + KVBLK - 1 >= qlo - W + 1)
#define MASKT(P0_, P1_, t) do { const int kb_ = KBASE(t); if ((!SK || ACT(t)) && (kb_ + KVBLK - 1 > qlo || kb_ <= qlo + QBLK - 1 - W)) mask_tile(P0_, P1_, qm - kb_, (unsigned)W); } while (0)
    constexpr int NQL = F32 ? 16 : 8;
    constexpr bool SK = WSKIP && !F32;
#define SEAM_K0() do { VMWN(NQL); if constexpr (F32) { SWRITE_KF(0); SBAR(); SLOAD_F((const float*)nxt.V, kbn); } else { SWRITE_HK(0); } SBAR(); } while (0)
    f32x16 pA0, pA1, pB0, pB1; float mnA, mnB, alA, alB; bf16x8 pa0, pa1, pa2, pa3;
    if constexpr (F32) { VMW(); SWRITE_VF(0); SBAR(); } else { SWRITE_HV(0); SBAR(); }
    if (NT > 1) { if constexpr (F32) SLOAD_F((const float*)Kh, KBASE(1)); else SLOAD_H(Kh, Vh, KBASE(1)); }
    SBAR(); qkt<0, SK>(pA0, pA1, K_lds, r32, hi, S.qr, ACT(0));
    if constexpr (F32) { if (NT > 1) { VMW(); SWRITE_KF(1); SBAR(); SLOAD_F((const float*)Vh, KBASE(1)); } }
    MASKT(pA0, pA1, 0); partialSM(pA0, pA1, m_reg, mnA, alA);
    if (NT > 1) { VMW(); if constexpr (F32) { SWRITE_VF(1); SBAR(); if (NT > 2) SLOAD_F((const float*)Kh, KBASE(2)); } else SWRITE_H(1); }
    __syncthreads();
#define HALF_STEP(PX0, PX1, mnX, alX, PY0, PY1, alY, t, KB, VB, SB) do {                                                      \
        SBAR(); qkt<KB, SK>(PX0, PX1, K_lds, r32, hi, S.qr, ACT(t));                                             \
        finishSM(PY0, PY1, alY, l_reg, pa0, pa1, pa2, pa3); SBAR();                                                           \
        if ((t) + 1 < NT) { if constexpr (F32) { VMW(); SWRITE_KF(SB); SBAR(); SLOAD_F((const float*)Vh, KBASE((t) + 1)); }  \
                            else { SLOAD_H(Kh, Vh, KBASE((t) + 1)); } SBAR(); }                                               \
        pv_tile<VB, SK>(o, vb0, pa0, pa1, pa2, pa3, ACT((t) - 1)); MASKT(PX0, PX1, (t)); partialSM(PX0, PX1, m_reg, mnX, alX);                                        \
        __syncthreads();                                                                                                      \
        if ((t) + 1 < NT) { VMW(); if constexpr (F32) { SWRITE_VF(SB); SBAR(); if ((t) + 2 < NT) SLOAD_F((const float*)Kh, KBASE((t) + 2)); } \
                            else { SWRITE_H(SB); } }                                                                          \
        RESC(alX); __syncthreads(); } while (0)
    for (int t = 1; t + 1 < NT; t += 2) {
        HALF_STEP(pB0, pB1, mnB, alB, pA0, pA1, alA, t, 1, 0, 0);
        HALF_STEP(pA0, pA1, mnA, alA, pB0, pB1, alB, t + 1, 0, 1, 1);
    }
    const bool even = (NT & 1) == 0;
    if (even) { SBAR(); qkt<1, SK>(pB0, pB1, K_lds, r32, hi, S.qr, ACT(NT - 1)); SBAR(); }
#define QROW(e) (nxt.Q + (size_t)(wid * QBLK + r32) * D + ((e) >> 1) * 16 + hi * 8 + ((e) & 1) * 4)
    if constexpr (F32) { SLOAD_F((const float*)nxt.K, kbn); SBAR();
#pragma unroll
        for (int e = 0; e < 8; ++e) S.tq[e] = *(const f32x4*)QROW(e); }
    else { SLOAD_H(nxt.K, nxt.V, kbn); SBAR();
#pragma unroll
        for (int d0 = 0; d0 < 8; ++d0) S.qr[d0] = load8<TIn>(nxt.Q + (size_t)(wid * QBLK + r32) * D + d0 * 16 + hi * 8); }
    SBAR();
    finishSM(pA0, pA1, alA, l_reg, pa0, pa1, pa2, pa3); SBAR();
    if constexpr (F32) {
#pragma unroll
        for (int e = 8; e < 16; ++e) S.tq[e] = *(const f32x4*)QROW(e); SBAR(); }
#undef QROW
    pv_tile<0, SK>(o, vb0, pa0, pa1, pa2, pa3, ACT(even ? NT - 2 : NT - 1));
    if (even) { MASKT(pB0, pB1, NT - 1); partialSM(pB0, pB1, m_reg, mnB, alB); __syncthreads(); RESC(alB);
        finishSM(pB0, pB1, alB, l_reg, pa0, pa1, pa2, pa3); SBAR(); pv_tile<1, SK>(o, vb0, pa0, pa1, pa2, pa3, ACT(NT - 1)); }
    SBAR(); SEAM_K0();
    if (hi == 0) li_l[r32] = l_reg; asm volatile("s_waitcnt lgkmcnt(0)" ::: "memory");
    float rli[16];
#pragma unroll
    for (int r = 0; r < 16; ++r) rli[r] = __builtin_amdgcn_rcpf(li_l[crow(r, hi)]);
    TOut* Ow = cur.O + (size_t)(wid * QBLK) * D;
#pragma unroll
    for (int r = 0; r < 16; ++r) { const int orow = crow(r, hi);
#pragma unroll
        for (int d0 = 0; d0 < 4; ++d0) { const float v = o[d0][r] * rli[r];
            if constexpr (same_t<TOut, float>::v) { Ow[(size_t)orow * D + d0 * 32 + r32] = v; }
            else { const float vn = __shfl_xor(v, 1);
                   if ((r32 & 1) == 0) *(unsigned*)(Ow + (size_t)orow * D + d0 * 32 + r32) = cvtpk(v, vn); } } }
    if constexpr (F32) {
#pragma unroll
        for (int d0 = 0; d0 < 8; ++d0) S.qr[d0] = pack8(S.tq[2 * d0], S.tq[2 * d0 + 1]); }
    __syncthreads();
#undef RESC
#undef KBASE
#undef ACT
#undef MASKT
#undef SEAM_K0
#undef HALF_STEP
}
#undef ROW
#undef VMW
#undef VMWN
#undef SLOAD_H
#undef SWRITE_HK
#undef SWRITE_HV
#undef SWRITE_H
#undef SLOAD_F
#undef SWRITE_KF
#undef SWRITE_VF
#undef KSWZ
#undef SBAR
}

namespace att2 {
typedef short bf16x8 __attribute__((ext_vector_type(8)));
typedef short s16x4 __attribute__((ext_vector_type(4)));
typedef float f32x16 __attribute__((ext_vector_type(16)));
typedef unsigned u32x4 __attribute__((ext_vector_type(4)));
constexpr float SCALE = 0.08838834764831845f, THR = 8.f, C2 = 1.4426950408889634f * SCALE;
constexpr int V_OFF = 0, K_OFF = 65536, PX_OFF = 98304, MX_OFF = 114688, WS_OFF = 118784, LDS_NEED = 120832;
#define A2_KSWZ(row, colB) ((row) * 256 + ((colB) ^ (((row) & 7) << 4)))
#define A2_SBAR() __builtin_amdgcn_sched_barrier(0)
template <int KB>
__device__ __forceinline__ void qkt(f32x16& p, const char* Kl, int krow, int hi, const bf16x8* qr) {
    p = f32x16{};
    const char* kbp[4];
#pragma unroll
    for (int dd = 0; dd < 4; ++dd) kbp[dd] = Kl + KB * 16384 + A2_KSWZ(krow, (dd * 16 + hi * 8) * 2);
    bf16x8 b[8];
#pragma unroll
    for (int d0 = 0; d0 < 8; ++d0) b[d0] = *reinterpret_cast<const bf16x8*>(kbp[d0 & 3] + (d0 >> 2) * 128);
    __builtin_amdgcn_s_setprio(1);
#pragma unroll
    for (int d0 = 0; d0 < 8; ++d0) p = __builtin_amdgcn_mfma_f32_32x32x16_bf16(b[d0], qr[d0], p, 0, 0, 0);
    __builtin_amdgcn_s_setprio(0);
}
template <int VOFFB>
__device__ __forceinline__ void pv(f32x16* o, int vb0, bf16x8 pa0, bf16x8 pa1, bf16x8 pa2, bf16x8 pa3) {
#define A2_TRRD(dst, off) asm volatile("ds_read_b64_tr_b16 %0, %1 offset:%2" : "=&v"(dst) : "v"(vb0), "i"(off) : "memory")
#define A2_PV_D0(d0) do { s16x4 l0, l1, l2, l3, h0, h1, h2, h3; constexpr int b_ = VOFFB + att::v_rd_off(d0, 0, 0); \
        A2_TRRD(l0, b_); A2_TRRD(h0, b_ + 2048); A2_TRRD(l1, b_ + 4096); A2_TRRD(h1, b_ + 6144); A2_TRRD(l2, b_ + 8192); A2_TRRD(h2, b_ + 10240); A2_TRRD(l3, b_ + 12288); A2_TRRD(h3, b_ + 14336); \
        asm volatile("s_waitcnt lgkmcnt(0)" ::: "memory"); A2_SBAR(); \
        o[d0] = __builtin_amdgcn_mfma_f32_32x32x16_bf16(pa0, (bf16x8){l0[0], l0[1], l0[2], l0[3], h0[0], h0[1], h0[2], h0[3]}, o[d0], 0, 0, 0); \
        o[d0] = __builtin_amdgcn_mfma_f32_32x32x16_bf16(pa1, (bf16x8){l1[0], l1[1], l1[2], l1[3], h1[0], h1[1], h1[2], h1[3]}, o[d0], 0, 0, 0); \
        o[d0] = __builtin_amdgcn_mfma_f32_32x32x16_bf16(pa2, (bf16x8){l2[0], l2[1], l2[2], l2[3], h2[0], h2[1], h2[2], h2[3]}, o[d0], 0, 0, 0); \
        o[d0] = __builtin_amdgcn_mfma_f32_32x32x16_bf16(pa3, (bf16x8){l3[0], l3[1], l3[2], l3[3], h3[0], h3[1], h3[2], h3[3]}, o[d0], 0, 0, 0); } while (0)
    __builtin_amdgcn_s_setprio(1); A2_PV_D0(0); A2_PV_D0(1); A2_PV_D0(2); A2_PV_D0(3); __builtin_amdgcn_s_setprio(0);
#undef A2_PV_D0
#undef A2_TRRD
}
__device__ __forceinline__ float rowmax16(const f32x16& p) {
    float pm = p[0];
#pragma unroll
    for (int r = 1; r < 16; ++r) pm = fmaxf(pm, p[r]);
    auto rr = __builtin_amdgcn_permlane32_swap(__float_as_uint(pm), __float_as_uint(pm), false, false);
    return fmaxf(__uint_as_float(rr[0]), __uint_as_float(rr[1]));
}
template <bool DEG>
__device__ __forceinline__ void block(const unsigned short* Q, const unsigned short* K, const unsigned short* V0, const unsigned short* V1, float* O0, float* O1, int P0, char* lds) {
    const int tid = opaque_tid(), wid = __builtin_amdgcn_readfirstlane(tid >> 6), lane = tid & 63, r32 = lane & 31, hi = lane >> 5, rg = wid >> 1, kh = wid & 1, hf = wid >> 2;
    const int NT = P0 / 64 + 2, qlo = P0 + 32 * rg;
    const int sr = tid >> 4, sc = (tid & 15) * 8, kws = A2_KSWZ(sr, sc * 2), vst0 = att::v_st(sr, sc), vst1 = att::v_st(32 + sr, sc);
    char* Vl = lds + V_OFF; char* Kl = lds + K_OFF;
    const int vb0 = (int)(uintptr_t)Vl + att::v_rd_base(lane) + kh * 16384, krow = 32 * kh + r32;
    float* wsl = (float*)(lds + WS_OFF) + wid * 64; float* al_l = wsl; float* li_l = wsl + 32;
    const float* li_p = (const float*)(lds + WS_OFF) + (wid ^ 1) * 64 + 32;
    float* mxw = (float*)(lds + MX_OFF) + wid * 64 + lane; const float* mxr = (const float*)(lds + MX_OFF) + (wid ^ 1) * 64 + lane;
    char* pxw = lds + PX_OFF + ((rg * 4 + 2 * kh) * 64 + lane) * 16; const char* pxr = lds + PX_OFF + (rg * 4 * 64 + lane) * 16;
    bf16x8 qr[8];
#pragma unroll
    for (int d0 = 0; d0 < 8; ++d0) qr[d0] = *reinterpret_cast<const bf16x8*>(Q + (size_t)(32 * rg + r32) * 128 + d0 * 16 + hi * 8);
    bf16x8 sk0, sk1, sv0, sv1, sv2, sv3;
#define A2_LOADK(t) do { const size_t o0_ = (size_t)((DEG ? 0 : (t)) * 64 + sr) * 128 + sc, o1_ = o0_ + 32 * 128; sk0 = *reinterpret_cast<const bf16x8*>(K + o0_); sk1 = *reinterpret_cast<const bf16x8*>(K + o1_); } while (0)
#define A2_LOADV(t) do { const size_t o0_ = (size_t)((DEG ? 0 : (t)) * 64 + sr) * 128 + sc, o1_ = o0_ + 32 * 128; \
        sv0 = *reinterpret_cast<const bf16x8*>(V0 + o0_); sv1 = *reinterpret_cast<const bf16x8*>(V0 + o1_); sv2 = *reinterpret_cast<const bf16x8*>(V1 + o0_); sv3 = *reinterpret_cast<const bf16x8*>(V1 + o1_); } while (0)
#define A2_BAR() do { asm volatile("s_waitcnt lgkmcnt(0)" ::: "memory"); __builtin_amdgcn_s_barrier(); asm volatile("" ::: "memory"); } while (0)
#define A2_WRITEK(b) do { *(bf16x8*)(Kl + (b) * 16384 + kws) = sk0; *(bf16x8*)(Kl + (b) * 16384 + kws + 32 * 256) = sk1; } while (0)
#define A2_WRITEV(b) do { *(bf16x8*)(Vl + (b) * 32768 + vst0) = sv0; *(bf16x8*)(Vl + (b) * 32768 + vst1) = sv1; *(bf16x8*)(Vl + (b) * 32768 + 16384 + vst0) = sv2; *(bf16x8*)(Vl + (b) * 32768 + 16384 + vst1) = sv3; } while (0)
#define A2_VMW(n) asm volatile("s_waitcnt vmcnt(%0)" :: "i"(n) : "memory")
#define A2_MASKMAX(PX, pmX, t) do { const int kb_ = (t) * 64 + 32 * kh; \
        if (kb_ + 31 > qlo) { const int dq_ = qlo + r32 - kb_ - 4 * hi; const float NEG_ = -__builtin_inff(); \
            _Pragma("unroll") for (int r = 0; r < 16; ++r) { const int c_ = (r & 3) + 8 * (r >> 2); if (dq_ - c_ < 0) PX[r] = NEG_; } } \
        pmX = rowmax16(PX); mxw[((t) & 1) * 512] = pmX; } while (0)
#define A2_FINISH(PY, pmY, alY, u) do { const float pm_ = fmaxf(pmY, mxr[((u) & 1) * 512]); float mn_; \
        if (__builtin_expect(__all((pm_ - m_reg) * SCALE <= THR), 1)) { mn_ = m_reg; alY = 1.f; } \
        else { mn_ = fmaxf(m_reg, pm_); alY = __builtin_amdgcn_exp2f((m_reg - mn_) * C2); m_reg = mn_; } \
        const float mnL_ = -mn_ * C2; \
        _Pragma("unroll") for (int r = 0; r < 16; ++r) PY[r] = __builtin_amdgcn_exp2f(fmaf(PY[r], C2, mnL_)); \
        float ps_ = 0.f; _Pragma("unroll") for (int r = 0; r < 16; ++r) ps_ += PY[r]; \
        { auto rr_ = __builtin_amdgcn_permlane32_swap(__float_as_uint(ps_), __float_as_uint(ps_), false, false); ps_ = __uint_as_float(rr_[0]) + __uint_as_float(rr_[1]); } \
        l_reg = l_reg * alY + ps_; \
        A2_PK4(PY, 0, pxw); A2_PK4(PY, 8, pxw + 1024); } while (0)
#define A2_PK4(P, B_, DST) do { unsigned a0_ = att::cvtpk(P[B_ + 0], P[B_ + 1]), a1_ = att::cvtpk(P[B_ + 2], P[B_ + 3]), b0_ = att::cvtpk(P[B_ + 4], P[B_ + 5]), b1_ = att::cvtpk(P[B_ + 6], P[B_ + 7]); \
        auto r0_ = __builtin_amdgcn_permlane32_swap(a0_, b0_, false, false); auto r1_ = __builtin_amdgcn_permlane32_swap(a1_, b1_, false, false); \
        u32x4 w_ = {r0_[0], r1_[0], r0_[1], r1_[1]}; *(u32x4*)(DST) = w_; } while (0)
#define A2_PVSTEP(alY, VOFFB) do { const bf16x8 pa0_ = *reinterpret_cast<const bf16x8*>(pxr), pa1_ = *reinterpret_cast<const bf16x8*>(pxr + 1024), pa2_ = *reinterpret_cast<const bf16x8*>(pxr + 2048), pa3_ = *reinterpret_cast<const bf16x8*>(pxr + 3072); \
        if (__any((alY) < 1.f)) { if (hi == 0) al_l[r32] = (alY); asm volatile("s_waitcnt lgkmcnt(0)" ::: "memory"); \
            _Pragma("unroll") for (int d_ = 0; d_ < 4; ++d_) _Pragma("unroll") for (int r = 0; r < 16; ++r) o[d_][r] *= al_l[att::crow(r, hi)]; } \
        pv<VOFFB>(o, vb0, pa0_, pa1_, pa2_, pa3_); } while (0)
#define A2_STEP(PX, pmX, PY, pmY, alY, t, KB) do { \
        if ((t) + 1 < NT) { A2_VMW(4); A2_WRITEK(1 - KB); if ((t) + 2 < NT) A2_LOADK((t) + 2); } A2_SBAR(); \
        qkt<KB>(PX, Kl, krow, hi, qr); \
        A2_FINISH(PY, pmY, alY, (t) - 1); \
        A2_MASKMAX(PX, pmX, t); \
        A2_BAR(); \
        if ((t) + 2 < NT) A2_VMW(2); else A2_VMW(0); \
        A2_WRITEV(KB); if ((t) + 1 < NT) A2_LOADV((t) + 1); A2_SBAR(); \
        A2_PVSTEP(alY, (1 - KB) * 32768); \
        A2_BAR(); } while (0)
    float m_reg = -1e30f, l_reg = 0.f; f32x16 o[4] = {};
    f32x16 pA, pB; float pmA, pmB, alA = 1.f, alB = 1.f;
    A2_LOADK(0); A2_VMW(0); A2_WRITEK(0); A2_LOADK(1); A2_LOADV(0);
    A2_BAR();
    if (hf == 1) A2_BAR();
    A2_VMW(4); A2_WRITEK(1); if (2 < NT) A2_LOADK(2); A2_SBAR();
    qkt<0>(pA, Kl, krow, hi, qr); A2_SBAR();
    A2_MASKMAX(pA, pmA, 0);
    A2_BAR();
    if (2 < NT) A2_VMW(2); else A2_VMW(0);
    A2_WRITEV(0); A2_LOADV(1);
    A2_BAR();
    A2_STEP(pB, pmB, pA, pmA, alA, 1, 1);
    for (int t = 2; t < NT; t += 2) {
        A2_STEP(pA, pmA, pB, pmB, alB, t, 0);
        A2_STEP(pB, pmB, pA, pmA, alA, t + 1, 1);
    }
    A2_FINISH(pB, pmB, alB, NT - 1);
    A2_BAR();
    A2_PVSTEP(alB, 32768);
    if (hf == 0) A2_BAR();
    if (hi == 0) li_l[r32] = l_reg;
    A2_BAR();
    float rli[16];
#pragma unroll
    for (int r = 0; r < 16; ++r) rli[r] = __builtin_amdgcn_rcpf(li_l[att::crow(r, hi)] + li_p[att::crow(r, hi)]);
    float* Ow = (kh ? O1 : O0) + (size_t)(32 * rg) * 128;
#pragma unroll
    for (int r = 0; r < 16; ++r) { const int orow = att::crow(r, hi);
#pragma unroll
        for (int d0 = 0; d0 < 4; ++d0) Ow[(size_t)orow * 128 + d0 * 32 + r32] = o[d0][r] * rli[r]; }
    A2_BAR();
#undef A2_LOADK
#undef A2_LOADV
#undef A2_BAR
#undef A2_WRITEK
#undef A2_WRITEV
#undef A2_VMW
#undef A2_MASKMAX
#undef A2_FINISH
#undef A2_PK4
#undef A2_PVSTEP
#undef A2_STEP
}
#undef A2_KSWZ
#undef A2_SBAR
}

#ifndef MK_PER_PHASE
#define MK_PER_PHASE 0
#endif
constexpr int NWAVES = 8, NTHR = 512;
constexpr int SEQ = 16384, DM = 4096, FFH = 11008, DEPTH = 4, NMODV = 6 * DM;
#ifndef PADK
#define PADK 64
#endif
constexpr int LDD = DM + PADK, LDF = FFH + PADK;
constexpr int ZG = 96;
constexpr size_t GS = (size_t)SEQ * 128;
constexpr int S5T = 64, S5NC = SEQ / S5T;
constexpr int KSL = 16;
constexpr float NORM_EPS = 1e-6f, SUBLN_EPS = 1e-5f;
constexpr int N_PHASES = 35;

constexpr size_t MiB = 1u << 20;
constexpr size_t WS_CTL = 0, CTL_ZERO_BYTES = 64 * 1024;
constexpr size_t WS_MODP = 1 * MiB;
constexpr size_t WS_MODL = 3 * MiB;
constexpr size_t WS_LAM = 3 * MiB + 512 * 1024;
constexpr size_t WS_S5P = 4 * MiB, S5P_LAYER = 4 * MiB + 256 * 1024;
constexpr size_t S5P_ABR = 0, S5P_ABI = 64 * 1024, S5P_ATR = 128 * 1024, S5P_ATI = 192 * 1024, S5P_BBR = 256 * 1024, S5P_BBI = 256 * 1024 + MiB;
constexpr size_t S5P_BBOP = 256 * 1024 + 2 * MiB, S5P_COP = 256 * 1024 + 3 * MiB;
#ifndef S5_MFMA
#define S5_MFMA 1
#endif
constexpr size_t W_IN_B = (size_t)12288 * LDD * 2, W_OUT_B = (size_t)4096 * LDD * 2, W_GLU_B = (size_t)8192 * LDD * 2, W_GU_B = (size_t)22016 * LDD * 2, W_DN_B = (size_t)4096 * LDF * 2;
constexpr size_t WS_WIN = 16 * MiB, WS_WOUT = WS_WIN + 2 * W_IN_B, WS_WGLU = WS_WOUT + 2 * W_OUT_B, WS_WGU = WS_WGLU + 2 * W_GLU_B, WS_WDN = WS_WGU + 4 * W_GU_B;
constexpr size_t WS_H = WS_WDN + 4 * W_DN_B;
constexpr size_t WS_MIX = WS_H + (size_t)SEQ * LDD * 2;
constexpr size_t WS_Z = WS_MIX + (size_t)SEQ * LDD * 2;
constexpr size_t WS_OT = WS_Z + (size_t)ZG * GS * 2;
constexpr size_t WS_S5F = WS_OT + (size_t)32 * GS * 4;
constexpr size_t WS_S5H = WS_S5F + (size_t)S5NC * 256 * 128 * 4;
constexpr size_t WS_END = WS_S5H + (size_t)S5NC * 256 * 128 * 4;
static_assert((size_t)SEQ * LDF * 2 <= (size_t)ZG * GS * 2, "hidden overlays Z");
static_assert(WS_WIN % 256 == 0 && WS_H % 256 == 0 && WS_OT % 256 == 0 && WS_S5F % 256 == 0, "alignment");
constexpr int CW_BAR = 1024;

constexpr int RING_BYTES = 131072, MISC_OFF = RING_BYTES + 320, LDS_BYTES = 147456;

#define GAS __attribute__((address_space(1)))
#define LAS __attribute__((address_space(3)))
typedef unsigned short bf16;
typedef unsigned v4u __attribute__((ext_vector_type(4)));
typedef unsigned v2u __attribute__((ext_vector_type(2)));
typedef float f32x4 __attribute__((ext_vector_type(4)));
#define LDS_WAIT() asm volatile("s_waitcnt lgkmcnt(0)" ::: "memory")
#define VM_WAIT() asm volatile("s_waitcnt vmcnt(0)" ::: "memory")
__device__ __forceinline__ unsigned pk2(float lo, float hi) { unsigned r; asm volatile("v_cvt_pk_bf16_f32 %0, %1, %2" : "=v"(r) : "v"(lo), "v"(hi)); return r; }
__device__ __forceinline__ float bflo(unsigned w) { return __builtin_bit_cast(float, w << 16); }
__device__ __forceinline__ float bfhi(unsigned w) { return __builtin_bit_cast(float, w & 0xffff0000u); }

#define XB_TMO      128
#define XB_XCNT(j)  (256  + 64 * (j))
#define XB_XSUB(j)  (1280 + 64 * (j))
#define XB_XGEN(j)  (2304 + 64 * (j))
#define XB_TOP      3328
#define XB_TOPGEN   3392
#define XCD_BAR_WORDS 3456
#define XB_SPIN_CAP (1u << 22)

__device__ __forceinline__ unsigned xb_ld(unsigned* p)              { return __hip_atomic_load(p, __ATOMIC_RELAXED, __HIP_MEMORY_SCOPE_AGENT); }
__device__ __forceinline__ unsigned xb_add(unsigned* p, unsigned v) { return __hip_atomic_fetch_add(p, v, __ATOMIC_RELAXED, __HIP_MEMORY_SCOPE_AGENT); }
__device__ __forceinline__ unsigned xb_xcc_id() { return (unsigned)__builtin_amdgcn_s_getreg((3 << 11) | 20) & 0xFu; }
#define XB_SPIN(cond, bar) do { unsigned _sp = 0; while (cond) { __builtin_amdgcn_s_sleep(1); \
    if ((++_sp & 255u) == 0u) { if (xb_ld(&(bar)[XB_TMO])) break; if (_sp > XB_SPIN_CAP) { atomicAdd(&(bar)[XB_TMO], 1u); break; } } } } while (0)

struct XcdBarrier {
    unsigned* bar; unsigned x;
    volatile LAS unsigned* st;
};
__device__ __forceinline__ XcdBarrier xcd_barrier_post(unsigned* bar, volatile LAS unsigned* st) {
    XcdBarrier b; b.bar = bar; b.x = xb_xcc_id(); b.st = st;
    if (threadIdx.x == 0) (void)xb_add(&bar[XB_XCNT(b.x)], 1u);
    return b;
}
__device__ __forceinline__ void xcd_barrier_complete(unsigned* bar, unsigned x, unsigned& nloc, unsigned& nx) {
    const unsigned G = gridDim.x * gridDim.y * gridDim.z;
    unsigned sum, cnt, mine, sp = 0u;
    for (;;) {
        sum = 0u; cnt = 0u; mine = 0u;
#pragma unroll
        for (unsigned j = 0; j < 16; ++j) { const unsigned c = xb_ld(&bar[XB_XCNT(j)]); sum += c; cnt += (c > 0u) ? 1u : 0u; mine = (j == x) ? c : mine; }
        if (sum == G) break;
        __builtin_amdgcn_s_sleep(1);
        if ((++sp & 255u) == 0u) { if (xb_ld(&bar[XB_TMO])) break; if (sp > XB_SPIN_CAP) { atomicAdd(&bar[XB_TMO], 1u); break; } }
    }
    nloc = mine > 0u ? mine : 1u; nx = cnt > 0u ? cnt : 1u;
}
__device__ __forceinline__ void xcd_barrier(const XcdBarrier& b) {
    asm volatile("s_waitcnt vmcnt(0)" ::: "memory");
    __syncthreads();
    if (threadIdx.x == 0) {
        unsigned* bar = b.bar;
        __builtin_amdgcn_s_waitcnt(0);
        unsigned nloc = b.st[0], nx = b.st[1];
        if (nloc == 0u) { xcd_barrier_complete(bar, b.x, nloc, nx); b.st[0] = nloc; b.st[1] = nx; }
        const unsigned old = xb_add(&bar[XB_XSUB(b.x)], 1u);
        const unsigned gen = old / nloc;
        if (old + 1u == (gen + 1u) * nloc) {
            __builtin_amdgcn_fence(__ATOMIC_RELEASE, "agent");
            asm volatile("s_waitcnt vmcnt(0)" ::: "memory");
            const unsigned og = xb_add(&bar[XB_TOP], 1u);
            const unsigned tg = og / nx;
            if (og + 1u == (tg + 1u) * nx) xb_add(&bar[XB_TOPGEN], 1u);
            else XB_SPIN(xb_ld(&bar[XB_TOPGEN]) == tg, bar);
            __builtin_amdgcn_fence(__ATOMIC_ACQUIRE, "agent");
            xb_add(&bar[XB_XGEN(b.x)], 1u);
            asm volatile("s_waitcnt vmcnt(0)" ::: "memory");
        } else {
            XB_SPIN(xb_ld(&bar[XB_XGEN(b.x)]) == gen, bar);
            __builtin_amdgcn_fence(__ATOMIC_ACQUIRE, "agent");
            asm volatile("s_waitcnt vmcnt(0)" ::: "memory");
        }
    }
    __syncthreads();
}

__device__ __forceinline__ float wave_sum(float v) {
#pragma unroll
    for (int o = 1; o < 64; o <<= 1) v += __shfl_xor(v, o);
    return v;
}

__device__ __forceinline__ void transpose_item(const float* W, int K, int N, bf16* WT, int ldw, int mode, LAS float* scr, int item, int lane) {
    const int nblk = N / 32, kb = item / nblk, nb = item - kb * nblk, k0 = 64 * kb, n0 = 32 * nb;
    const int drow0 = mode == 0 ? n0 : ((n0 >> 7) * 256 + (n0 & 127) + (mode == 2 ? 128 : 0));
#pragma unroll 8
    for (int i = 0; i < 32; ++i) { const int kk = 2 * i + (lane >> 5); scr[kk * 33 + (lane & 31)] = W[(size_t)(k0 + kk) * N + n0 + (lane & 31)]; }
    LDS_WAIT(); asm volatile("" ::: "memory");
    const int c = lane & 7;
#pragma unroll
    for (int j = 0; j < 4; ++j) { const int n = (lane >> 3) + 8 * j; const LAS float* s = scr + (8 * c) * 33 + n;
        v4u o; o.x = pk2(s[0 * 33], s[1 * 33]); o.y = pk2(s[2 * 33], s[3 * 33]); o.z = pk2(s[4 * 33], s[5 * 33]); o.w = pk2(s[6 * 33], s[7 * 33]);
        *(v4u*)(WT + (size_t)(drow0 + n) * ldw + k0 + 8 * c) = o; }
    LDS_WAIT(); asm volatile("" ::: "memory");
}
__device__ __forceinline__ void dsincos(double x, double& s, double& c) {
    const double k = rint(x * 0.63661977236758134308);
    double r = fma(-k, 1.5707963267948966192, x); r = fma(-k, 6.1232339957367658860e-17, r);
    const double r2 = r * r;
    double ps = -1.0 / 1307674368000.0; ps = fma(ps, r2, 1.0 / 6227020800.0); ps = fma(ps, r2, -1.0 / 39916800.0); ps = fma(ps, r2, 1.0 / 362880.0); ps = fma(ps, r2, -1.0 / 5040.0);
    ps = fma(ps, r2, 1.0 / 120.0); ps = fma(ps, r2, -1.0 / 6.0); ps = fma(ps, r2, 1.0); const double sn = r * ps;
    double pc = 1.0 / 20922789888000.0; pc = fma(pc, r2, -1.0 / 87178291200.0); pc = fma(pc, r2, 1.0 / 479001600.0); pc = fma(pc, r2, -1.0 / 3628800.0); pc = fma(pc, r2, 1.0 / 40320.0);
    pc = fma(pc, r2, -1.0 / 720.0); pc = fma(pc, r2, 1.0 / 24.0); pc = fma(pc, r2, -0.5); const double cs = fma(pc, r2, 1.0);
    const int q = (int)k & 3;
    s = (q == 0) ? sn : (q == 1) ? cs : (q == 2) ? -sn : -cs;
    c = (q == 0) ? cs : (q == 1) ? -sn : (q == 2) ? -cs : sn;
}
__device__ __forceinline__ double dexp(double x) {
    const double k = rint(x * 1.4426950408889634074);
    double r = fma(-k, 0.69314718055994528623, x); r = fma(-k, 2.3190468138462995584e-17, r);
    double p = 1.0 / 87178291200.0; p = fma(p, r, 1.0 / 6227020800.0); p = fma(p, r, 1.0 / 479001600.0); p = fma(p, r, 1.0 / 39916800.0); p = fma(p, r, 1.0 / 3628800.0); p = fma(p, r, 1.0 / 362880.0);
    p = fma(p, r, 1.0 / 40320.0); p = fma(p, r, 1.0 / 5040.0); p = fma(p, r, 1.0 / 720.0); p = fma(p, r, 1.0 / 120.0); p = fma(p, r, 1.0 / 24.0); p = fma(p, r, 1.0 / 6.0); p = fma(p, r, 0.5); p = fma(p, r, 1.0); p = fma(p, r, 1.0);
    const long long bits = (long long)(1023 + (int)k) << 52;
    return p * __builtin_bit_cast(double, bits);
}

struct Args { const float* in[29]; float* out; unsigned char* ws; int ph_lo, ph_hi; };

__device__ __forceinline__ void p0_prologue(const Args& A, LAS unsigned char* lds, int gw, int NGW, int wave, int lane) {
    unsigned char* ws = A.ws;
    for (int w = gw; w < 96 * KSL + 512 + 2048; w += NGW) {
    if (w >= 96 * KSL + 512) {
        const int idx = (w - 96 * KSL - 512) * 64 + lane, o = idx >> 16, r = idx & 65535, g = r >> 8, mm = (r >> 6) & 3, o16 = lane & 15, kq = lane >> 4;
        const int tau = 2 * mm, p0 = 16 * (tau & 3) + 4 * kq;
        const float* cs = (tau < 4 ? A.in[21] : A.in[22]) + (size_t)o * 256 * 16 * 64 + (size_t)(g * 16 + o16) * 64 + p0; const float sg = tau < 4 ? 1.0f : -1.0f;
        const f32x4 a = *(const f32x4*)cs * sg, b = *(const f32x4*)(cs + 16) * sg;
        v4u q; q.x = pk2(a.x, a.y); q.y = pk2(a.z, a.w); q.z = pk2(b.x, b.y); q.w = pk2(b.z, b.w);
        *(v4u*)(ws + WS_S5P + (size_t)o * S5P_LAYER + S5P_COP + ((size_t)((g * 4 + mm) * 64 + lane)) * 16) = q;
    } else if (w < 96 * KSL) {
        const int nb = w % 96, ks = w / 96;
        const float* wp = A.in[2] + (size_t)(ks * 256) * NMODV + nb * 256 + lane * 4; const float* cp = A.in[1] + ks * 256;
        f32x4 a = {0.f, 0.f, 0.f, 0.f};
#pragma unroll 8
        for (int k = 0; k < 256; ++k) { const float cv = cp[k]; const float s = cv / (1.0f + expf(-cv)); const f32x4 w = *(const f32x4*)(wp + (size_t)k * NMODV); a += s * w; }
        *(f32x4*)((float*)(ws + WS_MODP) + (size_t)ks * NMODV + nb * 256 + lane * 4) = a;
    } else {
        const int idx = (w - 96 * KSL) * 64 + lane, o = idx >> 14, gp = idx & 16383, g = gp >> 6;
        const double lr = (double)fminf(A.in[16][idx], -1e-4f), li = (double)A.in[17][idx], dt = dexp((double)A.in[18][o * 256 + g]);
        const double mag = dexp(lr * dt); double sn, cs; dsincos(li * dt, sn, cs);
        const double abr = mag * cs, abi = mag * sn, den = lr * lr + li * li, nr = abr - 1.0, ni = abi;
        const double fre = (nr * lr + ni * li) / den, fim = (ni * lr - nr * li) / den;
        double tr = abr, ti = abi;
#pragma unroll
        for (int q = 0; q < 6; ++q) { const double t2 = tr * tr - ti * ti; ti = 2.0 * tr * ti; tr = t2; }
        unsigned char* pb = ws + WS_S5P + (size_t)o * S5P_LAYER;
        ((float*)(pb + S5P_ABR))[gp] = (float)abr; ((float*)(pb + S5P_ABI))[gp] = (float)abi; ((float*)(pb + S5P_ATR))[gp] = (float)tr; ((float*)(pb + S5P_ATI))[gp] = (float)ti;
        const float* bre = A.in[19] + (size_t)idx * 16; const float* bim = A.in[20] + (size_t)idx * 16;
        float* obr = (float*)(pb + S5P_BBR) + (size_t)gp * 16; float* obi = (float*)(pb + S5P_BBI) + (size_t)gp * 16;
#pragma unroll
        for (int h4 = 0; h4 < 4; ++h4) { const f32x4 br = *(const f32x4*)(bre + 4 * h4), bi = *(const f32x4*)(bim + 4 * h4); f32x4 r, i;
#pragma unroll
            for (int j = 0; j < 4; ++j) { r[j] = (float)(fre * (double)br[j] - fim * (double)bi[j]); i[j] = (float)(fre * (double)bi[j] + fim * (double)br[j]); }
            *(f32x4*)(obr + 4 * h4) = r; *(f32x4*)(obi + 4 * h4) = i; }
        { const int p = gp & 63, ti = p >> 4, i16 = p & 15;
#pragma unroll
          for (int kq = 0; kq < 4; ++kq) { const f32x4 r = *(const f32x4*)(obr + 4 * kq), i = *(const f32x4*)(obi + 4 * kq);
              v2u pr, pi; pr.x = pk2(r.x, r.y); pr.y = pk2(r.z, r.w); pi.x = pk2(i.x, i.y); pi.y = pk2(i.z, i.w);
              *(v2u*)(pb + S5P_BBOP + ((size_t)((g * 8 + ti) * 64 + kq * 16 + i16)) * 8) = pr; *(v2u*)(pb + S5P_BBOP + ((size_t)((g * 8 + 4 + ti) * 64 + kq * 16 + i16)) * 8) = pi; } }
    }
    }
    if (gw < 2) { const int e = gw;
        const float s1 = wave_sum(A.in[10][e * 128 + lane] * A.in[11][e * 128 + lane] + A.in[10][e * 128 + 64 + lane] * A.in[11][e * 128 + 64 + lane]);
        const float s2 = wave_sum(A.in[12][e * 128 + lane] * A.in[13][e * 128 + lane] + A.in[12][e * 128 + 64 + lane] * A.in[13][e * 128 + 64 + lane]);
        const float lam_init = e == 0 ? 0.2f : 0.4707130183435842f;
        if (lane == 0) ((float*)(ws + WS_LAM))[e] = expf(s1) - expf(s2) + lam_init; }
    LAS float* scr = (LAS float*)(lds + wave * 16384);
    constexpr int I_IN = 64 * 384, I_OUT = 64 * 128, I_GLU = 64 * 128, I_GU = 64 * 344, I_DN = 172 * 128;
    constexpr int NITEMS = 2 * I_IN + 2 * I_OUT + 4 * I_GLU + 8 * I_GU + 4 * I_DN;
    for (int it = gw; it < NITEMS; it += NGW) {
        int r = it;
        if (r < 2 * I_IN) { const int e = r / I_IN; transpose_item(A.in[8] + (size_t)e * DM * 12288, DM, 12288, (bf16*)(ws + WS_WIN + e * W_IN_B), LDD, 0, scr, r - e * I_IN, lane); continue; } r -= 2 * I_IN;
        if (r < 2 * I_OUT) { const int e = r / I_OUT; transpose_item(A.in[15] + (size_t)e * DM * DM, DM, DM, (bf16*)(ws + WS_WOUT + e * W_OUT_B), LDD, 0, scr, r - e * I_OUT, lane); continue; } r -= 2 * I_OUT;
        if (r < 4 * I_GLU) { const int q = r / I_GLU, o = q >> 1, s = q & 1; transpose_item(A.in[24 + s] + (size_t)o * DM * DM, DM, DM, (bf16*)(ws + WS_WGLU + o * W_GLU_B), LDD, 1 + s, scr, r - q * I_GLU, lane); continue; } r -= 4 * I_GLU;
        if (r < 8 * I_GU) { const int q = r / I_GU, l = q >> 1, s = q & 1; transpose_item(A.in[26 + s] + (size_t)l * DM * FFH, DM, FFH, (bf16*)(ws + WS_WGU + l * W_GU_B), LDD, 1 + s, scr, r - q * I_GU, lane); continue; } r -= 8 * I_GU;
        { const int l = r / I_DN; transpose_item(A.in[28] + (size_t)l * FFH * DM, FFH, DM, (bf16*)(ws + WS_WDN + l * W_DN_B), LDF, 0, scr, r - l * I_DN, lane); }
    }
}
__device__ __forceinline__ void p1_modvec(const Args& A, int gtid, int NGT) {
    const float* mp = (const float*)(A.ws + WS_MODP); float* ml = (float*)(A.ws + WS_MODL);
    for (int i = gtid; i < DEPTH * NMODV; i += NGT) { const int j = i % NMODV; float v = A.in[3][j] + A.in[4][i];
#pragma unroll
        for (int ks = 0; ks < KSL; ++ks) v += mp[(size_t)ks * NMODV + j];
        ml[i] = v; }
}
__device__ __forceinline__ void norm_mod_phase(const float* src, const float* nw, const float* sh, const float* sc, bf16* dst, LAS unsigned char* lds, int tid, int gw, int NGW, int lane) {
    LAS float* w1 = (LAS float*)lds; LAS float* bb = w1 + DM;
    for (int i = tid; i < DM; i += NTHR) { w1[i] = nw[i] * (1.0f + sc[i]); bb[i] = sh[i]; }
    __syncthreads();
    for (int m = gw; m < SEQ; m += NGW) {
        const f32x4* xr = (const f32x4*)(src + (size_t)m * DM) + lane;
        f32x4 v[16]; float ss = 0.f;
#pragma unroll
        for (int j = 0; j < 16; ++j) { v[j] = xr[64 * j]; ss += (v[j].x * v[j].x + v[j].y * v[j].y) + (v[j].z * v[j].z + v[j].w * v[j].w); }
        const float rstd = 1.0f / sqrtf(wave_sum(ss) * (1.0f / DM) + NORM_EPS);
        v2u* o8 = (v2u*)(dst + (size_t)m * LDD) + lane;
#pragma unroll
        for (int j = 0; j < 16; ++j) { const int col = j * 256 + lane * 4; const f32x4 w = *(const LAS f32x4*)(w1 + col), b = *(const LAS f32x4*)(bb + col);
            const f32x4 y = v[j] * rstd * w + b; v2u p; p.x = pk2(y.x, y.y); p.y = pk2(y.z, y.w); o8[64 * j] = p; }
    }
    __syncthreads();
}
__device__ __forceinline__ void final_norm_phase(const float* src, const float* nw, float* dst, int gw, int NGW, int lane) {
    for (int m = gw; m < SEQ; m += NGW) {
        const f32x4* xr = (const f32x4*)(src + (size_t)m * DM) + lane;
        f32x4 v[16]; float ss = 0.f;
#pragma unroll
        for (int j = 0; j < 16; ++j) { v[j] = xr[64 * j]; ss += (v[j].x * v[j].x + v[j].y * v[j].y) + (v[j].z * v[j].z + v[j].w * v[j].w); }
        const float rstd = 1.0f / sqrtf(wave_sum(ss) * (1.0f / DM) + NORM_EPS);
        f32x4* o = (f32x4*)(dst + (size_t)m * DM) + lane; const f32x4* wv = (const f32x4*)nw + lane;
#pragma unroll
        for (int j = 0; j < 16; ++j) o[64 * j] = v[j] * rstd * wv[64 * j];
    }
}
__device__ __forceinline__ void conv_phase(const bf16* Z, const float* cw, bf16* MIX, int gtid, int NGT) {
    for (int i = gtid; i < SEQ * 256; i += NGT) {
        const int t = i >> 8, r = i & 255, gi = r >> 4, c8 = (r & 15) * 8;
        const size_t o = (size_t)t * 128 + c8;
        const v4u zero = {0u, 0u, 0u, 0u};
        const v4u vb = *(const v4u*)(Z + (size_t)gi * GS + o);
        const bf16* zc = Z + (size_t)(16 + gi) * GS + o; const bf16* zx = Z + (size_t)(32 + gi) * GS + o;
        const v4u c0 = *(const v4u*)zc, x0 = *(const v4u*)zx;
        const v4u c1 = t >= 1 ? *(const v4u*)(zc - 128) : zero, x1 = t >= 1 ? *(const v4u*)(zx - 128) : zero;
        const v4u c2 = t >= 2 ? *(const v4u*)(zc - 256) : zero, x2 = t >= 2 ? *(const v4u*)(zx - 256) : zero;
        const float* wp = cw + gi * 128 + c8;
        float y[8];
#pragma unroll
        for (int q = 0; q < 4; ++q) {
            const float u0l = bflo(c0[q]) * bflo(x0[q]), u0h = bfhi(c0[q]) * bfhi(x0[q]);
            const float u1l = bflo(c1[q]) * bflo(x1[q]), u1h = bfhi(c1[q]) * bfhi(x1[q]);
            const float u2l = bflo(c2[q]) * bflo(x2[q]), u2h = bfhi(c2[q]) * bfhi(x2[q]);
            const int j = 2 * q;
            y[j]     = bflo(vb[q]) * (wp[2 * 2048 + j] * u0l + wp[2048 + j] * u1l + wp[j] * u2l);
            y[j + 1] = bfhi(vb[q]) * (wp[2 * 2048 + j + 1] * u0h + wp[2048 + j + 1] * u1h + wp[j + 1] * u2h);
        }
        v4u w; w.x = pk2(y[0], y[1]); w.y = pk2(y[2], y[3]); w.z = pk2(y[4], y[5]); w.w = pk2(y[6], y[7]);
        *(v4u*)(MIX + (size_t)t * LDD + gi * 128 + c8) = w;
    }
}
__device__ __forceinline__ void combine_phase(const float* OT, const float* lamp, const float* sg, float lam_init, bf16* MIX, int gw, int NGW, int lane) {
    const float lam = lamp[0], os = 1.0f - lam_init;
    const int j = lane >> 5, c4 = (lane & 31) * 4;
    const f32x4 gv = *(const f32x4*)(sg + 128 * j + c4);
    for (int it = gw; it < SEQ * 8; it += NGW) {
        const int t = it >> 3, h = it & 7;
        const f32x4 a = *(const f32x4*)(OT + (size_t)(h * 4 + j) * GS + (size_t)t * 128 + c4), b = *(const f32x4*)(OT + (size_t)(h * 4 + 2 + j) * GS + (size_t)t * 128 + c4);
        const f32x4 o = a - lam * b;
        const float rstd = 1.0f / sqrtf(wave_sum((o.x * o.x + o.y * o.y) + (o.z * o.z + o.w * o.w)) * (1.0f / 256.0f) + SUBLN_EPS);
        const f32x4 y = o * (rstd * os) * gv;
        v2u p; p.x = pk2(y.x, y.y); p.y = pk2(y.z, y.w);
        *(v2u*)(MIX + (size_t)t * LDD + 2048 + 256 * h + 128 * j + c4) = p;
    }
}
__device__ __forceinline__ att::BlockRef<att::bf16, float> att_ref(const bf16* Z, float* OT, int item, int pass) {
    const int r = item >> 8, b = item & 255, vh = r * 8 + (b & 7), pair = b >> 3, qb = pass ? 63 - pair : pair;
    const int h = vh >> 2, m = (vh >> 1) & 1, j = vh & 1;
    att::BlockRef<att::bf16, float> R;
    R.Q = (const att::bf16*)(Z + (size_t)(48 + 2 * h + m) * GS + (size_t)qb * 256 * 128);
    R.K = (const att::bf16*)(Z + (size_t)(64 + 2 * h + m) * GS);
    R.V = (const att::bf16*)(Z + (size_t)(80 + 2 * h + j) * GS);
    R.O = OT + (size_t)vh * GS + (size_t)qb * 256 * 128; R.P0 = qb * 256;
    return R;
}
__device__ __forceinline__ void attn_phase(const bf16* Z, float* OT, char* lds, int bid, int G) {
    constexpr int TOTAL = 1024;
    int item = bid; if (item >= TOTAL) return;
    int pass = 0;
    att::BlockRef<att::bf16, float> cur = att_ref(Z, OT, item, 0);
    att::Seam<att::bf16> S;
    att::causal_swa_prime<att::bf16, float>(cur, SEQ, lds, S);
    for (;;) {
        const bool more_pass = pass == 0, more_item = item + G < TOTAL, last = !more_pass && !more_item;
        int itn = item, passn = 1;
        if (!more_pass) { passn = 0; itn = more_item ? item + G : item; }
        const att::BlockRef<att::bf16, float> nxt = last ? cur : att_ref(Z, OT, itn, passn);
        att::causal_swa_block<att::bf16, float>(cur, nxt, SEQ, SEQ, lds, S);
        if (last) break;
        cur = nxt; item = itn; pass = passn;
    }
}
#ifndef ATT2
#define ATT2 1
#endif
template <bool DEG>
__device__ __forceinline__ void attn2_phase(const bf16* Z, float* OT, char* lds, int bid, int G) {
    for (int item = bid; item < 1024; item += G) {
        const int r = item >> 8, b = item & 255, hm = 2 * (b & 7) + (r >> 1), pair = (r & 1) * 32 + (b >> 3), h = hm >> 1, m = hm & 1;
        for (int pass = 0; pass < 2; ++pass) { const int qb = pass ? 127 - pair : pair;
            att2::block<DEG>(Z + (size_t)(48 + 2 * h + m) * GS + (size_t)qb * 128 * 128, Z + (size_t)(64 + 2 * h + m) * GS, Z + (size_t)(80 + 2 * h) * GS, Z + (size_t)(81 + 2 * h) * GS,
                        OT + (size_t)(h * 4 + m * 2) * GS + (size_t)qb * 128 * 128, OT + (size_t)(h * 4 + m * 2 + 1) * GS + (size_t)qb * 128 * 128, qb * 128, lds); }
    }
}
__device__ __forceinline__ float gelu_tanh(float x) { const float z = 1.5957691216057308f * (x + 0.044715f * x * x * x); return x * __builtin_amdgcn_rcpf(1.0f + __builtin_amdgcn_exp2f(-1.4426950408889634f * z)); }
template <bool PASS2>
__device__ __forceinline__ void s5_pass(const bf16* Hin, const unsigned char* prm, const float* c_re, const float* c_im, const float* dsk, float* F, const float* HC, bf16* Gout,
                                        LAS unsigned char* lds, int gw, int NGW, int wave, int lane) {
    LAS float* lu = (LAS float*)(lds + wave * 4096);
    for (int item = gw; item < 256 * S5NC; item += NGW) {
        const int g = item & 255, c = item >> 8, gp = g * 64 + lane;
        { const bf16* up = Hin + (size_t)(c * S5T + lane) * LDD + 16 * g; const v4u a = *(const v4u*)up, b = *(const v4u*)(up + 8);
          LAS f32x4* ur = (LAS f32x4*)(lu + lane * 16);
          ur[0] = (f32x4){bflo(a.x), bfhi(a.x), bflo(a.y), bfhi(a.y)}; ur[1] = (f32x4){bflo(a.z), bfhi(a.z), bflo(a.w), bfhi(a.w)};
          ur[2] = (f32x4){bflo(b.x), bfhi(b.x), bflo(b.y), bfhi(b.y)}; ur[3] = (f32x4){bflo(b.z), bfhi(b.z), bflo(b.w), bfhi(b.w)}; }
        f32x4 bbr[4], bbi[4];
#pragma unroll
        for (int q = 0; q < 4; ++q) { bbr[q] = *(const f32x4*)((const float*)(prm + S5P_BBR) + (size_t)gp * 16 + 4 * q); bbi[q] = *(const f32x4*)((const float*)(prm + S5P_BBI) + (size_t)gp * 16 + 4 * q); }
        const float abr = ((const float*)(prm + S5P_ABR))[gp], abi = ((const float*)(prm + S5P_ABI))[gp];
        float hr = 0.f, hi = 0.f, cr[16], ci[16], dk = 0.f;
        if (PASS2) {
#pragma unroll
            for (int o = 0; o < 16; ++o) { cr[o] = c_re[(size_t)(g * 16 + o) * 64 + lane]; ci[o] = c_im[(size_t)(g * 16 + o) * 64 + lane]; }
            hr = HC[(size_t)(c * 256 + g) * 128 + lane]; hi = HC[(size_t)(c * 256 + g) * 128 + 64 + lane]; dk = dsk[16 * g + (lane >> 2)];
        }
        LDS_WAIT(); asm volatile("" ::: "memory");
#pragma unroll 2
        for (int t = 0; t < S5T; ++t) {
            const LAS f32x4* ut = (const LAS f32x4*)(lu + t * 16);
            float bur = 0.f, bui = 0.f;
#pragma unroll
            for (int q = 0; q < 4; ++q) { const f32x4 u = ut[q];
                bur += (bbr[q].x * u.x + bbr[q].y * u.y) + (bbr[q].z * u.z + bbr[q].w * u.w); bui += (bbi[q].x * u.x + bbi[q].y * u.y) + (bbi[q].z * u.z + bbi[q].w * u.w); }
            const float nr = abr * hr - abi * hi + bur, ni = abr * hi + abi * hr + bui; hr = nr; hi = ni;
            if (PASS2) {
                float v[16];
#pragma unroll
                for (int o = 0; o < 16; ++o) v[o] = hr * cr[o] - hi * ci[o];
#pragma unroll
                for (int i = 0; i < 8; ++i) { const float send = (lane & 32) ? v[i] : v[i + 8], keep = (lane & 32) ? v[i + 8] : v[i]; v[i] = keep + __shfl_xor(send, 32); }
#pragma unroll
                for (int i = 0; i < 4; ++i) { const float send = (lane & 16) ? v[i] : v[i + 4], keep = (lane & 16) ? v[i + 4] : v[i]; v[i] = keep + __shfl_xor(send, 16); }
#pragma unroll
                for (int i = 0; i < 2; ++i) { const float send = (lane & 8) ? v[i] : v[i + 2], keep = (lane & 8) ? v[i + 2] : v[i]; v[i] = keep + __shfl_xor(send, 8); }
                { const float send = (lane & 4) ? v[0] : v[1], keep = (lane & 4) ? v[1] : v[0]; v[0] = keep + __shfl_xor(send, 4); }
                v[0] += __shfl_xor(v[0], 2); v[0] += __shfl_xor(v[0], 1);
                const float yy = v[0] + dk * lu[t * 16 + (lane >> 2)];
                const float gl = gelu_tanh(yy);
                if ((lane & 3) == 0) Gout[(size_t)(c * S5T + t) * LDD + 16 * g + (lane >> 2)] = (bf16)(pk2(gl, gl) & 0xffffu);
            }
        }
        if (!PASS2) { F[(size_t)(c * 256 + g) * 128 + lane] = hr; F[(size_t)(c * 256 + g) * 128 + 64 + lane] = hi; }
        LDS_WAIT(); asm volatile("" ::: "memory");
    }
}

constexpr int S5TS = 8, S5SB = S5TS * 256 + 16;
typedef short s5_bf16x8 __attribute__((ext_vector_type(8)));
template <bool PASS2>
__device__ __forceinline__ void s5m_pass(const bf16* Hin, const unsigned char* prm, const float* dsk, float* F, const float* HC, bf16* Gout, LAS unsigned char* lds, int bid, int G) {
    const int tid = opaque_tid(), lane = tid & 63, w = __builtin_amdgcn_readfirstlane(tid >> 6), j = lane & 15, rq = lane >> 4;
    const int rowslot = tid >> 4, piece = tid & 15;
    constexpr int NST = S5T / S5TS, NQ = 16 * S5TS / 32;
    for (int unit = bid; unit < 32 * (S5NC / 16); unit += G) {
        const int gb = unit & 31, cs = unit >> 5, g = gb * 8 + w;
        v2u bb[8];
#pragma unroll
        for (int t8 = 0; t8 < 8; ++t8) bb[t8] = *(const v2u*)(prm + S5P_BBOP + ((size_t)((g * 8 + t8) * 64 + lane)) * 8);
        v4u cop[4];
        f32x4 ar[4], ai[4], sr[4], si[4], dk = {0.f, 0.f, 0.f, 0.f};
#pragma unroll
        for (int q = 0; q < 4; ++q) { ar[q] = *(const f32x4*)((const float*)(prm + S5P_ABR) + g * 64 + 16 * q + 4 * rq); ai[q] = *(const f32x4*)((const float*)(prm + S5P_ABI) + g * 64 + 16 * q + 4 * rq); }
        if (PASS2) {
#pragma unroll
            for (int mm = 0; mm < 4; ++mm) cop[mm] = *(const v4u*)(prm + S5P_COP + ((size_t)((g * 4 + mm) * 64 + lane)) * 16);
            const float* hc = HC + ((size_t)(cs * 16 + j) * 256 + g) * 128 + 4 * rq;
#pragma unroll
            for (int q = 0; q < 4; ++q) { sr[q] = *(const f32x4*)(hc + 16 * q); si[q] = *(const f32x4*)(hc + 64 + 16 * q); }
            dk = *(const f32x4*)(dsk + 16 * g + 4 * rq);
        } else {
#pragma unroll
            for (int q = 0; q < 4; ++q) { sr[q] = (f32x4){0.f, 0.f, 0.f, 0.f}; si[q] = (f32x4){0.f, 0.f, 0.f, 0.f}; }
        }
        const bf16* src = Hin + (size_t)(cs * 16 * S5T) * LDD + gb * 128 + piece * 8;
        bf16* dstp = PASS2 ? Gout + (size_t)(cs * 16 * S5T) * LDD + gb * 128 + piece * 8 : nullptr;
        v4u pre[NQ];
#pragma unroll
        for (int q = 0; q < NQ; ++q) { const int ri = q * 32 + rowslot, jj = ri / S5TS, tt = ri % S5TS; pre[q] = *(const v4u*)(src + (size_t)(jj * S5T + tt) * LDD); }
        for (int s = 0; s < NST; ++s) {
#pragma unroll
            for (int q = 0; q < NQ; ++q) { const int ri = q * 32 + rowslot, jj = ri / S5TS, tt = ri % S5TS; LAS v4u* lp = (LAS v4u*)(lds + jj * S5SB + tt * 256 + piece * 16);
                if (PASS2 && s > 0) { const v4u y = *lp; *(v4u*)(dstp + (size_t)(jj * S5T + (s - 1) * S5TS + tt) * LDD) = y; }
                *lp = pre[q]; }
            if (s + 1 < NST) {
#pragma unroll
                for (int q = 0; q < NQ; ++q) { const int ri = q * 32 + rowslot, jj = ri / S5TS, tt = ri % S5TS; pre[q] = *(const v4u*)(src + (size_t)(jj * S5T + (s + 1) * S5TS + tt) * LDD); } }
            LDS_WAIT(); __syncthreads();
            LAS unsigned char* up = lds + j * S5SB + w * 32 + rq * 8;
            v2u uu[S5TS];
#pragma unroll
            for (int tt = 0; tt < S5TS; ++tt) uu[tt] = *(const LAS v2u*)(up + tt * 256);
#pragma unroll
            for (int tt = 0; tt < S5TS; ++tt) {
                v4u ub; ub.x = uu[tt].x; ub.y = uu[tt].y; ub.z = 0u; ub.w = 0u;
                const s5_bf16x8 U = __builtin_bit_cast(s5_bf16x8, ub);
#pragma unroll
                for (int q = 0; q < 4; ++q) {
                    const f32x4 tr = ar[q] * sr[q] - ai[q] * si[q], ti = ar[q] * si[q] + ai[q] * sr[q];
                    v4u a0; a0.x = bb[q].x; a0.y = bb[q].y; a0.z = 0u; a0.w = 0u; v4u a1; a1.x = bb[4 + q].x; a1.y = bb[4 + q].y; a1.z = 0u; a1.w = 0u;
                    sr[q] = __builtin_amdgcn_mfma_f32_16x16x32_bf16(__builtin_bit_cast(s5_bf16x8, a0), U, tr, 0, 0, 0);
                    si[q] = __builtin_amdgcn_mfma_f32_16x16x32_bf16(__builtin_bit_cast(s5_bf16x8, a1), U, ti, 0, 0, 0);
                }
                if (PASS2) {
                    f32x4 y = {0.f, 0.f, 0.f, 0.f};
#pragma unroll
                    for (int mm = 0; mm < 4; ++mm) { const f32x4 t0 = mm < 2 ? sr[2 * mm] : si[2 * mm - 4], t1 = mm < 2 ? sr[2 * mm + 1] : si[2 * mm - 3];
                        v4u sb; sb.x = pk2(t0.x, t0.y); sb.y = pk2(t0.z, t0.w); sb.z = pk2(t1.x, t1.y); sb.w = pk2(t1.z, t1.w);
                        y = __builtin_amdgcn_mfma_f32_16x16x32_bf16(__builtin_bit_cast(s5_bf16x8, cop[mm]), __builtin_bit_cast(s5_bf16x8, sb), y, 0, 0, 0); }
                    const f32x4 uf = {bflo(uu[tt].x), bfhi(uu[tt].x), bflo(uu[tt].y), bfhi(uu[tt].y)};
                    const f32x4 yy = y + dk * uf;
                    v2u o; o.x = pk2(gelu_tanh(yy.x), gelu_tanh(yy.y)); o.y = pk2(gelu_tanh(yy.z), gelu_tanh(yy.w));
                    *(LAS v2u*)(up + tt * 256) = o;
                }
            }
            LDS_WAIT(); __syncthreads();
        }
        if (PASS2) {
#pragma unroll
            for (int q = 0; q < NQ; ++q) { const int ri = q * 32 + rowslot, jj = ri / S5TS, tt = ri % S5TS; const v4u y = *(const LAS v4u*)(lds + jj * S5SB + tt * 256 + piece * 16);
                *(v4u*)(dstp + (size_t)(jj * S5T + (NST - 1) * S5TS + tt) * LDD) = y; }
            LDS_WAIT();
        } else {
            float* fo = F + ((size_t)(cs * 16 + j) * 256 + g) * 128 + 4 * rq;
#pragma unroll
            for (int q = 0; q < 4; ++q) { *(f32x4*)(fo + 16 * q) = sr[q]; *(f32x4*)(fo + 64 + 16 * q) = si[q]; }
        }
    }
}
__device__ __forceinline__ void s5_carry(const unsigned char* prm, const float* F, float* HC, int gtid) {
    if (gtid < 256 * 64) {
        const int g = gtid >> 6, p = gtid & 63;
        const float atr = ((const float*)(prm + S5P_ATR))[gtid], ati = ((const float*)(prm + S5P_ATI))[gtid];
        float hr = 0.f, hi = 0.f;
#pragma unroll 8
        for (int c = 0; c < S5NC; ++c) { const size_t o = (size_t)(c * 256 + g) * 128 + p;
            HC[o] = hr; HC[o + 64] = hi; const float fr = F[o], fi = F[o + 64];
            const float nr = atr * hr - ati * hi + fr, ni = atr * hi + ati * hr + fi; hr = nr; hi = ni; }
    }
}

struct Ctx { int lo, hi, tid, lane, wave, gw, NGW, gtid, NGT, G, bid; };
#ifndef DUP_ATTN
#define DUP_ATTN 0
#endif
#ifndef DUP_S5
#define DUP_S5 0
#endif
#ifndef DUP_FFN1
#define DUP_FFN1 0
#endif
#ifndef DUP_FFN2
#define DUP_FFN2 0
#endif
#ifndef DUP_INP
#define DUP_INP 0
#endif
#ifndef DUP_PRO
#define DUP_PRO 0
#endif
#define IN(k) (lo <= (k) && (k) < hi)
#define SEAM(k) do { if (IN(k) && IN((k) + 1)) xcd_barrier(bar); } while (0)
#define FFN_PHASES(l, pb) do { \
    const float* ml_ = MODL + (size_t)(l) * NMODV; \
    if (IN((pb) + 5)) norm_mod_phase(XR, args.in[6] + (size_t)(l) * DM, ml_ + 3 * DM, ml_ + 4 * DM, Hb, lds, tid, gw, NGW, lane); \
    SEAM((pb) + 5); \
    if (IN((pb) + 6)) { pg8::Gemm g{Hb, (const bf16*)(ws + WS_WGU + (size_t)(l) * W_GU_B), SEQ, 2 * FFH, DM, LDD, LDD}; pg8::StaticOrder S; S.init(SEQ, 2 * FFH, G, bid); \
        pg8::EpiSwiGLU E{HID, LDF}; pg8::gemm_phase<pg8::EpiSwiGLU, pg8::StaticOrder, true, true>(lds, g, S, E); } \
    if (DUP_FFN1 && IN((pb) + 6)) { xcd_barrier(bar); pg8::Gemm g{Hb, (const bf16*)(ws + WS_WGU + (size_t)(l) * W_GU_B), SEQ, 2 * FFH, DM, LDD, LDD}; pg8::StaticOrder S; S.init(SEQ, 2 * FFH, G, bid); \
        pg8::EpiSwiGLU E{HID, LDF}; pg8::gemm_phase<pg8::EpiSwiGLU, pg8::StaticOrder, true, true>(lds, g, S, E); } \
    SEAM((pb) + 6); \
    if (DUP_FFN2 && IN((pb) + 7)) { xcd_barrier(bar); pg8::Gemm g{HID, (const bf16*)(ws + WS_WDN + (size_t)(l) * W_DN_B), SEQ, DM, FFH, LDF, LDF}; pg8::StaticOrder S; S.init(SEQ, DM, G, bid); \
        pg8::EpiResid E{XR, (float*)(ws + WS_OT), ml_ + 5 * DM, DM}; pg8::gemm_phase<pg8::EpiResid, pg8::StaticOrder, true, true>(lds, g, S, E); } \
    if (IN((pb) + 7)) { pg8::Gemm g{HID, (const bf16*)(ws + WS_WDN + (size_t)(l) * W_DN_B), SEQ, DM, FFH, LDF, LDF}; pg8::StaticOrder S; S.init(SEQ, DM, G, bid); \
        pg8::EpiResid E{XR, XR, ml_ + 5 * DM, DM}; pg8::gemm_phase<pg8::EpiResid, pg8::StaticOrder, true, true>(lds, g, S, E); } \
    SEAM((pb) + 7); } while (0)
template <int lp>
__device__ __forceinline__ void layer_pair(const Args& args, const Ctx& C, LAS unsigned char* lds, unsigned char* lds_raw, const XcdBarrier& bar) {
    const int lo = C.lo, hi = C.hi, tid = C.tid, lane = C.lane, wave = C.wave, gw = C.gw, NGW = C.NGW, gtid = C.gtid, NGT = C.NGT, G = C.G, bid = C.bid;
    unsigned char* ws = args.ws;
    bf16* const Hb = (bf16*)(ws + WS_H); bf16* const MIX = (bf16*)(ws + WS_MIX); bf16* const Z = (bf16*)(ws + WS_Z); bf16* const HID = (bf16*)(ws + WS_Z);
    float* const OT = (float*)(ws + WS_OT); float* const XR = args.out;
    const float* const MODL = (const float*)(ws + WS_MODL);
        { const int l = 2 * lp, pb = 2 + 8 * l; const float* ml = MODL + (size_t)l * NMODV;
          const float* xin = (l == 0) ? args.in[0] : XR;
          if (IN(pb)) norm_mod_phase(xin, args.in[5] + (size_t)l * DM, ml, ml + DM, Hb, lds, tid, gw, NGW, lane);
          SEAM(pb);
          if (IN(pb + 1)) { pg8::Gemm g{Hb, (const bf16*)(ws + WS_WIN + (size_t)lp * W_IN_B), SEQ, 12288, DM, LDD, LDD}; pg8::StaticOrder S; S.init(SEQ, 12288, G, bid);
              pg8::EpiHeadMajor E{Z, GS}; pg8::gemm_phase<pg8::EpiHeadMajor, pg8::StaticOrder, true, true>(lds, g, S, E); }
          if (DUP_INP && IN(pb + 1)) { xcd_barrier(bar); pg8::Gemm g{Hb, (const bf16*)(ws + WS_WIN + (size_t)lp * W_IN_B), SEQ, 12288, DM, LDD, LDD}; pg8::StaticOrder S; S.init(SEQ, 12288, G, bid);
              pg8::EpiHeadMajor E{Z, GS}; pg8::gemm_phase<pg8::EpiHeadMajor, pg8::StaticOrder, true, true>(lds, g, S, E); }
          SEAM(pb + 1);
          if (IN(pb + 2)) { conv_phase(Z, args.in[9] + (size_t)lp * 3 * 2048, MIX, gtid, NGT); if (ATT2) attn2_phase<false>(Z, OT, (char*)lds_raw, bid, G); else attn_phase(Z, OT, (char*)lds_raw, bid, G); if (DUP_ATTN == 1) { xcd_barrier(bar); attn2_phase<false>(Z, (float*)(ws + WS_END), (char*)lds_raw, bid, G); } if (DUP_ATTN == 2) { xcd_barrier(bar); attn2_phase<true>(Z, (float*)(ws + WS_END), (char*)lds_raw, bid, G); } }
          SEAM(pb + 2);
          if (IN(pb + 3)) combine_phase(OT, (const float*)(ws + WS_LAM) + lp, args.in[14] + lp * 256, lp == 0 ? 0.2f : 0.4707130183435842f, MIX, gw, NGW, lane);
          SEAM(pb + 3);
          if (IN(pb + 4)) { pg8::Gemm g{MIX, (const bf16*)(ws + WS_WOUT + (size_t)lp * W_OUT_B), SEQ, DM, DM, LDD, LDD}; pg8::StaticOrder S; S.init(SEQ, DM, G, bid);
              pg8::EpiResid E{xin, XR, ml + 2 * DM, DM}; pg8::gemm_phase<pg8::EpiResid, pg8::StaticOrder, true, true>(lds, g, S, E); }
          SEAM(pb + 4);
          FFN_PHASES(l, pb);
        }
        { const int l = 2 * lp + 1, pb = 2 + 8 * l; const float* ml = MODL + (size_t)l * NMODV;
          const unsigned char* prm = ws + WS_S5P + (size_t)lp * S5P_LAYER;
          float* const S5F = (float*)(ws + WS_S5F); float* const S5H = (float*)(ws + WS_S5H);
          if (IN(pb)) norm_mod_phase(XR, args.in[5] + (size_t)l * DM, ml, ml + DM, Hb, lds, tid, gw, NGW, lane);
          SEAM(pb);
          if (IN(pb + 1)) { if (S5_MFMA) s5m_pass<false>(Hb, prm, nullptr, S5F, nullptr, nullptr, lds, bid, G); else s5_pass<false>(Hb, prm, nullptr, nullptr, nullptr, S5F, nullptr, nullptr, lds, gw, NGW, wave, lane); }
          SEAM(pb + 1);
          if (IN(pb + 2)) s5_carry(prm, S5F, S5H, gtid);
          SEAM(pb + 2);
          if (IN(pb + 3)) { if (S5_MFMA) s5m_pass<true>(Hb, prm, args.in[23] + (size_t)lp * DM, nullptr, S5H, MIX, lds, bid, G); else s5_pass<true>(Hb, prm, args.in[21] + (size_t)lp * 256 * 16 * 64, args.in[22] + (size_t)lp * 256 * 16 * 64, args.in[23] + (size_t)lp * DM, nullptr, S5H, MIX, lds, gw, NGW, wave, lane); }
          if (DUP_S5) { xcd_barrier(bar);
          if (IN(pb + 1)) { if (S5_MFMA) s5m_pass<false>(Hb, prm, nullptr, S5F, nullptr, nullptr, lds, bid, G); else s5_pass<false>(Hb, prm, nullptr, nullptr, nullptr, S5F, nullptr, nullptr, lds, gw, NGW, wave, lane); }
          SEAM(pb + 1);
          if (IN(pb + 2)) s5_carry(prm, S5F, S5H, gtid);
          SEAM(pb + 2);
          if (IN(pb + 3)) { if (S5_MFMA) s5m_pass<true>(Hb, prm, args.in[23] + (size_t)lp * DM, nullptr, S5H, MIX, lds, bid, G); else s5_pass<true>(Hb, prm, args.in[21] + (size_t)lp * 256 * 16 * 64, args.in[22] + (size_t)lp * 256 * 16 * 64, args.in[23] + (size_t)lp * DM, nullptr, S5H, MIX, lds, gw, NGW, wave, lane); }
          }
          SEAM(pb + 3);
          if (IN(pb + 4)) { pg8::Gemm g{MIX, (const bf16*)(ws + WS_WGLU + (size_t)lp * W_GLU_B), SEQ, 2 * DM, DM, LDD, LDD}; pg8::StaticOrder S; S.init(SEQ, 2 * DM, G, bid);
              pg8::EpiGluResid E{XR, XR, ml + 2 * DM, DM}; pg8::gemm_phase<pg8::EpiGluResid, pg8::StaticOrder, true, true>(lds, g, S, E); }
          SEAM(pb + 4);
          FFN_PHASES(l, pb);
        }
    }
#undef FFN_PHASES
#undef IN
#undef SEAM

__global__ void __launch_bounds__(NTHR, 2) trunk_fwd(Args args) {
    extern __shared__ __attribute__((aligned(16))) unsigned char lds_raw[];
    LAS unsigned char* lds = (LAS unsigned char*)lds_raw;
    volatile LAS unsigned* MISC = (volatile LAS unsigned*)(lds + MISC_OFF);
    const int tid = opaque_tid(), lane = tid & 63, wave = __builtin_amdgcn_readfirstlane(tid >> 6);
    const int G = gridDim.x, bid = blockIdx.x;
    const int vcu = (G % 8 == 0) ? (bid % 8) * (G / 8) + bid / 8 : bid;
    const int gw = vcu * NWAVES + wave, NGW = G * NWAVES, gtid = vcu * NTHR + tid, NGT = G * NTHR;
    unsigned char* ws = args.ws;
    const int lo = args.ph_lo, hi = args.ph_hi;
    for (int u = tid; u < (LDS_BYTES - RING_BYTES) / 4; u += NTHR) ((LAS unsigned*)(lds + RING_BYTES))[u] = 0u;
    __syncthreads();
    XcdBarrier bar; bar.bar = (unsigned*)(ws + WS_CTL) + CW_BAR; bar.x = 0; bar.st = MISC + 8;
    if (hi - lo > 1) bar = xcd_barrier_post((unsigned*)(ws + WS_CTL) + CW_BAR, MISC + 8);
    const Ctx C{lo, hi, tid, lane, wave, gw, NGW, gtid, NGT, G, bid};
#define IN(k) (lo <= (k) && (k) < hi)
#define SEAM(k) do { if (IN(k) && IN((k) + 1)) xcd_barrier(bar); } while (0)

    bf16* const Hb = (bf16*)(ws + WS_H); bf16* const MIX = (bf16*)(ws + WS_MIX); bf16* const Z = (bf16*)(ws + WS_Z); bf16* const HID = (bf16*)(ws + WS_Z);
    float* const OT = (float*)(ws + WS_OT); float* const XR = args.out;
    const float* const MODL = (const float*)(ws + WS_MODL);

    if (IN(0)) { p0_prologue(args, lds, gw, NGW, wave, lane); if (DUP_PRO) { xcd_barrier(bar); p0_prologue(args, lds, gw, NGW, wave, lane); } }
    SEAM(0);
    if (IN(1)) p1_modvec(args, gtid, NGT);
    SEAM(1);


    layer_pair<0>(args, C, lds, lds_raw, bar);
    layer_pair<1>(args, C, lds, lds_raw, bar);
    if (IN(34)) final_norm_phase(XR, args.in[7], XR, gw, NGW, lane);
#undef IN
#undef SEAM
}

extern "C" void kernel_launch(void* const* d_in, const int* in_sizes, int n_in, void* d_out, int out_size, void* d_ws, size_t ws_size, hipStream_t stream) {
    static int grid = 0;
    if (grid == 0) {
        if (n_in != 29 || in_sizes[0] != SEQ * DM || out_size != SEQ * DM || ws_size < WS_END + (DUP_ATTN ? (size_t)32 * GS * 4 : 0)) {
            fprintf(stderr, "kernel_launch: built for 29 inputs, x/out of %d floats, >= %zu bytes of workspace; got n_in %d, in0 %d, out %d, ws %zu; nothing launched\n", SEQ * DM, (size_t)WS_END, n_in, n_in > 0 ? in_sizes[0] : -1, out_size, ws_size); grid = -1; return; }
        int dev = 0, cus = 0, per_cu = 0;
        if (hipGetDevice(&dev) != hipSuccess || hipDeviceGetAttribute(&cus, hipDeviceAttributeMultiprocessorCount, dev) != hipSuccess) { fprintf(stderr, "kernel_launch: device query failed\n"); grid = -1; return; }
        if (hipFuncSetAttribute((const void*)trunk_fwd, hipFuncAttributeMaxDynamicSharedMemorySize, LDS_BYTES) != hipSuccess) { fprintf(stderr, "kernel_launch: hipFuncSetAttribute failed\n"); grid = -1; return; }
        if (hipOccupancyMaxActiveBlocksPerMultiprocessor(&per_cu, (const void*)trunk_fwd, NTHR, LDS_BYTES) != hipSuccess || per_cu < 1) { fprintf(stderr, "kernel_launch: occupancy query reports %d workgroups per CU\n", per_cu); }
        (void)hipGetLastError();
        grid = cus;
        fprintf(stderr, "kernel_launch: grid %d, occupancy %d, ws %zu (need %zu)\n", grid, per_cu, ws_size, (size_t)WS_END);
    }
    if (grid < 0) return;
    if (hipMemsetAsync((char*)d_ws + WS_CTL, 0, CTL_ZERO_BYTES, stream) != hipSuccess) { fprintf(stderr, "kernel_launch: memset failed\n"); return; }
    Args a{};
    for (int i = 0; i < 29; ++i) a.in[i] = (const float*)d_in[i];
    a.out = (float*)d_out; a.ws = (unsigned char*)d_ws;
#if MK_PER_PHASE
    for (int p = 0; p < N_PHASES; ++p) { a.ph_lo = p; a.ph_hi = p + 1; hipLaunchKernelGGL(trunk_fwd, dim3(grid), dim3(NTHR), LDS_BYTES, stream, a); }
#else
    a.ph_lo = 0; a.ph_hi = N_PHASES;
    hipLaunchKernelGGL(trunk_fwd, dim3(grid), dim3(NTHR), LDS_BYTES, stream, a);
#endif
    const hipError_t le = hipPeekAtLastError();
    if (le != hipSuccess) fprintf(stderr, "kernel_launch: launch failed: %s\n", hipGetErrorName(le));
}
```

```cpp
#include <hip/hip_runtime.h>
#include <hip/hip_bf16.h>
#include <cstdio>
#include <cstdint>
__device__ __forceinline__ int opaque_tid() { int t; asm volatile("v_mov_b32 %0, %1" : "=v"(t) : "v"((int)threadIdx.x)); return t; }
namespace pg8 {
#define PG8_LAS __attribute__((address_space(3)))
typedef unsigned short bf16_t;
typedef short bf16x8 __attribute__((ext_vector_type(8)));
typedef float f32x4 __attribute__((ext_vector_type(4)));
typedef unsigned u32x4 __attribute__((ext_vector_type(4)));
constexpr int BM = 256, BK = 64, HALF = 128, HTB = HALF * BK * 2  , STAGE_BYTES = 8 * HTB, NXCD = 8, WGM = 8;

__host__ __device__ __forceinline__ int lds_byte(int r, int c) { const int st = (r >> 4) * 2 + (c >> 5), rr = r & 15, cc = c & 31, ob = rr * 64 + cc * 2; return st * 1024 + (ob ^ (((ob >> 9) & 1) << 5)); }
__host__ __device__ __forceinline__ void stage_rc(int b, int& R, int& C) { const int st = b / 1024, sb = b % 1024, swz = sb ^ (((sb >> 9) & 1) << 5); R = (st >> 1) * 16 + swz / 64; C = (st & 1) * 32 + (swz % 64) / 2; }
__host__ __device__ __forceinline__ int perm32(int rho) { const int n = rho >> 4, i = rho & 15; return 8 * (i >> 2) + 4 * n + (i & 3); }

struct Unit { int pm, pn; };
struct Gemm { const bf16_t* A; const bf16_t* Bt; int M, N, K, lda, ldb; };

struct StaticOrder {
    int nM, nN, nwg, G, c;
    __host__ __device__ void init(int M, int N, int G_, int c_) { nM = M / BM; nN = N / BM; nwg = nM * nN; G = G_; c = c_; }
    __host__ __device__ bool next(int i, Unit& u) const {
        const long L = (long)i * G + c; if (L >= nwg) return false;
        int wgid = (int)L; { const int q = nwg / NXCD, r = nwg % NXCD, xcd = wgid % NXCD, off = wgid / NXCD; wgid = (xcd < r ? xcd * (q + 1) : r * (q + 1) + (xcd - r) * q) + off; }
        const int nig = WGM * nN, gid = wgid / nig, fm = gid * WGM, gsz = (nM - fm) < WGM ? (nM - fm) : WGM;
        u.pm = fm + ((wgid % nig) % gsz); u.pn = (wgid % nig) / gsz; return true;
    }
    __device__ __forceinline__ void a_ready(const Unit&) const {}
    __device__ __forceinline__ void done(const Unit&) const {}
};

__device__ __forceinline__ unsigned cvt_pk_bf16(float lo, float hi) { unsigned r; asm volatile("v_cvt_pk_bf16_f32 %0, %1, %2" : "=v"(r) : "v"(lo), "v"(hi)); return r; }
__device__ __forceinline__ float fast_sigmoid(float x) { return __builtin_amdgcn_rcpf(1.0f + __builtin_amdgcn_exp2f(-1.4426950408889634f * x)); }

struct EpiHeadMajor {
    static constexpr bool PERM = true, AFTER_DRAIN = false;
    bf16_t* O; size_t gstride;
    __device__ __forceinline__ void operator()(const f32x4 (&acc)[2][2][4][2], const Unit& u, int wr, int wc, int fr, int fq) const {
        const int row0 = u.pm * BM + wr * 64 + fr, col0 = wc * 32 + 8 * fq;
#pragma unroll
        for (int ai = 0; ai < 2; ++ai)
#pragma unroll
            for (int m = 0; m < 4; ++m) { const size_t ro = (size_t)(row0 + ai * HALF + m * 16) * 128 + col0;
#pragma unroll
                for (int bj = 0; bj < 2; ++bj) { const f32x4 v0 = acc[ai][bj][m][0], v1 = acc[ai][bj][m][1];
                    u32x4 w; w.x = cvt_pk_bf16(v0[0], v0[1]); w.y = cvt_pk_bf16(v0[2], v0[3]); w.z = cvt_pk_bf16(v1[0], v1[1]); w.w = cvt_pk_bf16(v1[2], v1[3]);
                    *(u32x4*)(O + (size_t)(2 * u.pn + bj) * gstride + ro) = w; } }
    }
};
struct EpiResid {
    static constexpr bool PERM = false, AFTER_DRAIN = false;
    const float* base; float* out; const float* gate; int ldc;
    __device__ __forceinline__ void operator()(const f32x4 (&acc)[2][2][4][2], const Unit& u, int wr, int wc, int fr, int fq) const {
        const int row0 = u.pm * BM + wr * 64 + fr, col0 = u.pn * BM + wc * 32 + 4 * fq;
        f32x4 gv[2][2];
#pragma unroll
        for (int bj = 0; bj < 2; ++bj)
#pragma unroll
            for (int n = 0; n < 2; ++n) gv[bj][n] = *(const f32x4*)(gate + col0 + bj * HALF + n * 16);
#pragma unroll
        for (int ai = 0; ai < 2; ++ai) {
            f32x4 b[4][2][2];
#pragma unroll
            for (int m = 0; m < 4; ++m) { const size_t off = (size_t)(row0 + ai * HALF + m * 16) * ldc + col0;
#pragma unroll
                for (int bj = 0; bj < 2; ++bj)
#pragma unroll
                    for (int n = 0; n < 2; ++n) b[m][bj][n] = *(const f32x4*)(base + off + bj * HALF + n * 16); }
            asm volatile("" ::: "memory");
#pragma unroll
            for (int m = 0; m < 4; ++m) { const size_t off = (size_t)(row0 + ai * HALF + m * 16) * ldc + col0;
#pragma unroll
                for (int bj = 0; bj < 2; ++bj)
#pragma unroll
                    for (int n = 0; n < 2; ++n) *(f32x4*)(out + off + bj * HALF + n * 16) = b[m][bj][n] + gv[bj][n] * acc[ai][bj][m][n]; }
            asm volatile("" ::: "memory"); }
    }
};
struct EpiSwiGLU {
    static constexpr bool PERM = true, AFTER_DRAIN = false;
    bf16_t* O; int ldc;
    __device__ __forceinline__ void operator()(const f32x4 (&acc)[2][2][4][2], const Unit& u, int wr, int wc, int fr, int fq) const {
        const int row0 = u.pm * BM + wr * 64 + fr, col0 = u.pn * HALF + wc * 32 + 8 * fq;
#pragma unroll
        for (int ai = 0; ai < 2; ++ai)
#pragma unroll
            for (int m = 0; m < 4; ++m) { bf16_t* rowp = O + (size_t)(row0 + ai * HALF + m * 16) * ldc + col0;
                float r[8];
#pragma unroll
                for (int n = 0; n < 2; ++n)
#pragma unroll
                    for (int j = 0; j < 4; ++j) { const float g = acc[ai][0][m][n][j], up = acc[ai][1][m][n][j]; r[n * 4 + j] = g * fast_sigmoid(g) * up; }
                u32x4 w; w.x = cvt_pk_bf16(r[0], r[1]); w.y = cvt_pk_bf16(r[2], r[3]); w.z = cvt_pk_bf16(r[4], r[5]); w.w = cvt_pk_bf16(r[6], r[7]);
                *(u32x4*)rowp = w; }
    }
};
struct EpiGluResid {
    static constexpr bool PERM = false, AFTER_DRAIN = false;
    const float* base; float* out; const float* gate; int ldc;
    __device__ __forceinline__ void operator()(const f32x4 (&acc)[2][2][4][2], const Unit& u, int wr, int wc, int fr, int fq) const {
        const int row0 = u.pm * BM + wr * 64 + fr, col0 = u.pn * HALF + wc * 32 + 4 * fq;
        f32x4 gv[2];
#pragma unroll
        for (int n = 0; n < 2; ++n) gv[n] = *(const f32x4*)(gate + col0 + n * 16);
        f32x4 b[2][4][2];
#pragma unroll
        for (int ai = 0; ai < 2; ++ai)
#pragma unroll
            for (int m = 0; m < 4; ++m) { const size_t off = (size_t)(row0 + ai * HALF + m * 16) * ldc + col0;
#pragma unroll
                for (int n = 0; n < 2; ++n) b[ai][m][n] = *(const f32x4*)(base + off + n * 16); }
        asm volatile("" ::: "memory");
#pragma unroll
        for (int ai = 0; ai < 2; ++ai)
#pragma unroll
            for (int m = 0; m < 4; ++m) { const size_t off = (size_t)(row0 + ai * HALF + m * 16) * ldc + col0;
#pragma unroll
                for (int n = 0; n < 2; ++n) { const f32x4 a = acc[ai][0][m][n], sg = acc[ai][1][m][n]; f32x4 y;
#pragma unroll
                    for (int j = 0; j < 4; ++j) y[j] = a[j] * fast_sigmoid(sg[j]);
                    *(f32x4*)(out + off + n * 16) = b[ai][m][n] + gv[n] * y; } }
        asm volatile("" ::: "memory");
    }
};

template <class Epi, class Sched, bool ALIGN_EPI = false, bool SP2 = false>
__device__ __forceinline__ void gemm_phase(PG8_LAS unsigned char* lds, const Gemm g, const Sched& S, const Epi& E) {
    const int tid = opaque_tid(), wid = __builtin_amdgcn_readfirstlane(tid >> 6), lane = tid & 63, wr = wid >> 2, wc = wid & 3, fr = lane & 15, fq = lane >> 4;
    const int K = g.K, nt = K / BK;
    unsigned voffA[2], voffB[2];
#pragma unroll
    for (int i = 0; i < 2; ++i) { int R, C; stage_rc(tid * 16 + i * 8192, R, C); const int Rb = Epi::PERM ? ((R & ~31) + perm32(R & 31)) : R;
        voffA[i] = (unsigned)(R * g.lda + C) * 2u; voffB[i] = (unsigned)(Rb * g.ldb + C) * 2u; }
    const size_t kstep = (size_t)(BK * 2);
    const size_t hstepA = (size_t)HALF * g.lda * 2, hstepB = (size_t)HALF * g.ldb * 2;
    const size_t tstepA = 2 * hstepA, tstepB = 2 * hstepB;
    const unsigned ldsw = (unsigned)wid * 1024u;
    const int aoff = lds_byte(wr * 64 + fr, fq * 8), boff = lds_byte(wc * 32 + fr, fq * 8);
#define PG8_SA(b, h) (((b) * 2 + (h)) * HTB)
#define PG8_SB(b, h) ((4 + (b) * 2 + (h)) * HTB)
#define PG8_STAGE(bufoff, gbase, voff) do { _Pragma("unroll") for (int _i = 0; _i < 2; ++_i) \
        __builtin_amdgcn_global_load_lds((const unsigned*)((const char*)(gbase) + (voff)[_i]), (PG8_LAS unsigned*)(lds + (bufoff) + ldsw + _i * 8192), 16, 0, 0); } while (0)
#define PG8_LDA(dst, b, h) do { _Pragma("unroll") for (int m = 0; m < 4; ++m) _Pragma("unroll") for (int k = 0; k < 2; ++k) dst[m][k] = *(const PG8_LAS bf16x8*)(lds + PG8_SA(b, h) + aoff + m * 2048 + k * 1024); } while (0)
#define PG8_LDB(dst, b, h) do { _Pragma("unroll") for (int n = 0; n < 2; ++n) _Pragma("unroll") for (int k = 0; k < 2; ++k) dst[n][k] = *(const PG8_LAS bf16x8*)(lds + PG8_SB(b, h) + boff + n * 2048 + k * 1024); } while (0)
#define PG8_MMA(ai, bj, At, Bt) do { __builtin_amdgcn_s_setprio(3); _Pragma("unroll") for (int m = 0; m < 4; ++m) _Pragma("unroll") for (int n = 0; n < 2; ++n) _Pragma("unroll") for (int k = 0; k < 2; ++k) \
        acc[ai][bj][m][n] = __builtin_amdgcn_mfma_f32_16x16x32_bf16(Bt[n][k], At[m][k], acc[ai][bj][m][n], 0, 0, 0); __builtin_amdgcn_s_setprio(0); } while (0)
#define PG8_WAIT_V(n) asm volatile("s_waitcnt vmcnt(" #n ")" ::: "memory")
#define PG8_WAIT_L(n) asm volatile("s_waitcnt lgkmcnt(" #n ")" ::: "memory")
#define PG8_BAR __builtin_amdgcn_s_barrier()
#define PG8_SCHED __builtin_amdgcn_sched_barrier(0)
    Unit cur, nxt; int ui = 0;
    if (!S.next(0, cur)) return;
    f32x4 acc[2][2][4][2];
#pragma unroll
    for (int a = 0; a < 2; ++a)
#pragma unroll
        for (int b = 0; b < 2; ++b)
#pragma unroll
            for (int m = 0; m < 4; ++m)
#pragma unroll
                for (int n = 0; n < 2; ++n) acc[a][b][m][n] = (f32x4){0.f, 0.f, 0.f, 0.f};
    bf16x8 At[4][2], B0[2][2], B1[2][2];
    const char* cA = (const char*)g.A + (size_t)cur.pm * tstepA; const char* cB = (const char*)g.Bt + (size_t)cur.pn * tstepB;
    S.a_ready(cur);
    if constexpr (SP2) {
        PG8_STAGE(PG8_SB(0, 0), cB, voffB); PG8_STAGE(PG8_SB(0, 1), cB + hstepB, voffB); PG8_STAGE(PG8_SA(0, 0), cA, voffA); PG8_STAGE(PG8_SA(0, 1), cA + hstepA, voffA);
        if (wr == 1) PG8_BAR;
        PG8_WAIT_V(2); PG8_BAR;
        PG8_STAGE(PG8_SB(1, 0), cB + kstep, voffB); PG8_STAGE(PG8_SA(1, 0), cA + kstep, voffA); PG8_STAGE(PG8_SB(1, 1), cB + hstepB + kstep, voffB);
        PG8_WAIT_V(6); PG8_BAR;
    } else {
        PG8_STAGE(PG8_SB(0, 0), cB, voffB); PG8_STAGE(PG8_SA(0, 0), cA, voffA); PG8_STAGE(PG8_SB(0, 1), cB + hstepB, voffB); PG8_STAGE(PG8_SA(0, 1), cA + hstepA, voffA);
        if (wr == 1) PG8_BAR;
        PG8_WAIT_V(4); PG8_BAR;
        PG8_STAGE(PG8_SB(1, 0), cB + kstep, voffB); PG8_STAGE(PG8_SA(1, 0), cA + kstep, voffA); PG8_STAGE(PG8_SB(1, 1), cB + hstepB + kstep, voffB);
        PG8_WAIT_V(6); PG8_BAR;
    }
    for (;;) {
        const bool has_next = S.next(ui + 1, nxt);
        const char* nA = has_next ? (const char*)g.A + (size_t)nxt.pm * tstepA : cA; const char* nB = has_next ? (const char*)g.Bt + (size_t)nxt.pn * tstepB : cB;
        for (int t = 0; t < nt; t += 2) {
            const bool last = (t == nt - 2);
            const char* a1 = cA + (size_t)(t + 1) * kstep;
            const char* a2 = last ? nA : cA + (size_t)(t + 2) * kstep; const char* b2 = last ? nB : cB + (size_t)(t + 2) * kstep;
            const char* a3 = a2 + kstep; const char* b3 = b2 + kstep;
            if (last && has_next) S.a_ready(nxt);
            if constexpr (SP2) {
            PG8_LDB(B0, 0, 0); PG8_LDB(B1, 0, 1); PG8_SCHED; PG8_LDA(At, 0, 0); PG8_STAGE(PG8_SA(1, 1), a1 + hstepA, voffA);
            PG8_WAIT_V(8); PG8_WAIT_L(0); PG8_BAR; PG8_MMA(0, 0, At, B0); PG8_MMA(0, 1, At, B1); PG8_BAR; PG8_SCHED;
            PG8_LDA(At, 0, 1); PG8_STAGE(PG8_SB(0, 0), b2, voffB); PG8_STAGE(PG8_SB(0, 1), b2 + hstepB, voffB); PG8_STAGE(PG8_SA(0, 0), a2, voffA);
            PG8_WAIT_V(8); PG8_WAIT_L(0); PG8_BAR; PG8_MMA(1, 0, At, B0); PG8_MMA(1, 1, At, B1); PG8_BAR; PG8_SCHED;
            PG8_LDB(B0, 1, 0); PG8_LDB(B1, 1, 1); PG8_SCHED; PG8_LDA(At, 1, 0); PG8_STAGE(PG8_SA(0, 1), a2 + hstepA, voffA);
            PG8_WAIT_V(8); PG8_WAIT_L(0); PG8_BAR; PG8_MMA(0, 0, At, B0); PG8_MMA(0, 1, At, B1); PG8_BAR; PG8_SCHED;
            PG8_LDA(At, 1, 1); PG8_STAGE(PG8_SB(1, 0), b3, voffB); PG8_STAGE(PG8_SB(1, 1), b3 + hstepB, voffB); PG8_STAGE(PG8_SA(1, 0), a3, voffA);
            PG8_WAIT_V(8); PG8_WAIT_L(0); PG8_BAR; PG8_MMA(1, 0, At, B0); PG8_MMA(1, 1, At, B1); PG8_BAR; PG8_SCHED;
            } else {
            PG8_LDB(B0, 0, 0); PG8_SCHED; PG8_LDA(At, 0, 0); PG8_STAGE(PG8_SA(1, 1), a1 + hstepA, voffA);
            PG8_WAIT_L(8); PG8_BAR; PG8_WAIT_L(0); PG8_MMA(0, 0, At, B0); PG8_BAR; PG8_SCHED;
            PG8_LDB(B1, 0, 1); PG8_STAGE(PG8_SB(0, 0), b2, voffB);
            PG8_BAR; PG8_WAIT_L(0); PG8_MMA(0, 1, At, B1); PG8_BAR;
            PG8_LDA(At, 0, 1); PG8_STAGE(PG8_SA(0, 0), a2, voffA);
            PG8_BAR; PG8_WAIT_L(0); PG8_MMA(1, 0, At, B0); PG8_BAR; PG8_SCHED;
            PG8_STAGE(PG8_SB(0, 1), b2 + hstepB, voffB);
            PG8_WAIT_V(6); PG8_BAR; PG8_MMA(1, 1, At, B1); PG8_BAR;
            PG8_LDB(B0, 1, 0); PG8_SCHED; PG8_LDA(At, 1, 0); PG8_STAGE(PG8_SA(0, 1), a2 + hstepA, voffA);
            PG8_WAIT_L(8); PG8_BAR; PG8_WAIT_L(0); PG8_MMA(0, 0, At, B0); PG8_BAR; PG8_SCHED;
            PG8_LDB(B1, 1, 1); PG8_STAGE(PG8_SB(1, 0), b3, voffB);
            PG8_BAR; PG8_WAIT_L(0); PG8_MMA(0, 1, At, B1); PG8_BAR;
            PG8_LDA(At, 1, 1); PG8_STAGE(PG8_SA(1, 0), a3, voffA);
            PG8_BAR; PG8_WAIT_L(0); PG8_MMA(1, 0, At, B0); PG8_BAR; PG8_SCHED;
            PG8_STAGE(PG8_SB(1, 1), b3 + hstepB, voffB);
            PG8_WAIT_V(6); PG8_BAR; PG8_MMA(1, 1, At, B1); PG8_BAR;
            }
        }
        if constexpr (ALIGN_EPI) { if (wr == 0) PG8_BAR; }
        if constexpr (!Epi::AFTER_DRAIN) { E(acc, cur, wr, wc, fr, fq); S.done(cur); }
        if (!has_next) break;
#pragma unroll
        for (int a = 0; a < 2; ++a)
#pragma unroll
            for (int b = 0; b < 2; ++b)
#pragma unroll
                for (int m = 0; m < 4; ++m)
#pragma unroll
                    for (int n = 0; n < 2; ++n) acc[a][b][m][n] = (f32x4){0.f, 0.f, 0.f, 0.f};
        cur = nxt; cA = nA; cB = nB; ++ui;
        if constexpr (ALIGN_EPI) { if (wr == 1) PG8_BAR; }
    }
    PG8_WAIT_V(0);
    if constexpr (!ALIGN_EPI) { if (wr == 0) PG8_BAR; }
    PG8_BAR;
    if constexpr (Epi::AFTER_DRAIN) { E.fused(acc, cur, wr, wc, fr, fq, lds, wid, lane); S.done(cur); }
#undef PG8_SA
#undef PG8_SB
#undef PG8_STAGE
#undef PG8_LDA
#undef PG8_LDB
#undef PG8_MMA
#undef PG8_WAIT_V
#undef PG8_WAIT_L
#undef PG8_BAR
#undef PG8_SCHED
}
}

namespace att {
constexpr int D = 128;
constexpr float THR = 8.f;
constexpr bool WSKIP = false;
constexpr float SCALE = 0.08838834764831845f;
constexpr int NW = 8, QBLK = 32, KVBLK = 64, QB = NW * QBLK;
constexpr int SHM_V = KVBLK * D * 2, SHM_K = KVBLK * D * 2;
constexpr int LDS_BYTES = 2 * SHM_V + 2 * SHM_K + NW * 64 * 4;

using bf16 = __hip_bfloat16;
typedef short bf16x8 __attribute__((ext_vector_type(8)));
typedef short s16x4 __attribute__((ext_vector_type(4)));
typedef float f32x16 __attribute__((ext_vector_type(16)));
typedef float f32x4 __attribute__((ext_vector_type(4)));
typedef unsigned u32x4 __attribute__((ext_vector_type(4)));
template <class A, class Bt> struct same_t { static constexpr bool v = false; };
template <class A> struct same_t<A, A> { static constexpr bool v = true; };

#define KSWZ(row, colB) ((row) * 256 + ((colB) ^ (((row) & 7) << 4)))
#define SBAR() __builtin_amdgcn_sched_barrier(0)
__device__ __forceinline__ int v_st(int k, int c) { const int kk = (k & ~0xC) | ((k & 4) << 1) | ((k & 8) >> 1); return ((kk >> 3) * 4 + (c >> 5)) * 512 + ((kk & 7) * 32 + (c & 31)) * 2; }
__device__ __forceinline__ int v_rd_base(int lane) { return ((lane & 3) << 3) | (((lane >> 2) & 3) << 6) | (((lane >> 4) & 1) << 5) | (((lane >> 5) & 1) << 8); }
constexpr int v_rd_off(int d0, int ks, int half) { return d0 * 512 + ks * 4096 + half * 2048; }
__device__ __forceinline__ int crow(int r, int hi) { return (r & 3) + 8 * (r >> 2) + 4 * hi; }
__device__ __forceinline__ unsigned cvtpk(float lo, float hi) {
    unsigned r; asm volatile("v_cvt_pk_bf16_f32 %0, %1, %2" : "=v"(r) : "v"(lo), "v"(hi)); return r;
}
__device__ __forceinline__ bf16x8 pack8(f32x4 a, f32x4 b) {
    u32x4 w = {cvtpk(a[0], a[1]), cvtpk(a[2], a[3]), cvtpk(b[0], b[1]), cvtpk(b[2], b[3])};
    return *reinterpret_cast<bf16x8*>(&w);
}
template <class T> __device__ __forceinline__ bf16x8 load8(const T* p) {
    if constexpr (same_t<T, float>::v) { return pack8(*(const f32x4*)p, *(const f32x4*)(p + 4)); }
    else { return *reinterpret_cast<const bf16x8*>(p); }
}
__device__ __forceinline__ void mask_tile(f32x16& p0, f32x16& p1, int dq, unsigned W) {
    const float NEG = -__builtin_inff();
#pragma unroll
    for (int r = 0; r < 16; ++r) {
        const int c = (r & 3) + 8 * (r >> 2);
        if ((unsigned)(dq - c) >= W) p0[r] = NEG;
        if ((unsigned)(dq - c - 32) >= W) p1[r] = NEG;
    }
}
__device__ __forceinline__ void partialSM(f32x16& p0, f32x16& p1, float& m_reg, float& mn, float& alpha) {
    float pmax = p0[0]; for (int r = 1; r < 16; ++r) pmax = fmaxf(pmax, p0[r]); for (int r = 0; r < 16; ++r) pmax = fmaxf(pmax, p1[r]);
    { auto rr = __builtin_amdgcn_permlane32_swap(__float_as_uint(pmax), __float_as_uint(pmax), false, false);
      pmax = fmaxf(__uint_as_float(rr[0]), __uint_as_float(rr[1])); }
    constexpr float C2 = 1.4426950408889634f * SCALE;
    if (__builtin_expect(__all((pmax - m_reg) * SCALE <= THR), 1)) { mn = m_reg; alpha = 1.f; }
    else { mn = fmaxf(m_reg, pmax); alpha = __builtin_amdgcn_exp2f((m_reg - mn) * C2); m_reg = mn; }
    const float mnL = -mn * C2;
    for (int r = 0; r < 16; ++r) p0[r] = fmaf(p0[r], C2, mnL); for (int r = 0; r < 16; ++r) p1[r] = fmaf(p1[r], C2, mnL);
    for (int r = 0; r < 16; ++r) p0[r] = __builtin_amdgcn_exp2f(p0[r]);
}
__device__ __forceinline__ void finishSM(f32x16& p0, f32x16& p1, float alpha, float& l_reg, bf16x8& pa0, bf16x8& pa1, bf16x8& pa2, bf16x8& pa3) {
    for (int r = 0; r < 16; ++r) p1[r] = __builtin_amdgcn_exp2f(p1[r]);
    float ps = 0; for (int r = 0; r < 16; ++r) ps += p0[r]; for (int r = 0; r < 16; ++r) ps += p1[r];
    { auto rr = __builtin_amdgcn_permlane32_swap(__float_as_uint(ps), __float_as_uint(ps), false, false);
      ps = __uint_as_float(rr[0]) + __uint_as_float(rr[1]); }
    l_reg = l_reg * alpha + ps;
#define PK4(P, B_, OUT) do { unsigned a0 = cvtpk(P[B_+0], P[B_+1]), a1 = cvtpk(P[B_+2], P[B_+3]);                          \
        unsigned b0 = cvtpk(P[B_+4], P[B_+5]), b1 = cvtpk(P[B_+6], P[B_+7]);                                             \
        auto r0 = __builtin_amdgcn_permlane32_swap(a0, b0, false, false); auto r1 = __builtin_amdgcn_permlane32_swap(a1, b1, false, false); \
        u32x4 w = {r0[0], r1[0], r0[1], r1[1]}; OUT = *reinterpret_cast<bf16x8*>(&w); } while (0)
    PK4(p0, 0, pa0); PK4(p0, 8, pa1); PK4(p1, 0, pa2); PK4(p1, 8, pa3);
#undef PK4
}
template <int KB, bool SK>
__device__ __forceinline__ void qkt(f32x16& p0, f32x16& p1, const char* K_lds, int r32, int hi, const bf16x8* qr, bool act) {
    if (SK && !act) { const float NEG = -__builtin_inff();
#pragma unroll
        for (int r = 0; r < 16; ++r) { p0[r] = NEG; p1[r] = NEG; } return; }
    p0 = f32x16{}; p1 = f32x16{};
    const char* kb[4];
#pragma unroll
    for (int dd = 0; dd < 4; ++dd) kb[dd] = K_lds + KB * SHM_K + KSWZ(r32, (dd * 16 + hi * 8) * 2);
#pragma unroll
    for (int d0 = 0; d0 < 8; ++d0) { const char* a = kb[d0 & 3] + (d0 >> 2) * 128;
        bf16x8 b0 = *reinterpret_cast<const bf16x8*>(a);
        bf16x8 b1 = *reinterpret_cast<const bf16x8*>(a + 32 * 256);
        p0 = __builtin_amdgcn_mfma_f32_32x32x16_bf16(b0, qr[d0], p0, 0, 0, 0);
        p1 = __builtin_amdgcn_mfma_f32_32x32x16_bf16(b1, qr[d0], p1, 0, 0, 0); }
}
template <int VB, bool SK>
__device__ __forceinline__ void pv_tile(f32x16* o, int vb0, bf16x8 pa0, bf16x8 pa1, bf16x8 pa2, bf16x8 pa3, bool act) {
    if (SK && !act) return;
#define TRRD(dst, off) asm volatile("ds_read_b64_tr_b16 %0, %1 offset:%2" : "=&v"(dst) : "v"(vb0), "i"(off) : "memory")
#define PV_D0(d0) do { s16x4 l0, l1, l2, l3, h0, h1, h2, h3; constexpr int b_ = VB * SHM_V + v_rd_off(d0, 0, 0);     \
        TRRD(l0, b_); TRRD(h0, b_ + 2048); TRRD(l1, b_ + 4096); TRRD(h1, b_ + 6144); TRRD(l2, b_ + 8192); TRRD(h2, b_ + 10240); TRRD(l3, b_ + 12288); TRRD(h3, b_ + 14336); \
        asm volatile("s_waitcnt lgkmcnt(0)" ::: "memory"); SBAR();                 \
        o[d0] = __builtin_amdgcn_mfma_f32_32x32x16_bf16(pa0, (bf16x8){l0[0], l0[1], l0[2], l0[3], h0[0], h0[1], h0[2], h0[3]}, o[d0], 0, 0, 0);   \
        o[d0] = __builtin_amdgcn_mfma_f32_32x32x16_bf16(pa1, (bf16x8){l1[0], l1[1], l1[2], l1[3], h1[0], h1[1], h1[2], h1[3]}, o[d0], 0, 0, 0);   \
        o[d0] = __builtin_amdgcn_mfma_f32_32x32x16_bf16(pa2, (bf16x8){l2[0], l2[1], l2[2], l2[3], h2[0], h2[1], h2[2], h2[3]}, o[d0], 0, 0, 0);   \
        o[d0] = __builtin_amdgcn_mfma_f32_32x32x16_bf16(pa3, (bf16x8){l3[0], l3[1], l3[2], l3[3], h3[0], h3[1], h3[2], h3[3]}, o[d0], 0, 0, 0); } while (0)
    PV_D0(0); PV_D0(1); PV_D0(2); PV_D0(3);
#undef PV_D0
#undef TRRD
}

template <class TIn, class TOut> struct BlockRef { const TIn* Q; const TIn* K; const TIn* V; TOut* O; int P0; };
template <class TIn> struct Seam {
    bf16x8 qr[8];
    bf16x8 st_v0, st_v1, st_k0, st_k1; f32x4 sf0, sf1, sf2, sf3;
    f32x4 tq[16];
};
__device__ __forceinline__ int swa_jlo(int P0, int W) { const int lowk = P0 - W + 1; return lowk > 0 ? lowk / KVBLK : 0; }
#define ROW(p, k0, rr) ((p) + (size_t)((k0) + (rr)) * D + sc)
#define VMW() asm volatile("s_waitcnt vmcnt(0)" ::: "memory")
#define VMWN(n) asm volatile("s_waitcnt vmcnt(%0)" :: "i"(n) : "memory")
#define SLOAD_H(Kp, Vp, k0) do { S.st_v0 = load8<TIn>(ROW(Vp, k0, sr)); S.st_v1 = load8<TIn>(ROW(Vp, k0, 32 + sr));              \
                         S.st_k0 = load8<TIn>(ROW(Kp, k0, sr)); S.st_k1 = load8<TIn>(ROW(Kp, k0, 32 + sr)); } while (0)
#define SWRITE_HK(bf) do { *(bf16x8*)(K_lds + (bf) * SHM_K + kws) = S.st_k0; *(bf16x8*)(K_lds + (bf) * SHM_K + kws + 32 * 256) = S.st_k1; } while (0)
#define SWRITE_HV(bf) do { *(bf16x8*)(V_lds + (bf) * SHM_V + vst0) = S.st_v0; *(bf16x8*)(V_lds + (bf) * SHM_V + vst1) = S.st_v1; } while (0)
#define SWRITE_H(bf) do { SWRITE_HV(bf); SWRITE_HK(bf); } while (0)
#define SLOAD_F(p, k0) do { S.sf0 = *(const f32x4*)ROW(p, k0, sr); S.sf1 = *(const f32x4*)(ROW(p, k0, sr) + 4);                \
                            S.sf2 = *(const f32x4*)ROW(p, k0, 32 + sr); S.sf3 = *(const f32x4*)(ROW(p, k0, 32 + sr) + 4); } while (0)
#define SWRITE_KF(bf) do { *(bf16x8*)(K_lds + (bf) * SHM_K + kws) = pack8(S.sf0, S.sf1); *(bf16x8*)(K_lds + (bf) * SHM_K + kws + 32 * 256) = pack8(S.sf2, S.sf3); } while (0)
#define SWRITE_VF(bf) do { *(bf16x8*)(V_lds + (bf) * SHM_V + vst0) = pack8(S.sf0, S.sf1); *(bf16x8*)(V_lds + (bf) * SHM_V + vst1) = pack8(S.sf2, S.sf3); } while (0)
template <class TIn, class TOut>
__device__ __forceinline__ void causal_swa_prime(const BlockRef<TIn, TOut>& cur, int W, char* lds, Seam<TIn>& S) {
    constexpr bool F32 = same_t<TIn, float>::v;
    const int tid = opaque_tid(), wid = __builtin_amdgcn_readfirstlane(tid >> 6), lane = tid & 63, r32 = lane & 31, hi = lane >> 5;
    const int sr = tid >> 4, sc = (tid & 15) * 8, kws = KSWZ(sr, sc * 2); char* K_lds = lds + 2 * SHM_V;
    const int kb0 = swa_jlo(cur.P0, W) * KVBLK;
    for (int d0 = 0; d0 < 8; ++d0) S.qr[d0] = load8<TIn>(cur.Q + (size_t)(wid * QBLK + r32) * D + d0 * 16 + hi * 8);
    if constexpr (F32) { SLOAD_F((const float*)cur.K, kb0); VMW(); SWRITE_KF(0); SBAR(); SLOAD_F((const float*)cur.V, kb0); }
    else { SLOAD_H(cur.K, cur.V, kb0); VMW(); SWRITE_HK(0); }
    __syncthreads();
}
template <class TIn, class TOut>
__device__ __forceinline__ void causal_swa_block(const BlockRef<TIn, TOut>& cur, const BlockRef<TIn, TOut>& nxt, int skv, int W, char* lds, Seam<TIn>& S) {
    constexpr bool F32 = same_t<TIn, float>::v;
    const int tid = opaque_tid(), wid = __builtin_amdgcn_readfirstlane(tid >> 6), lane = tid & 63, r32 = lane & 31, hi = lane >> 5;
    const int j_lo = swa_jlo(cur.P0, W);
    int j_hi = (cur.P0 + QB - 1) / KVBLK + 1; if (j_hi > skv / KVBLK) j_hi = skv / KVBLK;
    const int NT = j_hi - j_lo;
    const int kbn = swa_jlo(nxt.P0, W) * KVBLK;
    const int qlo = cur.P0 + wid * QBLK, qm = qlo + r32 - 4 * hi;
    char* V_lds = lds; char* K_lds = lds + 2 * SHM_V;
    float* ws = (float*)(lds + 2 * SHM_V + 2 * SHM_K) + wid * 64; float* li_l = ws, * al_l = ws + 32;
    float m_reg = -1e30f, l_reg = 0; f32x16 o[4] = {};
    const int sr = tid >> 4, sc = (tid & 15) * 8, vst0 = v_st(sr, sc), vst1 = v_st(32 + sr, sc), kws = KSWZ(sr, sc * 2);
    const int vb0 = (int)(uintptr_t)V_lds + v_rd_base(lane);
    const TIn* Kh = cur.K; const TIn* Vh = cur.V;
#define RESC(a) do { if (__any((a) < 1.f)) { if (hi == 0) al_l[r32] = (a); asm volatile("s_waitcnt lgkmcnt(0)" ::: "memory");              \
                     for (int d_ = 0; d_ < 4; ++d_) for (int r = 0; r < 16; ++r) o[d_][r] *= al_l[crow(r, hi)]; } } while (0)
#define KBASE(t) ((j_lo + (t)) * KVBLK)
#define ACT(t) (KBASE(t) <= qlo + QBLK - 1 && KBASE(t) + KVBLK - 1 >= qlo - W + 1)
#define MASKT(P0_, P1_, t) do { const int kb_ = KBASE(t); if ((!SK || ACT(t)) && (kb_ + KVBLK - 1 > qlo || kb_ <= qlo + QBLK - 1 - W)) mask_tile(P0_, P1_, qm - kb_, (unsigned)W); } while (0)
    constexpr int NQL = F32 ? 16 : 8;
    constexpr bool SK = WSKIP && !F32;
#define SEAM_K0() do { VMWN(NQL); if constexpr (F32) { SWRITE_KF(0); SBAR(); SLOAD_F((const float*)nxt.V, kbn); } else { SWRITE_HK(0); } SBAR(); } while (0)
    f32x16 pA0, pA1, pB0, pB1; float mnA, mnB, alA, alB; bf16x8 pa0, pa1, pa2, pa3;
    if constexpr (F32) { VMW(); SWRITE_VF(0); SBAR(); } else { SWRITE_HV(0); SBAR(); }
    if (NT > 1) { if constexpr (F32) SLOAD_F((const float*)Kh, KBASE(1)); else SLOAD_H(Kh, Vh, KBASE(1)); }
    SBAR(); qkt<0, SK>(pA0, pA1, K_lds, r32, hi, S.qr, ACT(0));
    if constexpr (F32) { if (NT > 1) { VMW(); SWRITE_KF(1); SBAR(); SLOAD_F((const float*)Vh, KBASE(1)); } }
    MASKT(pA0, pA1, 0); partialSM(pA0, pA1, m_reg, mnA, alA);
    if (NT > 1) { VMW(); if constexpr (F32) { SWRITE_VF(1); SBAR(); if (NT > 2) SLOAD_F((const float*)Kh, KBASE(2)); } else SWRITE_H(1); }
    __syncthreads();
#define HALF_STEP(PX0, PX1, mnX, alX, PY0, PY1, alY, t, KB, VB, SB) do {                                                      \
        SBAR(); qkt<KB, SK>(PX0, PX1, K_lds, r32, hi, S.qr, ACT(t));                                             \
        finishSM(PY0, PY1, alY, l_reg, pa0, pa1, pa2, pa3); SBAR();                                                           \
        if ((t) + 1 < NT) { if constexpr (F32) { VMW(); SWRITE_KF(SB); SBAR(); SLOAD_F((const float*)Vh, KBASE((t) + 1)); }  \
                            else { SLOAD_H(Kh, Vh, KBASE((t) + 1)); } SBAR(); }                                               \
        pv_tile<VB, SK>(o, vb0, pa0, pa1, pa2, pa3, ACT((t) - 1)); MASKT(PX0, PX1, (t)); partialSM(PX0, PX1, m_reg, mnX, alX);                                        \
        __syncthreads();                                                                                                      \
        if ((t) + 1 < NT) { VMW(); if constexpr (F32) { SWRITE_VF(SB); SBAR(); if ((t) + 2 < NT) SLOAD_F((const float*)Kh, KBASE((t) + 2)); } \
                            else { SWRITE_H(SB); } }                                                                          \
        RESC(alX); __syncthreads(); } while (0)
    for (int t = 1; t + 1 < NT; t += 2) {
        HALF_STEP(pB0, pB1, mnB, alB, pA0, pA1, alA, t, 1, 0, 0);
        HALF_STEP(pA0, pA1, mnA, alA, pB0, pB1, alB, t + 1, 0, 1, 1);
    }
    const bool even = (NT & 1) == 0;
    if (even) { SBAR(); qkt<1, SK>(pB0, pB1, K_lds, r32, hi, S.qr, ACT(NT - 1)); SBAR(); }
#define QROW(e) (nxt.Q + (size_t)(wid * QBLK + r32) * D + ((e) >> 1) * 16 + hi * 8 + ((e) & 1) * 4)
    if constexpr (F32) { SLOAD_F((const float*)nxt.K, kbn); SBAR();
#pragma unroll
        for (int e = 0; e < 8; ++e) S.tq[e] = *(const f32x4*)QROW(e); }
    else { SLOAD_H(nxt.K, nxt.V, kbn); SBAR();
#pragma unroll
        for (int d0 = 0; d0 < 8; ++d0) S.qr[d0] = load8<TIn>(nxt.Q + (size_t)(wid * QBLK + r32) * D + d0 * 16 + hi * 8); }
    SBAR();
    finishSM(pA0, pA1, alA, l_reg, pa0, pa1, pa2, pa3); SBAR();
    if constexpr (F32) {
#pragma unroll
        for (int e = 8; e < 16; ++e) S.tq[e] = *(const f32x4*)QROW(e); SBAR(); }
#undef QROW
    pv_tile<0, SK>(o, vb0, pa0, pa1, pa2, pa3, ACT(even ? NT - 2 : NT - 1));
    if (even) { MASKT(pB0, pB1, NT - 1); partialSM(pB0, pB1, m_reg, mnB, alB); __syncthreads(); RESC(alB);
        finishSM(pB0, pB1, alB, l_reg, pa0, pa1, pa2, pa3); SBAR(); pv_tile<1, SK>(o, vb0, pa0, pa1, pa2, pa3, ACT(NT - 1)); }
    SBAR(); SEAM_K0();
    if (hi == 0) li_l[r32] = l_reg; asm volatile("s_waitcnt lgkmcnt(0)" ::: "memory");
    float rli[16];
#pragma unroll
    for (int r = 0; r < 16; ++r) rli[r] = __builtin_amdgcn_rcpf(li_l[crow(r, hi)]);
    TOut* Ow = cur.O + (size_t)(wid * QBLK) * D;
#pragma unroll
    for (int r = 0; r < 16; ++r) { const int orow = crow(r, hi);
#pragma unroll
        for (int d0 = 0; d0 < 4; ++d0) { const float v = o[d0][r] * rli[r];
            if constexpr (same_t<TOut, float>::v) { Ow[(size_t)orow * D + d0 * 32 + r32] = v; }
            else { const float vn = __shfl_xor(v, 1);
                   if ((r32 & 1) == 0) *(unsigned*)(Ow + (size_t)orow * D + d0 * 32 + r32) = cvtpk(v, vn); } } }
    if constexpr (F32) {
#pragma unroll
        for (int d0 = 0; d0 < 8; ++d0) S.qr[d0] = pack8(S.tq[2 * d0], S.tq[2 * d0 + 1]); }
    __syncthreads();
#undef RESC
#undef KBASE
#undef ACT
#undef MASKT
#undef SEAM_K0
#undef HALF_STEP
}
#undef ROW
#undef VMW
#undef VMWN
#undef SLOAD_H
#undef SWRITE_HK
#undef SWRITE_HV
#undef SWRITE_H
#undef SLOAD_F
#undef SWRITE_KF
#undef SWRITE_VF
#undef KSWZ
#undef SBAR
}

namespace att2 {
typedef short bf16x8 __attribute__((ext_vector_type(8)));
typedef short s16x4 __attribute__((ext_vector_type(4)));
typedef float f32x16 __attribute__((ext_vector_type(16)));
typedef unsigned u32x4 __attribute__((ext_vector_type(4)));
constexpr float SCALE = 0.08838834764831845f, THR = 8.f, C2 = 1.4426950408889634f * SCALE;
constexpr int V_OFF = 0, K_OFF = 65536, PX_OFF = 98304, MX_OFF = 114688, WS_OFF = 118784, LDS_NEED = 120832;
#define A2_KSWZ(row, colB) ((row) * 256 + ((colB) ^ (((row) & 7) << 4)))
#define A2_SBAR() __builtin_amdgcn_sched_barrier(0)
template <int KB>
__device__ __forceinline__ void qkt(f32x16& p, const char* Kl, int krow, int hi, const bf16x8* qr) {
    p = f32x16{};
    const char* kbp[4];
#pragma unroll
    for (int dd = 0; dd < 4; ++dd) kbp[dd] = Kl + KB * 16384 + A2_KSWZ(krow, (dd * 16 + hi * 8) * 2);
    bf16x8 b[8];
#pragma unroll
    for (int d0 = 0; d0 < 8; ++d0) b[d0] = *reinterpret_cast<const bf16x8*>(kbp[d0 & 3] + (d0 >> 2) * 128);
    __builtin_amdgcn_s_setprio(3);
#pragma unroll
    for (int d0 = 0; d0 < 8; ++d0) p = __builtin_amdgcn_mfma_f32_32x32x16_bf16(b[d0], qr[d0], p, 0, 0, 0);
    __builtin_amdgcn_s_setprio(0);
}
template <int VOFFB>
__device__ __forceinline__ void pv(f32x16* o, int vb0, bf16x8 pa0, bf16x8 pa1, bf16x8 pa2, bf16x8 pa3) {
#define A2_TRRD(dst, off) asm volatile("ds_read_b64_tr_b16 %0, %1 offset:%2" : "=&v"(dst) : "v"(vb0), "i"(off) : "memory")
#define A2_PV_D0(d0) do { s16x4 l0, l1, l2, l3, h0, h1, h2, h3; constexpr int b_ = VOFFB + att::v_rd_off(d0, 0, 0); \
        A2_TRRD(l0, b_); A2_TRRD(h0, b_ + 2048); A2_TRRD(l1, b_ + 4096); A2_TRRD(h1, b_ + 6144); A2_TRRD(l2, b_ + 8192); A2_TRRD(h2, b_ + 10240); A2_TRRD(l3, b_ + 12288); A2_TRRD(h3, b_ + 14336); \
        asm volatile("s_waitcnt lgkmcnt(0)" ::: "memory"); A2_SBAR(); \
        o[d0] = __builtin_amdgcn_mfma_f32_32x32x16_bf16(pa0, (bf16x8){l0[0], l0[1], l0[2], l0[3], h0[0], h0[1], h0[2], h0[3]}, o[d0], 0, 0, 0); \
        o[d0] = __builtin_amdgcn_mfma_f32_32x32x16_bf16(pa1, (bf16x8){l1[0], l1[1], l1[2], l1[3], h1[0], h1[1], h1[2], h1[3]}, o[d0], 0, 0, 0); \
        o[d0] = __builtin_amdgcn_mfma_f32_32x32x16_bf16(pa2, (bf16x8){l2[0], l2[1], l2[2], l2[3], h2[0], h2[1], h2[2], h2[3]}, o[d0], 0, 0, 0); \
        o[d0] = __builtin_amdgcn_mfma_f32_32x32x16_bf16(pa3, (bf16x8){l3[0], l3[1], l3[2], l3[3], h3[0], h3[1], h3[2], h3[3]}, o[d0], 0, 0, 0); } while (0)
    __builtin_amdgcn_s_setprio(3); A2_PV_D0(0); A2_PV_D0(1); A2_PV_D0(2); A2_PV_D0(3); __builtin_amdgcn_s_setprio(0);
#undef A2_PV_D0
#undef A2_TRRD
}
__device__ __forceinline__ float rowmax16(const f32x16& p) {
    float pm = p[0];
#pragma unroll
    for (int r = 1; r < 16; ++r) pm = fmaxf(pm, p[r]);
    auto rr = __builtin_amdgcn_permlane32_swap(__float_as_uint(pm), __float_as_uint(pm), false, false);
    return fmaxf(__uint_as_float(rr[0]), __uint_as_float(rr[1]));
}
template <bool DEG>
__device__ __forceinline__ void block(const unsigned short* Q, const unsigned short* K, const unsigned short* V0, const unsigned short* V1, float* O0, float* O1, int P0, char* lds) {
    const int tid = opaque_tid(), wid = __builtin_amdgcn_readfirstlane(tid >> 6), lane = tid & 63, r32 = lane & 31, hi = lane >> 5, rg = wid >> 1, kh = wid & 1, hf = wid >> 2;
    const int NT = P0 / 64 + 2, qlo = P0 + 32 * rg;
    const int sr = tid >> 4, sc = (tid & 15) * 8, kws = A2_KSWZ(sr, sc * 2), vst0 = att::v_st(sr, sc), vst1 = att::v_st(32 + sr, sc);
    char* Vl = lds + V_OFF; char* Kl = lds + K_OFF;
    const int vb0 = (int)(uintptr_t)Vl + att::v_rd_base(lane) + kh * 16384, krow = 32 * kh + r32;
    float* wsl = (float*)(lds + WS_OFF) + wid * 64; float* al_l = wsl; float* li_l = wsl + 32;
    const float* li_p = (const float*)(lds + WS_OFF) + (wid ^ 1) * 64 + 32;
    float* mxw = (float*)(lds + MX_OFF) + wid * 64 + lane; const float* mxr = (const float*)(lds + MX_OFF) + (wid ^ 1) * 64 + lane;
    char* pxw = lds + PX_OFF + ((rg * 4 + 2 * kh) * 64 + lane) * 16; const char* pxr = lds + PX_OFF + (rg * 4 * 64 + lane) * 16;
    bf16x8 qr[8];
#pragma unroll
    for (int d0 = 0; d0 < 8; ++d0) qr[d0] = *reinterpret_cast<const bf16x8*>(Q + (size_t)(32 * rg + r32) * 128 + d0 * 16 + hi * 8);
    bf16x8 sk0, sk1, sv0, sv1, sv2, sv3;
#define A2_LOADK(t) do { const size_t o0_ = (size_t)((DEG ? 0 : (t)) * 64 + sr) * 128 + sc, o1_ = o0_ + 32 * 128; sk0 = *reinterpret_cast<const bf16x8*>(K + o0_); sk1 = *reinterpret_cast<const bf16x8*>(K + o1_); } while (0)
#define A2_LOADV(t) do { const size_t o0_ = (size_t)((DEG ? 0 : (t)) * 64 + sr) * 128 + sc, o1_ = o0_ + 32 * 128; \
        sv0 = *reinterpret_cast<const bf16x8*>(V0 + o0_); sv1 = *reinterpret_cast<const bf16x8*>(V0 + o1_); sv2 = *reinterpret_cast<const bf16x8*>(V1 + o0_); sv3 = *reinterpret_cast<const bf16x8*>(V1 + o1_); } while (0)
#define A2_BAR() do { asm volatile("s_waitcnt lgkmcnt(0)" ::: "memory"); __builtin_amdgcn_s_barrier(); asm volatile("" ::: "memory"); } while (0)
#define A2_WRITEK(b) do { *(bf16x8*)(Kl + (b) * 16384 + kws) = sk0; *(bf16x8*)(Kl + (b) * 16384 + kws + 32 * 256) = sk1; } while (0)
#define A2_WRITEV(b) do { *(bf16x8*)(Vl + (b) * 32768 + vst0) = sv0; *(bf16x8*)(Vl + (b) * 32768 + vst1) = sv1; *(bf16x8*)(Vl + (b) * 32768 + 16384 + vst0) = sv2; *(bf16x8*)(Vl + (b) * 32768 + 16384 + vst1) = sv3; } while (0)
#define A2_VMW(n) asm volatile("s_waitcnt vmcnt(%0)" :: "i"(n) : "memory")
#define A2_MASKMAX(PX, pmX, t) do { const int kb_ = (t) * 64 + 32 * kh; \
        if (kb_ + 31 > qlo) { const int dq_ = qlo + r32 - kb_ - 4 * hi; const float NEG_ = -__builtin_inff(); \
            _Pragma("unroll") for (int r = 0; r < 16; ++r) { const int c_ = (r & 3) + 8 * (r >> 2); if (dq_ - c_ < 0) PX[r] = NEG_; } } \
        pmX = rowmax16(PX); mxw[((t) & 1) * 512] = pmX; } while (0)
#define A2_FINISH(PY, pmY, alY, u) do { const float pm_ = fmaxf(pmY, mxr[((u) & 1) * 512]); float mn_; \
        if (__builtin_expect(__all((pm_ - m_reg) * SCALE <= THR), 1)) { mn_ = m_reg; alY = 1.f; } \
        else { mn_ = fmaxf(m_reg, pm_); alY = __builtin_amdgcn_exp2f((m_reg - mn_) * C2); m_reg = mn_; } \
        const float mnL_ = -mn_ * C2; \
        _Pragma("unroll") for (int r = 0; r < 16; ++r) PY[r] = __builtin_amdgcn_exp2f(fmaf(PY[r], C2, mnL_)); \
        float ps_ = 0.f; _Pragma("unroll") for (int r = 0; r < 16; ++r) ps_ += PY[r]; \
        { auto rr_ = __builtin_amdgcn_permlane32_swap(__float_as_uint(ps_), __float_as_uint(ps_), false, false); ps_ = __uint_as_float(rr_[0]) + __uint_as_float(rr_[1]); } \
        l_reg = l_reg * alY + ps_; \
        A2_PK4(PY, 0, pxw); A2_PK4(PY, 8, pxw + 1024); } while (0)
#define A2_PK4(P, B_, DST) do { unsigned a0_ = att::cvtpk(P[B_ + 0], P[B_ + 1]), a1_ = att::cvtpk(P[B_ + 2], P[B_ + 3]), b0_ = att::cvtpk(P[B_ + 4], P[B_ + 5]), b1_ = att::cvtpk(P[B_ + 6], P[B_ + 7]); \
        auto r0_ = __builtin_amdgcn_permlane32_swap(a0_, b0_, false, false); auto r1_ = __builtin_amdgcn_permlane32_swap(a1_, b1_, false, false); \
        u32x4 w_ = {r0_[0], r1_[0], r0_[1], r1_[1]}; *(u32x4*)(DST) = w_; } while (0)
#define A2_PVSTEP(alY, VOFFB) do { const bf16x8 pa0_ = *reinterpret_cast<const bf16x8*>(pxr), pa1_ = *reinterpret_cast<const bf16x8*>(pxr + 1024), pa2_ = *reinterpret_cast<const bf16x8*>(pxr + 2048), pa3_ = *reinterpret_cast<const bf16x8*>(pxr + 3072); \
        if (__any((alY) < 1.f)) { if (hi == 0) al_l[r32] = (alY); asm volatile("s_waitcnt lgkmcnt(0)" ::: "memory"); \
            _Pragma("unroll") for (int d_ = 0; d_ < 4; ++d_) _Pragma("unroll") for (int r = 0; r < 16; ++r) o[d_][r] *= al_l[att::crow(r, hi)]; } \
        pv<VOFFB>(o, vb0, pa0_, pa1_, pa2_, pa3_); } while (0)
#define A2_STEP(PX, pmX, PY, pmY, alY, t, KB) do { \
        if ((t) + 1 < NT) { A2_VMW(4); A2_WRITEK(1 - KB); if ((t) + 2 < NT) A2_LOADK((t) + 2); } A2_SBAR(); \
        qkt<KB>(PX, Kl, krow, hi, qr); \
        A2_FINISH(PY, pmY, alY, (t) - 1); \
        A2_MASKMAX(PX, pmX, t); \
        A2_BAR(); \
        if ((t) + 2 < NT) A2_VMW(2); else A2_VMW(0); \
        A2_WRITEV(KB); if ((t) + 1 < NT) A2_LOADV((t) + 1); A2_SBAR(); \
        A2_PVSTEP(alY, (1 - KB) * 32768); \
        A2_BAR(); } while (0)
    float m_reg = -1e30f, l_reg = 0.f; f32x16 o[4] = {};
    f32x16 pA, pB; float pmA, pmB, alA = 1.f, alB = 1.f;
    A2_LOADK(0); A2_VMW(0); A2_WRITEK(0); A2_LOADK(1); A2_LOADV(0);
    A2_BAR();
    if (hf == 1) A2_BAR();
    A2_VMW(4); A2_WRITEK(1); if (2 < NT) A2_LOADK(2); A2_SBAR();
    qkt<0>(pA, Kl, krow, hi, qr); A2_SBAR();
    A2_MASKMAX(pA, pmA, 0);
    A2_BAR();
    if (2 < NT) A2_VMW(2); else A2_VMW(0);
    A2_WRITEV(0); A2_LOADV(1);
    A2_BAR();
    A2_STEP(pB, pmB, pA, pmA, alA, 1, 1);
    for (int t = 2; t < NT; t += 2) {
        A2_STEP(pA, pmA, pB, pmB, alB, t, 0);
        A2_STEP(pB, pmB, pA, pmA, alA, t + 1, 1);
    }
    A2_FINISH(pB, pmB, alB, NT - 1);
    A2_BAR();
    A2_PVSTEP(alB, 32768);
    if (hf == 0) A2_BAR();
    if (hi == 0) li_l[r32] = l_reg;
    A2_BAR();
    float rli[16];
#pragma unroll
    for (int r = 0; r < 16; ++r) rli[r] = __builtin_amdgcn_rcpf(li_l[att::crow(r, hi)] + li_p[att::crow(r, hi)]);
    float* Ow = (kh ? O1 : O0) + (size_t)(32 * rg) * 128;
#pragma unroll
    for (int r = 0; r < 16; ++r) { const int orow = att::crow(r, hi);
#pragma unroll
        for (int d0 = 0; d0 < 4; ++d0) Ow[(size_t)orow * 128 + d0 * 32 + r32] = o[d0][r] * rli[r]; }
    A2_BAR();
#undef A2_LOADK
#undef A2_LOADV
#undef A2_BAR
#undef A2_WRITEK
#undef A2_WRITEV
#undef A2_VMW
#undef A2_MASKMAX
#undef A2_FINISH
#undef A2_PK4
#undef A2_PVSTEP
#undef A2_STEP
}
#undef A2_KSWZ
#undef A2_SBAR
}

#ifndef MK_PER_PHASE
#define MK_PER_PHASE 0
#endif
constexpr int NWAVES = 8, NTHR = 512;
constexpr int SEQ = 16384, DM = 4096, FFH = 11008, DEPTH = 4, NMODV = 6 * DM;
#ifndef PADK
#define PADK 64
#endif
constexpr int LDD = DM + PADK, LDF = FFH + PADK;
constexpr int ZG = 96;
constexpr size_t GS = (size_t)SEQ * 128;
constexpr int S5T = 64, S5NC = SEQ / S5T;
constexpr int KSL = 16;
constexpr float NORM_EPS = 1e-6f, SUBLN_EPS = 1e-5f;
constexpr int N_PHASES = 35;

constexpr size_t MiB = 1u << 20;
constexpr size_t WS_CTL = 0, CTL_ZERO_BYTES = 64 * 1024;
constexpr size_t WS_MODP = 1 * MiB;
constexpr size_t WS_MODL = 3 * MiB;
constexpr size_t WS_LAM = 3 * MiB + 512 * 1024;
constexpr size_t WS_S5P = 4 * MiB, S5P_LAYER = 4 * MiB + 256 * 1024;
constexpr size_t S5P_ABR = 0, S5P_ABI = 64 * 1024, S5P_ATR = 128 * 1024, S5P_ATI = 192 * 1024, S5P_BBR = 256 * 1024, S5P_BBI = 256 * 1024 + MiB;
constexpr size_t S5P_BBOP = 256 * 1024 + 2 * MiB, S5P_COP = 256 * 1024 + 3 * MiB;
#ifndef S5_MFMA
#define S5_MFMA 1
#endif
constexpr size_t W_IN_B = (size_t)12288 * LDD * 2, W_OUT_B = (size_t)4096 * LDD * 2, W_GLU_B = (size_t)8192 * LDD * 2, W_GU_B = (size_t)22016 * LDD * 2, W_DN_B = (size_t)4096 * LDF * 2;
constexpr size_t WS_WIN = 16 * MiB, WS_WOUT = WS_WIN + 2 * W_IN_B, WS_WGLU = WS_WOUT + 2 * W_OUT_B, WS_WGU = WS_WGLU + 2 * W_GLU_B, WS_WDN = WS_WGU + 4 * W_GU_B;
constexpr size_t WS_H = WS_WDN + 4 * W_DN_B;
constexpr size_t WS_MIX = WS_H + (size_t)SEQ * LDD * 2;
constexpr size_t WS_Z = WS_MIX + (size_t)SEQ * LDD * 2;
constexpr size_t WS_OT = WS_Z + (size_t)ZG * GS * 2;
constexpr size_t WS_S5F = WS_OT + (size_t)32 * GS * 4;
constexpr size_t WS_S5H = WS_S5F + (size_t)S5NC * 256 * 128 * 4;
constexpr size_t WS_END = WS_S5H + (size_t)S5NC * 256 * 128 * 4;
static_assert((size_t)SEQ * LDF * 2 <= (size_t)ZG * GS * 2, "hidden overlays Z");
static_assert(WS_WIN % 256 == 0 && WS_H % 256 == 0 && WS_OT % 256 == 0 && WS_S5F % 256 == 0, "alignment");
constexpr int CW_BAR = 1024;

constexpr int RING_BYTES = 131072, MISC_OFF = RING_BYTES + 320, LDS_BYTES = 147456;

#define GAS __attribute__((address_space(1)))
#define LAS __attribute__((address_space(3)))
typedef unsigned short bf16;
typedef unsigned v4u __attribute__((ext_vector_type(4)));
typedef unsigned v2u __attribute__((ext_vector_type(2)));
typedef float f32x4 __attribute__((ext_vector_type(4)));
#define LDS_WAIT() asm volatile("s_waitcnt lgkmcnt(0)" ::: "memory")
#define VM_WAIT() asm volatile("s_waitcnt vmcnt(0)" ::: "memory")
__device__ __forceinline__ unsigned pk2(float lo, float hi) { unsigned r; asm volatile("v_cvt_pk_bf16_f32 %0, %1, %2" : "=v"(r) : "v"(lo), "v"(hi)); return r; }
__device__ __forceinline__ float bflo(unsigned w) { return __builtin_bit_cast(float, w << 16); }
__device__ __forceinline__ float bfhi(unsigned w) { return __builtin_bit_cast(float, w & 0xffff0000u); }

#define XB_TMO      128
#define XB_XCNT(j)  (256  + 64 * (j))
#define XB_XSUB(j)  (1280 + 64 * (j))
#define XB_XGEN(j)  (2304 + 64 * (j))
#define XB_TOP      3328
#define XB_TOPGEN   3392
#define XCD_BAR_WORDS 3456
#define XB_SPIN_CAP (1u << 22)

__device__ __forceinline__ unsigned xb_ld(unsigned* p)              { return __hip_atomic_load(p, __ATOMIC_RELAXED, __HIP_MEMORY_SCOPE_AGENT); }
__device__ __forceinline__ unsigned xb_add(unsigned* p, unsigned v) { return __hip_atomic_fetch_add(p, v, __ATOMIC_RELAXED, __HIP_MEMORY_SCOPE_AGENT); }
__device__ __forceinline__ unsigned xb_xcc_id() { return (unsigned)__builtin_amdgcn_s_getreg((3 << 11) | 20) & 0xFu; }
#define XB_SPIN(cond, bar) do { unsigned _sp = 0; while (cond) { __builtin_amdgcn_s_sleep(1); \
    if ((++_sp & 255u) == 0u) { if (xb_ld(&(bar)[XB_TMO])) break; if (_sp > XB_SPIN_CAP) { atomicAdd(&(bar)[XB_TMO], 1u); break; } } } } while (0)

struct XcdBarrier {
    unsigned* bar; unsigned x;
    volatile LAS unsigned* st;
};
__device__ __forceinline__ XcdBarrier xcd_barrier_post(unsigned* bar, volatile LAS unsigned* st) {
    XcdBarrier b; b.bar = bar; b.x = xb_xcc_id(); b.st = st;
    if (threadIdx.x == 0) (void)xb_add(&bar[XB_XCNT(b.x)], 1u);
    return b;
}
__device__ __forceinline__ void xcd_barrier_complete(unsigned* bar, unsigned x, unsigned& nloc, unsigned& nx) {
    const unsigned G = gridDim.x * gridDim.y * gridDim.z;
    unsigned sum, cnt, mine, sp = 0u;
    for (;;) {
        sum = 0u; cnt = 0u; mine = 0u;
#pragma unroll
        for (unsigned j = 0; j < 16; ++j) { const unsigned c = xb_ld(&bar[XB_XCNT(j)]); sum += c; cnt += (c > 0u) ? 1u : 0u; mine = (j == x) ? c : mine; }
        if (sum == G) break;
        __builtin_amdgcn_s_sleep(1);
        if ((++sp & 255u) == 0u) { if (xb_ld(&bar[XB_TMO])) break; if (sp > XB_SPIN_CAP) { atomicAdd(&bar[XB_TMO], 1u); break; } }
    }
    nloc = mine > 0u ? mine : 1u; nx = cnt > 0u ? cnt : 1u;
}
__device__ __forceinline__ void xcd_barrier(const XcdBarrier& b) {
    asm volatile("s_waitcnt vmcnt(0)" ::: "memory");
    __syncthreads();
    if (threadIdx.x == 0) {
        unsigned* bar = b.bar;
        __builtin_amdgcn_s_waitcnt(0);
        unsigned nloc = b.st[0], nx = b.st[1];
        if (nloc == 0u) { xcd_barrier_complete(bar, b.x, nloc, nx); b.st[0] = nloc; b.st[1] = nx; }
        const unsigned old = xb_add(&bar[XB_XSUB(b.x)], 1u);
        const unsigned gen = old / nloc;
        if (old + 1u == (gen + 1u) * nloc) {
            __builtin_amdgcn_fence(__ATOMIC_RELEASE, "agent");
            asm volatile("s_waitcnt vmcnt(0)" ::: "memory");
            const unsigned og = xb_add(&bar[XB_TOP], 1u);
            const unsigned tg = og / nx;
            if (og + 1u == (tg + 1u) * nx) xb_add(&bar[XB_TOPGEN], 1u);
            else XB_SPIN(xb_ld(&bar[XB_TOPGEN]) == tg, bar);
            __builtin_amdgcn_fence(__ATOMIC_ACQUIRE, "agent");
            xb_add(&bar[XB_XGEN(b.x)], 1u);
            asm volatile("s_waitcnt vmcnt(0)" ::: "memory");
        } else {
            XB_SPIN(xb_ld(&bar[XB_XGEN(b.x)]) == gen, bar);
            __builtin_amdgcn_fence(__ATOMIC_ACQUIRE, "agent");
            asm volatile("s_waitcnt vmcnt(0)" ::: "memory");
        }
    }
    __syncthreads();
}

__device__ __forceinline__ float wave_sum(float v) {
#pragma unroll
    for (int o = 1; o < 64; o <<= 1) v += __shfl_xor(v, o);
    return v;
}

__device__ __forceinline__ void transpose_item(const float* W, int K, int N, bf16* WT, int ldw, int mode, LAS float* scr, int item, int lane) {
    const int nblk = N / 32, kb = item / nblk, nb = item - kb * nblk, k0 = 64 * kb, n0 = 32 * nb;
    const int drow0 = mode == 0 ? n0 : ((n0 >> 7) * 256 + (n0 & 127) + (mode == 2 ? 128 : 0));
#pragma unroll 8
    for (int i = 0; i < 32; ++i) { const int kk = 2 * i + (lane >> 5); scr[kk * 33 + (lane & 31)] = W[(size_t)(k0 + kk) * N + n0 + (lane & 31)]; }
    LDS_WAIT(); asm volatile("" ::: "memory");
    const int c = lane & 7;
#pragma unroll
    for (int j = 0; j < 4; ++j) { const int n = (lane >> 3) + 8 * j; const LAS float* s = scr + (8 * c) * 33 + n;
        v4u o; o.x = pk2(s[0 * 33], s[1 * 33]); o.y = pk2(s[2 * 33], s[3 * 33]); o.z = pk2(s[4 * 33], s[5 * 33]); o.w = pk2(s[6 * 33], s[7 * 33]);
        *(v4u*)(WT + (size_t)(drow0 + n) * ldw + k0 + 8 * c) = o; }
    LDS_WAIT(); asm volatile("" ::: "memory");
}
__device__ __forceinline__ void dsincos(double x, double& s, double& c) {
    const double k = rint(x * 0.63661977236758134308);
    double r = fma(-k, 1.5707963267948966192, x); r = fma(-k, 6.1232339957367658860e-17, r);
    const double r2 = r * r;
    double ps = -1.0 / 1307674368000.0; ps = fma(ps, r2, 1.0 / 6227020800.0); ps = fma(ps, r2, -1.0 / 39916800.0); ps = fma(ps, r2, 1.0 / 362880.0); ps = fma(ps, r2, -1.0 / 5040.0);
    ps = fma(ps, r2, 1.0 / 120.0); ps = fma(ps, r2, -1.0 / 6.0); ps = fma(ps, r2, 1.0); const double sn = r * ps;
    double pc = 1.0 / 20922789888000.0; pc = fma(pc, r2, -1.0 / 87178291200.0); pc = fma(pc, r2, 1.0 / 479001600.0); pc = fma(pc, r2, -1.0 / 3628800.0); pc = fma(pc, r2, 1.0 / 40320.0);
    pc = fma(pc, r2, -1.0 / 720.0); pc = fma(pc, r2, 1.0 / 24.0); pc = fma(pc, r2, -0.5); const double cs = fma(pc, r2, 1.0);
    const int q = (int)k & 3;
    s = (q == 0) ? sn : (q == 1) ? cs : (q == 2) ? -sn : -cs;
    c = (q == 0) ? cs : (q == 1) ? -sn : (q == 2) ? -cs : sn;
}
__device__ __forceinline__ double dexp(double x) {
    const double k = rint(x * 1.4426950408889634074);
    double r = fma(-k, 0.69314718055994528623, x); r = fma(-k, 2.3190468138462995584e-17, r);
    double p = 1.0 / 87178291200.0; p = fma(p, r, 1.0 / 6227020800.0); p = fma(p, r, 1.0 / 479001600.0); p = fma(p, r, 1.0 / 39916800.0); p = fma(p, r, 1.0 / 3628800.0); p = fma(p, r, 1.0 / 362880.0);
    p = fma(p, r, 1.0 / 40320.0); p = fma(p, r, 1.0 / 5040.0); p = fma(p, r, 1.0 / 720.0); p = fma(p, r, 1.0 / 120.0); p = fma(p, r, 1.0 / 24.0); p = fma(p, r, 1.0 / 6.0); p = fma(p, r, 0.5); p = fma(p, r, 1.0); p = fma(p, r, 1.0);
    const long long bits = (long long)(1023 + (int)k) << 52;
    return p * __builtin_bit_cast(double, bits);
}

struct Args { const float* in[29]; float* out; unsigned char* ws; int ph_lo, ph_hi; };

__device__ __forceinline__ void p0_prologue(const Args& A, LAS unsigned char* lds, int gw, int NGW, int wave, int lane) {
    unsigned char* ws = A.ws;
    for (int w = gw; w < 96 * KSL + 512 + 2048; w += NGW) {
    if (w >= 96 * KSL + 512) {
        const int idx = (w - 96 * KSL - 512) * 64 + lane, o = idx >> 16, r = idx & 65535, g = r >> 8, mm = (r >> 6) & 3, o16 = lane & 15, kq = lane >> 4;
        const int tau = 2 * mm, p0 = 16 * (tau & 3) + 4 * kq;
        const float* cs = (tau < 4 ? A.in[21] : A.in[22]) + (size_t)o * 256 * 16 * 64 + (size_t)(g * 16 + o16) * 64 + p0; const float sg = tau < 4 ? 1.0f : -1.0f;
        const f32x4 a = *(const f32x4*)cs * sg, b = *(const f32x4*)(cs + 16) * sg;
        v4u q; q.x = pk2(a.x, a.y); q.y = pk2(a.z, a.w); q.z = pk2(b.x, b.y); q.w = pk2(b.z, b.w);
        *(v4u*)(ws + WS_S5P + (size_t)o * S5P_LAYER + S5P_COP + ((size_t)((g * 4 + mm) * 64 + lane)) * 16) = q;
    } else if (w < 96 * KSL) {
        const int nb = w % 96, ks = w / 96;
        const float* wp = A.in[2] + (size_t)(ks * 256) * NMODV + nb * 256 + lane * 4; const float* cp = A.in[1] + ks * 256;
        f32x4 a = {0.f, 0.f, 0.f, 0.f};
#pragma unroll 8
        for (int k = 0; k < 256; ++k) { const float cv = cp[k]; const float s = cv / (1.0f + expf(-cv)); const f32x4 w = *(const f32x4*)(wp + (size_t)k * NMODV); a += s * w; }
        *(f32x4*)((float*)(ws + WS_MODP) + (size_t)ks * NMODV + nb * 256 + lane * 4) = a;
    } else {
        const int idx = (w - 96 * KSL) * 64 + lane, o = idx >> 14, gp = idx & 16383, g = gp >> 6;
        const double lr = (double)fminf(A.in[16][idx], -1e-4f), li = (double)A.in[17][idx], dt = dexp((double)A.in[18][o * 256 + g]);
        const double mag = dexp(lr * dt); double sn, cs; dsincos(li * dt, sn, cs);
        const double abr = mag * cs, abi = mag * sn, den = lr * lr + li * li, nr = abr - 1.0, ni = abi;
        const double fre = (nr * lr + ni * li) / den, fim = (ni * lr - nr * li) / den;
        double tr = abr, ti = abi;
#pragma unroll
        for (int q = 0; q < 6; ++q) { const double t2 = tr * tr - ti * ti; ti = 2.0 * tr * ti; tr = t2; }
        unsigned char* pb = ws + WS_S5P + (size_t)o * S5P_LAYER;
        ((float*)(pb + S5P_ABR))[gp] = (float)abr; ((float*)(pb + S5P_ABI))[gp] = (float)abi; ((float*)(pb + S5P_ATR))[gp] = (float)tr; ((float*)(pb + S5P_ATI))[gp] = (float)ti;
        const float* bre = A.in[19] + (size_t)idx * 16; const float* bim = A.in[20] + (size_t)idx * 16;
        float* obr = (float*)(pb + S5P_BBR) + (size_t)gp * 16; float* obi = (float*)(pb + S5P_BBI) + (size_t)gp * 16;
#pragma unroll
        for (int h4 = 0; h4 < 4; ++h4) { const f32x4 br = *(const f32x4*)(bre + 4 * h4), bi = *(const f32x4*)(bim + 4 * h4); f32x4 r, i;
#pragma unroll
            for (int j = 0; j < 4; ++j) { r[j] = (float)(fre * (double)br[j] - fim * (double)bi[j]); i[j] = (float)(fre * (double)bi[j] + fim * (double)br[j]); }
            *(f32x4*)(obr + 4 * h4) = r; *(f32x4*)(obi + 4 * h4) = i; }
        { const int p = gp & 63, ti = p >> 4, i16 = p & 15;
#pragma unroll
          for (int kq = 0; kq < 4; ++kq) { const f32x4 r = *(const f32x4*)(obr + 4 * kq), i = *(const f32x4*)(obi + 4 * kq);
              v2u pr, pi; pr.x = pk2(r.x, r.y); pr.y = pk2(r.z, r.w); pi.x = pk2(i.x, i.y); pi.y = pk2(i.z, i.w);
              *(v2u*)(pb + S5P_BBOP + ((size_t)((g * 8 + ti) * 64 + kq * 16 + i16)) * 8) = pr; *(v2u*)(pb + S5P_BBOP + ((size_t)((g * 8 + 4 + ti) * 64 + kq * 16 + i16)) * 8) = pi; } }
    }
    }
    if (gw < 2) { const int e = gw;
        const float s1 = wave_sum(A.in[10][e * 128 + lane] * A.in[11][e * 128 + lane] + A.in[10][e * 128 + 64 + lane] * A.in[11][e * 128 + 64 + lane]);
        const float s2 = wave_sum(A.in[12][e * 128 + lane] * A.in[13][e * 128 + lane] + A.in[12][e * 128 + 64 + lane] * A.in[13][e * 128 + 64 + lane]);
        const float lam_init = e == 0 ? 0.2f : 0.4707130183435842f;
        if (lane == 0) ((float*)(ws + WS_LAM))[e] = expf(s1) - expf(s2) + lam_init; }
    LAS float* scr = (LAS float*)(lds + wave * 16384);
    constexpr int I_IN = 64 * 384, I_OUT = 64 * 128, I_GLU = 64 * 128, I_GU = 64 * 344, I_DN = 172 * 128;
    constexpr int NITEMS = 2 * I_IN + 2 * I_OUT + 4 * I_GLU + 8 * I_GU + 4 * I_DN;
    for (int it = gw; it < NITEMS; it += NGW) {
        int r = it;
        if (r < 2 * I_IN) { const int e = r / I_IN; transpose_item(A.in[8] + (size_t)e * DM * 12288, DM, 12288, (bf16*)(ws + WS_WIN + e * W_IN_B), LDD, 0, scr, r - e * I_IN, lane); continue; } r -= 2 * I_IN;
        if (r < 2 * I_OUT) { const int e = r / I_OUT; transpose_item(A.in[15] + (size_t)e * DM * DM, DM, DM, (bf16*)(ws + WS_WOUT + e * W_OUT_B), LDD, 0, scr, r - e * I_OUT, lane); continue; } r -= 2 * I_OUT;
        if (r < 4 * I_GLU) { const int q = r / I_GLU, o = q >> 1, s = q & 1; transpose_item(A.in[24 + s] + (size_t)o * DM * DM, DM, DM, (bf16*)(ws + WS_WGLU + o * W_GLU_B), LDD, 1 + s, scr, r - q * I_GLU, lane); continue; } r -= 4 * I_GLU;
        if (r < 8 * I_GU) { const int q = r / I_GU, l = q >> 1, s = q & 1; transpose_item(A.in[26 + s] + (size_t)l * DM * FFH, DM, FFH, (bf16*)(ws + WS_WGU + l * W_GU_B), LDD, 1 + s, scr, r - q * I_GU, lane); continue; } r -= 8 * I_GU;
        { const int l = r / I_DN; transpose_item(A.in[28] + (size_t)l * FFH * DM, FFH, DM, (bf16*)(ws + WS_WDN + l * W_DN_B), LDF, 0, scr, r - l * I_DN, lane); }
    }
}
__device__ __forceinline__ void p1_modvec(const Args& A, int gtid, int NGT) {
    const float* mp = (const float*)(A.ws + WS_MODP); float* ml = (float*)(A.ws + WS_MODL);
    for (int i = gtid; i < DEPTH * NMODV; i += NGT) { const int j = i % NMODV; float v = A.in[3][j] + A.in[4][i];
#pragma unroll
        for (int ks = 0; ks < KSL; ++ks) v += mp[(size_t)ks * NMODV + j];
        ml[i] = v; }
}
__device__ __forceinline__ void norm_mod_phase(const float* src, const float* nw, const float* sh, const float* sc, bf16* dst, LAS unsigned char* lds, int tid, int gw, int NGW, int lane) {
    LAS float* w1 = (LAS float*)lds; LAS float* bb = w1 + DM;
    for (int i = tid; i < DM; i += NTHR) { w1[i] = nw[i] * (1.0f + sc[i]); bb[i] = sh[i]; }
    __syncthreads();
    for (int m = gw; m < SEQ; m += NGW) {
        const f32x4* xr = (const f32x4*)(src + (size_t)m * DM) + lane;
        f32x4 v[16]; float ss = 0.f;
#pragma unroll
        for (int j = 0; j < 16; ++j) { v[j] = xr[64 * j]; ss += (v[j].x * v[j].x + v[j].y * v[j].y) + (v[j].z * v[j].z + v[j].w * v[j].w); }
        const float rstd = 1.0f / sqrtf(wave_sum(ss) * (1.0f / DM) + NORM_EPS);
        v2u* o8 = (v2u*)(dst + (size_t)m * LDD) + lane;
#pragma unroll
        for (int j = 0; j < 16; ++j) { const int col = j * 256 + lane * 4; const f32x4 w = *(const LAS f32x4*)(w1 + col), b = *(const LAS f32x4*)(bb + col);
            const f32x4 y = v[j] * rstd * w + b; v2u p; p.x = pk2(y.x, y.y); p.y = pk2(y.z, y.w); o8[64 * j] = p; }
    }
    __syncthreads();
}
__device__ __forceinline__ void final_norm_phase(const float* src, const float* nw, float* dst, int gw, int NGW, int lane) {
    for (int m = gw; m < SEQ; m += NGW) {
        const f32x4* xr = (const f32x4*)(src + (size_t)m * DM) + lane;
        f32x4 v[16]; float ss = 0.f;
#pragma unroll
        for (int j = 0; j < 16; ++j) { v[j] = xr[64 * j]; ss += (v[j].x * v[j].x + v[j].y * v[j].y) + (v[j].z * v[j].z + v[j].w * v[j].w); }
        const float rstd = 1.0f / sqrtf(wave_sum(ss) * (1.0f / DM) + NORM_EPS);
        f32x4* o = (f32x4*)(dst + (size_t)m * DM) + lane; const f32x4* wv = (const f32x4*)nw + lane;
#pragma unroll
        for (int j = 0; j < 16; ++j) o[64 * j] = v[j] * rstd * wv[64 * j];
    }
}
__device__ __forceinline__ void conv_phase(const bf16* Z, const float* cw, bf16* MIX, int gtid, int NGT) {
    for (int i = gtid; i < SEQ * 256; i += NGT) {
        const int t = i >> 8, r = i & 255, gi = r >> 4, c8 = (r & 15) * 8;
        const size_t o = (size_t)t * 128 + c8;
        const v4u zero = {0u, 0u, 0u, 0u};
        const v4u vb = *(const v4u*)(Z + (size_t)gi * GS + o);
        const bf16* zc = Z + (size_t)(16 + gi) * GS + o; const bf16* zx = Z + (size_t)(32 + gi) * GS + o;
        const v4u c0 = *(const v4u*)zc, x0 = *(const v4u*)zx;
        const v4u c1 = t >= 1 ? *(const v4u*)(zc - 128) : zero, x1 = t >= 1 ? *(const v4u*)(zx - 128) : zero;
        const v4u c2 = t >= 2 ? *(const v4u*)(zc - 256) : zero, x2 = t >= 2 ? *(const v4u*)(zx - 256) : zero;
        const float* wp = cw + gi * 128 + c8;
        float y[8];
#pragma unroll
        for (int q = 0; q < 4; ++q) {
            const float u0l = bflo(c0[q]) * bflo(x0[q]), u0h = bfhi(c0[q]) * bfhi(x0[q]);
            const float u1l = bflo(c1[q]) * bflo(x1[q]), u1h = bfhi(c1[q]) * bfhi(x1[q]);
            const float u2l = bflo(c2[q]) * bflo(x2[q]), u2h = bfhi(c2[q]) * bfhi(x2[q]);
            const int j = 2 * q;
            y[j]     = bflo(vb[q]) * (wp[2 * 2048 + j] * u0l + wp[2048 + j] * u1l + wp[j] * u2l);
            y[j + 1] = bfhi(vb[q]) * (wp[2 * 2048 + j + 1] * u0h + wp[2048 + j + 1] * u1h + wp[j + 1] * u2h);
        }
        v4u w; w.x = pk2(y[0], y[1]); w.y = pk2(y[2], y[3]); w.z = pk2(y[4], y[5]); w.w = pk2(y[6], y[7]);
        *(v4u*)(MIX + (size_t)t * LDD + gi * 128 + c8) = w;
    }
}
__device__ __forceinline__ void combine_phase(const float* OT, const float* lamp, const float* sg, float lam_init, bf16* MIX, int gw, int NGW, int lane) {
    const float lam = lamp[0], os = 1.0f - lam_init;
    const int j = lane >> 5, c4 = (lane & 31) * 4;
    const f32x4 gv = *(const f32x4*)(sg + 128 * j + c4);
    for (int it = gw; it < SEQ * 8; it += NGW) {
        const int t = it >> 3, h = it & 7;
        const f32x4 a = *(const f32x4*)(OT + (size_t)(h * 4 + j) * GS + (size_t)t * 128 + c4), b = *(const f32x4*)(OT + (size_t)(h * 4 + 2 + j) * GS + (size_t)t * 128 + c4);
        const f32x4 o = a - lam * b;
        const float rstd = 1.0f / sqrtf(wave_sum((o.x * o.x + o.y * o.y) + (o.z * o.z + o.w * o.w)) * (1.0f / 256.0f) + SUBLN_EPS);
        const f32x4 y = o * (rstd * os) * gv;
        v2u p; p.x = pk2(y.x, y.y); p.y = pk2(y.z, y.w);
        *(v2u*)(MIX + (size_t)t * LDD + 2048 + 256 * h + 128 * j + c4) = p;
    }
}
__device__ __forceinline__ att::BlockRef<att::bf16, float> att_ref(const bf16* Z, float* OT, int item, int pass) {
    const int r = item >> 8, b = item & 255, vh = r * 8 + (b & 7), pair = b >> 3, qb = pass ? 63 - pair : pair;
    const int h = vh >> 2, m = (vh >> 1) & 1, j = vh & 1;
    att::BlockRef<att::bf16, float> R;
    R.Q = (const att::bf16*)(Z + (size_t)(48 + 2 * h + m) * GS + (size_t)qb * 256 * 128);
    R.K = (const att::bf16*)(Z + (size_t)(64 + 2 * h + m) * GS);
    R.V = (const att::bf16*)(Z + (size_t)(80 + 2 * h + j) * GS);
    R.O = OT + (size_t)vh * GS + (size_t)qb * 256 * 128; R.P0 = qb * 256;
    return R;
}
__device__ __forceinline__ void attn_phase(const bf16* Z, float* OT, char* lds, int bid, int G) {
    constexpr int TOTAL = 1024;
    int item = bid; if (item >= TOTAL) return;
    int pass = 0;
    att::BlockRef<att::bf16, float> cur = att_ref(Z, OT, item, 0);
    att::Seam<att::bf16> S;
    att::causal_swa_prime<att::bf16, float>(cur, SEQ, lds, S);
    for (;;) {
        const bool more_pass = pass == 0, more_item = item + G < TOTAL, last = !more_pass && !more_item;
        int itn = item, passn = 1;
        if (!more_pass) { passn = 0; itn = more_item ? item + G : item; }
        const att::BlockRef<att::bf16, float> nxt = last ? cur : att_ref(Z, OT, itn, passn);
        att::causal_swa_block<att::bf16, float>(cur, nxt, SEQ, SEQ, lds, S);
        if (last) break;
        cur = nxt; item = itn; pass = passn;
    }
}
#ifndef ATT2
#define ATT2 1
#endif
template <bool DEG>
__device__ __forceinline__ void attn2_phase(const bf16* Z, float* OT, char* lds, int bid, int G) {
    for (int item = bid; item < 1024; item += G) {
        const int r = item >> 8, b = item & 255, hm = 2 * (b & 7) + (r >> 1), pair = (r & 1) * 32 + (b >> 3), h = hm >> 1, m = hm & 1;
        for (int pass = 0; pass < 2; ++pass) { const int qb = pass ? 127 - pair : pair;
            att2::block<DEG>(Z + (size_t)(48 + 2 * h + m) * GS + (size_t)qb * 128 * 128, Z + (size_t)(64 + 2 * h + m) * GS, Z + (size_t)(80 + 2 * h) * GS, Z + (size_t)(81 + 2 * h) * GS,
                        OT + (size_t)(h * 4 + m * 2) * GS + (size_t)qb * 128 * 128, OT + (size_t)(h * 4 + m * 2 + 1) * GS + (size_t)qb * 128 * 128, qb * 128, lds); }
    }
}
__device__ __forceinline__ float gelu_tanh(float x) { const float z = 1.5957691216057308f * (x + 0.044715f * x * x * x); return x * __builtin_amdgcn_rcpf(1.0f + __builtin_amdgcn_exp2f(-1.4426950408889634f * z)); }
template <bool PASS2>
__device__ __forceinline__ void s5_pass(const bf16* Hin, const unsigned char* prm, const float* c_re, const float* c_im, const float* dsk, float* F, const float* HC, bf16* Gout,
                                        LAS unsigned char* lds, int gw, int NGW, int wave, int lane) {
    LAS float* lu = (LAS float*)(lds + wave * 4096);
    for (int item = gw; item < 256 * S5NC; item += NGW) {
        const int g = item & 255, c = item >> 8, gp = g * 64 + lane;
        { const bf16* up = Hin + (size_t)(c * S5T + lane) * LDD + 16 * g; const v4u a = *(const v4u*)up, b = *(const v4u*)(up + 8);
          LAS f32x4* ur = (LAS f32x4*)(lu + lane * 16);
          ur[0] = (f32x4){bflo(a.x), bfhi(a.x), bflo(a.y), bfhi(a.y)}; ur[1] = (f32x4){bflo(a.z), bfhi(a.z), bflo(a.w), bfhi(a.w)};
          ur[2] = (f32x4){bflo(b.x), bfhi(b.x), bflo(b.y), bfhi(b.y)}; ur[3] = (f32x4){bflo(b.z), bfhi(b.z), bflo(b.w), bfhi(b.w)}; }
        f32x4 bbr[4], bbi[4];
#pragma unroll
        for (int q = 0; q < 4; ++q) { bbr[q] = *(const f32x4*)((const float*)(prm + S5P_BBR) + (size_t)gp * 16 + 4 * q); bbi[q] = *(const f32x4*)((const float*)(prm + S5P_BBI) + (size_t)gp * 16 + 4 * q); }
        const float abr = ((const float*)(prm + S5P_ABR))[gp], abi = ((const float*)(prm + S5P_ABI))[gp];
        float hr = 0.f, hi = 0.f, cr[16], ci[16], dk = 0.f;
        if (PASS2) {
#pragma unroll
            for (int o = 0; o < 16; ++o) { cr[o] = c_re[(size_t)(g * 16 + o) * 64 + lane]; ci[o] = c_im[(size_t)(g * 16 + o) * 64 + lane]; }
            hr = HC[(size_t)(c * 256 + g) * 128 + lane]; hi = HC[(size_t)(c * 256 + g) * 128 + 64 + lane]; dk = dsk[16 * g + (lane >> 2)];
        }
        LDS_WAIT(); asm volatile("" ::: "memory");
#pragma unroll 2
        for (int t = 0; t < S5T; ++t) {
            const LAS f32x4* ut = (const LAS f32x4*)(lu + t * 16);
            float bur = 0.f, bui = 0.f;
#pragma unroll
            for (int q = 0; q < 4; ++q) { const f32x4 u = ut[q];
                bur += (bbr[q].x * u.x + bbr[q].y * u.y) + (bbr[q].z * u.z + bbr[q].w * u.w); bui += (bbi[q].x * u.x + bbi[q].y * u.y) + (bbi[q].z * u.z + bbi[q].w * u.w); }
            const float nr = abr * hr - abi * hi + bur, ni = abr * hi + abi * hr + bui; hr = nr; hi = ni;
            if (PASS2) {
                float v[16];
#pragma unroll
                for (int o = 0; o < 16; ++o) v[o] = hr * cr[o] - hi * ci[o];
#pragma unroll
                for (int i = 0; i < 8; ++i) { const float send = (lane & 32) ? v[i] : v[i + 8], keep = (lane & 32) ? v[i + 8] : v[i]; v[i] = keep + __shfl_xor(send, 32); }
#pragma unroll
                for (int i = 0; i < 4; ++i) { const float send = (lane & 16) ? v[i] : v[i + 4], keep = (lane & 16) ? v[i + 4] : v[i]; v[i] = keep + __shfl_xor(send, 16); }
#pragma unroll
                for (int i = 0; i < 2; ++i) { const float send = (lane & 8) ? v[i] : v[i + 2], keep = (lane & 8) ? v[i + 2] : v[i]; v[i] = keep + __shfl_xor(send, 8); }
                { const float send = (lane & 4) ? v[0] : v[1], keep = (lane & 4) ? v[1] : v[0]; v[0] = keep + __shfl_xor(send, 4); }
                v[0] += __shfl_xor(v[0], 2); v[0] += __shfl_xor(v[0], 1);
                const float yy = v[0] + dk * lu[t * 16 + (lane >> 2)];
                const float gl = gelu_tanh(yy);
                if ((lane & 3) == 0) Gout[(size_t)(c * S5T + t) * LDD + 16 * g + (lane >> 2)] = (bf16)(pk2(gl, gl) & 0xffffu);
            }
        }
        if (!PASS2) { F[(size_t)(c * 256 + g) * 128 + lane] = hr; F[(size_t)(c * 256 + g) * 128 + 64 + lane] = hi; }
        LDS_WAIT(); asm volatile("" ::: "memory");
    }
}

constexpr int S5TS = 8, S5SB = S5TS * 256 + 16;
typedef short s5_bf16x8 __attribute__((ext_vector_type(8)));
template <bool PASS2>
__device__ __forceinline__ void s5m_pass(const bf16* Hin, const unsigned char* prm, const float* dsk, float* F, const float* HC, bf16* Gout, LAS unsigned char* lds, int bid, int G) {
    const int tid = opaque_tid(), lane = tid & 63, w = __builtin_amdgcn_readfirstlane(tid >> 6), j = lane & 15, rq = lane >> 4;
    const int rowslot = tid >> 4, piece = tid & 15;
    constexpr int NST = S5T / S5TS, NQ = 16 * S5TS / 32;
    for (int unit = bid; unit < 32 * (S5NC / 16); unit += G) {
        const int gb = unit & 31, cs = unit >> 5, g = gb * 8 + w;
        v2u bb[8];
#pragma unroll
        for (int t8 = 0; t8 < 8; ++t8) bb[t8] = *(const v2u*)(prm + S5P_BBOP + ((size_t)((g * 8 + t8) * 64 + lane)) * 8);
        v4u cop[4];
        f32x4 ar[4], ai[4], sr[4], si[4], dk = {0.f, 0.f, 0.f, 0.f};
#pragma unroll
        for (int q = 0; q < 4; ++q) { ar[q] = *(const f32x4*)((const float*)(prm + S5P_ABR) + g * 64 + 16 * q + 4 * rq); ai[q] = *(const f32x4*)((const float*)(prm + S5P_ABI) + g * 64 + 16 * q + 4 * rq); }
        if (PASS2) {
#pragma unroll
            for (int mm = 0; mm < 4; ++mm) cop[mm] = *(const v4u*)(prm + S5P_COP + ((size_t)((g * 4 + mm) * 64 + lane)) * 16);
            const float* hc = HC + ((size_t)(cs * 16 + j) * 256 + g) * 128 + 4 * rq;
#pragma unroll
            for (int q = 0; q < 4; ++q) { sr[q] = *(const f32x4*)(hc + 16 * q); si[q] = *(const f32x4*)(hc + 64 + 16 * q); }
            dk = *(const f32x4*)(dsk + 16 * g + 4 * rq);
        } else {
#pragma unroll
            for (int q = 0; q < 4; ++q) { sr[q] = (f32x4){0.f, 0.f, 0.f, 0.f}; si[q] = (f32x4){0.f, 0.f, 0.f, 0.f}; }
        }
        const bf16* src = Hin + (size_t)(cs * 16 * S5T) * LDD + gb * 128 + piece * 8;
        bf16* dstp = PASS2 ? Gout + (size_t)(cs * 16 * S5T) * LDD + gb * 128 + piece * 8 : nullptr;
        v4u pre[NQ];
#pragma unroll
        for (int q = 0; q < NQ; ++q) { const int ri = q * 32 + rowslot, jj = ri / S5TS, tt = ri % S5TS; pre[q] = *(const v4u*)(src + (size_t)(jj * S5T + tt) * LDD); }
        for (int s = 0; s < NST; ++s) {
#pragma unroll
            for (int q = 0; q < NQ; ++q) { const int ri = q * 32 + rowslot, jj = ri / S5TS, tt = ri % S5TS; LAS v4u* lp = (LAS v4u*)(lds + jj * S5SB + tt * 256 + piece * 16);
                if (PASS2 && s > 0) { const v4u y = *lp; *(v4u*)(dstp + (size_t)(jj * S5T + (s - 1) * S5TS + tt) * LDD) = y; }
                *lp = pre[q]; }
            if (s + 1 < NST) {
#pragma unroll
                for (int q = 0; q < NQ; ++q) { const int ri = q * 32 + rowslot, jj = ri / S5TS, tt = ri % S5TS; pre[q] = *(const v4u*)(src + (size_t)(jj * S5T + (s + 1) * S5TS + tt) * LDD); } }
            LDS_WAIT(); __syncthreads();
            LAS unsigned char* up = lds + j * S5SB + w * 32 + rq * 8;
            v2u uu[S5TS];
#pragma unroll
            for (int tt = 0; tt < S5TS; ++tt) uu[tt] = *(const LAS v2u*)(up + tt * 256);
#pragma unroll
            for (int tt = 0; tt < S5TS; ++tt) {
                v4u ub; ub.x = uu[tt].x; ub.y = uu[tt].y; ub.z = 0u; ub.w = 0u;
                const s5_bf16x8 U = __builtin_bit_cast(s5_bf16x8, ub);
#pragma unroll
                for (int q = 0; q < 4; ++q) {
                    const f32x4 tr = ar[q] * sr[q] - ai[q] * si[q], ti = ar[q] * si[q] + ai[q] * sr[q];
                    v4u a0; a0.x = bb[q].x; a0.y = bb[q].y; a0.z = 0u; a0.w = 0u; v4u a1; a1.x = bb[4 + q].x; a1.y = bb[4 + q].y; a1.z = 0u; a1.w = 0u;
                    sr[q] = __builtin_amdgcn_mfma_f32_16x16x32_bf16(__builtin_bit_cast(s5_bf16x8, a0), U, tr, 0, 0, 0);
                    si[q] = __builtin_amdgcn_mfma_f32_16x16x32_bf16(__builtin_bit_cast(s5_bf16x8, a1), U, ti, 0, 0, 0);
                }
                if (PASS2) {
                    f32x4 y = {0.f, 0.f, 0.f, 0.f};
#pragma unroll
                    for (int mm = 0; mm < 4; ++mm) { const f32x4 t0 = mm < 2 ? sr[2 * mm] : si[2 * mm - 4], t1 = mm < 2 ? sr[2 * mm + 1] : si[2 * mm - 3];
                        v4u sb; sb.x = pk2(t0.x, t0.y); sb.y = pk2(t0.z, t0.w); sb.z = pk2(t1.x, t1.y); sb.w = pk2(t1.z, t1.w);
                        y = __builtin_amdgcn_mfma_f32_16x16x32_bf16(__builtin_bit_cast(s5_bf16x8, cop[mm]), __builtin_bit_cast(s5_bf16x8, sb), y, 0, 0, 0); }
                    const f32x4 uf = {bflo(uu[tt].x), bfhi(uu[tt].x), bflo(uu[tt].y), bfhi(uu[tt].y)};
                    const f32x4 yy = y + dk * uf;
                    v2u o; o.x = pk2(gelu_tanh(yy.x), gelu_tanh(yy.y)); o.y = pk2(gelu_tanh(yy.z), gelu_tanh(yy.w));
                    *(LAS v2u*)(up + tt * 256) = o;
                }
            }
            LDS_WAIT(); __syncthreads();
        }
        if (PASS2) {
#pragma unroll
            for (int q = 0; q < NQ; ++q) { const int ri = q * 32 + rowslot, jj = ri / S5TS, tt = ri % S5TS; const v4u y = *(const LAS v4u*)(lds + jj * S5SB + tt * 256 + piece * 16);
                *(v4u*)(dstp + (size_t)(jj * S5T + (NST - 1) * S5TS + tt) * LDD) = y; }
            LDS_WAIT();
        } else {
            float* fo = F + ((size_t)(cs * 16 + j) * 256 + g) * 128 + 4 * rq;
#pragma unroll
            for (int q = 0; q < 4; ++q) { *(f32x4*)(fo + 16 * q) = sr[q]; *(f32x4*)(fo + 64 + 16 * q) = si[q]; }
        }
    }
}
__device__ __forceinline__ void s5_carry(const unsigned char* prm, const float* F, float* HC, int gtid) {
    if (gtid < 256 * 64) {
        const int g = gtid >> 6, p = gtid & 63;
        const float atr = ((const float*)(prm + S5P_ATR))[gtid], ati = ((const float*)(prm + S5P_ATI))[gtid];
        float hr = 0.f, hi = 0.f;
#pragma unroll 8
        for (int c = 0; c < S5NC; ++c) { const size_t o = (size_t)(c * 256 + g) * 128 + p;
            HC[o] = hr; HC[o + 64] = hi; const float fr = F[o], fi = F[o + 64];
            const float nr = atr * hr - ati * hi + fr, ni = atr * hi + ati * hr + fi; hr = nr; hi = ni; }
    }
}

struct Ctx { int lo, hi, tid, lane, wave, gw, NGW, gtid, NGT, G, bid; };
#ifndef DUP_ATTN
#define DUP_ATTN 0
#endif
#ifndef DUP_S5
#define DUP_S5 0
#endif
#ifndef DUP_FFN1
#define DUP_FFN1 0
#endif
#ifndef DUP_FFN2
#define DUP_FFN2 0
#endif
#ifndef DUP_INP
#define DUP_INP 0
#endif
#ifndef DUP_PRO
#define DUP_PRO 0
#endif
#define IN(k) (lo <= (k) && (k) < hi)
#define SEAM(k) do { if (IN(k) && IN((k) + 1)) xcd_barrier(bar); } while (0)
#define FFN_PHASES(l, pb) do { \
    const float* ml_ = MODL + (size_t)(l) * NMODV; \
    if (IN((pb) + 5)) norm_mod_phase(XR, args.in[6] + (size_t)(l) * DM, ml_ + 3 * DM, ml_ + 4 * DM, Hb, lds, tid, gw, NGW, lane); \
    SEAM((pb) + 5); \
    if (IN((pb) + 6)) { pg8::Gemm g{Hb, (const bf16*)(ws + WS_WGU + (size_t)(l) * W_GU_B), SEQ, 2 * FFH, DM, LDD, LDD}; pg8::StaticOrder S; S.init(SEQ, 2 * FFH, G, bid); \
        pg8::EpiSwiGLU E{HID, LDF}; pg8::gemm_phase<pg8::EpiSwiGLU, pg8::StaticOrder, true, true>(lds, g, S, E); } \
    if (DUP_FFN1 && IN((pb) + 6)) { xcd_barrier(bar); pg8::Gemm g{Hb, (const bf16*)(ws + WS_WGU + (size_t)(l) * W_GU_B), SEQ, 2 * FFH, DM, LDD, LDD}; pg8::StaticOrder S; S.init(SEQ, 2 * FFH, G, bid); \
        pg8::EpiSwiGLU E{HID, LDF}; pg8::gemm_phase<pg8::EpiSwiGLU, pg8::StaticOrder, true, true>(lds, g, S, E); } \
    SEAM((pb) + 6); \
    if (DUP_FFN2 && IN((pb) + 7)) { xcd_barrier(bar); pg8::Gemm g{HID, (const bf16*)(ws + WS_WDN + (size_t)(l) * W_DN_B), SEQ, DM, FFH, LDF, LDF}; pg8::StaticOrder S; S.init(SEQ, DM, G, bid); \
        pg8::EpiResid E{XR, (float*)(ws + WS_OT), ml_ + 5 * DM, DM}; pg8::gemm_phase<pg8::EpiResid, pg8::StaticOrder, true, true>(lds, g, S, E); } \
    if (IN((pb) + 7)) { pg8::Gemm g{HID, (const bf16*)(ws + WS_WDN + (size_t)(l) * W_DN_B), SEQ, DM, FFH, LDF, LDF}; pg8::StaticOrder S; S.init(SEQ, DM, G, bid); \
        pg8::EpiResid E{XR, XR, ml_ + 5 * DM, DM}; pg8::gemm_phase<pg8::EpiResid, pg8::StaticOrder, true, true>(lds, g, S, E); } \
    SEAM((pb) + 7); } while (0)
template <int lp>
__device__ __forceinline__ void layer_pair(const Args& args, const Ctx& C, LAS unsigned char* lds, unsigned char* lds_raw, const XcdBarrier& bar) {
    const int lo = C.lo, hi = C.hi, tid = C.tid, lane = C.lane, wave = C.wave, gw = C.gw, NGW = C.NGW, gtid = C.gtid, NGT = C.NGT, G = C.G, bid = C.bid;
    unsigned char* ws = args.ws;
    bf16* const Hb = (bf16*)(ws + WS_H); bf16* const MIX = (bf16*)(ws + WS_MIX); bf16* const Z = (bf16*)(ws + WS_Z); bf16* const HID = (bf16*)(ws + WS_Z);
    float* const OT = (float*)(ws + WS_OT); float* const XR = args.out;
    const float* const MODL = (const float*)(ws + WS_MODL);
        { const int l = 2 * lp, pb = 2 + 8 * l; const float* ml = MODL + (size_t)l * NMODV;
          const float* xin = (l == 0) ? args.in[0] : XR;
          if (IN(pb)) norm_mod_phase(xin, args.in[5] + (size_t)l * DM, ml, ml + DM, Hb, lds, tid, gw, NGW, lane);
          SEAM(pb);
          if (IN(pb + 1)) { pg8::Gemm g{Hb, (const bf16*)(ws + WS_WIN + (size_t)lp * W_IN_B), SEQ, 12288, DM, LDD, LDD}; pg8::StaticOrder S; S.init(SEQ, 12288, G, bid);
              pg8::EpiHeadMajor E{Z, GS}; pg8::gemm_phase<pg8::EpiHeadMajor, pg8::StaticOrder, true, true>(lds, g, S, E); }
          if (DUP_INP && IN(pb + 1)) { xcd_barrier(bar); pg8::Gemm g{Hb, (const bf16*)(ws + WS_WIN + (size_t)lp * W_IN_B), SEQ, 12288, DM, LDD, LDD}; pg8::StaticOrder S; S.init(SEQ, 12288, G, bid);
              pg8::EpiHeadMajor E{Z, GS}; pg8::gemm_phase<pg8::EpiHeadMajor, pg8::StaticOrder, true, true>(lds, g, S, E); }
          SEAM(pb + 1);
          if (IN(pb + 2)) { conv_phase(Z, args.in[9] + (size_t)lp * 3 * 2048, MIX, gtid, NGT); if (ATT2) attn2_phase<false>(Z, OT, (char*)lds_raw, bid, G); else attn_phase(Z, OT, (char*)lds_raw, bid, G); if (DUP_ATTN == 1) { xcd_barrier(bar); attn2_phase<false>(Z, (float*)(ws + WS_END), (char*)lds_raw, bid, G); } if (DUP_ATTN == 2) { xcd_barrier(bar); attn2_phase<true>(Z, (float*)(ws + WS_END), (char*)lds_raw, bid, G); } }
          SEAM(pb + 2);
          if (IN(pb + 3)) combine_phase(OT, (const float*)(ws + WS_LAM) + lp, args.in[14] + lp * 256, lp == 0 ? 0.2f : 0.4707130183435842f, MIX, gw, NGW, lane);
          SEAM(pb + 3);
          if (IN(pb + 4)) { pg8::Gemm g{MIX, (const bf16*)(ws + WS_WOUT + (size_t)lp * W_OUT_B), SEQ, DM, DM, LDD, LDD}; pg8::StaticOrder S; S.init(SEQ, DM, G, bid);
              pg8::EpiResid E{xin, XR, ml + 2 * DM, DM}; pg8::gemm_phase<pg8::EpiResid, pg8::StaticOrder, true, true>(lds, g, S, E); }
          SEAM(pb + 4);
          FFN_PHASES(l, pb);
        }
        { const int l = 2 * lp + 1, pb = 2 + 8 * l; const float* ml = MODL + (size_t)l * NMODV;
          const unsigned char* prm = ws + WS_S5P + (size_t)lp * S5P_LAYER;
          float* const S5F = (float*)(ws + WS_S5F); float* const S5H = (float*)(ws + WS_S5H);
          if (IN(pb)) norm_mod_phase(XR, args.in[5] + (size_t)l * DM, ml, ml + DM, Hb, lds, tid, gw, NGW, lane);
          SEAM(pb);
          if (IN(pb + 1)) { if (S5_MFMA) s5m_pass<false>(Hb, prm, nullptr, S5F, nullptr, nullptr, lds, bid, G); else s5_pass<false>(Hb, prm, nullptr, nullptr, nullptr, S5F, nullptr, nullptr, lds, gw, NGW, wave, lane); }
          SEAM(pb + 1);
          if (IN(pb + 2)) s5_carry(prm, S5F, S5H, gtid);
          SEAM(pb + 2);
          if (IN(pb + 3)) { if (S5_MFMA) s5m_pass<true>(Hb, prm, args.in[23] + (size_t)lp * DM, nullptr, S5H, MIX, lds, bid, G); else s5_pass<true>(Hb, prm, args.in[21] + (size_t)lp * 256 * 16 * 64, args.in[22] + (size_t)lp * 256 * 16 * 64, args.in[23] + (size_t)lp * DM, nullptr, S5H, MIX, lds, gw, NGW, wave, lane); }
          if (DUP_S5) { xcd_barrier(bar);
          if (IN(pb + 1)) { if (S5_MFMA) s5m_pass<false>(Hb, prm, nullptr, S5F, nullptr, nullptr, lds, bid, G); else s5_pass<false>(Hb, prm, nullptr, nullptr, nullptr, S5F, nullptr, nullptr, lds, gw, NGW, wave, lane); }
          SEAM(pb + 1);
          if (IN(pb + 2)) s5_carry(prm, S5F, S5H, gtid);
          SEAM(pb + 2);
          if (IN(pb + 3)) { if (S5_MFMA) s5m_pass<true>(Hb, prm, args.in[23] + (size_t)lp * DM, nullptr, S5H, MIX, lds, bid, G); else s5_pass<true>(Hb, prm, args.in[21] + (size_t)lp * 256 * 16 * 64, args.in[22] + (size_t)lp * 256 * 16 * 64, args.in[23] + (size_t)lp * DM, nullptr, S5H, MIX, lds, gw, NGW, wave, lane); }
          }
          SEAM(pb + 3);
          if (IN(pb + 4)) { pg8::Gemm g{MIX, (const bf16*)(ws + WS_WGLU + (size_t)lp * W_GLU_B), SEQ, 2 * DM, DM, LDD, LDD}; pg8::StaticOrder S; S.init(SEQ, 2 * DM, G, bid);
              pg8::EpiGluResid E{XR, XR, ml + 2 * DM, DM}; pg8::gemm_phase<pg8::EpiGluResid, pg8::StaticOrder, true, true>(lds, g, S, E); }
          SEAM(pb + 4);
          FFN_PHASES(l, pb);
        }
    }
#undef FFN_PHASES
#undef IN
#undef SEAM

__global__ void __launch_bounds__(NTHR, 2) trunk_fwd(Args args) {
    extern __shared__ __attribute__((aligned(16))) unsigned char lds_raw[];
    LAS unsigned char* lds = (LAS unsigned char*)lds_raw;
    volatile LAS unsigned* MISC = (volatile LAS unsigned*)(lds + MISC_OFF);
    const int tid = opaque_tid(), lane = tid & 63, wave = __builtin_amdgcn_readfirstlane(tid >> 6);
    const int G = gridDim.x, bid = blockIdx.x;
    const int vcu = (G % 8 == 0) ? (bid % 8) * (G / 8) + bid / 8 : bid;
    const int gw = vcu * NWAVES + wave, NGW = G * NWAVES, gtid = vcu * NTHR + tid, NGT = G * NTHR;
    unsigned char* ws = args.ws;
    const int lo = args.ph_lo, hi = args.ph_hi;
    for (int u = tid; u < (LDS_BYTES - RING_BYTES) / 4; u += NTHR) ((LAS unsigned*)(lds + RING_BYTES))[u] = 0u;
    __syncthreads();
    XcdBarrier bar; bar.bar = (unsigned*)(ws + WS_CTL) + CW_BAR; bar.x = 0; bar.st = MISC + 8;
    if (hi - lo > 1) bar = xcd_barrier_post((unsigned*)(ws + WS_CTL) + CW_BAR, MISC + 8);
    const Ctx C{lo, hi, tid, lane, wave, gw, NGW, gtid, NGT, G, bid};
#define IN(k) (lo <= (k) && (k) < hi)
#define SEAM(k) do { if (IN(k) && IN((k) + 1)) xcd_barrier(bar); } while (0)

    bf16* const Hb = (bf16*)(ws + WS_H); bf16* const MIX = (bf16*)(ws + WS_MIX); bf16* const Z = (bf16*)(ws + WS_Z); bf16* const HID = (bf16*)(ws + WS_Z);
    float* const OT = (float*)(ws + WS_OT); float* const XR = args.out;
    const float* const MODL = (const float*)(ws + WS_MODL);

    if (IN(0)) { p0_prologue(args, lds, gw, NGW, wave, lane); if (DUP_PRO) { xcd_barrier(bar); p0_prologue(args, lds, gw, NGW, wave, lane); } }
    SEAM(0);
    if (IN(1)) p1_modvec(args, gtid, NGT);
    SEAM(1);


    layer_pair<0>(args, C, lds, lds_raw, bar);
    layer_pair<1>(args, C, lds, lds_raw, bar);
    if (IN(34)) final_norm_phase(XR, args.in[7], XR, gw, NGW, lane);
#undef IN
#undef SEAM
}

extern "C" void kernel_launch(void* const* d_in, const int* in_sizes, int n_in, void* d_out, int out_size, void* d_ws, size_t ws_size, hipStream_t stream) {
    static int grid = 0;
    if (grid == 0) {
        if (n_in != 29 || in_sizes[0] != SEQ * DM || out_size != SEQ * DM || ws_size < WS_END + (DUP_ATTN ? (size_t)32 * GS * 4 : 0)) {
            fprintf(stderr, "kernel_launch: built for 29 inputs, x/out of %d floats, >= %zu bytes of workspace; got n_in %d, in0 %d, out %d, ws %zu; nothing launched\n", SEQ * DM, (size_t)WS_END, n_in, n_in > 0 ? in_sizes[0] : -1, out_size, ws_size); grid = -1; return; }
        int dev = 0, cus = 0, per_cu = 0;
        if (hipGetDevice(&dev) != hipSuccess || hipDeviceGetAttribute(&cus, hipDeviceAttributeMultiprocessorCount, dev) != hipSuccess) { fprintf(stderr, "kernel_launch: device query failed\n"); grid = -1; return; }
        if (hipFuncSetAttribute((const void*)trunk_fwd, hipFuncAttributeMaxDynamicSharedMemorySize, LDS_BYTES) != hipSuccess) { fprintf(stderr, "kernel_launch: hipFuncSetAttribute failed\n"); grid = -1; return; }
        if (hipOccupancyMaxActiveBlocksPerMultiprocessor(&per_cu, (const void*)trunk_fwd, NTHR, LDS_BYTES) != hipSuccess || per_cu < 1) { fprintf(stderr, "kernel_launch: occupancy query reports %d workgroups per CU\n", per_cu); }
        (void)hipGetLastError();
        grid = cus;
        fprintf(stderr, "kernel_launch: grid %d, occupancy %d, ws %zu (need %zu)\n", grid, per_cu, ws_size, (size_t)WS_END);
    }
    if (grid < 0) return;
    if (hipMemsetAsync((char*)d_ws + WS_CTL, 0, CTL_ZERO_BYTES, stream) != hipSuccess) { fprintf(stderr, "kernel_launch: memset failed\n"); return; }
    Args a{};
    for (int i = 0; i < 29; ++i) a.in[i] = (const float*)d_in[i];
    a.out = (float*)d_out; a.ws = (unsigned char*)d_ws;
#if MK_PER_PHASE
    for (int p = 0; p < N_PHASES; ++p) { a.ph_lo = p; a.ph_hi = p + 1; hipLaunchKernelGGL(trunk_fwd, dim3(grid), dim3(NTHR), LDS_BYTES, stream, a); }
#else
    a.ph_lo = 0; a.ph_hi = N_PHASES;
    hipLaunchKernelGGL(trunk_fwd, dim3(grid), dim3(NTHR), LDS_BYTES, stream, a);
#endif
    const hipError_t le = hipPeekAtLastError();
    if (le != hipSuccess) fprintf(stderr, "kernel_launch: launch failed: %s\n", hipGetErrorName(le));
}
```

```cpp
#include <hip/hip_runtime.h>
#include <hip/hip_bf16.h>
#include <cstdio>
#include <cstdint>
__device__ __forceinline__ int opaque_tid() { int t; asm volatile("v_mov_b32 %0, %1" : "=v"(t) : "v"((int)threadIdx.x)); return t; }
namespace pg8 {
#define PG8_LAS __attribute__((address_space(3)))
typedef unsigned short bf16_t;
typedef short bf16x8 __attribute__((ext_vector_type(8)));
typedef float f32x4 __attribute__((ext_vector_type(4)));
typedef unsigned u32x4 __attribute__((ext_vector_type(4)));
constexpr int BM = 256, BK = 64, HALF = 128, HTB = HALF * BK * 2  , STAGE_BYTES = 8 * HTB, NXCD = 8, WGM = 8;

__host__ __device__ __forceinline__ int lds_byte(int r, int c) { const int st = (r >> 4) * 2 + (c >> 5), rr = r & 15, cc = c & 31, ob = rr * 64 + cc * 2; return st * 1024 + (ob ^ (((ob >> 9) & 1) << 5)); }
__host__ __device__ __forceinline__ void stage_rc(int b, int& R, int& C) { const int st = b / 1024, sb = b % 1024, swz = sb ^ (((sb >> 9) & 1) << 5); R = (st >> 1) * 16 + swz / 64; C = (st & 1) * 32 + (swz % 64) / 2; }
__host__ __device__ __forceinline__ int perm32(int rho) { const int n = rho >> 4, i = rho & 15; return 8 * (i >> 2) + 4 * n + (i & 3); }

struct Unit { int pm, pn; };
struct Gemm { const bf16_t* A; const bf16_t* Bt; int M, N, K, lda, ldb; };

struct StaticOrder {
    int nM, nN, nwg, G, c;
    __host__ __device__ void init(int M, int N, int G_, int c_) { nM = M / BM; nN = N / BM; nwg = nM * nN; G = G_; c = c_; }
    __host__ __device__ bool next(int i, Unit& u) const {
        const long L = (long)i * G + c; if (L >= nwg) return false;
        int wgid = (int)L; { const int q = nwg / NXCD, r = nwg % NXCD, xcd = wgid % NXCD, off = wgid / NXCD; wgid = (xcd < r ? xcd * (q + 1) : r * (q + 1) + (xcd - r) * q) + off; }
        const int nig = WGM * nN, gid = wgid / nig, fm = gid * WGM, gsz = (nM - fm) < WGM ? (nM - fm) : WGM;
        u.pm = fm + ((wgid % nig) % gsz); u.pn = (wgid % nig) / gsz; return true;
    }
    __device__ __forceinline__ void a_ready(const Unit&) const {}
    __device__ __forceinline__ void done(const Unit&) const {}
};

__device__ __forceinline__ unsigned cvt_pk_bf16(float lo, float hi) { unsigned r; asm volatile("v_cvt_pk_bf16_f32 %0, %1, %2" : "=v"(r) : "v"(lo), "v"(hi)); return r; }
__device__ __forceinline__ float fast_sigmoid(float x) { return __builtin_amdgcn_rcpf(1.0f + __builtin_amdgcn_exp2f(-1.4426950408889634f * x)); }

struct EpiHeadMajor {
    static constexpr bool PERM = true, AFTER_DRAIN = false;
    bf16_t* O; size_t gstride;
    __device__ __forceinline__ void operator()(const f32x4 (&acc)[2][2][4][2], const Unit& u, int wr, int wc, int fr, int fq) const {
        const int row0 = u.pm * BM + wr * 64 + fr, col0 = wc * 32 + 8 * fq;
#pragma unroll
        for (int ai = 0; ai < 2; ++ai)
#pragma unroll
            for (int m = 0; m < 4; ++m) { const size_t ro = (size_t)(row0 + ai * HALF + m * 16) * 128 + col0;
#pragma unroll
                for (int bj = 0; bj < 2; ++bj) { const f32x4 v0 = acc[ai][bj][m][0], v1 = acc[ai][bj][m][1];
                    u32x4 w; w.x = cvt_pk_bf16(v0[0], v0[1]); w.y = cvt_pk_bf16(v0[2], v0[3]); w.z = cvt_pk_bf16(v1[0], v1[1]); w.w = cvt_pk_bf16(v1[2], v1[3]);
                    *(u32x4*)(O + (size_t)(2 * u.pn + bj) * gstride + ro) = w; } }
    }
};
struct EpiResid {
    static constexpr bool PERM = false, AFTER_DRAIN = false;
    const float* base; float* out; const float* gate; int ldc;
    __device__ __forceinline__ void operator()(const f32x4 (&acc)[2][2][4][2], const Unit& u, int wr, int wc, int fr, int fq) const {
        const int row0 = u.pm * BM + wr * 64 + fr, col0 = u.pn * BM + wc * 32 + 4 * fq;
        f32x4 gv[2][2];
#pragma unroll
        for (int bj = 0; bj < 2; ++bj)
#pragma unroll
            for (int n = 0; n < 2; ++n) gv[bj][n] = *(const f32x4*)(gate + col0 + bj * HALF + n * 16);
#pragma unroll
        for (int ai = 0; ai < 2; ++ai) {
            f32x4 b[4][2][2];
#pragma unroll
            for (int m = 0; m < 4; ++m) { const size_t off = (size_t)(row0 + ai * HALF + m * 16) * ldc + col0;
#pragma unroll
                for (int bj = 0; bj < 2; ++bj)
#pragma unroll
                    for (int n = 0; n < 2; ++n) b[m][bj][n] = *(const f32x4*)(base + off + bj * HALF + n * 16); }
            asm volatile("" ::: "memory");
#pragma unroll
            for (int m = 0; m < 4; ++m) { const size_t off = (size_t)(row0 + ai * HALF + m * 16) * ldc + col0;
#pragma unroll
                for (int bj = 0; bj < 2; ++bj)
#pragma unroll
                    for (int n = 0; n < 2; ++n) *(f32x4*)(out + off + bj * HALF + n * 16) = b[m][bj][n] + gv[bj][n] * acc[ai][bj][m][n]; }
            asm volatile("" ::: "memory"); }
    }
};
struct EpiSwiGLU {
    static constexpr bool PERM = true, AFTER_DRAIN = false;
    bf16_t* O; int ldc;
    __device__ __forceinline__ void operator()(const f32x4 (&acc)[2][2][4][2], const Unit& u, int wr, int wc, int fr, int fq) const {
        const int row0 = u.pm * BM + wr * 64 + fr, col0 = u.pn * HALF + wc * 32 + 8 * fq;
#pragma unroll
        for (int ai = 0; ai < 2; ++ai)
#pragma unroll
            for (int m = 0; m < 4; ++m) { bf16_t* rowp = O + (size_t)(row0 + ai * HALF + m * 16) * ldc + col0;
                float r[8];
#pragma unroll
                for (int n = 0; n < 2; ++n)
#pragma unroll
                    for (int j = 0; j < 4; ++j) { const float g = acc[ai][0][m][n][j], up = acc[ai][1][m][n][j]; r[n * 4 + j] = g * fast_sigmoid(g) * up; }
                u32x4 w; w.x = cvt_pk_bf16(r[0], r[1]); w.y = cvt_pk_bf16(r[2], r[3]); w.z = cvt_pk_bf16(r[4], r[5]); w.w = cvt_pk_bf16(r[6], r[7]);
                *(u32x4*)rowp = w; }
    }
};
struct EpiGluResid {
    static constexpr bool PERM = false, AFTER_DRAIN = false;
    const float* base; float* out; const float* gate; int ldc;
    __device__ __forceinline__ void operator()(const f32x4 (&acc)[2][2][4][2], const Unit& u, int wr, int wc, int fr, int fq) const {
        const int row0 = u.pm * BM + wr * 64 + fr, col0 = u.pn * HALF + wc * 32 + 4 * fq;
        f32x4 gv[2];
#pragma unroll
        for (int n = 0; n < 2; ++n) gv[n] = *(const f32x4*)(gate + col0 + n * 16);
        f32x4 b[2][4][2];
#pragma unroll
        for (int ai = 0; ai < 2; ++ai)
#pragma unroll
            for (int m = 0; m < 4; ++m) { const size_t off = (size_t)(row0 + ai * HALF + m * 16) * ldc + col0;
#pragma unroll
                for (int n = 0; n < 2; ++n) b[ai][m][n] = *(const f32x4*)(base + off + n * 16); }
        asm volatile("" ::: "memory");
#pragma unroll
        for (int ai = 0; ai < 2; ++ai)
#pragma unroll
            for (int m = 0; m < 4; ++m) { const size_t off = (size_t)(row0 + ai * HALF + m * 16) * ldc + col0;
#pragma unroll
                for (int n = 0; n < 2; ++n) { const f32x4 a = acc[ai][0][m][n], sg = acc[ai][1][m][n]; f32x4 y;
#pragma unroll
                    for (int j = 0; j < 4; ++j) y[j] = a[j] * fast_sigmoid(sg[j]);
                    *(f32x4*)(out + off + n * 16) = b[ai][m][n] + gv[n] * y; } }
        asm volatile("" ::: "memory");
    }
};

template <class Epi, class Sched, bool ALIGN_EPI = false, bool SP2 = false>
__device__ __forceinline__ void gemm_phase(PG8_LAS unsigned char* lds, const Gemm g, const Sched& S, const Epi& E) {
    const int tid = opaque_tid(), wid = __builtin_amdgcn_readfirstlane(tid >> 6), lane = tid & 63, wr = wid >> 2, wc = wid & 3, fr = lane & 15, fq = lane >> 4;
    const int K = g.K, nt = K / BK;
    unsigned voffA[2], voffB[2];
#pragma unroll
    for (int i = 0; i < 2; ++i) { int R, C; stage_rc(tid * 16 + i * 8192, R, C); const int Rb = Epi::PERM ? ((R & ~31) + perm32(R & 31)) : R;
        voffA[i] = (unsigned)(R * g.lda + C) * 2u; voffB[i] = (unsigned)(Rb * g.ldb + C) * 2u; }
    const size_t kstep = (size_t)(BK * 2);
    const size_t hstepA = (size_t)HALF * g.lda * 2, hstepB = (size_t)HALF * g.ldb * 2;
    const size_t tstepA = 2 * hstepA, tstepB = 2 * hstepB;
    const unsigned ldsw = (unsigned)wid * 1024u;
    const int aoff = lds_byte(wr * 64 + fr, fq * 8), boff = lds_byte(wc * 32 + fr, fq * 8);
#define PG8_SA(b, h) (((b) * 2 + (h)) * HTB)
#define PG8_SB(b, h) ((4 + (b) * 2 + (h)) * HTB)
#define PG8_STAGE(bufoff, gbase, voff) do { _Pragma("unroll") for (int _i = 0; _i < 2; ++_i) \
        __builtin_amdgcn_global_load_lds((const unsigned*)((const char*)(gbase) + (voff)[_i]), (PG8_LAS unsigned*)(lds + (bufoff) + ldsw + _i * 8192), 16, 0, 0); } while (0)
#define PG8_LDA(dst, b, h) do { _Pragma("unroll") for (int m = 0; m < 4; ++m) _Pragma("unroll") for (int k = 0; k < 2; ++k) dst[m][k] = *(const PG8_LAS bf16x8*)(lds + PG8_SA(b, h) + aoff + m * 2048 + k * 1024); } while (0)
#define PG8_LDB(dst, b, h) do { _Pragma("unroll") for (int n = 0; n < 2; ++n) _Pragma("unroll") for (int k = 0; k < 2; ++k) dst[n][k] = *(const PG8_LAS bf16x8*)(lds + PG8_SB(b, h) + boff + n * 2048 + k * 1024); } while (0)
#define PG8_MMA(ai, bj, At, Bt) do { __builtin_amdgcn_s_setprio(3); _Pragma("unroll") for (int m = 0; m < 4; ++m) _Pragma("unroll") for (int n = 0; n < 2; ++n) _Pragma("unroll") for (int k = 0; k < 2; ++k) \
        acc[ai][bj][m][n] = __builtin_amdgcn_mfma_f32_16x16x32_bf16(Bt[n][k], At[m][k], acc[ai][bj][m][n], 0, 0, 0); __builtin_amdgcn_s_setprio(0); } while (0)
#define PG8_WAIT_V(n) asm volatile("s_waitcnt vmcnt(" #n ")" ::: "memory")
#define PG8_WAIT_L(n) asm volatile("s_waitcnt lgkmcnt(" #n ")" ::: "memory")
#define PG8_BAR __builtin_amdgcn_s_barrier()
#define PG8_SCHED __builtin_amdgcn_sched_barrier(0)
    Unit cur, nxt; int ui = 0;
    if (!S.next(0, cur)) return;
    f32x4 acc[2][2][4][2];
#pragma unroll
    for (int a = 0; a < 2; ++a)
#pragma unroll
        for (int b = 0; b < 2; ++b)
#pragma unroll
            for (int m = 0; m < 4; ++m)
#pragma unroll
                for (int n = 0; n < 2; ++n) acc[a][b][m][n] = (f32x4){0.f, 0.f, 0.f, 0.f};
    bf16x8 At[4][2], B0[2][2], B1[2][2];
    const char* cA = (const char*)g.A + (size_t)cur.pm * tstepA; const char* cB = (const char*)g.Bt + (size_t)cur.pn * tstepB;
    S.a_ready(cur);
    if constexpr (SP2) {
        PG8_STAGE(PG8_SB(0, 0), cB, voffB); PG8_STAGE(PG8_SB(0, 1), cB + hstepB, voffB); PG8_STAGE(PG8_SA(0, 0), cA, voffA); PG8_STAGE(PG8_SA(0, 1), cA + hstepA, voffA);
        if (wr == 1) PG8_BAR;
        PG8_WAIT_V(2); PG8_BAR;
        PG8_STAGE(PG8_SB(1, 0), cB + kstep, voffB); PG8_STAGE(PG8_SA(1, 0), cA + kstep, voffA); PG8_STAGE(PG8_SB(1, 1), cB + hstepB + kstep, voffB);
        PG8_WAIT_V(6); PG8_BAR;
    } else {
        PG8_STAGE(PG8_SB(0, 0), cB, voffB); PG8_STAGE(PG8_SA(0, 0), cA, voffA); PG8_STAGE(PG8_SB(0, 1), cB + hstepB, voffB); PG8_STAGE(PG8_SA(0, 1), cA + hstepA, voffA);
        if (wr == 1) PG8_BAR;
        PG8_WAIT_V(4); PG8_BAR;
        PG8_STAGE(PG8_SB(1, 0), cB + kstep, voffB); PG8_STAGE(PG8_SA(1, 0), cA + kstep, voffA); PG8_STAGE(PG8_SB(1, 1), cB + hstepB + kstep, voffB);
        PG8_WAIT_V(6); PG8_BAR;
    }
    for (;;) {
        const bool has_next = S.next(ui + 1, nxt);
        const char* nA = has_next ? (const char*)g.A + (size_t)nxt.pm * tstepA : cA; const char* nB = has_next ? (const char*)g.Bt + (size_t)nxt.pn * tstepB : cB;
        for (int t = 0; t < nt; t += 2) {
            const bool last = (t == nt - 2);
            const char* a1 = cA + (size_t)(t + 1) * kstep;
            const char* a2 = last ? nA : cA + (size_t)(t + 2) * kstep; const char* b2 = last ? nB : cB + (size_t)(t + 2) * kstep;
            const char* a3 = a2 + kstep; const char* b3 = b2 + kstep;
            if (last && has_next) S.a_ready(nxt);
            if constexpr (SP2) {
            PG8_LDB(B0, 0, 0); PG8_LDB(B1, 0, 1); PG8_SCHED; PG8_LDA(At, 0, 0); PG8_STAGE(PG8_SA(1, 1), a1 + hstepA, voffA);
            PG8_WAIT_V(8); PG8_WAIT_L(0); PG8_BAR; PG8_MMA(0, 0, At, B0); PG8_MMA(0, 1, At, B1); PG8_BAR; PG8_SCHED;
            PG8_LDA(At, 0, 1); PG8_STAGE(PG8_SB(0, 0), b2, voffB); PG8_STAGE(PG8_SB(0, 1), b2 + hstepB, voffB); PG8_STAGE(PG8_SA(0, 0), a2, voffA);
            PG8_WAIT_V(8); PG8_WAIT_L(0); PG8_BAR; PG8_MMA(1, 0, At, B0); PG8_MMA(1, 1, At, B1); PG8_BAR; PG8_SCHED;
            PG8_LDB(B0, 1, 0); PG8_LDB(B1, 1, 1); PG8_SCHED; PG8_LDA(At, 1, 0); PG8_STAGE(PG8_SA(0, 1), a2 + hstepA, voffA);
            PG8_WAIT_V(8); PG8_WAIT_L(0); PG8_BAR; PG8_MMA(0, 0, At, B0); PG8_MMA(0, 1, At, B1); PG8_BAR; PG8_SCHED;
            PG8_LDA(At, 1, 1); PG8_STAGE(PG8_SB(1, 0), b3, voffB); PG8_STAGE(PG8_SB(1, 1), b3 + hstepB, voffB); PG8_STAGE(PG8_SA(1, 0), a3, voffA);
            PG8_WAIT_V(8); PG8_WAIT_L(0); PG8_BAR; PG8_MMA(1, 0, At, B0); PG8_MMA(1, 1, At, B1); PG8_BAR; PG8_SCHED;
            } else {
            PG8_LDB(B0, 0, 0); PG8_SCHED; PG8_LDA(At, 0, 0); PG8_STAGE(PG8_SA(1, 1), a1 + hstepA, voffA);
            PG8_WAIT_L(8); PG8_BAR; PG8_WAIT_L(0); PG8_MMA(0, 0, At, B0); PG8_BAR; PG8_SCHED;
            PG8_LDB(B1, 0, 1); PG8_STAGE(PG8_SB(0, 0), b2, voffB);
            PG8_BAR; PG8_WAIT_L(0); PG8_MMA(0, 1, At, B1); PG8_BAR;
            PG8_LDA(At, 0, 1); PG8_STAGE(PG8_SA(0, 0), a2, voffA);
            PG8_BAR; PG8_WAIT_L(0); PG8_MMA(1, 0, At, B0); PG8_BAR; PG8_SCHED;
            PG8_STAGE(PG8_SB(0, 1), b2 + hstepB, voffB);
            PG8_WAIT_V(6); PG8_BAR; PG8_MMA(1, 1, At, B1); PG8_BAR;
            PG8_LDB(B0, 1, 0); PG8_SCHED; PG8_LDA(At, 1, 0); PG8_STAGE(PG8_SA(0, 1), a2 + hstepA, voffA);
            PG8_WAIT_L(8); PG8_BAR; PG8_WAIT_L(0); PG8_MMA(0, 0, At, B0); PG8_BAR; PG8_SCHED;
            PG8_LDB(B1, 1, 1); PG8_STAGE(PG8_SB(1, 0), b3, voffB);
            PG8_BAR; PG8_WAIT_L(0); PG8_MMA(0, 1, At, B1); PG8_BAR;
            PG8_LDA(At, 1, 1); PG8_STAGE(PG8_SA(1, 0), a3, voffA);
            PG8_BAR; PG8_WAIT_L(0); PG8_MMA(1, 0, At, B0); PG8_BAR; PG8_SCHED;
            PG8_STAGE(PG8_SB(1, 1), b3 + hstepB, voffB);
            PG8_WAIT_V(6); PG8_BAR; PG8_MMA(1, 1, At, B1); PG8_BAR;
            }
        }
        if constexpr (ALIGN_EPI) { if (wr == 0) PG8_BAR; }
        if constexpr (!Epi::AFTER_DRAIN) { E(acc, cur, wr, wc, fr, fq); S.done(cur); }
        if (!has_next) break;
#pragma unroll
        for (int a = 0; a < 2; ++a)
#pragma unroll
            for (int b = 0; b < 2; ++b)
#pragma unroll
                for (int m = 0; m < 4; ++m)
#pragma unroll
                    for (int n = 0; n < 2; ++n) acc[a][b][m][n] = (f32x4){0.f, 0.f, 0.f, 0.f};
        cur = nxt; cA = nA; cB = nB; ++ui;
        if constexpr (ALIGN_EPI) { if (wr == 1) PG8_BAR; }
    }
    PG8_WAIT_V(0);
    if constexpr (!ALIGN_EPI) { if (wr == 0) PG8_BAR; }
    PG8_BAR;
    if constexpr (Epi::AFTER_DRAIN) { E.fused(acc, cur, wr, wc, fr, fq, lds, wid, lane); S.done(cur); }
#undef PG8_SA
#undef PG8_SB
#undef PG8_STAGE
#undef PG8_LDA
#undef PG8_LDB
#undef PG8_MMA
#undef PG8_WAIT_V
#undef PG8_WAIT_L
#undef PG8_BAR
#undef PG8_SCHED
}
}

namespace att {
constexpr int D = 128;
constexpr float THR = 8.f;
constexpr bool WSKIP = false;
constexpr float SCALE = 0.08838834764831845f;
constexpr int NW = 8, QBLK = 32, KVBLK = 64, QB = NW * QBLK;
constexpr int SHM_V = KVBLK * D * 2, SHM_K = KVBLK * D * 2;
constexpr int LDS_BYTES = 2 * SHM_V + 2 * SHM_K + NW * 64 * 4;

using bf16 = __hip_bfloat16;
typedef short bf16x8 __attribute__((ext_vector_type(8)));
typedef short s16x4 __attribute__((ext_vector_type(4)));
typedef float f32x16 __attribute__((ext_vector_type(16)));
typedef float f32x4 __attribute__((ext_vector_type(4)));
typedef unsigned u32x4 __attribute__((ext_vector_type(4)));
template <class A, class Bt> struct same_t { static constexpr bool v = false; };
template <class A> struct same_t<A, A> { static constexpr bool v = true; };

#define KSWZ(row, colB) ((row) * 256 + ((colB) ^ (((row) & 7) << 4)))
#define SBAR() __builtin_amdgcn_sched_barrier(0)
__device__ __forceinline__ int v_st(int k, int c) { const int kk = (k & ~0xC) | ((k & 4) << 1) | ((k & 8) >> 1); return ((kk >> 3) * 4 + (c >> 5)) * 512 + ((kk & 7) * 32 + (c & 31)) * 2; }
__device__ __forceinline__ int v_rd_base(int lane) { return ((lane & 3) << 3) | (((lane >> 2) & 3) << 6) | (((lane >> 4) & 1) << 5) | (((lane >> 5) & 1) << 8); }
constexpr int v_rd_off(int d0, int ks, int half) { return d0 * 512 + ks * 4096 + half * 2048; }
__device__ __forceinline__ int crow(int r, int hi) { return (r & 3) + 8 * (r >> 2) + 4 * hi; }
__device__ __forceinline__ unsigned cvtpk(float lo, float hi) {
    unsigned r; asm volatile("v_cvt_pk_bf16_f32 %0, %1, %2" : "=v"(r) : "v"(lo), "v"(hi)); return r;
}
__device__ __forceinline__ bf16x8 pack8(f32x4 a, f32x4 b) {
    u32x4 w = {cvtpk(a[0], a[1]), cvtpk(a[2], a[3]), cvtpk(b[0], b[1]), cvtpk(b[2], b[3])};
    return *reinterpret_cast<bf16x8*>(&w);
}
template <class T> __device__ __forceinline__ bf16x8 load8(const T* p) {
    if constexpr (same_t<T, float>::v) { return pack8(*(const f32x4*)p, *(const f32x4*)(p + 4)); }
    else { return *reinterpret_cast<const bf16x8*>(p); }
}
__device__ __forceinline__ void mask_tile(f32x16& p0, f32x16& p1, int dq, unsigned W) {
    const float NEG = -__builtin_inff();
#pragma unroll
    for (int r = 0; r < 16; ++r) {
        const int c = (r & 3) + 8 * (r >> 2);
        if ((unsigned)(dq - c) >= W) p0[r] = NEG;
        if ((unsigned)(dq - c - 32) >= W) p1[r] = NEG;
    }
}
__device__ __forceinline__ void partialSM(f32x16& p0, f32x16& p1, float& m_reg, float& mn, float& alpha) {
    float pmax = p0[0]; for (int r = 1; r < 16; ++r) pmax = fmaxf(pmax, p0[r]); for (int r = 0; r < 16; ++r) pmax = fmaxf(pmax, p1[r]);
    { auto rr = __builtin_amdgcn_permlane32_swap(__float_as_uint(pmax), __float_as_uint(pmax), false, false);
      pmax = fmaxf(__uint_as_float(rr[0]), __uint_as_float(rr[1])); }
    constexpr float C2 = 1.4426950408889634f * SCALE;
    if (__builtin_expect(__all((pmax - m_reg) * SCALE <= THR), 1)) { mn = m_reg; alpha = 1.f; }
    else { mn = fmaxf(m_reg, pmax); alpha = __builtin_amdgcn_exp2f((m_reg - mn) * C2); m_reg = mn; }
    const float mnL = -mn * C2;
    for (int r = 0; r < 16; ++r) p0[r] = fmaf(p0[r], C2, mnL); for (int r = 0; r < 16; ++r) p1[r] = fmaf(p1[r], C2, mnL);
    for (int r = 0; r < 16; ++r) p0[r] = __builtin_amdgcn_exp2f(p0[r]);
}
__device__ __forceinline__ void finishSM(f32x16& p0, f32x16& p1, float alpha, float& l_reg, bf16x8& pa0, bf16x8& pa1, bf16x8& pa2, bf16x8& pa3) {
    for (int r = 0; r < 16; ++r) p1[r] = __builtin_amdgcn_exp2f(p1[r]);
    float ps = 0; for (int r = 0; r < 16; ++r) ps += p0[r]; for (int r = 0; r < 16; ++r) ps += p1[r];
    { auto rr = __builtin_amdgcn_permlane32_swap(__float_as_uint(ps), __float_as_uint(ps), false, false);
      ps = __uint_as_float(rr[0]) + __uint_as_float(rr[1]); }
    l_reg = l_reg * alpha + ps;
#define PK4(P, B_, OUT) do { unsigned a0 = cvtpk(P[B_+0], P[B_+1]), a1 = cvtpk(P[B_+2], P[B_+3]);                          \
        unsigned b0 = cvtpk(P[B_+4], P[B_+5]), b1 = cvtpk(P[B_+6], P[B_+7]);                                             \
        auto r0 = __builtin_amdgcn_permlane32_swap(a0, b0, false, false); auto r1 = __builtin_amdgcn_permlane32_swap(a1, b1, false, false); \
        u32x4 w = {r0[0], r1[0], r0[1], r1[1]}; OUT = *reinterpret_cast<bf16x8*>(&w); } while (0)
    PK4(p0, 0, pa0); PK4(p0, 8, pa1); PK4(p1, 0, pa2); PK4(p1, 8, pa3);
#undef PK4
}
template <int KB, bool SK>
__device__ __forceinline__ void qkt(f32x16& p0, f32x16& p1, const char* K_lds, int r32, int hi, const bf16x8* qr, bool act) {
    if (SK && !act) { const float NEG = -__builtin_inff();
#pragma unroll
        for (int r = 0; r < 16; ++r) { p0[r] = NEG; p1[r] = NEG; } return; }
    p0 = f32x16{}; p1 = f32x16{};
    const char* kb[4];
#pragma unroll
    for (int dd = 0; dd < 4; ++dd) kb[dd] = K_lds + KB * SHM_K + KSWZ(r32, (dd * 16 + hi * 8) * 2);
#pragma unroll
    for (int d0 = 0; d0 < 8; ++d0) { const char* a = kb[d0 & 3] + (d0 >> 2) * 128;
        bf16x8 b0 = *reinterpret_cast<const bf16x8*>(a);
        bf16x8 b1 = *reinterpret_cast<const bf16x8*>(a + 32 * 256);
        p0 = __builtin_amdgcn_mfma_f32_32x32x16_bf16(b0, qr[d0], p0, 0, 0, 0);
        p1 = __builtin_amdgcn_mfma_f32_32x32x16_bf16(b1, qr[d0], p1, 0, 0, 0); }
}
template <int VB, bool SK>
__device__ __forceinline__ void pv_tile(f32x16* o, int vb0, bf16x8 pa0, bf16x8 pa1, bf16x8 pa2, bf16x8 pa3, bool act) {
    if (SK && !act) return;
#define TRRD(dst, off) asm volatile("ds_read_b64_tr_b16 %0, %1 offset:%2" : "=&v"(dst) : "v"(vb0), "i"(off) : "memory")
#define PV_D0(d0) do { s16x4 l0, l1, l2, l3, h0, h1, h2, h3; constexpr int b_ = VB * SHM_V + v_rd_off(d0, 0, 0);     \
        TRRD(l0, b_); TRRD(h0, b_ + 2048); TRRD(l1, b_ + 4096); TRRD(h1, b_ + 6144); TRRD(l2, b_ + 8192); TRRD(h2, b_ + 10240); TRRD(l3, b_ + 12288); TRRD(h3, b_ + 14336); \
        asm volatile("s_waitcnt lgkmcnt(0)" ::: "memory"); SBAR();                 \
        o[d0] = __builtin_amdgcn_mfma_f32_32x32x16_bf16(pa0, (bf16x8){l0[0], l0[1], l0[2], l0[3], h0[0], h0[1], h0[2], h0[3]}, o[d0], 0, 0, 0);   \
        o[d0] = __builtin_amdgcn_mfma_f32_32x32x16_bf16(pa1, (bf16x8){l1[0], l1[1], l1[2], l1[3], h1[0], h1[1], h1[2], h1[3]}, o[d0], 0, 0, 0);   \
        o[d0] = __builtin_amdgcn_mfma_f32_32x32x16_bf16(pa2, (bf16x8){l2[0], l2[1], l2[2], l2[3], h2[0], h2[1], h2[2], h2[3]}, o[d0], 0, 0, 0);   \
        o[d0] = __builtin_amdgcn_mfma_f32_32x32x16_bf16(pa3, (bf16x8){l3[0], l3[1], l3[2], l3[3], h3[0], h3[1], h3[2], h3[3]}, o[d0], 0, 0, 0); } while (0)
    PV_D0(0); PV_D0(1); PV_D0(2); PV_D0(3);
#undef PV_D0
#undef TRRD
}

template <class TIn, class TOut> struct BlockRef { const TIn* Q; const TIn* K; const TIn* V; TOut* O; int P0; };
template <class TIn> struct Seam {
    bf16x8 qr[8];
    bf16x8 st_v0, st_v1, st_k0, st_k1; f32x4 sf0, sf1, sf2, sf3;
    f32x4 tq[16];
};
__device__ __forceinline__ int swa_jlo(int P0, int W) { const int lowk = P0 - W + 1; return lowk > 0 ? lowk / KVBLK : 0; }
#define ROW(p, k0, rr) ((p) + (size_t)((k0) + (rr)) * D + sc)
#define VMW() asm volatile("s_waitcnt vmcnt(0)" ::: "memory")
#define VMWN(n) asm volatile("s_waitcnt vmcnt(%0)" :: "i"(n) : "memory")
#define SLOAD_H(Kp, Vp, k0) do { S.st_v0 = load8<TIn>(ROW(Vp, k0, sr)); S.st_v1 = load8<TIn>(ROW(Vp, k0, 32 + sr));              \
                         S.st_k0 = load8<TIn>(ROW(Kp, k0, sr)); S.st_k1 = load8<TIn>(ROW(Kp, k0, 32 + sr)); } while (0)
#define SWRITE_HK(bf) do { *(bf16x8*)(K_lds + (bf) * SHM_K + kws) = S.st_k0; *(bf16x8*)(K_lds + (bf) * SHM_K + kws + 32 * 256) = S.st_k1; } while (0)
#define SWRITE_HV(bf) do { *(bf16x8*)(V_lds + (bf) * SHM_V + vst0) = S.st_v0; *(bf16x8*)(V_lds + (bf) * SHM_V + vst1) = S.st_v1; } while (0)
#define SWRITE_H(bf) do { SWRITE_HV(bf); SWRITE_HK(bf); } while (0)
#define SLOAD_F(p, k0) do { S.sf0 = *(const f32x4*)ROW(p, k0, sr); S.sf1 = *(const f32x4*)(ROW(p, k0, sr) + 4);                \
                            S.sf2 = *(const f32x4*)ROW(p, k0, 32 + sr); S.sf3 = *(const f32x4*)(ROW(p, k0, 32 + sr) + 4); } while (0)
#define SWRITE_KF(bf) do { *(bf16x8*)(K_lds + (bf) * SHM_K + kws) = pack8(S.sf0, S.sf1); *(bf16x8*)(K_lds + (bf) * SHM_K + kws + 32 * 256) = pack8(S.sf2, S.sf3); } while (0)
#define SWRITE_VF(bf) do { *(bf16x8*)(V_lds + (bf) * SHM_V + vst0) = pack8(S.sf0, S.sf1); *(bf16x8*)(V_lds + (bf) * SHM_V + vst1) = pack8(S.sf2, S.sf3); } while (0)
template <class TIn, class TOut>
__device__ __forceinline__ void causal_swa_prime(const BlockRef<TIn, TOut>& cur, int W, char* lds, Seam<TIn>& S) {
    constexpr bool F32 = same_t<TIn, float>::v;
    const int tid = opaque_tid(), wid = __builtin_amdgcn_readfirstlane(tid >> 6), lane = tid & 63, r32 = lane & 31, hi = lane >> 5;
    const int sr = tid >> 4, sc = (tid & 15) * 8, kws = KSWZ(sr, sc * 2); char* K_lds = lds + 2 * SHM_V;
    const int kb0 = swa_jlo(cur.P0, W) * KVBLK;
    for (int d0 = 0; d0 < 8; ++d0) S.qr[d0] = load8<TIn>(cur.Q + (size_t)(wid * QBLK + r32) * D + d0 * 16 + hi * 8);
    if constexpr (F32) { SLOAD_F((const float*)cur.K, kb0); VMW(); SWRITE_KF(0); SBAR(); SLOAD_F((const float*)cur.V, kb0); }
    else { SLOAD_H(cur.K, cur.V, kb0); VMW(); SWRITE_HK(0); }
    __syncthreads();
}
template <class TIn, class TOut>
__device__ __forceinline__ void causal_swa_block(const BlockRef<TIn, TOut>& cur, const BlockRef<TIn, TOut>& nxt, int skv, int W, char* lds, Seam<TIn>& S) {
    constexpr bool F32 = same_t<TIn, float>::v;
    const int tid = opaque_tid(), wid = __builtin_amdgcn_readfirstlane(tid >> 6), lane = tid & 63, r32 = lane & 31, hi = lane >> 5;
    const int j_lo = swa_jlo(cur.P0, W);
    int j_hi = (cur.P0 + QB - 1) / KVBLK + 1; if (j_hi > skv / KVBLK) j_hi = skv / KVBLK;
    const int NT = j_hi - j_lo;
    const int kbn = swa_jlo(nxt.P0, W) * KVBLK;
    const int qlo = cur.P0 + wid * QBLK, qm = qlo + r32 - 4 * hi;
    char* V_lds = lds; char* K_lds = lds + 2 * SHM_V;
    float* ws = (float*)(lds + 2 * SHM_V + 2 * SHM_K) + wid * 64; float* li_l = ws, * al_l = ws + 32;
    float m_reg = -1e30f, l_reg = 0; f32x16 o[4] = {};
    const int sr = tid >> 4, sc = (tid & 15) * 8, vst0 = v_st(sr, sc), vst1 = v_st(32 + sr, sc), kws = KSWZ(sr, sc * 2);
    const int vb0 = (int)(uintptr_t)V_lds + v_rd_base(lane);
    const TIn* Kh = cur.K; const TIn* Vh = cur.V;
#define RESC(a) do { if (__any((a) < 1.f)) { if (hi == 0) al_l[r32] = (a); asm volatile("s_waitcnt lgkmcnt(0)" ::: "memory");              \
                     for (int d_ = 0; d_ < 4; ++d_) for (int r = 0; r < 16; ++r) o[d_][r] *= al_l[crow(r, hi)]; } } while (0)
#define KBASE(t) ((j_lo + (t)) * KVBLK)
#define ACT(t) (KBASE(t) <= qlo + QBLK - 1 && KBASE(t) + KVBLK - 1 >= qlo - W + 1)
#define MASKT(P0_, P1_, t) do { const int kb_ = KBASE(t); if ((!SK || ACT(t)) && (kb_ + KVBLK - 1 > qlo || kb_ <= qlo + QBLK - 1 - W)) mask_tile(P0_, P1_, qm - kb_, (unsigned)W); } while (0)
    constexpr int NQL = F32 ? 16 : 8;
    constexpr bool SK = WSKIP && !F32;
#define SEAM_K0() do { VMWN(NQL); if constexpr (F32) { SWRITE_KF(0); SBAR(); SLOAD_F((const float*)nxt.V, kbn); } else { SWRITE_HK(0); } SBAR(); } while (0)
    f32x16 pA0, pA1, pB0, pB1; float mnA, mnB, alA, alB; bf16x8 pa0, pa1, pa2, pa3;
    if constexpr (F32) { VMW(); SWRITE_VF(0); SBAR(); } else { SWRITE_HV(0); SBAR(); }
    if (NT > 1) { if constexpr (F32) SLOAD_F((const float*)Kh, KBASE(1)); else SLOAD_H(Kh, Vh, KBASE(1)); }
    SBAR(); qkt<0, SK>(pA0, pA1, K_lds, r32, hi, S.qr, ACT(0));
    if constexpr (F32) { if (NT > 1) { VMW(); SWRITE_KF(1); SBAR(); SLOAD_F((const float*)Vh, KBASE(1)); } }
    MASKT(pA0, pA1, 0); partialSM(pA0, pA1, m_reg, mnA, alA);
    if (NT > 1) { VMW(); if constexpr (F32) { SWRITE_VF(1); SBAR(); if (NT > 2) SLOAD_F((const float*)Kh, KBASE(2)); } else SWRITE_H(1); }
    __syncthreads();
#define HALF_STEP(PX0, PX1, mnX, alX, PY0, PY1, alY, t, KB, VB, SB) do {                                                      \
        SBAR(); qkt<KB, SK>(PX0, PX1, K_lds, r32, hi, S.qr, ACT(t));                                             \
        finishSM(PY0, PY1, alY, l_reg, pa0, pa1, pa2, pa3); SBAR();                                                           \
        if ((t) + 1 < NT) { if constexpr (F32) { VMW(); SWRITE_KF(SB); SBAR(); SLOAD_F((const float*)Vh, KBASE((t) + 1)); }  \
                            else { SLOAD_H(Kh, Vh, KBASE((t) + 1)); } SBAR(); }                                               \
        pv_tile<VB, SK>(o, vb0, pa0, pa1, pa2, pa3, ACT((t) - 1)); MASKT(PX0, PX1, (t)); partialSM(PX0, PX1, m_reg, mnX, alX);                                        \
        __syncthreads();                                                                                                      \
        if ((t) + 1 < NT) { VMW(); if constexpr (F32) { SWRITE_VF(SB); SBAR(); if ((t) + 2 < NT) SLOAD_F((const float*)Kh, KBASE((t) + 2)); } \
                            else { SWRITE_H(SB); } }                                                                          \
        RESC(alX); __syncthreads(); } while (0)
    for (int t = 1; t + 1 < NT; t += 2) {
        HALF_STEP(pB0, pB1, mnB, alB, pA0, pA1, alA, t, 1, 0, 0);
        HALF_STEP(pA0, pA1, mnA, alA, pB0, pB1, alB, t + 1, 0, 1, 1);
    }
    const bool even = (NT & 1) == 0;
    if (even) { SBAR(); qkt<1, SK>(pB0, pB1, K_lds, r32, hi, S.qr, ACT(NT - 1)); SBAR(); }
#define QROW(e) (nxt.Q + (size_t)(wid * QBLK + r32) * D + ((e) >> 1) * 16 + hi * 8 + ((e) & 1) * 4)
    if constexpr (F32) { SLOAD_F((const float*)nxt.K, kbn); SBAR();
#pragma unroll
        for (int e = 0; e < 8; ++e) S.tq[e] = *(const f32x4*)QROW(e); }
    else { SLOAD_H(nxt.K, nxt.V, kbn); SBAR();
#pragma unroll
        for (int d0 = 0; d0 < 8; ++d0) S.qr[d0] = load8<TIn>(nxt.Q + (size_t)(wid * QBLK + r32) * D + d0 * 16 + hi * 8); }
    SBAR();
    finishSM(pA0, pA1, alA, l_reg, pa0, pa1, pa2, pa3); SBAR();
    if constexpr (F32) {
#pragma unroll
        for (int e = 8; e < 16; ++e) S.tq[e] = *(const f32x4*)QROW(e); SBAR(); }
#undef QROW
    pv_tile<0, SK>(o, vb0, pa0, pa1, pa2, pa3, ACT(even ? NT - 2 : NT - 1));
    if (even) { MASKT(pB0, pB1, NT - 1); partialSM(pB0, pB1, m_reg, mnB, alB); __syncthreads(); RESC(alB);
        finishSM(pB0, pB1, alB, l_reg, pa0, pa1, pa2, pa3); SBAR(); pv_tile<1, SK>(o, vb0, pa0, pa1, pa2, pa3, ACT(NT - 1)); }
    SBAR(); SEAM_K0();
    if (hi == 0) li_l[r32] = l_reg; asm volatile("s_waitcnt lgkmcnt(0)" ::: "memory");
    float rli[16];
#pragma unroll
    for (int r = 0; r < 16; ++r) rli[r] = __builtin_amdgcn_rcpf(li_l[crow(r, hi)]);
    TOut* Ow = cur.O + (size_t)(wid * QBLK) * D;
#pragma unroll
    for (int r = 0; r < 16; ++r) { const int orow = crow(r, hi);
#pragma unroll
        for (int d0 = 0; d0 < 4; ++d0) { const float v = o[d0][r] * rli[r];
            if constexpr (same_t<TOut, float>::v) { Ow[(size_t)orow * D + d0 * 32 + r32] = v; }
            else { const float vn = __shfl_xor(v, 1);
                   if ((r32 & 1) == 0) *(unsigned*)(Ow + (size_t)orow * D + d0 * 32 + r32) = cvtpk(v, vn); } } }
    if constexpr (F32) {
#pragma unroll
        for (int d0 = 0; d0 < 8; ++d0) S.qr[d0] = pack8(S.tq[2 * d0], S.tq[2 * d0 + 1]); }
    __syncthreads();
#undef RESC
#undef KBASE
#undef ACT
#undef MASKT
#undef SEAM_K0
#undef HALF_STEP
}
#undef ROW
#undef VMW
#undef VMWN
#undef SLOAD_H
#undef SWRITE_HK
#undef SWRITE_HV
#undef SWRITE_H
#undef SLOAD_F
#undef SWRITE_KF
#undef SWRITE_VF
#undef KSWZ
#undef SBAR
}

namespace att2 {
typedef short bf16x8 __attribute__((ext_vector_type(8)));
typedef short s16x4 __attribute__((ext_vector_type(4)));
typedef float f32x16 __attribute__((ext_vector_type(16)));
typedef unsigned u32x4 __attribute__((ext_vector_type(4)));
constexpr float SCALE = 0.08838834764831845f, THR = 8.f, C2 = 1.4426950408889634f * SCALE;
constexpr int V_OFF = 0, K_OFF = 65536, PX_OFF = 98304, MX_OFF = 114688, WS_OFF = 118784, LDS_NEED = 120832;
#define A2_KSWZ(row, colB) ((row) * 256 + ((colB) ^ (((row) & 7) << 4)))
#define A2_SBAR() __builtin_amdgcn_sched_barrier(0)
template <int KB>
__device__ __forceinline__ void qkt(f32x16& p, const char* Kl, int krow, int hi, const bf16x8* qr) {
    p = f32x16{};
    const char* kbp[4];
#pragma unroll
    for (int dd = 0; dd < 4; ++dd) kbp[dd] = Kl + KB * 16384 + A2_KSWZ(krow, (dd * 16 + hi * 8) * 2);
    bf16x8 b[8];
#pragma unroll
    for (int d0 = 0; d0 < 8; ++d0) b[d0] = *reinterpret_cast<const bf16x8*>(kbp[d0 & 3] + (d0 >> 2) * 128);
    __builtin_amdgcn_s_setprio(3);
#pragma unroll
    for (int d0 = 0; d0 < 8; ++d0) p = __builtin_amdgcn_mfma_f32_32x32x16_bf16(b[d0], qr[d0], p, 0, 0, 0);
    __builtin_amdgcn_s_setprio(0);
}
template <int VOFFB>
__device__ __forceinline__ void pv(f32x16* o, int vb0, bf16x8 pa0, bf16x8 pa1, bf16x8 pa2, bf16x8 pa3) {
#define A2_TRRD(dst, off) asm volatile("ds_read_b64_tr_b16 %0, %1 offset:%2" : "=&v"(dst) : "v"(vb0), "i"(off) : "memory")
#define A2_PV_D0(d0) do { s16x4 l0, l1, l2, l3, h0, h1, h2, h3; constexpr int b_ = VOFFB + att::v_rd_off(d0, 0, 0); \
        A2_TRRD(l0, b_); A2_TRRD(h0, b_ + 2048); A2_TRRD(l1, b_ + 4096); A2_TRRD(h1, b_ + 6144); A2_TRRD(l2, b_ + 8192); A2_TRRD(h2, b_ + 10240); A2_TRRD(l3, b_ + 12288); A2_TRRD(h3, b_ + 14336); \
        asm volatile("s_waitcnt lgkmcnt(0)" ::: "memory"); A2_SBAR(); \
        o[d0] = __builtin_amdgcn_mfma_f32_32x32x16_bf16(pa0, (bf16x8){l0[0], l0[1], l0[2], l0[3], h0[0], h0[1], h0[2], h0[3]}, o[d0], 0, 0, 0); \
        o[d0] = __builtin_amdgcn_mfma_f32_32x32x16_bf16(pa1, (bf16x8){l1[0], l1[1], l1[2], l1[3], h1[0], h1[1], h1[2], h1[3]}, o[d0], 0, 0, 0); \
        o[d0] = __builtin_amdgcn_mfma_f32_32x32x16_bf16(pa2, (bf16x8){l2[0], l2[1], l2[2], l2[3], h2[0], h2[1], h2[2], h2[3]}, o[d0], 0, 0, 0); \
        o[d0] = __builtin_amdgcn_mfma_f32_32x32x16_bf16(pa3, (bf16x8){l3[0], l3[1], l3[2], l3[3], h3[0], h3[1], h3[2], h3[3]}, o[d0], 0, 0, 0); } while (0)
    __builtin_amdgcn_s_setprio(3); A2_PV_D0(0); A2_PV_D0(1); A2_PV_D0(2); A2_PV_D0(3); __builtin_amdgcn_s_setprio(0);
#undef A2_PV_D0
#undef A2_TRRD
}
__device__ __forceinline__ float rowmax16(const f32x16& p) {
    float pm = p[0];
#pragma unroll
    for (int r = 1; r < 16; ++r) pm = fmaxf(pm, p[r]);
    auto rr = __builtin_amdgcn_permlane32_swap(__float_as_uint(pm), __float_as_uint(pm), false, false);
    return fmaxf(__uint_as_float(rr[0]), __uint_as_float(rr[1]));
}
template <bool DEG>
__device__ __forceinline__ void block(const unsigned short* Q, const unsigned short* K, const unsigned short* V0, const unsigned short* V1, float* O0, float* O1, int P0, char* lds) {
    const int tid = opaque_tid(), wid = __builtin_amdgcn_readfirstlane(tid >> 6), lane = tid & 63, r32 = lane & 31, hi = lane >> 5, rg = wid >> 1, kh = wid & 1, hf = wid >> 2;
    const int NT = P0 / 64 + 2, qlo = P0 + 32 * rg;
    const int sr = tid >> 4, sc = (tid & 15) * 8, kws = A2_KSWZ(sr, sc * 2), vst0 = att::v_st(sr, sc), vst1 = att::v_st(32 + sr, sc);
    char* Vl = lds + V_OFF; char* Kl = lds + K_OFF;
    const int vb0 = (int)(uintptr_t)Vl + att::v_rd_base(lane) + kh * 16384, krow = 32 * kh + r32;
    float* wsl = (float*)(lds + WS_OFF) + wid * 64; float* al_l = wsl; float* li_l = wsl + 32;
    const float* li_p = (const float*)(lds + WS_OFF) + (wid ^ 1) * 64 + 32;
    float* mxw = (float*)(lds + MX_OFF) + wid * 64 + lane; const float* mxr = (const float*)(lds + MX_OFF) + (wid ^ 1) * 64 + lane;
    char* pxw = lds + PX_OFF + ((rg * 4 + 2 * kh) * 64 + lane) * 16; const char* pxr = lds + PX_OFF + (rg * 4 * 64 + lane) * 16;
    bf16x8 qr[8];
#pragma unroll
    for (int d0 = 0; d0 < 8; ++d0) qr[d0] = *reinterpret_cast<const bf16x8*>(Q + (size_t)(32 * rg + r32) * 128 + d0 * 16 + hi * 8);
    bf16x8 sk0, sk1, sv0, sv1, sv2, sv3;
#define A2_LOADK(t) do { const size_t o0_ = (size_t)((DEG ? 0 : (t)) * 64 + sr) * 128 + sc, o1_ = o0_ + 32 * 128; sk0 = *reinterpret_cast<const bf16x8*>(K + o0_); sk1 = *reinterpret_cast<const bf16x8*>(K + o1_); } while (0)
#define A2_LOADV(t) do { const size_t o0_ = (size_t)((DEG ? 0 : (t)) * 64 + sr) * 128 + sc, o1_ = o0_ + 32 * 128; \
        sv0 = *reinterpret_cast<const bf16x8*>(V0 + o0_); sv1 = *reinterpret_cast<const bf16x8*>(V0 + o1_); sv2 = *reinterpret_cast<const bf16x8*>(V1 + o0_); sv3 = *reinterpret_cast<const bf16x8*>(V1 + o1_); } while (0)
#define A2_BAR() do { asm volatile("s_waitcnt lgkmcnt(0)" ::: "memory"); __builtin_amdgcn_s_barrier(); asm volatile("" ::: "memory"); } while (0)
#define A2_WRITEK(b) do { *(bf16x8*)(Kl + (b) * 16384 + kws) = sk0; *(bf16x8*)(Kl + (b) * 16384 + kws + 32 * 256) = sk1; } while (0)
#define A2_WRITEV(b) do { *(bf16x8*)(Vl + (b) * 32768 + vst0) = sv0; *(bf16x8*)(Vl + (b) * 32768 + vst1) = sv1; *(bf16x8*)(Vl + (b) * 32768 + 16384 + vst0) = sv2; *(bf16x8*)(Vl + (b) * 32768 + 16384 + vst1) = sv3; } while (0)
#define A2_VMW(n) asm volatile("s_waitcnt vmcnt(%0)" :: "i"(n) : "memory")
#define A2_MASKMAX(PX, pmX, t) do { const int kb_ = (t) * 64 + 32 * kh; \
        if (kb_ + 31 > qlo) { const int dq_ = qlo + r32 - kb_ - 4 * hi; const float NEG_ = -__builtin_inff(); \
            _Pragma("unroll") for (int r = 0; r < 16; ++r) { const int c_ = (r & 3) + 8 * (r >> 2); if (dq_ - c_ < 0) PX[r] = NEG_; } } \
        pmX = rowmax16(PX); mxw[((t) & 1) * 512] = pmX; } while (0)
#define A2_FINISH(PY, pmY, alY, u) do { const float pm_ = fmaxf(pmY, mxr[((u) & 1) * 512]); float mn_; \
        if (__builtin_expect(__all((pm_ - m_reg) * SCALE <= THR), 1)) { mn_ = m_reg; alY = 1.f; } \
        else { mn_ = fmaxf(m_reg, pm_); alY = __builtin_amdgcn_exp2f((m_reg - mn_) * C2); m_reg = mn_; } \
        const float mnL_ = -mn_ * C2; \
        _Pragma("unroll") for (int r = 0; r < 16; ++r) PY[r] = __builtin_amdgcn_exp2f(fmaf(PY[r], C2, mnL_)); \
        float ps_ = 0.f; _Pragma("unroll") for (int r = 0; r < 16; ++r) ps_ += PY[r]; \
        { auto rr_ = __builtin_amdgcn_permlane32_swap(__float_as_uint(ps_), __float_as_uint(ps_), false, false); ps_ = __uint_as_float(rr_[0]) + __uint_as_float(rr_[1]); } \
        l_reg = l_reg * alY + ps_; \
        A2_PK4(PY, 0, pxw); A2_PK4(PY, 8, pxw + 1024); } while (0)
#define A2_PK4(P, B_, DST) do { unsigned a0_ = att::cvtpk(P[B_ + 0], P[B_ + 1]), a1_ = att::cvtpk(P[B_ + 2], P[B_ + 3]), b0_ = att::cvtpk(P[B_ + 4], P[B_ + 5]), b1_ = att::cvtpk(P[B_ + 6], P[B_ + 7]); \
        auto r0_ = __builtin_amdgcn_permlane32_swap(a0_, b0_, false, false); auto r1_ = __builtin_amdgcn_permlane32_swap(a1_, b1_, false, false); \
        u32x4 w_ = {r0_[0], r1_[0], r0_[1], r1_[1]}; *(u32x4*)(DST) = w_; } while (0)
#define A2_PVSTEP(alY, VOFFB) do { const bf16x8 pa0_ = *reinterpret_cast<const bf16x8*>(pxr), pa1_ = *reinterpret_cast<const bf16x8*>(pxr + 1024), pa2_ = *reinterpret_cast<const bf16x8*>(pxr + 2048), pa3_ = *reinterpret_cast<const bf16x8*>(pxr + 3072); \
        if (__any((alY) < 1.f)) { if (hi == 0) al_l[r32] = (alY); asm volatile("s_waitcnt lgkmcnt(0)" ::: "memory"); \
            _Pragma("unroll") for (int d_ = 0; d_ < 4; ++d_) _Pragma("unroll") for (int r = 0; r < 16; ++r) o[d_][r] *= al_l[att::crow(r, hi)]; } \
        pv<VOFFB>(o, vb0, pa0_, pa1_, pa2_, pa3_); } while (0)
#define A2_STEP(PX, pmX, PY, pmY, alY, t, KB) do { \
        if ((t) + 1 < NT) { A2_VMW(4); A2_WRITEK(1 - KB); if ((t) + 2 < NT) A2_LOADK((t) + 2); } A2_SBAR(); \
        qkt<KB>(PX, Kl, krow, hi, qr); \
        A2_FINISH(PY, pmY, alY, (t) - 1); \
        A2_MASKMAX(PX, pmX, t); \
        A2_BAR(); \
        if ((t) + 2 < NT) A2_VMW(2); else A2_VMW(0); \
        A2_WRITEV(KB); if ((t) + 1 < NT) A2_LOADV((t) + 1); A2_SBAR(); \
        A2_PVSTEP(alY, (1 - KB) * 32768); \
        A2_BAR(); } while (0)
    float m_reg = -1e30f, l_reg = 0.f; f32x16 o[4] = {};
    f32x16 pA, pB; float pmA, pmB, alA = 1.f, alB = 1.f;
    A2_LOADK(0); A2_VMW(0); A2_WRITEK(0); A2_LOADK(1); A2_LOADV(0);
    A2_BAR();
    if (hf == 1) A2_BAR();
    A2_VMW(4); A2_WRITEK(1); if (2 < NT) A2_LOADK(2); A2_SBAR();
    qkt<0>(pA, Kl, krow, hi, qr); A2_SBAR();
    A2_MASKMAX(pA, pmA, 0);
    A2_BAR();
    if (2 < NT) A2_VMW(2); else A2_VMW(0);
    A2_WRITEV(0); A2_LOADV(1);
    A2_BAR();
    A2_STEP(pB, pmB, pA, pmA, alA, 1, 1);
    for (int t = 2; t < NT; t += 2) {
        A2_STEP(pA, pmA, pB, pmB, alB, t, 0);
        A2_STEP(pB, pmB, pA, pmA, alA, t + 1, 1);
    }
    A2_FINISH(pB, pmB, alB, NT - 1);
    A2_BAR();
    A2_PVSTEP(alB, 32768);
    if (hf == 0) A2_BAR();
    if (hi == 0) li_l[r32] = l_reg;
    A2_BAR();
    float rli[16];
#pragma unroll
    for (int r = 0; r < 16; ++r) rli[r] = __builtin_amdgcn_rcpf(li_l[att::crow(r, hi)] + li_p[att::crow(r, hi)]);
    float* Ow = (kh ? O1 : O0) + (size_t)(32 * rg) * 128;
#pragma unroll
    for (int r = 0; r < 16; ++r) { const int orow = att::crow(r, hi);
#pragma unroll
        for (int d0 = 0; d0 < 4; ++d0) Ow[(size_t)orow * 128 + d0 * 32 + r32] = o[d0][r] * rli[r]; }
    A2_BAR();
#undef A2_LOADK
#undef A2_LOADV
#undef A2_BAR
#undef A2_WRITEK
#undef A2_WRITEV
#undef A2_VMW
#undef A2_MASKMAX
#undef A2_FINISH
#undef A2_PK4
#undef A2_PVSTEP
#undef A2_STEP
}
#undef A2_KSWZ
#undef A2_SBAR
}

#ifndef MK_PER_PHASE
#define MK_PER_PHASE 0
#endif
constexpr int NWAVES = 8, NTHR = 512;
constexpr int SEQ = 16384, DM = 4096, FFH = 11008, DEPTH = 4, NMODV = 6 * DM;
#ifndef PADK
#define PADK 64
#endif
constexpr int LDD = DM + PADK, LDF = FFH + PADK;
constexpr int ZG = 96;
constexpr size_t GS = (size_t)SEQ * 128;
constexpr int S5T = 64, S5NC = SEQ / S5T;
constexpr int KSL = 16;
constexpr float NORM_EPS = 1e-6f, SUBLN_EPS = 1e-5f;
constexpr int N_PHASES = 35;

constexpr size_t MiB = 1u << 20;
constexpr size_t WS_CTL = 0, CTL_ZERO_BYTES = 64 * 1024;
constexpr size_t WS_MODP = 1 * MiB;
constexpr size_t WS_MODL = 3 * MiB;
constexpr size_t WS_LAM = 3 * MiB + 512 * 1024;
constexpr size_t WS_S5P = 4 * MiB, S5P_LAYER = 4 * MiB + 256 * 1024;
constexpr size_t S5P_ABR = 0, S5P_ABI = 64 * 1024, S5P_ATR = 128 * 1024, S5P_ATI = 192 * 1024, S5P_BBR = 256 * 1024, S5P_BBI = 256 * 1024 + MiB;
constexpr size_t S5P_BBOP = 256 * 1024 + 2 * MiB, S5P_COP = 256 * 1024 + 3 * MiB;
#ifndef S5_MFMA
#define S5_MFMA 1
#endif
constexpr size_t W_IN_B = (size_t)12288 * LDD * 2, W_OUT_B = (size_t)4096 * LDD * 2, W_GLU_B = (size_t)8192 * LDD * 2, W_GU_B = (size_t)22016 * LDD * 2, W_DN_B = (size_t)4096 * LDF * 2;
constexpr size_t WS_WIN = 16 * MiB, WS_WOUT = WS_WIN + 2 * W_IN_B, WS_WGLU = WS_WOUT + 2 * W_OUT_B, WS_WGU = WS_WGLU + 2 * W_GLU_B, WS_WDN = WS_WGU + 4 * W_GU_B;
constexpr size_t WS_H = WS_WDN + 4 * W_DN_B;
constexpr size_t WS_MIX = WS_H + (size_t)SEQ * LDD * 2;
constexpr size_t WS_Z = WS_MIX + (size_t)SEQ * LDD * 2;
constexpr size_t WS_OT = WS_Z + (size_t)ZG * GS * 2;
constexpr size_t WS_S5F = WS_OT + (size_t)32 * GS * 4;
constexpr size_t WS_S5H = WS_S5F + (size_t)S5NC * 256 * 128 * 4;
constexpr size_t WS_END = WS_S5H + (size_t)S5NC * 256 * 128 * 4;
static_assert((size_t)SEQ * LDF * 2 <= (size_t)ZG * GS * 2, "hidden overlays Z");
static_assert(WS_WIN % 256 == 0 && WS_H % 256 == 0 && WS_OT % 256 == 0 && WS_S5F % 256 == 0, "alignment");
constexpr int CW_BAR = 1024;

constexpr int RING_BYTES = 131072, MISC_OFF = RING_BYTES + 320, LDS_BYTES = 147456;

#define GAS __attribute__((address_space(1)))
#define LAS __attribute__((address_space(3)))
typedef unsigned short bf16;
typedef unsigned v4u __attribute__((ext_vector_type(4)));
typedef unsigned v2u __attribute__((ext_vector_type(2)));
typedef float f32x4 __attribute__((ext_vector_type(4)));
#define LDS_WAIT() asm volatile("s_waitcnt lgkmcnt(0)" ::: "memory")
#define VM_WAIT() asm volatile("s_waitcnt vmcnt(0)" ::: "memory")
__device__ __forceinline__ unsigned pk2(float lo, float hi) { unsigned r; asm volatile("v_cvt_pk_bf16_f32 %0, %1, %2" : "=v"(r) : "v"(lo), "v"(hi)); return r; }
__device__ __forceinline__ float bflo(unsigned w) { return __builtin_bit_cast(float, w << 16); }
__device__ __forceinline__ float bfhi(unsigned w) { return __builtin_bit_cast(float, w & 0xffff0000u); }

#define XB_TMO      128
#define XB_XCNT(j)  (256  + 64 * (j))
#define XB_XSUB(j)  (1280 + 64 * (j))
#define XB_XGEN(j)  (2304 + 64 * (j))
#define XB_TOP      3328
#define XB_TOPGEN   3392
#define XCD_BAR_WORDS 3456
#define XB_SPIN_CAP (1u << 22)

__device__ __forceinline__ unsigned xb_ld(unsigned* p)              { return __hip_atomic_load(p, __ATOMIC_RELAXED, __HIP_MEMORY_SCOPE_AGENT); }
__device__ __forceinline__ unsigned xb_add(unsigned* p, unsigned v) { return __hip_atomic_fetch_add(p, v, __ATOMIC_RELAXED, __HIP_MEMORY_SCOPE_AGENT); }
__device__ __forceinline__ unsigned xb_xcc_id() { return (unsigned)__builtin_amdgcn_s_getreg((3 << 11) | 20) & 0xFu; }
#define XB_SPIN(cond, bar) do { unsigned _sp = 0; while (cond) { __builtin_amdgcn_s_sleep(1); \
    if ((++_sp & 255u) == 0u) { if (xb_ld(&(bar)[XB_TMO])) break; if (_sp > XB_SPIN_CAP) { atomicAdd(&(bar)[XB_TMO], 1u); break; } } } } while (0)

struct XcdBarrier {
    unsigned* bar; unsigned x;
    volatile LAS unsigned* st;
};
__device__ __forceinline__ XcdBarrier xcd_barrier_post(unsigned* bar, volatile LAS unsigned* st) {
    XcdBarrier b; b.bar = bar; b.x = xb_xcc_id(); b.st = st;
    if (threadIdx.x == 0) (void)xb_add(&bar[XB_XCNT(b.x)], 1u);
    return b;
}
__device__ __forceinline__ void xcd_barrier_complete(unsigned* bar, unsigned x, unsigned& nloc, unsigned& nx) {
    const unsigned G = gridDim.x * gridDim.y * gridDim.z;
    unsigned sum, cnt, mine, sp = 0u;
    for (;;) {
        sum = 0u; cnt = 0u; mine = 0u;
#pragma unroll
        for (unsigned j = 0; j < 16; ++j) { const unsigned c = xb_ld(&bar[XB_XCNT(j)]); sum += c; cnt += (c > 0u) ? 1u : 0u; mine = (j == x) ? c : mine; }
        if (sum == G) break;
        __builtin_amdgcn_s_sleep(1);
        if ((++sp & 255u) == 0u) { if (xb_ld(&bar[XB_TMO])) break; if (sp > XB_SPIN_CAP) { atomicAdd(&bar[XB_TMO], 1u); break; } }
    }
    nloc = mine > 0u ? mine : 1u; nx = cnt > 0u ? cnt : 1u;
}
__device__ __forceinline__ void xcd_barrier(const XcdBarrier& b) {
    asm volatile("s_waitcnt vmcnt(0)" ::: "memory");
    __syncthreads();
    if (threadIdx.x == 0) {
        unsigned* bar = b.bar;
        __builtin_amdgcn_s_waitcnt(0);
        unsigned nloc = b.st[0], nx = b.st[1];
        if (nloc == 0u) { xcd_barrier_complete(bar, b.x, nloc, nx); b.st[0] = nloc; b.st[1] = nx; }
        const unsigned old = xb_add(&bar[XB_XSUB(b.x)], 1u);
        const unsigned gen = old / nloc;
        if (old + 1u == (gen + 1u) * nloc) {
            __builtin_amdgcn_fence(__ATOMIC_RELEASE, "agent");
            asm volatile("s_waitcnt vmcnt(0)" ::: "memory");
            const unsigned og = xb_add(&bar[XB_TOP], 1u);
            const unsigned tg = og / nx;
            if (og + 1u == (tg + 1u) * nx) xb_add(&bar[XB_TOPGEN], 1u);
            else XB_SPIN(xb_ld(&bar[XB_TOPGEN]) == tg, bar);
            __builtin_amdgcn_fence(__ATOMIC_ACQUIRE, "agent");
            xb_add(&bar[XB_XGEN(b.x)], 1u);
            asm volatile("s_waitcnt vmcnt(0)" ::: "memory");
        } else {
            XB_SPIN(xb_ld(&bar[XB_XGEN(b.x)]) == gen, bar);
            __builtin_amdgcn_fence(__ATOMIC_ACQUIRE, "agent");
            asm volatile("s_waitcnt vmcnt(0)" ::: "memory");
        }
    }
    __syncthreads();
}

__device__ __forceinline__ float wave_sum(float v) {
#pragma unroll
    for (int o = 1; o < 64; o <<= 1) v += __shfl_xor(v, o);
    return v;
}

__device__ __forceinline__ void transpose_item(const float* W, int K, int N, bf16* WT, int ldw, int mode, LAS float* scr, int item, int lane) {
    const int nblk = N / 32, kb = item / nblk, nb = item - kb * nblk, k0 = 64 * kb, n0 = 32 * nb;
    const int drow0 = mode == 0 ? n0 : ((n0 >> 7) * 256 + (n0 & 127) + (mode == 2 ? 128 : 0));
#pragma unroll 8
    for (int i = 0; i < 32; ++i) { const int kk = 2 * i + (lane >> 5); scr[kk * 33 + (lane & 31)] = W[(size_t)(k0 + kk) * N + n0 + (lane & 31)]; }
    LDS_WAIT(); asm volatile("" ::: "memory");
    const int c = lane & 7;
#pragma unroll
    for (int j = 0; j < 4; ++j) { const int n = (lane >> 3) + 8 * j; const LAS float* s = scr + (8 * c) * 33 + n;
        v4u o; o.x = pk2(s[0 * 33], s[1 * 33]); o.y = pk2(s[2 * 33], s[3 * 33]); o.z = pk2(s[4 * 33], s[5 * 33]); o.w = pk2(s[6 * 33], s[7 * 33]);
        *(v4u*)(WT + (size_t)(drow0 + n) * ldw + k0 + 8 * c) = o; }
    LDS_WAIT(); asm volatile("" ::: "memory");
}
__device__ __forceinline__ void dsincos(double x, double& s, double& c) {
    const double k = rint(x * 0.63661977236758134308);
    double r = fma(-k, 1.5707963267948966192, x); r = fma(-k, 6.1232339957367658860e-17, r);
    const double r2 = r * r;
    double ps = -1.0 / 1307674368000.0; ps = fma(ps, r2, 1.0 / 6227020800.0); ps = fma(ps, r2, -1.0 / 39916800.0); ps = fma(ps, r2, 1.0 / 362880.0); ps = fma(ps, r2, -1.0 / 5040.0);
    ps = fma(ps, r2, 1.0 / 120.0); ps = fma(ps, r2, -1.0 / 6.0); ps = fma(ps, r2, 1.0); const double sn = r * ps;
    double pc = 1.0 / 20922789888000.0; pc = fma(pc, r2, -1.0 / 87178291200.0); pc = fma(pc, r2, 1.0 / 479001600.0); pc = fma(pc, r2, -1.0 / 3628800.0); pc = fma(pc, r2, 1.0 / 40320.0);
    pc = fma(pc, r2, -1.0 / 720.0); pc = fma(pc, r2, 1.0 / 24.0); pc = fma(pc, r2, -0.5); const double cs = fma(pc, r2, 1.0);
    const int q = (int)k & 3;
    s = (q == 0) ? sn : (q == 1) ? cs : (q == 2) ? -sn : -cs;
    c = (q == 0) ? cs : (q == 1) ? -sn : (q == 2) ? -cs : sn;
}
__device__ __forceinline__ double dexp(double x) {
    const double k = rint(x * 1.4426950408889634074);
    double r = fma(-k, 0.69314718055994528623, x); r = fma(-k, 2.3190468138462995584e-17, r);
    double p = 1.0 / 87178291200.0; p = fma(p, r, 1.0 / 6227020800.0); p = fma(p, r, 1.0 / 479001600.0); p = fma(p, r, 1.0 / 39916800.0); p = fma(p, r, 1.0 / 3628800.0); p = fma(p, r, 1.0 / 362880.0);
    p = fma(p, r, 1.0 / 40320.0); p = fma(p, r, 1.0 / 5040.0); p = fma(p, r, 1.0 / 720.0); p = fma(p, r, 1.0 / 120.0); p = fma(p, r, 1.0 / 24.0); p = fma(p, r, 1.0 / 6.0); p = fma(p, r, 0.5); p = fma(p, r, 1.0); p = fma(p, r, 1.0);
    const long long bits = (long long)(1023 + (int)k) << 52;
    return p * __builtin_bit_cast(double, bits);
}

struct Args { const float* in[29]; float* out; unsigned char* ws; int ph_lo, ph_hi; };

__device__ __forceinline__ void p0_prologue(const Args& A, LAS unsigned char* lds, int gw, int NGW, int wave, int lane) {
    unsigned char* ws = A.ws;
    for (int w = gw; w < 96 * KSL + 512 + 2048; w += NGW) {
    if (w >= 96 * KSL + 512) {
        const int idx = (w - 96 * KSL - 512) * 64 + lane, o = idx >> 16, r = idx & 65535, g = r >> 8, mm = (r >> 6) & 3, o16 = lane & 15, kq = lane >> 4;
        const int tau = 2 * mm, p0 = 16 * (tau & 3) + 4 * kq;
        const float* cs = (tau < 4 ? A.in[21] : A.in[22]) + (size_t)o * 256 * 16 * 64 + (size_t)(g * 16 + o16) * 64 + p0; const float sg = tau < 4 ? 1.0f : -1.0f;
        const f32x4 a = *(const f32x4*)cs * sg, b = *(const f32x4*)(cs + 16) * sg;
        v4u q; q.x = pk2(a.x, a.y); q.y = pk2(a.z, a.w); q.z = pk2(b.x, b.y); q.w = pk2(b.z, b.w);
        *(v4u*)(ws + WS_S5P + (size_t)o * S5P_LAYER + S5P_COP + ((size_t)((g * 4 + mm) * 64 + lane)) * 16) = q;
    } else if (w < 96 * KSL) {
        const int nb = w % 96, ks = w / 96;
        const float* wp = A.in[2] + (size_t)(ks * 256) * NMODV + nb * 256 + lane * 4; const float* cp = A.in[1] + ks * 256;
        f32x4 a = {0.f, 0.f, 0.f, 0.f};
#pragma unroll 8
        for (int k = 0; k < 256; ++k) { const float cv = cp[k]; const float s = cv / (1.0f + expf(-cv)); const f32x4 w = *(const f32x4*)(wp + (size_t)k * NMODV); a += s * w; }
        *(f32x4*)((float*)(ws + WS_MODP) + (size_t)ks * NMODV + nb * 256 + lane * 4) = a;
    } else {
        const int idx = (w - 96 * KSL) * 64 + lane, o = idx >> 14, gp = idx & 16383, g = gp >> 6;
        const double lr = (double)fminf(A.in[16][idx], -1e-4f), li = (double)A.in[17][idx], dt = dexp((double)A.in[18][o * 256 + g]);
        const double mag = dexp(lr * dt); double sn, cs; dsincos(li * dt, sn, cs);
        const double abr = mag * cs, abi = mag * sn, den = lr * lr + li * li, nr = abr - 1.0, ni = abi;
        const double fre = (nr * lr + ni * li) / den, fim = (ni * lr - nr * li) / den;
        double tr = abr, ti = abi;
#pragma unroll
        for (int q = 0; q < 6; ++q) { const double t2 = tr * tr - ti * ti; ti = 2.0 * tr * ti; tr = t2; }
        unsigned char* pb = ws + WS_S5P + (size_t)o * S5P_LAYER;
        ((float*)(pb + S5P_ABR))[gp] = (float)abr; ((float*)(pb + S5P_ABI))[gp] = (float)abi; ((float*)(pb + S5P_ATR))[gp] = (float)tr; ((float*)(pb + S5P_ATI))[gp] = (float)ti;
        const float* bre = A.in[19] + (size_t)idx * 16; const float* bim = A.in[20] + (size_t)idx * 16;
        float* obr = (float*)(pb + S5P_BBR) + (size_t)gp * 16; float* obi = (float*)(pb + S5P_BBI) + (size_t)gp * 16;
#pragma unroll
        for (int h4 = 0; h4 < 4; ++h4) { const f32x4 br = *(const f32x4*)(bre + 4 * h4), bi = *(const f32x4*)(bim + 4 * h4); f32x4 r, i;
#pragma unroll
            for (int j = 0; j < 4; ++j) { r[j] = (float)(fre * (double)br[j] - fim * (double)bi[j]); i[j] = (float)(fre * (double)bi[j] + fim * (double)br[j]); }
            *(f32x4*)(obr + 4 * h4) = r; *(f32x4*)(obi + 4 * h4) = i; }
        { const int p = gp & 63, ti = p >> 4, i16 = p & 15;
#pragma unroll
          for (int kq = 0; kq < 4; ++kq) { const f32x4 r = *(const f32x4*)(obr + 4 * kq), i = *(const f32x4*)(obi + 4 * kq);
              v2u pr, pi; pr.x = pk2(r.x, r.y); pr.y = pk2(r.z, r.w); pi.x = pk2(i.x, i.y); pi.y = pk2(i.z, i.w);
              *(v2u*)(pb + S5P_BBOP + ((size_t)((g * 8 + ti) * 64 + kq * 16 + i16)) * 8) = pr; *(v2u*)(pb + S5P_BBOP + ((size_t)((g * 8 + 4 + ti) * 64 + kq * 16 + i16)) * 8) = pi; } }
    }
    }
    if (gw < 2) { const int e = gw;
        const float s1 = wave_sum(A.in[10][e * 128 + lane] * A.in[11][e * 128 + lane] + A.in[10][e * 128 + 64 + lane] * A.in[11][e * 128 + 64 + lane]);
        const float s2 = wave_sum(A.in[12][e * 128 + lane] * A.in[13][e * 128 + lane] + A.in[12][e * 128 + 64 + lane] * A.in[13][e * 128 + 64 + lane]);
        const float lam_init = e == 0 ? 0.2f : 0.4707130183435842f;
        if (lane == 0) ((float*)(ws + WS_LAM))[e] = expf(s1) - expf(s2) + lam_init; }
    LAS float* scr = (LAS float*)(lds + wave * 16384);
    constexpr int I_IN = 64 * 384, I_OUT = 64 * 128, I_GLU = 64 * 128, I_GU = 64 * 344, I_DN = 172 * 128;
    constexpr int NITEMS = 2 * I_IN + 2 * I_OUT + 4 * I_GLU + 8 * I_GU + 4 * I_DN;
    for (int it = gw; it < NITEMS; it += NGW) {
        int r = it;
        if (r < 2 * I_IN) { const int e = r / I_IN; transpose_item(A.in[8] + (size_t)e * DM * 12288, DM, 12288, (bf16*)(ws + WS_WIN + e * W_IN_B), LDD, 0, scr, r - e * I_IN, lane); continue; } r -= 2 * I_IN;
        if (r < 2 * I_OUT) { const int e = r / I_OUT; transpose_item(A.in[15] + (size_t)e * DM * DM, DM, DM, (bf16*)(ws + WS_WOUT + e * W_OUT_B), LDD, 0, scr, r - e * I_OUT, lane); continue; } r -= 2 * I_OUT;
        if (r < 4 * I_GLU) { const int q = r / I_GLU, o = q >> 1, s = q & 1; transpose_item(A.in[24 + s] + (size_t)o * DM * DM, DM, DM, (bf16*)(ws + WS_WGLU + o * W_GLU_B), LDD, 1 + s, scr, r - q * I_GLU, lane); continue; } r -= 4 * I_GLU;
        if (r < 8 * I_GU) { const int q = r / I_GU, l = q >> 1, s = q & 1; transpose_item(A.in[26 + s] + (size_t)l * DM * FFH, DM, FFH, (bf16*)(ws + WS_WGU + l * W_GU_B), LDD, 1 + s, scr, r - q * I_GU, lane); continue; } r -= 8 * I_GU;
        { const int l = r / I_DN; transpose_item(A.in[28] + (size_t)l * FFH * DM, FFH, DM, (bf16*)(ws + WS_WDN + l * W_DN_B), LDF, 0, scr, r - l * I_DN, lane); }
    }
}
__device__ __forceinline__ void p1_modvec(const Args& A, int gtid, int NGT) {
    const float* mp = (const float*)(A.ws + WS_MODP); float* ml = (float*)(A.ws + WS_MODL);
    for (int i = gtid; i < DEPTH * NMODV; i += NGT) { const int j = i % NMODV; float v = A.in[3][j] + A.in[4][i];
#pragma unroll
        for (int ks = 0; ks < KSL; ++ks) v += mp[(size_t)ks * NMODV + j];
        ml[i] = v; }
}
__device__ __forceinline__ void norm_mod_phase(const float* src, const float* nw, const float* sh, const float* sc, bf16* dst, LAS unsigned char* lds, int tid, int gw, int NGW, int lane) {
    LAS float* w1 = (LAS float*)lds; LAS float* bb = w1 + DM;
    for (int i = tid; i < DM; i += NTHR) { w1[i] = nw[i] * (1.0f + sc[i]); bb[i] = sh[i]; }
    __syncthreads();
    for (int m = gw; m < SEQ; m += NGW) {
        const f32x4* xr = (const f32x4*)(src + (size_t)m * DM) + lane;
        f32x4 v[16]; float ss = 0.f;
#pragma unroll
        for (int j = 0; j < 16; ++j) { v[j] = xr[64 * j]; ss += (v[j].x * v[j].x + v[j].y * v[j].y) + (v[j].z * v[j].z + v[j].w * v[j].w); }
        const float rstd = 1.0f / sqrtf(wave_sum(ss) * (1.0f / DM) + NORM_EPS);
        v2u* o8 = (v2u*)(dst + (size_t)m * LDD) + lane;
#pragma unroll
        for (int j = 0; j < 16; ++j) { const int col = j * 256 + lane * 4; const f32x4 w = *(const LAS f32x4*)(w1 + col), b = *(const LAS f32x4*)(bb + col);
            const f32x4 y = v[j] * rstd * w + b; v2u p; p.x = pk2(y.x, y.y); p.y = pk2(y.z, y.w); o8[64 * j] = p; }
    }
    __syncthreads();
}
__device__ __forceinline__ void final_norm_phase(const float* src, const float* nw, float* dst, int gw, int NGW, int lane) {
    for (int m = gw; m < SEQ; m += NGW) {
        const f32x4* xr = (const f32x4*)(src + (size_t)m * DM) + lane;
        f32x4 v[16]; float ss = 0.f;
#pragma unroll
        for (int j = 0; j < 16; ++j) { v[j] = xr[64 * j]; ss += (v[j].x * v[j].x + v[j].y * v[j].y) + (v[j].z * v[j].z + v[j].w * v[j].w); }
        const float rstd = 1.0f / sqrtf(wave_sum(ss) * (1.0f / DM) + NORM_EPS);
        f32x4* o = (f32x4*)(dst + (size_t)m * DM) + lane; const f32x4* wv = (const f32x4*)nw + lane;
#pragma unroll
        for (int j = 0; j < 16; ++j) o[64 * j] = v[j] * rstd * wv[64 * j];
    }
}
__device__ __forceinline__ void conv_phase(const bf16* Z, const float* cw, bf16* MIX, int gtid, int NGT) {
    for (int i = gtid; i < SEQ * 256; i += NGT) {
        const int t = i >> 8, r = i & 255, gi = r >> 4, c8 = (r & 15) * 8;
        const size_t o = (size_t)t * 128 + c8;
        const v4u zero = {0u, 0u, 0u, 0u};
        const v4u vb = *(const v4u*)(Z + (size_t)gi * GS + o);
        const bf16* zc = Z + (size_t)(16 + gi) * GS + o; const bf16* zx = Z + (size_t)(32 + gi) * GS + o;
        const v4u c0 = *(const v4u*)zc, x0 = *(const v4u*)zx;
        const v4u c1 = t >= 1 ? *(const v4u*)(zc - 128) : zero, x1 = t >= 1 ? *(const v4u*)(zx - 128) : zero;
        const v4u c2 = t >= 2 ? *(const v4u*)(zc - 256) : zero, x2 = t >= 2 ? *(const v4u*)(zx - 256) : zero;
        const float* wp = cw + gi * 128 + c8;
        float y[8];
#pragma unroll
        for (int q = 0; q < 4; ++q) {
            const float u0l = bflo(c0[q]) * bflo(x0[q]), u0h = bfhi(c0[q]) * bfhi(x0[q]);
            const float u1l = bflo(c1[q]) * bflo(x1[q]), u1h = bfhi(c1[q]) * bfhi(x1[q]);
            const float u2l = bflo(c2[q]) * bflo(x2[q]), u2h = bfhi(c2[q]) * bfhi(x2[q]);
            const int j = 2 * q;
            y[j]     = bflo(vb[q]) * (wp[2 * 2048 + j] * u0l + wp[2048 + j] * u1l + wp[j] * u2l);
            y[j + 1] = bfhi(vb[q]) * (wp[2 * 2048 + j + 1] * u0h + wp[2048 + j + 1] * u1h + wp[j + 1] * u2h);
        }
        v4u w; w.x = pk2(y[0], y[1]); w.y = pk2(y[2], y[3]); w.z = pk2(y[4], y[5]); w.w = pk2(y[6], y[7]);
        *(v4u*)(MIX + (size_t)t * LDD + gi * 128 + c8) = w;
    }
}
__device__ __forceinline__ void combine_phase(const float* OT, const float* lamp, const float* sg, float lam_init, bf16* MIX, int gw, int NGW, int lane) {
    const float lam = lamp[0], os = 1.0f - lam_init;
    const int j = lane >> 5, c4 = (lane & 31) * 4;
    const f32x4 gv = *(const f32x4*)(sg + 128 * j + c4);
    for (int it0 = gw * 4; it0 < SEQ * 8; it0 += NGW * 4) {
        f32x4 a[4], b[4];
#pragma unroll
        for (int q = 0; q < 4; ++q) { const int it = it0 + q, t = it >> 3, h = it & 7;
            a[q] = *(const f32x4*)(OT + (size_t)(h * 4 + j) * GS + (size_t)t * 128 + c4); b[q] = *(const f32x4*)(OT + (size_t)(h * 4 + 2 + j) * GS + (size_t)t * 128 + c4); }
#pragma unroll
        for (int q = 0; q < 4; ++q) { const int it = it0 + q, t = it >> 3, h = it & 7;
            const f32x4 o = a[q] - lam * b[q];
            const float rstd = 1.0f / sqrtf(wave_sum((o.x * o.x + o.y * o.y) + (o.z * o.z + o.w * o.w)) * (1.0f / 256.0f) + SUBLN_EPS);
            const f32x4 y = o * (rstd * os) * gv;
            v2u p; p.x = pk2(y.x, y.y); p.y = pk2(y.z, y.w);
            *(v2u*)(MIX + (size_t)t * LDD + 2048 + 256 * h + 128 * j + c4) = p; }
    }
}
__device__ __forceinline__ att::BlockRef<att::bf16, float> att_ref(const bf16* Z, float* OT, int item, int pass) {
    const int r = item >> 8, b = item & 255, vh = r * 8 + (b & 7), pair = b >> 3, qb = pass ? 63 - pair : pair;
    const int h = vh >> 2, m = (vh >> 1) & 1, j = vh & 1;
    att::BlockRef<att::bf16, float> R;
    R.Q = (const att::bf16*)(Z + (size_t)(48 + 2 * h + m) * GS + (size_t)qb * 256 * 128);
    R.K = (const att::bf16*)(Z + (size_t)(64 + 2 * h + m) * GS);
    R.V = (const att::bf16*)(Z + (size_t)(80 + 2 * h + j) * GS);
    R.O = OT + (size_t)vh * GS + (size_t)qb * 256 * 128; R.P0 = qb * 256;
    return R;
}
__device__ __forceinline__ void attn_phase(const bf16* Z, float* OT, char* lds, int bid, int G) {
    constexpr int TOTAL = 1024;
    int item = bid; if (item >= TOTAL) return;
    int pass = 0;
    att::BlockRef<att::bf16, float> cur = att_ref(Z, OT, item, 0);
    att::Seam<att::bf16> S;
    att::causal_swa_prime<att::bf16, float>(cur, SEQ, lds, S);
    for (;;) {
        const bool more_pass = pass == 0, more_item = item + G < TOTAL, last = !more_pass && !more_item;
        int itn = item, passn = 1;
        if (!more_pass) { passn = 0; itn = more_item ? item + G : item; }
        const att::BlockRef<att::bf16, float> nxt = last ? cur : att_ref(Z, OT, itn, passn);
        att::causal_swa_block<att::bf16, float>(cur, nxt, SEQ, SEQ, lds, S);
        if (last) break;
        cur = nxt; item = itn; pass = passn;
    }
}
#ifndef ATT2
#define ATT2 1
#endif
template <bool DEG>
__device__ __forceinline__ void attn2_phase(const bf16* Z, float* OT, char* lds, int bid, int G) {
    for (int item = bid; item < 1024; item += G) {
        const int r = item >> 8, b = item & 255, hm = 2 * (b & 7) + (r >> 1), pair = (r & 1) * 32 + (b >> 3), h = hm >> 1, m = hm & 1;
        for (int pass = 0; pass < 2; ++pass) { const int qb = pass ? 127 - pair : pair;
            att2::block<DEG>(Z + (size_t)(48 + 2 * h + m) * GS + (size_t)qb * 128 * 128, Z + (size_t)(64 + 2 * h + m) * GS, Z + (size_t)(80 + 2 * h) * GS, Z + (size_t)(81 + 2 * h) * GS,
                        OT + (size_t)(h * 4 + m * 2) * GS + (size_t)qb * 128 * 128, OT + (size_t)(h * 4 + m * 2 + 1) * GS + (size_t)qb * 128 * 128, qb * 128, lds); }
    }
}
__device__ __forceinline__ float gelu_tanh(float x) { const float z = 1.5957691216057308f * (x + 0.044715f * x * x * x); return x * __builtin_amdgcn_rcpf(1.0f + __builtin_amdgcn_exp2f(-1.4426950408889634f * z)); }
template <bool PASS2>
__device__ __forceinline__ void s5_pass(const bf16* Hin, const unsigned char* prm, const float* c_re, const float* c_im, const float* dsk, float* F, const float* HC, bf16* Gout,
                                        LAS unsigned char* lds, int gw, int NGW, int wave, int lane) {
    LAS float* lu = (LAS float*)(lds + wave * 4096);
    for (int item = gw; item < 256 * S5NC; item += NGW) {
        const int g = item & 255, c = item >> 8, gp = g * 64 + lane;
        { const bf16* up = Hin + (size_t)(c * S5T + lane) * LDD + 16 * g; const v4u a = *(const v4u*)up, b = *(const v4u*)(up + 8);
          LAS f32x4* ur = (LAS f32x4*)(lu + lane * 16);
          ur[0] = (f32x4){bflo(a.x), bfhi(a.x), bflo(a.y), bfhi(a.y)}; ur[1] = (f32x4){bflo(a.z), bfhi(a.z), bflo(a.w), bfhi(a.w)};
          ur[2] = (f32x4){bflo(b.x), bfhi(b.x), bflo(b.y), bfhi(b.y)}; ur[3] = (f32x4){bflo(b.z), bfhi(b.z), bflo(b.w), bfhi(b.w)}; }
        f32x4 bbr[4], bbi[4];
#pragma unroll
        for (int q = 0; q < 4; ++q) { bbr[q] = *(const f32x4*)((const float*)(prm + S5P_BBR) + (size_t)gp * 16 + 4 * q); bbi[q] = *(const f32x4*)((const float*)(prm + S5P_BBI) + (size_t)gp * 16 + 4 * q); }
        const float abr = ((const float*)(prm + S5P_ABR))[gp], abi = ((const float*)(prm + S5P_ABI))[gp];
        float hr = 0.f, hi = 0.f, cr[16], ci[16], dk = 0.f;
        if (PASS2) {
#pragma unroll
            for (int o = 0; o < 16; ++o) { cr[o] = c_re[(size_t)(g * 16 + o) * 64 + lane]; ci[o] = c_im[(size_t)(g * 16 + o) * 64 + lane]; }
            hr = HC[(size_t)(c * 256 + g) * 128 + lane]; hi = HC[(size_t)(c * 256 + g) * 128 + 64 + lane]; dk = dsk[16 * g + (lane >> 2)];
        }
        LDS_WAIT(); asm volatile("" ::: "memory");
#pragma unroll 2
        for (int t = 0; t < S5T; ++t) {
            const LAS f32x4* ut = (const LAS f32x4*)(lu + t * 16);
            float bur = 0.f, bui = 0.f;
#pragma unroll
            for (int q = 0; q < 4; ++q) { const f32x4 u = ut[q];
                bur += (bbr[q].x * u.x + bbr[q].y * u.y) + (bbr[q].z * u.z + bbr[q].w * u.w); bui += (bbi[q].x * u.x + bbi[q].y * u.y) + (bbi[q].z * u.z + bbi[q].w * u.w); }
            const float nr = abr * hr - abi * hi + bur, ni = abr * hi + abi * hr + bui; hr = nr; hi = ni;
            if (PASS2) {
                float v[16];
#pragma unroll
                for (int o = 0; o < 16; ++o) v[o] = hr * cr[o] - hi * ci[o];
#pragma unroll
                for (int i = 0; i < 8; ++i) { const float send = (lane & 32) ? v[i] : v[i + 8], keep = (lane & 32) ? v[i + 8] : v[i]; v[i] = keep + __shfl_xor(send, 32); }
#pragma unroll
                for (int i = 0; i < 4; ++i) { const float send = (lane & 16) ? v[i] : v[i + 4], keep = (lane & 16) ? v[i + 4] : v[i]; v[i] = keep + __shfl_xor(send, 16); }
#pragma unroll
                for (int i = 0; i < 2; ++i) { const float send = (lane & 8) ? v[i] : v[i + 2], keep = (lane & 8) ? v[i + 2] : v[i]; v[i] = keep + __shfl_xor(send, 8); }
                { const float send = (lane & 4) ? v[0] : v[1], keep = (lane & 4) ? v[1] : v[0]; v[0] = keep + __shfl_xor(send, 4); }
                v[0] += __shfl_xor(v[0], 2); v[0] += __shfl_xor(v[0], 1);
                const float yy = v[0] + dk * lu[t * 16 + (lane >> 2)];
                const float gl = gelu_tanh(yy);
                if ((lane & 3) == 0) Gout[(size_t)(c * S5T + t) * LDD + 16 * g + (lane >> 2)] = (bf16)(pk2(gl, gl) & 0xffffu);
            }
        }
        if (!PASS2) { F[(size_t)(c * 256 + g) * 128 + lane] = hr; F[(size_t)(c * 256 + g) * 128 + 64 + lane] = hi; }
        LDS_WAIT(); asm volatile("" ::: "memory");
    }
}

constexpr int S5TS = 8, S5SB = S5TS * 256 + 16;
typedef short s5_bf16x8 __attribute__((ext_vector_type(8)));
template <bool PASS2>
__device__ __forceinline__ void s5m_pass(const bf16* Hin, const unsigned char* prm, const float* dsk, float* F, const float* HC, bf16* Gout, LAS unsigned char* lds, int bid, int G) {
    const int tid = opaque_tid(), lane = tid & 63, w = __builtin_amdgcn_readfirstlane(tid >> 6), j = lane & 15, rq = lane >> 4;
    const int rowslot = tid >> 4, piece = tid & 15;
    constexpr int NST = S5T / S5TS, NQ = 16 * S5TS / 32;
    for (int unit = bid; unit < 32 * (S5NC / 16); unit += G) {
        const int gb = unit & 31, cs = unit >> 5, g = gb * 8 + w;
        v2u bb[8];
#pragma unroll
        for (int t8 = 0; t8 < 8; ++t8) bb[t8] = *(const v2u*)(prm + S5P_BBOP + ((size_t)((g * 8 + t8) * 64 + lane)) * 8);
        v4u cop[4];
        f32x4 ar[4], ai[4], sr[4], si[4], dk = {0.f, 0.f, 0.f, 0.f};
#pragma unroll
        for (int q = 0; q < 4; ++q) { ar[q] = *(const f32x4*)((const float*)(prm + S5P_ABR) + g * 64 + 16 * q + 4 * rq); ai[q] = *(const f32x4*)((const float*)(prm + S5P_ABI) + g * 64 + 16 * q + 4 * rq); }
        if (PASS2) {
#pragma unroll
            for (int mm = 0; mm < 4; ++mm) cop[mm] = *(const v4u*)(prm + S5P_COP + ((size_t)((g * 4 + mm) * 64 + lane)) * 16);
            const float* hc = HC + ((size_t)(cs * 16 + j) * 256 + g) * 128 + 4 * rq;
#pragma unroll
            for (int q = 0; q < 4; ++q) { sr[q] = *(const f32x4*)(hc + 16 * q); si[q] = *(const f32x4*)(hc + 64 + 16 * q); }
            dk = *(const f32x4*)(dsk + 16 * g + 4 * rq);
        } else {
#pragma unroll
            for (int q = 0; q < 4; ++q) { sr[q] = (f32x4){0.f, 0.f, 0.f, 0.f}; si[q] = (f32x4){0.f, 0.f, 0.f, 0.f}; }
        }
        const bf16* src = Hin + (size_t)(cs * 16 * S5T) * LDD + gb * 128 + piece * 8;
        bf16* dstp = PASS2 ? Gout + (size_t)(cs * 16 * S5T) * LDD + gb * 128 + piece * 8 : nullptr;
        v4u pre[NQ];
#pragma unroll
        for (int q = 0; q < NQ; ++q) { const int ri = q * 32 + rowslot, jj = ri / S5TS, tt = ri % S5TS; pre[q] = *(const v4u*)(src + (size_t)(jj * S5T + tt) * LDD); }
        for (int s = 0; s < NST; ++s) {
#pragma unroll
            for (int q = 0; q < NQ; ++q) { const int ri = q * 32 + rowslot, jj = ri / S5TS, tt = ri % S5TS; LAS v4u* lp = (LAS v4u*)(lds + jj * S5SB + tt * 256 + piece * 16);
                if (PASS2 && s > 0) { const v4u y = *lp; *(v4u*)(dstp + (size_t)(jj * S5T + (s - 1) * S5TS + tt) * LDD) = y; }
                *lp = pre[q]; }
            if (s + 1 < NST) {
#pragma unroll
                for (int q = 0; q < NQ; ++q) { const int ri = q * 32 + rowslot, jj = ri / S5TS, tt = ri % S5TS; pre[q] = *(const v4u*)(src + (size_t)(jj * S5T + (s + 1) * S5TS + tt) * LDD); } }
            LDS_WAIT(); __syncthreads();
            LAS unsigned char* up = lds + j * S5SB + w * 32 + rq * 8;
            v2u uu[S5TS];
#pragma unroll
            for (int tt = 0; tt < S5TS; ++tt) uu[tt] = *(const LAS v2u*)(up + tt * 256);
#pragma unroll
            for (int tt = 0; tt < S5TS; ++tt) {
                v4u ub; ub.x = uu[tt].x; ub.y = uu[tt].y; ub.z = 0u; ub.w = 0u;
                const s5_bf16x8 U = __builtin_bit_cast(s5_bf16x8, ub);
#pragma unroll
                for (int q = 0; q < 4; ++q) {
                    const f32x4 tr = ar[q] * sr[q] - ai[q] * si[q], ti = ar[q] * si[q] + ai[q] * sr[q];
                    v4u a0; a0.x = bb[q].x; a0.y = bb[q].y; a0.z = 0u; a0.w = 0u; v4u a1; a1.x = bb[4 + q].x; a1.y = bb[4 + q].y; a1.z = 0u; a1.w = 0u;
                    sr[q] = __builtin_amdgcn_mfma_f32_16x16x32_bf16(__builtin_bit_cast(s5_bf16x8, a0), U, tr, 0, 0, 0);
                    si[q] = __builtin_amdgcn_mfma_f32_16x16x32_bf16(__builtin_bit_cast(s5_bf16x8, a1), U, ti, 0, 0, 0);
                }
                if (PASS2) {
                    f32x4 y = {0.f, 0.f, 0.f, 0.f};
#pragma unroll
                    for (int mm = 0; mm < 4; ++mm) { const f32x4 t0 = mm < 2 ? sr[2 * mm] : si[2 * mm - 4], t1 = mm < 2 ? sr[2 * mm + 1] : si[2 * mm - 3];
                        v4u sb; sb.x = pk2(t0.x, t0.y); sb.y = pk2(t0.z, t0.w); sb.z = pk2(t1.x, t1.y); sb.w = pk2(t1.z, t1.w);
                        y = __builtin_amdgcn_mfma_f32_16x16x32_bf16(__builtin_bit_cast(s5_bf16x8, cop[mm]), __builtin_bit_cast(s5_bf16x8, sb), y, 0, 0, 0); }
                    const f32x4 uf = {bflo(uu[tt].x), bfhi(uu[tt].x), bflo(uu[tt].y), bfhi(uu[tt].y)};
                    const f32x4 yy = y + dk * uf;
                    v2u o; o.x = pk2(gelu_tanh(yy.x), gelu_tanh(yy.y)); o.y = pk2(gelu_tanh(yy.z), gelu_tanh(yy.w));
                    *(LAS v2u*)(up + tt * 256) = o;
                }
            }
            LDS_WAIT(); __syncthreads();
        }
        if (PASS2) {
#pragma unroll
            for (int q = 0; q < NQ; ++q) { const int ri = q * 32 + rowslot, jj = ri / S5TS, tt = ri % S5TS; const v4u y = *(const LAS v4u*)(lds + jj * S5SB + tt * 256 + piece * 16);
                *(v4u*)(dstp + (size_t)(jj * S5T + (NST - 1) * S5TS + tt) * LDD) = y; }
            LDS_WAIT();
        } else {
            float* fo = F + ((size_t)(cs * 16 + j) * 256 + g) * 128 + 4 * rq;
#pragma unroll
            for (int q = 0; q < 4; ++q) { *(f32x4*)(fo + 16 * q) = sr[q]; *(f32x4*)(fo + 64 + 16 * q) = si[q]; }
        }
    }
}
__device__ __forceinline__ void s5_carry(const unsigned char* prm, const float* F, float* HC, int bid, int G, int wave, int lane) {
    if (wave != 0) return;
    for (int g = bid; g < 256; g += G) {
        const int p = lane, gp = g * 64 + p;
        const float atr = ((const float*)(prm + S5P_ATR))[gp], ati = ((const float*)(prm + S5P_ATI))[gp];
        float hr = 0.f, hi = 0.f;
        for (int c0 = 0; c0 < S5NC; c0 += 32) {
            float fr[32], fi[32];
#pragma unroll
            for (int q = 0; q < 32; ++q) { const size_t o = (size_t)((c0 + q) * 256 + g) * 128 + p; fr[q] = F[o]; fi[q] = F[o + 64]; }
#pragma unroll
            for (int q = 0; q < 32; ++q) { const size_t o = (size_t)((c0 + q) * 256 + g) * 128 + p;
                HC[o] = hr; HC[o + 64] = hi;
                const float nr = atr * hr - ati * hi + fr[q], ni = atr * hi + ati * hr + fi[q]; hr = nr; hi = ni; }
        }
    }
}

struct Ctx { int lo, hi, tid, lane, wave, gw, NGW, gtid, NGT, G, bid; };
#ifndef DUP_ATTN
#define DUP_ATTN 0
#endif
#ifndef DUP_S5
#define DUP_S5 0
#endif
#ifndef DUP_FFN1
#define DUP_FFN1 0
#endif
#ifndef DUP_FFN2
#define DUP_FFN2 0
#endif
#ifndef DUP_INP
#define DUP_INP 0
#endif
#ifndef DUP_PRO
#define DUP_PRO 0
#endif
#define IN(k) (lo <= (k) && (k) < hi)
#define SEAM(k) do { if (IN(k) && IN((k) + 1)) xcd_barrier(bar); } while (0)
#define FFN_PHASES(l, pb) do { \
    const float* ml_ = MODL + (size_t)(l) * NMODV; \
    if (IN((pb) + 5)) norm_mod_phase(XR, args.in[6] + (size_t)(l) * DM, ml_ + 3 * DM, ml_ + 4 * DM, Hb, lds, tid, gw, NGW, lane); \
    SEAM((pb) + 5); \
    if (IN((pb) + 6)) { pg8::Gemm g{Hb, (const bf16*)(ws + WS_WGU + (size_t)(l) * W_GU_B), SEQ, 2 * FFH, DM, LDD, LDD}; pg8::StaticOrder S; S.init(SEQ, 2 * FFH, G, bid); \
        pg8::EpiSwiGLU E{HID, LDF}; pg8::gemm_phase<pg8::EpiSwiGLU, pg8::StaticOrder, true, true>(lds, g, S, E); } \
    if (DUP_FFN1 && IN((pb) + 6)) { xcd_barrier(bar); pg8::Gemm g{Hb, (const bf16*)(ws + WS_WGU + (size_t)(l) * W_GU_B), SEQ, 2 * FFH, DM, LDD, LDD}; pg8::StaticOrder S; S.init(SEQ, 2 * FFH, G, bid); \
        pg8::EpiSwiGLU E{HID, LDF}; pg8::gemm_phase<pg8::EpiSwiGLU, pg8::StaticOrder, true, true>(lds, g, S, E); } \
    SEAM((pb) + 6); \
    if (DUP_FFN2 && IN((pb) + 7)) { xcd_barrier(bar); pg8::Gemm g{HID, (const bf16*)(ws + WS_WDN + (size_t)(l) * W_DN_B), SEQ, DM, FFH, LDF, LDF}; pg8::StaticOrder S; S.init(SEQ, DM, G, bid); \
        pg8::EpiResid E{XR, (float*)(ws + WS_OT), ml_ + 5 * DM, DM}; pg8::gemm_phase<pg8::EpiResid, pg8::StaticOrder, true, true>(lds, g, S, E); } \
    if (IN((pb) + 7)) { pg8::Gemm g{HID, (const bf16*)(ws + WS_WDN + (size_t)(l) * W_DN_B), SEQ, DM, FFH, LDF, LDF}; pg8::StaticOrder S; S.init(SEQ, DM, G, bid); \
        pg8::EpiResid E{XR, XR, ml_ + 5 * DM, DM}; pg8::gemm_phase<pg8::EpiResid, pg8::StaticOrder, true, true>(lds, g, S, E); } \
    SEAM((pb) + 7); } while (0)
template <int lp>
__device__ __forceinline__ void layer_pair(const Args& args, const Ctx& C, LAS unsigned char* lds, unsigned char* lds_raw, const XcdBarrier& bar) {
    const int lo = C.lo, hi = C.hi, tid = C.tid, lane = C.lane, wave = C.wave, gw = C.gw, NGW = C.NGW, gtid = C.gtid, NGT = C.NGT, G = C.G, bid = C.bid;
    unsigned char* ws = args.ws;
    bf16* const Hb = (bf16*)(ws + WS_H); bf16* const MIX = (bf16*)(ws + WS_MIX); bf16* const Z = (bf16*)(ws + WS_Z); bf16* const HID = (bf16*)(ws + WS_Z);
    float* const OT = (float*)(ws + WS_OT); float* const XR = args.out;
    const float* const MODL = (const float*)(ws + WS_MODL);
        { const int l = 2 * lp, pb = 2 + 8 * l; const float* ml = MODL + (size_t)l * NMODV;
          const float* xin = (l == 0) ? args.in[0] : XR;
          if (IN(pb)) norm_mod_phase(xin, args.in[5] + (size_t)l * DM, ml, ml + DM, Hb, lds, tid, gw, NGW, lane);
          SEAM(pb);
          if (IN(pb + 1)) { pg8::Gemm g{Hb, (const bf16*)(ws + WS_WIN + (size_t)lp * W_IN_B), SEQ, 12288, DM, LDD, LDD}; pg8::StaticOrder S; S.init(SEQ, 12288, G, bid);
              pg8::EpiHeadMajor E{Z, GS}; pg8::gemm_phase<pg8::EpiHeadMajor, pg8::StaticOrder, true, true>(lds, g, S, E); }
          if (DUP_INP && IN(pb + 1)) { xcd_barrier(bar); pg8::Gemm g{Hb, (const bf16*)(ws + WS_WIN + (size_t)lp * W_IN_B), SEQ, 12288, DM, LDD, LDD}; pg8::StaticOrder S; S.init(SEQ, 12288, G, bid);
              pg8::EpiHeadMajor E{Z, GS}; pg8::gemm_phase<pg8::EpiHeadMajor, pg8::StaticOrder, true, true>(lds, g, S, E); }
          SEAM(pb + 1);
          if (IN(pb + 2)) { conv_phase(Z, args.in[9] + (size_t)lp * 3 * 2048, MIX, gtid, NGT); if (ATT2) attn2_phase<false>(Z, OT, (char*)lds_raw, bid, G); else attn_phase(Z, OT, (char*)lds_raw, bid, G); if (DUP_ATTN == 1) { xcd_barrier(bar); attn2_phase<false>(Z, (float*)(ws + WS_END), (char*)lds_raw, bid, G); } if (DUP_ATTN == 2) { xcd_barrier(bar); attn2_phase<true>(Z, (float*)(ws + WS_END), (char*)lds_raw, bid, G); } }
          SEAM(pb + 2);
          if (IN(pb + 3)) combine_phase(OT, (const float*)(ws + WS_LAM) + lp, args.in[14] + lp * 256, lp == 0 ? 0.2f : 0.4707130183435842f, MIX, gw, NGW, lane);
          SEAM(pb + 3);
          if (IN(pb + 4)) { pg8::Gemm g{MIX, (const bf16*)(ws + WS_WOUT + (size_t)lp * W_OUT_B), SEQ, DM, DM, LDD, LDD}; pg8::StaticOrder S; S.init(SEQ, DM, G, bid);
              pg8::EpiResid E{xin, XR, ml + 2 * DM, DM}; pg8::gemm_phase<pg8::EpiResid, pg8::StaticOrder, true, true>(lds, g, S, E); }
          SEAM(pb + 4);
          FFN_PHASES(l, pb);
        }
        { const int l = 2 * lp + 1, pb = 2 + 8 * l; const float* ml = MODL + (size_t)l * NMODV;
          const unsigned char* prm = ws + WS_S5P + (size_t)lp * S5P_LAYER;
          float* const S5F = (float*)(ws + WS_S5F); float* const S5H = (float*)(ws + WS_S5H);
          if (IN(pb)) norm_mod_phase(XR, args.in[5] + (size_t)l * DM, ml, ml + DM, Hb, lds, tid, gw, NGW, lane);
          SEAM(pb);
          if (IN(pb + 1)) { if (S5_MFMA) s5m_pass<false>(Hb, prm, nullptr, S5F, nullptr, nullptr, lds, bid, G); else s5_pass<false>(Hb, prm, nullptr, nullptr, nullptr, S5F, nullptr, nullptr, lds, gw, NGW, wave, lane); }
          SEAM(pb + 1);
          if (IN(pb + 2)) s5_carry(prm, S5F, S5H, bid, G, wave, lane);
          SEAM(pb + 2);
          if (IN(pb + 3)) { if (S5_MFMA) s5m_pass<true>(Hb, prm, args.in[23] + (size_t)lp * DM, nullptr, S5H, MIX, lds, bid, G); else s5_pass<true>(Hb, prm, args.in[21] + (size_t)lp * 256 * 16 * 64, args.in[22] + (size_t)lp * 256 * 16 * 64, args.in[23] + (size_t)lp * DM, nullptr, S5H, MIX, lds, gw, NGW, wave, lane); }
          if (DUP_S5) { xcd_barrier(bar);
          if (IN(pb + 1)) { if (S5_MFMA) s5m_pass<false>(Hb, prm, nullptr, S5F, nullptr, nullptr, lds, bid, G); else s5_pass<false>(Hb, prm, nullptr, nullptr, nullptr, S5F, nullptr, nullptr, lds, gw, NGW, wave, lane); }
          SEAM(pb + 1);
          if (IN(pb + 2)) s5_carry(prm, S5F, S5H, bid, G, wave, lane);
          SEAM(pb + 2);
          if (IN(pb + 3)) { if (S5_MFMA) s5m_pass<true>(Hb, prm, args.in[23] + (size_t)lp * DM, nullptr, S5H, MIX, lds, bid, G); else s5_pass<true>(Hb, prm, args.in[21] + (size_t)lp * 256 * 16 * 64, args.in[22] + (size_t)lp * 256 * 16 * 64, args.in[23] + (size_t)lp * DM, nullptr, S5H, MIX, lds, gw, NGW, wave, lane); }
          }
          SEAM(pb + 3);
          if (IN(pb + 4)) { pg8::Gemm g{MIX, (const bf16*)(ws + WS_WGLU + (size_t)lp * W_GLU_B), SEQ, 2 * DM, DM, LDD, LDD}; pg8::StaticOrder S; S.init(SEQ, 2 * DM, G, bid);
              pg8::EpiGluResid E{XR, XR, ml + 2 * DM, DM}; pg8::gemm_phase<pg8::EpiGluResid, pg8::StaticOrder, true, true>(lds, g, S, E); }
          SEAM(pb + 4);
          FFN_PHASES(l, pb);
        }
    }
#undef FFN_PHASES
#undef IN
#undef SEAM

__global__ void __launch_bounds__(NTHR, 2) trunk_fwd(Args args) {
    extern __shared__ __attribute__((aligned(16))) unsigned char lds_raw[];
    LAS unsigned char* lds = (LAS unsigned char*)lds_raw;
    volatile LAS unsigned* MISC = (volatile LAS unsigned*)(lds + MISC_OFF);
    const int tid = opaque_tid(), lane = tid & 63, wave = __builtin_amdgcn_readfirstlane(tid >> 6);
    const int G = gridDim.x, bid = blockIdx.x;
    const int vcu = (G % 8 == 0) ? (bid % 8) * (G / 8) + bid / 8 : bid;
    const int gw = vcu * NWAVES + wave, NGW = G * NWAVES, gtid = vcu * NTHR + tid, NGT = G * NTHR;
    unsigned char* ws = args.ws;
    const int lo = args.ph_lo, hi = args.ph_hi;
    for (int u = tid; u < (LDS_BYTES - RING_BYTES) / 4; u += NTHR) ((LAS unsigned*)(lds + RING_BYTES))[u] = 0u;
    __syncthreads();
    XcdBarrier bar; bar.bar = (unsigned*)(ws + WS_CTL) + CW_BAR; bar.x = 0; bar.st = MISC + 8;
    if (hi - lo > 1) bar = xcd_barrier_post((unsigned*)(ws + WS_CTL) + CW_BAR, MISC + 8);
    const Ctx C{lo, hi, tid, lane, wave, gw, NGW, gtid, NGT, G, bid};
#define IN(k) (lo <= (k) && (k) < hi)
#define SEAM(k) do { if (IN(k) && IN((k) + 1)) xcd_barrier(bar); } while (0)

    bf16* const Hb = (bf16*)(ws + WS_H); bf16* const MIX = (bf16*)(ws + WS_MIX); bf16* const Z = (bf16*)(ws + WS_Z); bf16* const HID = (bf16*)(ws + WS_Z);
    float* const OT = (float*)(ws + WS_OT); float* const XR = args.out;
    const float* const MODL = (const float*)(ws + WS_MODL);

    if (IN(0)) { p0_prologue(args, lds, gw, NGW, wave, lane); if (DUP_PRO) { xcd_barrier(bar); p0_prologue(args, lds, gw, NGW, wave, lane); } }
    SEAM(0);
    if (IN(1)) p1_modvec(args, gtid, NGT);
    SEAM(1);


    layer_pair<0>(args, C, lds, lds_raw, bar);
    layer_pair<1>(args, C, lds, lds_raw, bar);
    if (IN(34)) final_norm_phase(XR, args.in[7], XR, gw, NGW, lane);
#undef IN
#undef SEAM
}

extern "C" void kernel_launch(void* const* d_in, const int* in_sizes, int n_in, void* d_out, int out_size, void* d_ws, size_t ws_size, hipStream_t stream) {
    static int grid = 0;
    if (grid == 0) {
        if (n_in != 29 || in_sizes[0] != SEQ * DM || out_size != SEQ * DM || ws_size < WS_END + (DUP_ATTN ? (size_t)32 * GS * 4 : 0)) {
            fprintf(stderr, "kernel_launch: built for 29 inputs, x/out of %d floats, >= %zu bytes of workspace; got n_in %d, in0 %d, out %d, ws %zu; nothing launched\n", SEQ * DM, (size_t)WS_END, n_in, n_in > 0 ? in_sizes[0] : -1, out_size, ws_size); grid = -1; return; }
        int dev = 0, cus = 0, per_cu = 0;
        if (hipGetDevice(&dev) != hipSuccess || hipDeviceGetAttribute(&cus, hipDeviceAttributeMultiprocessorCount, dev) != hipSuccess) { fprintf(stderr, "kernel_launch: device query failed\n"); grid = -1; return; }
        if (hipFuncSetAttribute((const void*)trunk_fwd, hipFuncAttributeMaxDynamicSharedMemorySize, LDS_BYTES) != hipSuccess) { fprintf(stderr, "kernel_launch: hipFuncSetAttribute failed\n"); grid = -1; return; }
        if (hipOccupancyMaxActiveBlocksPerMultiprocessor(&per_cu, (const void*)trunk_fwd, NTHR, LDS_BYTES) != hipSuccess || per_cu < 1) { fprintf(stderr, "kernel_launch: occupancy query reports %d workgroups per CU\n", per_cu); }
        (void)hipGetLastError();
        grid = cus;
        fprintf(stderr, "kernel_launch: grid %d, occupancy %d, ws %zu (need %zu)\n", grid, per_cu, ws_size, (size_t)WS_END);
    }
    if (grid < 0) return;
    if (hipMemsetAsync((char*)d_ws + WS_CTL, 0, CTL_ZERO_BYTES, stream) != hipSuccess) { fprintf(stderr, "kernel_launch: memset failed\n"); return; }
    Args a{};
    for (int i = 0; i < 29; ++i) a.in[i] = (const float*)d_in[i];
    a.out = (float*)d_out; a.ws = (unsigned char*)d_ws;
#if MK_PER_PHASE
    for (int p = 0; p < N_PHASES; ++p) { a.ph_lo = p; a.ph_hi = p + 1; hipLaunchKernelGGL(trunk_fwd, dim3(grid), dim3(NTHR), LDS_BYTES, stream, a); }
#else
    a.ph_lo = 0; a.ph_hi = N_PHASES;
    hipLaunchKernelGGL(trunk_fwd, dim3(grid), dim3(NTHR), LDS_BYTES, stream, a);
#endif
    const hipError_t le = hipPeekAtLastError();
    if (le != hipSuccess) fprintf(stderr, "kernel_launch: launch failed: %s\n", hipGetErrorName(le));
}
```

```cpp
#include <hip/hip_runtime.h>
#include <hip/hip_bf16.h>
#include <cstdio>
#include <cstdint>
__device__ __forceinline__ int opaque_tid() { int t; asm volatile("v_mov_b32 %0, %1" : "=v"(t) : "v"((int)threadIdx.x)); return t; }
namespace pg8 {
#define PG8_LAS __attribute__((address_space(3)))
typedef unsigned short bf16_t;
typedef short bf16x8 __attribute__((ext_vector_type(8)));
typedef float f32x4 __attribute__((ext_vector_type(4)));
typedef unsigned u32x4 __attribute__((ext_vector_type(4)));
constexpr int BM = 256, BK = 64, HALF = 128, HTB = HALF * BK * 2  , STAGE_BYTES = 8 * HTB, NXCD = 8, WGM = 8;

__host__ __device__ __forceinline__ int lds_byte(int r, int c) { const int st = (r >> 4) * 2 + (c >> 5), rr = r & 15, cc = c & 31, ob = rr * 64 + cc * 2; return st * 1024 + (ob ^ (((ob >> 9) & 1) << 5)); }
__host__ __device__ __forceinline__ void stage_rc(int b, int& R, int& C) { const int st = b / 1024, sb = b % 1024, swz = sb ^ (((sb >> 9) & 1) << 5); R = (st >> 1) * 16 + swz / 64; C = (st & 1) * 32 + (swz % 64) / 2; }
__host__ __device__ __forceinline__ int perm32(int rho) { const int n = rho >> 4, i = rho & 15; return 8 * (i >> 2) + 4 * n + (i & 3); }

struct Unit { int pm, pn; };
struct Gemm { const bf16_t* A; const bf16_t* Bt; int M, N, K, lda, ldb; };

struct StaticOrder {
    int nM, nN, nwg, G, c, wgm;
    __host__ __device__ void init(int M, int N, int G_, int c_, int wgm_ = WGM) { nM = M / BM; nN = N / BM; nwg = nM * nN; G = G_; c = c_; wgm = wgm_; }
    __host__ __device__ bool next(int i, Unit& u) const {
        const long L = (long)i * G + c; if (L >= nwg) return false;
        int wgid = (int)L; { const int q = nwg / NXCD, r = nwg % NXCD, xcd = wgid % NXCD, off = wgid / NXCD; wgid = (xcd < r ? xcd * (q + 1) : r * (q + 1) + (xcd - r) * q) + off; }
        const int nig = wgm * nN, gid = wgid / nig, fm = gid * wgm, gsz = (nM - fm) < wgm ? (nM - fm) : wgm;
        u.pm = fm + ((wgid % nig) % gsz); u.pn = (wgid % nig) / gsz; return true;
    }
    __device__ __forceinline__ void a_ready(const Unit&) const {}
    __device__ __forceinline__ void done(const Unit&) const {}
};

__device__ __forceinline__ unsigned cvt_pk_bf16(float lo, float hi) { unsigned r; asm volatile("v_cvt_pk_bf16_f32 %0, %1, %2" : "=v"(r) : "v"(lo), "v"(hi)); return r; }
__device__ __forceinline__ float fast_sigmoid(float x) { return __builtin_amdgcn_rcpf(1.0f + __builtin_amdgcn_exp2f(-1.4426950408889634f * x)); }

struct EpiHeadMajor {
    static constexpr bool PERM = true, AFTER_DRAIN = false;
    bf16_t* O; size_t gstride;
    __device__ __forceinline__ void operator()(const f32x4 (&acc)[2][2][4][2], const Unit& u, int wr, int wc, int fr, int fq) const {
        const int row0 = u.pm * BM + wr * 64 + fr, col0 = wc * 32 + 8 * fq;
#pragma unroll
        for (int ai = 0; ai < 2; ++ai)
#pragma unroll
            for (int m = 0; m < 4; ++m) { const size_t ro = (size_t)(row0 + ai * HALF + m * 16) * 128 + col0;
#pragma unroll
                for (int bj = 0; bj < 2; ++bj) { const f32x4 v0 = acc[ai][bj][m][0], v1 = acc[ai][bj][m][1];
                    u32x4 w; w.x = cvt_pk_bf16(v0[0], v0[1]); w.y = cvt_pk_bf16(v0[2], v0[3]); w.z = cvt_pk_bf16(v1[0], v1[1]); w.w = cvt_pk_bf16(v1[2], v1[3]);
                    *(u32x4*)(O + (size_t)(2 * u.pn + bj) * gstride + ro) = w; } }
    }
};
struct EpiResid {
    static constexpr bool PERM = false, AFTER_DRAIN = false;
    const float* base; float* out; const float* gate; int ldc;
    __device__ __forceinline__ void operator()(const f32x4 (&acc)[2][2][4][2], const Unit& u, int wr, int wc, int fr, int fq) const {
        const int row0 = u.pm * BM + wr * 64 + fr, col0 = u.pn * BM + wc * 32 + 4 * fq;
        f32x4 gv[2][2];
#pragma unroll
        for (int bj = 0; bj < 2; ++bj)
#pragma unroll
            for (int n = 0; n < 2; ++n) gv[bj][n] = *(const f32x4*)(gate + col0 + bj * HALF + n * 16);
#pragma unroll
        for (int ai = 0; ai < 2; ++ai) {
            f32x4 b[4][2][2];
#pragma unroll
            for (int m = 0; m < 4; ++m) { const size_t off = (size_t)(row0 + ai * HALF + m * 16) * ldc + col0;
#pragma unroll
                for (int bj = 0; bj < 2; ++bj)
#pragma unroll
                    for (int n = 0; n < 2; ++n) b[m][bj][n] = *(const f32x4*)(base + off + bj * HALF + n * 16); }
            asm volatile("" ::: "memory");
#pragma unroll
            for (int m = 0; m < 4; ++m) { const size_t off = (size_t)(row0 + ai * HALF + m * 16) * ldc + col0;
#pragma unroll
                for (int bj = 0; bj < 2; ++bj)
#pragma unroll
                    for (int n = 0; n < 2; ++n) *(f32x4*)(out + off + bj * HALF + n * 16) = b[m][bj][n] + gv[bj][n] * acc[ai][bj][m][n]; }
            asm volatile("" ::: "memory"); }
    }
};
struct EpiSwiGLU {
    static constexpr bool PERM = true, AFTER_DRAIN = false;
    bf16_t* O; int ldc;
    __device__ __forceinline__ void operator()(const f32x4 (&acc)[2][2][4][2], const Unit& u, int wr, int wc, int fr, int fq) const {
        const int row0 = u.pm * BM + wr * 64 + fr, col0 = u.pn * HALF + wc * 32 + 8 * fq;
#pragma unroll
        for (int ai = 0; ai < 2; ++ai)
#pragma unroll
            for (int m = 0; m < 4; ++m) { bf16_t* rowp = O + (size_t)(row0 + ai * HALF + m * 16) * ldc + col0;
                float r[8];
#pragma unroll
                for (int n = 0; n < 2; ++n)
#pragma unroll
                    for (int j = 0; j < 4; ++j) { const float g = acc[ai][0][m][n][j], up = acc[ai][1][m][n][j]; r[n * 4 + j] = g * fast_sigmoid(g) * up; }
                u32x4 w; w.x = cvt_pk_bf16(r[0], r[1]); w.y = cvt_pk_bf16(r[2], r[3]); w.z = cvt_pk_bf16(r[4], r[5]); w.w = cvt_pk_bf16(r[6], r[7]);
                *(u32x4*)rowp = w; }
    }
};
struct EpiGluResid {
    static constexpr bool PERM = false, AFTER_DRAIN = false;
    const float* base; float* out; const float* gate; int ldc;
    __device__ __forceinline__ void operator()(const f32x4 (&acc)[2][2][4][2], const Unit& u, int wr, int wc, int fr, int fq) const {
        const int row0 = u.pm * BM + wr * 64 + fr, col0 = u.pn * HALF + wc * 32 + 4 * fq;
        f32x4 gv[2];
#pragma unroll
        for (int n = 0; n < 2; ++n) gv[n] = *(const f32x4*)(gate + col0 + n * 16);
        f32x4 b[2][4][2];
#pragma unroll
        for (int ai = 0; ai < 2; ++ai)
#pragma unroll
            for (int m = 0; m < 4; ++m) { const size_t off = (size_t)(row0 + ai * HALF + m * 16) * ldc + col0;
#pragma unroll
                for (int n = 0; n < 2; ++n) b[ai][m][n] = *(const f32x4*)(base + off + n * 16); }
        asm volatile("" ::: "memory");
#pragma unroll
        for (int ai = 0; ai < 2; ++ai)
#pragma unroll
            for (int m = 0; m < 4; ++m) { const size_t off = (size_t)(row0 + ai * HALF + m * 16) * ldc + col0;
#pragma unroll
                for (int n = 0; n < 2; ++n) { const f32x4 a = acc[ai][0][m][n], sg = acc[ai][1][m][n]; f32x4 y;
#pragma unroll
                    for (int j = 0; j < 4; ++j) y[j] = a[j] * fast_sigmoid(sg[j]);
                    *(f32x4*)(out + off + n * 16) = b[ai][m][n] + gv[n] * y; } }
        asm volatile("" ::: "memory");
    }
};

template <class Epi, class Sched, bool ALIGN_EPI = false, bool SP2 = false>
__device__ __forceinline__ void gemm_phase(PG8_LAS unsigned char* lds, const Gemm g, const Sched& S, const Epi& E) {
    const int tid = opaque_tid(), wid = __builtin_amdgcn_readfirstlane(tid >> 6), lane = tid & 63, wr = wid >> 2, wc = wid & 3, fr = lane & 15, fq = lane >> 4;
    const int K = g.K, nt = K / BK;
    unsigned voffA[2], voffB[2];
#pragma unroll
    for (int i = 0; i < 2; ++i) { int R, C; stage_rc(tid * 16 + i * 8192, R, C); const int Rb = Epi::PERM ? ((R & ~31) + perm32(R & 31)) : R;
        voffA[i] = (unsigned)(R * g.lda + C) * 2u; voffB[i] = (unsigned)(Rb * g.ldb + C) * 2u; }
    const size_t kstep = (size_t)(BK * 2);
    const size_t hstepA = (size_t)HALF * g.lda * 2, hstepB = (size_t)HALF * g.ldb * 2;
    const size_t tstepA = 2 * hstepA, tstepB = 2 * hstepB;
    const unsigned ldsw = (unsigned)wid * 1024u;
    const int aoff = lds_byte(wr * 64 + fr, fq * 8), boff = lds_byte(wc * 32 + fr, fq * 8);
#define PG8_SA(b, h) (((b) * 2 + (h)) * HTB)
#define PG8_SB(b, h) ((4 + (b) * 2 + (h)) * HTB)
#define PG8_STAGE(bufoff, gbase, voff) do { _Pragma("unroll") for (int _i = 0; _i < 2; ++_i) \
        __builtin_amdgcn_global_load_lds((const unsigned*)((const char*)(gbase) + (voff)[_i]), (PG8_LAS unsigned*)(lds + (bufoff) + ldsw + _i * 8192), 16, 0, 0); } while (0)
#define PG8_LDA(dst, b, h) do { _Pragma("unroll") for (int m = 0; m < 4; ++m) _Pragma("unroll") for (int k = 0; k < 2; ++k) dst[m][k] = *(const PG8_LAS bf16x8*)(lds + PG8_SA(b, h) + aoff + m * 2048 + k * 1024); } while (0)
#define PG8_LDB(dst, b, h) do { _Pragma("unroll") for (int n = 0; n < 2; ++n) _Pragma("unroll") for (int k = 0; k < 2; ++k) dst[n][k] = *(const PG8_LAS bf16x8*)(lds + PG8_SB(b, h) + boff + n * 2048 + k * 1024); } while (0)
#define PG8_MMA(ai, bj, At, Bt) do { __builtin_amdgcn_s_setprio(3); _Pragma("unroll") for (int m = 0; m < 4; ++m) _Pragma("unroll") for (int n = 0; n < 2; ++n) _Pragma("unroll") for (int k = 0; k < 2; ++k) \
        acc[ai][bj][m][n] = __builtin_amdgcn_mfma_f32_16x16x32_bf16(Bt[n][k], At[m][k], acc[ai][bj][m][n], 0, 0, 0); __builtin_amdgcn_s_setprio(0); } while (0)
#define PG8_WAIT_V(n) asm volatile("s_waitcnt vmcnt(" #n ")" ::: "memory")
#define PG8_WAIT_L(n) asm volatile("s_waitcnt lgkmcnt(" #n ")" ::: "memory")
#define PG8_BAR __builtin_amdgcn_s_barrier()
#define PG8_SCHED __builtin_amdgcn_sched_barrier(0)
    Unit cur, nxt; int ui = 0;
    if (!S.next(0, cur)) return;
    f32x4 acc[2][2][4][2];
#pragma unroll
    for (int a = 0; a < 2; ++a)
#pragma unroll
        for (int b = 0; b < 2; ++b)
#pragma unroll
            for (int m = 0; m < 4; ++m)
#pragma unroll
                for (int n = 0; n < 2; ++n) acc[a][b][m][n] = (f32x4){0.f, 0.f, 0.f, 0.f};
    bf16x8 At[4][2], B0[2][2], B1[2][2];
    const char* cA = (const char*)g.A + (size_t)cur.pm * tstepA; const char* cB = (const char*)g.Bt + (size_t)cur.pn * tstepB;
    S.a_ready(cur);
    if constexpr (SP2) {
        PG8_STAGE(PG8_SB(0, 0), cB, voffB); PG8_STAGE(PG8_SB(0, 1), cB + hstepB, voffB); PG8_STAGE(PG8_SA(0, 0), cA, voffA); PG8_STAGE(PG8_SA(0, 1), cA + hstepA, voffA);
        if (wr == 1) PG8_BAR;
        PG8_WAIT_V(2); PG8_BAR;
        PG8_STAGE(PG8_SB(1, 0), cB + kstep, voffB); PG8_STAGE(PG8_SA(1, 0), cA + kstep, voffA); PG8_STAGE(PG8_SB(1, 1), cB + hstepB + kstep, voffB);
        PG8_WAIT_V(6); PG8_BAR;
    } else {
        PG8_STAGE(PG8_SB(0, 0), cB, voffB); PG8_STAGE(PG8_SA(0, 0), cA, voffA); PG8_STAGE(PG8_SB(0, 1), cB + hstepB, voffB); PG8_STAGE(PG8_SA(0, 1), cA + hstepA, voffA);
        if (wr == 1) PG8_BAR;
        PG8_WAIT_V(4); PG8_BAR;
        PG8_STAGE(PG8_SB(1, 0), cB + kstep, voffB); PG8_STAGE(PG8_SA(1, 0), cA + kstep, voffA); PG8_STAGE(PG8_SB(1, 1), cB + hstepB + kstep, voffB);
        PG8_WAIT_V(6); PG8_BAR;
    }
    for (;;) {
        const bool has_next = S.next(ui + 1, nxt);
        const char* nA = has_next ? (const char*)g.A + (size_t)nxt.pm * tstepA : cA; const char* nB = has_next ? (const char*)g.Bt + (size_t)nxt.pn * tstepB : cB;
        for (int t = 0; t < nt; t += 2) {
            const bool last = (t == nt - 2);
            const char* a1 = cA + (size_t)(t + 1) * kstep;
            const char* a2 = last ? nA : cA + (size_t)(t + 2) * kstep; const char* b2 = last ? nB : cB + (size_t)(t + 2) * kstep;
            const char* a3 = a2 + kstep; const char* b3 = b2 + kstep;
            if (last && has_next) S.a_ready(nxt);
            if constexpr (SP2) {
            PG8_LDB(B0, 0, 0); PG8_LDB(B1, 0, 1); PG8_SCHED; PG8_LDA(At, 0, 0); PG8_STAGE(PG8_SA(1, 1), a1 + hstepA, voffA);
            PG8_WAIT_V(8); PG8_WAIT_L(0); PG8_BAR; PG8_MMA(0, 0, At, B0); PG8_MMA(0, 1, At, B1); PG8_BAR; PG8_SCHED;
            PG8_LDA(At, 0, 1); PG8_STAGE(PG8_SB(0, 0), b2, voffB); PG8_STAGE(PG8_SB(0, 1), b2 + hstepB, voffB); PG8_STAGE(PG8_SA(0, 0), a2, voffA);
            PG8_WAIT_V(8); PG8_WAIT_L(0); PG8_BAR; PG8_MMA(1, 0, At, B0); PG8_MMA(1, 1, At, B1); PG8_BAR; PG8_SCHED;
            PG8_LDB(B0, 1, 0); PG8_LDB(B1, 1, 1); PG8_SCHED; PG8_LDA(At, 1, 0); PG8_STAGE(PG8_SA(0, 1), a2 + hstepA, voffA);
            PG8_WAIT_V(8); PG8_WAIT_L(0); PG8_BAR; PG8_MMA(0, 0, At, B0); PG8_MMA(0, 1, At, B1); PG8_BAR; PG8_SCHED;
            PG8_LDA(At, 1, 1); PG8_STAGE(PG8_SB(1, 0), b3, voffB); PG8_STAGE(PG8_SB(1, 1), b3 + hstepB, voffB); PG8_STAGE(PG8_SA(1, 0), a3, voffA);
            PG8_WAIT_V(8); PG8_WAIT_L(0); PG8_BAR; PG8_MMA(1, 0, At, B0); PG8_MMA(1, 1, At, B1); PG8_BAR; PG8_SCHED;
            } else {
            PG8_LDB(B0, 0, 0); PG8_SCHED; PG8_LDA(At, 0, 0); PG8_STAGE(PG8_SA(1, 1), a1 + hstepA, voffA);
            PG8_WAIT_L(8); PG8_BAR; PG8_WAIT_L(0); PG8_MMA(0, 0, At, B0); PG8_BAR; PG8_SCHED;
            PG8_LDB(B1, 0, 1); PG8_STAGE(PG8_SB(0, 0), b2, voffB);
            PG8_BAR; PG8_WAIT_L(0); PG8_MMA(0, 1, At, B1); PG8_BAR;
            PG8_LDA(At, 0, 1); PG8_STAGE(PG8_SA(0, 0), a2, voffA);
            PG8_BAR; PG8_WAIT_L(0); PG8_MMA(1, 0, At, B0); PG8_BAR; PG8_SCHED;
            PG8_STAGE(PG8_SB(0, 1), b2 + hstepB, voffB);
            PG8_WAIT_V(6); PG8_BAR; PG8_MMA(1, 1, At, B1); PG8_BAR;
            PG8_LDB(B0, 1, 0); PG8_SCHED; PG8_LDA(At, 1, 0); PG8_STAGE(PG8_SA(0, 1), a2 + hstepA, voffA);
            PG8_WAIT_L(8); PG8_BAR; PG8_WAIT_L(0); PG8_MMA(0, 0, At, B0); PG8_BAR; PG8_SCHED;
            PG8_LDB(B1, 1, 1); PG8_STAGE(PG8_SB(1, 0), b3, voffB);
            PG8_BAR; PG8_WAIT_L(0); PG8_MMA(0, 1, At, B1); PG8_BAR;
            PG8_LDA(At, 1, 1); PG8_STAGE(PG8_SA(1, 0), a3, voffA);
            PG8_BAR; PG8_WAIT_L(0); PG8_MMA(1, 0, At, B0); PG8_BAR; PG8_SCHED;
            PG8_STAGE(PG8_SB(1, 1), b3 + hstepB, voffB);
            PG8_WAIT_V(6); PG8_BAR; PG8_MMA(1, 1, At, B1); PG8_BAR;
            }
        }
        if constexpr (ALIGN_EPI) { if (wr == 0) PG8_BAR; }
        if constexpr (!Epi::AFTER_DRAIN) { E(acc, cur, wr, wc, fr, fq); S.done(cur); }
        if (!has_next) break;
#pragma unroll
        for (int a = 0; a < 2; ++a)
#pragma unroll
            for (int b = 0; b < 2; ++b)
#pragma unroll
                for (int m = 0; m < 4; ++m)
#pragma unroll
                    for (int n = 0; n < 2; ++n) acc[a][b][m][n] = (f32x4){0.f, 0.f, 0.f, 0.f};
        cur = nxt; cA = nA; cB = nB; ++ui;
        if constexpr (ALIGN_EPI) { if (wr == 1) PG8_BAR; }
    }
    PG8_WAIT_V(0);
    if constexpr (!ALIGN_EPI) { if (wr == 0) PG8_BAR; }
    PG8_BAR;
    if constexpr (Epi::AFTER_DRAIN) { E.fused(acc, cur, wr, wc, fr, fq, lds, wid, lane); S.done(cur); }
#undef PG8_SA
#undef PG8_SB
#undef PG8_STAGE
#undef PG8_LDA
#undef PG8_LDB
#undef PG8_MMA
#undef PG8_WAIT_V
#undef PG8_WAIT_L
#undef PG8_BAR
#undef PG8_SCHED
}
}

namespace att {
constexpr int D = 128;
constexpr float THR = 8.f;
constexpr bool WSKIP = false;
constexpr float SCALE = 0.08838834764831845f;
constexpr int NW = 8, QBLK = 32, KVBLK = 64, QB = NW * QBLK;
constexpr int SHM_V = KVBLK * D * 2, SHM_K = KVBLK * D * 2;
constexpr int LDS_BYTES = 2 * SHM_V + 2 * SHM_K + NW * 64 * 4;

using bf16 = __hip_bfloat16;
typedef short bf16x8 __attribute__((ext_vector_type(8)));
typedef short s16x4 __attribute__((ext_vector_type(4)));
typedef float f32x16 __attribute__((ext_vector_type(16)));
typedef float f32x4 __attribute__((ext_vector_type(4)));
typedef unsigned u32x4 __attribute__((ext_vector_type(4)));
template <class A, class Bt> struct same_t { static constexpr bool v = false; };
template <class A> struct same_t<A, A> { static constexpr bool v = true; };

#define KSWZ(row, colB) ((row) * 256 + ((colB) ^ (((row) & 7) << 4)))
#define SBAR() __builtin_amdgcn_sched_barrier(0)
__device__ __forceinline__ int v_st(int k, int c) { const int kk = (k & ~0xC) | ((k & 4) << 1) | ((k & 8) >> 1); return ((kk >> 3) * 4 + (c >> 5)) * 512 + ((kk & 7) * 32 + (c & 31)) * 2; }
__device__ __forceinline__ int v_rd_base(int lane) { return ((lane & 3) << 3) | (((lane >> 2) & 3) << 6) | (((lane >> 4) & 1) << 5) | (((lane >> 5) & 1) << 8); }
constexpr int v_rd_off(int d0, int ks, int half) { return d0 * 512 + ks * 4096 + half * 2048; }
__device__ __forceinline__ int crow(int r, int hi) { return (r & 3) + 8 * (r >> 2) + 4 * hi; }
__device__ __forceinline__ unsigned cvtpk(float lo, float hi) {
    unsigned r; asm volatile("v_cvt_pk_bf16_f32 %0, %1, %2" : "=v"(r) : "v"(lo), "v"(hi)); return r;
}
__device__ __forceinline__ bf16x8 pack8(f32x4 a, f32x4 b) {
    u32x4 w = {cvtpk(a[0], a[1]), cvtpk(a[2], a[3]), cvtpk(b[0], b[1]), cvtpk(b[2], b[3])};
    return *reinterpret_cast<bf16x8*>(&w);
}
template <class T> __device__ __forceinline__ bf16x8 load8(const T* p) {
    if constexpr (same_t<T, float>::v) { return pack8(*(const f32x4*)p, *(const f32x4*)(p + 4)); }
    else { return *reinterpret_cast<const bf16x8*>(p); }
}
__device__ __forceinline__ void mask_tile(f32x16& p0, f32x16& p1, int dq, unsigned W) {
    const float NEG = -__builtin_inff();
#pragma unroll
    for (int r = 0; r < 16; ++r) {
        const int c = (r & 3) + 8 * (r >> 2);
        if ((unsigned)(dq - c) >= W) p0[r] = NEG;
        if ((unsigned)(dq - c - 32) >= W) p1[r] = NEG;
    }
}
__device__ __forceinline__ void partialSM(f32x16& p0, f32x16& p1, float& m_reg, float& mn, float& alpha) {
    float pmax = p0[0]; for (int r = 1; r < 16; ++r) pmax = fmaxf(pmax, p0[r]); for (int r = 0; r < 16; ++r) pmax = fmaxf(pmax, p1[r]);
    { auto rr = __builtin_amdgcn_permlane32_swap(__float_as_uint(pmax), __float_as_uint(pmax), false, false);
      pmax = fmaxf(__uint_as_float(rr[0]), __uint_as_float(rr[1])); }
    constexpr float C2 = 1.4426950408889634f * SCALE;
    if (__builtin_expect(__all((pmax - m_reg) * SCALE <= THR), 1)) { mn = m_reg; alpha = 1.f; }
    else { mn = fmaxf(m_reg, pmax); alpha = __builtin_amdgcn_exp2f((m_reg - mn) * C2); m_reg = mn; }
    const float mnL = -mn * C2;
    for (int r = 0; r < 16; ++r) p0[r] = fmaf(p0[r], C2, mnL); for (int r = 0; r < 16; ++r) p1[r] = fmaf(p1[r], C2, mnL);
    for (int r = 0; r < 16; ++r) p0[r] = __builtin_amdgcn_exp2f(p0[r]);
}
__device__ __forceinline__ void finishSM(f32x16& p0, f32x16& p1, float alpha, float& l_reg, bf16x8& pa0, bf16x8& pa1, bf16x8& pa2, bf16x8& pa3) {
    for (int r = 0; r < 16; ++r) p1[r] = __builtin_amdgcn_exp2f(p1[r]);
    float ps = 0; for (int r = 0; r < 16; ++r) ps += p0[r]; for (int r = 0; r < 16; ++r) ps += p1[r];
    { auto rr = __builtin_amdgcn_permlane32_swap(__float_as_uint(ps), __float_as_uint(ps), false, false);
      ps = __uint_as_float(rr[0]) + __uint_as_float(rr[1]); }
    l_reg = l_reg * alpha + ps;
#define PK4(P, B_, OUT) do { unsigned a0 = cvtpk(P[B_+0], P[B_+1]), a1 = cvtpk(P[B_+2], P[B_+3]);                          \
        unsigned b0 = cvtpk(P[B_+4], P[B_+5]), b1 = cvtpk(P[B_+6], P[B_+7]);                                             \
        auto r0 = __builtin_amdgcn_permlane32_swap(a0, b0, false, false); auto r1 = __builtin_amdgcn_permlane32_swap(a1, b1, false, false); \
        u32x4 w = {r0[0], r1[0], r0[1], r1[1]}; OUT = *reinterpret_cast<bf16x8*>(&w); } while (0)
    PK4(p0, 0, pa0); PK4(p0, 8, pa1); PK4(p1, 0, pa2); PK4(p1, 8, pa3);
#undef PK4
}
template <int KB, bool SK>
__device__ __forceinline__ void qkt(f32x16& p0, f32x16& p1, const char* K_lds, int r32, int hi, const bf16x8* qr, bool act) {
    if (SK && !act) { const float NEG = -__builtin_inff();
#pragma unroll
        for (int r = 0; r < 16; ++r) { p0[r] = NEG; p1[r] = NEG; } return; }
    p0 = f32x16{}; p1 = f32x16{};
    const char* kb[4];
#pragma unroll
    for (int dd = 0; dd < 4; ++dd) kb[dd] = K_lds + KB * SHM_K + KSWZ(r32, (dd * 16 + hi * 8) * 2);
#pragma unroll
    for (int d0 = 0; d0 < 8; ++d0) { const char* a = kb[d0 & 3] + (d0 >> 2) * 128;
        bf16x8 b0 = *reinterpret_cast<const bf16x8*>(a);
        bf16x8 b1 = *reinterpret_cast<const bf16x8*>(a + 32 * 256);
        p0 = __builtin_amdgcn_mfma_f32_32x32x16_bf16(b0, qr[d0], p0, 0, 0, 0);
        p1 = __builtin_amdgcn_mfma_f32_32x32x16_bf16(b1, qr[d0], p1, 0, 0, 0); }
}
template <int VB, bool SK>
__device__ __forceinline__ void pv_tile(f32x16* o, int vb0, bf16x8 pa0, bf16x8 pa1, bf16x8 pa2, bf16x8 pa3, bool act) {
    if (SK && !act) return;
#define TRRD(dst, off) asm volatile("ds_read_b64_tr_b16 %0, %1 offset:%2" : "=&v"(dst) : "v"(vb0), "i"(off) : "memory")
#define PV_D0(d0) do { s16x4 l0, l1, l2, l3, h0, h1, h2, h3; constexpr int b_ = VB * SHM_V + v_rd_off(d0, 0, 0);     \
        TRRD(l0, b_); TRRD(h0, b_ + 2048); TRRD(l1, b_ + 4096); TRRD(h1, b_ + 6144); TRRD(l2, b_ + 8192); TRRD(h2, b_ + 10240); TRRD(l3, b_ + 12288); TRRD(h3, b_ + 14336); \
        asm volatile("s_waitcnt lgkmcnt(0)" ::: "memory"); SBAR();                 \
        o[d0] = __builtin_amdgcn_mfma_f32_32x32x16_bf16(pa0, (bf16x8){l0[0], l0[1], l0[2], l0[3], h0[0], h0[1], h0[2], h0[3]}, o[d0], 0, 0, 0);   \
        o[d0] = __builtin_amdgcn_mfma_f32_32x32x16_bf16(pa1, (bf16x8){l1[0], l1[1], l1[2], l1[3], h1[0], h1[1], h1[2], h1[3]}, o[d0], 0, 0, 0);   \
        o[d0] = __builtin_amdgcn_mfma_f32_32x32x16_bf16(pa2, (bf16x8){l2[0], l2[1], l2[2], l2[3], h2[0], h2[1], h2[2], h2[3]}, o[d0], 0, 0, 0);   \
        o[d0] = __builtin_amdgcn_mfma_f32_32x32x16_bf16(pa3, (bf16x8){l3[0], l3[1], l3[2], l3[3], h3[0], h3[1], h3[2], h3[3]}, o[d0], 0, 0, 0); } while (0)
    PV_D0(0); PV_D0(1); PV_D0(2); PV_D0(3);
#undef PV_D0
#undef TRRD
}

template <class TIn, class TOut> struct BlockRef { const TIn* Q; const TIn* K; const TIn* V; TOut* O; int P0; };
template <class TIn> struct Seam {
    bf16x8 qr[8];
    bf16x8 st_v0, st_v1, st_k0, st_k1; f32x4 sf0, sf1, sf2, sf3;
    f32x4 tq[16];
};
__device__ __forceinline__ int swa_jlo(int P0, int W) { const int lowk = P0 - W + 1; return lowk > 0 ? lowk / KVBLK : 0; }
#define ROW(p, k0, rr) ((p) + (size_t)((k0) + (rr)) * D + sc)
#define VMW() asm volatile("s_waitcnt vmcnt(0)" ::: "memory")
#define VMWN(n) asm volatile("s_waitcnt vmcnt(%0)" :: "i"(n) : "memory")
#define SLOAD_H(Kp, Vp, k0) do { S.st_v0 = load8<TIn>(ROW(Vp, k0, sr)); S.st_v1 = load8<TIn>(ROW(Vp, k0, 32 + sr));              \
                         S.st_k0 = load8<TIn>(ROW(Kp, k0, sr)); S.st_k1 = load8<TIn>(ROW(Kp, k0, 32 + sr)); } while (0)
#define SWRITE_HK(bf) do { *(bf16x8*)(K_lds + (bf) * SHM_K + kws) = S.st_k0; *(bf16x8*)(K_lds + (bf) * SHM_K + kws + 32 * 256) = S.st_k1; } while (0)
#define SWRITE_HV(bf) do { *(bf16x8*)(V_lds + (bf) * SHM_V + vst0) = S.st_v0; *(bf16x8*)(V_lds + (bf) * SHM_V + vst1) = S.st_v1; } while (0)
#define SWRITE_H(bf) do { SWRITE_HV(bf); SWRITE_HK(bf); } while (0)
#define SLOAD_F(p, k0) do { S.sf0 = *(const f32x4*)ROW(p, k0, sr); S.sf1 = *(const f32x4*)(ROW(p, k0, sr) + 4);                \
                            S.sf2 = *(const f32x4*)ROW(p, k0, 32 + sr); S.sf3 = *(const f32x4*)(ROW(p, k0, 32 + sr) + 4); } while (0)
#define SWRITE_KF(bf) do { *(bf16x8*)(K_lds + (bf) * SHM_K + kws) = pack8(S.sf0, S.sf1); *(bf16x8*)(K_lds + (bf) * SHM_K + kws + 32 * 256) = pack8(S.sf2, S.sf3); } while (0)
#define SWRITE_VF(bf) do { *(bf16x8*)(V_lds + (bf) * SHM_V + vst0) = pack8(S.sf0, S.sf1); *(bf16x8*)(V_lds + (bf) * SHM_V + vst1) = pack8(S.sf2, S.sf3); } while (0)
template <class TIn, class TOut>
__device__ __forceinline__ void causal_swa_prime(const BlockRef<TIn, TOut>& cur, int W, char* lds, Seam<TIn>& S) {
    constexpr bool F32 = same_t<TIn, float>::v;
    const int tid = opaque_tid(), wid = __builtin_amdgcn_readfirstlane(tid >> 6), lane = tid & 63, r32 = lane & 31, hi = lane >> 5;
    const int sr = tid >> 4, sc = (tid & 15) * 8, kws = KSWZ(sr, sc * 2); char* K_lds = lds + 2 * SHM_V;
    const int kb0 = swa_jlo(cur.P0, W) * KVBLK;
    for (int d0 = 0; d0 < 8; ++d0) S.qr[d0] = load8<TIn>(cur.Q + (size_t)(wid * QBLK + r32) * D + d0 * 16 + hi * 8);
    if constexpr (F32) { SLOAD_F((const float*)cur.K, kb0); VMW(); SWRITE_KF(0); SBAR(); SLOAD_F((const float*)cur.V, kb0); }
    else { SLOAD_H(cur.K, cur.V, kb0); VMW(); SWRITE_HK(0); }
    __syncthreads();
}
template <class TIn, class TOut>
__device__ __forceinline__ void causal_swa_block(const BlockRef<TIn, TOut>& cur, const BlockRef<TIn, TOut>& nxt, int skv, int W, char* lds, Seam<TIn>& S) {
    constexpr bool F32 = same_t<TIn, float>::v;
    const int tid = opaque_tid(), wid = __builtin_amdgcn_readfirstlane(tid >> 6), lane = tid & 63, r32 = lane & 31, hi = lane >> 5;
    const int j_lo = swa_jlo(cur.P0, W);
    int j_hi = (cur.P0 + QB - 1) / KVBLK + 1; if (j_hi > skv / KVBLK) j_hi = skv / KVBLK;
    const int NT = j_hi - j_lo;
    const int kbn = swa_jlo(nxt.P0, W) * KVBLK;
    const int qlo = cur.P0 + wid * QBLK, qm = qlo + r32 - 4 * hi;
    char* V_lds = lds; char* K_lds = lds + 2 * SHM_V;
    float* ws = (float*)(lds + 2 * SHM_V + 2 * SHM_K) + wid * 64; float* li_l = ws, * al_l = ws + 32;
    float m_reg = -1e30f, l_reg = 0; f32x16 o[4] = {};
    const int sr = tid >> 4, sc = (tid & 15) * 8, vst0 = v_st(sr, sc), vst1 = v_st(32 + sr, sc), kws = KSWZ(sr, sc * 2);
    const int vb0 = (int)(uintptr_t)V_lds + v_rd_base(lane);
    const TIn* Kh = cur.K; const TIn* Vh = cur.V;
#define RESC(a) do { if (__any((a) < 1.f)) { if (hi == 0) al_l[r32] = (a); asm volatile("s_waitcnt lgkmcnt(0)" ::: "memory");              \
                     for (int d_ = 0; d_ < 4; ++d_) for (int r = 0; r < 16; ++r) o[d_][r] *= al_l[crow(r, hi)]; } } while (0)
#define KBASE(t) ((j_lo + (t)) * KVBLK)
#define ACT(t) (KBASE(t) <= qlo + QBLK - 1 && KBASE(t) + KVBLK - 1 >= qlo - W + 1)
#define MASKT(P0_, P1_, t) do { const int kb_ = KBASE(t); if ((!SK || ACT(t)) && (kb_ + KVBLK - 1 > qlo || kb_ <= qlo + QBLK - 1 - W)) mask_tile(P0_, P1_, qm - kb_, (unsigned)W); } while (0)
    constexpr int NQL = F32 ? 16 : 8;
    constexpr bool SK = WSKIP && !F32;
#define SEAM_K0() do { VMWN(NQL); if constexpr (F32) { SWRITE_KF(0); SBAR(); SLOAD_F((const float*)nxt.V, kbn); } else { SWRITE_HK(0); } SBAR(); } while (0)
    f32x16 pA0, pA1, pB0, pB1; float mnA, mnB, alA, alB; bf16x8 pa0, pa1, pa2, pa3;
    if constexpr (F32) { VMW(); SWRITE_VF(0); SBAR(); } else { SWRITE_HV(0); SBAR(); }
    if (NT > 1) { if constexpr (F32) SLOAD_F((const float*)Kh, KBASE(1)); else SLOAD_H(Kh, Vh, KBASE(1)); }
    SBAR(); qkt<0, SK>(pA0, pA1, K_lds, r32, hi, S.qr, ACT(0));
    if constexpr (F32) { if (NT > 1) { VMW(); SWRITE_KF(1); SBAR(); SLOAD_F((const float*)Vh, KBASE(1)); } }
    MASKT(pA0, pA1, 0); partialSM(pA0, pA1, m_reg, mnA, alA);
    if (NT > 1) { VMW(); if constexpr (F32) { SWRITE_VF(1); SBAR(); if (NT > 2) SLOAD_F((const float*)Kh, KBASE(2)); } else SWRITE_H(1); }
    __syncthreads();
#define HALF_STEP(PX0, PX1, mnX, alX, PY0, PY1, alY, t, KB, VB, SB) do {                                                      \
        SBAR(); qkt<KB, SK>(PX0, PX1, K_lds, r32, hi, S.qr, ACT(t));                                             \
        finishSM(PY0, PY1, alY, l_reg, pa0, pa1, pa2, pa3); SBAR();                                                           \
        if ((t) + 1 < NT) { if constexpr (F32) { VMW(); SWRITE_KF(SB); SBAR(); SLOAD_F((const float*)Vh, KBASE((t) + 1)); }  \
                            else { SLOAD_H(Kh, Vh, KBASE((t) + 1)); } SBAR(); }                                               \
        pv_tile<VB, SK>(o, vb0, pa0, pa1, pa2, pa3, ACT((t) - 1)); MASKT(PX0, PX1, (t)); partialSM(PX0, PX1, m_reg, mnX, alX);                                        \
        __syncthreads();                                                                                                      \
        if ((t) + 1 < NT) { VMW(); if constexpr (F32) { SWRITE_VF(SB); SBAR(); if ((t) + 2 < NT) SLOAD_F((const float*)Kh, KBASE((t) + 2)); } \
                            else { SWRITE_H(SB); } }                                                                          \
        RESC(alX); __syncthreads(); } while (0)
    for (int t = 1; t + 1 < NT; t += 2) {
        HALF_STEP(pB0, pB1, mnB, alB, pA0, pA1, alA, t, 1, 0, 0);
        HALF_STEP(pA0, pA1, mnA, alA, pB0, pB1, alB, t + 1, 0, 1, 1);
    }
    const bool even = (NT & 1) == 0;
    if (even) { SBAR(); qkt<1, SK>(pB0, pB1, K_lds, r32, hi, S.qr, ACT(NT - 1)); SBAR(); }
#define QROW(e) (nxt.Q + (size_t)(wid * QBLK + r32) * D + ((e) >> 1) * 16 + hi * 8 + ((e) & 1) * 4)
    if constexpr (F32) { SLOAD_F((const float*)nxt.K, kbn); SBAR();
#pragma unroll
        for (int e = 0; e < 8; ++e) S.tq[e] = *(const f32x4*)QROW(e); }
    else { SLOAD_H(nxt.K, nxt.V, kbn); SBAR();
#pragma unroll
        for (int d0 = 0; d0 < 8; ++d0) S.qr[d0] = load8<TIn>(nxt.Q + (size_t)(wid * QBLK + r32) * D + d0 * 16 + hi * 8); }
    SBAR();
    finishSM(pA0, pA1, alA, l_reg, pa0, pa1, pa2, pa3); SBAR();
    if constexpr (F32) {
#pragma unroll
        for (int e = 8; e < 16; ++e) S.tq[e] = *(const f32x4*)QROW(e); SBAR(); }
#undef QROW
    pv_tile<0, SK>(o, vb0, pa0, pa1, pa2, pa3, ACT(even ? NT - 2 : NT - 1));
    if (even) { MASKT(pB0, pB1, NT - 1); partialSM(pB0, pB1, m_reg, mnB, alB); __syncthreads(); RESC(alB);
        finishSM(pB0, pB1, alB, l_reg, pa0, pa1, pa2, pa3); SBAR(); pv_tile<1, SK>(o, vb0, pa0, pa1, pa2, pa3, ACT(NT - 1)); }
    SBAR(); SEAM_K0();
    if (hi == 0) li_l[r32] = l_reg; asm volatile("s_waitcnt lgkmcnt(0)" ::: "memory");
    float rli[16];
#pragma unroll
    for (int r = 0; r < 16; ++r) rli[r] = __builtin_amdgcn_rcpf(li_l[crow(r, hi)]);
    TOut* Ow = cur.O + (size_t)(wid * QBLK) * D;
#pragma unroll
    for (int r = 0; r < 16; ++r) { const int orow = crow(r, hi);
#pragma unroll
        for (int d0 = 0; d0 < 4; ++d0) { const float v = o[d0][r] * rli[r];
            if constexpr (same_t<TOut, float>::v) { Ow[(size_t)orow * D + d0 * 32 + r32] = v; }
            else { const float vn = __shfl_xor(v, 1);
                   if ((r32 & 1) == 0) *(unsigned*)(Ow + (size_t)orow * D + d0 * 32 + r32) = cvtpk(v, vn); } } }
    if constexpr (F32) {
#pragma unroll
        for (int d0 = 0; d0 < 8; ++d0) S.qr[d0] = pack8(S.tq[2 * d0], S.tq[2 * d0 + 1]); }
    __syncthreads();
#undef RESC
#undef KBASE
#undef ACT
#undef MASKT
#undef SEAM_K0
#undef HALF_STEP
}
#undef ROW
#undef VMW
#undef VMWN
#undef SLOAD_H
#undef SWRITE_HK
#undef SWRITE_HV
#undef SWRITE_H
#undef SLOAD_F
#undef SWRITE_KF
#undef SWRITE_VF
#undef KSWZ
#undef SBAR
}

namespace att2 {
typedef short bf16x8 __attribute__((ext_vector_type(8)));
typedef short s16x4 __attribute__((ext_vector_type(4)));
typedef float f32x16 __attribute__((ext_vector_type(16)));
typedef unsigned u32x4 __attribute__((ext_vector_type(4)));
constexpr float SCALE = 0.08838834764831845f, THR = 8.f, C2 = 1.4426950408889634f * SCALE;
constexpr int V_OFF = 0, K_OFF = 65536, PX_OFF = 98304, MX_OFF = 114688, WS_OFF = 118784, LDS_NEED = 120832;
#define A2_KSWZ(row, colB) ((row) * 256 + ((colB) ^ (((row) & 7) << 4)))
#define A2_SBAR() __builtin_amdgcn_sched_barrier(0)
template <int KB>
__device__ __forceinline__ void qkt(f32x16& p, const char* Kl, int krow, int hi, const bf16x8* qr) {
    p = f32x16{};
    const char* kbp[4];
#pragma unroll
    for (int dd = 0; dd < 4; ++dd) kbp[dd] = Kl + KB * 16384 + A2_KSWZ(krow, (dd * 16 + hi * 8) * 2);
    bf16x8 b[8];
#pragma unroll
    for (int d0 = 0; d0 < 8; ++d0) b[d0] = *reinterpret_cast<const bf16x8*>(kbp[d0 & 3] + (d0 >> 2) * 128);
    __builtin_amdgcn_s_setprio(3);
#pragma unroll
    for (int d0 = 0; d0 < 8; ++d0) p = __builtin_amdgcn_mfma_f32_32x32x16_bf16(b[d0], qr[d0], p, 0, 0, 0);
    __builtin_amdgcn_s_setprio(0);
}
template <int VOFFB>
__device__ __forceinline__ void pv(f32x16* o, int vb0, bf16x8 pa0, bf16x8 pa1, bf16x8 pa2, bf16x8 pa3) {
#define A2_TRRD(dst, off) asm volatile("ds_read_b64_tr_b16 %0, %1 offset:%2" : "=&v"(dst) : "v"(vb0), "i"(off) : "memory")
#define A2_PV_D0(d0) do { s16x4 l0, l1, l2, l3, h0, h1, h2, h3; constexpr int b_ = VOFFB + att::v_rd_off(d0, 0, 0); \
        A2_TRRD(l0, b_); A2_TRRD(h0, b_ + 2048); A2_TRRD(l1, b_ + 4096); A2_TRRD(h1, b_ + 6144); A2_TRRD(l2, b_ + 8192); A2_TRRD(h2, b_ + 10240); A2_TRRD(l3, b_ + 12288); A2_TRRD(h3, b_ + 14336); \
        asm volatile("s_waitcnt lgkmcnt(0)" ::: "memory"); A2_SBAR(); \
        o[d0] = __builtin_amdgcn_mfma_f32_32x32x16_bf16(pa0, (bf16x8){l0[0], l0[1], l0[2], l0[3], h0[0], h0[1], h0[2], h0[3]}, o[d0], 0, 0, 0); \
        o[d0] = __builtin_amdgcn_mfma_f32_32x32x16_bf16(pa1, (bf16x8){l1[0], l1[1], l1[2], l1[3], h1[0], h1[1], h1[2], h1[3]}, o[d0], 0, 0, 0); \
        o[d0] = __builtin_amdgcn_mfma_f32_32x32x16_bf16(pa2, (bf16x8){l2[0], l2[1], l2[2], l2[3], h2[0], h2[1], h2[2], h2[3]}, o[d0], 0, 0, 0); \
        o[d0] = __builtin_amdgcn_mfma_f32_32x32x16_bf16(pa3, (bf16x8){l3[0], l3[1], l3[2], l3[3], h3[0], h3[1], h3[2], h3[3]}, o[d0], 0, 0, 0); } while (0)
    __builtin_amdgcn_s_setprio(3); A2_PV_D0(0); A2_PV_D0(1); A2_PV_D0(2); A2_PV_D0(3); __builtin_amdgcn_s_setprio(0);
#undef A2_PV_D0
#undef A2_TRRD
}
__device__ __forceinline__ float rowmax16(const f32x16& p) {
    float pm = p[0];
#pragma unroll
    for (int r = 1; r < 16; ++r) pm = fmaxf(pm, p[r]);
    auto rr = __builtin_amdgcn_permlane32_swap(__float_as_uint(pm), __float_as_uint(pm), false, false);
    return fmaxf(__uint_as_float(rr[0]), __uint_as_float(rr[1]));
}
template <bool DEG>
__device__ __forceinline__ void block(const unsigned short* Q, const unsigned short* K, const unsigned short* V0, const unsigned short* V1, float* O0, float* O1, int P0, char* lds) {
    const int tid = opaque_tid(), wid = __builtin_amdgcn_readfirstlane(tid >> 6), lane = tid & 63, r32 = lane & 31, hi = lane >> 5, rg = wid >> 1, kh = wid & 1, hf = wid >> 2;
    const int NT = P0 / 64 + 2, qlo = P0 + 32 * rg;
    const int sr = tid >> 4, sc = (tid & 15) * 8, kws = A2_KSWZ(sr, sc * 2), vst0 = att::v_st(sr, sc), vst1 = att::v_st(32 + sr, sc);
    char* Vl = lds + V_OFF; char* Kl = lds + K_OFF;
    const int vb0 = (int)(uintptr_t)Vl + att::v_rd_base(lane) + kh * 16384, krow = 32 * kh + r32;
    float* wsl = (float*)(lds + WS_OFF) + wid * 64; float* al_l = wsl; float* li_l = wsl + 32;
    const float* li_p = (const float*)(lds + WS_OFF) + (wid ^ 1) * 64 + 32;
    float* mxw = (float*)(lds + MX_OFF) + wid * 64 + lane; const float* mxr = (const float*)(lds + MX_OFF) + (wid ^ 1) * 64 + lane;
    char* pxw = lds + PX_OFF + ((rg * 4 + 2 * kh) * 64 + lane) * 16; const char* pxr = lds + PX_OFF + (rg * 4 * 64 + lane) * 16;
    bf16x8 qr[8];
#pragma unroll
    for (int d0 = 0; d0 < 8; ++d0) qr[d0] = *reinterpret_cast<const bf16x8*>(Q + (size_t)(32 * rg + r32) * 128 + d0 * 16 + hi * 8);
    bf16x8 sk0, sk1, sv0, sv1, sv2, sv3;
#define A2_LOADK(t) do { const size_t o0_ = (size_t)((DEG ? 0 : (t)) * 64 + sr) * 128 + sc, o1_ = o0_ + 32 * 128; sk0 = *reinterpret_cast<const bf16x8*>(K + o0_); sk1 = *reinterpret_cast<const bf16x8*>(K + o1_); } while (0)
#define A2_LOADV(t) do { const size_t o0_ = (size_t)((DEG ? 0 : (t)) * 64 + sr) * 128 + sc, o1_ = o0_ + 32 * 128; \
        sv0 = *reinterpret_cast<const bf16x8*>(V0 + o0_); sv1 = *reinterpret_cast<const bf16x8*>(V0 + o1_); sv2 = *reinterpret_cast<const bf16x8*>(V1 + o0_); sv3 = *reinterpret_cast<const bf16x8*>(V1 + o1_); } while (0)
#define A2_BAR() do { asm volatile("s_waitcnt lgkmcnt(0)" ::: "memory"); __builtin_amdgcn_s_barrier(); asm volatile("" ::: "memory"); } while (0)
#define A2_WRITEK(b) do { *(bf16x8*)(Kl + (b) * 16384 + kws) = sk0; *(bf16x8*)(Kl + (b) * 16384 + kws + 32 * 256) = sk1; } while (0)
#define A2_WRITEV(b) do { *(bf16x8*)(Vl + (b) * 32768 + vst0) = sv0; *(bf16x8*)(Vl + (b) * 32768 + vst1) = sv1; *(bf16x8*)(Vl + (b) * 32768 + 16384 + vst0) = sv2; *(bf16x8*)(Vl + (b) * 32768 + 16384 + vst1) = sv3; } while (0)
#define A2_VMW(n) asm volatile("s_waitcnt vmcnt(%0)" :: "i"(n) : "memory")
#define A2_MASKMAX(PX, pmX, t) do { const int kb_ = (t) * 64 + 32 * kh; \
        if (kb_ + 31 > qlo) { const int dq_ = qlo + r32 - kb_ - 4 * hi; const float NEG_ = -__builtin_inff(); \
            _Pragma("unroll") for (int r = 0; r < 16; ++r) { const int c_ = (r & 3) + 8 * (r >> 2); if (dq_ - c_ < 0) PX[r] = NEG_; } } \
        pmX = rowmax16(PX); mxw[((t) & 1) * 512] = pmX; } while (0)
#define A2_FINISH(PY, pmY, alY, u) do { const float pm_ = fmaxf(pmY, mxr[((u) & 1) * 512]); float mn_; \
        if (__builtin_expect(__all((pm_ - m_reg) * SCALE <= THR), 1)) { mn_ = m_reg; alY = 1.f; } \
        else { mn_ = fmaxf(m_reg, pm_); alY = __builtin_amdgcn_exp2f((m_reg - mn_) * C2); m_reg = mn_; } \
        const float mnL_ = -mn_ * C2; \
        _Pragma("unroll") for (int r = 0; r < 16; ++r) PY[r] = __builtin_amdgcn_exp2f(fmaf(PY[r], C2, mnL_)); \
        float ps_ = 0.f; _Pragma("unroll") for (int r = 0; r < 16; ++r) ps_ += PY[r]; \
        { auto rr_ = __builtin_amdgcn_permlane32_swap(__float_as_uint(ps_), __float_as_uint(ps_), false, false); ps_ = __uint_as_float(rr_[0]) + __uint_as_float(rr_[1]); } \
        l_reg = l_reg * alY + ps_; \
        A2_PK4(PY, 0, pxw); A2_PK4(PY, 8, pxw + 1024); } while (0)
#define A2_PK4(P, B_, DST) do { unsigned a0_ = att::cvtpk(P[B_ + 0], P[B_ + 1]), a1_ = att::cvtpk(P[B_ + 2], P[B_ + 3]), b0_ = att::cvtpk(P[B_ + 4], P[B_ + 5]), b1_ = att::cvtpk(P[B_ + 6], P[B_ + 7]); \
        auto r0_ = __builtin_amdgcn_permlane32_swap(a0_, b0_, false, false); auto r1_ = __builtin_amdgcn_permlane32_swap(a1_, b1_, false, false); \
        u32x4 w_ = {r0_[0], r1_[0], r0_[1], r1_[1]}; *(u32x4*)(DST) = w_; } while (0)
#define A2_PVSTEP(alY, VOFFB) do { const bf16x8 pa0_ = *reinterpret_cast<const bf16x8*>(pxr), pa1_ = *reinterpret_cast<const bf16x8*>(pxr + 1024), pa2_ = *reinterpret_cast<const bf16x8*>(pxr + 2048), pa3_ = *reinterpret_cast<const bf16x8*>(pxr + 3072); \
        if (__any((alY) < 1.f)) { if (hi == 0) al_l[r32] = (alY); asm volatile("s_waitcnt lgkmcnt(0)" ::: "memory"); \
            _Pragma("unroll") for (int d_ = 0; d_ < 4; ++d_) _Pragma("unroll") for (int r = 0; r < 16; ++r) o[d_][r] *= al_l[att::crow(r, hi)]; } \
        pv<VOFFB>(o, vb0, pa0_, pa1_, pa2_, pa3_); } while (0)
#define A2_STEP(PX, pmX, PY, pmY, alY, t, KB) do { \
        if ((t) + 1 < NT) { A2_VMW(4); A2_WRITEK(1 - KB); if ((t) + 2 < NT) A2_LOADK((t) + 2); } A2_SBAR(); \
        qkt<KB>(PX, Kl, krow, hi, qr); \
        A2_FINISH(PY, pmY, alY, (t) - 1); \
        A2_MASKMAX(PX, pmX, t); \
        A2_BAR(); \
        if ((t) + 2 < NT) A2_VMW(2); else A2_VMW(0); \
        A2_WRITEV(KB); if ((t) + 1 < NT) A2_LOADV((t) + 1); A2_SBAR(); \
        A2_PVSTEP(alY, (1 - KB) * 32768); \
        A2_BAR(); } while (0)
    float m_reg = -1e30f, l_reg = 0.f; f32x16 o[4] = {};
    f32x16 pA, pB; float pmA, pmB, alA = 1.f, alB = 1.f;
    A2_LOADK(0); A2_VMW(0); A2_WRITEK(0); A2_LOADK(1); A2_LOADV(0);
    A2_BAR();
    if (hf == 1) A2_BAR();
    A2_VMW(4); A2_WRITEK(1); if (2 < NT) A2_LOADK(2); A2_SBAR();
    qkt<0>(pA, Kl, krow, hi, qr); A2_SBAR();
    A2_MASKMAX(pA, pmA, 0);
    A2_BAR();
    if (2 < NT) A2_VMW(2); else A2_VMW(0);
    A2_WRITEV(0); A2_LOADV(1);
    A2_BAR();
    A2_STEP(pB, pmB, pA, pmA, alA, 1, 1);
    for (int t = 2; t < NT; t += 2) {
        A2_STEP(pA, pmA, pB, pmB, alB, t, 0);
        A2_STEP(pB, pmB, pA, pmA, alA, t + 1, 1);
    }
    A2_FINISH(pB, pmB, alB, NT - 1);
    A2_BAR();
    A2_PVSTEP(alB, 32768);
    if (hf == 0) A2_BAR();
    if (hi == 0) li_l[r32] = l_reg;
    A2_BAR();
    float rli[16];
#pragma unroll
    for (int r = 0; r < 16; ++r) rli[r] = __builtin_amdgcn_rcpf(li_l[att::crow(r, hi)] + li_p[att::crow(r, hi)]);
    float* Ow = (kh ? O1 : O0) + (size_t)(32 * rg) * 128;
#pragma unroll
    for (int r = 0; r < 16; ++r) { const int orow = att::crow(r, hi);
#pragma unroll
        for (int d0 = 0; d0 < 4; ++d0) Ow[(size_t)orow * 128 + d0 * 32 + r32] = o[d0][r] * rli[r]; }
    A2_BAR();
#undef A2_LOADK
#undef A2_LOADV
#undef A2_BAR
#undef A2_WRITEK
#undef A2_WRITEV
#undef A2_VMW
#undef A2_MASKMAX
#undef A2_FINISH
#undef A2_PK4
#undef A2_PVSTEP
#undef A2_STEP
}
#undef A2_KSWZ
#undef A2_SBAR
}

#ifndef MK_PER_PHASE
#define MK_PER_PHASE 0
#endif
constexpr int NWAVES = 8, NTHR = 512;
constexpr int SEQ = 16384, DM = 4096, FFH = 11008, DEPTH = 4, NMODV = 6 * DM;
#ifndef PADK
#define PADK 64
#endif
constexpr int LDD = DM + PADK, LDF = FFH + PADK;
constexpr int ZG = 96;
constexpr size_t GS = (size_t)SEQ * 128;
constexpr int S5T = 64, S5NC = SEQ / S5T;
constexpr int KSL = 16;
constexpr float NORM_EPS = 1e-6f, SUBLN_EPS = 1e-5f;
constexpr int N_PHASES = 35;

constexpr size_t MiB = 1u << 20;
constexpr size_t WS_CTL = 0, CTL_ZERO_BYTES = 64 * 1024;
constexpr size_t WS_MODP = 1 * MiB;
constexpr size_t WS_MODL = 3 * MiB;
constexpr size_t WS_LAM = 3 * MiB + 512 * 1024;
constexpr size_t WS_S5P = 4 * MiB, S5P_LAYER = 4 * MiB + 256 * 1024;
constexpr size_t S5P_ABR = 0, S5P_ABI = 64 * 1024, S5P_ATR = 128 * 1024, S5P_ATI = 192 * 1024, S5P_BBR = 256 * 1024, S5P_BBI = 256 * 1024 + MiB;
constexpr size_t S5P_BBOP = 256 * 1024 + 2 * MiB, S5P_COP = 256 * 1024 + 3 * MiB;
#ifndef S5_MFMA
#define S5_MFMA 1
#endif
constexpr size_t W_IN_B = (size_t)12288 * LDD * 2, W_OUT_B = (size_t)4096 * LDD * 2, W_GLU_B = (size_t)8192 * LDD * 2, W_GU_B = (size_t)22016 * LDD * 2, W_DN_B = (size_t)4096 * LDF * 2;
constexpr size_t WS_WIN = 16 * MiB, WS_WOUT = WS_WIN + 2 * W_IN_B, WS_WGLU = WS_WOUT + 2 * W_OUT_B, WS_WGU = WS_WGLU + 2 * W_GLU_B, WS_WDN = WS_WGU + 4 * W_GU_B;
constexpr size_t WS_H = WS_WDN + 4 * W_DN_B;
constexpr size_t WS_MIX = WS_H + (size_t)SEQ * LDD * 2;
constexpr size_t WS_Z = WS_MIX + (size_t)SEQ * LDD * 2;
constexpr size_t WS_OT = WS_Z + (size_t)ZG * GS * 2;
constexpr size_t WS_S5F = WS_OT + (size_t)32 * GS * 4;
constexpr size_t WS_S5H = WS_S5F + (size_t)S5NC * 256 * 128 * 4;
constexpr size_t WS_END = WS_S5H + (size_t)S5NC * 256 * 128 * 4;
static_assert((size_t)SEQ * LDF * 2 <= (size_t)ZG * GS * 2, "hidden overlays Z");
static_assert(WS_WIN % 256 == 0 && WS_H % 256 == 0 && WS_OT % 256 == 0 && WS_S5F % 256 == 0, "alignment");
constexpr int CW_BAR = 1024;

constexpr int RING_BYTES = 131072, MISC_OFF = RING_BYTES + 320, LDS_BYTES = 147456;

#define GAS __attribute__((address_space(1)))
#define LAS __attribute__((address_space(3)))
typedef unsigned short bf16;
typedef unsigned v4u __attribute__((ext_vector_type(4)));
typedef unsigned v2u __attribute__((ext_vector_type(2)));
typedef float f32x4 __attribute__((ext_vector_type(4)));
#define LDS_WAIT() asm volatile("s_waitcnt lgkmcnt(0)" ::: "memory")
#define VM_WAIT() asm volatile("s_waitcnt vmcnt(0)" ::: "memory")
__device__ __forceinline__ unsigned pk2(float lo, float hi) { unsigned r; asm volatile("v_cvt_pk_bf16_f32 %0, %1, %2" : "=v"(r) : "v"(lo), "v"(hi)); return r; }
__device__ __forceinline__ float bflo(unsigned w) { return __builtin_bit_cast(float, w << 16); }
__device__ __forceinline__ float bfhi(unsigned w) { return __builtin_bit_cast(float, w & 0xffff0000u); }

#define XB_TMO      128
#define XB_XCNT(j)  (256  + 64 * (j))
#define XB_XSUB(j)  (1280 + 64 * (j))
#define XB_XGEN(j)  (2304 + 64 * (j))
#define XB_TOP      3328
#define XB_TOPGEN   3392
#define XCD_BAR_WORDS 3456
#define XB_SPIN_CAP (1u << 22)

__device__ __forceinline__ unsigned xb_ld(unsigned* p)              { return __hip_atomic_load(p, __ATOMIC_RELAXED, __HIP_MEMORY_SCOPE_AGENT); }
__device__ __forceinline__ unsigned xb_add(unsigned* p, unsigned v) { return __hip_atomic_fetch_add(p, v, __ATOMIC_RELAXED, __HIP_MEMORY_SCOPE_AGENT); }
__device__ __forceinline__ unsigned xb_xcc_id() { return (unsigned)__builtin_amdgcn_s_getreg((3 << 11) | 20) & 0xFu; }
#define XB_SPIN(cond, bar) do { unsigned _sp = 0; while (cond) { __builtin_amdgcn_s_sleep(1); \
    if ((++_sp & 255u) == 0u) { if (xb_ld(&(bar)[XB_TMO])) break; if (_sp > XB_SPIN_CAP) { atomicAdd(&(bar)[XB_TMO], 1u); break; } } } } while (0)

struct XcdBarrier {
    unsigned* bar; unsigned x;
    volatile LAS unsigned* st;
};
__device__ __forceinline__ XcdBarrier xcd_barrier_post(unsigned* bar, volatile LAS unsigned* st) {
    XcdBarrier b; b.bar = bar; b.x = xb_xcc_id(); b.st = st;
    if (threadIdx.x == 0) (void)xb_add(&bar[XB_XCNT(b.x)], 1u);
    return b;
}
__device__ __forceinline__ void xcd_barrier_complete(unsigned* bar, unsigned x, unsigned& nloc, unsigned& nx) {
    const unsigned G = gridDim.x * gridDim.y * gridDim.z;
    unsigned sum, cnt, mine, sp = 0u;
    for (;;) {
        sum = 0u; cnt = 0u; mine = 0u;
#pragma unroll
        for (unsigned j = 0; j < 16; ++j) { const unsigned c = xb_ld(&bar[XB_XCNT(j)]); sum += c; cnt += (c > 0u) ? 1u : 0u; mine = (j == x) ? c : mine; }
        if (sum == G) break;
        __builtin_amdgcn_s_sleep(1);
        if ((++sp & 255u) == 0u) { if (xb_ld(&bar[XB_TMO])) break; if (sp > XB_SPIN_CAP) { atomicAdd(&bar[XB_TMO], 1u); break; } }
    }
    nloc = mine > 0u ? mine : 1u; nx = cnt > 0u ? cnt : 1u;
}
__device__ __forceinline__ void xcd_barrier(const XcdBarrier& b) {
    asm volatile("s_waitcnt vmcnt(0)" ::: "memory");
    __syncthreads();
    if (threadIdx.x == 0) {
        unsigned* bar = b.bar;
        __builtin_amdgcn_s_waitcnt(0);
        unsigned nloc = b.st[0], nx = b.st[1];
        if (nloc == 0u) { xcd_barrier_complete(bar, b.x, nloc, nx); b.st[0] = nloc; b.st[1] = nx; }
        const unsigned old = xb_add(&bar[XB_XSUB(b.x)], 1u);
        const unsigned gen = old / nloc;
        if (old + 1u == (gen + 1u) * nloc) {
            __builtin_amdgcn_fence(__ATOMIC_RELEASE, "agent");
            asm volatile("s_waitcnt vmcnt(0)" ::: "memory");
            const unsigned og = xb_add(&bar[XB_TOP], 1u);
            const unsigned tg = og / nx;
            if (og + 1u == (tg + 1u) * nx) xb_add(&bar[XB_TOPGEN], 1u);
            else XB_SPIN(xb_ld(&bar[XB_TOPGEN]) == tg, bar);
            __builtin_amdgcn_fence(__ATOMIC_ACQUIRE, "agent");
            xb_add(&bar[XB_XGEN(b.x)], 1u);
            asm volatile("s_waitcnt vmcnt(0)" ::: "memory");
        } else {
            XB_SPIN(xb_ld(&bar[XB_XGEN(b.x)]) == gen, bar);
            __builtin_amdgcn_fence(__ATOMIC_ACQUIRE, "agent");
            asm volatile("s_waitcnt vmcnt(0)" ::: "memory");
        }
    }
    __syncthreads();
}

__device__ __forceinline__ float wave_sum(float v) {
#pragma unroll
    for (int o = 1; o < 64; o <<= 1) v += __shfl_xor(v, o);
    return v;
}

__device__ __forceinline__ void transpose_item(const float* W, int K, int N, bf16* WT, int ldw, int mode, LAS float* scr, int item, int lane) {
    const int nblk = N / 32, kb = item / nblk, nb = item - kb * nblk, k0 = 64 * kb, n0 = 32 * nb;
    const int drow0 = mode == 0 ? n0 : ((n0 >> 7) * 256 + (n0 & 127) + (mode == 2 ? 128 : 0));
#pragma unroll 8
    for (int i = 0; i < 32; ++i) { const int kk = 2 * i + (lane >> 5); scr[kk * 33 + (lane & 31)] = W[(size_t)(k0 + kk) * N + n0 + (lane & 31)]; }
    LDS_WAIT(); asm volatile("" ::: "memory");
    const int c = lane & 7;
#pragma unroll
    for (int j = 0; j < 4; ++j) { const int n = (lane >> 3) + 8 * j; const LAS float* s = scr + (8 * c) * 33 + n;
        v4u o; o.x = pk2(s[0 * 33], s[1 * 33]); o.y = pk2(s[2 * 33], s[3 * 33]); o.z = pk2(s[4 * 33], s[5 * 33]); o.w = pk2(s[6 * 33], s[7 * 33]);
        *(v4u*)(WT + (size_t)(drow0 + n) * ldw + k0 + 8 * c) = o; }
    LDS_WAIT(); asm volatile("" ::: "memory");
}
__device__ __forceinline__ void dsincos(double x, double& s, double& c) {
    const double k = rint(x * 0.63661977236758134308);
    double r = fma(-k, 1.5707963267948966192, x); r = fma(-k, 6.1232339957367658860e-17, r);
    const double r2 = r * r;
    double ps = -1.0 / 1307674368000.0; ps = fma(ps, r2, 1.0 / 6227020800.0); ps = fma(ps, r2, -1.0 / 39916800.0); ps = fma(ps, r2, 1.0 / 362880.0); ps = fma(ps, r2, -1.0 / 5040.0);
    ps = fma(ps, r2, 1.0 / 120.0); ps = fma(ps, r2, -1.0 / 6.0); ps = fma(ps, r2, 1.0); const double sn = r * ps;
    double pc = 1.0 / 20922789888000.0; pc = fma(pc, r2, -1.0 / 87178291200.0); pc = fma(pc, r2, 1.0 / 479001600.0); pc = fma(pc, r2, -1.0 / 3628800.0); pc = fma(pc, r2, 1.0 / 40320.0);
    pc = fma(pc, r2, -1.0 / 720.0); pc = fma(pc, r2, 1.0 / 24.0); pc = fma(pc, r2, -0.5); const double cs = fma(pc, r2, 1.0);
    const int q = (int)k & 3;
    s = (q == 0) ? sn : (q == 1) ? cs : (q == 2) ? -sn : -cs;
    c = (q == 0) ? cs : (q == 1) ? -sn : (q == 2) ? -cs : sn;
}
__device__ __forceinline__ double dexp(double x) {
    const double k = rint(x * 1.4426950408889634074);
    double r = fma(-k, 0.69314718055994528623, x); r = fma(-k, 2.3190468138462995584e-17, r);
    double p = 1.0 / 87178291200.0; p = fma(p, r, 1.0 / 6227020800.0); p = fma(p, r, 1.0 / 479001600.0); p = fma(p, r, 1.0 / 39916800.0); p = fma(p, r, 1.0 / 3628800.0); p = fma(p, r, 1.0 / 362880.0);
    p = fma(p, r, 1.0 / 40320.0); p = fma(p, r, 1.0 / 5040.0); p = fma(p, r, 1.0 / 720.0); p = fma(p, r, 1.0 / 120.0); p = fma(p, r, 1.0 / 24.0); p = fma(p, r, 1.0 / 6.0); p = fma(p, r, 0.5); p = fma(p, r, 1.0); p = fma(p, r, 1.0);
    const long long bits = (long long)(1023 + (int)k) << 52;
    return p * __builtin_bit_cast(double, bits);
}

struct Args { const float* in[29]; float* out; unsigned char* ws; int ph_lo, ph_hi; };

__device__ __forceinline__ void p0_prologue(const Args& A, LAS unsigned char* lds, int gw, int NGW, int wave, int lane) {
    unsigned char* ws = A.ws;
    for (int w = gw; w < 96 * KSL + 512 + 2048; w += NGW) {
    if (w >= 96 * KSL + 512) {
        const int idx = (w - 96 * KSL - 512) * 64 + lane, o = idx >> 16, r = idx & 65535, g = r >> 8, mm = (r >> 6) & 3, o16 = lane & 15, kq = lane >> 4;
        const int tau = 2 * mm, p0 = 16 * (tau & 3) + 4 * kq;
        const float* cs = (tau < 4 ? A.in[21] : A.in[22]) + (size_t)o * 256 * 16 * 64 + (size_t)(g * 16 + o16) * 64 + p0; const float sg = tau < 4 ? 1.0f : -1.0f;
        const f32x4 a = *(const f32x4*)cs * sg, b = *(const f32x4*)(cs + 16) * sg;
        v4u q; q.x = pk2(a.x, a.y); q.y = pk2(a.z, a.w); q.z = pk2(b.x, b.y); q.w = pk2(b.z, b.w);
        *(v4u*)(ws + WS_S5P + (size_t)o * S5P_LAYER + S5P_COP + ((size_t)((g * 4 + mm) * 64 + lane)) * 16) = q;
    } else if (w < 96 * KSL) {
        const int nb = w % 96, ks = w / 96;
        const float* wp = A.in[2] + (size_t)(ks * 256) * NMODV + nb * 256 + lane * 4; const float* cp = A.in[1] + ks * 256;
        f32x4 a = {0.f, 0.f, 0.f, 0.f};
#pragma unroll 8
        for (int k = 0; k < 256; ++k) { const float cv = cp[k]; const float s = cv / (1.0f + expf(-cv)); const f32x4 w = *(const f32x4*)(wp + (size_t)k * NMODV); a += s * w; }
        *(f32x4*)((float*)(ws + WS_MODP) + (size_t)ks * NMODV + nb * 256 + lane * 4) = a;
    } else {
        const int idx = (w - 96 * KSL) * 64 + lane, o = idx >> 14, gp = idx & 16383, g = gp >> 6;
        const double lr = (double)fminf(A.in[16][idx], -1e-4f), li = (double)A.in[17][idx], dt = dexp((double)A.in[18][o * 256 + g]);
        const double mag = dexp(lr * dt); double sn, cs; dsincos(li * dt, sn, cs);
        const double abr = mag * cs, abi = mag * sn, den = lr * lr + li * li, nr = abr - 1.0, ni = abi;
        const double fre = (nr * lr + ni * li) / den, fim = (ni * lr - nr * li) / den;
        double tr = abr, ti = abi;
#pragma unroll
        for (int q = 0; q < 6; ++q) { const double t2 = tr * tr - ti * ti; ti = 2.0 * tr * ti; tr = t2; }
        unsigned char* pb = ws + WS_S5P + (size_t)o * S5P_LAYER;
        ((float*)(pb + S5P_ABR))[gp] = (float)abr; ((float*)(pb + S5P_ABI))[gp] = (float)abi; ((float*)(pb + S5P_ATR))[gp] = (float)tr; ((float*)(pb + S5P_ATI))[gp] = (float)ti;
        const float* bre = A.in[19] + (size_t)idx * 16; const float* bim = A.in[20] + (size_t)idx * 16;
        float* obr = (float*)(pb + S5P_BBR) + (size_t)gp * 16; float* obi = (float*)(pb + S5P_BBI) + (size_t)gp * 16;
#pragma unroll
        for (int h4 = 0; h4 < 4; ++h4) { const f32x4 br = *(const f32x4*)(bre + 4 * h4), bi = *(const f32x4*)(bim + 4 * h4); f32x4 r, i;
#pragma unroll
            for (int j = 0; j < 4; ++j) { r[j] = (float)(fre * (double)br[j] - fim * (double)bi[j]); i[j] = (float)(fre * (double)bi[j] + fim * (double)br[j]); }
            *(f32x4*)(obr + 4 * h4) = r; *(f32x4*)(obi + 4 * h4) = i; }
        { const int p = gp & 63, ti = p >> 4, i16 = p & 15;
#pragma unroll
          for (int kq = 0; kq < 4; ++kq) { const f32x4 r = *(const f32x4*)(obr + 4 * kq), i = *(const f32x4*)(obi + 4 * kq);
              v2u pr, pi; pr.x = pk2(r.x, r.y); pr.y = pk2(r.z, r.w); pi.x = pk2(i.x, i.y); pi.y = pk2(i.z, i.w);
              *(v2u*)(pb + S5P_BBOP + ((size_t)((g * 8 + ti) * 64 + kq * 16 + i16)) * 8) = pr; *(v2u*)(pb + S5P_BBOP + ((size_t)((g * 8 + 4 + ti) * 64 + kq * 16 + i16)) * 8) = pi; } }
    }
    }
    if (gw < 2) { const int e = gw;
        const float s1 = wave_sum(A.in[10][e * 128 + lane] * A.in[11][e * 128 + lane] + A.in[10][e * 128 + 64 + lane] * A.in[11][e * 128 + 64 + lane]);
        const float s2 = wave_sum(A.in[12][e * 128 + lane] * A.in[13][e * 128 + lane] + A.in[12][e * 128 + 64 + lane] * A.in[13][e * 128 + 64 + lane]);
        const float lam_init = e == 0 ? 0.2f : 0.4707130183435842f;
        if (lane == 0) ((float*)(ws + WS_LAM))[e] = expf(s1) - expf(s2) + lam_init; }
    LAS float* scr = (LAS float*)(lds + wave * 16384);
    constexpr int I_IN = 64 * 384, I_OUT = 64 * 128, I_GLU = 64 * 128, I_GU = 64 * 344, I_DN = 172 * 128;
    constexpr int NITEMS = 2 * I_IN + 2 * I_OUT + 4 * I_GLU + 8 * I_GU + 4 * I_DN;
    for (int it = gw; it < NITEMS; it += NGW) {
        int r = it;
        if (r < 2 * I_IN) { const int e = r / I_IN; transpose_item(A.in[8] + (size_t)e * DM * 12288, DM, 12288, (bf16*)(ws + WS_WIN + e * W_IN_B), LDD, 0, scr, r - e * I_IN, lane); continue; } r -= 2 * I_IN;
        if (r < 2 * I_OUT) { const int e = r / I_OUT; transpose_item(A.in[15] + (size_t)e * DM * DM, DM, DM, (bf16*)(ws + WS_WOUT + e * W_OUT_B), LDD, 0, scr, r - e * I_OUT, lane); continue; } r -= 2 * I_OUT;
        if (r < 4 * I_GLU) { const int q = r / I_GLU, o = q >> 1, s = q & 1; transpose_item(A.in[24 + s] + (size_t)o * DM * DM, DM, DM, (bf16*)(ws + WS_WGLU + o * W_GLU_B), LDD, 1 + s, scr, r - q * I_GLU, lane); continue; } r -= 4 * I_GLU;
        if (r < 8 * I_GU) { const int q = r / I_GU, l = q >> 1, s = q & 1; transpose_item(A.in[26 + s] + (size_t)l * DM * FFH, DM, FFH, (bf16*)(ws + WS_WGU + l * W_GU_B), LDD, 1 + s, scr, r - q * I_GU, lane); continue; } r -= 8 * I_GU;
        { const int l = r / I_DN; transpose_item(A.in[28] + (size_t)l * FFH * DM, FFH, DM, (bf16*)(ws + WS_WDN + l * W_DN_B), LDF, 0, scr, r - l * I_DN, lane); }
    }
}
__device__ __forceinline__ void p1_modvec(const Args& A, int gtid, int NGT) {
    const float* mp = (const float*)(A.ws + WS_MODP); float* ml = (float*)(A.ws + WS_MODL);
    for (int i = gtid; i < DEPTH * NMODV; i += NGT) { const int j = i % NMODV; float v = A.in[3][j] + A.in[4][i];
#pragma unroll
        for (int ks = 0; ks < KSL; ++ks) v += mp[(size_t)ks * NMODV + j];
        ml[i] = v; }
}
__device__ __forceinline__ void norm_mod_phase(const float* src, const float* nw, const float* sh, const float* sc, bf16* dst, LAS unsigned char* lds, int tid, int gw, int NGW, int lane) {
    LAS float* w1 = (LAS float*)lds; LAS float* bb = w1 + DM;
    for (int i = tid; i < DM; i += NTHR) { w1[i] = nw[i] * (1.0f + sc[i]); bb[i] = sh[i]; }
    __syncthreads();
    for (int m = gw; m < SEQ; m += NGW) {
        const f32x4* xr = (const f32x4*)(src + (size_t)m * DM) + lane;
        f32x4 v[16]; float ss = 0.f;
#pragma unroll
        for (int j = 0; j < 16; ++j) { v[j] = xr[64 * j]; ss += (v[j].x * v[j].x + v[j].y * v[j].y) + (v[j].z * v[j].z + v[j].w * v[j].w); }
        const float rstd = 1.0f / sqrtf(wave_sum(ss) * (1.0f / DM) + NORM_EPS);
        v2u* o8 = (v2u*)(dst + (size_t)m * LDD) + lane;
#pragma unroll
        for (int j = 0; j < 16; ++j) { const int col = j * 256 + lane * 4; const f32x4 w = *(const LAS f32x4*)(w1 + col), b = *(const LAS f32x4*)(bb + col);
            const f32x4 y = v[j] * rstd * w + b; v2u p; p.x = pk2(y.x, y.y); p.y = pk2(y.z, y.w); o8[64 * j] = p; }
    }
    __syncthreads();
}
__device__ __forceinline__ void final_norm_phase(const float* src, const float* nw, float* dst, int gw, int NGW, int lane) {
    for (int m = gw; m < SEQ; m += NGW) {
        const f32x4* xr = (const f32x4*)(src + (size_t)m * DM) + lane;
        f32x4 v[16]; float ss = 0.f;
#pragma unroll
        for (int j = 0; j < 16; ++j) { v[j] = xr[64 * j]; ss += (v[j].x * v[j].x + v[j].y * v[j].y) + (v[j].z * v[j].z + v[j].w * v[j].w); }
        const float rstd = 1.0f / sqrtf(wave_sum(ss) * (1.0f / DM) + NORM_EPS);
        f32x4* o = (f32x4*)(dst + (size_t)m * DM) + lane; const f32x4* wv = (const f32x4*)nw + lane;
#pragma unroll
        for (int j = 0; j < 16; ++j) o[64 * j] = v[j] * rstd * wv[64 * j];
    }
}
__device__ __forceinline__ void conv_phase(const bf16* Z, const float* cw, bf16* MIX, int gtid, int NGT) {
    for (int i = gtid; i < SEQ * 256; i += NGT) {
        const int t = i >> 8, r = i & 255, gi = r >> 4, c8 = (r & 15) * 8;
        const size_t o = (size_t)t * 128 + c8;
        const v4u zero = {0u, 0u, 0u, 0u};
        const v4u vb = *(const v4u*)(Z + (size_t)gi * GS + o);
        const bf16* zc = Z + (size_t)(16 + gi) * GS + o; const bf16* zx = Z + (size_t)(32 + gi) * GS + o;
        const v4u c0 = *(const v4u*)zc, x0 = *(const v4u*)zx;
        const v4u c1 = t >= 1 ? *(const v4u*)(zc - 128) : zero, x1 = t >= 1 ? *(const v4u*)(zx - 128) : zero;
        const v4u c2 = t >= 2 ? *(const v4u*)(zc - 256) : zero, x2 = t >= 2 ? *(const v4u*)(zx - 256) : zero;
        const float* wp = cw + gi * 128 + c8;
        float y[8];
#pragma unroll
        for (int q = 0; q < 4; ++q) {
            const float u0l = bflo(c0[q]) * bflo(x0[q]), u0h = bfhi(c0[q]) * bfhi(x0[q]);
            const float u1l = bflo(c1[q]) * bflo(x1[q]), u1h = bfhi(c1[q]) * bfhi(x1[q]);
            const float u2l = bflo(c2[q]) * bflo(x2[q]), u2h = bfhi(c2[q]) * bfhi(x2[q]);
            const int j = 2 * q;
            y[j]     = bflo(vb[q]) * (wp[2 * 2048 + j] * u0l + wp[2048 + j] * u1l + wp[j] * u2l);
            y[j + 1] = bfhi(vb[q]) * (wp[2 * 2048 + j + 1] * u0h + wp[2048 + j + 1] * u1h + wp[j + 1] * u2h);
        }
        v4u w; w.x = pk2(y[0], y[1]); w.y = pk2(y[2], y[3]); w.z = pk2(y[4], y[5]); w.w = pk2(y[6], y[7]);
        *(v4u*)(MIX + (size_t)t * LDD + gi * 128 + c8) = w;
    }
}
__device__ __forceinline__ void combine_phase(const float* OT, const float* lamp, const float* sg, float lam_init, bf16* MIX, int gw, int NGW, int lane) {
    const float lam = lamp[0], os = 1.0f - lam_init;
    const int j = lane >> 5, c4 = (lane & 31) * 4;
    const f32x4 gv = *(const f32x4*)(sg + 128 * j + c4);
    for (int it0 = gw * 4; it0 < SEQ * 8; it0 += NGW * 4) {
        f32x4 a[4], b[4];
#pragma unroll
        for (int q = 0; q < 4; ++q) { const int it = it0 + q, t = it >> 3, h = it & 7;
            a[q] = *(const f32x4*)(OT + (size_t)(h * 4 + j) * GS + (size_t)t * 128 + c4); b[q] = *(const f32x4*)(OT + (size_t)(h * 4 + 2 + j) * GS + (size_t)t * 128 + c4); }
#pragma unroll
        for (int q = 0; q < 4; ++q) { const int it = it0 + q, t = it >> 3, h = it & 7;
            const f32x4 o = a[q] - lam * b[q];
            const float rstd = 1.0f / sqrtf(wave_sum((o.x * o.x + o.y * o.y) + (o.z * o.z + o.w * o.w)) * (1.0f / 256.0f) + SUBLN_EPS);
            const f32x4 y = o * (rstd * os) * gv;
            v2u p; p.x = pk2(y.x, y.y); p.y = pk2(y.z, y.w);
            *(v2u*)(MIX + (size_t)t * LDD + 2048 + 256 * h + 128 * j + c4) = p; }
    }
}
__device__ __forceinline__ att::BlockRef<att::bf16, float> att_ref(const bf16* Z, float* OT, int item, int pass) {
    const int r = item >> 8, b = item & 255, vh = r * 8 + (b & 7), pair = b >> 3, qb = pass ? 63 - pair : pair;
    const int h = vh >> 2, m = (vh >> 1) & 1, j = vh & 1;
    att::BlockRef<att::bf16, float> R;
    R.Q = (const att::bf16*)(Z + (size_t)(48 + 2 * h + m) * GS + (size_t)qb * 256 * 128);
    R.K = (const att::bf16*)(Z + (size_t)(64 + 2 * h + m) * GS);
    R.V = (const att::bf16*)(Z + (size_t)(80 + 2 * h + j) * GS);
    R.O = OT + (size_t)vh * GS + (size_t)qb * 256 * 128; R.P0 = qb * 256;
    return R;
}
__device__ __forceinline__ void attn_phase(const bf16* Z, float* OT, char* lds, int bid, int G) {
    constexpr int TOTAL = 1024;
    int item = bid; if (item >= TOTAL) return;
    int pass = 0;
    att::BlockRef<att::bf16, float> cur = att_ref(Z, OT, item, 0);
    att::Seam<att::bf16> S;
    att::causal_swa_prime<att::bf16, float>(cur, SEQ, lds, S);
    for (;;) {
        const bool more_pass = pass == 0, more_item = item + G < TOTAL, last = !more_pass && !more_item;
        int itn = item, passn = 1;
        if (!more_pass) { passn = 0; itn = more_item ? item + G : item; }
        const att::BlockRef<att::bf16, float> nxt = last ? cur : att_ref(Z, OT, itn, passn);
        att::causal_swa_block<att::bf16, float>(cur, nxt, SEQ, SEQ, lds, S);
        if (last) break;
        cur = nxt; item = itn; pass = passn;
    }
}
#ifndef ATT2
#define ATT2 1
#endif
template <bool DEG>
__device__ __forceinline__ void attn2_phase(const bf16* Z, float* OT, char* lds, int bid, int G) {
    for (int item = bid; item < 1024; item += G) {
        const int r = item >> 8, b = item & 255, hm = 2 * (b & 7) + (r >> 1), pair = (r & 1) * 32 + (b >> 3), h = hm >> 1, m = hm & 1;
        for (int pass = 0; pass < 2; ++pass) { const int qb = pass ? 127 - pair : pair;
            att2::block<DEG>(Z + (size_t)(48 + 2 * h + m) * GS + (size_t)qb * 128 * 128, Z + (size_t)(64 + 2 * h + m) * GS, Z + (size_t)(80 + 2 * h) * GS, Z + (size_t)(81 + 2 * h) * GS,
                        OT + (size_t)(h * 4 + m * 2) * GS + (size_t)qb * 128 * 128, OT + (size_t)(h * 4 + m * 2 + 1) * GS + (size_t)qb * 128 * 128, qb * 128, lds); }
    }
}
__device__ __forceinline__ float gelu_tanh(float x) { const float z = 1.5957691216057308f * (x + 0.044715f * x * x * x); return x * __builtin_amdgcn_rcpf(1.0f + __builtin_amdgcn_exp2f(-1.4426950408889634f * z)); }
template <bool PASS2>
__device__ __forceinline__ void s5_pass(const bf16* Hin, const unsigned char* prm, const float* c_re, const float* c_im, const float* dsk, float* F, const float* HC, bf16* Gout,
                                        LAS unsigned char* lds, int gw, int NGW, int wave, int lane) {
    LAS float* lu = (LAS float*)(lds + wave * 4096);
    for (int item = gw; item < 256 * S5NC; item += NGW) {
        const int g = item & 255, c = item >> 8, gp = g * 64 + lane;
        { const bf16* up = Hin + (size_t)(c * S5T + lane) * LDD + 16 * g; const v4u a = *(const v4u*)up, b = *(const v4u*)(up + 8);
          LAS f32x4* ur = (LAS f32x4*)(lu + lane * 16);
          ur[0] = (f32x4){bflo(a.x), bfhi(a.x), bflo(a.y), bfhi(a.y)}; ur[1] = (f32x4){bflo(a.z), bfhi(a.z), bflo(a.w), bfhi(a.w)};
          ur[2] = (f32x4){bflo(b.x), bfhi(b.x), bflo(b.y), bfhi(b.y)}; ur[3] = (f32x4){bflo(b.z), bfhi(b.z), bflo(b.w), bfhi(b.w)}; }
        f32x4 bbr[4], bbi[4];
#pragma unroll
        for (int q = 0; q < 4; ++q) { bbr[q] = *(const f32x4*)((const float*)(prm + S5P_BBR) + (size_t)gp * 16 + 4 * q); bbi[q] = *(const f32x4*)((const float*)(prm + S5P_BBI) + (size_t)gp * 16 + 4 * q); }
        const float abr = ((const float*)(prm + S5P_ABR))[gp], abi = ((const float*)(prm + S5P_ABI))[gp];
        float hr = 0.f, hi = 0.f, cr[16], ci[16], dk = 0.f;
        if (PASS2) {
#pragma unroll
            for (int o = 0; o < 16; ++o) { cr[o] = c_re[(size_t)(g * 16 + o) * 64 + lane]; ci[o] = c_im[(size_t)(g * 16 + o) * 64 + lane]; }
            hr = HC[(size_t)(c * 256 + g) * 128 + lane]; hi = HC[(size_t)(c * 256 + g) * 128 + 64 + lane]; dk = dsk[16 * g + (lane >> 2)];
        }
        LDS_WAIT(); asm volatile("" ::: "memory");
#pragma unroll 2
        for (int t = 0; t < S5T; ++t) {
            const LAS f32x4* ut = (const LAS f32x4*)(lu + t * 16);
            float bur = 0.f, bui = 0.f;
#pragma unroll
            for (int q = 0; q < 4; ++q) { const f32x4 u = ut[q];
                bur += (bbr[q].x * u.x + bbr[q].y * u.y) + (bbr[q].z * u.z + bbr[q].w * u.w); bui += (bbi[q].x * u.x + bbi[q].y * u.y) + (bbi[q].z * u.z + bbi[q].w * u.w); }
            const float nr = abr * hr - abi * hi + bur, ni = abr * hi + abi * hr + bui; hr = nr; hi = ni;
            if (PASS2) {
                float v[16];
#pragma unroll
                for (int o = 0; o < 16; ++o) v[o] = hr * cr[o] - hi * ci[o];
#pragma unroll
                for (int i = 0; i < 8; ++i) { const float send = (lane & 32) ? v[i] : v[i + 8], keep = (lane & 32) ? v[i + 8] : v[i]; v[i] = keep + __shfl_xor(send, 32); }
#pragma unroll
                for (int i = 0; i < 4; ++i) { const float send = (lane & 16) ? v[i] : v[i + 4], keep = (lane & 16) ? v[i + 4] : v[i]; v[i] = keep + __shfl_xor(send, 16); }
#pragma unroll
                for (int i = 0; i < 2; ++i) { const float send = (lane & 8) ? v[i] : v[i + 2], keep = (lane & 8) ? v[i + 2] : v[i]; v[i] = keep + __shfl_xor(send, 8); }
                { const float send = (lane & 4) ? v[0] : v[1], keep = (lane & 4) ? v[1] : v[0]; v[0] = keep + __shfl_xor(send, 4); }
                v[0] += __shfl_xor(v[0], 2); v[0] += __shfl_xor(v[0], 1);
                const float yy = v[0] + dk * lu[t * 16 + (lane >> 2)];
                const float gl = gelu_tanh(yy);
                if ((lane & 3) == 0) Gout[(size_t)(c * S5T + t) * LDD + 16 * g + (lane >> 2)] = (bf16)(pk2(gl, gl) & 0xffffu);
            }
        }
        if (!PASS2) { F[(size_t)(c * 256 + g) * 128 + lane] = hr; F[(size_t)(c * 256 + g) * 128 + 64 + lane] = hi; }
        LDS_WAIT(); asm volatile("" ::: "memory");
    }
}

constexpr int S5TS = 8, S5SB = S5TS * 256 + 16;
typedef short s5_bf16x8 __attribute__((ext_vector_type(8)));
template <bool PASS2>
__device__ __forceinline__ void s5m_pass(const bf16* Hin, const unsigned char* prm, const float* dsk, float* F, const float* HC, bf16* Gout, LAS unsigned char* lds, int bid, int G) {
    const int tid = opaque_tid(), lane = tid & 63, w = __builtin_amdgcn_readfirstlane(tid >> 6), j = lane & 15, rq = lane >> 4;
    const int rowslot = tid >> 4, piece = tid & 15;
    constexpr int NST = S5T / S5TS, NQ = 16 * S5TS / 32;
    for (int unit = bid; unit < 32 * (S5NC / 16); unit += G) {
        const int gb = unit & 31, cs = unit >> 5, g = gb * 8 + w;
        v2u bb[8];
#pragma unroll
        for (int t8 = 0; t8 < 8; ++t8) bb[t8] = *(const v2u*)(prm + S5P_BBOP + ((size_t)((g * 8 + t8) * 64 + lane)) * 8);
        v4u cop[4];
        f32x4 ar[4], ai[4], sr[4], si[4], dk = {0.f, 0.f, 0.f, 0.f};
#pragma unroll
        for (int q = 0; q < 4; ++q) { ar[q] = *(const f32x4*)((const float*)(prm + S5P_ABR) + g * 64 + 16 * q + 4 * rq); ai[q] = *(const f32x4*)((const float*)(prm + S5P_ABI) + g * 64 + 16 * q + 4 * rq); }
        if (PASS2) {
#pragma unroll
            for (int mm = 0; mm < 4; ++mm) cop[mm] = *(const v4u*)(prm + S5P_COP + ((size_t)((g * 4 + mm) * 64 + lane)) * 16);
            const float* hc = HC + ((size_t)(cs * 16 + j) * 256 + g) * 128 + 4 * rq;
#pragma unroll
            for (int q = 0; q < 4; ++q) { sr[q] = *(const f32x4*)(hc + 16 * q); si[q] = *(const f32x4*)(hc + 64 + 16 * q); }
            dk = *(const f32x4*)(dsk + 16 * g + 4 * rq);
        } else {
#pragma unroll
            for (int q = 0; q < 4; ++q) { sr[q] = (f32x4){0.f, 0.f, 0.f, 0.f}; si[q] = (f32x4){0.f, 0.f, 0.f, 0.f}; }
        }
        const bf16* src = Hin + (size_t)(cs * 16 * S5T) * LDD + gb * 128 + piece * 8;
        bf16* dstp = PASS2 ? Gout + (size_t)(cs * 16 * S5T) * LDD + gb * 128 + piece * 8 : nullptr;
        v4u pre[NQ];
#pragma unroll
        for (int q = 0; q < NQ; ++q) { const int ri = q * 32 + rowslot, jj = ri / S5TS, tt = ri % S5TS; pre[q] = *(const v4u*)(src + (size_t)(jj * S5T + tt) * LDD); }
        for (int s = 0; s < NST; ++s) {
#pragma unroll
            for (int q = 0; q < NQ; ++q) { const int ri = q * 32 + rowslot, jj = ri / S5TS, tt = ri % S5TS; LAS v4u* lp = (LAS v4u*)(lds + jj * S5SB + tt * 256 + piece * 16);
                if (PASS2 && s > 0) { const v4u y = *lp; *(v4u*)(dstp + (size_t)(jj * S5T + (s - 1) * S5TS + tt) * LDD) = y; }
                *lp = pre[q]; }
            if (s + 1 < NST) {
#pragma unroll
                for (int q = 0; q < NQ; ++q) { const int ri = q * 32 + rowslot, jj = ri / S5TS, tt = ri % S5TS; pre[q] = *(const v4u*)(src + (size_t)(jj * S5T + (s + 1) * S5TS + tt) * LDD); } }
            LDS_WAIT(); __syncthreads();
            LAS unsigned char* up = lds + j * S5SB + w * 32 + rq * 8;
            v2u uu[S5TS];
#pragma unroll
            for (int tt = 0; tt < S5TS; ++tt) uu[tt] = *(const LAS v2u*)(up + tt * 256);
#pragma unroll
            for (int tt = 0; tt < S5TS; ++tt) {
                v4u ub; ub.x = uu[tt].x; ub.y = uu[tt].y; ub.z = 0u; ub.w = 0u;
                const s5_bf16x8 U = __builtin_bit_cast(s5_bf16x8, ub);
#pragma unroll
                for (int q = 0; q < 4; ++q) {
                    const f32x4 tr = ar[q] * sr[q] - ai[q] * si[q], ti = ar[q] * si[q] + ai[q] * sr[q];
                    v4u a0; a0.x = bb[q].x; a0.y = bb[q].y; a0.z = 0u; a0.w = 0u; v4u a1; a1.x = bb[4 + q].x; a1.y = bb[4 + q].y; a1.z = 0u; a1.w = 0u;
                    sr[q] = __builtin_amdgcn_mfma_f32_16x16x32_bf16(__builtin_bit_cast(s5_bf16x8, a0), U, tr, 0, 0, 0);
                    si[q] = __builtin_amdgcn_mfma_f32_16x16x32_bf16(__builtin_bit_cast(s5_bf16x8, a1), U, ti, 0, 0, 0);
                }
                if (PASS2) {
                    f32x4 y = {0.f, 0.f, 0.f, 0.f};
#pragma unroll
                    for (int mm = 0; mm < 4; ++mm) { const f32x4 t0 = mm < 2 ? sr[2 * mm] : si[2 * mm - 4], t1 = mm < 2 ? sr[2 * mm + 1] : si[2 * mm - 3];
                        v4u sb; sb.x = pk2(t0.x, t0.y); sb.y = pk2(t0.z, t0.w); sb.z = pk2(t1.x, t1.y); sb.w = pk2(t1.z, t1.w);
                        y = __builtin_amdgcn_mfma_f32_16x16x32_bf16(__builtin_bit_cast(s5_bf16x8, cop[mm]), __builtin_bit_cast(s5_bf16x8, sb), y, 0, 0, 0); }
                    const f32x4 uf = {bflo(uu[tt].x), bfhi(uu[tt].x), bflo(uu[tt].y), bfhi(uu[tt].y)};
                    const f32x4 yy = y + dk * uf;
                    v2u o; o.x = pk2(gelu_tanh(yy.x), gelu_tanh(yy.y)); o.y = pk2(gelu_tanh(yy.z), gelu_tanh(yy.w));
                    *(LAS v2u*)(up + tt * 256) = o;
                }
            }
            LDS_WAIT(); __syncthreads();
        }
        if (PASS2) {
#pragma unroll
            for (int q = 0; q < NQ; ++q) { const int ri = q * 32 + rowslot, jj = ri / S5TS, tt = ri % S5TS; const v4u y = *(const LAS v4u*)(lds + jj * S5SB + tt * 256 + piece * 16);
                *(v4u*)(dstp + (size_t)(jj * S5T + (NST - 1) * S5TS + tt) * LDD) = y; }
            LDS_WAIT();
        } else {
            float* fo = F + ((size_t)(cs * 16 + j) * 256 + g) * 128 + 4 * rq;
#pragma unroll
            for (int q = 0; q < 4; ++q) { *(f32x4*)(fo + 16 * q) = sr[q]; *(f32x4*)(fo + 64 + 16 * q) = si[q]; }
        }
    }
}
__device__ __forceinline__ void s5_carry(const unsigned char* prm, const float* F, float* HC, int bid, int G, int wave, int lane) {
    if (wave != 0) return;
    for (int g = bid; g < 256; g += G) {
        const int p = lane, gp = g * 64 + p;
        const float atr = ((const float*)(prm + S5P_ATR))[gp], ati = ((const float*)(prm + S5P_ATI))[gp];
        float hr = 0.f, hi = 0.f;
        for (int c0 = 0; c0 < S5NC; c0 += 32) {
            float fr[32], fi[32];
#pragma unroll
            for (int q = 0; q < 32; ++q) { const size_t o = (size_t)((c0 + q) * 256 + g) * 128 + p; fr[q] = F[o]; fi[q] = F[o + 64]; }
#pragma unroll
            for (int q = 0; q < 32; ++q) { const size_t o = (size_t)((c0 + q) * 256 + g) * 128 + p;
                HC[o] = hr; HC[o + 64] = hi;
                const float nr = atr * hr - ati * hi + fr[q], ni = atr * hi + ati * hr + fi[q]; hr = nr; hi = ni; }
        }
    }
}

struct Ctx { int lo, hi, tid, lane, wave, gw, NGW, gtid, NGT, G, bid; };
#ifndef WGM_IN
#define WGM_IN 8
#endif
#ifndef WGM_OUT
#define WGM_OUT 2
#endif
#ifndef WGM_GLU
#define WGM_GLU 4
#endif
#ifndef WGM_F1
#define WGM_F1 8
#endif
#ifndef WGM_F2
#define WGM_F2 2
#endif
#ifndef DUP_ATTN
#define DUP_ATTN 0
#endif
#ifndef DUP_S5
#define DUP_S5 0
#endif
#ifndef DUP_FFN1
#define DUP_FFN1 0
#endif
#ifndef DUP_FFN2
#define DUP_FFN2 0
#endif
#ifndef DUP_INP
#define DUP_INP 0
#endif
#ifndef DUP_PRO
#define DUP_PRO 0
#endif
#define IN(k) (lo <= (k) && (k) < hi)
#define SEAM(k) do { if (IN(k) && IN((k) + 1)) xcd_barrier(bar); } while (0)
#define FFN_PHASES(l, pb) do { \
    const float* ml_ = MODL + (size_t)(l) * NMODV; \
    if (IN((pb) + 5)) norm_mod_phase(XR, args.in[6] + (size_t)(l) * DM, ml_ + 3 * DM, ml_ + 4 * DM, Hb, lds, tid, gw, NGW, lane); \
    SEAM((pb) + 5); \
    if (IN((pb) + 6)) { pg8::Gemm g{Hb, (const bf16*)(ws + WS_WGU + (size_t)(l) * W_GU_B), SEQ, 2 * FFH, DM, LDD, LDD}; pg8::StaticOrder S; S.init(SEQ, 2 * FFH, G, bid, WGM_F1); \
        pg8::EpiSwiGLU E{HID, LDF}; pg8::gemm_phase<pg8::EpiSwiGLU, pg8::StaticOrder, true, true>(lds, g, S, E); } \
    if (DUP_FFN1 && IN((pb) + 6)) { xcd_barrier(bar); pg8::Gemm g{Hb, (const bf16*)(ws + WS_WGU + (size_t)(l) * W_GU_B), SEQ, 2 * FFH, DM, LDD, LDD}; pg8::StaticOrder S; S.init(SEQ, 2 * FFH, G, bid, WGM_F1); \
        pg8::EpiSwiGLU E{HID, LDF}; pg8::gemm_phase<pg8::EpiSwiGLU, pg8::StaticOrder, true, true>(lds, g, S, E); } \
    SEAM((pb) + 6); \
    if (DUP_FFN2 && IN((pb) + 7)) { xcd_barrier(bar); pg8::Gemm g{HID, (const bf16*)(ws + WS_WDN + (size_t)(l) * W_DN_B), SEQ, DM, FFH, LDF, LDF}; pg8::StaticOrder S; S.init(SEQ, DM, G, bid, WGM_F2); \
        pg8::EpiResid E{XR, (float*)(ws + WS_OT), ml_ + 5 * DM, DM}; pg8::gemm_phase<pg8::EpiResid, pg8::StaticOrder, true, true>(lds, g, S, E); } \
    if (IN((pb) + 7)) { pg8::Gemm g{HID, (const bf16*)(ws + WS_WDN + (size_t)(l) * W_DN_B), SEQ, DM, FFH, LDF, LDF}; pg8::StaticOrder S; S.init(SEQ, DM, G, bid, WGM_F2); \
        pg8::EpiResid E{XR, XR, ml_ + 5 * DM, DM}; pg8::gemm_phase<pg8::EpiResid, pg8::StaticOrder, true, true>(lds, g, S, E); } \
    SEAM((pb) + 7); } while (0)
template <int lp>
__device__ __forceinline__ void layer_pair(const Args& args, const Ctx& C, LAS unsigned char* lds, unsigned char* lds_raw, const XcdBarrier& bar) {
    const int lo = C.lo, hi = C.hi, tid = C.tid, lane = C.lane, wave = C.wave, gw = C.gw, NGW = C.NGW, gtid = C.gtid, NGT = C.NGT, G = C.G, bid = C.bid;
    unsigned char* ws = args.ws;
    bf16* const Hb = (bf16*)(ws + WS_H); bf16* const MIX = (bf16*)(ws + WS_MIX); bf16* const Z = (bf16*)(ws + WS_Z); bf16* const HID = (bf16*)(ws + WS_Z);
    float* const OT = (float*)(ws + WS_OT); float* const XR = args.out;
    const float* const MODL = (const float*)(ws + WS_MODL);
        { const int l = 2 * lp, pb = 2 + 8 * l; const float* ml = MODL + (size_t)l * NMODV;
          const float* xin = (l == 0) ? args.in[0] : XR;
          if (IN(pb)) norm_mod_phase(xin, args.in[5] + (size_t)l * DM, ml, ml + DM, Hb, lds, tid, gw, NGW, lane);
          SEAM(pb);
          if (IN(pb + 1)) { pg8::Gemm g{Hb, (const bf16*)(ws + WS_WIN + (size_t)lp * W_IN_B), SEQ, 12288, DM, LDD, LDD}; pg8::StaticOrder S; S.init(SEQ, 12288, G, bid, WGM_IN);
              pg8::EpiHeadMajor E{Z, GS}; pg8::gemm_phase<pg8::EpiHeadMajor, pg8::StaticOrder, true, true>(lds, g, S, E); }
          if (DUP_INP && IN(pb + 1)) { xcd_barrier(bar); pg8::Gemm g{Hb, (const bf16*)(ws + WS_WIN + (size_t)lp * W_IN_B), SEQ, 12288, DM, LDD, LDD}; pg8::StaticOrder S; S.init(SEQ, 12288, G, bid, WGM_IN);
              pg8::EpiHeadMajor E{Z, GS}; pg8::gemm_phase<pg8::EpiHeadMajor, pg8::StaticOrder, true, true>(lds, g, S, E); }
          SEAM(pb + 1);
          if (IN(pb + 2)) { conv_phase(Z, args.in[9] + (size_t)lp * 3 * 2048, MIX, gtid, NGT); if (ATT2) attn2_phase<false>(Z, OT, (char*)lds_raw, bid, G); else attn_phase(Z, OT, (char*)lds_raw, bid, G); if (DUP_ATTN == 1) { xcd_barrier(bar); attn2_phase<false>(Z, (float*)(ws + WS_END), (char*)lds_raw, bid, G); } if (DUP_ATTN == 2) { xcd_barrier(bar); attn2_phase<true>(Z, (float*)(ws + WS_END), (char*)lds_raw, bid, G); } }
          SEAM(pb + 2);
          if (IN(pb + 3)) combine_phase(OT, (const float*)(ws + WS_LAM) + lp, args.in[14] + lp * 256, lp == 0 ? 0.2f : 0.4707130183435842f, MIX, gw, NGW, lane);
          SEAM(pb + 3);
          if (IN(pb + 4)) { pg8::Gemm g{MIX, (const bf16*)(ws + WS_WOUT + (size_t)lp * W_OUT_B), SEQ, DM, DM, LDD, LDD}; pg8::StaticOrder S; S.init(SEQ, DM, G, bid, WGM_OUT);
              pg8::EpiResid E{xin, XR, ml + 2 * DM, DM}; pg8::gemm_phase<pg8::EpiResid, pg8::StaticOrder, true, true>(lds, g, S, E); }
          SEAM(pb + 4);
          FFN_PHASES(l, pb);
        }
        { const int l = 2 * lp + 1, pb = 2 + 8 * l; const float* ml = MODL + (size_t)l * NMODV;
          const unsigned char* prm = ws + WS_S5P + (size_t)lp * S5P_LAYER;
          float* const S5F = (float*)(ws + WS_S5F); float* const S5H = (float*)(ws + WS_S5H);
          if (IN(pb)) norm_mod_phase(XR, args.in[5] + (size_t)l * DM, ml, ml + DM, Hb, lds, tid, gw, NGW, lane);
          SEAM(pb);
          if (IN(pb + 1)) { if (S5_MFMA) s5m_pass<false>(Hb, prm, nullptr, S5F, nullptr, nullptr, lds, bid, G); else s5_pass<false>(Hb, prm, nullptr, nullptr, nullptr, S5F, nullptr, nullptr, lds, gw, NGW, wave, lane); }
          SEAM(pb + 1);
          if (IN(pb + 2)) s5_carry(prm, S5F, S5H, bid, G, wave, lane);
          SEAM(pb + 2);
          if (IN(pb + 3)) { if (S5_MFMA) s5m_pass<true>(Hb, prm, args.in[23] + (size_t)lp * DM, nullptr, S5H, MIX, lds, bid, G); else s5_pass<true>(Hb, prm, args.in[21] + (size_t)lp * 256 * 16 * 64, args.in[22] + (size_t)lp * 256 * 16 * 64, args.in[23] + (size_t)lp * DM, nullptr, S5H, MIX, lds, gw, NGW, wave, lane); }
          if (DUP_S5) { xcd_barrier(bar);
          if (IN(pb + 1)) { if (S5_MFMA) s5m_pass<false>(Hb, prm, nullptr, S5F, nullptr, nullptr, lds, bid, G); else s5_pass<false>(Hb, prm, nullptr, nullptr, nullptr, S5F, nullptr, nullptr, lds, gw, NGW, wave, lane); }
          SEAM(pb + 1);
          if (IN(pb + 2)) s5_carry(prm, S5F, S5H, bid, G, wave, lane);
          SEAM(pb + 2);
          if (IN(pb + 3)) { if (S5_MFMA) s5m_pass<true>(Hb, prm, args.in[23] + (size_t)lp * DM, nullptr, S5H, MIX, lds, bid, G); else s5_pass<true>(Hb, prm, args.in[21] + (size_t)lp * 256 * 16 * 64, args.in[22] + (size_t)lp * 256 * 16 * 64, args.in[23] + (size_t)lp * DM, nullptr, S5H, MIX, lds, gw, NGW, wave, lane); }
          }
          SEAM(pb + 3);
          if (IN(pb + 4)) { pg8::Gemm g{MIX, (const bf16*)(ws + WS_WGLU + (size_t)lp * W_GLU_B), SEQ, 2 * DM, DM, LDD, LDD}; pg8::StaticOrder S; S.init(SEQ, 2 * DM, G, bid, WGM_GLU);
              pg8::EpiGluResid E{XR, XR, ml + 2 * DM, DM}; pg8::gemm_phase<pg8::EpiGluResid, pg8::StaticOrder, true, true>(lds, g, S, E); }
          SEAM(pb + 4);
          FFN_PHASES(l, pb);
        }
    }
#undef FFN_PHASES
#undef IN
#undef SEAM

__global__ void __launch_bounds__(NTHR, 2) trunk_fwd(Args args) {
    extern __shared__ __attribute__((aligned(16))) unsigned char lds_raw[];
    LAS unsigned char* lds = (LAS unsigned char*)lds_raw;
    volatile LAS unsigned* MISC = (volatile LAS unsigned*)(lds + MISC_OFF);
    const int tid = opaque_tid(), lane = tid & 63, wave = __builtin_amdgcn_readfirstlane(tid >> 6);
    const int G = gridDim.x, bid = blockIdx.x;
    const int vcu = (G % 8 == 0) ? (bid % 8) * (G / 8) + bid / 8 : bid;
    const int gw = vcu * NWAVES + wave, NGW = G * NWAVES, gtid = vcu * NTHR + tid, NGT = G * NTHR;
    unsigned char* ws = args.ws;
    const int lo = args.ph_lo, hi = args.ph_hi;
    for (int u = tid; u < (LDS_BYTES - RING_BYTES) / 4; u += NTHR) ((LAS unsigned*)(lds + RING_BYTES))[u] = 0u;
    __syncthreads();
    XcdBarrier bar; bar.bar = (unsigned*)(ws + WS_CTL) + CW_BAR; bar.x = 0; bar.st = MISC + 8;
    if (hi - lo > 1) bar = xcd_barrier_post((unsigned*)(ws + WS_CTL) + CW_BAR, MISC + 8);
    const Ctx C{lo, hi, tid, lane, wave, gw, NGW, gtid, NGT, G, bid};
#define IN(k) (lo <= (k) && (k) < hi)
#define SEAM(k) do { if (IN(k) && IN((k) + 1)) xcd_barrier(bar); } while (0)

    bf16* const Hb = (bf16*)(ws + WS_H); bf16* const MIX = (bf16*)(ws + WS_MIX); bf16* const Z = (bf16*)(ws + WS_Z); bf16* const HID = (bf16*)(ws + WS_Z);
    float* const OT = (float*)(ws + WS_OT); float* const XR = args.out;
    const float* const MODL = (const float*)(ws + WS_MODL);

    if (IN(0)) { p0_prologue(args, lds, gw, NGW, wave, lane); if (DUP_PRO) { xcd_barrier(bar); p0_prologue(args, lds, gw, NGW, wave, lane); } }
    SEAM(0);
    if (IN(1)) p1_modvec(args, gtid, NGT);
    SEAM(1);


    layer_pair<0>(args, C, lds, lds_raw, bar);
    layer_pair<1>(args, C, lds, lds_raw, bar);
    if (IN(34)) final_norm_phase(XR, args.in[7], XR, gw, NGW, lane);
#undef IN
#undef SEAM
}

extern "C" void kernel_launch(void* const* d_in, const int* in_sizes, int n_in, void* d_out, int out_size, void* d_ws, size_t ws_size, hipStream_t stream) {
    static int grid = 0;
    if (grid == 0) {
        if (n_in != 29 || in_sizes[0] != SEQ * DM || out_size != SEQ * DM || ws_size < WS_END + (DUP_ATTN ? (size_t)32 * GS * 4 : 0)) {
            fprintf(stderr, "kernel_launch: built for 29 inputs, x/out of %d floats, >= %zu bytes of workspace; got n_in %d, in0 %d, out %d, ws %zu; nothing launched\n", SEQ * DM, (size_t)WS_END, n_in, n_in > 0 ? in_sizes[0] : -1, out_size, ws_size); grid = -1; return; }
        int dev = 0, cus = 0, per_cu = 0;
        if (hipGetDevice(&dev) != hipSuccess || hipDeviceGetAttribute(&cus, hipDeviceAttributeMultiprocessorCount, dev) != hipSuccess) { fprintf(stderr, "kernel_launch: device query failed\n"); grid = -1; return; }
        if (hipFuncSetAttribute((const void*)trunk_fwd, hipFuncAttributeMaxDynamicSharedMemorySize, LDS_BYTES) != hipSuccess) { fprintf(stderr, "kernel_launch: hipFuncSetAttribute failed\n"); grid = -1; return; }
        if (hipOccupancyMaxActiveBlocksPerMultiprocessor(&per_cu, (const void*)trunk_fwd, NTHR, LDS_BYTES) != hipSuccess || per_cu < 1) { fprintf(stderr, "kernel_launch: occupancy query reports %d workgroups per CU\n", per_cu); }
        (void)hipGetLastError();
        grid = cus;
        fprintf(stderr, "kernel_launch: grid %d, occupancy %d, ws %zu (need %zu)\n", grid, per_cu, ws_size, (size_t)WS_END);
    }
    if (grid < 0) return;
    if (hipMemsetAsync((char*)d_ws + WS_CTL, 0, CTL_ZERO_BYTES, stream) != hipSuccess) { fprintf(stderr, "kernel_launch: memset failed\n"); return; }
    Args a{};
    for (int i = 0; i < 29; ++i) a.in[i] = (const float*)d_in[i];
    a.out = (float*)d_out; a.ws = (unsigned char*)d_ws;
#if MK_PER_PHASE
    for (int p = 0; p < N_PHASES; ++p) { a.ph_lo = p; a.ph_hi = p + 1; hipLaunchKernelGGL(trunk_fwd, dim3(grid), dim3(NTHR), LDS_BYTES, stream, a); }
#else
    a.ph_lo = 0; a.ph_hi = N_PHASES;
    hipLaunchKernelGGL(trunk_fwd, dim3(grid), dim3(NTHR), LDS_BYTES, stream, a);
#endif
    const hipError_t le = hipPeekAtLastError();
    if (le != hipSuccess) fprintf(stderr, "kernel_launch: launch failed: %s\n", hipGetErrorName(le));
}
```

```cpp
#include <hip/hip_runtime.h>
#include <hip/hip_bf16.h>
#include <cstdio>
#include <cstdint>
__device__ __forceinline__ int opaque_tid() { int t; asm volatile("v_mov_b32 %0, %1" : "=v"(t) : "v"((int)threadIdx.x)); return t; }
namespace pg8 {
#define PG8_LAS __attribute__((address_space(3)))
typedef unsigned short bf16_t;
typedef short bf16x8 __attribute__((ext_vector_type(8)));
typedef float f32x4 __attribute__((ext_vector_type(4)));
typedef unsigned u32x4 __attribute__((ext_vector_type(4)));
constexpr int BM = 256, BK = 64, HALF = 128, HTB = HALF * BK * 2  , STAGE_BYTES = 8 * HTB, NXCD = 8, WGM = 8;

__host__ __device__ __forceinline__ int lds_byte(int r, int c) { const int st = (r >> 4) * 2 + (c >> 5), rr = r & 15, cc = c & 31, ob = rr * 64 + cc * 2; return st * 1024 + (ob ^ (((ob >> 9) & 1) << 5)); }
__host__ __device__ __forceinline__ void stage_rc(int b, int& R, int& C) { const int st = b / 1024, sb = b % 1024, swz = sb ^ (((sb >> 9) & 1) << 5); R = (st >> 1) * 16 + swz / 64; C = (st & 1) * 32 + (swz % 64) / 2; }
__host__ __device__ __forceinline__ int perm32(int rho) { const int n = rho >> 4, i = rho & 15; return 8 * (i >> 2) + 4 * n + (i & 3); }

struct Unit { int pm, pn; };
struct Gemm { const bf16_t* A; const bf16_t* Bt; int M, N, K, lda, ldb; };

struct StaticOrder {
    int nM, nN, nwg, G, c, wgm;
    __host__ __device__ void init(int M, int N, int G_, int c_, int wgm_ = WGM) { nM = M / BM; nN = N / BM; nwg = nM * nN; G = G_; c = c_; wgm = wgm_; }
    __host__ __device__ bool next(int i, Unit& u) const {
        const long L = (long)i * G + c; if (L >= nwg) return false;
        int wgid = (int)L; { const int q = nwg / NXCD, r = nwg % NXCD, xcd = wgid % NXCD, off = wgid / NXCD; wgid = (xcd < r ? xcd * (q + 1) : r * (q + 1) + (xcd - r) * q) + off; }
        const int nig = wgm * nN, gid = wgid / nig, fm = gid * wgm, gsz = (nM - fm) < wgm ? (nM - fm) : wgm;
        u.pm = fm + ((wgid % nig) % gsz); u.pn = (wgid % nig) / gsz; return true;
    }
    __device__ __forceinline__ void a_ready(const Unit&) const {}
    __device__ __forceinline__ void done(const Unit&) const {}
};

__device__ __forceinline__ unsigned cvt_pk_bf16(float lo, float hi) { unsigned r; asm volatile("v_cvt_pk_bf16_f32 %0, %1, %2" : "=v"(r) : "v"(lo), "v"(hi)); return r; }
__device__ __forceinline__ float fast_sigmoid(float x) { return __builtin_amdgcn_rcpf(1.0f + __builtin_amdgcn_exp2f(-1.4426950408889634f * x)); }

struct EpiHeadMajor {
    static constexpr bool PERM = true, AFTER_DRAIN = false;
    bf16_t* O; size_t gstride;
    __device__ __forceinline__ void operator()(const f32x4 (&acc)[2][2][4][2], const Unit& u, int wr, int wc, int fr, int fq) const {
        const int row0 = u.pm * BM + wr * 64 + fr, col0 = wc * 32 + 8 * fq;
#pragma unroll
        for (int ai = 0; ai < 2; ++ai)
#pragma unroll
            for (int m = 0; m < 4; ++m) { const size_t ro = (size_t)(row0 + ai * HALF + m * 16) * 128 + col0;
#pragma unroll
                for (int bj = 0; bj < 2; ++bj) { const f32x4 v0 = acc[ai][bj][m][0], v1 = acc[ai][bj][m][1];
                    u32x4 w; w.x = cvt_pk_bf16(v0[0], v0[1]); w.y = cvt_pk_bf16(v0[2], v0[3]); w.z = cvt_pk_bf16(v1[0], v1[1]); w.w = cvt_pk_bf16(v1[2], v1[3]);
                    *(u32x4*)(O + (size_t)(2 * u.pn + bj) * gstride + ro) = w; } }
    }
};
struct EpiResid {
    static constexpr bool PERM = false, AFTER_DRAIN = false;
    const float* base; float* out; const float* gate; int ldc;
    __device__ __forceinline__ void operator()(const f32x4 (&acc)[2][2][4][2], const Unit& u, int wr, int wc, int fr, int fq) const {
        const int row0 = u.pm * BM + wr * 64 + fr, col0 = u.pn * BM + wc * 32 + 4 * fq;
        f32x4 gv[2][2];
#pragma unroll
        for (int bj = 0; bj < 2; ++bj)
#pragma unroll
            for (int n = 0; n < 2; ++n) gv[bj][n] = *(const f32x4*)(gate + col0 + bj * HALF + n * 16);
#pragma unroll
        for (int ai = 0; ai < 2; ++ai) {
            f32x4 b[4][2][2];
#pragma unroll
            for (int m = 0; m < 4; ++m) { const size_t off = (size_t)(row0 + ai * HALF + m * 16) * ldc + col0;
#pragma unroll
                for (int bj = 0; bj < 2; ++bj)
#pragma unroll
                    for (int n = 0; n < 2; ++n) b[m][bj][n] = *(const f32x4*)(base + off + bj * HALF + n * 16); }
            asm volatile("" ::: "memory");
#pragma unroll
            for (int m = 0; m < 4; ++m) { const size_t off = (size_t)(row0 + ai * HALF + m * 16) * ldc + col0;
#pragma unroll
                for (int bj = 0; bj < 2; ++bj)
#pragma unroll
                    for (int n = 0; n < 2; ++n) *(f32x4*)(out + off + bj * HALF + n * 16) = b[m][bj][n] + gv[bj][n] * acc[ai][bj][m][n]; }
            asm volatile("" ::: "memory"); }
    }
};
struct EpiSwiGLU {
    static constexpr bool PERM = true, AFTER_DRAIN = false;
    bf16_t* O; int ldc;
    __device__ __forceinline__ void operator()(const f32x4 (&acc)[2][2][4][2], const Unit& u, int wr, int wc, int fr, int fq) const {
        const int row0 = u.pm * BM + wr * 64 + fr, col0 = u.pn * HALF + wc * 32 + 8 * fq;
#pragma unroll
        for (int ai = 0; ai < 2; ++ai)
#pragma unroll
            for (int m = 0; m < 4; ++m) { bf16_t* rowp = O + (size_t)(row0 + ai * HALF + m * 16) * ldc + col0;
                float r[8];
#pragma unroll
                for (int n = 0; n < 2; ++n)
#pragma unroll
                    for (int j = 0; j < 4; ++j) { const float g = acc[ai][0][m][n][j], up = acc[ai][1][m][n][j]; r[n * 4 + j] = g * fast_sigmoid(g) * up; }
                u32x4 w; w.x = cvt_pk_bf16(r[0], r[1]); w.y = cvt_pk_bf16(r[2], r[3]); w.z = cvt_pk_bf16(r[4], r[5]); w.w = cvt_pk_bf16(r[6], r[7]);
                *(u32x4*)rowp = w; }
    }
};
struct EpiGluResid {
    static constexpr bool PERM = false, AFTER_DRAIN = false;
    const float* base; float* out; const float* gate; int ldc;
    __device__ __forceinline__ void operator()(const f32x4 (&acc)[2][2][4][2], const Unit& u, int wr, int wc, int fr, int fq) const {
        const int row0 = u.pm * BM + wr * 64 + fr, col0 = u.pn * HALF + wc * 32 + 4 * fq;
        f32x4 gv[2];
#pragma unroll
        for (int n = 0; n < 2; ++n) gv[n] = *(const f32x4*)(gate + col0 + n * 16);
        f32x4 b[2][4][2];
#pragma unroll
        for (int ai = 0; ai < 2; ++ai)
#pragma unroll
            for (int m = 0; m < 4; ++m) { const size_t off = (size_t)(row0 + ai * HALF + m * 16) * ldc + col0;
#pragma unroll
                for (int n = 0; n < 2; ++n) b[ai][m][n] = *(const f32x4*)(base + off + n * 16); }
        asm volatile("" ::: "memory");
#pragma unroll
        for (int ai = 0; ai < 2; ++ai)
#pragma unroll
            for (int m = 0; m < 4; ++m) { const size_t off = (size_t)(row0 + ai * HALF + m * 16) * ldc + col0;
#pragma unroll
                for (int n = 0; n < 2; ++n) { const f32x4 a = acc[ai][0][m][n], sg = acc[ai][1][m][n]; f32x4 y;
#pragma unroll
                    for (int j = 0; j < 4; ++j) y[j] = a[j] * fast_sigmoid(sg[j]);
                    *(f32x4*)(out + off + n * 16) = b[ai][m][n] + gv[n] * y; } }
        asm volatile("" ::: "memory");
    }
};

template <class Epi, class Sched, bool ALIGN_EPI = false, bool SP2 = false>
__device__ __forceinline__ void gemm_phase(PG8_LAS unsigned char* lds, const Gemm g, const Sched& S, const Epi& E) {
    const int tid = opaque_tid(), wid = __builtin_amdgcn_readfirstlane(tid >> 6), lane = tid & 63, wr = wid >> 2, wc = wid & 3, fr = lane & 15, fq = lane >> 4;
    const int K = g.K, nt = K / BK;
    unsigned voffA[2], voffB[2];
#pragma unroll
    for (int i = 0; i < 2; ++i) { int R, C; stage_rc(tid * 16 + i * 8192, R, C); const int Rb = Epi::PERM ? ((R & ~31) + perm32(R & 31)) : R;
        voffA[i] = (unsigned)(R * g.lda + C) * 2u; voffB[i] = (unsigned)(Rb * g.ldb + C) * 2u; }
    const size_t kstep = (size_t)(BK * 2);
    const size_t hstepA = (size_t)HALF * g.lda * 2, hstepB = (size_t)HALF * g.ldb * 2;
    const size_t tstepA = 2 * hstepA, tstepB = 2 * hstepB;
    const unsigned ldsw = (unsigned)wid * 1024u;
    const int aoff = lds_byte(wr * 64 + fr, fq * 8), boff = lds_byte(wc * 32 + fr, fq * 8);
#define PG8_SA(b, h) (((b) * 2 + (h)) * HTB)
#define PG8_SB(b, h) ((4 + (b) * 2 + (h)) * HTB)
#define PG8_STAGE(bufoff, gbase, voff) do { _Pragma("unroll") for (int _i = 0; _i < 2; ++_i) \
        __builtin_amdgcn_global_load_lds((const unsigned*)((const char*)(gbase) + (voff)[_i]), (PG8_LAS unsigned*)(lds + (bufoff) + ldsw + _i * 8192), 16, 0, 0); } while (0)
#define PG8_LDA(dst, b, h) do { _Pragma("unroll") for (int m = 0; m < 4; ++m) _Pragma("unroll") for (int k = 0; k < 2; ++k) dst[m][k] = *(const PG8_LAS bf16x8*)(lds + PG8_SA(b, h) + aoff + m * 2048 + k * 1024); } while (0)
#define PG8_LDB(dst, b, h) do { _Pragma("unroll") for (int n = 0; n < 2; ++n) _Pragma("unroll") for (int k = 0; k < 2; ++k) dst[n][k] = *(const PG8_LAS bf16x8*)(lds + PG8_SB(b, h) + boff + n * 2048 + k * 1024); } while (0)
#define PG8_MMA(ai, bj, At, Bt) do { __builtin_amdgcn_s_setprio(3); _Pragma("unroll") for (int m = 0; m < 4; ++m) _Pragma("unroll") for (int n = 0; n < 2; ++n) _Pragma("unroll") for (int k = 0; k < 2; ++k) \
        acc[ai][bj][m][n] = __builtin_amdgcn_mfma_f32_16x16x32_bf16(Bt[n][k], At[m][k], acc[ai][bj][m][n], 0, 0, 0); __builtin_amdgcn_s_setprio(0); } while (0)
#define PG8_WAIT_V(n) asm volatile("s_waitcnt vmcnt(" #n ")" ::: "memory")
#define PG8_WAIT_L(n) asm volatile("s_waitcnt lgkmcnt(" #n ")" ::: "memory")
#define PG8_BAR __builtin_amdgcn_s_barrier()
#define PG8_SCHED __builtin_amdgcn_sched_barrier(0)
    Unit cur, nxt; int ui = 0;
    if (!S.next(0, cur)) return;
    f32x4 acc[2][2][4][2];
#pragma unroll
    for (int a = 0; a < 2; ++a)
#pragma unroll
        for (int b = 0; b < 2; ++b)
#pragma unroll
            for (int m = 0; m < 4; ++m)
#pragma unroll
                for (int n = 0; n < 2; ++n) acc[a][b][m][n] = (f32x4){0.f, 0.f, 0.f, 0.f};
    bf16x8 At[4][2], B0[2][2], B1[2][2];
    const char* cA = (const char*)g.A + (size_t)cur.pm * tstepA; const char* cB = (const char*)g.Bt + (size_t)cur.pn * tstepB;
    S.a_ready(cur);
    if constexpr (SP2) {
        PG8_STAGE(PG8_SB(0, 0), cB, voffB); PG8_STAGE(PG8_SB(0, 1), cB + hstepB, voffB); PG8_STAGE(PG8_SA(0, 0), cA, voffA); PG8_STAGE(PG8_SA(0, 1), cA + hstepA, voffA);
        if (wr == 1) PG8_BAR;
        PG8_WAIT_V(2); PG8_BAR;
        PG8_STAGE(PG8_SB(1, 0), cB + kstep, voffB); PG8_STAGE(PG8_SA(1, 0), cA + kstep, voffA); PG8_STAGE(PG8_SB(1, 1), cB + hstepB + kstep, voffB);
        PG8_WAIT_V(6); PG8_BAR;
    } else {
        PG8_STAGE(PG8_SB(0, 0), cB, voffB); PG8_STAGE(PG8_SA(0, 0), cA, voffA); PG8_STAGE(PG8_SB(0, 1), cB + hstepB, voffB); PG8_STAGE(PG8_SA(0, 1), cA + hstepA, voffA);
        if (wr == 1) PG8_BAR;
        PG8_WAIT_V(4); PG8_BAR;
        PG8_STAGE(PG8_SB(1, 0), cB + kstep, voffB); PG8_STAGE(PG8_SA(1, 0), cA + kstep, voffA); PG8_STAGE(PG8_SB(1, 1), cB + hstepB + kstep, voffB);
        PG8_WAIT_V(6); PG8_BAR;
    }
    for (;;) {
        const bool has_next = S.next(ui + 1, nxt);
        const char* nA = has_next ? (const char*)g.A + (size_t)nxt.pm * tstepA : cA; const char* nB = has_next ? (const char*)g.Bt + (size_t)nxt.pn * tstepB : cB;
        for (int t = 0; t < nt; t += 2) {
            const bool last = (t == nt - 2);
            const char* a1 = cA + (size_t)(t + 1) * kstep;
            const char* a2 = last ? nA : cA + (size_t)(t + 2) * kstep; const char* b2 = last ? nB : cB + (size_t)(t + 2) * kstep;
            const char* a3 = a2 + kstep; const char* b3 = b2 + kstep;
            if (last && has_next) S.a_ready(nxt);
            if constexpr (SP2) {
            PG8_LDB(B0, 0, 0); PG8_LDB(B1, 0, 1); PG8_SCHED; PG8_LDA(At, 0, 0); PG8_STAGE(PG8_SA(1, 1), a1 + hstepA, voffA);
            PG8_WAIT_V(8); PG8_WAIT_L(0); PG8_BAR; PG8_MMA(0, 0, At, B0); PG8_MMA(0, 1, At, B1); PG8_BAR; PG8_SCHED;
            PG8_LDA(At, 0, 1); PG8_STAGE(PG8_SB(0, 0), b2, voffB); PG8_STAGE(PG8_SB(0, 1), b2 + hstepB, voffB); PG8_STAGE(PG8_SA(0, 0), a2, voffA);
            PG8_WAIT_V(8); PG8_WAIT_L(0); PG8_BAR; PG8_MMA(1, 0, At, B0); PG8_MMA(1, 1, At, B1); PG8_BAR; PG8_SCHED;
            PG8_LDB(B0, 1, 0); PG8_LDB(B1, 1, 1); PG8_SCHED; PG8_LDA(At, 1, 0); PG8_STAGE(PG8_SA(0, 1), a2 + hstepA, voffA);
            PG8_WAIT_V(8); PG8_WAIT_L(0); PG8_BAR; PG8_MMA(0, 0, At, B0); PG8_MMA(0, 1, At, B1); PG8_BAR; PG8_SCHED;
            PG8_LDA(At, 1, 1); PG8_STAGE(PG8_SB(1, 0), b3, voffB); PG8_STAGE(PG8_SB(1, 1), b3 + hstepB, voffB); PG8_STAGE(PG8_SA(1, 0), a3, voffA);
            PG8_WAIT_V(8); PG8_WAIT_L(0); PG8_BAR; PG8_MMA(1, 0, At, B0); PG8_MMA(1, 1, At, B1); PG8_BAR; PG8_SCHED;
            } else {
            PG8_LDB(B0, 0, 0); PG8_SCHED; PG8_LDA(At, 0, 0); PG8_STAGE(PG8_SA(1, 1), a1 + hstepA, voffA);
            PG8_WAIT_L(8); PG8_BAR; PG8_WAIT_L(0); PG8_MMA(0, 0, At, B0); PG8_BAR; PG8_SCHED;
            PG8_LDB(B1, 0, 1); PG8_STAGE(PG8_SB(0, 0), b2, voffB);
            PG8_BAR; PG8_WAIT_L(0); PG8_MMA(0, 1, At, B1); PG8_BAR;
            PG8_LDA(At, 0, 1); PG8_STAGE(PG8_SA(0, 0), a2, voffA);
            PG8_BAR; PG8_WAIT_L(0); PG8_MMA(1, 0, At, B0); PG8_BAR; PG8_SCHED;
            PG8_STAGE(PG8_SB(0, 1), b2 + hstepB, voffB);
            PG8_WAIT_V(6); PG8_BAR; PG8_MMA(1, 1, At, B1); PG8_BAR;
            PG8_LDB(B0, 1, 0); PG8_SCHED; PG8_LDA(At, 1, 0); PG8_STAGE(PG8_SA(0, 1), a2 + hstepA, voffA);
            PG8_WAIT_L(8); PG8_BAR; PG8_WAIT_L(0); PG8_MMA(0, 0, At, B0); PG8_BAR; PG8_SCHED;
            PG8_LDB(B1, 1, 1); PG8_STAGE(PG8_SB(1, 0), b3, voffB);
            PG8_BAR; PG8_WAIT_L(0); PG8_MMA(0, 1, At, B1); PG8_BAR;
            PG8_LDA(At, 1, 1); PG8_STAGE(PG8_SA(1, 0), a3, voffA);
            PG8_BAR; PG8_WAIT_L(0); PG8_MMA(1, 0, At, B0); PG8_BAR; PG8_SCHED;
            PG8_STAGE(PG8_SB(1, 1), b3 + hstepB, voffB);
            PG8_WAIT_V(6); PG8_BAR; PG8_MMA(1, 1, At, B1); PG8_BAR;
            }
        }
        if constexpr (ALIGN_EPI) { if (wr == 0) PG8_BAR; }
        if constexpr (!Epi::AFTER_DRAIN) { E(acc, cur, wr, wc, fr, fq); S.done(cur); }
        if (!has_next) break;
#pragma unroll
        for (int a = 0; a < 2; ++a)
#pragma unroll
            for (int b = 0; b < 2; ++b)
#pragma unroll
                for (int m = 0; m < 4; ++m)
#pragma unroll
                    for (int n = 0; n < 2; ++n) acc[a][b][m][n] = (f32x4){0.f, 0.f, 0.f, 0.f};
        cur = nxt; cA = nA; cB = nB; ++ui;
        if constexpr (ALIGN_EPI) { if (wr == 1) PG8_BAR; }
    }
    PG8_WAIT_V(0);
    if constexpr (!ALIGN_EPI) { if (wr == 0) PG8_BAR; }
    PG8_BAR;
    if constexpr (Epi::AFTER_DRAIN) { E.fused(acc, cur, wr, wc, fr, fq, lds, wid, lane); S.done(cur); }
#undef PG8_SA
#undef PG8_SB
#undef PG8_STAGE
#undef PG8_LDA
#undef PG8_LDB
#undef PG8_MMA
#undef PG8_WAIT_V
#undef PG8_WAIT_L
#undef PG8_BAR
#undef PG8_SCHED
}
}

namespace att {
constexpr int D = 128;
constexpr float THR = 8.f;
constexpr bool WSKIP = false;
constexpr float SCALE = 0.08838834764831845f;
constexpr int NW = 8, QBLK = 32, KVBLK = 64, QB = NW * QBLK;
constexpr int SHM_V = KVBLK * D * 2, SHM_K = KVBLK * D * 2;
constexpr int LDS_BYTES = 2 * SHM_V + 2 * SHM_K + NW * 64 * 4;

using bf16 = __hip_bfloat16;
typedef short bf16x8 __attribute__((ext_vector_type(8)));
typedef short s16x4 __attribute__((ext_vector_type(4)));
typedef float f32x16 __attribute__((ext_vector_type(16)));
typedef float f32x4 __attribute__((ext_vector_type(4)));
typedef unsigned u32x4 __attribute__((ext_vector_type(4)));
template <class A, class Bt> struct same_t { static constexpr bool v = false; };
template <class A> struct same_t<A, A> { static constexpr bool v = true; };

#define KSWZ(row, colB) ((row) * 256 + ((colB) ^ (((row) & 7) << 4)))
#define SBAR() __builtin_amdgcn_sched_barrier(0)
__device__ __forceinline__ int v_st(int k, int c) { const int kk = (k & ~0xC) | ((k & 4) << 1) | ((k & 8) >> 1); return ((kk >> 3) * 4 + (c >> 5)) * 512 + ((kk & 7) * 32 + (c & 31)) * 2; }
__device__ __forceinline__ int v_rd_base(int lane) { return ((lane & 3) << 3) | (((lane >> 2) & 3) << 6) | (((lane >> 4) & 1) << 5) | (((lane >> 5) & 1) << 8); }
constexpr int v_rd_off(int d0, int ks, int half) { return d0 * 512 + ks * 4096 + half * 2048; }
__device__ __forceinline__ int crow(int r, int hi) { return (r & 3) + 8 * (r >> 2) + 4 * hi; }
__device__ __forceinline__ unsigned cvtpk(float lo, float hi) {
    unsigned r; asm volatile("v_cvt_pk_bf16_f32 %0, %1, %2" : "=v"(r) : "v"(lo), "v"(hi)); return r;
}
__device__ __forceinline__ bf16x8 pack8(f32x4 a, f32x4 b) {
    u32x4 w = {cvtpk(a[0], a[1]), cvtpk(a[2], a[3]), cvtpk(b[0], b[1]), cvtpk(b[2], b[3])};
    return *reinterpret_cast<bf16x8*>(&w);
}
template <class T> __device__ __forceinline__ bf16x8 load8(const T* p) {
    if constexpr (same_t<T, float>::v) { return pack8(*(const f32x4*)p, *(const f32x4*)(p + 4)); }
    else { return *reinterpret_cast<const bf16x8*>(p); }
}
__device__ __forceinline__ void mask_tile(f32x16& p0, f32x16& p1, int dq, unsigned W) {
    const float NEG = -__builtin_inff();
#pragma unroll
    for (int r = 0; r < 16; ++r) {
        const int c = (r & 3) + 8 * (r >> 2);
        if ((unsigned)(dq - c) >= W) p0[r] = NEG;
        if ((unsigned)(dq - c - 32) >= W) p1[r] = NEG;
    }
}
__device__ __forceinline__ void partialSM(f32x16& p0, f32x16& p1, float& m_reg, float& mn, float& alpha) {
    float pmax = p0[0]; for (int r = 1; r < 16; ++r) pmax = fmaxf(pmax, p0[r]); for (int r = 0; r < 16; ++r) pmax = fmaxf(pmax, p1[r]);
    { auto rr = __builtin_amdgcn_permlane32_swap(__float_as_uint(pmax), __float_as_uint(pmax), false, false);
      pmax = fmaxf(__uint_as_float(rr[0]), __uint_as_float(rr[1])); }
    constexpr float C2 = 1.4426950408889634f * SCALE;
    if (__builtin_expect(__all((pmax - m_reg) * SCALE <= THR), 1)) { mn = m_reg; alpha = 1.f; }
    else { mn = fmaxf(m_reg, pmax); alpha = __builtin_amdgcn_exp2f((m_reg - mn) * C2); m_reg = mn; }
    const float mnL = -mn * C2;
    for (int r = 0; r < 16; ++r) p0[r] = fmaf(p0[r], C2, mnL); for (int r = 0; r < 16; ++r) p1[r] = fmaf(p1[r], C2, mnL);
    for (int r = 0; r < 16; ++r) p0[r] = __builtin_amdgcn_exp2f(p0[r]);
}
__device__ __forceinline__ void finishSM(f32x16& p0, f32x16& p1, float alpha, float& l_reg, bf16x8& pa0, bf16x8& pa1, bf16x8& pa2, bf16x8& pa3) {
    for (int r = 0; r < 16; ++r) p1[r] = __builtin_amdgcn_exp2f(p1[r]);
    float ps = 0; for (int r = 0; r < 16; ++r) ps += p0[r]; for (int r = 0; r < 16; ++r) ps += p1[r];
    { auto rr = __builtin_amdgcn_permlane32_swap(__float_as_uint(ps), __float_as_uint(ps), false, false);
      ps = __uint_as_float(rr[0]) + __uint_as_float(rr[1]); }
    l_reg = l_reg * alpha + ps;
#define PK4(P, B_, OUT) do { unsigned a0 = cvtpk(P[B_+0], P[B_+1]), a1 = cvtpk(P[B_+2], P[B_+3]);                          \
        unsigned b0 = cvtpk(P[B_+4], P[B_+5]), b1 = cvtpk(P[B_+6], P[B_+7]);                                             \
        auto r0 = __builtin_amdgcn_permlane32_swap(a0, b0, false, false); auto r1 = __builtin_amdgcn_permlane32_swap(a1, b1, false, false); \
        u32x4 w = {r0[0], r1[0], r0[1], r1[1]}; OUT = *reinterpret_cast<bf16x8*>(&w); } while (0)
    PK4(p0, 0, pa0); PK4(p0, 8, pa1); PK4(p1, 0, pa2); PK4(p1, 8, pa3);
#undef PK4
}
template <int KB, bool SK>
__device__ __forceinline__ void qkt(f32x16& p0, f32x16& p1, const char* K_lds, int r32, int hi, const bf16x8* qr, bool act) {
    if (SK && !act) { const float NEG = -__builtin_inff();
#pragma unroll
        for (int r = 0; r < 16; ++r) { p0[r] = NEG; p1[r] = NEG; } return; }
    p0 = f32x16{}; p1 = f32x16{};
    const char* kb[4];
#pragma unroll
    for (int dd = 0; dd < 4; ++dd) kb[dd] = K_lds + KB * SHM_K + KSWZ(r32, (dd * 16 + hi * 8) * 2);
#pragma unroll
    for (int d0 = 0; d0 < 8; ++d0) { const char* a = kb[d0 & 3] + (d0 >> 2) * 128;
        bf16x8 b0 = *reinterpret_cast<const bf16x8*>(a);
        bf16x8 b1 = *reinterpret_cast<const bf16x8*>(a + 32 * 256);
        p0 = __builtin_amdgcn_mfma_f32_32x32x16_bf16(b0, qr[d0], p0, 0, 0, 0);
        p1 = __builtin_amdgcn_mfma_f32_32x32x16_bf16(b1, qr[d0], p1, 0, 0, 0); }
}
template <int VB, bool SK>
__device__ __forceinline__ void pv_tile(f32x16* o, int vb0, bf16x8 pa0, bf16x8 pa1, bf16x8 pa2, bf16x8 pa3, bool act) {
    if (SK && !act) return;
#define TRRD(dst, off) asm volatile("ds_read_b64_tr_b16 %0, %1 offset:%2" : "=&v"(dst) : "v"(vb0), "i"(off) : "memory")
#define PV_D0(d0) do { s16x4 l0, l1, l2, l3, h0, h1, h2, h3; constexpr int b_ = VB * SHM_V + v_rd_off(d0, 0, 0);     \
        TRRD(l0, b_); TRRD(h0, b_ + 2048); TRRD(l1, b_ + 4096); TRRD(h1, b_ + 6144); TRRD(l2, b_ + 8192); TRRD(h2, b_ + 10240); TRRD(l3, b_ + 12288); TRRD(h3, b_ + 14336); \
        asm volatile("s_waitcnt lgkmcnt(0)" ::: "memory"); SBAR();                 \
        o[d0] = __builtin_amdgcn_mfma_f32_32x32x16_bf16(pa0, (bf16x8){l0[0], l0[1], l0[2], l0[3], h0[0], h0[1], h0[2], h0[3]}, o[d0], 0, 0, 0);   \
        o[d0] = __builtin_amdgcn_mfma_f32_32x32x16_bf16(pa1, (bf16x8){l1[0], l1[1], l1[2], l1[3], h1[0], h1[1], h1[2], h1[3]}, o[d0], 0, 0, 0);   \
        o[d0] = __builtin_amdgcn_mfma_f32_32x32x16_bf16(pa2, (bf16x8){l2[0], l2[1], l2[2], l2[3], h2[0], h2[1], h2[2], h2[3]}, o[d0], 0, 0, 0);   \
        o[d0] = __builtin_amdgcn_mfma_f32_32x32x16_bf16(pa3, (bf16x8){l3[0], l3[1], l3[2], l3[3], h3[0], h3[1], h3[2], h3[3]}, o[d0], 0, 0, 0); } while (0)
    PV_D0(0); PV_D0(1); PV_D0(2); PV_D0(3);
#undef PV_D0
#undef TRRD
}

template <class TIn, class TOut> struct BlockRef { const TIn* Q; const TIn* K; const TIn* V; TOut* O; int P0; };
template <class TIn> struct Seam {
    bf16x8 qr[8];
    bf16x8 st_v0, st_v1, st_k0, st_k1; f32x4 sf0, sf1, sf2, sf3;
    f32x4 tq[16];
};
__device__ __forceinline__ int swa_jlo(int P0, int W) { const int lowk = P0 - W + 1; return lowk > 0 ? lowk / KVBLK : 0; }
#define ROW(p, k0, rr) ((p) + (size_t)((k0) + (rr)) * D + sc)
#define VMW() asm volatile("s_waitcnt vmcnt(0)" ::: "memory")
#define VMWN(n) asm volatile("s_waitcnt vmcnt(%0)" :: "i"(n) : "memory")
#define SLOAD_H(Kp, Vp, k0) do { S.st_v0 = load8<TIn>(ROW(Vp, k0, sr)); S.st_v1 = load8<TIn>(ROW(Vp, k0, 32 + sr));              \
                         S.st_k0 = load8<TIn>(ROW(Kp, k0, sr)); S.st_k1 = load8<TIn>(ROW(Kp, k0, 32 + sr)); } while (0)
#define SWRITE_HK(bf) do { *(bf16x8*)(K_lds + (bf) * SHM_K + kws) = S.st_k0; *(bf16x8*)(K_lds + (bf) * SHM_K + kws + 32 * 256) = S.st_k1; } while (0)
#define SWRITE_HV(bf) do { *(bf16x8*)(V_lds + (bf) * SHM_V + vst0) = S.st_v0; *(bf16x8*)(V_lds + (bf) * SHM_V + vst1) = S.st_v1; } while (0)
#define SWRITE_H(bf) do { SWRITE_HV(bf); SWRITE_HK(bf); } while (0)
#define SLOAD_F(p, k0) do { S.sf0 = *(const f32x4*)ROW(p, k0, sr); S.sf1 = *(const f32x4*)(ROW(p, k0, sr) + 4);                \
                            S.sf2 = *(const f32x4*)ROW(p, k0, 32 + sr); S.sf3 = *(const f32x4*)(ROW(p, k0, 32 + sr) + 4); } while (0)
#define SWRITE_KF(bf) do { *(bf16x8*)(K_lds + (bf) * SHM_K + kws) = pack8(S.sf0, S.sf1); *(bf16x8*)(K_lds + (bf) * SHM_K + kws + 32 * 256) = pack8(S.sf2, S.sf3); } while (0)
#define SWRITE_VF(bf) do { *(bf16x8*)(V_lds + (bf) * SHM_V + vst0) = pack8(S.sf0, S.sf1); *(bf16x8*)(V_lds + (bf) * SHM_V + vst1) = pack8(S.sf2, S.sf3); } while (0)
template <class TIn, class TOut>
__device__ __forceinline__ void causal_swa_prime(const BlockRef<TIn, TOut>& cur, int W, char* lds, Seam<TIn>& S) {
    constexpr bool F32 = same_t<TIn, float>::v;
    const int tid = opaque_tid(), wid = __builtin_amdgcn_readfirstlane(tid >> 6), lane = tid & 63, r32 = lane & 31, hi = lane >> 5;
    const int sr = tid >> 4, sc = (tid & 15) * 8, kws = KSWZ(sr, sc * 2); char* K_lds = lds + 2 * SHM_V;
    const int kb0 = swa_jlo(cur.P0, W) * KVBLK;
    for (int d0 = 0; d0 < 8; ++d0) S.qr[d0] = load8<TIn>(cur.Q + (size_t)(wid * QBLK + r32) * D + d0 * 16 + hi * 8);
    if constexpr (F32) { SLOAD_F((const float*)cur.K, kb0); VMW(); SWRITE_KF(0); SBAR(); SLOAD_F((const float*)cur.V, kb0); }
    else { SLOAD_H(cur.K, cur.V, kb0); VMW(); SWRITE_HK(0); }
    __syncthreads();
}
template <class TIn, class TOut>
__device__ __forceinline__ void causal_swa_block(const BlockRef<TIn, TOut>& cur, const BlockRef<TIn, TOut>& nxt, int skv, int W, char* lds, Seam<TIn>& S) {
    constexpr bool F32 = same_t<TIn, float>::v;
    const int tid = opaque_tid(), wid = __builtin_amdgcn_readfirstlane(tid >> 6), lane = tid & 63, r32 = lane & 31, hi = lane >> 5;
    const int j_lo = swa_jlo(cur.P0, W);
    int j_hi = (cur.P0 + QB - 1) / KVBLK + 1; if (j_hi > skv / KVBLK) j_hi = skv / KVBLK;
    const int NT = j_hi - j_lo;
    const int kbn = swa_jlo(nxt.P0, W) * KVBLK;
    const int qlo = cur.P0 + wid * QBLK, qm = qlo + r32 - 4 * hi;
    char* V_lds = lds; char* K_lds = lds + 2 * SHM_V;
    float* ws = (float*)(lds + 2 * SHM_V + 2 * SHM_K) + wid * 64; float* li_l = ws, * al_l = ws + 32;
    float m_reg = -1e30f, l_reg = 0; f32x16 o[4] = {};
    const int sr = tid >> 4, sc = (tid & 15) * 8, vst0 = v_st(sr, sc), vst1 = v_st(32 + sr, sc), kws = KSWZ(sr, sc * 2);
    const int vb0 = (int)(uintptr_t)V_lds + v_rd_base(lane);
    const TIn* Kh = cur.K; const TIn* Vh = cur.V;
#define RESC(a) do { if (__any((a) < 1.f)) { if (hi == 0) al_l[r32] = (a); asm volatile("s_waitcnt lgkmcnt(0)" ::: "memory");              \
                     for (int d_ = 0; d_ < 4; ++d_) for (int r = 0; r < 16; ++r) o[d_][r] *= al_l[crow(r, hi)]; } } while (0)
#define KBASE(t) ((j_lo + (t)) * KVBLK)
#define ACT(t) (KBASE(t) <= qlo + QBLK - 1 && KBASE(t) + KVBLK - 1 >= qlo - W + 1)
#define MASKT(P0_, P1_, t) do { const int kb_ = KBASE(t); if ((!SK || ACT(t)) && (kb_ + KVBLK - 1 > qlo || kb_ <= qlo + QBLK - 1 - W)) mask_tile(P0_, P1_, qm - kb_, (unsigned)W); } while (0)
    constexpr int NQL = F32 ? 16 : 8;
    constexpr bool SK = WSKIP && !F32;
#define SEAM_K0() do { VMWN(NQL); if constexpr (F32) { SWRITE_KF(0); SBAR(); SLOAD_F((const float*)nxt.V, kbn); } else { SWRITE_HK(0); } SBAR(); } while (0)
    f32x16 pA0, pA1, pB0, pB1; float mnA, mnB, alA, alB; bf16x8 pa0, pa1, pa2, pa3;
    if constexpr (F32) { VMW(); SWRITE_VF(0); SBAR(); } else { SWRITE_HV(0); SBAR(); }
    if (NT > 1) { if constexpr (F32) SLOAD_F((const float*)Kh, KBASE(1)); else SLOAD_H(Kh, Vh, KBASE(1)); }
    SBAR(); qkt<0, SK>(pA0, pA1, K_lds, r32, hi, S.qr, ACT(0));
    if constexpr (F32) { if (NT > 1) { VMW(); SWRITE_KF(1); SBAR(); SLOAD_F((const float*)Vh, KBASE(1)); } }
    MASKT(pA0, pA1, 0); partialSM(pA0, pA1, m_reg, mnA, alA);
    if (NT > 1) { VMW(); if constexpr (F32) { SWRITE_VF(1); SBAR(); if (NT > 2) SLOAD_F((const float*)Kh, KBASE(2)); } else SWRITE_H(1); }
    __syncthreads();
#define HALF_STEP(PX0, PX1, mnX, alX, PY0, PY1, alY, t, KB, VB, SB) do {                                                      \
        SBAR(); qkt<KB, SK>(PX0, PX1, K_lds, r32, hi, S.qr, ACT(t));                                             \
        finishSM(PY0, PY1, alY, l_reg, pa0, pa1, pa2, pa3); SBAR();                                                           \
        if ((t) + 1 < NT) { if constexpr (F32) { VMW(); SWRITE_KF(SB); SBAR(); SLOAD_F((const float*)Vh, KBASE((t) + 1)); }  \
                            else { SLOAD_H(Kh, Vh, KBASE((t) + 1)); } SBAR(); }                                               \
        pv_tile<VB, SK>(o, vb0, pa0, pa1, pa2, pa3, ACT((t) - 1)); MASKT(PX0, PX1, (t)); partialSM(PX0, PX1, m_reg, mnX, alX);                                        \
        __syncthreads();                                                                                                      \
        if ((t) + 1 < NT) { VMW(); if constexpr (F32) { SWRITE_VF(SB); SBAR(); if ((t) + 2 < NT) SLOAD_F((const float*)Kh, KBASE((t) + 2)); } \
                            else { SWRITE_H(SB); } }                                                                          \
        RESC(alX); __syncthreads(); } while (0)
    for (int t = 1; t + 1 < NT; t += 2) {
        HALF_STEP(pB0, pB1, mnB, alB, pA0, pA1, alA, t, 1, 0, 0);
        HALF_STEP(pA0, pA1, mnA, alA, pB0, pB1, alB, t + 1, 0, 1, 1);
    }
    const bool even = (NT & 1) == 0;
    if (even) { SBAR(); qkt<1, SK>(pB0, pB1, K_lds, r32, hi, S.qr, ACT(NT - 1)); SBAR(); }
#define QROW(e) (nxt.Q + (size_t)(wid * QBLK + r32) * D + ((e) >> 1) * 16 + hi * 8 + ((e) & 1) * 4)
    if constexpr (F32) { SLOAD_F((const float*)nxt.K, kbn); SBAR();
#pragma unroll
        for (int e = 0; e < 8; ++e) S.tq[e] = *(const f32x4*)QROW(e); }
    else { SLOAD_H(nxt.K, nxt.V, kbn); SBAR();
#pragma unroll
        for (int d0 = 0; d0 < 8; ++d0) S.qr[d0] = load8<TIn>(nxt.Q + (size_t)(wid * QBLK + r32) * D + d0 * 16 + hi * 8); }
    SBAR();
    finishSM(pA0, pA1, alA, l_reg, pa0, pa1, pa2, pa3); SBAR();
    if constexpr (F32) {
#pragma unroll
        for (int e = 8; e < 16; ++e) S.tq[e] = *(const f32x4*)QROW(e); SBAR(); }
#undef QROW
    pv_tile<0, SK>(o, vb0, pa0, pa1, pa2, pa3, ACT(even ? NT - 2 : NT - 1));
    if (even) { MASKT(pB0, pB1, NT - 1); partialSM(pB0, pB1, m_reg, mnB, alB); __syncthreads(); RESC(alB);
        finishSM(pB0, pB1, alB, l_reg, pa0, pa1, pa2, pa3); SBAR(); pv_tile<1, SK>(o, vb0, pa0, pa1, pa2, pa3, ACT(NT - 1)); }
    SBAR(); SEAM_K0();
    if (hi == 0) li_l[r32] = l_reg; asm volatile("s_waitcnt lgkmcnt(0)" ::: "memory");
    float rli[16];
#pragma unroll
    for (int r = 0; r < 16; ++r) rli[r] = __builtin_amdgcn_rcpf(li_l[crow(r, hi)]);
    TOut* Ow = cur.O + (size_t)(wid * QBLK) * D;
#pragma unroll
    for (int r = 0; r < 16; ++r) { const int orow = crow(r, hi);
#pragma unroll
        for (int d0 = 0; d0 < 4; ++d0) { const float v = o[d0][r] * rli[r];
            if constexpr (same_t<TOut, float>::v) { Ow[(size_t)orow * D + d0 * 32 + r32] = v; }
            else { const float vn = __shfl_xor(v, 1);
                   if ((r32 & 1) == 0) *(unsigned*)(Ow + (size_t)orow * D + d0 * 32 + r32) = cvtpk(v, vn); } } }
    if constexpr (F32) {
#pragma unroll
        for (int d0 = 0; d0 < 8; ++d0) S.qr[d0] = pack8(S.tq[2 * d0], S.tq[2 * d0 + 1]); }
    __syncthreads();
#undef RESC
#undef KBASE
#undef ACT
#undef MASKT
#undef SEAM_K0
#undef HALF_STEP
}
#undef ROW
#undef VMW
#undef VMWN
#undef SLOAD_H
#undef SWRITE_HK
#undef SWRITE_HV
#undef SWRITE_H
#undef SLOAD_F
#undef SWRITE_KF
#undef SWRITE_VF
#undef KSWZ
#undef SBAR
}

namespace att2 {
typedef short bf16x8 __attribute__((ext_vector_type(8)));
typedef short s16x4 __attribute__((ext_vector_type(4)));
typedef float f32x16 __attribute__((ext_vector_type(16)));
typedef unsigned u32x4 __attribute__((ext_vector_type(4)));
constexpr float SCALE = 0.08838834764831845f, THR = 8.f, C2 = 1.4426950408889634f * SCALE;
constexpr int V_OFF = 0, K_OFF = 65536, PX_OFF = 98304, MX_OFF = 114688, WS_OFF = 118784, LDS_NEED = 120832;
#define A2_KSWZ(row, colB) ((row) * 256 + ((colB) ^ (((row) & 7) << 4)))
#define A2_SBAR() __builtin_amdgcn_sched_barrier(0)
template <int KB>
__device__ __forceinline__ void qkt(f32x16& p, const char* Kl, int krow, int hi, const bf16x8* qr) {
    p = f32x16{};
    const char* kbp[4];
#pragma unroll
    for (int dd = 0; dd < 4; ++dd) kbp[dd] = Kl + KB * 16384 + A2_KSWZ(krow, (dd * 16 + hi * 8) * 2);
    bf16x8 b[8];
#pragma unroll
    for (int d0 = 0; d0 < 8; ++d0) b[d0] = *reinterpret_cast<const bf16x8*>(kbp[d0 & 3] + (d0 >> 2) * 128);
    __builtin_amdgcn_s_setprio(3);
#pragma unroll
    for (int d0 = 0; d0 < 8; ++d0) p = __builtin_amdgcn_mfma_f32_32x32x16_bf16(b[d0], qr[d0], p, 0, 0, 0);
    __builtin_amdgcn_s_setprio(0);
}
template <int VOFFB>
__device__ __forceinline__ void pv(f32x16* o, int vb0, bf16x8 pa0, bf16x8 pa1, bf16x8 pa2, bf16x8 pa3) {
#define A2_TRRD(dst, off) asm volatile("ds_read_b64_tr_b16 %0, %1 offset:%2" : "=&v"(dst) : "v"(vb0), "i"(off) : "memory")
#define A2_PV_D0(d0) do { s16x4 l0, l1, l2, l3, h0, h1, h2, h3; constexpr int b_ = VOFFB + att::v_rd_off(d0, 0, 0); \
        A2_TRRD(l0, b_); A2_TRRD(h0, b_ + 2048); A2_TRRD(l1, b_ + 4096); A2_TRRD(h1, b_ + 6144); A2_TRRD(l2, b_ + 8192); A2_TRRD(h2, b_ + 10240); A2_TRRD(l3, b_ + 12288); A2_TRRD(h3, b_ + 14336); \
        asm volatile("s_waitcnt lgkmcnt(0)" ::: "memory"); A2_SBAR(); \
        o[d0] = __builtin_amdgcn_mfma_f32_32x32x16_bf16(pa0, (bf16x8){l0[0], l0[1], l0[2], l0[3], h0[0], h0[1], h0[2], h0[3]}, o[d0], 0, 0, 0); \
        o[d0] = __builtin_amdgcn_mfma_f32_32x32x16_bf16(pa1, (bf16x8){l1[0], l1[1], l1[2], l1[3], h1[0], h1[1], h1[2], h1[3]}, o[d0], 0, 0, 0); \
        o[d0] = __builtin_amdgcn_mfma_f32_32x32x16_bf16(pa2, (bf16x8){l2[0], l2[1], l2[2], l2[3], h2[0], h2[1], h2[2], h2[3]}, o[d0], 0, 0, 0); \
        o[d0] = __builtin_amdgcn_mfma_f32_32x32x16_bf16(pa3, (bf16x8){l3[0], l3[1], l3[2], l3[3], h3[0], h3[1], h3[2], h3[3]}, o[d0], 0, 0, 0); } while (0)
    __builtin_amdgcn_s_setprio(3); A2_PV_D0(0); A2_PV_D0(1); A2_PV_D0(2); A2_PV_D0(3); __builtin_amdgcn_s_setprio(0);
#undef A2_PV_D0
#undef A2_TRRD
}
__device__ __forceinline__ float rowmax16(const f32x16& p) {
    float pm = p[0];
#pragma unroll
    for (int r = 1; r < 16; ++r) pm = fmaxf(pm, p[r]);
    auto rr = __builtin_amdgcn_permlane32_swap(__float_as_uint(pm), __float_as_uint(pm), false, false);
    return fmaxf(__uint_as_float(rr[0]), __uint_as_float(rr[1]));
}
template <bool DEG>
__device__ __forceinline__ void block(const unsigned short* Q, const unsigned short* K, const unsigned short* V0, const unsigned short* V1, float* O0, float* O1, int P0, char* lds) {
    const int tid = opaque_tid(), wid = __builtin_amdgcn_readfirstlane(tid >> 6), lane = tid & 63, r32 = lane & 31, hi = lane >> 5, rg = wid >> 1, kh = wid & 1, hf = wid >> 2;
    const int NT = P0 / 64 + 2, qlo = P0 + 32 * rg;
    const int sr = tid >> 4, sc = (tid & 15) * 8, kws = A2_KSWZ(sr, sc * 2), vst0 = att::v_st(sr, sc), vst1 = att::v_st(32 + sr, sc);
    char* Vl = lds + V_OFF; char* Kl = lds + K_OFF;
    const int vb0 = (int)(uintptr_t)Vl + att::v_rd_base(lane) + kh * 16384, krow = 32 * kh + r32;
    float* wsl = (float*)(lds + WS_OFF) + wid * 64; float* al_l = wsl; float* li_l = wsl + 32;
    const float* li_p = (const float*)(lds + WS_OFF) + (wid ^ 1) * 64 + 32;
    float* mxw = (float*)(lds + MX_OFF) + wid * 64 + lane; const float* mxr = (const float*)(lds + MX_OFF) + (wid ^ 1) * 64 + lane;
    char* pxw = lds + PX_OFF + ((rg * 4 + 2 * kh) * 64 + lane) * 16; const char* pxr = lds + PX_OFF + (rg * 4 * 64 + lane) * 16;
    bf16x8 qr[8];
#pragma unroll
    for (int d0 = 0; d0 < 8; ++d0) qr[d0] = *reinterpret_cast<const bf16x8*>(Q + (size_t)(32 * rg + r32) * 128 + d0 * 16 + hi * 8);
    bf16x8 sk0, sk1, sv0, sv1, sv2, sv3;
#define A2_LOADK(t) do { const size_t o0_ = (size_t)((DEG ? 0 : (t)) * 64 + sr) * 128 + sc, o1_ = o0_ + 32 * 128; sk0 = *reinterpret_cast<const bf16x8*>(K + o0_); sk1 = *reinterpret_cast<const bf16x8*>(K + o1_); } while (0)
#define A2_LOADV(t) do { const size_t o0_ = (size_t)((DEG ? 0 : (t)) * 64 + sr) * 128 + sc, o1_ = o0_ + 32 * 128; \
        sv0 = *reinterpret_cast<const bf16x8*>(V0 + o0_); sv1 = *reinterpret_cast<const bf16x8*>(V0 + o1_); sv2 = *reinterpret_cast<const bf16x8*>(V1 + o0_); sv3 = *reinterpret_cast<const bf16x8*>(V1 + o1_); } while (0)
#define A2_BAR() do { asm volatile("s_waitcnt lgkmcnt(0)" ::: "memory"); __builtin_amdgcn_s_barrier(); asm volatile("" ::: "memory"); } while (0)
#define A2_WRITEK(b) do { *(bf16x8*)(Kl + (b) * 16384 + kws) = sk0; *(bf16x8*)(Kl + (b) * 16384 + kws + 32 * 256) = sk1; } while (0)
#define A2_WRITEV(b) do { *(bf16x8*)(Vl + (b) * 32768 + vst0) = sv0; *(bf16x8*)(Vl + (b) * 32768 + vst1) = sv1; *(bf16x8*)(Vl + (b) * 32768 + 16384 + vst0) = sv2; *(bf16x8*)(Vl + (b) * 32768 + 16384 + vst1) = sv3; } while (0)
#define A2_VMW(n) asm volatile("s_waitcnt vmcnt(%0)" :: "i"(n) : "memory")
#define A2_MASKMAX(PX, pmX, t) do { const int kb_ = (t) * 64 + 32 * kh; \
        if (__builtin_expect(kb_ + 31 > qlo, 0)) { asm volatile("; diagonal tile: mask" ::: "memory");     \
            const int dq_ = qlo + r32 - kb_ - 4 * hi; const float NEG_ = -__builtin_inff(); \
            _Pragma("unroll") for (int r = 0; r < 16; ++r) { const int c_ = (r & 3) + 8 * (r >> 2); if (dq_ - c_ < 0) PX[r] = NEG_; } } \
        pmX = rowmax16(PX); mxw[((t) & 1) * 512] = pmX; } while (0)
#define A2_FINISH(PY, pmY, alY, u) do { const float pm_ = fmaxf(pmY, mxr[((u) & 1) * 512]); float mn_; \
        if (__builtin_expect(__all((pm_ - m_reg) * SCALE <= THR), 1)) { mn_ = m_reg; alY = 1.f; } \
        else { mn_ = fmaxf(m_reg, pm_); alY = __builtin_amdgcn_exp2f((m_reg - mn_) * C2); m_reg = mn_; } \
        const float mnL_ = -mn_ * C2; \
        _Pragma("unroll") for (int r = 0; r < 16; ++r) PY[r] = __builtin_amdgcn_exp2f(fmaf(PY[r], C2, mnL_)); \
        float ps_ = 0.f; _Pragma("unroll") for (int r = 0; r < 16; ++r) ps_ += PY[r]; \
        { auto rr_ = __builtin_amdgcn_permlane32_swap(__float_as_uint(ps_), __float_as_uint(ps_), false, false); ps_ = __uint_as_float(rr_[0]) + __uint_as_float(rr_[1]); } \
        l_reg = l_reg * alY + ps_; \
        A2_PK4(PY, 0, pxw); A2_PK4(PY, 8, pxw + 1024); } while (0)
#define A2_PK4(P, B_, DST) do { unsigned a0_ = att::cvtpk(P[B_ + 0], P[B_ + 1]), a1_ = att::cvtpk(P[B_ + 2], P[B_ + 3]), b0_ = att::cvtpk(P[B_ + 4], P[B_ + 5]), b1_ = att::cvtpk(P[B_ + 6], P[B_ + 7]); \
        auto r0_ = __builtin_amdgcn_permlane32_swap(a0_, b0_, false, false); auto r1_ = __builtin_amdgcn_permlane32_swap(a1_, b1_, false, false); \
        u32x4 w_ = {r0_[0], r1_[0], r0_[1], r1_[1]}; *(u32x4*)(DST) = w_; } while (0)
#define A2_PVSTEP(alY, VOFFB) do { const bf16x8 pa0_ = *reinterpret_cast<const bf16x8*>(pxr), pa1_ = *reinterpret_cast<const bf16x8*>(pxr + 1024), pa2_ = *reinterpret_cast<const bf16x8*>(pxr + 2048), pa3_ = *reinterpret_cast<const bf16x8*>(pxr + 3072); \
        if (__any((alY) < 1.f)) { if (hi == 0) al_l[r32] = (alY); asm volatile("s_waitcnt lgkmcnt(0)" ::: "memory"); \
            _Pragma("unroll") for (int d_ = 0; d_ < 4; ++d_) _Pragma("unroll") for (int r = 0; r < 16; ++r) o[d_][r] *= al_l[att::crow(r, hi)]; } \
        pv<VOFFB>(o, vb0, pa0_, pa1_, pa2_, pa3_); } while (0)
#define A2_STEP(PX, pmX, PY, pmY, alY, t, KB) do { \
        A2_FINISH(PY, pmY, alY, (t) - 1); A2_SBAR(); \
        qkt<KB>(PX, Kl, krow, hi, qr); A2_SBAR(); \
        A2_MASKMAX(PX, pmX, t); A2_SBAR(); \
        if ((t) + 1 < NT) { A2_VMW(4); A2_WRITEK(1 - KB); if ((t) + 2 < NT) A2_LOADK((t) + 2); } \
        A2_BAR(); \
        A2_PVSTEP(alY, (1 - KB) * 32768); A2_SBAR(); \
        if ((t) + 2 < NT) A2_VMW(2); else A2_VMW(0); \
        A2_WRITEV(KB); if ((t) + 1 < NT) A2_LOADV((t) + 1); \
        A2_BAR(); } while (0)
    float m_reg = -1e30f, l_reg = 0.f; f32x16 o[4] = {};
    f32x16 pA, pB; float pmA, pmB, alA = 1.f, alB = 1.f;
    A2_LOADK(0); A2_VMW(0); A2_WRITEK(0); A2_LOADK(1); A2_LOADV(0);
    A2_BAR();
    if (hf == 1) A2_BAR();
    qkt<0>(pA, Kl, krow, hi, qr); A2_SBAR();
    A2_MASKMAX(pA, pmA, 0); A2_SBAR();
    A2_VMW(4); A2_WRITEK(1); if (2 < NT) A2_LOADK(2);
    A2_BAR();
    if (2 < NT) A2_VMW(2); else A2_VMW(0);
    A2_WRITEV(0); A2_LOADV(1);
    A2_BAR();
    A2_STEP(pB, pmB, pA, pmA, alA, 1, 1);
    for (int t = 2; t < NT; t += 2) {
        A2_STEP(pA, pmA, pB, pmB, alB, t, 0);
        A2_STEP(pB, pmB, pA, pmA, alA, t + 1, 1);
    }
    A2_FINISH(pB, pmB, alB, NT - 1);
    A2_BAR();
    A2_PVSTEP(alB, 32768);
    if (hf == 0) A2_BAR();
    if (hi == 0) li_l[r32] = l_reg;
    A2_BAR();
    float rli[16];
#pragma unroll
    for (int r = 0; r < 16; ++r) rli[r] = __builtin_amdgcn_rcpf(li_l[att::crow(r, hi)] + li_p[att::crow(r, hi)]);
    float* Ow = (kh ? O1 : O0) + (size_t)(32 * rg) * 128;
#pragma unroll
    for (int r = 0; r < 16; ++r) { const int orow = att::crow(r, hi);
#pragma unroll
        for (int d0 = 0; d0 < 4; ++d0) Ow[(size_t)orow * 128 + d0 * 32 + r32] = o[d0][r] * rli[r]; }
    A2_BAR();
#undef A2_LOADK
#undef A2_LOADV
#undef A2_BAR
#undef A2_WRITEK
#undef A2_WRITEV
#undef A2_VMW
#undef A2_MASKMAX
#undef A2_FINISH
#undef A2_PK4
#undef A2_PVSTEP
#undef A2_STEP
}
#undef A2_KSWZ
#undef A2_SBAR
}

#ifndef MK_PER_PHASE
#define MK_PER_PHASE 0
#endif
constexpr int NWAVES = 8, NTHR = 512;
constexpr int SEQ = 16384, DM = 4096, FFH = 11008, DEPTH = 4, NMODV = 6 * DM;
#ifndef PADK
#define PADK 64
#endif
constexpr int LDD = DM + PADK, LDF = FFH + PADK;
constexpr int ZG = 96;
constexpr size_t GS = (size_t)SEQ * 128;
constexpr int S5T = 64, S5NC = SEQ / S5T;
constexpr int KSL = 16;
constexpr float NORM_EPS = 1e-6f, SUBLN_EPS = 1e-5f;
constexpr int N_PHASES = 35;

constexpr size_t MiB = 1u << 20;
constexpr size_t WS_CTL = 0, CTL_ZERO_BYTES = 64 * 1024;
constexpr size_t WS_MODP = 1 * MiB;
constexpr size_t WS_MODL = 3 * MiB;
constexpr size_t WS_LAM = 3 * MiB + 512 * 1024;
constexpr size_t WS_S5P = 4 * MiB, S5P_LAYER = 4 * MiB + 256 * 1024;
constexpr size_t S5P_ABR = 0, S5P_ABI = 64 * 1024, S5P_ATR = 128 * 1024, S5P_ATI = 192 * 1024, S5P_BBR = 256 * 1024, S5P_BBI = 256 * 1024 + MiB;
constexpr size_t S5P_BBOP = 256 * 1024 + 2 * MiB, S5P_COP = 256 * 1024 + 3 * MiB;
#ifndef S5_MFMA
#define S5_MFMA 1
#endif
constexpr size_t W_IN_B = (size_t)12288 * LDD * 2, W_OUT_B = (size_t)4096 * LDD * 2, W_GLU_B = (size_t)8192 * LDD * 2, W_GU_B = (size_t)22016 * LDD * 2, W_DN_B = (size_t)4096 * LDF * 2;
constexpr size_t WS_WIN = 16 * MiB, WS_WOUT = WS_WIN + 2 * W_IN_B, WS_WGLU = WS_WOUT + 2 * W_OUT_B, WS_WGU = WS_WGLU + 2 * W_GLU_B, WS_WDN = WS_WGU + 4 * W_GU_B;
constexpr size_t WS_H = WS_WDN + 4 * W_DN_B;
constexpr size_t WS_MIX = WS_H + (size_t)SEQ * LDD * 2;
constexpr size_t WS_Z = WS_MIX + (size_t)SEQ * LDD * 2;
constexpr size_t WS_OT = WS_Z + (size_t)ZG * GS * 2;
constexpr size_t WS_S5F = WS_OT + (size_t)32 * GS * 4;
constexpr size_t WS_S5H = WS_S5F + (size_t)S5NC * 256 * 128 * 4;
constexpr size_t WS_END = WS_S5H + (size_t)S5NC * 256 * 128 * 4;
static_assert((size_t)SEQ * LDF * 2 <= (size_t)ZG * GS * 2, "hidden overlays Z");
static_assert(WS_WIN % 256 == 0 && WS_H % 256 == 0 && WS_OT % 256 == 0 && WS_S5F % 256 == 0, "alignment");
constexpr int CW_BAR = 1024;

constexpr int RING_BYTES = 131072, MISC_OFF = RING_BYTES + 320, LDS_BYTES = 147456;

#define GAS __attribute__((address_space(1)))
#define LAS __attribute__((address_space(3)))
typedef unsigned short bf16;
typedef unsigned v4u __attribute__((ext_vector_type(4)));
typedef unsigned v2u __attribute__((ext_vector_type(2)));
typedef float f32x4 __attribute__((ext_vector_type(4)));
#define LDS_WAIT() asm volatile("s_waitcnt lgkmcnt(0)" ::: "memory")
#define VM_WAIT() asm volatile("s_waitcnt vmcnt(0)" ::: "memory")
__device__ __forceinline__ unsigned pk2(float lo, float hi) { unsigned r; asm volatile("v_cvt_pk_bf16_f32 %0, %1, %2" : "=v"(r) : "v"(lo), "v"(hi)); return r; }
__device__ __forceinline__ float bflo(unsigned w) { return __builtin_bit_cast(float, w << 16); }
__device__ __forceinline__ float bfhi(unsigned w) { return __builtin_bit_cast(float, w & 0xffff0000u); }

#define XB_TMO      128
#define XB_XCNT(j)  (256  + 64 * (j))
#define XB_XSUB(j)  (1280 + 64 * (j))
#define XB_XGEN(j)  (2304 + 64 * (j))
#define XB_TOP      3328
#define XB_TOPGEN   3392
#define XCD_BAR_WORDS 3456
#define XB_SPIN_CAP (1u << 22)

__device__ __forceinline__ unsigned xb_ld(unsigned* p)              { return __hip_atomic_load(p, __ATOMIC_RELAXED, __HIP_MEMORY_SCOPE_AGENT); }
__device__ __forceinline__ unsigned xb_add(unsigned* p, unsigned v) { return __hip_atomic_fetch_add(p, v, __ATOMIC_RELAXED, __HIP_MEMORY_SCOPE_AGENT); }
__device__ __forceinline__ unsigned xb_xcc_id() { return (unsigned)__builtin_amdgcn_s_getreg((3 << 11) | 20) & 0xFu; }
#define XB_SPIN(cond, bar) do { unsigned _sp = 0; while (cond) { __builtin_amdgcn_s_sleep(1); \
    if ((++_sp & 255u) == 0u) { if (xb_ld(&(bar)[XB_TMO])) break; if (_sp > XB_SPIN_CAP) { atomicAdd(&(bar)[XB_TMO], 1u); break; } } } } while (0)

struct XcdBarrier {
    unsigned* bar; unsigned x;
    volatile LAS unsigned* st;
};
__device__ __forceinline__ XcdBarrier xcd_barrier_post(unsigned* bar, volatile LAS unsigned* st) {
    XcdBarrier b; b.bar = bar; b.x = xb_xcc_id(); b.st = st;
    if (threadIdx.x == 0) (void)xb_add(&bar[XB_XCNT(b.x)], 1u);
    return b;
}
__device__ __forceinline__ void xcd_barrier_complete(unsigned* bar, unsigned x, unsigned& nloc, unsigned& nx) {
    const unsigned G = gridDim.x * gridDim.y * gridDim.z;
    unsigned sum, cnt, mine, sp = 0u;
    for (;;) {
        sum = 0u; cnt = 0u; mine = 0u;
#pragma unroll
        for (unsigned j = 0; j < 16; ++j) { const unsigned c = xb_ld(&bar[XB_XCNT(j)]); sum += c; cnt += (c > 0u) ? 1u : 0u; mine = (j == x) ? c : mine; }
        if (sum == G) break;
        __builtin_amdgcn_s_sleep(1);
        if ((++sp & 255u) == 0u) { if (xb_ld(&bar[XB_TMO])) break; if (sp > XB_SPIN_CAP) { atomicAdd(&bar[XB_TMO], 1u); break; } }
    }
    nloc = mine > 0u ? mine : 1u; nx = cnt > 0u ? cnt : 1u;
}
__device__ __forceinline__ void xcd_barrier(const XcdBarrier& b) {
    asm volatile("s_waitcnt vmcnt(0)" ::: "memory");
    __syncthreads();
    if (threadIdx.x == 0) {
        unsigned* bar = b.bar;
        __builtin_amdgcn_s_waitcnt(0);
        unsigned nloc = b.st[0], nx = b.st[1];
        if (nloc == 0u) { xcd_barrier_complete(bar, b.x, nloc, nx); b.st[0] = nloc; b.st[1] = nx; }
        const unsigned old = xb_add(&bar[XB_XSUB(b.x)], 1u);
        const unsigned gen = old / nloc;
        if (old + 1u == (gen + 1u) * nloc) {
            __builtin_amdgcn_fence(__ATOMIC_RELEASE, "agent");
            asm volatile("s_waitcnt vmcnt(0)" ::: "memory");
            const unsigned og = xb_add(&bar[XB_TOP], 1u);
            const unsigned tg = og / nx;
            if (og + 1u == (tg + 1u) * nx) xb_add(&bar[XB_TOPGEN], 1u);
            else XB_SPIN(xb_ld(&bar[XB_TOPGEN]) == tg, bar);
            __builtin_amdgcn_fence(__ATOMIC_ACQUIRE, "agent");
            xb_add(&bar[XB_XGEN(b.x)], 1u);
            asm volatile("s_waitcnt vmcnt(0)" ::: "memory");
        } else {
            XB_SPIN(xb_ld(&bar[XB_XGEN(b.x)]) == gen, bar);
            __builtin_amdgcn_fence(__ATOMIC_ACQUIRE, "agent");
            asm volatile("s_waitcnt vmcnt(0)" ::: "memory");
        }
    }
    __syncthreads();
}

__device__ __forceinline__ float wave_sum(float v) {
#pragma unroll
    for (int o = 1; o < 64; o <<= 1) v += __shfl_xor(v, o);
    return v;
}

__device__ __forceinline__ void transpose_item(const float* W, int K, int N, bf16* WT, int ldw, int mode, LAS float* scr, int item, int lane) {
    const int nblk = N / 32, kb = item / nblk, nb = item - kb * nblk, k0 = 64 * kb, n0 = 32 * nb;
    const int drow0 = mode == 0 ? n0 : ((n0 >> 7) * 256 + (n0 & 127) + (mode == 2 ? 128 : 0));
#pragma unroll 8
    for (int i = 0; i < 32; ++i) { const int kk = 2 * i + (lane >> 5); scr[kk * 33 + (lane & 31)] = W[(size_t)(k0 + kk) * N + n0 + (lane & 31)]; }
    LDS_WAIT(); asm volatile("" ::: "memory");
    const int c = lane & 7;
#pragma unroll
    for (int j = 0; j < 4; ++j) { const int n = (lane >> 3) + 8 * j; const LAS float* s = scr + (8 * c) * 33 + n;
        v4u o; o.x = pk2(s[0 * 33], s[1 * 33]); o.y = pk2(s[2 * 33], s[3 * 33]); o.z = pk2(s[4 * 33], s[5 * 33]); o.w = pk2(s[6 * 33], s[7 * 33]);
        *(v4u*)(WT + (size_t)(drow0 + n) * ldw + k0 + 8 * c) = o; }
    LDS_WAIT(); asm volatile("" ::: "memory");
}
__device__ __forceinline__ void dsincos(double x, double& s, double& c) {
    const double k = rint(x * 0.63661977236758134308);
    double r = fma(-k, 1.5707963267948966192, x); r = fma(-k, 6.1232339957367658860e-17, r);
    const double r2 = r * r;
    double ps = -1.0 / 1307674368000.0; ps = fma(ps, r2, 1.0 / 6227020800.0); ps = fma(ps, r2, -1.0 / 39916800.0); ps = fma(ps, r2, 1.0 / 362880.0); ps = fma(ps, r2, -1.0 / 5040.0);
    ps = fma(ps, r2, 1.0 / 120.0); ps = fma(ps, r2, -1.0 / 6.0); ps = fma(ps, r2, 1.0); const double sn = r * ps;
    double pc = 1.0 / 20922789888000.0; pc = fma(pc, r2, -1.0 / 87178291200.0); pc = fma(pc, r2, 1.0 / 479001600.0); pc = fma(pc, r2, -1.0 / 3628800.0); pc = fma(pc, r2, 1.0 / 40320.0);
    pc = fma(pc, r2, -1.0 / 720.0); pc = fma(pc, r2, 1.0 / 24.0); pc = fma(pc, r2, -0.5); const double cs = fma(pc, r2, 1.0);
    const int q = (int)k & 3;
    s = (q == 0) ? sn : (q == 1) ? cs : (q == 2) ? -sn : -cs;
    c = (q == 0) ? cs : (q == 1) ? -sn : (q == 2) ? -cs : sn;
}
__device__ __forceinline__ double dexp(double x) {
    const double k = rint(x * 1.4426950408889634074);
    double r = fma(-k, 0.69314718055994528623, x); r = fma(-k, 2.3190468138462995584e-17, r);
    double p = 1.0 / 87178291200.0; p = fma(p, r, 1.0 / 6227020800.0); p = fma(p, r, 1.0 / 479001600.0); p = fma(p, r, 1.0 / 39916800.0); p = fma(p, r, 1.0 / 3628800.0); p = fma(p, r, 1.0 / 362880.0);
    p = fma(p, r, 1.0 / 40320.0); p = fma(p, r, 1.0 / 5040.0); p = fma(p, r, 1.0 / 720.0); p = fma(p, r, 1.0 / 120.0); p = fma(p, r, 1.0 / 24.0); p = fma(p, r, 1.0 / 6.0); p = fma(p, r, 0.5); p = fma(p, r, 1.0); p = fma(p, r, 1.0);
    const long long bits = (long long)(1023 + (int)k) << 52;
    return p * __builtin_bit_cast(double, bits);
}

struct Args { const float* in[29]; float* out; unsigned char* ws; int ph_lo, ph_hi; };

__device__ __forceinline__ void p0_prologue(const Args& A, LAS unsigned char* lds, int gw, int NGW, int wave, int lane) {
    unsigned char* ws = A.ws;
    for (int w = gw; w < 96 * KSL + 512 + 2048; w += NGW) {
    if (w >= 96 * KSL + 512) {
        const int idx = (w - 96 * KSL - 512) * 64 + lane, o = idx >> 16, r = idx & 65535, g = r >> 8, mm = (r >> 6) & 3, o16 = lane & 15, kq = lane >> 4;
        const int tau = 2 * mm, p0 = 16 * (tau & 3) + 4 * kq;
        const float* cs = (tau < 4 ? A.in[21] : A.in[22]) + (size_t)o * 256 * 16 * 64 + (size_t)(g * 16 + o16) * 64 + p0; const float sg = tau < 4 ? 1.0f : -1.0f;
        const f32x4 a = *(const f32x4*)cs * sg, b = *(const f32x4*)(cs + 16) * sg;
        v4u q; q.x = pk2(a.x, a.y); q.y = pk2(a.z, a.w); q.z = pk2(b.x, b.y); q.w = pk2(b.z, b.w);
        *(v4u*)(ws + WS_S5P + (size_t)o * S5P_LAYER + S5P_COP + ((size_t)((g * 4 + mm) * 64 + lane)) * 16) = q;
    } else if (w < 96 * KSL) {
        const int nb = w % 96, ks = w / 96;
        const float* wp = A.in[2] + (size_t)(ks * 256) * NMODV + nb * 256 + lane * 4; const float* cp = A.in[1] + ks * 256;
        f32x4 a = {0.f, 0.f, 0.f, 0.f};
#pragma unroll 8
        for (int k = 0; k < 256; ++k) { const float cv = cp[k]; const float s = cv / (1.0f + expf(-cv)); const f32x4 w = *(const f32x4*)(wp + (size_t)k * NMODV); a += s * w; }
        *(f32x4*)((float*)(ws + WS_MODP) + (size_t)ks * NMODV + nb * 256 + lane * 4) = a;
    } else {
        const int idx = (w - 96 * KSL) * 64 + lane, o = idx >> 14, gp = idx & 16383, g = gp >> 6;
        const double lr = (double)fminf(A.in[16][idx], -1e-4f), li = (double)A.in[17][idx], dt = dexp((double)A.in[18][o * 256 + g]);
        const double mag = dexp(lr * dt); double sn, cs; dsincos(li * dt, sn, cs);
        const double abr = mag * cs, abi = mag * sn, den = lr * lr + li * li, nr = abr - 1.0, ni = abi;
        const double fre = (nr * lr + ni * li) / den, fim = (ni * lr - nr * li) / den;
        double tr = abr, ti = abi;
#pragma unroll
        for (int q = 0; q < 6; ++q) { const double t2 = tr * tr - ti * ti; ti = 2.0 * tr * ti; tr = t2; }
        unsigned char* pb = ws + WS_S5P + (size_t)o * S5P_LAYER;
        ((float*)(pb + S5P_ABR))[gp] = (float)abr; ((float*)(pb + S5P_ABI))[gp] = (float)abi; ((float*)(pb + S5P_ATR))[gp] = (float)tr; ((float*)(pb + S5P_ATI))[gp] = (float)ti;
        const float* bre = A.in[19] + (size_t)idx * 16; const float* bim = A.in[20] + (size_t)idx * 16;
        float* obr = (float*)(pb + S5P_BBR) + (size_t)gp * 16; float* obi = (float*)(pb + S5P_BBI) + (size_t)gp * 16;
#pragma unroll
        for (int h4 = 0; h4 < 4; ++h4) { const f32x4 br = *(const f32x4*)(bre + 4 * h4), bi = *(const f32x4*)(bim + 4 * h4); f32x4 r, i;
#pragma unroll
            for (int j = 0; j < 4; ++j) { r[j] = (float)(fre * (double)br[j] - fim * (double)bi[j]); i[j] = (float)(fre * (double)bi[j] + fim * (double)br[j]); }
            *(f32x4*)(obr + 4 * h4) = r; *(f32x4*)(obi + 4 * h4) = i; }
        { const int p = gp & 63, ti = p >> 4, i16 = p & 15;
#pragma unroll
          for (int kq = 0; kq < 4; ++kq) { const f32x4 r = *(const f32x4*)(obr + 4 * kq), i = *(const f32x4*)(obi + 4 * kq);
              v2u pr, pi; pr.x = pk2(r.x, r.y); pr.y = pk2(r.z, r.w); pi.x = pk2(i.x, i.y); pi.y = pk2(i.z, i.w);
              *(v2u*)(pb + S5P_BBOP + ((size_t)((g * 8 + ti) * 64 + kq * 16 + i16)) * 8) = pr; *(v2u*)(pb + S5P_BBOP + ((size_t)((g * 8 + 4 + ti) * 64 + kq * 16 + i16)) * 8) = pi; } }
    }
    }
    if (gw < 2) { const int e = gw;
        const float s1 = wave_sum(A.in[10][e * 128 + lane] * A.in[11][e * 128 + lane] + A.in[10][e * 128 + 64 + lane] * A.in[11][e * 128 + 64 + lane]);
        const float s2 = wave_sum(A.in[12][e * 128 + lane] * A.in[13][e * 128 + lane] + A.in[12][e * 128 + 64 + lane] * A.in[13][e * 128 + 64 + lane]);
        const float lam_init = e == 0 ? 0.2f : 0.4707130183435842f;
        if (lane == 0) ((float*)(ws + WS_LAM))[e] = expf(s1) - expf(s2) + lam_init; }
    LAS float* scr = (LAS float*)(lds + wave * 16384);
    constexpr int I_IN = 64 * 384, I_OUT = 64 * 128, I_GLU = 64 * 128, I_GU = 64 * 344, I_DN = 172 * 128;
    constexpr int NITEMS = 2 * I_IN + 2 * I_OUT + 4 * I_GLU + 8 * I_GU + 4 * I_DN;
    for (int it = gw; it < NITEMS; it += NGW) {
        int r = it;
        if (r < 2 * I_IN) { const int e = r / I_IN; transpose_item(A.in[8] + (size_t)e * DM * 12288, DM, 12288, (bf16*)(ws + WS_WIN + e * W_IN_B), LDD, 0, scr, r - e * I_IN, lane); continue; } r -= 2 * I_IN;
        if (r < 2 * I_OUT) { const int e = r / I_OUT; transpose_item(A.in[15] + (size_t)e * DM * DM, DM, DM, (bf16*)(ws + WS_WOUT + e * W_OUT_B), LDD, 0, scr, r - e * I_OUT, lane); continue; } r -= 2 * I_OUT;
        if (r < 4 * I_GLU) { const int q = r / I_GLU, o = q >> 1, s = q & 1; transpose_item(A.in[24 + s] + (size_t)o * DM * DM, DM, DM, (bf16*)(ws + WS_WGLU + o * W_GLU_B), LDD, 1 + s, scr, r - q * I_GLU, lane); continue; } r -= 4 * I_GLU;
        if (r < 8 * I_GU) { const int q = r / I_GU, l = q >> 1, s = q & 1; transpose_item(A.in[26 + s] + (size_t)l * DM * FFH, DM, FFH, (bf16*)(ws + WS_WGU + l * W_GU_B), LDD, 1 + s, scr, r - q * I_GU, lane); continue; } r -= 8 * I_GU;
        { const int l = r / I_DN; transpose_item(A.in[28] + (size_t)l * FFH * DM, FFH, DM, (bf16*)(ws + WS_WDN + l * W_DN_B), LDF, 0, scr, r - l * I_DN, lane); }
    }
}
__device__ __forceinline__ void p1_modvec(const Args& A, int gtid, int NGT) {
    const float* mp = (const float*)(A.ws + WS_MODP); float* ml = (float*)(A.ws + WS_MODL);
    for (int i = gtid; i < DEPTH * NMODV; i += NGT) { const int j = i % NMODV; float v = A.in[3][j] + A.in[4][i];
#pragma unroll
        for (int ks = 0; ks < KSL; ++ks) v += mp[(size_t)ks * NMODV + j];
        ml[i] = v; }
}
__device__ __forceinline__ void norm_mod_phase(const float* src, const float* nw, const float* sh, const float* sc, bf16* dst, LAS unsigned char* lds, int tid, int gw, int NGW, int lane) {
    LAS float* w1 = (LAS float*)lds; LAS float* bb = w1 + DM;
    for (int i = tid; i < DM; i += NTHR) { w1[i] = nw[i] * (1.0f + sc[i]); bb[i] = sh[i]; }
    __syncthreads();
    for (int m = gw; m < SEQ; m += NGW) {
        const f32x4* xr = (const f32x4*)(src + (size_t)m * DM) + lane;
        f32x4 v[16]; float ss = 0.f;
#pragma unroll
        for (int j = 0; j < 16; ++j) { v[j] = xr[64 * j]; ss += (v[j].x * v[j].x + v[j].y * v[j].y) + (v[j].z * v[j].z + v[j].w * v[j].w); }
        const float rstd = 1.0f / sqrtf(wave_sum(ss) * (1.0f / DM) + NORM_EPS);
        v2u* o8 = (v2u*)(dst + (size_t)m * LDD) + lane;
#pragma unroll
        for (int j = 0; j < 16; ++j) { const int col = j * 256 + lane * 4; const f32x4 w = *(const LAS f32x4*)(w1 + col), b = *(const LAS f32x4*)(bb + col);
            const f32x4 y = v[j] * rstd * w + b; v2u p; p.x = pk2(y.x, y.y); p.y = pk2(y.z, y.w); o8[64 * j] = p; }
    }
    __syncthreads();
}
__device__ __forceinline__ void final_norm_phase(const float* src, const float* nw, float* dst, int gw, int NGW, int lane) {
    for (int m = gw; m < SEQ; m += NGW) {
        const f32x4* xr = (const f32x4*)(src + (size_t)m * DM) + lane;
        f32x4 v[16]; float ss = 0.f;
#pragma unroll
        for (int j = 0; j < 16; ++j) { v[j] = xr[64 * j]; ss += (v[j].x * v[j].x + v[j].y * v[j].y) + (v[j].z * v[j].z + v[j].w * v[j].w); }
        const float rstd = 1.0f / sqrtf(wave_sum(ss) * (1.0f / DM) + NORM_EPS);
        f32x4* o = (f32x4*)(dst + (size_t)m * DM) + lane; const f32x4* wv = (const f32x4*)nw + lane;
#pragma unroll
        for (int j = 0; j < 16; ++j) o[64 * j] = v[j] * rstd * wv[64 * j];
    }
}
__device__ __forceinline__ void conv_phase(const bf16* Z, const float* cw, bf16* MIX, int gtid, int NGT) {
    for (int i = gtid; i < SEQ * 256; i += NGT) {
        const int t = i >> 8, r = i & 255, gi = r >> 4, c8 = (r & 15) * 8;
        const size_t o = (size_t)t * 128 + c8;
        const v4u zero = {0u, 0u, 0u, 0u};
        const v4u vb = *(const v4u*)(Z + (size_t)gi * GS + o);
        const bf16* zc = Z + (size_t)(16 + gi) * GS + o; const bf16* zx = Z + (size_t)(32 + gi) * GS + o;
        const v4u c0 = *(const v4u*)zc, x0 = *(const v4u*)zx;
        const v4u c1 = t >= 1 ? *(const v4u*)(zc - 128) : zero, x1 = t >= 1 ? *(const v4u*)(zx - 128) : zero;
        const v4u c2 = t >= 2 ? *(const v4u*)(zc - 256) : zero, x2 = t >= 2 ? *(const v4u*)(zx - 256) : zero;
        const float* wp = cw + gi * 128 + c8;
        float y[8];
#pragma unroll
        for (int q = 0; q < 4; ++q) {
            const float u0l = bflo(c0[q]) * bflo(x0[q]), u0h = bfhi(c0[q]) * bfhi(x0[q]);
            const float u1l = bflo(c1[q]) * bflo(x1[q]), u1h = bfhi(c1[q]) * bfhi(x1[q]);
            const float u2l = bflo(c2[q]) * bflo(x2[q]), u2h = bfhi(c2[q]) * bfhi(x2[q]);
            const int j = 2 * q;
            y[j]     = bflo(vb[q]) * (wp[2 * 2048 + j] * u0l + wp[2048 + j] * u1l + wp[j] * u2l);
            y[j + 1] = bfhi(vb[q]) * (wp[2 * 2048 + j + 1] * u0h + wp[2048 + j + 1] * u1h + wp[j + 1] * u2h);
        }
        v4u w; w.x = pk2(y[0], y[1]); w.y = pk2(y[2], y[3]); w.z = pk2(y[4], y[5]); w.w = pk2(y[6], y[7]);
        *(v4u*)(MIX + (size_t)t * LDD + gi * 128 + c8) = w;
    }
}
__device__ __forceinline__ void combine_phase(const float* OT, const float* lamp, const float* sg, float lam_init, bf16* MIX, int gw, int NGW, int lane) {
    const float lam = lamp[0], os = 1.0f - lam_init;
    const int j = lane >> 5, c4 = (lane & 31) * 4;
    const f32x4 gv = *(const f32x4*)(sg + 128 * j + c4);
    for (int it0 = gw * 4; it0 < SEQ * 8; it0 += NGW * 4) {
        f32x4 a[4], b[4];
#pragma unroll
        for (int q = 0; q < 4; ++q) { const int it = it0 + q, t = it >> 3, h = it & 7;
            a[q] = *(const f32x4*)(OT + (size_t)(h * 4 + j) * GS + (size_t)t * 128 + c4); b[q] = *(const f32x4*)(OT + (size_t)(h * 4 + 2 + j) * GS + (size_t)t * 128 + c4); }
#pragma unroll
        for (int q = 0; q < 4; ++q) { const int it = it0 + q, t = it >> 3, h = it & 7;
            const f32x4 o = a[q] - lam * b[q];
            const float rstd = 1.0f / sqrtf(wave_sum((o.x * o.x + o.y * o.y) + (o.z * o.z + o.w * o.w)) * (1.0f / 256.0f) + SUBLN_EPS);
            const f32x4 y = o * (rstd * os) * gv;
            v2u p; p.x = pk2(y.x, y.y); p.y = pk2(y.z, y.w);
            *(v2u*)(MIX + (size_t)t * LDD + 2048 + 256 * h + 128 * j + c4) = p; }
    }
}
__device__ __forceinline__ att::BlockRef<att::bf16, float> att_ref(const bf16* Z, float* OT, int item, int pass) {
    const int r = item >> 8, b = item & 255, vh = r * 8 + (b & 7), pair = b >> 3, qb = pass ? 63 - pair : pair;
    const int h = vh >> 2, m = (vh >> 1) & 1, j = vh & 1;
    att::BlockRef<att::bf16, float> R;
    R.Q = (const att::bf16*)(Z + (size_t)(48 + 2 * h + m) * GS + (size_t)qb * 256 * 128);
    R.K = (const att::bf16*)(Z + (size_t)(64 + 2 * h + m) * GS);
    R.V = (const att::bf16*)(Z + (size_t)(80 + 2 * h + j) * GS);
    R.O = OT + (size_t)vh * GS + (size_t)qb * 256 * 128; R.P0 = qb * 256;
    return R;
}
__device__ __forceinline__ void attn_phase(const bf16* Z, float* OT, char* lds, int bid, int G) {
    constexpr int TOTAL = 1024;
    int item = bid; if (item >= TOTAL) return;
    int pass = 0;
    att::BlockRef<att::bf16, float> cur = att_ref(Z, OT, item, 0);
    att::Seam<att::bf16> S;
    att::causal_swa_prime<att::bf16, float>(cur, SEQ, lds, S);
    for (;;) {
        const bool more_pass = pass == 0, more_item = item + G < TOTAL, last = !more_pass && !more_item;
        int itn = item, passn = 1;
        if (!more_pass) { passn = 0; itn = more_item ? item + G : item; }
        const att::BlockRef<att::bf16, float> nxt = last ? cur : att_ref(Z, OT, itn, passn);
        att::causal_swa_block<att::bf16, float>(cur, nxt, SEQ, SEQ, lds, S);
        if (last) break;
        cur = nxt; item = itn; pass = passn;
    }
}
#ifndef ATT2
#define ATT2 1
#endif
template <bool DEG>
__device__ __forceinline__ void attn2_phase(const bf16* Z, float* OT, char* lds, int bid, int G) {
    for (int item = bid; item < 1024; item += G) {
        const int r = item >> 8, b = item & 255, hm = 2 * (b & 7) + (r >> 1), pair = (r & 1) * 32 + (b >> 3), h = hm >> 1, m = hm & 1;
        for (int pass = 0; pass < 2; ++pass) { const int qb = pass ? 127 - pair : pair;
            att2::block<DEG>(Z + (size_t)(48 + 2 * h + m) * GS + (size_t)qb * 128 * 128, Z + (size_t)(64 + 2 * h + m) * GS, Z + (size_t)(80 + 2 * h) * GS, Z + (size_t)(81 + 2 * h) * GS,
                        OT + (size_t)(h * 4 + m * 2) * GS + (size_t)qb * 128 * 128, OT + (size_t)(h * 4 + m * 2 + 1) * GS + (size_t)qb * 128 * 128, qb * 128, lds); }
    }
}
__device__ __forceinline__ float gelu_tanh(float x) { const float z = 1.5957691216057308f * (x + 0.044715f * x * x * x); return x * __builtin_amdgcn_rcpf(1.0f + __builtin_amdgcn_exp2f(-1.4426950408889634f * z)); }
template <bool PASS2>
__device__ __forceinline__ void s5_pass(const bf16* Hin, const unsigned char* prm, const float* c_re, const float* c_im, const float* dsk, float* F, const float* HC, bf16* Gout,
                                        LAS unsigned char* lds, int gw, int NGW, int wave, int lane) {
    LAS float* lu = (LAS float*)(lds + wave * 4096);
    for (int item = gw; item < 256 * S5NC; item += NGW) {
        const int g = item & 255, c = item >> 8, gp = g * 64 + lane;
        { const bf16* up = Hin + (size_t)(c * S5T + lane) * LDD + 16 * g; const v4u a = *(const v4u*)up, b = *(const v4u*)(up + 8);
          LAS f32x4* ur = (LAS f32x4*)(lu + lane * 16);
          ur[0] = (f32x4){bflo(a.x), bfhi(a.x), bflo(a.y), bfhi(a.y)}; ur[1] = (f32x4){bflo(a.z), bfhi(a.z), bflo(a.w), bfhi(a.w)};
          ur[2] = (f32x4){bflo(b.x), bfhi(b.x), bflo(b.y), bfhi(b.y)}; ur[3] = (f32x4){bflo(b.z), bfhi(b.z), bflo(b.w), bfhi(b.w)}; }
        f32x4 bbr[4], bbi[4];
#pragma unroll
        for (int q = 0; q < 4; ++q) { bbr[q] = *(const f32x4*)((const float*)(prm + S5P_BBR) + (size_t)gp * 16 + 4 * q); bbi[q] = *(const f32x4*)((const float*)(prm + S5P_BBI) + (size_t)gp * 16 + 4 * q); }
        const float abr = ((const float*)(prm + S5P_ABR))[gp], abi = ((const float*)(prm + S5P_ABI))[gp];
        float hr = 0.f, hi = 0.f, cr[16], ci[16], dk = 0.f;
        if (PASS2) {
#pragma unroll
            for (int o = 0; o < 16; ++o) { cr[o] = c_re[(size_t)(g * 16 + o) * 64 + lane]; ci[o] = c_im[(size_t)(g * 16 + o) * 64 + lane]; }
            hr = HC[(size_t)(c * 256 + g) * 128 + lane]; hi = HC[(size_t)(c * 256 + g) * 128 + 64 + lane]; dk = dsk[16 * g + (lane >> 2)];
        }
        LDS_WAIT(); asm volatile("" ::: "memory");
#pragma unroll 2
        for (int t = 0; t < S5T; ++t) {
            const LAS f32x4* ut = (const LAS f32x4*)(lu + t * 16);
            float bur = 0.f, bui = 0.f;
#pragma unroll
            for (int q = 0; q < 4; ++q) { const f32x4 u = ut[q];
                bur += (bbr[q].x * u.x + bbr[q].y * u.y) + (bbr[q].z * u.z + bbr[q].w * u.w); bui += (bbi[q].x * u.x + bbi[q].y * u.y) + (bbi[q].z * u.z + bbi[q].w * u.w); }
            const float nr = abr * hr - abi * hi + bur, ni = abr * hi + abi * hr + bui; hr = nr; hi = ni;
            if (PASS2) {
                float v[16];
#pragma unroll
                for (int o = 0; o < 16; ++o) v[o] = hr * cr[o] - hi * ci[o];
#pragma unroll
                for (int i = 0; i < 8; ++i) { const float send = (lane & 32) ? v[i] : v[i + 8], keep = (lane & 32) ? v[i + 8] : v[i]; v[i] = keep + __shfl_xor(send, 32); }
#pragma unroll
                for (int i = 0; i < 4; ++i) { const float send = (lane & 16) ? v[i] : v[i + 4], keep = (lane & 16) ? v[i + 4] : v[i]; v[i] = keep + __shfl_xor(send, 16); }
#pragma unroll
                for (int i = 0; i < 2; ++i) { const float send = (lane & 8) ? v[i] : v[i + 2], keep = (lane & 8) ? v[i + 2] : v[i]; v[i] = keep + __shfl_xor(send, 8); }
                { const float send = (lane & 4) ? v[0] : v[1], keep = (lane & 4) ? v[1] : v[0]; v[0] = keep + __shfl_xor(send, 4); }
                v[0] += __shfl_xor(v[0], 2); v[0] += __shfl_xor(v[0], 1);
                const float yy = v[0] + dk * lu[t * 16 + (lane >> 2)];
                const float gl = gelu_tanh(yy);
                if ((lane & 3) == 0) Gout[(size_t)(c * S5T + t) * LDD + 16 * g + (lane >> 2)] = (bf16)(pk2(gl, gl) & 0xffffu);
            }
        }
        if (!PASS2) { F[(size_t)(c * 256 + g) * 128 + lane] = hr; F[(size_t)(c * 256 + g) * 128 + 64 + lane] = hi; }
        LDS_WAIT(); asm volatile("" ::: "memory");
    }
}

constexpr int S5TS = 8, S5SB = S5TS * 256 + 16;
typedef short s5_bf16x8 __attribute__((ext_vector_type(8)));
template <bool PASS2>
__device__ __forceinline__ void s5m_pass(const bf16* Hin, const unsigned char* prm, const float* dsk, float* F, const float* HC, bf16* Gout, LAS unsigned char* lds, int bid, int G) {
    const int tid = opaque_tid(), lane = tid & 63, w = __builtin_amdgcn_readfirstlane(tid >> 6), j = lane & 15, rq = lane >> 4;
    const int rowslot = tid >> 4, piece = tid & 15;
    constexpr int NST = S5T / S5TS, NQ = 16 * S5TS / 32;
    for (int unit = bid; unit < 32 * (S5NC / 16); unit += G) {
        const int gb = unit & 31, cs = unit >> 5, g = gb * 8 + w;
        v2u bb[8];
#pragma unroll
        for (int t8 = 0; t8 < 8; ++t8) bb[t8] = *(const v2u*)(prm + S5P_BBOP + ((size_t)((g * 8 + t8) * 64 + lane)) * 8);
        v4u cop[4];
        f32x4 ar[4], ai[4], sr[4], si[4], dk = {0.f, 0.f, 0.f, 0.f};
#pragma unroll
        for (int q = 0; q < 4; ++q) { ar[q] = *(const f32x4*)((const float*)(prm + S5P_ABR) + g * 64 + 16 * q + 4 * rq); ai[q] = *(const f32x4*)((const float*)(prm + S5P_ABI) + g * 64 + 16 * q + 4 * rq); }
        if (PASS2) {
#pragma unroll
            for (int mm = 0; mm < 4; ++mm) cop[mm] = *(const v4u*)(prm + S5P_COP + ((size_t)((g * 4 + mm) * 64 + lane)) * 16);
            const float* hc = HC + ((size_t)(cs * 16 + j) * 256 + g) * 128 + 4 * rq;
#pragma unroll
            for (int q = 0; q < 4; ++q) { sr[q] = *(const f32x4*)(hc + 16 * q); si[q] = *(const f32x4*)(hc + 64 + 16 * q); }
            dk = *(const f32x4*)(dsk + 16 * g + 4 * rq);
        } else {
#pragma unroll
            for (int q = 0; q < 4; ++q) { sr[q] = (f32x4){0.f, 0.f, 0.f, 0.f}; si[q] = (f32x4){0.f, 0.f, 0.f, 0.f}; }
        }
        const bf16* src = Hin + (size_t)(cs * 16 * S5T) * LDD + gb * 128 + piece * 8;
        bf16* dstp = PASS2 ? Gout + (size_t)(cs * 16 * S5T) * LDD + gb * 128 + piece * 8 : nullptr;
        v4u pre[NQ];
#pragma unroll
        for (int q = 0; q < NQ; ++q) { const int ri = q * 32 + rowslot, jj = ri / S5TS, tt = ri % S5TS; pre[q] = *(const v4u*)(src + (size_t)(jj * S5T + tt) * LDD); }
        for (int s = 0; s < NST; ++s) {
#pragma unroll
            for (int q = 0; q < NQ; ++q) { const int ri = q * 32 + rowslot, jj = ri / S5TS, tt = ri % S5TS; LAS v4u* lp = (LAS v4u*)(lds + jj * S5SB + tt * 256 + piece * 16);
                if (PASS2 && s > 0) { const v4u y = *lp; *(v4u*)(dstp + (size_t)(jj * S5T + (s - 1) * S5TS + tt) * LDD) = y; }
                *lp = pre[q]; }
            if (s + 1 < NST) {
#pragma unroll
                for (int q = 0; q < NQ; ++q) { const int ri = q * 32 + rowslot, jj = ri / S5TS, tt = ri % S5TS; pre[q] = *(const v4u*)(src + (size_t)(jj * S5T + (s + 1) * S5TS + tt) * LDD); } }
            LDS_WAIT(); __syncthreads();
            LAS unsigned char* up = lds + j * S5SB + w * 32 + rq * 8;
            v2u uu[S5TS];
#pragma unroll
            for (int tt = 0; tt < S5TS; ++tt) uu[tt] = *(const LAS v2u*)(up + tt * 256);
#pragma unroll
            for (int tt = 0; tt < S5TS; ++tt) {
                v4u ub; ub.x = uu[tt].x; ub.y = uu[tt].y; ub.z = 0u; ub.w = 0u;
                const s5_bf16x8 U = __builtin_bit_cast(s5_bf16x8, ub);
#pragma unroll
                for (int q = 0; q < 4; ++q) {
                    const f32x4 tr = ar[q] * sr[q] - ai[q] * si[q], ti = ar[q] * si[q] + ai[q] * sr[q];
                    v4u a0; a0.x = bb[q].x; a0.y = bb[q].y; a0.z = 0u; a0.w = 0u; v4u a1; a1.x = bb[4 + q].x; a1.y = bb[4 + q].y; a1.z = 0u; a1.w = 0u;
                    sr[q] = __builtin_amdgcn_mfma_f32_16x16x32_bf16(__builtin_bit_cast(s5_bf16x8, a0), U, tr, 0, 0, 0);
                    si[q] = __builtin_amdgcn_mfma_f32_16x16x32_bf16(__builtin_bit_cast(s5_bf16x8, a1), U, ti, 0, 0, 0);
                }
                if (PASS2) {
                    f32x4 y = {0.f, 0.f, 0.f, 0.f};
#pragma unroll
                    for (int mm = 0; mm < 4; ++mm) { const f32x4 t0 = mm < 2 ? sr[2 * mm] : si[2 * mm - 4], t1 = mm < 2 ? sr[2 * mm + 1] : si[2 * mm - 3];
                        v4u sb; sb.x = pk2(t0.x, t0.y); sb.y = pk2(t0.z, t0.w); sb.z = pk2(t1.x, t1.y); sb.w = pk2(t1.z, t1.w);
                        y = __builtin_amdgcn_mfma_f32_16x16x32_bf16(__builtin_bit_cast(s5_bf16x8, cop[mm]), __builtin_bit_cast(s5_bf16x8, sb), y, 0, 0, 0); }
                    const f32x4 uf = {bflo(uu[tt].x), bfhi(uu[tt].x), bflo(uu[tt].y), bfhi(uu[tt].y)};
                    const f32x4 yy = y + dk * uf;
                    v2u o; o.x = pk2(gelu_tanh(yy.x), gelu_tanh(yy.y)); o.y = pk2(gelu_tanh(yy.z), gelu_tanh(yy.w));
                    *(LAS v2u*)(up + tt * 256) = o;
                }
            }
            LDS_WAIT(); __syncthreads();
        }
        if (PASS2) {
#pragma unroll
            for (int q = 0; q < NQ; ++q) { const int ri = q * 32 + rowslot, jj = ri / S5TS, tt = ri % S5TS; const v4u y = *(const LAS v4u*)(lds + jj * S5SB + tt * 256 + piece * 16);
                *(v4u*)(dstp + (size_t)(jj * S5T + (NST - 1) * S5TS + tt) * LDD) = y; }
            LDS_WAIT();
        } else {
            float* fo = F + ((size_t)(cs * 16 + j) * 256 + g) * 128 + 4 * rq;
#pragma unroll
            for (int q = 0; q < 4; ++q) { *(f32x4*)(fo + 16 * q) = sr[q]; *(f32x4*)(fo + 64 + 16 * q) = si[q]; }
        }
    }
}
__device__ __forceinline__ void s5_carry(const unsigned char* prm, const float* F, float* HC, int bid, int G, int wave, int lane) {
    if (wave != 0) return;
    for (int g = bid; g < 256; g += G) {
        const int p = lane, gp = g * 64 + p;
        const float atr = ((const float*)(prm + S5P_ATR))[gp], ati = ((const float*)(prm + S5P_ATI))[gp];
        float hr = 0.f, hi = 0.f;
        for (int c0 = 0; c0 < S5NC; c0 += 32) {
            float fr[32], fi[32];
#pragma unroll
            for (int q = 0; q < 32; ++q) { const size_t o = (size_t)((c0 + q) * 256 + g) * 128 + p; fr[q] = F[o]; fi[q] = F[o + 64]; }
#pragma unroll
            for (int q = 0; q < 32; ++q) { const size_t o = (size_t)((c0 + q) * 256 + g) * 128 + p;
                HC[o] = hr; HC[o + 64] = hi;
                const float nr = atr * hr - ati * hi + fr[q], ni = atr * hi + ati * hr + fi[q]; hr = nr; hi = ni; }
        }
    }
}

struct Ctx { int lo, hi, tid, lane, wave, gw, NGW, gtid, NGT, G, bid; };
#ifndef WGM_IN
#define WGM_IN 8
#endif
#ifndef WGM_OUT
#define WGM_OUT 2
#endif
#ifndef WGM_GLU
#define WGM_GLU 4
#endif
#ifndef WGM_F1
#define WGM_F1 8
#endif
#ifndef WGM_F2
#define WGM_F2 2
#endif
#ifndef DUP_ATTN
#define DUP_ATTN 0
#endif
#ifndef DUP_S5
#define DUP_S5 0
#endif
#ifndef DUP_FFN1
#define DUP_FFN1 0
#endif
#ifndef DUP_FFN2
#define DUP_FFN2 0
#endif
#ifndef DUP_INP
#define DUP_INP 0
#endif
#ifndef DUP_PRO
#define DUP_PRO 0
#endif
#define IN(k) (lo <= (k) && (k) < hi)
#define SEAM(k) do { if (IN(k) && IN((k) + 1)) xcd_barrier(bar); } while (0)
#define FFN_PHASES(l, pb) do { \
    const float* ml_ = MODL + (size_t)(l) * NMODV; \
    if (IN((pb) + 5)) norm_mod_phase(XR, args.in[6] + (size_t)(l) * DM, ml_ + 3 * DM, ml_ + 4 * DM, Hb, lds, tid, gw, NGW, lane); \
    SEAM((pb) + 5); \
    if (IN((pb) + 6)) { pg8::Gemm g{Hb, (const bf16*)(ws + WS_WGU + (size_t)(l) * W_GU_B), SEQ, 2 * FFH, DM, LDD, LDD}; pg8::StaticOrder S; S.init(SEQ, 2 * FFH, G, bid, WGM_F1); \
        pg8::EpiSwiGLU E{HID, LDF}; pg8::gemm_phase<pg8::EpiSwiGLU, pg8::StaticOrder, true, true>(lds, g, S, E); } \
    if (DUP_FFN1 && IN((pb) + 6)) { xcd_barrier(bar); pg8::Gemm g{Hb, (const bf16*)(ws + WS_WGU + (size_t)(l) * W_GU_B), SEQ, 2 * FFH, DM, LDD, LDD}; pg8::StaticOrder S; S.init(SEQ, 2 * FFH, G, bid, WGM_F1); \
        pg8::EpiSwiGLU E{HID, LDF}; pg8::gemm_phase<pg8::EpiSwiGLU, pg8::StaticOrder, true, true>(lds, g, S, E); } \
    SEAM((pb) + 6); \
    if (DUP_FFN2 && IN((pb) + 7)) { xcd_barrier(bar); pg8::Gemm g{HID, (const bf16*)(ws + WS_WDN + (size_t)(l) * W_DN_B), SEQ, DM, FFH, LDF, LDF}; pg8::StaticOrder S; S.init(SEQ, DM, G, bid, WGM_F2); \
        pg8::EpiResid E{XR, (float*)(ws + WS_OT), ml_ + 5 * DM, DM}; pg8::gemm_phase<pg8::EpiResid, pg8::StaticOrder, true, true>(lds, g, S, E); } \
    if (IN((pb) + 7)) { pg8::Gemm g{HID, (const bf16*)(ws + WS_WDN + (size_t)(l) * W_DN_B), SEQ, DM, FFH, LDF, LDF}; pg8::StaticOrder S; S.init(SEQ, DM, G, bid, WGM_F2); \
        pg8::EpiResid E{XR, XR, ml_ + 5 * DM, DM}; pg8::gemm_phase<pg8::EpiResid, pg8::StaticOrder, true, true>(lds, g, S, E); } \
    SEAM((pb) + 7); } while (0)
template <int lp>
__device__ __forceinline__ void layer_pair(const Args& args, const Ctx& C, LAS unsigned char* lds, unsigned char* lds_raw, const XcdBarrier& bar) {
    const int lo = C.lo, hi = C.hi, tid = C.tid, lane = C.lane, wave = C.wave, gw = C.gw, NGW = C.NGW, gtid = C.gtid, NGT = C.NGT, G = C.G, bid = C.bid;
    unsigned char* ws = args.ws;
    bf16* const Hb = (bf16*)(ws + WS_H); bf16* const MIX = (bf16*)(ws + WS_MIX); bf16* const Z = (bf16*)(ws + WS_Z); bf16* const HID = (bf16*)(ws + WS_Z);
    float* const OT = (float*)(ws + WS_OT); float* const XR = args.out;
    const float* const MODL = (const float*)(ws + WS_MODL);
        { const int l = 2 * lp, pb = 2 + 8 * l; const float* ml = MODL + (size_t)l * NMODV;
          const float* xin = (l == 0) ? args.in[0] : XR;
          if (IN(pb)) norm_mod_phase(xin, args.in[5] + (size_t)l * DM, ml, ml + DM, Hb, lds, tid, gw, NGW, lane);
          SEAM(pb);
          if (IN(pb + 1)) { pg8::Gemm g{Hb, (const bf16*)(ws + WS_WIN + (size_t)lp * W_IN_B), SEQ, 12288, DM, LDD, LDD}; pg8::StaticOrder S; S.init(SEQ, 12288, G, bid, WGM_IN);
              pg8::EpiHeadMajor E{Z, GS}; pg8::gemm_phase<pg8::EpiHeadMajor, pg8::StaticOrder, true, true>(lds, g, S, E); }
          if (DUP_INP && IN(pb + 1)) { xcd_barrier(bar); pg8::Gemm g{Hb, (const bf16*)(ws + WS_WIN + (size_t)lp * W_IN_B), SEQ, 12288, DM, LDD, LDD}; pg8::StaticOrder S; S.init(SEQ, 12288, G, bid, WGM_IN);
              pg8::EpiHeadMajor E{Z, GS}; pg8::gemm_phase<pg8::EpiHeadMajor, pg8::StaticOrder, true, true>(lds, g, S, E); }
          SEAM(pb + 1);
          if (IN(pb + 2)) { conv_phase(Z, args.in[9] + (size_t)lp * 3 * 2048, MIX, gtid, NGT); if (ATT2) attn2_phase<false>(Z, OT, (char*)lds_raw, bid, G); else attn_phase(Z, OT, (char*)lds_raw, bid, G); if (DUP_ATTN == 1) { xcd_barrier(bar); attn2_phase<false>(Z, (float*)(ws + WS_END), (char*)lds_raw, bid, G); } if (DUP_ATTN == 2) { xcd_barrier(bar); attn2_phase<true>(Z, (float*)(ws + WS_END), (char*)lds_raw, bid, G); } }
          SEAM(pb + 2);
          if (IN(pb + 3)) combine_phase(OT, (const float*)(ws + WS_LAM) + lp, args.in[14] + lp * 256, lp == 0 ? 0.2f : 0.4707130183435842f, MIX, gw, NGW, lane);
          SEAM(pb + 3);
          if (IN(pb + 4)) { pg8::Gemm g{MIX, (const bf16*)(ws + WS_WOUT + (size_t)lp * W_OUT_B), SEQ, DM, DM, LDD, LDD}; pg8::StaticOrder S; S.init(SEQ, DM, G, bid, WGM_OUT);
              pg8::EpiResid E{xin, XR, ml + 2 * DM, DM}; pg8::gemm_phase<pg8::EpiResid, pg8::StaticOrder, true, true>(lds, g, S, E); }
          SEAM(pb + 4);
          FFN_PHASES(l, pb);
        }
        { const int l = 2 * lp + 1, pb = 2 + 8 * l; const float* ml = MODL + (size_t)l * NMODV;
          const unsigned char* prm = ws + WS_S5P + (size_t)lp * S5P_LAYER;
          float* const S5F = (float*)(ws + WS_S5F); float* const S5H = (float*)(ws + WS_S5H);
          if (IN(pb)) norm_mod_phase(XR, args.in[5] + (size_t)l * DM, ml, ml + DM, Hb, lds, tid, gw, NGW, lane);
          SEAM(pb);
          if (IN(pb + 1)) { if (S5_MFMA) s5m_pass<false>(Hb, prm, nullptr, S5F, nullptr, nullptr, lds, bid, G); else s5_pass<false>(Hb, prm, nullptr, nullptr, nullptr, S5F, nullptr, nullptr, lds, gw, NGW, wave, lane); }
          SEAM(pb + 1);
          if (IN(pb + 2)) s5_carry(prm, S5F, S5H, bid, G, wave, lane);
          SEAM(pb + 2);
          if (IN(pb + 3)) { if (S5_MFMA) s5m_pass<true>(Hb, prm, args.in[23] + (size_t)lp * DM, nullptr, S5H, MIX, lds, bid, G); else s5_pass<true>(Hb, prm, args.in[21] + (size_t)lp * 256 * 16 * 64, args.in[22] + (size_t)lp * 256 * 16 * 64, args.in[23] + (size_t)lp * DM, nullptr, S5H, MIX, lds, gw, NGW, wave, lane); }
          if (DUP_S5) { xcd_barrier(bar);
          if (IN(pb + 1)) { if (S5_MFMA) s5m_pass<false>(Hb, prm, nullptr, S5F, nullptr, nullptr, lds, bid, G); else s5_pass<false>(Hb, prm, nullptr, nullptr, nullptr, S5F, nullptr, nullptr, lds, gw, NGW, wave, lane); }
          SEAM(pb + 1);
          if (IN(pb + 2)) s5_carry(prm, S5F, S5H, bid, G, wave, lane);
          SEAM(pb + 2);
          if (IN(pb + 3)) { if (S5_MFMA) s5m_pass<true>(Hb, prm, args.in[23] + (size_t)lp * DM, nullptr, S5H, MIX, lds, bid, G); else s5_pass<true>(Hb, prm, args.in[21] + (size_t)lp * 256 * 16 * 64, args.in[22] + (size_t)lp * 256 * 16 * 64, args.in[23] + (size_t)lp * DM, nullptr, S5H, MIX, lds, gw, NGW, wave, lane); }
          }
          SEAM(pb + 3);
          if (IN(pb + 4)) { pg8::Gemm g{MIX, (const bf16*)(ws + WS_WGLU + (size_t)lp * W_GLU_B), SEQ, 2 * DM, DM, LDD, LDD}; pg8::StaticOrder S; S.init(SEQ, 2 * DM, G, bid, WGM_GLU);
              pg8::EpiGluResid E{XR, XR, ml + 2 * DM, DM}; pg8::gemm_phase<pg8::EpiGluResid, pg8::StaticOrder, true, true>(lds, g, S, E); }
          SEAM(pb + 4);
          FFN_PHASES(l, pb);
        }
    }
#undef FFN_PHASES
#undef IN
#undef SEAM

__global__ void __launch_bounds__(NTHR, 2) trunk_fwd(Args args) {
    extern __shared__ __attribute__((aligned(16))) unsigned char lds_raw[];
    LAS unsigned char* lds = (LAS unsigned char*)lds_raw;
    volatile LAS unsigned* MISC = (volatile LAS unsigned*)(lds + MISC_OFF);
    const int tid = opaque_tid(), lane = tid & 63, wave = __builtin_amdgcn_readfirstlane(tid >> 6);
    const int G = gridDim.x, bid = blockIdx.x;
    const int vcu = (G % 8 == 0) ? (bid % 8) * (G / 8) + bid / 8 : bid;
    const int gw = vcu * NWAVES + wave, NGW = G * NWAVES, gtid = vcu * NTHR + tid, NGT = G * NTHR;
    unsigned char* ws = args.ws;
    const int lo = args.ph_lo, hi = args.ph_hi;
    for (int u = tid; u < (LDS_BYTES - RING_BYTES) / 4; u += NTHR) ((LAS unsigned*)(lds + RING_BYTES))[u] = 0u;
    __syncthreads();
    XcdBarrier bar; bar.bar = (unsigned*)(ws + WS_CTL) + CW_BAR; bar.x = 0; bar.st = MISC + 8;
    if (hi - lo > 1) bar = xcd_barrier_post((unsigned*)(ws + WS_CTL) + CW_BAR, MISC + 8);
    const Ctx C{lo, hi, tid, lane, wave, gw, NGW, gtid, NGT, G, bid};
#define IN(k) (lo <= (k) && (k) < hi)
#define SEAM(k) do { if (IN(k) && IN((k) + 1)) xcd_barrier(bar); } while (0)

    bf16* const Hb = (bf16*)(ws + WS_H); bf16* const MIX = (bf16*)(ws + WS_MIX); bf16* const Z = (bf16*)(ws + WS_Z); bf16* const HID = (bf16*)(ws + WS_Z);
    float* const OT = (float*)(ws + WS_OT); float* const XR = args.out;
    const float* const MODL = (const float*)(ws + WS_MODL);

    if (IN(0)) { p0_prologue(args, lds, gw, NGW, wave, lane); if (DUP_PRO) { xcd_barrier(bar); p0_prologue(args, lds, gw, NGW, wave, lane); } }
    SEAM(0);
    if (IN(1)) p1_modvec(args, gtid, NGT);
    SEAM(1);


    layer_pair<0>(args, C, lds, lds_raw, bar);
    layer_pair<1>(args, C, lds, lds_raw, bar);
    if (IN(34)) final_norm_phase(XR, args.in[7], XR, gw, NGW, lane);
#undef IN
#undef SEAM
}

extern "C" void kernel_launch(void* const* d_in, const int* in_sizes, int n_in, void* d_out, int out_size, void* d_ws, size_t ws_size, hipStream_t stream) {
    static int grid = 0;
    if (grid == 0) {
        if (n_in != 29 || in_sizes[0] != SEQ * DM || out_size != SEQ * DM || ws_size < WS_END + (DUP_ATTN ? (size_t)32 * GS * 4 : 0)) {
            fprintf(stderr, "kernel_launch: built for 29 inputs, x/out of %d floats, >= %zu bytes of workspace; got n_in %d, in0 %d, out %d, ws %zu; nothing launched\n", SEQ * DM, (size_t)WS_END, n_in, n_in > 0 ? in_sizes[0] : -1, out_size, ws_size); grid = -1; return; }
        int dev = 0, cus = 0, per_cu = 0;
        if (hipGetDevice(&dev) != hipSuccess || hipDeviceGetAttribute(&cus, hipDeviceAttributeMultiprocessorCount, dev) != hipSuccess) { fprintf(stderr, "kernel_launch: device query failed\n"); grid = -1; return; }
        if (hipFuncSetAttribute((const void*)trunk_fwd, hipFuncAttributeMaxDynamicSharedMemorySize, LDS_BYTES) != hipSuccess) { fprintf(stderr, "kernel_launch: hipFuncSetAttribute failed\n"); grid = -1; return; }
        if (hipOccupancyMaxActiveBlocksPerMultiprocessor(&per_cu, (const void*)trunk_fwd, NTHR, LDS_BYTES) != hipSuccess || per_cu < 1) { fprintf(stderr, "kernel_launch: occupancy query reports %d workgroups per CU\n", per_cu); }
        (void)hipGetLastError();
        grid = cus;
        fprintf(stderr, "kernel_launch: grid %d, occupancy %d, ws %zu (need %zu)\n", grid, per_cu, ws_size, (size_t)WS_END);
    }
    if (grid < 0) return;
    if (hipMemsetAsync((char*)d_ws + WS_CTL, 0, CTL_ZERO_BYTES, stream) != hipSuccess) { fprintf(stderr, "kernel_launch: memset failed\n"); return; }
    Args a{};
    for (int i = 0; i < 29; ++i) a.in[i] = (const float*)d_in[i];
    a.out = (float*)d_out; a.ws = (unsigned char*)d_ws;
#if MK_PER_PHASE
    for (int p = 0; p < N_PHASES; ++p) { a.ph_lo = p; a.ph_hi = p + 1; hipLaunchKernelGGL(trunk_fwd, dim3(grid), dim3(NTHR), LDS_BYTES, stream, a); }
#else
    a.ph_lo = 0; a.ph_hi = N_PHASES;
    hipLaunchKernelGGL(trunk_fwd, dim3(grid), dim3(NTHR), LDS_BYTES, stream, a);
#endif
    const hipError_t le = hipPeekAtLastError();
    if (le != hipSuccess) fprintf(stderr, "kernel_launch: launch failed: %s\n", hipGetErrorName(le));
}
```

```cpp
#include <hip/hip_runtime.h>
#include <hip/hip_bf16.h>
#include <cstdio>
#include <cstdint>
__device__ __forceinline__ int opaque_tid() { int t; asm volatile("v_mov_b32 %0, %1" : "=v"(t) : "v"((int)threadIdx.x)); return t; }
namespace pg8 {
#define PG8_LAS __attribute__((address_space(3)))
typedef unsigned short bf16_t;
typedef short bf16x8 __attribute__((ext_vector_type(8)));
typedef float f32x4 __attribute__((ext_vector_type(4)));
typedef unsigned u32x4 __attribute__((ext_vector_type(4)));
constexpr int BM = 256, BK = 64, HALF = 128, HTB = HALF * BK * 2  , STAGE_BYTES = 8 * HTB, NXCD = 8, WGM = 8;

__host__ __device__ __forceinline__ int lds_byte(int r, int c) { const int st = (r >> 4) * 2 + (c >> 5), rr = r & 15, cc = c & 31, ob = rr * 64 + cc * 2; return st * 1024 + (ob ^ (((ob >> 9) & 1) << 5)); }
__host__ __device__ __forceinline__ void stage_rc(int b, int& R, int& C) { const int st = b / 1024, sb = b % 1024, swz = sb ^ (((sb >> 9) & 1) << 5); R = (st >> 1) * 16 + swz / 64; C = (st & 1) * 32 + (swz % 64) / 2; }
__host__ __device__ __forceinline__ int perm32(int rho) { const int n = rho >> 4, i = rho & 15; return 8 * (i >> 2) + 4 * n + (i & 3); }

struct Unit { int pm, pn; };
struct Gemm { const bf16_t* A; const bf16_t* Bt; int M, N, K, lda, ldb; };

struct StaticOrder {
    int nM, nN, nwg, G, c, wgm;
    __host__ __device__ void init(int M, int N, int G_, int c_, int wgm_ = WGM) { nM = M / BM; nN = N / BM; nwg = nM * nN; G = G_; c = c_; wgm = wgm_; }
    __host__ __device__ bool next(int i, Unit& u) const {
        const long L = (long)i * G + c; if (L >= nwg) return false;
        int wgid = (int)L; { const int q = nwg / NXCD, r = nwg % NXCD, xcd = wgid % NXCD, off = wgid / NXCD; wgid = (xcd < r ? xcd * (q + 1) : r * (q + 1) + (xcd - r) * q) + off; }
        const int nig = wgm * nN, gid = wgid / nig, fm = gid * wgm, gsz = (nM - fm) < wgm ? (nM - fm) : wgm;
        u.pm = fm + ((wgid % nig) % gsz); u.pn = (wgid % nig) / gsz; return true;
    }
    __device__ __forceinline__ void a_ready(const Unit&) const {}
    __device__ __forceinline__ void done(const Unit&) const {}
};

__device__ __forceinline__ unsigned cvt_pk_bf16(float lo, float hi) { unsigned r; asm volatile("v_cvt_pk_bf16_f32 %0, %1, %2" : "=v"(r) : "v"(lo), "v"(hi)); return r; }
__device__ __forceinline__ float fast_sigmoid(float x) { return __builtin_amdgcn_rcpf(1.0f + __builtin_amdgcn_exp2f(-1.4426950408889634f * x)); }

struct EpiHeadMajor {
    static constexpr bool PERM = true, AFTER_DRAIN = false;
    bf16_t* O; size_t gstride;
    __device__ __forceinline__ void operator()(const f32x4 (&acc)[2][2][4][2], const Unit& u, int wr, int wc, int fr, int fq) const {
        const int row0 = u.pm * BM + wr * 64 + fr, col0 = wc * 32 + 8 * fq;
#pragma unroll
        for (int ai = 0; ai < 2; ++ai)
#pragma unroll
            for (int m = 0; m < 4; ++m) { const size_t ro = (size_t)(row0 + ai * HALF + m * 16) * 128 + col0;
#pragma unroll
                for (int bj = 0; bj < 2; ++bj) { const f32x4 v0 = acc[ai][bj][m][0], v1 = acc[ai][bj][m][1];
                    u32x4 w; w.x = cvt_pk_bf16(v0[0], v0[1]); w.y = cvt_pk_bf16(v0[2], v0[3]); w.z = cvt_pk_bf16(v1[0], v1[1]); w.w = cvt_pk_bf16(v1[2], v1[3]);
                    *(u32x4*)(O + (size_t)(2 * u.pn + bj) * gstride + ro) = w; } }
    }
};
struct EpiResid {
    static constexpr bool PERM = false, AFTER_DRAIN = false;
    const float* base; float* out; const float* gate; int ldc;
    __device__ __forceinline__ void operator()(const f32x4 (&acc)[2][2][4][2], const Unit& u, int wr, int wc, int fr, int fq) const {
        const int row0 = u.pm * BM + wr * 64 + fr, col0 = u.pn * BM + wc * 32 + 4 * fq;
        f32x4 gv[2][2];
#pragma unroll
        for (int bj = 0; bj < 2; ++bj)
#pragma unroll
            for (int n = 0; n < 2; ++n) gv[bj][n] = *(const f32x4*)(gate + col0 + bj * HALF + n * 16);
#pragma unroll
        for (int ai = 0; ai < 2; ++ai) {
            f32x4 b[4][2][2];
#pragma unroll
            for (int m = 0; m < 4; ++m) { const size_t off = (size_t)(row0 + ai * HALF + m * 16) * ldc + col0;
#pragma unroll
                for (int bj = 0; bj < 2; ++bj)
#pragma unroll
                    for (int n = 0; n < 2; ++n) b[m][bj][n] = *(const f32x4*)(base + off + bj * HALF + n * 16); }
            asm volatile("" ::: "memory");
#pragma unroll
            for (int m = 0; m < 4; ++m) { const size_t off = (size_t)(row0 + ai * HALF + m * 16) * ldc + col0;
#pragma unroll
                for (int bj = 0; bj < 2; ++bj)
#pragma unroll
                    for (int n = 0; n < 2; ++n) *(f32x4*)(out + off + bj * HALF + n * 16) = b[m][bj][n] + gv[bj][n] * acc[ai][bj][m][n]; }
            asm volatile("" ::: "memory"); }
    }
};
struct EpiSwiGLU {
    static constexpr bool PERM = true, AFTER_DRAIN = false;
    bf16_t* O; int ldc;
    __device__ __forceinline__ void operator()(const f32x4 (&acc)[2][2][4][2], const Unit& u, int wr, int wc, int fr, int fq) const {
        const int row0 = u.pm * BM + wr * 64 + fr, col0 = u.pn * HALF + wc * 32 + 8 * fq;
#pragma unroll
        for (int ai = 0; ai < 2; ++ai)
#pragma unroll
            for (int m = 0; m < 4; ++m) { bf16_t* rowp = O + (size_t)(row0 + ai * HALF + m * 16) * ldc + col0;
                float r[8];
#pragma unroll
                for (int n = 0; n < 2; ++n)
#pragma unroll
                    for (int j = 0; j < 4; ++j) { const float g = acc[ai][0][m][n][j], up = acc[ai][1][m][n][j]; r[n * 4 + j] = g * fast_sigmoid(g) * up; }
                u32x4 w; w.x = cvt_pk_bf16(r[0], r[1]); w.y = cvt_pk_bf16(r[2], r[3]); w.z = cvt_pk_bf16(r[4], r[5]); w.w = cvt_pk_bf16(r[6], r[7]);
                *(u32x4*)rowp = w; }
    }
};
struct EpiGluResid {
    static constexpr bool PERM = false, AFTER_DRAIN = false;
    const float* base; float* out; const float* gate; int ldc;
    __device__ __forceinline__ void operator()(const f32x4 (&acc)[2][2][4][2], const Unit& u, int wr, int wc, int fr, int fq) const {
        const int row0 = u.pm * BM + wr * 64 + fr, col0 = u.pn * HALF + wc * 32 + 4 * fq;
        f32x4 gv[2];
#pragma unroll
        for (int n = 0; n < 2; ++n) gv[n] = *(const f32x4*)(gate + col0 + n * 16);
        f32x4 b[2][4][2];
#pragma unroll
        for (int ai = 0; ai < 2; ++ai)
#pragma unroll
            for (int m = 0; m < 4; ++m) { const size_t off = (size_t)(row0 + ai * HALF + m * 16) * ldc + col0;
#pragma unroll
                for (int n = 0; n < 2; ++n) b[ai][m][n] = *(const f32x4*)(base + off + n * 16); }
        asm volatile("" ::: "memory");
#pragma unroll
        for (int ai = 0; ai < 2; ++ai)
#pragma unroll
            for (int m = 0; m < 4; ++m) { const size_t off = (size_t)(row0 + ai * HALF + m * 16) * ldc + col0;
#pragma unroll
                for (int n = 0; n < 2; ++n) { const f32x4 a = acc[ai][0][m][n], sg = acc[ai][1][m][n]; f32x4 y;
#pragma unroll
                    for (int j = 0; j < 4; ++j) y[j] = a[j] * fast_sigmoid(sg[j]);
                    *(f32x4*)(out + off + n * 16) = b[ai][m][n] + gv[n] * y; } }
        asm volatile("" ::: "memory");
    }
};

template <class Epi, class Sched, bool ALIGN_EPI = false, bool SP2 = false>
__device__ __forceinline__ void gemm_phase(PG8_LAS unsigned char* lds, const Gemm g, const Sched& S, const Epi& E) {
    const int tid = opaque_tid(), wid = __builtin_amdgcn_readfirstlane(tid >> 6), lane = tid & 63, wr = wid >> 2, wc = wid & 3, fr = lane & 15, fq = lane >> 4;
    const int K = g.K, nt = K / BK;
    unsigned voffA[2], voffB[2];
#pragma unroll
    for (int i = 0; i < 2; ++i) { int R, C; stage_rc(tid * 16 + i * 8192, R, C); const int Rb = Epi::PERM ? ((R & ~31) + perm32(R & 31)) : R;
        voffA[i] = (unsigned)(R * g.lda + C) * 2u; voffB[i] = (unsigned)(Rb * g.ldb + C) * 2u; }
    const size_t kstep = (size_t)(BK * 2);
    const size_t hstepA = (size_t)HALF * g.lda * 2, hstepB = (size_t)HALF * g.ldb * 2;
    const size_t tstepA = 2 * hstepA, tstepB = 2 * hstepB;
    const unsigned ldsw = (unsigned)wid * 1024u;
    const int aoff = lds_byte(wr * 64 + fr, fq * 8), boff = lds_byte(wc * 32 + fr, fq * 8);
#define PG8_SA(b, h) (((b) * 2 + (h)) * HTB)
#define PG8_SB(b, h) ((4 + (b) * 2 + (h)) * HTB)
#define PG8_STAGE(bufoff, gbase, voff) do { _Pragma("unroll") for (int _i = 0; _i < 2; ++_i) \
        __builtin_amdgcn_global_load_lds((const unsigned*)((const char*)(gbase) + (voff)[_i]), (PG8_LAS unsigned*)(lds + (bufoff) + ldsw + _i * 8192), 16, 0, 0); } while (0)
#define PG8_LDA(dst, b, h) do { _Pragma("unroll") for (int m = 0; m < 4; ++m) _Pragma("unroll") for (int k = 0; k < 2; ++k) dst[m][k] = *(const PG8_LAS bf16x8*)(lds + PG8_SA(b, h) + aoff + m * 2048 + k * 1024); } while (0)
#define PG8_LDB(dst, b, h) do { _Pragma("unroll") for (int n = 0; n < 2; ++n) _Pragma("unroll") for (int k = 0; k < 2; ++k) dst[n][k] = *(const PG8_LAS bf16x8*)(lds + PG8_SB(b, h) + boff + n * 2048 + k * 1024); } while (0)
#define PG8_MMA(ai, bj, At, Bt) do { __builtin_amdgcn_s_setprio(3); _Pragma("unroll") for (int m = 0; m < 4; ++m) _Pragma("unroll") for (int n = 0; n < 2; ++n) _Pragma("unroll") for (int k = 0; k < 2; ++k) \
        acc[ai][bj][m][n] = __builtin_amdgcn_mfma_f32_16x16x32_bf16(Bt[n][k], At[m][k], acc[ai][bj][m][n], 0, 0, 0); __builtin_amdgcn_s_setprio(0); } while (0)
#define PG8_WAIT_V(n) asm volatile("s_waitcnt vmcnt(" #n ")" ::: "memory")
#define PG8_WAIT_L(n) asm volatile("s_waitcnt lgkmcnt(" #n ")" ::: "memory")
#define PG8_BAR __builtin_amdgcn_s_barrier()
#define PG8_SCHED __builtin_amdgcn_sched_barrier(0)
    Unit cur, nxt; int ui = 0;
    if (!S.next(0, cur)) return;
    f32x4 acc[2][2][4][2];
#pragma unroll
    for (int a = 0; a < 2; ++a)
#pragma unroll
        for (int b = 0; b < 2; ++b)
#pragma unroll
            for (int m = 0; m < 4; ++m)
#pragma unroll
                for (int n = 0; n < 2; ++n) acc[a][b][m][n] = (f32x4){0.f, 0.f, 0.f, 0.f};
    bf16x8 At[4][2], B0[2][2], B1[2][2];
    const char* cA = (const char*)g.A + (size_t)cur.pm * tstepA; const char* cB = (const char*)g.Bt + (size_t)cur.pn * tstepB;
    S.a_ready(cur);
    if constexpr (SP2) {
        PG8_STAGE(PG8_SB(0, 0), cB, voffB); PG8_STAGE(PG8_SB(0, 1), cB + hstepB, voffB); PG8_STAGE(PG8_SA(0, 0), cA, voffA); PG8_STAGE(PG8_SA(0, 1), cA + hstepA, voffA);
        if (wr == 1) PG8_BAR;
        PG8_WAIT_V(2); PG8_BAR;
        PG8_STAGE(PG8_SB(1, 0), cB + kstep, voffB); PG8_STAGE(PG8_SA(1, 0), cA + kstep, voffA); PG8_STAGE(PG8_SB(1, 1), cB + hstepB + kstep, voffB);
        PG8_WAIT_V(6); PG8_BAR;
    } else {
        PG8_STAGE(PG8_SB(0, 0), cB, voffB); PG8_STAGE(PG8_SA(0, 0), cA, voffA); PG8_STAGE(PG8_SB(0, 1), cB + hstepB, voffB); PG8_STAGE(PG8_SA(0, 1), cA + hstepA, voffA);
        if (wr == 1) PG8_BAR;
        PG8_WAIT_V(4); PG8_BAR;
        PG8_STAGE(PG8_SB(1, 0), cB + kstep, voffB); PG8_STAGE(PG8_SA(1, 0), cA + kstep, voffA); PG8_STAGE(PG8_SB(1, 1), cB + hstepB + kstep, voffB);
        PG8_WAIT_V(6); PG8_BAR;
    }
    for (;;) {
        const bool has_next = S.next(ui + 1, nxt);
        const char* nA = has_next ? (const char*)g.A + (size_t)nxt.pm * tstepA : cA; const char* nB = has_next ? (const char*)g.Bt + (size_t)nxt.pn * tstepB : cB;
        for (int t = 0; t < nt; t += 2) {
            const bool last = (t == nt - 2);
            const char* a1 = cA + (size_t)(t + 1) * kstep;
            const char* a2 = last ? nA : cA + (size_t)(t + 2) * kstep; const char* b2 = last ? nB : cB + (size_t)(t + 2) * kstep;
            const char* a3 = a2 + kstep; const char* b3 = b2 + kstep;
            if (last && has_next) S.a_ready(nxt);
            if constexpr (SP2) {
            PG8_LDB(B0, 0, 0); PG8_LDB(B1, 0, 1); PG8_SCHED; PG8_LDA(At, 0, 0); PG8_STAGE(PG8_SA(1, 1), a1 + hstepA, voffA);
            PG8_WAIT_V(8); PG8_WAIT_L(0); PG8_BAR; PG8_MMA(0, 0, At, B0); PG8_MMA(0, 1, At, B1); PG8_BAR; PG8_SCHED;
            PG8_LDA(At, 0, 1); PG8_STAGE(PG8_SB(0, 0), b2, voffB); PG8_STAGE(PG8_SB(0, 1), b2 + hstepB, voffB); PG8_STAGE(PG8_SA(0, 0), a2, voffA);
            PG8_WAIT_V(8); PG8_WAIT_L(0); PG8_BAR; PG8_MMA(1, 0, At, B0); PG8_MMA(1, 1, At, B1); PG8_BAR; PG8_SCHED;
            PG8_LDB(B0, 1, 0); PG8_LDB(B1, 1, 1); PG8_SCHED; PG8_LDA(At, 1, 0); PG8_STAGE(PG8_SA(0, 1), a2 + hstepA, voffA);
            PG8_WAIT_V(8); PG8_WAIT_L(0); PG8_BAR; PG8_MMA(0, 0, At, B0); PG8_MMA(0, 1, At, B1); PG8_BAR; PG8_SCHED;
            PG8_LDA(At, 1, 1); PG8_STAGE(PG8_SB(1, 0), b3, voffB); PG8_STAGE(PG8_SB(1, 1), b3 + hstepB, voffB); PG8_STAGE(PG8_SA(1, 0), a3, voffA);
            PG8_WAIT_V(8); PG8_WAIT_L(0); PG8_BAR; PG8_MMA(1, 0, At, B0); PG8_MMA(1, 1, At, B1); PG8_BAR; PG8_SCHED;
            } else {
            PG8_LDB(B0, 0, 0); PG8_SCHED; PG8_LDA(At, 0, 0); PG8_STAGE(PG8_SA(1, 1), a1 + hstepA, voffA);
            PG8_WAIT_L(8); PG8_BAR; PG8_WAIT_L(0); PG8_MMA(0, 0, At, B0); PG8_BAR; PG8_SCHED;
            PG8_LDB(B1, 0, 1); PG8_STAGE(PG8_SB(0, 0), b2, voffB);
            PG8_BAR; PG8_WAIT_L(0); PG8_MMA(0, 1, At, B1); PG8_BAR;
            PG8_LDA(At, 0, 1); PG8_STAGE(PG8_SA(0, 0), a2, voffA);
            PG8_BAR; PG8_WAIT_L(0); PG8_MMA(1, 0, At, B0); PG8_BAR; PG8_SCHED;
            PG8_STAGE(PG8_SB(0, 1), b2 + hstepB, voffB);
            PG8_WAIT_V(6); PG8_BAR; PG8_MMA(1, 1, At, B1); PG8_BAR;
            PG8_LDB(B0, 1, 0); PG8_SCHED; PG8_LDA(At, 1, 0); PG8_STAGE(PG8_SA(0, 1), a2 + hstepA, voffA);
            PG8_WAIT_L(8); PG8_BAR; PG8_WAIT_L(0); PG8_MMA(0, 0, At, B0); PG8_BAR; PG8_SCHED;
            PG8_LDB(B1, 1, 1); PG8_STAGE(PG8_SB(1, 0), b3, voffB);
            PG8_BAR; PG8_WAIT_L(0); PG8_MMA(0, 1, At, B1); PG8_BAR;
            PG8_LDA(At, 1, 1); PG8_STAGE(PG8_SA(1, 0), a3, voffA);
            PG8_BAR; PG8_WAIT_L(0); PG8_MMA(1, 0, At, B0); PG8_BAR; PG8_SCHED;
            PG8_STAGE(PG8_SB(1, 1), b3 + hstepB, voffB);
            PG8_WAIT_V(6); PG8_BAR; PG8_MMA(1, 1, At, B1); PG8_BAR;
            }
        }
        if constexpr (ALIGN_EPI) { if (wr == 0) PG8_BAR; }
        if constexpr (!Epi::AFTER_DRAIN) { E(acc, cur, wr, wc, fr, fq); S.done(cur); }
        if (!has_next) break;
#pragma unroll
        for (int a = 0; a < 2; ++a)
#pragma unroll
            for (int b = 0; b < 2; ++b)
#pragma unroll
                for (int m = 0; m < 4; ++m)
#pragma unroll
                    for (int n = 0; n < 2; ++n) acc[a][b][m][n] = (f32x4){0.f, 0.f, 0.f, 0.f};
        cur = nxt; cA = nA; cB = nB; ++ui;
        if constexpr (ALIGN_EPI) { if (wr == 1) PG8_BAR; }
    }
    PG8_WAIT_V(0);
    if constexpr (!ALIGN_EPI) { if (wr == 0) PG8_BAR; }
    PG8_BAR;
    if constexpr (Epi::AFTER_DRAIN) { E.fused(acc, cur, wr, wc, fr, fq, lds, wid, lane); S.done(cur); }
#undef PG8_SA
#undef PG8_SB
#undef PG8_STAGE
#undef PG8_LDA
#undef PG8_LDB
#undef PG8_MMA
#undef PG8_WAIT_V
#undef PG8_WAIT_L
#undef PG8_BAR
#undef PG8_SCHED
}
}

namespace att {
constexpr int D = 128;
constexpr float THR = 8.f;
constexpr bool WSKIP = false;
constexpr float SCALE = 0.08838834764831845f;
constexpr int NW = 8, QBLK = 32, KVBLK = 64, QB = NW * QBLK;
constexpr int SHM_V = KVBLK * D * 2, SHM_K = KVBLK * D * 2;
constexpr int LDS_BYTES = 2 * SHM_V + 2 * SHM_K + NW * 64 * 4;

using bf16 = __hip_bfloat16;
typedef short bf16x8 __attribute__((ext_vector_type(8)));
typedef short s16x4 __attribute__((ext_vector_type(4)));
typedef float f32x16 __attribute__((ext_vector_type(16)));
typedef float f32x4 __attribute__((ext_vector_type(4)));
typedef unsigned u32x4 __attribute__((ext_vector_type(4)));
template <class A, class Bt> struct same_t { static constexpr bool v = false; };
template <class A> struct same_t<A, A> { static constexpr bool v = true; };

#define KSWZ(row, colB) ((row) * 256 + ((colB) ^ (((row) & 7) << 4)))
#define SBAR() __builtin_amdgcn_sched_barrier(0)
__device__ __forceinline__ int v_st(int k, int c) { const int kk = (k & ~0xC) | ((k & 4) << 1) | ((k & 8) >> 1); return ((kk >> 3) * 4 + (c >> 5)) * 512 + ((kk & 7) * 32 + (c & 31)) * 2; }
__device__ __forceinline__ int v_rd_base(int lane) { return ((lane & 3) << 3) | (((lane >> 2) & 3) << 6) | (((lane >> 4) & 1) << 5) | (((lane >> 5) & 1) << 8); }
constexpr int v_rd_off(int d0, int ks, int half) { return d0 * 512 + ks * 4096 + half * 2048; }
__device__ __forceinline__ int crow(int r, int hi) { return (r & 3) + 8 * (r >> 2) + 4 * hi; }
__device__ __forceinline__ unsigned cvtpk(float lo, float hi) {
    unsigned r; asm volatile("v_cvt_pk_bf16_f32 %0, %1, %2" : "=v"(r) : "v"(lo), "v"(hi)); return r;
}
__device__ __forceinline__ bf16x8 pack8(f32x4 a, f32x4 b) {
    u32x4 w = {cvtpk(a[0], a[1]), cvtpk(a[2], a[3]), cvtpk(b[0], b[1]), cvtpk(b[2], b[3])};
    return *reinterpret_cast<bf16x8*>(&w);
}
template <class T> __device__ __forceinline__ bf16x8 load8(const T* p) {
    if constexpr (same_t<T, float>::v) { return pack8(*(const f32x4*)p, *(const f32x4*)(p + 4)); }
    else { return *reinterpret_cast<const bf16x8*>(p); }
}
__device__ __forceinline__ void mask_tile(f32x16& p0, f32x16& p1, int dq, unsigned W) {
    const float NEG = -__builtin_inff();
#pragma unroll
    for (int r = 0; r < 16; ++r) {
        const int c = (r & 3) + 8 * (r >> 2);
        if ((unsigned)(dq - c) >= W) p0[r] = NEG;
        if ((unsigned)(dq - c - 32) >= W) p1[r] = NEG;
    }
}
__device__ __forceinline__ void partialSM(f32x16& p0, f32x16& p1, float& m_reg, float& mn, float& alpha) {
    float pmax = p0[0]; for (int r = 1; r < 16; ++r) pmax = fmaxf(pmax, p0[r]); for (int r = 0; r < 16; ++r) pmax = fmaxf(pmax, p1[r]);
    { auto rr = __builtin_amdgcn_permlane32_swap(__float_as_uint(pmax), __float_as_uint(pmax), false, false);
      pmax = fmaxf(__uint_as_float(rr[0]), __uint_as_float(rr[1])); }
    constexpr float C2 = 1.4426950408889634f * SCALE;
    if (__builtin_expect(__all((pmax - m_reg) * SCALE <= THR), 1)) { mn = m_reg; alpha = 1.f; }
    else { mn = fmaxf(m_reg, pmax); alpha = __builtin_amdgcn_exp2f((m_reg - mn) * C2); m_reg = mn; }
    const float mnL = -mn * C2;
    for (int r = 0; r < 16; ++r) p0[r] = fmaf(p0[r], C2, mnL); for (int r = 0; r < 16; ++r) p1[r] = fmaf(p1[r], C2, mnL);
    for (int r = 0; r < 16; ++r) p0[r] = __builtin_amdgcn_exp2f(p0[r]);
}
__device__ __forceinline__ void finishSM(f32x16& p0, f32x16& p1, float alpha, float& l_reg, bf16x8& pa0, bf16x8& pa1, bf16x8& pa2, bf16x8& pa3) {
    for (int r = 0; r < 16; ++r) p1[r] = __builtin_amdgcn_exp2f(p1[r]);
    float ps = 0; for (int r = 0; r < 16; ++r) ps += p0[r]; for (int r = 0; r < 16; ++r) ps += p1[r];
    { auto rr = __builtin_amdgcn_permlane32_swap(__float_as_uint(ps), __float_as_uint(ps), false, false);
      ps = __uint_as_float(rr[0]) + __uint_as_float(rr[1]); }
    l_reg = l_reg * alpha + ps;
#define PK4(P, B_, OUT) do { unsigned a0 = cvtpk(P[B_+0], P[B_+1]), a1 = cvtpk(P[B_+2], P[B_+3]);                          \
        unsigned b0 = cvtpk(P[B_+4], P[B_+5]), b1 = cvtpk(P[B_+6], P[B_+7]);                                             \
        auto r0 = __builtin_amdgcn_permlane32_swap(a0, b0, false, false); auto r1 = __builtin_amdgcn_permlane32_swap(a1, b1, false, false); \
        u32x4 w = {r0[0], r1[0], r0[1], r1[1]}; OUT = *reinterpret_cast<bf16x8*>(&w); } while (0)
    PK4(p0, 0, pa0); PK4(p0, 8, pa1); PK4(p1, 0, pa2); PK4(p1, 8, pa3);
#undef PK4
}
template <int KB, bool SK>
__device__ __forceinline__ void qkt(f32x16& p0, f32x16& p1, const char* K_lds, int r32, int hi, const bf16x8* qr, bool act) {
    if (SK && !act) { const float NEG = -__builtin_inff();
#pragma unroll
        for (int r = 0; r < 16; ++r) { p0[r] = NEG; p1[r] = NEG; } return; }
    p0 = f32x16{}; p1 = f32x16{};
    const char* kb[4];
#pragma unroll
    for (int dd = 0; dd < 4; ++dd) kb[dd] = K_lds + KB * SHM_K + KSWZ(r32, (dd * 16 + hi * 8) * 2);
#pragma unroll
    for (int d0 = 0; d0 < 8; ++d0) { const char* a = kb[d0 & 3] + (d0 >> 2) * 128;
        bf16x8 b0 = *reinterpret_cast<const bf16x8*>(a);
        bf16x8 b1 = *reinterpret_cast<const bf16x8*>(a + 32 * 256);
        p0 = __builtin_amdgcn_mfma_f32_32x32x16_bf16(b0, qr[d0], p0, 0, 0, 0);
        p1 = __builtin_amdgcn_mfma_f32_32x32x16_bf16(b1, qr[d0], p1, 0, 0, 0); }
}
template <int VB, bool SK>
__device__ __forceinline__ void pv_tile(f32x16* o, int vb0, bf16x8 pa0, bf16x8 pa1, bf16x8 pa2, bf16x8 pa3, bool act) {
    if (SK && !act) return;
#define TRRD(dst, off) asm volatile("ds_read_b64_tr_b16 %0, %1 offset:%2" : "=&v"(dst) : "v"(vb0), "i"(off) : "memory")
#define PV_D0(d0) do { s16x4 l0, l1, l2, l3, h0, h1, h2, h3; constexpr int b_ = VB * SHM_V + v_rd_off(d0, 0, 0);     \
        TRRD(l0, b_); TRRD(h0, b_ + 2048); TRRD(l1, b_ + 4096); TRRD(h1, b_ + 6144); TRRD(l2, b_ + 8192); TRRD(h2, b_ + 10240); TRRD(l3, b_ + 12288); TRRD(h3, b_ + 14336); \
        asm volatile("s_waitcnt lgkmcnt(0)" ::: "memory"); SBAR();                 \
        o[d0] = __builtin_amdgcn_mfma_f32_32x32x16_bf16(pa0, (bf16x8){l0[0], l0[1], l0[2], l0[3], h0[0], h0[1], h0[2], h0[3]}, o[d0], 0, 0, 0);   \
        o[d0] = __builtin_amdgcn_mfma_f32_32x32x16_bf16(pa1, (bf16x8){l1[0], l1[1], l1[2], l1[3], h1[0], h1[1], h1[2], h1[3]}, o[d0], 0, 0, 0);   \
        o[d0] = __builtin_amdgcn_mfma_f32_32x32x16_bf16(pa2, (bf16x8){l2[0], l2[1], l2[2], l2[3], h2[0], h2[1], h2[2], h2[3]}, o[d0], 0, 0, 0);   \
        o[d0] = __builtin_amdgcn_mfma_f32_32x32x16_bf16(pa3, (bf16x8){l3[0], l3[1], l3[2], l3[3], h3[0], h3[1], h3[2], h3[3]}, o[d0], 0, 0, 0); } while (0)
    PV_D0(0); PV_D0(1); PV_D0(2); PV_D0(3);
#undef PV_D0
#undef TRRD
}

template <class TIn, class TOut> struct BlockRef { const TIn* Q; const TIn* K; const TIn* V; TOut* O; int P0; };
template <class TIn> struct Seam {
    bf16x8 qr[8];
    bf16x8 st_v0, st_v1, st_k0, st_k1; f32x4 sf0, sf1, sf2, sf3;
    f32x4 tq[16];
};
__device__ __forceinline__ int swa_jlo(int P0, int W) { const int lowk = P0 - W + 1; return lowk > 0 ? lowk / KVBLK : 0; }
#define ROW(p, k0, rr) ((p) + (size_t)((k0) + (rr)) * D + sc)
#define VMW() asm volatile("s_waitcnt vmcnt(0)" ::: "memory")
#define VMWN(n) asm volatile("s_waitcnt vmcnt(%0)" :: "i"(n) : "memory")
#define SLOAD_H(Kp, Vp, k0) do { S.st_v0 = load8<TIn>(ROW(Vp, k0, sr)); S.st_v1 = load8<TIn>(ROW(Vp, k0, 32 + sr));              \
                         S.st_k0 = load8<TIn>(ROW(Kp, k0, sr)); S.st_k1 = load8<TIn>(ROW(Kp, k0, 32 + sr)); } while (0)
#define SWRITE_HK(bf) do { *(bf16x8*)(K_lds + (bf) * SHM_K + kws) = S.st_k0; *(bf16x8*)(K_lds + (bf) * SHM_K + kws + 32 * 256) = S.st_k1; } while (0)
#define SWRITE_HV(bf) do { *(bf16x8*)(V_lds + (bf) * SHM_V + vst0) = S.st_v0; *(bf16x8*)(V_lds + (bf) * SHM_V + vst1) = S.st_v1; } while (0)
#define SWRITE_H(bf) do { SWRITE_HV(bf); SWRITE_HK(bf); } while (0)
#define SLOAD_F(p, k0) do { S.sf0 = *(const f32x4*)ROW(p, k0, sr); S.sf1 = *(const f32x4*)(ROW(p, k0, sr) + 4);                \
                            S.sf2 = *(const f32x4*)ROW(p, k0, 32 + sr); S.sf3 = *(const f32x4*)(ROW(p, k0, 32 + sr) + 4); } while (0)
#define SWRITE_KF(bf) do { *(bf16x8*)(K_lds + (bf) * SHM_K + kws) = pack8(S.sf0, S.sf1); *(bf16x8*)(K_lds + (bf) * SHM_K + kws + 32 * 256) = pack8(S.sf2, S.sf3); } while (0)
#define SWRITE_VF(bf) do { *(bf16x8*)(V_lds + (bf) * SHM_V + vst0) = pack8(S.sf0, S.sf1); *(bf16x8*)(V_lds + (bf) * SHM_V + vst1) = pack8(S.sf2, S.sf3); } while (0)
template <class TIn, class TOut>
__device__ __forceinline__ void causal_swa_prime(const BlockRef<TIn, TOut>& cur, int W, char* lds, Seam<TIn>& S) {
    constexpr bool F32 = same_t<TIn, float>::v;
    const int tid = opaque_tid(), wid = __builtin_amdgcn_readfirstlane(tid >> 6), lane = tid & 63, r32 = lane & 31, hi = lane >> 5;
    const int sr = tid >> 4, sc = (tid & 15) * 8, kws = KSWZ(sr, sc * 2); char* K_lds = lds + 2 * SHM_V;
    const int kb0 = swa_jlo(cur.P0, W) * KVBLK;
    for (int d0 = 0; d0 < 8; ++d0) S.qr[d0] = load8<TIn>(cur.Q + (size_t)(wid * QBLK + r32) * D + d0 * 16 + hi * 8);
    if constexpr (F32) { SLOAD_F((const float*)cur.K, kb0); VMW(); SWRITE_KF(0); SBAR(); SLOAD_F((const float*)cur.V, kb0); }
    else { SLOAD_H(cur.K, cur.V, kb0); VMW(); SWRITE_HK(0); }
    __syncthreads();
}
template <class TIn, class TOut>
__device__ __forceinline__ void causal_swa_block(const BlockRef<TIn, TOut>& cur, const BlockRef<TIn, TOut>& nxt, int skv, int W, char* lds, Seam<TIn>& S) {
    constexpr bool F32 = same_t<TIn, float>::v;
    const int tid = opaque_tid(), wid = __builtin_amdgcn_readfirstlane(tid >> 6), lane = tid & 63, r32 = lane & 31, hi = lane >> 5;
    const int j_lo = swa_jlo(cur.P0, W);
    int j_hi = (cur.P0 + QB - 1) / KVBLK + 1; if (j_hi > skv / KVBLK) j_hi = skv / KVBLK;
    const int NT = j_hi - j_lo;
    const int kbn = swa_jlo(nxt.P0, W) * KVBLK;
    const int qlo = cur.P0 + wid * QBLK, qm = qlo + r32 - 4 * hi;
    char* V_lds = lds; char* K_lds = lds + 2 * SHM_V;
    float* ws = (float*)(lds + 2 * SHM_V + 2 * SHM_K) + wid * 64; float* li_l = ws, * al_l = ws + 32;
    float m_reg = -1e30f, l_reg = 0; f32x16 o[4] = {};
    const int sr = tid >> 4, sc = (tid & 15) * 8, vst0 = v_st(sr, sc), vst1 = v_st(32 + sr, sc), kws = KSWZ(sr, sc * 2);
    const int vb0 = (int)(uintptr_t)V_lds + v_rd_base(lane);
    const TIn* Kh = cur.K; const TIn* Vh = cur.V;
#define RESC(a) do { if (__any((a) < 1.f)) { if (hi == 0) al_l[r32] = (a); asm volatile("s_waitcnt lgkmcnt(0)" ::: "memory");              \
                     for (int d_ = 0; d_ < 4; ++d_) for (int r = 0; r < 16; ++r) o[d_][r] *= al_l[crow(r, hi)]; } } while (0)
#define KBASE(t) ((j_lo + (t)) * KVBLK)
#define ACT(t) (KBASE(t) <= qlo + QBLK - 1 && KBASE(t) + KVBLK - 1 >= qlo - W + 1)
#define MASKT(P0_, P1_, t) do { const int kb_ = KBASE(t); if ((!SK || ACT(t)) && (kb_ + KVBLK - 1 > qlo || kb_ <= qlo + QBLK - 1 - W)) mask_tile(P0_, P1_, qm - kb_, (unsigned)W); } while (0)
    constexpr int NQL = F32 ? 16 : 8;
    constexpr bool SK = WSKIP && !F32;
#define SEAM_K0() do { VMWN(NQL); if constexpr (F32) { SWRITE_KF(0); SBAR(); SLOAD_F((const float*)nxt.V, kbn); } else { SWRITE_HK(0); } SBAR(); } while (0)
    f32x16 pA0, pA1, pB0, pB1; float mnA, mnB, alA, alB; bf16x8 pa0, pa1, pa2, pa3;
    if constexpr (F32) { VMW(); SWRITE_VF(0); SBAR(); } else { SWRITE_HV(0); SBAR(); }
    if (NT > 1) { if constexpr (F32) SLOAD_F((const float*)Kh, KBASE(1)); else SLOAD_H(Kh, Vh, KBASE(1)); }
    SBAR(); qkt<0, SK>(pA0, pA1, K_lds, r32, hi, S.qr, ACT(0));
    if constexpr (F32) { if (NT > 1) { VMW(); SWRITE_KF(1); SBAR(); SLOAD_F((const float*)Vh, KBASE(1)); } }
    MASKT(pA0, pA1, 0); partialSM(pA0, pA1, m_reg, mnA, alA);
    if (NT > 1) { VMW(); if constexpr (F32) { SWRITE_VF(1); SBAR(); if (NT > 2) SLOAD_F((const float*)Kh, KBASE(2)); } else SWRITE_H(1); }
    __syncthreads();
#define HALF_STEP(PX0, PX1, mnX, alX, PY0, PY1, alY, t, KB, VB, SB) do {                                                      \
        SBAR(); qkt<KB, SK>(PX0, PX1, K_lds, r32, hi, S.qr, ACT(t));                                             \
        finishSM(PY0, PY1, alY, l_reg, pa0, pa1, pa2, pa3); SBAR();                                                           \
        if ((t) + 1 < NT) { if constexpr (F32) { VMW(); SWRITE_KF(SB); SBAR(); SLOAD_F((const float*)Vh, KBASE((t) + 1)); }  \
                            else { SLOAD_H(Kh, Vh, KBASE((t) + 1)); } SBAR(); }                                               \
        pv_tile<VB, SK>(o, vb0, pa0, pa1, pa2, pa3, ACT((t) - 1)); MASKT(PX0, PX1, (t)); partialSM(PX0, PX1, m_reg, mnX, alX);                                        \
        __syncthreads();                                                                                                      \
        if ((t) + 1 < NT) { VMW(); if constexpr (F32) { SWRITE_VF(SB); SBAR(); if ((t) + 2 < NT) SLOAD_F((const float*)Kh, KBASE((t) + 2)); } \
                            else { SWRITE_H(SB); } }                                                                          \
        RESC(alX); __syncthreads(); } while (0)
    for (int t = 1; t + 1 < NT; t += 2) {
        HALF_STEP(pB0, pB1, mnB, alB, pA0, pA1, alA, t, 1, 0, 0);
        HALF_STEP(pA0, pA1, mnA, alA, pB0, pB1, alB, t + 1, 0, 1, 1);
    }
    const bool even = (NT & 1) == 0;
    if (even) { SBAR(); qkt<1, SK>(pB0, pB1, K_lds, r32, hi, S.qr, ACT(NT - 1)); SBAR(); }
#define QROW(e) (nxt.Q + (size_t)(wid * QBLK + r32) * D + ((e) >> 1) * 16 + hi * 8 + ((e) & 1) * 4)
    if constexpr (F32) { SLOAD_F((const float*)nxt.K, kbn); SBAR();
#pragma unroll
        for (int e = 0; e < 8; ++e) S.tq[e] = *(const f32x4*)QROW(e); }
    else { SLOAD_H(nxt.K, nxt.V, kbn); SBAR();
#pragma unroll
        for (int d0 = 0; d0 < 8; ++d0) S.qr[d0] = load8<TIn>(nxt.Q + (size_t)(wid * QBLK + r32) * D + d0 * 16 + hi * 8); }
    SBAR();
    finishSM(pA0, pA1, alA, l_reg, pa0, pa1, pa2, pa3); SBAR();
    if constexpr (F32) {
#pragma unroll
        for (int e = 8; e < 16; ++e) S.tq[e] = *(const f32x4*)QROW(e); SBAR(); }
#undef QROW
    pv_tile<0, SK>(o, vb0, pa0, pa1, pa2, pa3, ACT(even ? NT - 2 : NT - 1));
    if (even) { MASKT(pB0, pB1, NT - 1); partialSM(pB0, pB1, m_reg, mnB, alB); __syncthreads(); RESC(alB);
        finishSM(pB0, pB1, alB, l_reg, pa0, pa1, pa2, pa3); SBAR(); pv_tile<1, SK>(o, vb0, pa0, pa1, pa2, pa3, ACT(NT - 1)); }
    SBAR(); SEAM_K0();
    if (hi == 0) li_l[r32] = l_reg; asm volatile("s_waitcnt lgkmcnt(0)" ::: "memory");
    float rli[16];
#pragma unroll
    for (int r = 0; r < 16; ++r) rli[r] = __builtin_amdgcn_rcpf(li_l[crow(r, hi)]);
    TOut* Ow = cur.O + (size_t)(wid * QBLK) * D;
#pragma unroll
    for (int r = 0; r < 16; ++r) { const int orow = crow(r, hi);
#pragma unroll
        for (int d0 = 0; d0 < 4; ++d0) { const float v = o[d0][r] * rli[r];
            if constexpr (same_t<TOut, float>::v) { Ow[(size_t)orow * D + d0 * 32 + r32] = v; }
            else { const float vn = __shfl_xor(v, 1);
                   if ((r32 & 1) == 0) *(unsigned*)(Ow + (size_t)orow * D + d0 * 32 + r32) = cvtpk(v, vn); } } }
    if constexpr (F32) {
#pragma unroll
        for (int d0 = 0; d0 < 8; ++d0) S.qr[d0] = pack8(S.tq[2 * d0], S.tq[2 * d0 + 1]); }
    __syncthreads();
#undef RESC
#undef KBASE
#undef ACT
#undef MASKT
#undef SEAM_K0
#undef HALF_STEP
}
#undef ROW
#undef VMW
#undef VMWN
#undef SLOAD_H
#undef SWRITE_HK
#undef SWRITE_HV
#undef SWRITE_H
#undef SLOAD_F
#undef SWRITE_KF
#undef SWRITE_VF
#undef KSWZ
#undef SBAR
}

namespace att2 {
typedef short bf16x8 __attribute__((ext_vector_type(8)));
typedef short s16x4 __attribute__((ext_vector_type(4)));
typedef float f32x16 __attribute__((ext_vector_type(16)));
typedef unsigned u32x4 __attribute__((ext_vector_type(4)));
constexpr float SCALE = 0.08838834764831845f, THR = 8.f, C2 = 1.4426950408889634f * SCALE;
constexpr int V_OFF = 0, K_OFF = 65536, PX_OFF = 98304, MX_OFF = 114688, WS_OFF = 118784, LDS_NEED = 120832;
#define A2_KSWZ(row, colB) ((row) * 256 + ((colB) ^ (((row) & 7) << 4)))
#define A2_SBAR() __builtin_amdgcn_sched_barrier(0)
template <int KB>
__device__ __forceinline__ void qkt(f32x16& p, const char* Kl, int krow, int hi, const bf16x8* qr) {
    p = f32x16{};
    const char* kbp[4];
#pragma unroll
    for (int dd = 0; dd < 4; ++dd) kbp[dd] = Kl + KB * 16384 + A2_KSWZ(krow, (dd * 16 + hi * 8) * 2);
    bf16x8 b[8];
#pragma unroll
    for (int d0 = 0; d0 < 8; ++d0) b[d0] = *reinterpret_cast<const bf16x8*>(kbp[d0 & 3] + (d0 >> 2) * 128);
    __builtin_amdgcn_s_setprio(3);
#pragma unroll
    for (int d0 = 0; d0 < 8; ++d0) p = __builtin_amdgcn_mfma_f32_32x32x16_bf16(b[d0], qr[d0], p, 0, 0, 0);
    __builtin_amdgcn_s_setprio(0);
}
template <int VOFFB>
__device__ __forceinline__ void pv(f32x16* o, int vb0, bf16x8 pa0, bf16x8 pa1, bf16x8 pa2, bf16x8 pa3) {
#define A2_TRRD(dst, off) asm volatile("ds_read_b64_tr_b16 %0, %1 offset:%2" : "=&v"(dst) : "v"(vb0), "i"(off) : "memory")
#define A2_PV_D0(d0) do { s16x4 l0, l1, l2, l3, h0, h1, h2, h3; constexpr int b_ = VOFFB + att::v_rd_off(d0, 0, 0); \
        A2_TRRD(l0, b_); A2_TRRD(h0, b_ + 2048); A2_TRRD(l1, b_ + 4096); A2_TRRD(h1, b_ + 6144); A2_TRRD(l2, b_ + 8192); A2_TRRD(h2, b_ + 10240); A2_TRRD(l3, b_ + 12288); A2_TRRD(h3, b_ + 14336); \
        asm volatile("s_waitcnt lgkmcnt(0)" ::: "memory"); A2_SBAR(); \
        o[d0] = __builtin_amdgcn_mfma_f32_32x32x16_bf16(pa0, (bf16x8){l0[0], l0[1], l0[2], l0[3], h0[0], h0[1], h0[2], h0[3]}, o[d0], 0, 0, 0); \
        o[d0] = __builtin_amdgcn_mfma_f32_32x32x16_bf16(pa1, (bf16x8){l1[0], l1[1], l1[2], l1[3], h1[0], h1[1], h1[2], h1[3]}, o[d0], 0, 0, 0); \
        o[d0] = __builtin_amdgcn_mfma_f32_32x32x16_bf16(pa2, (bf16x8){l2[0], l2[1], l2[2], l2[3], h2[0], h2[1], h2[2], h2[3]}, o[d0], 0, 0, 0); \
        o[d0] = __builtin_amdgcn_mfma_f32_32x32x16_bf16(pa3, (bf16x8){l3[0], l3[1], l3[2], l3[3], h3[0], h3[1], h3[2], h3[3]}, o[d0], 0, 0, 0); } while (0)
    __builtin_amdgcn_s_setprio(3); A2_PV_D0(0); A2_PV_D0(1); A2_PV_D0(2); A2_PV_D0(3); __builtin_amdgcn_s_setprio(0);
#undef A2_PV_D0
#undef A2_TRRD
}
__device__ __forceinline__ float rowmax16(const f32x16& p) {
    float pm = p[0];
#pragma unroll
    for (int r = 1; r < 16; ++r) pm = fmaxf(pm, p[r]);
    auto rr = __builtin_amdgcn_permlane32_swap(__float_as_uint(pm), __float_as_uint(pm), false, false);
    return fmaxf(__uint_as_float(rr[0]), __uint_as_float(rr[1]));
}
template <bool DEG>
__device__ __forceinline__ void block(const unsigned short* Q, const unsigned short* K, const unsigned short* V0, const unsigned short* V1, float* O0, float* O1, int P0, char* lds) {
    const int tid = opaque_tid(), wid = __builtin_amdgcn_readfirstlane(tid >> 6), lane = tid & 63, r32 = lane & 31, hi = lane >> 5, rg = wid >> 1, kh = wid & 1, hf = wid >> 2;
    const int NT = P0 / 64 + 2, qlo = P0 + 32 * rg;
    const int sr = tid >> 4, sc = (tid & 15) * 8, kws = A2_KSWZ(sr, sc * 2), vst0 = att::v_st(sr, sc), vst1 = att::v_st(32 + sr, sc);
    char* Vl = lds + V_OFF; char* Kl = lds + K_OFF;
    const int vb0 = (int)(uintptr_t)Vl + att::v_rd_base(lane) + kh * 16384, krow = 32 * kh + r32;
    float* wsl = (float*)(lds + WS_OFF) + wid * 64; float* al_l = wsl; float* li_l = wsl + 32;
    const float* li_p = (const float*)(lds + WS_OFF) + (wid ^ 1) * 64 + 32;
    float* mxw = (float*)(lds + MX_OFF) + wid * 64 + lane; const float* mxr = (const float*)(lds + MX_OFF) + (wid ^ 1) * 64 + lane;
    char* pxw = lds + PX_OFF + ((rg * 4 + 2 * kh) * 64 + lane) * 16; const char* pxr = lds + PX_OFF + (rg * 4 * 64 + lane) * 16;
    bf16x8 qr[8];
#pragma unroll
    for (int d0 = 0; d0 < 8; ++d0) qr[d0] = *reinterpret_cast<const bf16x8*>(Q + (size_t)(32 * rg + r32) * 128 + d0 * 16 + hi * 8);
    bf16x8 sk0, sk1, sv0, sv1, sv2, sv3;
#define A2_LOADK(t) do { const size_t o0_ = (size_t)((DEG ? 0 : (t)) * 64 + sr) * 128 + sc, o1_ = o0_ + 32 * 128; sk0 = *reinterpret_cast<const bf16x8*>(K + o0_); sk1 = *reinterpret_cast<const bf16x8*>(K + o1_); } while (0)
#define A2_LOADV(t) do { const size_t o0_ = (size_t)((DEG ? 0 : (t)) * 64 + sr) * 128 + sc, o1_ = o0_ + 32 * 128; \
        sv0 = *reinterpret_cast<const bf16x8*>(V0 + o0_); sv1 = *reinterpret_cast<const bf16x8*>(V0 + o1_); sv2 = *reinterpret_cast<const bf16x8*>(V1 + o0_); sv3 = *reinterpret_cast<const bf16x8*>(V1 + o1_); } while (0)
#define A2_BAR() do { asm volatile("s_waitcnt lgkmcnt(0)" ::: "memory"); __builtin_amdgcn_s_barrier(); asm volatile("" ::: "memory"); } while (0)
#define A2_WRITEK(b) do { *(bf16x8*)(Kl + (b) * 16384 + kws) = sk0; *(bf16x8*)(Kl + (b) * 16384 + kws + 32 * 256) = sk1; } while (0)
#define A2_WRITEV(b) do { *(bf16x8*)(Vl + (b) * 32768 + vst0) = sv0; *(bf16x8*)(Vl + (b) * 32768 + vst1) = sv1; *(bf16x8*)(Vl + (b) * 32768 + 16384 + vst0) = sv2; *(bf16x8*)(Vl + (b) * 32768 + 16384 + vst1) = sv3; } while (0)
#define A2_VMW(n) asm volatile("s_waitcnt vmcnt(%0)" :: "i"(n) : "memory")
#define A2_MASKMAX(PX, pmX, t) do { const int kb_ = (t) * 64 + 32 * kh; \
        if (__builtin_expect(kb_ + 31 > qlo, 0)) { asm volatile("; diagonal tile: mask" ::: "memory");     \
            const int dq_ = qlo + r32 - kb_ - 4 * hi; const float NEG_ = -__builtin_inff(); \
            _Pragma("unroll") for (int r = 0; r < 16; ++r) { const int c_ = (r & 3) + 8 * (r >> 2); if (dq_ - c_ < 0) PX[r] = NEG_; } } \
        pmX = rowmax16(PX); mxw[((t) & 1) * 512] = pmX; } while (0)
#define A2_FINISH(PY, pmY, alY, u) do { const float pm_ = fmaxf(pmY, mxr[((u) & 1) * 512]); float mn_; \
        if (__builtin_expect(__all((pm_ - m_reg) * SCALE <= THR), 1)) { mn_ = m_reg; alY = 1.f; } \
        else { mn_ = fmaxf(m_reg, pm_); alY = __builtin_amdgcn_exp2f((m_reg - mn_) * C2); m_reg = mn_; } \
        const float mnL_ = -mn_ * C2; \
        _Pragma("unroll") for (int r = 0; r < 16; ++r) PY[r] = __builtin_amdgcn_exp2f(fmaf(PY[r], C2, mnL_)); \
        float ps_ = 0.f; _Pragma("unroll") for (int r = 0; r < 16; ++r) ps_ += PY[r]; \
        { auto rr_ = __builtin_amdgcn_permlane32_swap(__float_as_uint(ps_), __float_as_uint(ps_), false, false); ps_ = __uint_as_float(rr_[0]) + __uint_as_float(rr_[1]); } \
        l_reg = l_reg * alY + ps_; \
        A2_PK4(PY, 0, pxw); A2_PK4(PY, 8, pxw + 1024); } while (0)
#define A2_PK4(P, B_, DST) do { unsigned a0_ = att::cvtpk(P[B_ + 0], P[B_ + 1]), a1_ = att::cvtpk(P[B_ + 2], P[B_ + 3]), b0_ = att::cvtpk(P[B_ + 4], P[B_ + 5]), b1_ = att::cvtpk(P[B_ + 6], P[B_ + 7]); \
        auto r0_ = __builtin_amdgcn_permlane32_swap(a0_, b0_, false, false); auto r1_ = __builtin_amdgcn_permlane32_swap(a1_, b1_, false, false); \
        u32x4 w_ = {r0_[0], r1_[0], r0_[1], r1_[1]}; *(u32x4*)(DST) = w_; } while (0)
#define A2_PVSTEP(alY, VOFFB) do { const bf16x8 pa0_ = *reinterpret_cast<const bf16x8*>(pxr), pa1_ = *reinterpret_cast<const bf16x8*>(pxr + 1024), pa2_ = *reinterpret_cast<const bf16x8*>(pxr + 2048), pa3_ = *reinterpret_cast<const bf16x8*>(pxr + 3072); \
        if (__any((alY) < 1.f)) { if (hi == 0) al_l[r32] = (alY); asm volatile("s_waitcnt lgkmcnt(0)" ::: "memory"); \
            _Pragma("unroll") for (int d_ = 0; d_ < 4; ++d_) _Pragma("unroll") for (int r = 0; r < 16; ++r) o[d_][r] *= al_l[att::crow(r, hi)]; } \
        pv<VOFFB>(o, vb0, pa0_, pa1_, pa2_, pa3_); } while (0)
#define A2_STEP(PX, pmX, PY, pmY, alY, t, KB) do { \
        __builtin_amdgcn_s_setprio(2); A2_FINISH(PY, pmY, alY, (t) - 1); __builtin_amdgcn_s_setprio(0); A2_SBAR(); \
        qkt<KB>(PX, Kl, krow, hi, qr); A2_SBAR(); \
        __builtin_amdgcn_s_setprio(2); A2_MASKMAX(PX, pmX, t); __builtin_amdgcn_s_setprio(0); A2_SBAR(); \
        if ((t) + 1 < NT) { A2_VMW(4); A2_WRITEK(1 - KB); if ((t) + 2 < NT) A2_LOADK((t) + 2); } \
        A2_BAR(); \
        A2_PVSTEP(alY, (1 - KB) * 32768); A2_SBAR(); \
        if ((t) + 2 < NT) A2_VMW(2); else A2_VMW(0); \
        A2_WRITEV(KB); if ((t) + 1 < NT) A2_LOADV((t) + 1); \
        A2_BAR(); } while (0)
    float m_reg = -1e30f, l_reg = 0.f; f32x16 o[4] = {};
    f32x16 pA, pB; float pmA, pmB, alA = 1.f, alB = 1.f;
    A2_LOADK(0); A2_VMW(0); A2_WRITEK(0); A2_LOADK(1); A2_LOADV(0);
    A2_BAR();
    if (hf == 1) A2_BAR();
    qkt<0>(pA, Kl, krow, hi, qr); A2_SBAR();
    A2_MASKMAX(pA, pmA, 0); A2_SBAR();
    A2_VMW(4); A2_WRITEK(1); if (2 < NT) A2_LOADK(2);
    A2_BAR();
    if (2 < NT) A2_VMW(2); else A2_VMW(0);
    A2_WRITEV(0); A2_LOADV(1);
    A2_BAR();
    A2_STEP(pB, pmB, pA, pmA, alA, 1, 1);
    for (int t = 2; t < NT; t += 2) {
        A2_STEP(pA, pmA, pB, pmB, alB, t, 0);
        A2_STEP(pB, pmB, pA, pmA, alA, t + 1, 1);
    }
    A2_FINISH(pB, pmB, alB, NT - 1);
    A2_BAR();
    A2_PVSTEP(alB, 32768);
    if (hf == 0) A2_BAR();
    if (hi == 0) li_l[r32] = l_reg;
    A2_BAR();
    float rli[16];
#pragma unroll
    for (int r = 0; r < 16; ++r) rli[r] = __builtin_amdgcn_rcpf(li_l[att::crow(r, hi)] + li_p[att::crow(r, hi)]);
    float* Ow = (kh ? O1 : O0) + (size_t)(32 * rg) * 128;
#pragma unroll
    for (int r = 0; r < 16; ++r) { const int orow = att::crow(r, hi);
#pragma unroll
        for (int d0 = 0; d0 < 4; ++d0) Ow[(size_t)orow * 128 + d0 * 32 + r32] = o[d0][r] * rli[r]; }
    A2_BAR();
#undef A2_LOADK
#undef A2_LOADV
#undef A2_BAR
#undef A2_WRITEK
#undef A2_WRITEV
#undef A2_VMW
#undef A2_MASKMAX
#undef A2_FINISH
#undef A2_PK4
#undef A2_PVSTEP
#undef A2_STEP
}
#undef A2_KSWZ
#undef A2_SBAR
}

#ifndef MK_PER_PHASE
#define MK_PER_PHASE 0
#endif
constexpr int NWAVES = 8, NTHR = 512;
constexpr int SEQ = 16384, DM = 4096, FFH = 11008, DEPTH = 4, NMODV = 6 * DM;
#ifndef PADK
#define PADK 64
#endif
constexpr int LDD = DM + PADK, LDF = FFH + PADK;
constexpr int ZG = 96;
constexpr size_t GS = (size_t)SEQ * 128;
constexpr int S5T = 64, S5NC = SEQ / S5T;
constexpr int KSL = 16;
constexpr float NORM_EPS = 1e-6f, SUBLN_EPS = 1e-5f;
constexpr int N_PHASES = 35;

constexpr size_t MiB = 1u << 20;
constexpr size_t WS_CTL = 0, CTL_ZERO_BYTES = 64 * 1024;
constexpr size_t WS_MODP = 1 * MiB;
constexpr size_t WS_MODL = 3 * MiB;
constexpr size_t WS_LAM = 3 * MiB + 512 * 1024;
constexpr size_t WS_S5P = 4 * MiB, S5P_LAYER = 4 * MiB + 256 * 1024;
constexpr size_t S5P_ABR = 0, S5P_ABI = 64 * 1024, S5P_ATR = 128 * 1024, S5P_ATI = 192 * 1024, S5P_BBR = 256 * 1024, S5P_BBI = 256 * 1024 + MiB;
constexpr size_t S5P_BBOP = 256 * 1024 + 2 * MiB, S5P_COP = 256 * 1024 + 3 * MiB;
#ifndef S5_MFMA
#define S5_MFMA 1
#endif
constexpr size_t W_IN_B = (size_t)12288 * LDD * 2, W_OUT_B = (size_t)4096 * LDD * 2, W_GLU_B = (size_t)8192 * LDD * 2, W_GU_B = (size_t)22016 * LDD * 2, W_DN_B = (size_t)4096 * LDF * 2;
constexpr size_t WS_WIN = 16 * MiB, WS_WOUT = WS_WIN + 2 * W_IN_B, WS_WGLU = WS_WOUT + 2 * W_OUT_B, WS_WGU = WS_WGLU + 2 * W_GLU_B, WS_WDN = WS_WGU + 4 * W_GU_B;
constexpr size_t WS_H = WS_WDN + 4 * W_DN_B;
constexpr size_t WS_MIX = WS_H + (size_t)SEQ * LDD * 2;
constexpr size_t WS_Z = WS_MIX + (size_t)SEQ * LDD * 2;
constexpr size_t WS_OT = WS_Z + (size_t)ZG * GS * 2;
constexpr size_t WS_S5F = WS_OT + (size_t)32 * GS * 4;
constexpr size_t WS_S5H = WS_S5F + (size_t)S5NC * 256 * 128 * 4;
constexpr size_t WS_END = WS_S5H + (size_t)S5NC * 256 * 128 * 4;
static_assert((size_t)SEQ * LDF * 2 <= (size_t)ZG * GS * 2, "hidden overlays Z");
static_assert(WS_WIN % 256 == 0 && WS_H % 256 == 0 && WS_OT % 256 == 0 && WS_S5F % 256 == 0, "alignment");
constexpr int CW_BAR = 1024;

constexpr int RING_BYTES = 131072, MISC_OFF = RING_BYTES + 320, LDS_BYTES = 147456;

#define GAS __attribute__((address_space(1)))
#define LAS __attribute__((address_space(3)))
typedef unsigned short bf16;
typedef unsigned v4u __attribute__((ext_vector_type(4)));
typedef unsigned v2u __attribute__((ext_vector_type(2)));
typedef float f32x4 __attribute__((ext_vector_type(4)));
#define LDS_WAIT() asm volatile("s_waitcnt lgkmcnt(0)" ::: "memory")
#define VM_WAIT() asm volatile("s_waitcnt vmcnt(0)" ::: "memory")
__device__ __forceinline__ unsigned pk2(float lo, float hi) { unsigned r; asm volatile("v_cvt_pk_bf16_f32 %0, %1, %2" : "=v"(r) : "v"(lo), "v"(hi)); return r; }
__device__ __forceinline__ float bflo(unsigned w) { return __builtin_bit_cast(float, w << 16); }
__device__ __forceinline__ float bfhi(unsigned w) { return __builtin_bit_cast(float, w & 0xffff0000u); }

#define XB_TMO      128
#define XB_XCNT(j)  (256  + 64 * (j))
#define XB_XSUB(j)  (1280 + 64 * (j))
#define XB_XGEN(j)  (2304 + 64 * (j))
#define XB_TOP      3328
#define XB_TOPGEN   3392
#define XCD_BAR_WORDS 3456
#define XB_SPIN_CAP (1u << 22)

__device__ __forceinline__ unsigned xb_ld(unsigned* p)              { return __hip_atomic_load(p, __ATOMIC_RELAXED, __HIP_MEMORY_SCOPE_AGENT); }
__device__ __forceinline__ unsigned xb_add(unsigned* p, unsigned v) { return __hip_atomic_fetch_add(p, v, __ATOMIC_RELAXED, __HIP_MEMORY_SCOPE_AGENT); }
__device__ __forceinline__ unsigned xb_xcc_id() { return (unsigned)__builtin_amdgcn_s_getreg((3 << 11) | 20) & 0xFu; }
#define XB_SPIN(cond, bar) do { unsigned _sp = 0; while (cond) { __builtin_amdgcn_s_sleep(1); \
    if ((++_sp & 255u) == 0u) { if (xb_ld(&(bar)[XB_TMO])) break; if (_sp > XB_SPIN_CAP) { atomicAdd(&(bar)[XB_TMO], 1u); break; } } } } while (0)

struct XcdBarrier {
    unsigned* bar; unsigned x;
    volatile LAS unsigned* st;
};
__device__ __forceinline__ XcdBarrier xcd_barrier_post(unsigned* bar, volatile LAS unsigned* st) {
    XcdBarrier b; b.bar = bar; b.x = xb_xcc_id(); b.st = st;
    if (threadIdx.x == 0) (void)xb_add(&bar[XB_XCNT(b.x)], 1u);
    return b;
}
__device__ __forceinline__ void xcd_barrier_complete(unsigned* bar, unsigned x, unsigned& nloc, unsigned& nx) {
    const unsigned G = gridDim.x * gridDim.y * gridDim.z;
    unsigned sum, cnt, mine, sp = 0u;
    for (;;) {
        sum = 0u; cnt = 0u; mine = 0u;
#pragma unroll
        for (unsigned j = 0; j < 16; ++j) { const unsigned c = xb_ld(&bar[XB_XCNT(j)]); sum += c; cnt += (c > 0u) ? 1u : 0u; mine = (j == x) ? c : mine; }
        if (sum == G) break;
        __builtin_amdgcn_s_sleep(1);
        if ((++sp & 255u) == 0u) { if (xb_ld(&bar[XB_TMO])) break; if (sp > XB_SPIN_CAP) { atomicAdd(&bar[XB_TMO], 1u); break; } }
    }
    nloc = mine > 0u ? mine : 1u; nx = cnt > 0u ? cnt : 1u;
}
__device__ __forceinline__ void xcd_barrier(const XcdBarrier& b) {
    asm volatile("s_waitcnt vmcnt(0)" ::: "memory");
    __syncthreads();
    if (threadIdx.x == 0) {
        unsigned* bar = b.bar;
        __builtin_amdgcn_s_waitcnt(0);
        unsigned nloc = b.st[0], nx = b.st[1];
        if (nloc == 0u) { xcd_barrier_complete(bar, b.x, nloc, nx); b.st[0] = nloc; b.st[1] = nx; }
        const unsigned old = xb_add(&bar[XB_XSUB(b.x)], 1u);
        const unsigned gen = old / nloc;
        if (old + 1u == (gen + 1u) * nloc) {
            __builtin_amdgcn_fence(__ATOMIC_RELEASE, "agent");
            asm volatile("s_waitcnt vmcnt(0)" ::: "memory");
            const unsigned og = xb_add(&bar[XB_TOP], 1u);
            const unsigned tg = og / nx;
            if (og + 1u == (tg + 1u) * nx) xb_add(&bar[XB_TOPGEN], 1u);
            else XB_SPIN(xb_ld(&bar[XB_TOPGEN]) == tg, bar);
            __builtin_amdgcn_fence(__ATOMIC_ACQUIRE, "agent");
            xb_add(&bar[XB_XGEN(b.x)], 1u);
            asm volatile("s_waitcnt vmcnt(0)" ::: "memory");
        } else {
            XB_SPIN(xb_ld(&bar[XB_XGEN(b.x)]) == gen, bar);
            __builtin_amdgcn_fence(__ATOMIC_ACQUIRE, "agent");
            asm volatile("s_waitcnt vmcnt(0)" ::: "memory");
        }
    }
    __syncthreads();
}

__device__ __forceinline__ float wave_sum(float v) {
#pragma unroll
    for (int o = 1; o < 64; o <<= 1) v += __shfl_xor(v, o);
    return v;
}

__device__ __forceinline__ void transpose_item(const float* W, int K, int N, bf16* WT, int ldw, int mode, LAS float* scr, int item, int lane) {
    const int nblk = N / 32, kb = item / nblk, nb = item - kb * nblk, k0 = 64 * kb, n0 = 32 * nb;
    const int drow0 = mode == 0 ? n0 : ((n0 >> 7) * 256 + (n0 & 127) + (mode == 2 ? 128 : 0));
#pragma unroll 8
    for (int i = 0; i < 32; ++i) { const int kk = 2 * i + (lane >> 5); scr[kk * 33 + (lane & 31)] = W[(size_t)(k0 + kk) * N + n0 + (lane & 31)]; }
    LDS_WAIT(); asm volatile("" ::: "memory");
    const int c = lane & 7;
#pragma unroll
    for (int j = 0; j < 4; ++j) { const int n = (lane >> 3) + 8 * j; const LAS float* s = scr + (8 * c) * 33 + n;
        v4u o; o.x = pk2(s[0 * 33], s[1 * 33]); o.y = pk2(s[2 * 33], s[3 * 33]); o.z = pk2(s[4 * 33], s[5 * 33]); o.w = pk2(s[6 * 33], s[7 * 33]);
        *(v4u*)(WT + (size_t)(drow0 + n) * ldw + k0 + 8 * c) = o; }
    LDS_WAIT(); asm volatile("" ::: "memory");
}
__device__ __forceinline__ void dsincos(double x, double& s, double& c) {
    const double k = rint(x * 0.63661977236758134308);
    double r = fma(-k, 1.5707963267948966192, x); r = fma(-k, 6.1232339957367658860e-17, r);
    const double r2 = r * r;
    double ps = -1.0 / 1307674368000.0; ps = fma(ps, r2, 1.0 / 6227020800.0); ps = fma(ps, r2, -1.0 / 39916800.0); ps = fma(ps, r2, 1.0 / 362880.0); ps = fma(ps, r2, -1.0 / 5040.0);
    ps = fma(ps, r2, 1.0 / 120.0); ps = fma(ps, r2, -1.0 / 6.0); ps = fma(ps, r2, 1.0); const double sn = r * ps;
    double pc = 1.0 / 20922789888000.0; pc = fma(pc, r2, -1.0 / 87178291200.0); pc = fma(pc, r2, 1.0 / 479001600.0); pc = fma(pc, r2, -1.0 / 3628800.0); pc = fma(pc, r2, 1.0 / 40320.0);
    pc = fma(pc, r2, -1.0 / 720.0); pc = fma(pc, r2, 1.0 / 24.0); pc = fma(pc, r2, -0.5); const double cs = fma(pc, r2, 1.0);
    const int q = (int)k & 3;
    s = (q == 0) ? sn : (q == 1) ? cs : (q == 2) ? -sn : -cs;
    c = (q == 0) ? cs : (q == 1) ? -sn : (q == 2) ? -cs : sn;
}
__device__ __forceinline__ double dexp(double x) {
    const double k = rint(x * 1.4426950408889634074);
    double r = fma(-k, 0.69314718055994528623, x); r = fma(-k, 2.3190468138462995584e-17, r);
    double p = 1.0 / 87178291200.0; p = fma(p, r, 1.0 / 6227020800.0); p = fma(p, r, 1.0 / 479001600.0); p = fma(p, r, 1.0 / 39916800.0); p = fma(p, r, 1.0 / 3628800.0); p = fma(p, r, 1.0 / 362880.0);
    p = fma(p, r, 1.0 / 40320.0); p = fma(p, r, 1.0 / 5040.0); p = fma(p, r, 1.0 / 720.0); p = fma(p, r, 1.0 / 120.0); p = fma(p, r, 1.0 / 24.0); p = fma(p, r, 1.0 / 6.0); p = fma(p, r, 0.5); p = fma(p, r, 1.0); p = fma(p, r, 1.0);
    const long long bits = (long long)(1023 + (int)k) << 52;
    return p * __builtin_bit_cast(double, bits);
}

struct Args { const float* in[29]; float* out; unsigned char* ws; int ph_lo, ph_hi; };

__device__ __forceinline__ void p0_prologue(const Args& A, LAS unsigned char* lds, int gw, int NGW, int wave, int lane) {
    unsigned char* ws = A.ws;
    for (int w = gw; w < 96 * KSL + 512 + 2048; w += NGW) {
    if (w >= 96 * KSL + 512) {
        const int idx = (w - 96 * KSL - 512) * 64 + lane, o = idx >> 16, r = idx & 65535, g = r >> 8, mm = (r >> 6) & 3, o16 = lane & 15, kq = lane >> 4;
        const int tau = 2 * mm, p0 = 16 * (tau & 3) + 4 * kq;
        const float* cs = (tau < 4 ? A.in[21] : A.in[22]) + (size_t)o * 256 * 16 * 64 + (size_t)(g * 16 + o16) * 64 + p0; const float sg = tau < 4 ? 1.0f : -1.0f;
        const f32x4 a = *(const f32x4*)cs * sg, b = *(const f32x4*)(cs + 16) * sg;
        v4u q; q.x = pk2(a.x, a.y); q.y = pk2(a.z, a.w); q.z = pk2(b.x, b.y); q.w = pk2(b.z, b.w);
        *(v4u*)(ws + WS_S5P + (size_t)o * S5P_LAYER + S5P_COP + ((size_t)((g * 4 + mm) * 64 + lane)) * 16) = q;
    } else if (w < 96 * KSL) {
        const int nb = w % 96, ks = w / 96;
        const float* wp = A.in[2] + (size_t)(ks * 256) * NMODV + nb * 256 + lane * 4; const float* cp = A.in[1] + ks * 256;
        f32x4 a = {0.f, 0.f, 0.f, 0.f};
#pragma unroll 8
        for (int k = 0; k < 256; ++k) { const float cv = cp[k]; const float s = cv / (1.0f + expf(-cv)); const f32x4 w = *(const f32x4*)(wp + (size_t)k * NMODV); a += s * w; }
        *(f32x4*)((float*)(ws + WS_MODP) + (size_t)ks * NMODV + nb * 256 + lane * 4) = a;
    } else {
        const int idx = (w - 96 * KSL) * 64 + lane, o = idx >> 14, gp = idx & 16383, g = gp >> 6;
        const double lr = (double)fminf(A.in[16][idx], -1e-4f), li = (double)A.in[17][idx], dt = dexp((double)A.in[18][o * 256 + g]);
        const double mag = dexp(lr * dt); double sn, cs; dsincos(li * dt, sn, cs);
        const double abr = mag * cs, abi = mag * sn, den = lr * lr + li * li, nr = abr - 1.0, ni = abi;
        const double fre = (nr * lr + ni * li) / den, fim = (ni * lr - nr * li) / den;
        double tr = abr, ti = abi;
#pragma unroll
        for (int q = 0; q < 6; ++q) { const double t2 = tr * tr - ti * ti; ti = 2.0 * tr * ti; tr = t2; }
        unsigned char* pb = ws + WS_S5P + (size_t)o * S5P_LAYER;
        ((float*)(pb + S5P_ABR))[gp] = (float)abr; ((float*)(pb + S5P_ABI))[gp] = (float)abi; ((float*)(pb + S5P_ATR))[gp] = (float)tr; ((float*)(pb + S5P_ATI))[gp] = (float)ti;
        const float* bre = A.in[19] + (size_t)idx * 16; const float* bim = A.in[20] + (size_t)idx * 16;
        float* obr = (float*)(pb + S5P_BBR) + (size_t)gp * 16; float* obi = (float*)(pb + S5P_BBI) + (size_t)gp * 16;
#pragma unroll
        for (int h4 = 0; h4 < 4; ++h4) { const f32x4 br = *(const f32x4*)(bre + 4 * h4), bi = *(const f32x4*)(bim + 4 * h4); f32x4 r, i;
#pragma unroll
            for (int j = 0; j < 4; ++j) { r[j] = (float)(fre * (double)br[j] - fim * (double)bi[j]); i[j] = (float)(fre * (double)bi[j] + fim * (double)br[j]); }
            *(f32x4*)(obr + 4 * h4) = r; *(f32x4*)(obi + 4 * h4) = i; }
        { const int p = gp & 63, ti = p >> 4, i16 = p & 15;
#pragma unroll
          for (int kq = 0; kq < 4; ++kq) { const f32x4 r = *(const f32x4*)(obr + 4 * kq), i = *(const f32x4*)(obi + 4 * kq);
              v2u pr, pi; pr.x = pk2(r.x, r.y); pr.y = pk2(r.z, r.w); pi.x = pk2(i.x, i.y); pi.y = pk2(i.z, i.w);
              *(v2u*)(pb + S5P_BBOP + ((size_t)((g * 8 + ti) * 64 + kq * 16 + i16)) * 8) = pr; *(v2u*)(pb + S5P_BBOP + ((size_t)((g * 8 + 4 + ti) * 64 + kq * 16 + i16)) * 8) = pi; } }
    }
    }
    if (gw < 2) { const int e = gw;
        const float s1 = wave_sum(A.in[10][e * 128 + lane] * A.in[11][e * 128 + lane] + A.in[10][e * 128 + 64 + lane] * A.in[11][e * 128 + 64 + lane]);
        const float s2 = wave_sum(A.in[12][e * 128 + lane] * A.in[13][e * 128 + lane] + A.in[12][e * 128 + 64 + lane] * A.in[13][e * 128 + 64 + lane]);
        const float lam_init = e == 0 ? 0.2f : 0.4707130183435842f;
        if (lane == 0) ((float*)(ws + WS_LAM))[e] = expf(s1) - expf(s2) + lam_init; }
    LAS float* scr = (LAS float*)(lds + wave * 16384);
    constexpr int I_IN = 64 * 384, I_OUT = 64 * 128, I_GLU = 64 * 128, I_GU = 64 * 344, I_DN = 172 * 128;
    constexpr int NITEMS = 2 * I_IN + 2 * I_OUT + 4 * I_GLU + 8 * I_GU + 4 * I_DN;
    for (int it = gw; it < NITEMS; it += NGW) {
        int r = it;
        if (r < 2 * I_IN) { const int e = r / I_IN; transpose_item(A.in[8] + (size_t)e * DM * 12288, DM, 12288, (bf16*)(ws + WS_WIN + e * W_IN_B), LDD, 0, scr, r - e * I_IN, lane); continue; } r -= 2 * I_IN;
        if (r < 2 * I_OUT) { const int e = r / I_OUT; transpose_item(A.in[15] + (size_t)e * DM * DM, DM, DM, (bf16*)(ws + WS_WOUT + e * W_OUT_B), LDD, 0, scr, r - e * I_OUT, lane); continue; } r -= 2 * I_OUT;
        if (r < 4 * I_GLU) { const int q = r / I_GLU, o = q >> 1, s = q & 1; transpose_item(A.in[24 + s] + (size_t)o * DM * DM, DM, DM, (bf16*)(ws + WS_WGLU + o * W_GLU_B), LDD, 1 + s, scr, r - q * I_GLU, lane); continue; } r -= 4 * I_GLU;
        if (r < 8 * I_GU) { const int q = r / I_GU, l = q >> 1, s = q & 1; transpose_item(A.in[26 + s] + (size_t)l * DM * FFH, DM, FFH, (bf16*)(ws + WS_WGU + l * W_GU_B), LDD, 1 + s, scr, r - q * I_GU, lane); continue; } r -= 8 * I_GU;
        { const int l = r / I_DN; transpose_item(A.in[28] + (size_t)l * FFH * DM, FFH, DM, (bf16*)(ws + WS_WDN + l * W_DN_B), LDF, 0, scr, r - l * I_DN, lane); }
    }
}
__device__ __forceinline__ void p1_modvec(const Args& A, int gtid, int NGT) {
    const float* mp = (const float*)(A.ws + WS_MODP); float* ml = (float*)(A.ws + WS_MODL);
    for (int i = gtid; i < DEPTH * NMODV; i += NGT) { const int j = i % NMODV; float v = A.in[3][j] + A.in[4][i];
#pragma unroll
        for (int ks = 0; ks < KSL; ++ks) v += mp[(size_t)ks * NMODV + j];
        ml[i] = v; }
}
__device__ __forceinline__ void norm_mod_phase(const float* src, const float* nw, const float* sh, const float* sc, bf16* dst, LAS unsigned char* lds, int tid, int gw, int NGW, int lane) {
    LAS float* w1 = (LAS float*)lds; LAS float* bb = w1 + DM;
    for (int i = tid; i < DM; i += NTHR) { w1[i] = nw[i] * (1.0f + sc[i]); bb[i] = sh[i]; }
    __syncthreads();
    for (int m = gw; m < SEQ; m += NGW) {
        const f32x4* xr = (const f32x4*)(src + (size_t)m * DM) + lane;
        f32x4 v[16]; float ss = 0.f;
#pragma unroll
        for (int j = 0; j < 16; ++j) { v[j] = xr[64 * j]; ss += (v[j].x * v[j].x + v[j].y * v[j].y) + (v[j].z * v[j].z + v[j].w * v[j].w); }
        const float rstd = 1.0f / sqrtf(wave_sum(ss) * (1.0f / DM) + NORM_EPS);
        v2u* o8 = (v2u*)(dst + (size_t)m * LDD) + lane;
#pragma unroll
        for (int j = 0; j < 16; ++j) { const int col = j * 256 + lane * 4; const f32x4 w = *(const LAS f32x4*)(w1 + col), b = *(const LAS f32x4*)(bb + col);
            const f32x4 y = v[j] * rstd * w + b; v2u p; p.x = pk2(y.x, y.y); p.y = pk2(y.z, y.w); o8[64 * j] = p; }
    }
    __syncthreads();
}
__device__ __forceinline__ void final_norm_phase(const float* src, const float* nw, float* dst, int gw, int NGW, int lane) {
    for (int m = gw; m < SEQ; m += NGW) {
        const f32x4* xr = (const f32x4*)(src + (size_t)m * DM) + lane;
        f32x4 v[16]; float ss = 0.f;
#pragma unroll
        for (int j = 0; j < 16; ++j) { v[j] = xr[64 * j]; ss += (v[j].x * v[j].x + v[j].y * v[j].y) + (v[j].z * v[j].z + v[j].w * v[j].w); }
        const float rstd = 1.0f / sqrtf(wave_sum(ss) * (1.0f / DM) + NORM_EPS);
        f32x4* o = (f32x4*)(dst + (size_t)m * DM) + lane; const f32x4* wv = (const f32x4*)nw + lane;
#pragma unroll
        for (int j = 0; j < 16; ++j) o[64 * j] = v[j] * rstd * wv[64 * j];
    }
}
__device__ __forceinline__ void conv_phase(const bf16* Z, const float* cw, bf16* MIX, int gtid, int NGT) {
    for (int i = gtid; i < SEQ * 256; i += NGT) {
        const int t = i >> 8, r = i & 255, gi = r >> 4, c8 = (r & 15) * 8;
        const size_t o = (size_t)t * 128 + c8;
        const v4u zero = {0u, 0u, 0u, 0u};
        const v4u vb = *(const v4u*)(Z + (size_t)gi * GS + o);
        const bf16* zc = Z + (size_t)(16 + gi) * GS + o; const bf16* zx = Z + (size_t)(32 + gi) * GS + o;
        const v4u c0 = *(const v4u*)zc, x0 = *(const v4u*)zx;
        const v4u c1 = t >= 1 ? *(const v4u*)(zc - 128) : zero, x1 = t >= 1 ? *(const v4u*)(zx - 128) : zero;
        const v4u c2 = t >= 2 ? *(const v4u*)(zc - 256) : zero, x2 = t >= 2 ? *(const v4u*)(zx - 256) : zero;
        const float* wp = cw + gi * 128 + c8;
        float y[8];
#pragma unroll
        for (int q = 0; q < 4; ++q) {
            const float u0l = bflo(c0[q]) * bflo(x0[q]), u0h = bfhi(c0[q]) * bfhi(x0[q]);
            const float u1l = bflo(c1[q]) * bflo(x1[q]), u1h = bfhi(c1[q]) * bfhi(x1[q]);
            const float u2l = bflo(c2[q]) * bflo(x2[q]), u2h = bfhi(c2[q]) * bfhi(x2[q]);
            const int j = 2 * q;
            y[j]     = bflo(vb[q]) * (wp[2 * 2048 + j] * u0l + wp[2048 + j] * u1l + wp[j] * u2l);
            y[j + 1] = bfhi(vb[q]) * (wp[2 * 2048 + j + 1] * u0h + wp[2048 + j + 1] * u1h + wp[j + 1] * u2h);
        }
        v4u w; w.x = pk2(y[0], y[1]); w.y = pk2(y[2], y[3]); w.z = pk2(y[4], y[5]); w.w = pk2(y[6], y[7]);
        *(v4u*)(MIX + (size_t)t * LDD + gi * 128 + c8) = w;
    }
}
__device__ __forceinline__ void combine_phase(const float* OT, const float* lamp, const float* sg, float lam_init, bf16* MIX, int gw, int NGW, int lane) {
    const float lam = lamp[0], os = 1.0f - lam_init;
    const int j = lane >> 5, c4 = (lane & 31) * 4;
    const f32x4 gv = *(const f32x4*)(sg + 128 * j + c4);
    for (int it0 = gw * 4; it0 < SEQ * 8; it0 += NGW * 4) {
        f32x4 a[4], b[4];
#pragma unroll
        for (int q = 0; q < 4; ++q) { const int it = it0 + q, t = it >> 3, h = it & 7;
            a[q] = *(const f32x4*)(OT + (size_t)(h * 4 + j) * GS + (size_t)t * 128 + c4); b[q] = *(const f32x4*)(OT + (size_t)(h * 4 + 2 + j) * GS + (size_t)t * 128 + c4); }
#pragma unroll
        for (int q = 0; q < 4; ++q) { const int it = it0 + q, t = it >> 3, h = it & 7;
            const f32x4 o = a[q] - lam * b[q];
            const float rstd = 1.0f / sqrtf(wave_sum((o.x * o.x + o.y * o.y) + (o.z * o.z + o.w * o.w)) * (1.0f / 256.0f) + SUBLN_EPS);
            const f32x4 y = o * (rstd * os) * gv;
            v2u p; p.x = pk2(y.x, y.y); p.y = pk2(y.z, y.w);
            *(v2u*)(MIX + (size_t)t * LDD + 2048 + 256 * h + 128 * j + c4) = p; }
    }
}
__device__ __forceinline__ att::BlockRef<att::bf16, float> att_ref(const bf16* Z, float* OT, int item, int pass) {
    const int r = item >> 8, b = item & 255, vh = r * 8 + (b & 7), pair = b >> 3, qb = pass ? 63 - pair : pair;
    const int h = vh >> 2, m = (vh >> 1) & 1, j = vh & 1;
    att::BlockRef<att::bf16, float> R;
    R.Q = (const att::bf16*)(Z + (size_t)(48 + 2 * h + m) * GS + (size_t)qb * 256 * 128);
    R.K = (const att::bf16*)(Z + (size_t)(64 + 2 * h + m) * GS);
    R.V = (const att::bf16*)(Z + (size_t)(80 + 2 * h + j) * GS);
    R.O = OT + (size_t)vh * GS + (size_t)qb * 256 * 128; R.P0 = qb * 256;
    return R;
}
__device__ __forceinline__ void attn_phase(const bf16* Z, float* OT, char* lds, int bid, int G) {
    constexpr int TOTAL = 1024;
    int item = bid; if (item >= TOTAL) return;
    int pass = 0;
    att::BlockRef<att::bf16, float> cur = att_ref(Z, OT, item, 0);
    att::Seam<att::bf16> S;
    att::causal_swa_prime<att::bf16, float>(cur, SEQ, lds, S);
    for (;;) {
        const bool more_pass = pass == 0, more_item = item + G < TOTAL, last = !more_pass && !more_item;
        int itn = item, passn = 1;
        if (!more_pass) { passn = 0; itn = more_item ? item + G : item; }
        const att::BlockRef<att::bf16, float> nxt = last ? cur : att_ref(Z, OT, itn, passn);
        att::causal_swa_block<att::bf16, float>(cur, nxt, SEQ, SEQ, lds, S);
        if (last) break;
        cur = nxt; item = itn; pass = passn;
    }
}
#ifndef ATT2
#define ATT2 1
#endif
template <bool DEG>
__device__ __forceinline__ void attn2_phase(const bf16* Z, float* OT, char* lds, int bid, int G) {
    for (int item = bid; item < 1024; item += G) {
        const int r = item >> 8, b = item & 255, hm = 2 * (b & 7) + (r >> 1), pair = (r & 1) * 32 + (b >> 3), h = hm >> 1, m = hm & 1;
        for (int pass = 0; pass < 2; ++pass) { const int qb = pass ? 127 - pair : pair;
            att2::block<DEG>(Z + (size_t)(48 + 2 * h + m) * GS + (size_t)qb * 128 * 128, Z + (size_t)(64 + 2 * h + m) * GS, Z + (size_t)(80 + 2 * h) * GS, Z + (size_t)(81 + 2 * h) * GS,
                        OT + (size_t)(h * 4 + m * 2) * GS + (size_t)qb * 128 * 128, OT + (size_t)(h * 4 + m * 2 + 1) * GS + (size_t)qb * 128 * 128, qb * 128, lds); }
    }
}
__device__ __forceinline__ float gelu_tanh(float x) { const float z = 1.5957691216057308f * (x + 0.044715f * x * x * x); return x * __builtin_amdgcn_rcpf(1.0f + __builtin_amdgcn_exp2f(-1.4426950408889634f * z)); }
template <bool PASS2>
__device__ __forceinline__ void s5_pass(const bf16* Hin, const unsigned char* prm, const float* c_re, const float* c_im, const float* dsk, float* F, const float* HC, bf16* Gout,
                                        LAS unsigned char* lds, int gw, int NGW, int wave, int lane) {
    LAS float* lu = (LAS float*)(lds + wave * 4096);
    for (int item = gw; item < 256 * S5NC; item += NGW) {
        const int g = item & 255, c = item >> 8, gp = g * 64 + lane;
        { const bf16* up = Hin + (size_t)(c * S5T + lane) * LDD + 16 * g; const v4u a = *(const v4u*)up, b = *(const v4u*)(up + 8);
          LAS f32x4* ur = (LAS f32x4*)(lu + lane * 16);
          ur[0] = (f32x4){bflo(a.x), bfhi(a.x), bflo(a.y), bfhi(a.y)}; ur[1] = (f32x4){bflo(a.z), bfhi(a.z), bflo(a.w), bfhi(a.w)};
          ur[2] = (f32x4){bflo(b.x), bfhi(b.x), bflo(b.y), bfhi(b.y)}; ur[3] = (f32x4){bflo(b.z), bfhi(b.z), bflo(b.w), bfhi(b.w)}; }
        f32x4 bbr[4], bbi[4];
#pragma unroll
        for (int q = 0; q < 4; ++q) { bbr[q] = *(const f32x4*)((const float*)(prm + S5P_BBR) + (size_t)gp * 16 + 4 * q); bbi[q] = *(const f32x4*)((const float*)(prm + S5P_BBI) + (size_t)gp * 16 + 4 * q); }
        const float abr = ((const float*)(prm + S5P_ABR))[gp], abi = ((const float*)(prm + S5P_ABI))[gp];
        float hr = 0.f, hi = 0.f, cr[16], ci[16], dk = 0.f;
        if (PASS2) {
#pragma unroll
            for (int o = 0; o < 16; ++o) { cr[o] = c_re[(size_t)(g * 16 + o) * 64 + lane]; ci[o] = c_im[(size_t)(g * 16 + o) * 64 + lane]; }
            hr = HC[(size_t)(c * 256 + g) * 128 + lane]; hi = HC[(size_t)(c * 256 + g) * 128 + 64 + lane]; dk = dsk[16 * g + (lane >> 2)];
        }
        LDS_WAIT(); asm volatile("" ::: "memory");
#pragma unroll 2
        for (int t = 0; t < S5T; ++t) {
            const LAS f32x4* ut = (const LAS f32x4*)(lu + t * 16);
            float bur = 0.f, bui = 0.f;
#pragma unroll
            for (int q = 0; q < 4; ++q) { const f32x4 u = ut[q];
                bur += (bbr[q].x * u.x + bbr[q].y * u.y) + (bbr[q].z * u.z + bbr[q].w * u.w); bui += (bbi[q].x * u.x + bbi[q].y * u.y) + (bbi[q].z * u.z + bbi[q].w * u.w); }
            const float nr = abr * hr - abi * hi + bur, ni = abr * hi + abi * hr + bui; hr = nr; hi = ni;
            if (PASS2) {
                float v[16];
#pragma unroll
                for (int o = 0; o < 16; ++o) v[o] = hr * cr[o] - hi * ci[o];
#pragma unroll
                for (int i = 0; i < 8; ++i) { const float send = (lane & 32) ? v[i] : v[i + 8], keep = (lane & 32) ? v[i + 8] : v[i]; v[i] = keep + __shfl_xor(send, 32); }
#pragma unroll
                for (int i = 0; i < 4; ++i) { const float send = (lane & 16) ? v[i] : v[i + 4], keep = (lane & 16) ? v[i + 4] : v[i]; v[i] = keep + __shfl_xor(send, 16); }
#pragma unroll
                for (int i = 0; i < 2; ++i) { const float send = (lane & 8) ? v[i] : v[i + 2], keep = (lane & 8) ? v[i + 2] : v[i]; v[i] = keep + __shfl_xor(send, 8); }
                { const float send = (lane & 4) ? v[0] : v[1], keep = (lane & 4) ? v[1] : v[0]; v[0] = keep + __shfl_xor(send, 4); }
                v[0] += __shfl_xor(v[0], 2); v[0] += __shfl_xor(v[0], 1);
                const float yy = v[0] + dk * lu[t * 16 + (lane >> 2)];
                const float gl = gelu_tanh(yy);
                if ((lane & 3) == 0) Gout[(size_t)(c * S5T + t) * LDD + 16 * g + (lane >> 2)] = (bf16)(pk2(gl, gl) & 0xffffu);
            }
        }
        if (!PASS2) { F[(size_t)(c * 256 + g) * 128 + lane] = hr; F[(size_t)(c * 256 + g) * 128 + 64 + lane] = hi; }
        LDS_WAIT(); asm volatile("" ::: "memory");
    }
}

constexpr int S5TS = 8, S5SB = S5TS * 256 + 16;
typedef short s5_bf16x8 __attribute__((ext_vector_type(8)));
template <bool PASS2>
__device__ __forceinline__ void s5m_pass(const bf16* Hin, const unsigned char* prm, const float* dsk, float* F, const float* HC, bf16* Gout, LAS unsigned char* lds, int bid, int G) {
    const int tid = opaque_tid(), lane = tid & 63, w = __builtin_amdgcn_readfirstlane(tid >> 6), j = lane & 15, rq = lane >> 4;
    const int rowslot = tid >> 4, piece = tid & 15;
    constexpr int NST = S5T / S5TS, NQ = 16 * S5TS / 32;
    for (int unit = bid; unit < 32 * (S5NC / 16); unit += G) {
        const int gb = unit & 31, cs = unit >> 5, g = gb * 8 + w;
        v2u bb[8];
#pragma unroll
        for (int t8 = 0; t8 < 8; ++t8) bb[t8] = *(const v2u*)(prm + S5P_BBOP + ((size_t)((g * 8 + t8) * 64 + lane)) * 8);
        v4u cop[4];
        f32x4 ar[4], ai[4], sr[4], si[4], dk = {0.f, 0.f, 0.f, 0.f};
#pragma unroll
        for (int q = 0; q < 4; ++q) { ar[q] = *(const f32x4*)((const float*)(prm + S5P_ABR) + g * 64 + 16 * q + 4 * rq); ai[q] = *(const f32x4*)((const float*)(prm + S5P_ABI) + g * 64 + 16 * q + 4 * rq); }
        if (PASS2) {
#pragma unroll
            for (int mm = 0; mm < 4; ++mm) cop[mm] = *(const v4u*)(prm + S5P_COP + ((size_t)((g * 4 + mm) * 64 + lane)) * 16);
            const float* hc = HC + ((size_t)(cs * 16 + j) * 256 + g) * 128 + 4 * rq;
#pragma unroll
            for (int q = 0; q < 4; ++q) { sr[q] = *(const f32x4*)(hc + 16 * q); si[q] = *(const f32x4*)(hc + 64 + 16 * q); }
            dk = *(const f32x4*)(dsk + 16 * g + 4 * rq);
        } else {
#pragma unroll
            for (int q = 0; q < 4; ++q) { sr[q] = (f32x4){0.f, 0.f, 0.f, 0.f}; si[q] = (f32x4){0.f, 0.f, 0.f, 0.f}; }
        }
        const bf16* src = Hin + (size_t)(cs * 16 * S5T) * LDD + gb * 128 + piece * 8;
        bf16* dstp = PASS2 ? Gout + (size_t)(cs * 16 * S5T) * LDD + gb * 128 + piece * 8 : nullptr;
        v4u pre[NQ];
#pragma unroll
        for (int q = 0; q < NQ; ++q) { const int ri = q * 32 + rowslot, jj = ri / S5TS, tt = ri % S5TS; pre[q] = *(const v4u*)(src + (size_t)(jj * S5T + tt) * LDD); }
        for (int s = 0; s < NST; ++s) {
#pragma unroll
            for (int q = 0; q < NQ; ++q) { const int ri = q * 32 + rowslot, jj = ri / S5TS, tt = ri % S5TS; LAS v4u* lp = (LAS v4u*)(lds + jj * S5SB + tt * 256 + piece * 16);
                if (PASS2 && s > 0) { const v4u y = *lp; *(v4u*)(dstp + (size_t)(jj * S5T + (s - 1) * S5TS + tt) * LDD) = y; }
                *lp = pre[q]; }
            if (s + 1 < NST) {
#pragma unroll
                for (int q = 0; q < NQ; ++q) { const int ri = q * 32 + rowslot, jj = ri / S5TS, tt = ri % S5TS; pre[q] = *(const v4u*)(src + (size_t)(jj * S5T + (s + 1) * S5TS + tt) * LDD); } }
            LDS_WAIT(); __syncthreads();
            LAS unsigned char* up = lds + j * S5SB + w * 32 + rq * 8;
            v2u uu[S5TS];
#pragma unroll
            for (int tt = 0; tt < S5TS; ++tt) uu[tt] = *(const LAS v2u*)(up + tt * 256);
#pragma unroll
            for (int tt = 0; tt < S5TS; ++tt) {
                v4u ub; ub.x = uu[tt].x; ub.y = uu[tt].y; ub.z = 0u; ub.w = 0u;
                const s5_bf16x8 U = __builtin_bit_cast(s5_bf16x8, ub);
#pragma unroll
                for (int q = 0; q < 4; ++q) {
                    const f32x4 tr = ar[q] * sr[q] - ai[q] * si[q], ti = ar[q] * si[q] + ai[q] * sr[q];
                    v4u a0; a0.x = bb[q].x; a0.y = bb[q].y; a0.z = 0u; a0.w = 0u; v4u a1; a1.x = bb[4 + q].x; a1.y = bb[4 + q].y; a1.z = 0u; a1.w = 0u;
                    sr[q] = __builtin_amdgcn_mfma_f32_16x16x32_bf16(__builtin_bit_cast(s5_bf16x8, a0), U, tr, 0, 0, 0);
                    si[q] = __builtin_amdgcn_mfma_f32_16x16x32_bf16(__builtin_bit_cast(s5_bf16x8, a1), U, ti, 0, 0, 0);
                }
                if (PASS2) {
                    f32x4 y = {0.f, 0.f, 0.f, 0.f};
#pragma unroll
                    for (int mm = 0; mm < 4; ++mm) { const f32x4 t0 = mm < 2 ? sr[2 * mm] : si[2 * mm - 4], t1 = mm < 2 ? sr[2 * mm + 1] : si[2 * mm - 3];
                        v4u sb; sb.x = pk2(t0.x, t0.y); sb.y = pk2(t0.z, t0.w); sb.z = pk2(t1.x, t1.y); sb.w = pk2(t1.z, t1.w);
                        y = __builtin_amdgcn_mfma_f32_16x16x32_bf16(__builtin_bit_cast(s5_bf16x8, cop[mm]), __builtin_bit_cast(s5_bf16x8, sb), y, 0, 0, 0); }
                    const f32x4 uf = {bflo(uu[tt].x), bfhi(uu[tt].x), bflo(uu[tt].y), bfhi(uu[tt].y)};
                    const f32x4 yy = y + dk * uf;
                    v2u o; o.x = pk2(gelu_tanh(yy.x), gelu_tanh(yy.y)); o.y = pk2(gelu_tanh(yy.z), gelu_tanh(yy.w));
                    *(LAS v2u*)(up + tt * 256) = o;
                }
            }
            LDS_WAIT(); __syncthreads();
        }
        if (PASS2) {
#pragma unroll
            for (int q = 0; q < NQ; ++q) { const int ri = q * 32 + rowslot, jj = ri / S5TS, tt = ri % S5TS; const v4u y = *(const LAS v4u*)(lds + jj * S5SB + tt * 256 + piece * 16);
                *(v4u*)(dstp + (size_t)(jj * S5T + (NST - 1) * S5TS + tt) * LDD) = y; }
            LDS_WAIT();
        } else {
            float* fo = F + ((size_t)(cs * 16 + j) * 256 + g) * 128 + 4 * rq;
#pragma unroll
            for (int q = 0; q < 4; ++q) { *(f32x4*)(fo + 16 * q) = sr[q]; *(f32x4*)(fo + 64 + 16 * q) = si[q]; }
        }
    }
}
__device__ __forceinline__ void s5_carry(const unsigned char* prm, const float* F, float* HC, int bid, int G, int wave, int lane) {
    if (wave != 0) return;
    for (int g = bid; g < 256; g += G) {
        const int p = lane, gp = g * 64 + p;
        const float atr = ((const float*)(prm + S5P_ATR))[gp], ati = ((const float*)(prm + S5P_ATI))[gp];
        float hr = 0.f, hi = 0.f;
        for (int c0 = 0; c0 < S5NC; c0 += 32) {
            float fr[32], fi[32];
#pragma unroll
            for (int q = 0; q < 32; ++q) { const size_t o = (size_t)((c0 + q) * 256 + g) * 128 + p; fr[q] = F[o]; fi[q] = F[o + 64]; }
#pragma unroll
            for (int q = 0; q < 32; ++q) { const size_t o = (size_t)((c0 + q) * 256 + g) * 128 + p;
                HC[o] = hr; HC[o + 64] = hi;
                const float nr = atr * hr - ati * hi + fr[q], ni = atr * hi + ati * hr + fi[q]; hr = nr; hi = ni; }
        }
    }
}

struct Ctx { int lo, hi, tid, lane, wave, gw, NGW, gtid, NGT, G, bid; };
#ifndef WGM_IN
#define WGM_IN 8
#endif
#ifndef WGM_OUT
#define WGM_OUT 2
#endif
#ifndef WGM_GLU
#define WGM_GLU 4
#endif
#ifndef WGM_F1
#define WGM_F1 8
#endif
#ifndef WGM_F2
#define WGM_F2 2
#endif
#ifndef DUP_ATTN
#define DUP_ATTN 0
#endif
#ifndef DUP_S5
#define DUP_S5 0
#endif
#ifndef DUP_FFN1
#define DUP_FFN1 0
#endif
#ifndef DUP_FFN2
#define DUP_FFN2 0
#endif
#ifndef DUP_INP
#define DUP_INP 0
#endif
#ifndef DUP_PRO
#define DUP_PRO 0
#endif
#define IN(k) (lo <= (k) && (k) < hi)
#define SEAM(k) do { if (IN(k) && IN((k) + 1)) xcd_barrier(bar); } while (0)
#define FFN_PHASES(l, pb) do { \
    const float* ml_ = MODL + (size_t)(l) * NMODV; \
    if (IN((pb) + 5)) norm_mod_phase(XR, args.in[6] + (size_t)(l) * DM, ml_ + 3 * DM, ml_ + 4 * DM, Hb, lds, tid, gw, NGW, lane); \
    SEAM((pb) + 5); \
    if (IN((pb) + 6)) { pg8::Gemm g{Hb, (const bf16*)(ws + WS_WGU + (size_t)(l) * W_GU_B), SEQ, 2 * FFH, DM, LDD, LDD}; pg8::StaticOrder S; S.init(SEQ, 2 * FFH, G, bid, WGM_F1); \
        pg8::EpiSwiGLU E{HID, LDF}; pg8::gemm_phase<pg8::EpiSwiGLU, pg8::StaticOrder, true, true>(lds, g, S, E); } \
    if (DUP_FFN1 && IN((pb) + 6)) { xcd_barrier(bar); pg8::Gemm g{Hb, (const bf16*)(ws + WS_WGU + (size_t)(l) * W_GU_B), SEQ, 2 * FFH, DM, LDD, LDD}; pg8::StaticOrder S; S.init(SEQ, 2 * FFH, G, bid, WGM_F1); \
        pg8::EpiSwiGLU E{HID, LDF}; pg8::gemm_phase<pg8::EpiSwiGLU, pg8::StaticOrder, true, true>(lds, g, S, E); } \
    SEAM((pb) + 6); \
    if (DUP_FFN2 && IN((pb) + 7)) { xcd_barrier(bar); pg8::Gemm g{HID, (const bf16*)(ws + WS_WDN + (size_t)(l) * W_DN_B), SEQ, DM, FFH, LDF, LDF}; pg8::StaticOrder S; S.init(SEQ, DM, G, bid, WGM_F2); \
        pg8::EpiResid E{XR, (float*)(ws + WS_OT), ml_ + 5 * DM, DM}; pg8::gemm_phase<pg8::EpiResid, pg8::StaticOrder, true, true>(lds, g, S, E); } \
    if (IN((pb) + 7)) { pg8::Gemm g{HID, (const bf16*)(ws + WS_WDN + (size_t)(l) * W_DN_B), SEQ, DM, FFH, LDF, LDF}; pg8::StaticOrder S; S.init(SEQ, DM, G, bid, WGM_F2); \
        pg8::EpiResid E{XR, XR, ml_ + 5 * DM, DM}; pg8::gemm_phase<pg8::EpiResid, pg8::StaticOrder, true, true>(lds, g, S, E); } \
    SEAM((pb) + 7); } while (0)
template <int lp>
__device__ __forceinline__ void layer_pair(const Args& args, const Ctx& C, LAS unsigned char* lds, unsigned char* lds_raw, const XcdBarrier& bar) {
    const int lo = C.lo, hi = C.hi, tid = C.tid, lane = C.lane, wave = C.wave, gw = C.gw, NGW = C.NGW, gtid = C.gtid, NGT = C.NGT, G = C.G, bid = C.bid;
    unsigned char* ws = args.ws;
    bf16* const Hb = (bf16*)(ws + WS_H); bf16* const MIX = (bf16*)(ws + WS_MIX); bf16* const Z = (bf16*)(ws + WS_Z); bf16* const HID = (bf16*)(ws + WS_Z);
    float* const OT = (float*)(ws + WS_OT); float* const XR = args.out;
    const float* const MODL = (const float*)(ws + WS_MODL);
        { const int l = 2 * lp, pb = 2 + 8 * l; const float* ml = MODL + (size_t)l * NMODV;
          const float* xin = (l == 0) ? args.in[0] : XR;
          if (IN(pb)) norm_mod_phase(xin, args.in[5] + (size_t)l * DM, ml, ml + DM, Hb, lds, tid, gw, NGW, lane);
          SEAM(pb);
          if (IN(pb + 1)) { pg8::Gemm g{Hb, (const bf16*)(ws + WS_WIN + (size_t)lp * W_IN_B), SEQ, 12288, DM, LDD, LDD}; pg8::StaticOrder S; S.init(SEQ, 12288, G, bid, WGM_IN);
              pg8::EpiHeadMajor E{Z, GS}; pg8::gemm_phase<pg8::EpiHeadMajor, pg8::StaticOrder, true, true>(lds, g, S, E); }
          if (DUP_INP && IN(pb + 1)) { xcd_barrier(bar); pg8::Gemm g{Hb, (const bf16*)(ws + WS_WIN + (size_t)lp * W_IN_B), SEQ, 12288, DM, LDD, LDD}; pg8::StaticOrder S; S.init(SEQ, 12288, G, bid, WGM_IN);
              pg8::EpiHeadMajor E{Z, GS}; pg8::gemm_phase<pg8::EpiHeadMajor, pg8::StaticOrder, true, true>(lds, g, S, E); }
          SEAM(pb + 1);
          if (IN(pb + 2)) { conv_phase(Z, args.in[9] + (size_t)lp * 3 * 2048, MIX, gtid, NGT); if (ATT2) attn2_phase<false>(Z, OT, (char*)lds_raw, bid, G); else attn_phase(Z, OT, (char*)lds_raw, bid, G); if (DUP_ATTN == 1) { xcd_barrier(bar); attn2_phase<false>(Z, (float*)(ws + WS_END), (char*)lds_raw, bid, G); } if (DUP_ATTN == 2) { xcd_barrier(bar); attn2_phase<true>(Z, (float*)(ws + WS_END), (char*)lds_raw, bid, G); } }
          SEAM(pb + 2);
          if (IN(pb + 3)) combine_phase(OT, (const float*)(ws + WS_LAM) + lp, args.in[14] + lp * 256, lp == 0 ? 0.2f : 0.4707130183435842f, MIX, gw, NGW, lane);
          SEAM(pb + 3);
          if (IN(pb + 4)) { pg8::Gemm g{MIX, (const bf16*)(ws + WS_WOUT + (size_t)lp * W_OUT_B), SEQ, DM, DM, LDD, LDD}; pg8::StaticOrder S; S.init(SEQ, DM, G, bid, WGM_OUT);
              pg8::EpiResid E{xin, XR, ml + 2 * DM, DM}; pg8::gemm_phase<pg8::EpiResid, pg8::StaticOrder, true, true>(lds, g, S, E); }
          SEAM(pb + 4);
          FFN_PHASES(l, pb);
        }
        { const int l = 2 * lp + 1, pb = 2 + 8 * l; const float* ml = MODL + (size_t)l * NMODV;
          const unsigned char* prm = ws + WS_S5P + (size_t)lp * S5P_LAYER;
          float* const S5F = (float*)(ws + WS_S5F); float* const S5H = (float*)(ws + WS_S5H);
          if (IN(pb)) norm_mod_phase(XR, args.in[5] + (size_t)l * DM, ml, ml + DM, Hb, lds, tid, gw, NGW, lane);
          SEAM(pb);
          if (IN(pb + 1)) { if (S5_MFMA) s5m_pass<false>(Hb, prm, nullptr, S5F, nullptr, nullptr, lds, bid, G); else s5_pass<false>(Hb, prm, nullptr, nullptr, nullptr, S5F, nullptr, nullptr, lds, gw, NGW, wave, lane); }
          SEAM(pb + 1);
          if (IN(pb + 2)) s5_carry(prm, S5F, S5H, bid, G, wave, lane);
          SEAM(pb + 2);
          if (IN(pb + 3)) { if (S5_MFMA) s5m_pass<true>(Hb, prm, args.in[23] + (size_t)lp * DM, nullptr, S5H, MIX, lds, bid, G); else s5_pass<true>(Hb, prm, args.in[21] + (size_t)lp * 256 * 16 * 64, args.in[22] + (size_t)lp * 256 * 16 * 64, args.in[23] + (size_t)lp * DM, nullptr, S5H, MIX, lds, gw, NGW, wave, lane); }
          if (DUP_S5) { xcd_barrier(bar);
          if (IN(pb + 1)) { if (S5_MFMA) s5m_pass<false>(Hb, prm, nullptr, S5F, nullptr, nullptr, lds, bid, G); else s5_pass<false>(Hb, prm, nullptr, nullptr, nullptr, S5F, nullptr, nullptr, lds, gw, NGW, wave, lane); }
          SEAM(pb + 1);
          if (IN(pb + 2)) s5_carry(prm, S5F, S5H, bid, G, wave, lane);
          SEAM(pb + 2);
          if (IN(pb + 3)) { if (S5_MFMA) s5m_pass<true>(Hb, prm, args.in[23] + (size_t)lp * DM, nullptr, S5H, MIX, lds, bid, G); else s5_pass<true>(Hb, prm, args.in[21] + (size_t)lp * 256 * 16 * 64, args.in[22] + (size_t)lp * 256 * 16 * 64, args.in[23] + (size_t)lp * DM, nullptr, S5H, MIX, lds, gw, NGW, wave, lane); }
          }
          SEAM(pb + 3);
          if (IN(pb + 4)) { pg8::Gemm g{MIX, (const bf16*)(ws + WS_WGLU + (size_t)lp * W_GLU_B), SEQ, 2 * DM, DM, LDD, LDD}; pg8::StaticOrder S; S.init(SEQ, 2 * DM, G, bid, WGM_GLU);
              pg8::EpiGluResid E{XR, XR, ml + 2 * DM, DM}; pg8::gemm_phase<pg8::EpiGluResid, pg8::StaticOrder, true, true>(lds, g, S, E); }
          SEAM(pb + 4);
          FFN_PHASES(l, pb);
        }
    }
#undef FFN_PHASES
#undef IN
#undef SEAM

__global__ void __launch_bounds__(NTHR, 2) trunk_fwd(Args args) {
    extern __shared__ __attribute__((aligned(16))) unsigned char lds_raw[];
    LAS unsigned char* lds = (LAS unsigned char*)lds_raw;
    volatile LAS unsigned* MISC = (volatile LAS unsigned*)(lds + MISC_OFF);
    const int tid = opaque_tid(), lane = tid & 63, wave = __builtin_amdgcn_readfirstlane(tid >> 6);
    const int G = gridDim.x, bid = blockIdx.x;
    const int vcu = (G % 8 == 0) ? (bid % 8) * (G / 8) + bid / 8 : bid;
    const int gw = vcu * NWAVES + wave, NGW = G * NWAVES, gtid = vcu * NTHR + tid, NGT = G * NTHR;
    unsigned char* ws = args.ws;
    const int lo = args.ph_lo, hi = args.ph_hi;
    for (int u = tid; u < (LDS_BYTES - RING_BYTES) / 4; u += NTHR) ((LAS unsigned*)(lds + RING_BYTES))[u] = 0u;
    __syncthreads();
    XcdBarrier bar; bar.bar = (unsigned*)(ws + WS_CTL) + CW_BAR; bar.x = 0; bar.st = MISC + 8;
    if (hi - lo > 1) bar = xcd_barrier_post((unsigned*)(ws + WS_CTL) + CW_BAR, MISC + 8);
    const Ctx C{lo, hi, tid, lane, wave, gw, NGW, gtid, NGT, G, bid};
#define IN(k) (lo <= (k) && (k) < hi)
#define SEAM(k) do { if (IN(k) && IN((k) + 1)) xcd_barrier(bar); } while (0)

    bf16* const Hb = (bf16*)(ws + WS_H); bf16* const MIX = (bf16*)(ws + WS_MIX); bf16* const Z = (bf16*)(ws + WS_Z); bf16* const HID = (bf16*)(ws + WS_Z);
    float* const OT = (float*)(ws + WS_OT); float* const XR = args.out;
    const float* const MODL = (const float*)(ws + WS_MODL);

    if (IN(0)) { p0_prologue(args, lds, gw, NGW, wave, lane); if (DUP_PRO) { xcd_barrier(bar); p0_prologue(args, lds, gw, NGW, wave, lane); } }
    SEAM(0);
    if (IN(1)) p1_modvec(args, gtid, NGT);
    SEAM(1);


    layer_pair<0>(args, C, lds, lds_raw, bar);
    layer_pair<1>(args, C, lds, lds_raw, bar);
    if (IN(34)) final_norm_phase(XR, args.in[7], XR, gw, NGW, lane);
#undef IN
#undef SEAM
}

extern "C" void kernel_launch(void* const* d_in, const int* in_sizes, int n_in, void* d_out, int out_size, void* d_ws, size_t ws_size, hipStream_t stream) {
    static int grid = 0;
    if (grid == 0) {
        if (n_in != 29 || in_sizes[0] != SEQ * DM || out_size != SEQ * DM || ws_size < WS_END + (DUP_ATTN ? (size_t)32 * GS * 4 : 0)) {
            fprintf(stderr, "kernel_launch: built for 29 inputs, x/out of %d floats, >= %zu bytes of workspace; got n_in %d, in0 %d, out %d, ws %zu; nothing launched\n", SEQ * DM, (size_t)WS_END, n_in, n_in > 0 ? in_sizes[0] : -1, out_size, ws_size); grid = -1; return; }
        int dev = 0, cus = 0, per_cu = 0;
        if (hipGetDevice(&dev) != hipSuccess || hipDeviceGetAttribute(&cus, hipDeviceAttributeMultiprocessorCount, dev) != hipSuccess) { fprintf(stderr, "kernel_launch: device query failed\n"); grid = -1; return; }
        if (hipFuncSetAttribute((const void*)trunk_fwd, hipFuncAttributeMaxDynamicSharedMemorySize, LDS_BYTES) != hipSuccess) { fprintf(stderr, "kernel_launch: hipFuncSetAttribute failed\n"); grid = -1; return; }
        if (hipOccupancyMaxActiveBlocksPerMultiprocessor(&per_cu, (const void*)trunk_fwd, NTHR, LDS_BYTES) != hipSuccess || per_cu < 1) { fprintf(stderr, "kernel_launch: occupancy query reports %d workgroups per CU\n", per_cu); }
        (void)hipGetLastError();
        grid = cus;
        fprintf(stderr, "kernel_launch: grid %d, occupancy %d, ws %zu (need %zu)\n", grid, per_cu, ws_size, (size_t)WS_END);
    }
    if (grid < 0) return;
    if (hipMemsetAsync((char*)d_ws + WS_CTL, 0, CTL_ZERO_BYTES, stream) != hipSuccess) { fprintf(stderr, "kernel_launch: memset failed\n"); return; }
    Args a{};
    for (int i = 0; i < 29; ++i) a.in[i] = (const float*)d_in[i];
    a.out = (float*)d_out; a.ws = (unsigned char*)d_ws;
#if MK_PER_PHASE
    for (int p = 0; p < N_PHASES; ++p) { a.ph_lo = p; a.ph_hi = p + 1; hipLaunchKernelGGL(trunk_fwd, dim3(grid), dim3(NTHR), LDS_BYTES, stream, a); }
#else
    a.ph_lo = 0; a.ph_hi = N_PHASES;
    hipLaunchKernelGGL(trunk_fwd, dim3(grid), dim3(NTHR), LDS_BYTES, stream, a);
#endif
    const hipError_t le = hipPeekAtLastError();
    if (le != hipSuccess) fprintf(stderr, "kernel_launch: launch failed: %s\n", hipGetErrorName(le));
}
```

```cpp
#include <hip/hip_runtime.h>
#include <hip/hip_bf16.h>
#include <cstdio>
#include <cstdint>
__device__ __forceinline__ int opaque_tid() { int t; asm volatile("v_mov_b32 %0, %1" : "=v"(t) : "v"((int)threadIdx.x)); return t; }
namespace pg8 {
#define PG8_LAS __attribute__((address_space(3)))
typedef unsigned short bf16_t;
typedef short bf16x8 __attribute__((ext_vector_type(8)));
typedef float f32x4 __attribute__((ext_vector_type(4)));
typedef unsigned u32x4 __attribute__((ext_vector_type(4)));
constexpr int BM = 256, BK = 64, HALF = 128, HTB = HALF * BK * 2  , STAGE_BYTES = 8 * HTB, NXCD = 8, WGM = 8;

__host__ __device__ __forceinline__ int lds_byte(int r, int c) { const int st = (r >> 4) * 2 + (c >> 5), rr = r & 15, cc = c & 31, ob = rr * 64 + cc * 2; return st * 1024 + (ob ^ (((ob >> 9) & 1) << 5)); }
__host__ __device__ __forceinline__ void stage_rc(int b, int& R, int& C) { const int st = b / 1024, sb = b % 1024, swz = sb ^ (((sb >> 9) & 1) << 5); R = (st >> 1) * 16 + swz / 64; C = (st & 1) * 32 + (swz % 64) / 2; }
__host__ __device__ __forceinline__ int perm32(int rho) { const int n = rho >> 4, i = rho & 15; return 8 * (i >> 2) + 4 * n + (i & 3); }

struct Unit { int pm, pn; };
struct Gemm { const bf16_t* A; const bf16_t* Bt; int M, N, K, lda, ldb; };

struct StaticOrder {
    int nM, nN, nwg, G, c, wgm;
    __host__ __device__ void init(int M, int N, int G_, int c_, int wgm_ = WGM) { nM = M / BM; nN = N / BM; nwg = nM * nN; G = G_; c = c_; wgm = wgm_; }
    __host__ __device__ bool next(int i, Unit& u) const {
        const long L = (long)i * G + c; if (L >= nwg) return false;
        int wgid = (int)L; { const int q = nwg / NXCD, r = nwg % NXCD, xcd = wgid % NXCD, off = wgid / NXCD; wgid = (xcd < r ? xcd * (q + 1) : r * (q + 1) + (xcd - r) * q) + off; }
        const int nig = wgm * nN, gid = wgid / nig, fm = gid * wgm, gsz = (nM - fm) < wgm ? (nM - fm) : wgm;
        u.pm = fm + ((wgid % nig) % gsz); u.pn = (wgid % nig) / gsz; return true;
    }
    __device__ __forceinline__ void a_ready(const Unit&) const {}
    __device__ __forceinline__ void done(const Unit&) const {}
};

__device__ __forceinline__ unsigned cvt_pk_bf16(float lo, float hi) { unsigned r; asm volatile("v_cvt_pk_bf16_f32 %0, %1, %2" : "=v"(r) : "v"(lo), "v"(hi)); return r; }
__device__ __forceinline__ float fast_sigmoid(float x) { return __builtin_amdgcn_rcpf(1.0f + __builtin_amdgcn_exp2f(-1.4426950408889634f * x)); }

struct EpiHeadMajor {
    static constexpr bool PERM = true, AFTER_DRAIN = false;
    bf16_t* O; size_t gstride;
    __device__ __forceinline__ void operator()(const f32x4 (&acc)[2][2][4][2], const Unit& u, int wr, int wc, int fr, int fq) const {
        const int row0 = u.pm * BM + wr * 64 + fr, col0 = wc * 32 + 8 * fq;
#pragma unroll
        for (int ai = 0; ai < 2; ++ai)
#pragma unroll
            for (int m = 0; m < 4; ++m) { const size_t ro = (size_t)(row0 + ai * HALF + m * 16) * 128 + col0;
#pragma unroll
                for (int bj = 0; bj < 2; ++bj) { const f32x4 v0 = acc[ai][bj][m][0], v1 = acc[ai][bj][m][1];
                    u32x4 w; w.x = cvt_pk_bf16(v0[0], v0[1]); w.y = cvt_pk_bf16(v0[2], v0[3]); w.z = cvt_pk_bf16(v1[0], v1[1]); w.w = cvt_pk_bf16(v1[2], v1[3]);
                    *(u32x4*)(O + (size_t)(2 * u.pn + bj) * gstride + ro) = w; } }
    }
};
struct EpiResid {
    static constexpr bool PERM = false, AFTER_DRAIN = false;
    const float* base; float* out; const float* gate; int ldc;
    __device__ __forceinline__ void operator()(const f32x4 (&acc)[2][2][4][2], const Unit& u, int wr, int wc, int fr, int fq) const {
        const int row0 = u.pm * BM + wr * 64 + fr, col0 = u.pn * BM + wc * 32 + 4 * fq;
        f32x4 gv[2][2];
#pragma unroll
        for (int bj = 0; bj < 2; ++bj)
#pragma unroll
            for (int n = 0; n < 2; ++n) gv[bj][n] = *(const f32x4*)(gate + col0 + bj * HALF + n * 16);
#pragma unroll
        for (int ai = 0; ai < 2; ++ai) {
            f32x4 b[4][2][2];
#pragma unroll
            for (int m = 0; m < 4; ++m) { const size_t off = (size_t)(row0 + ai * HALF + m * 16) * ldc + col0;
#pragma unroll
                for (int bj = 0; bj < 2; ++bj)
#pragma unroll
                    for (int n = 0; n < 2; ++n) b[m][bj][n] = *(const f32x4*)(base + off + bj * HALF + n * 16); }
            asm volatile("" ::: "memory");
#pragma unroll
            for (int m = 0; m < 4; ++m) { const size_t off = (size_t)(row0 + ai * HALF + m * 16) * ldc + col0;
#pragma unroll
                for (int bj = 0; bj < 2; ++bj)
#pragma unroll
                    for (int n = 0; n < 2; ++n) *(f32x4*)(out + off + bj * HALF + n * 16) = b[m][bj][n] + gv[bj][n] * acc[ai][bj][m][n]; }
            asm volatile("" ::: "memory"); }
    }
};
struct EpiSwiGLU {
    static constexpr bool PERM = true, AFTER_DRAIN = false;
    bf16_t* O; int ldc;
    __device__ __forceinline__ void operator()(const f32x4 (&acc)[2][2][4][2], const Unit& u, int wr, int wc, int fr, int fq) const {
        const int row0 = u.pm * BM + wr * 64 + fr, col0 = u.pn * HALF + wc * 32 + 8 * fq;
#pragma unroll
        for (int ai = 0; ai < 2; ++ai)
#pragma unroll
            for (int m = 0; m < 4; ++m) { bf16_t* rowp = O + (size_t)(row0 + ai * HALF + m * 16) * ldc + col0;
                float r[8];
#pragma unroll
                for (int n = 0; n < 2; ++n)
#pragma unroll
                    for (int j = 0; j < 4; ++j) { const float g = acc[ai][0][m][n][j], up = acc[ai][1][m][n][j]; r[n * 4 + j] = g * fast_sigmoid(g) * up; }
                u32x4 w; w.x = cvt_pk_bf16(r[0], r[1]); w.y = cvt_pk_bf16(r[2], r[3]); w.z = cvt_pk_bf16(r[4], r[5]); w.w = cvt_pk_bf16(r[6], r[7]);
                *(u32x4*)rowp = w; }
    }
};
struct EpiGluResid {
    static constexpr bool PERM = false, AFTER_DRAIN = false;
    const float* base; float* out; const float* gate; int ldc;
    __device__ __forceinline__ void operator()(const f32x4 (&acc)[2][2][4][2], const Unit& u, int wr, int wc, int fr, int fq) const {
        const int row0 = u.pm * BM + wr * 64 + fr, col0 = u.pn * HALF + wc * 32 + 4 * fq;
        f32x4 gv[2];
#pragma unroll
        for (int n = 0; n < 2; ++n) gv[n] = *(const f32x4*)(gate + col0 + n * 16);
        f32x4 b[2][4][2];
#pragma unroll
        for (int ai = 0; ai < 2; ++ai)
#pragma unroll
            for (int m = 0; m < 4; ++m) { const size_t off = (size_t)(row0 + ai * HALF + m * 16) * ldc + col0;
#pragma unroll
                for (int n = 0; n < 2; ++n) b[ai][m][n] = *(const f32x4*)(base + off + n * 16); }
        asm volatile("" ::: "memory");
#pragma unroll
        for (int ai = 0; ai < 2; ++ai)
#pragma unroll
            for (int m = 0; m < 4; ++m) { const size_t off = (size_t)(row0 + ai * HALF + m * 16) * ldc + col0;
#pragma unroll
                for (int n = 0; n < 2; ++n) { const f32x4 a = acc[ai][0][m][n], sg = acc[ai][1][m][n]; f32x4 y;
#pragma unroll
                    for (int j = 0; j < 4; ++j) y[j] = a[j] * fast_sigmoid(sg[j]);
                    *(f32x4*)(out + off + n * 16) = b[ai][m][n] + gv[n] * y; } }
        asm volatile("" ::: "memory");
    }
};

template <class Epi, class Sched, bool ALIGN_EPI = false, bool SP2 = false>
__device__ __forceinline__ void gemm_phase(PG8_LAS unsigned char* lds, const Gemm g, const Sched& S, const Epi& E) {
    const int tid = opaque_tid(), wid = __builtin_amdgcn_readfirstlane(tid >> 6), lane = tid & 63, wr = wid >> 2, wc = wid & 3, fr = lane & 15, fq = lane >> 4;
    const int K = g.K, nt = K / BK;
    unsigned voffA[2], voffB[2];
#pragma unroll
    for (int i = 0; i < 2; ++i) { int R, C; stage_rc(tid * 16 + i * 8192, R, C); const int Rb = Epi::PERM ? ((R & ~31) + perm32(R & 31)) : R;
        voffA[i] = (unsigned)(R * g.lda + C) * 2u; voffB[i] = (unsigned)(Rb * g.ldb + C) * 2u; }
    const size_t kstep = (size_t)(BK * 2);
    const size_t hstepA = (size_t)HALF * g.lda * 2, hstepB = (size_t)HALF * g.ldb * 2;
    const size_t tstepA = 2 * hstepA, tstepB = 2 * hstepB;
    const unsigned ldsw = (unsigned)wid * 1024u;
    const int aoff = lds_byte(wr * 64 + fr, fq * 8), boff = lds_byte(wc * 32 + fr, fq * 8);
#define PG8_SA(b, h) (((b) * 2 + (h)) * HTB)
#define PG8_SB(b, h) ((4 + (b) * 2 + (h)) * HTB)
#define PG8_STAGE(bufoff, gbase, voff) do { _Pragma("unroll") for (int _i = 0; _i < 2; ++_i) \
        __builtin_amdgcn_global_load_lds((const unsigned*)((const char*)(gbase) + (voff)[_i]), (PG8_LAS unsigned*)(lds + (bufoff) + ldsw + _i * 8192), 16, 0, 0); } while (0)
#define PG8_LDA(dst, b, h) do { _Pragma("unroll") for (int m = 0; m < 4; ++m) _Pragma("unroll") for (int k = 0; k < 2; ++k) dst[m][k] = *(const PG8_LAS bf16x8*)(lds + PG8_SA(b, h) + aoff + m * 2048 + k * 1024); } while (0)
#define PG8_LDB(dst, b, h) do { _Pragma("unroll") for (int n = 0; n < 2; ++n) _Pragma("unroll") for (int k = 0; k < 2; ++k) dst[n][k] = *(const PG8_LAS bf16x8*)(lds + PG8_SB(b, h) + boff + n * 2048 + k * 1024); } while (0)
#define PG8_MMA(ai, bj, At, Bt) do { __builtin_amdgcn_s_setprio(3); _Pragma("unroll") for (int m = 0; m < 4; ++m) _Pragma("unroll") for (int n = 0; n < 2; ++n) _Pragma("unroll") for (int k = 0; k < 2; ++k) \
        acc[ai][bj][m][n] = __builtin_amdgcn_mfma_f32_16x16x32_bf16(Bt[n][k], At[m][k], acc[ai][bj][m][n], 0, 0, 0); __builtin_amdgcn_s_setprio(0); } while (0)
#define PG8_WAIT_V(n) asm volatile("s_waitcnt vmcnt(" #n ")" ::: "memory")
#define PG8_WAIT_L(n) asm volatile("s_waitcnt lgkmcnt(" #n ")" ::: "memory")
#define PG8_BAR __builtin_amdgcn_s_barrier()
#define PG8_SCHED __builtin_amdgcn_sched_barrier(0)
    Unit cur, nxt; int ui = 0;
    if (!S.next(0, cur)) return;
    f32x4 acc[2][2][4][2];
#pragma unroll
    for (int a = 0; a < 2; ++a)
#pragma unroll
        for (int b = 0; b < 2; ++b)
#pragma unroll
            for (int m = 0; m < 4; ++m)
#pragma unroll
                for (int n = 0; n < 2; ++n) acc[a][b][m][n] = (f32x4){0.f, 0.f, 0.f, 0.f};
    bf16x8 At[4][2], B0[2][2], B1[2][2];
    const char* cA = (const char*)g.A + (size_t)cur.pm * tstepA; const char* cB = (const char*)g.Bt + (size_t)cur.pn * tstepB;
    S.a_ready(cur);
    if constexpr (SP2) {
        PG8_STAGE(PG8_SB(0, 0), cB, voffB); PG8_STAGE(PG8_SB(0, 1), cB + hstepB, voffB); PG8_STAGE(PG8_SA(0, 0), cA, voffA); PG8_STAGE(PG8_SA(0, 1), cA + hstepA, voffA);
        if (wr == 1) PG8_BAR;
        PG8_WAIT_V(2); PG8_BAR;
        PG8_STAGE(PG8_SB(1, 0), cB + kstep, voffB); PG8_STAGE(PG8_SB(1, 1), cB + hstepB + kstep, voffB);
        PG8_WAIT_V(4); PG8_BAR;
    } else {
        PG8_STAGE(PG8_SB(0, 0), cB, voffB); PG8_STAGE(PG8_SA(0, 0), cA, voffA); PG8_STAGE(PG8_SB(0, 1), cB + hstepB, voffB); PG8_STAGE(PG8_SA(0, 1), cA + hstepA, voffA);
        if (wr == 1) PG8_BAR;
        PG8_WAIT_V(4); PG8_BAR;
        PG8_STAGE(PG8_SB(1, 0), cB + kstep, voffB); PG8_STAGE(PG8_SA(1, 0), cA + kstep, voffA); PG8_STAGE(PG8_SB(1, 1), cB + hstepB + kstep, voffB);
        PG8_WAIT_V(6); PG8_BAR;
    }
    for (;;) {
        const bool has_next = S.next(ui + 1, nxt);
        const char* nA = has_next ? (const char*)g.A + (size_t)nxt.pm * tstepA : cA; const char* nB = has_next ? (const char*)g.Bt + (size_t)nxt.pn * tstepB : cB;
        for (int t = 0; t < nt; t += 2) {
            const bool last = (t == nt - 2);
            const char* a1 = cA + (size_t)(t + 1) * kstep;
            const char* a2 = last ? nA : cA + (size_t)(t + 2) * kstep; const char* b2 = last ? nB : cB + (size_t)(t + 2) * kstep;
            const char* a3 = a2 + kstep; const char* b3 = b2 + kstep;
            if (last && has_next) S.a_ready(nxt);
            if constexpr (SP2) {
            PG8_LDB(B0, 0, 0); PG8_LDB(B1, 0, 1); PG8_SCHED; PG8_LDA(At, 0, 0); PG8_STAGE(PG8_SA(1, 0), a1, voffA); PG8_STAGE(PG8_SA(1, 1), a1 + hstepA, voffA);
            PG8_WAIT_V(8); PG8_WAIT_L(0); PG8_BAR; PG8_MMA(0, 0, At, B0); PG8_MMA(0, 1, At, B1); PG8_BAR; PG8_SCHED;
            PG8_LDA(At, 0, 1); PG8_STAGE(PG8_SB(0, 0), b2, voffB); PG8_STAGE(PG8_SB(0, 1), b2 + hstepB, voffB);
            PG8_WAIT_V(6); PG8_WAIT_L(0); PG8_BAR; PG8_MMA(1, 0, At, B0); PG8_MMA(1, 1, At, B1); PG8_BAR; PG8_SCHED;
            PG8_LDB(B0, 1, 0); PG8_LDB(B1, 1, 1); PG8_SCHED; PG8_LDA(At, 1, 0); PG8_STAGE(PG8_SA(0, 0), a2, voffA); PG8_STAGE(PG8_SA(0, 1), a2 + hstepA, voffA);
            PG8_WAIT_V(8); PG8_WAIT_L(0); PG8_BAR; PG8_MMA(0, 0, At, B0); PG8_MMA(0, 1, At, B1); PG8_BAR; PG8_SCHED;
            PG8_LDA(At, 1, 1); PG8_STAGE(PG8_SB(1, 0), b3, voffB); PG8_STAGE(PG8_SB(1, 1), b3 + hstepB, voffB);
            PG8_WAIT_V(6); PG8_WAIT_L(0); PG8_BAR; PG8_MMA(1, 0, At, B0); PG8_MMA(1, 1, At, B1); PG8_BAR; PG8_SCHED;
            } else {
            PG8_LDB(B0, 0, 0); PG8_SCHED; PG8_LDA(At, 0, 0); PG8_STAGE(PG8_SA(1, 1), a1 + hstepA, voffA);
            PG8_WAIT_L(8); PG8_BAR; PG8_WAIT_L(0); PG8_MMA(0, 0, At, B0); PG8_BAR; PG8_SCHED;
            PG8_LDB(B1, 0, 1); PG8_STAGE(PG8_SB(0, 0), b2, voffB);
            PG8_BAR; PG8_WAIT_L(0); PG8_MMA(0, 1, At, B1); PG8_BAR;
            PG8_LDA(At, 0, 1); PG8_STAGE(PG8_SA(0, 0), a2, voffA);
            PG8_BAR; PG8_WAIT_L(0); PG8_MMA(1, 0, At, B0); PG8_BAR; PG8_SCHED;
            PG8_STAGE(PG8_SB(0, 1), b2 + hstepB, voffB);
            PG8_WAIT_V(6); PG8_BAR; PG8_MMA(1, 1, At, B1); PG8_BAR;
            PG8_LDB(B0, 1, 0); PG8_SCHED; PG8_LDA(At, 1, 0); PG8_STAGE(PG8_SA(0, 1), a2 + hstepA, voffA);
            PG8_WAIT_L(8); PG8_BAR; PG8_WAIT_L(0); PG8_MMA(0, 0, At, B0); PG8_BAR; PG8_SCHED;
            PG8_LDB(B1, 1, 1); PG8_STAGE(PG8_SB(1, 0), b3, voffB);
            PG8_BAR; PG8_WAIT_L(0); PG8_MMA(0, 1, At, B1); PG8_BAR;
            PG8_LDA(At, 1, 1); PG8_STAGE(PG8_SA(1, 0), a3, voffA);
            PG8_BAR; PG8_WAIT_L(0); PG8_MMA(1, 0, At, B0); PG8_BAR; PG8_SCHED;
            PG8_STAGE(PG8_SB(1, 1), b3 + hstepB, voffB);
            PG8_WAIT_V(6); PG8_BAR; PG8_MMA(1, 1, At, B1); PG8_BAR;
            }
        }
        if constexpr (ALIGN_EPI) { if (wr == 0) PG8_BAR; }
        if constexpr (!Epi::AFTER_DRAIN) { E(acc, cur, wr, wc, fr, fq); S.done(cur); }
        if (!has_next) break;
#pragma unroll
        for (int a = 0; a < 2; ++a)
#pragma unroll
            for (int b = 0; b < 2; ++b)
#pragma unroll
                for (int m = 0; m < 4; ++m)
#pragma unroll
                    for (int n = 0; n < 2; ++n) acc[a][b][m][n] = (f32x4){0.f, 0.f, 0.f, 0.f};
        cur = nxt; cA = nA; cB = nB; ++ui;
        if constexpr (ALIGN_EPI) { if (wr == 1) PG8_BAR; }
    }
    PG8_WAIT_V(0);
    if constexpr (!ALIGN_EPI) { if (wr == 0) PG8_BAR; }
    PG8_BAR;
    if constexpr (Epi::AFTER_DRAIN) { E.fused(acc, cur, wr, wc, fr, fq, lds, wid, lane); S.done(cur); }
#undef PG8_SA
#undef PG8_SB
#undef PG8_STAGE
#undef PG8_LDA
#undef PG8_LDB
#undef PG8_MMA
#undef PG8_WAIT_V
#undef PG8_WAIT_L
#undef PG8_BAR
#undef PG8_SCHED
}
}

namespace att {
constexpr int D = 128;
constexpr float THR = 8.f;
constexpr bool WSKIP = false;
constexpr float SCALE = 0.08838834764831845f;
constexpr int NW = 8, QBLK = 32, KVBLK = 64, QB = NW * QBLK;
constexpr int SHM_V = KVBLK * D * 2, SHM_K = KVBLK * D * 2;
constexpr int LDS_BYTES = 2 * SHM_V + 2 * SHM_K + NW * 64 * 4;

using bf16 = __hip_bfloat16;
typedef short bf16x8 __attribute__((ext_vector_type(8)));
typedef short s16x4 __attribute__((ext_vector_type(4)));
typedef float f32x16 __attribute__((ext_vector_type(16)));
typedef float f32x4 __attribute__((ext_vector_type(4)));
typedef unsigned u32x4 __attribute__((ext_vector_type(4)));
template <class A, class Bt> struct same_t { static constexpr bool v = false; };
template <class A> struct same_t<A, A> { static constexpr bool v = true; };

#define KSWZ(row, colB) ((row) * 256 + ((colB) ^ (((row) & 7) << 4)))
#define SBAR() __builtin_amdgcn_sched_barrier(0)
__device__ __forceinline__ int v_st(int k, int c) { const int kk = (k & ~0xC) | ((k & 4) << 1) | ((k & 8) >> 1); return ((kk >> 3) * 4 + (c >> 5)) * 512 + ((kk & 7) * 32 + (c & 31)) * 2; }
__device__ __forceinline__ int v_rd_base(int lane) { return ((lane & 3) << 3) | (((lane >> 2) & 3) << 6) | (((lane >> 4) & 1) << 5) | (((lane >> 5) & 1) << 8); }
constexpr int v_rd_off(int d0, int ks, int half) { return d0 * 512 + ks * 4096 + half * 2048; }
__device__ __forceinline__ int crow(int r, int hi) { return (r & 3) + 8 * (r >> 2) + 4 * hi; }
__device__ __forceinline__ unsigned cvtpk(float lo, float hi) {
    unsigned r; asm volatile("v_cvt_pk_bf16_f32 %0, %1, %2" : "=v"(r) : "v"(lo), "v"(hi)); return r;
}
__device__ __forceinline__ bf16x8 pack8(f32x4 a, f32x4 b) {
    u32x4 w = {cvtpk(a[0], a[1]), cvtpk(a[2], a[3]), cvtpk(b[0], b[1]), cvtpk(b[2], b[3])};
    return *reinterpret_cast<bf16x8*>(&w);
}
template <class T> __device__ __forceinline__ bf16x8 load8(const T* p) {
    if constexpr (same_t<T, float>::v) { return pack8(*(const f32x4*)p, *(const f32x4*)(p + 4)); }
    else { return *reinterpret_cast<const bf16x8*>(p); }
}
__device__ __forceinline__ void mask_tile(f32x16& p0, f32x16& p1, int dq, unsigned W) {
    const float NEG = -__builtin_inff();
#pragma unroll
    for (int r = 0; r < 16; ++r) {
        const int c = (r & 3) + 8 * (r >> 2);
        if ((unsigned)(dq - c) >= W) p0[r] = NEG;
        if ((unsigned)(dq - c - 32) >= W) p1[r] = NEG;
    }
}
__device__ __forceinline__ void partialSM(f32x16& p0, f32x16& p1, float& m_reg, float& mn, float& alpha) {
    float pmax = p0[0]; for (int r = 1; r < 16; ++r) pmax = fmaxf(pmax, p0[r]); for (int r = 0; r < 16; ++r) pmax = fmaxf(pmax, p1[r]);
    { auto rr = __builtin_amdgcn_permlane32_swap(__float_as_uint(pmax), __float_as_uint(pmax), false, false);
      pmax = fmaxf(__uint_as_float(rr[0]), __uint_as_float(rr[1])); }
    constexpr float C2 = 1.4426950408889634f * SCALE;
    if (__builtin_expect(__all((pmax - m_reg) * SCALE <= THR), 1)) { mn = m_reg; alpha = 1.f; }
    else { mn = fmaxf(m_reg, pmax); alpha = __builtin_amdgcn_exp2f((m_reg - mn) * C2); m_reg = mn; }
    const float mnL = -mn * C2;
    for (int r = 0; r < 16; ++r) p0[r] = fmaf(p0[r], C2, mnL); for (int r = 0; r < 16; ++r) p1[r] = fmaf(p1[r], C2, mnL);
    for (int r = 0; r < 16; ++r) p0[r] = __builtin_amdgcn_exp2f(p0[r]);
}
__device__ __forceinline__ void finishSM(f32x16& p0, f32x16& p1, float alpha, float& l_reg, bf16x8& pa0, bf16x8& pa1, bf16x8& pa2, bf16x8& pa3) {
    for (int r = 0; r < 16; ++r) p1[r] = __builtin_amdgcn_exp2f(p1[r]);
    float ps = 0; for (int r = 0; r < 16; ++r) ps += p0[r]; for (int r = 0; r < 16; ++r) ps += p1[r];
    { auto rr = __builtin_amdgcn_permlane32_swap(__float_as_uint(ps), __float_as_uint(ps), false, false);
      ps = __uint_as_float(rr[0]) + __uint_as_float(rr[1]); }
    l_reg = l_reg * alpha + ps;
#define PK4(P, B_, OUT) do { unsigned a0 = cvtpk(P[B_+0], P[B_+1]), a1 = cvtpk(P[B_+2], P[B_+3]);                          \
        unsigned b0 = cvtpk(P[B_+4], P[B_+5]), b1 = cvtpk(P[B_+6], P[B_+7]);                                             \
        auto r0 = __builtin_amdgcn_permlane32_swap(a0, b0, false, false); auto r1 = __builtin_amdgcn_permlane32_swap(a1, b1, false, false); \
        u32x4 w = {r0[0], r1[0], r0[1], r1[1]}; OUT = *reinterpret_cast<bf16x8*>(&w); } while (0)
    PK4(p0, 0, pa0); PK4(p0, 8, pa1); PK4(p1, 0, pa2); PK4(p1, 8, pa3);
#undef PK4
}
template <int KB, bool SK>
__device__ __forceinline__ void qkt(f32x16& p0, f32x16& p1, const char* K_lds, int r32, int hi, const bf16x8* qr, bool act) {
    if (SK && !act) { const float NEG = -__builtin_inff();
#pragma unroll
        for (int r = 0; r < 16; ++r) { p0[r] = NEG; p1[r] = NEG; } return; }
    p0 = f32x16{}; p1 = f32x16{};
    const char* kb[4];
#pragma unroll
    for (int dd = 0; dd < 4; ++dd) kb[dd] = K_lds + KB * SHM_K + KSWZ(r32, (dd * 16 + hi * 8) * 2);
#pragma unroll
    for (int d0 = 0; d0 < 8; ++d0) { const char* a = kb[d0 & 3] + (d0 >> 2) * 128;
        bf16x8 b0 = *reinterpret_cast<const bf16x8*>(a);
        bf16x8 b1 = *reinterpret_cast<const bf16x8*>(a + 32 * 256);
        p0 = __builtin_amdgcn_mfma_f32_32x32x16_bf16(b0, qr[d0], p0, 0, 0, 0);
        p1 = __builtin_amdgcn_mfma_f32_32x32x16_bf16(b1, qr[d0], p1, 0, 0, 0); }
}
template <int VB, bool SK>
__device__ __forceinline__ void pv_tile(f32x16* o, int vb0, bf16x8 pa0, bf16x8 pa1, bf16x8 pa2, bf16x8 pa3, bool act) {
    if (SK && !act) return;
#define TRRD(dst, off) asm volatile("ds_read_b64_tr_b16 %0, %1 offset:%2" : "=&v"(dst) : "v"(vb0), "i"(off) : "memory")
#define PV_D0(d0) do { s16x4 l0, l1, l2, l3, h0, h1, h2, h3; constexpr int b_ = VB * SHM_V + v_rd_off(d0, 0, 0);     \
        TRRD(l0, b_); TRRD(h0, b_ + 2048); TRRD(l1, b_ + 4096); TRRD(h1, b_ + 6144); TRRD(l2, b_ + 8192); TRRD(h2, b_ + 10240); TRRD(l3, b_ + 12288); TRRD(h3, b_ + 14336); \
        asm volatile("s_waitcnt lgkmcnt(0)" ::: "memory"); SBAR();                 \
        o[d0] = __builtin_amdgcn_mfma_f32_32x32x16_bf16(pa0, (bf16x8){l0[0], l0[1], l0[2], l0[3], h0[0], h0[1], h0[2], h0[3]}, o[d0], 0, 0, 0);   \
        o[d0] = __builtin_amdgcn_mfma_f32_32x32x16_bf16(pa1, (bf16x8){l1[0], l1[1], l1[2], l1[3], h1[0], h1[1], h1[2], h1[3]}, o[d0], 0, 0, 0);   \
        o[d0] = __builtin_amdgcn_mfma_f32_32x32x16_bf16(pa2, (bf16x8){l2[0], l2[1], l2[2], l2[3], h2[0], h2[1], h2[2], h2[3]}, o[d0], 0, 0, 0);   \
        o[d0] = __builtin_amdgcn_mfma_f32_32x32x16_bf16(pa3, (bf16x8){l3[0], l3[1], l3[2], l3[3], h3[0], h3[1], h3[2], h3[3]}, o[d0], 0, 0, 0); } while (0)
    PV_D0(0); PV_D0(1); PV_D0(2); PV_D0(3);
#undef PV_D0
#undef TRRD
}

template <class TIn, class TOut> struct BlockRef { const TIn* Q; const TIn* K; const TIn* V; TOut* O; int P0; };
template <class TIn> struct Seam {
    bf16x8 qr[8];
    bf16x8 st_v0, st_v1, st_k0, st_k1; f32x4 sf0, sf1, sf2, sf3;
    f32x4 tq[16];
};
__device__ __forceinline__ int swa_jlo(int P0, int W) { const int lowk = P0 - W + 1; return lowk > 0 ? lowk / KVBLK : 0; }
#define ROW(p, k0, rr) ((p) + (size_t)((k0) + (rr)) * D + sc)
#define VMW() asm volatile("s_waitcnt vmcnt(0)" ::: "memory")
#define VMWN(n) asm volatile("s_waitcnt vmcnt(%0)" :: "i"(n) : "memory")
#define SLOAD_H(Kp, Vp, k0) do { S.st_v0 = load8<TIn>(ROW(Vp, k0, sr)); S.st_v1 = load8<TIn>(ROW(Vp, k0, 32 + sr));              \
                         S.st_k0 = load8<TIn>(ROW(Kp, k0, sr)); S.st_k1 = load8<TIn>(ROW(Kp, k0, 32 + sr)); } while (0)
#define SWRITE_HK(bf) do { *(bf16x8*)(K_lds + (bf) * SHM_K + kws) = S.st_k0; *(bf16x8*)(K_lds + (bf) * SHM_K + kws + 32 * 256) = S.st_k1; } while (0)
#define SWRITE_HV(bf) do { *(bf16x8*)(V_lds + (bf) * SHM_V + vst0) = S.st_v0; *(bf16x8*)(V_lds + (bf) * SHM_V + vst1) = S.st_v1; } while (0)
#define SWRITE_H(bf) do { SWRITE_HV(bf); SWRITE_HK(bf); } while (0)
#define SLOAD_F(p, k0) do { S.sf0 = *(const f32x4*)ROW(p, k0, sr); S.sf1 = *(const f32x4*)(ROW(p, k0, sr) + 4);                \
                            S.sf2 = *(const f32x4*)ROW(p, k0, 32 + sr); S.sf3 = *(const f32x4*)(ROW(p, k0, 32 + sr) + 4); } while (0)
#define SWRITE_KF(bf) do { *(bf16x8*)(K_lds + (bf) * SHM_K + kws) = pack8(S.sf0, S.sf1); *(bf16x8*)(K_lds + (bf) * SHM_K + kws + 32 * 256) = pack8(S.sf2, S.sf3); } while (0)
#define SWRITE_VF(bf) do { *(bf16x8*)(V_lds + (bf) * SHM_V + vst0) = pack8(S.sf0, S.sf1); *(bf16x8*)(V_lds + (bf) * SHM_V + vst1) = pack8(S.sf2, S.sf3); } while (0)
template <class TIn, class TOut>
__device__ __forceinline__ void causal_swa_prime(const BlockRef<TIn, TOut>& cur, int W, char* lds, Seam<TIn>& S) {
    constexpr bool F32 = same_t<TIn, float>::v;
    const int tid = opaque_tid(), wid = __builtin_amdgcn_readfirstlane(tid >> 6), lane = tid & 63, r32 = lane & 31, hi = lane >> 5;
    const int sr = tid >> 4, sc = (tid & 15) * 8, kws = KSWZ(sr, sc * 2); char* K_lds = lds + 2 * SHM_V;
    const int kb0 = swa_jlo(cur.P0, W) * KVBLK;
    for (int d0 = 0; d0 < 8; ++d0) S.qr[d0] = load8<TIn>(cur.Q + (size_t)(wid * QBLK + r32) * D + d0 * 16 + hi * 8);
    if constexpr (F32) { SLOAD_F((const float*)cur.K, kb0); VMW(); SWRITE_KF(0); SBAR(); SLOAD_F((const float*)cur.V, kb0); }
    else { SLOAD_H(cur.K, cur.V, kb0); VMW(); SWRITE_HK(0); }
    __syncthreads();
}
template <class TIn, class TOut>
__device__ __forceinline__ void causal_swa_block(const BlockRef<TIn, TOut>& cur, const BlockRef<TIn, TOut>& nxt, int skv, int W, char* lds, Seam<TIn>& S) {
    constexpr bool F32 = same_t<TIn, float>::v;
    const int tid = opaque_tid(), wid = __builtin_amdgcn_readfirstlane(tid >> 6), lane = tid & 63, r32 = lane & 31, hi = lane >> 5;
    const int j_lo = swa_jlo(cur.P0, W);
    int j_hi = (cur.P0 + QB - 1) / KVBLK + 1; if (j_hi > skv / KVBLK) j_hi = skv / KVBLK;
    const int NT = j_hi - j_lo;
    const int kbn = swa_jlo(nxt.P0, W) * KVBLK;
    const int qlo = cur.P0 + wid * QBLK, qm = qlo + r32 - 4 * hi;
    char* V_lds = lds; char* K_lds = lds + 2 * SHM_V;
    float* ws = (float*)(lds + 2 * SHM_V + 2 * SHM_K) + wid * 64; float* li_l = ws, * al_l = ws + 32;
    float m_reg = -1e30f, l_reg = 0; f32x16 o[4] = {};
    const int sr = tid >> 4, sc = (tid & 15) * 8, vst0 = v_st(sr, sc), vst1 = v_st(32 + sr, sc), kws = KSWZ(sr, sc * 2);
    const int vb0 = (int)(uintptr_t)V_lds + v_rd_base(lane);
    const TIn* Kh = cur.K; const TIn* Vh = cur.V;
#define RESC(a) do { if (__any((a) < 1.f)) { if (hi == 0) al_l[r32] = (a); asm volatile("s_waitcnt lgkmcnt(0)" ::: "memory");              \
                     for (int d_ = 0; d_ < 4; ++d_) for (int r = 0; r < 16; ++r) o[d_][r] *= al_l[crow(r, hi)]; } } while (0)
#define KBASE(t) ((j_lo + (t)) * KVBLK)
#define ACT(t) (KBASE(t) <= qlo + QBLK - 1 && KBASE(t) + KVBLK - 1 >= qlo - W + 1)
#define MASKT(P0_, P1_, t) do { const int kb_ = KBASE(t); if ((!SK || ACT(t)) && (kb_ + KVBLK - 1 > qlo || kb_ <= qlo + QBLK - 1 - W)) mask_tile(P0_, P1_, qm - kb_, (unsigned)W); } while (0)
    constexpr int NQL = F32 ? 16 : 8;
    constexpr bool SK = WSKIP && !F32;
#define SEAM_K0() do { VMWN(NQL); if constexpr (F32) { SWRITE_KF(0); SBAR(); SLOAD_F((const float*)nxt.V, kbn); } else { SWRITE_HK(0); } SBAR(); } while (0)
    f32x16 pA0, pA1, pB0, pB1; float mnA, mnB, alA, alB; bf16x8 pa0, pa1, pa2, pa3;
    if constexpr (F32) { VMW(); SWRITE_VF(0); SBAR(); } else { SWRITE_HV(0); SBAR(); }
    if (NT > 1) { if constexpr (F32) SLOAD_F((const float*)Kh, KBASE(1)); else SLOAD_H(Kh, Vh, KBASE(1)); }
    SBAR(); qkt<0, SK>(pA0, pA1, K_lds, r32, hi, S.qr, ACT(0));
    if constexpr (F32) { if (NT > 1) { VMW(); SWRITE_KF(1); SBAR(); SLOAD_F((const float*)Vh, KBASE(1)); } }
    MASKT(pA0, pA1, 0); partialSM(pA0, pA1, m_reg, mnA, alA);
    if (NT > 1) { VMW(); if constexpr (F32) { SWRITE_VF(1); SBAR(); if (NT > 2) SLOAD_F((const float*)Kh, KBASE(2)); } else SWRITE_H(1); }
    __syncthreads();
#define HALF_STEP(PX0, PX1, mnX, alX, PY0, PY1, alY, t, KB, VB, SB) do {                                                      \
        SBAR(); qkt<KB, SK>(PX0, PX1, K_lds, r32, hi, S.qr, ACT(t));                                             \
        finishSM(PY0, PY1, alY, l_reg, pa0, pa1, pa2, pa3); SBAR();                                                           \
        if ((t) + 1 < NT) { if constexpr (F32) { VMW(); SWRITE_KF(SB); SBAR(); SLOAD_F((const float*)Vh, KBASE((t) + 1)); }  \
                            else { SLOAD_H(Kh, Vh, KBASE((t) + 1)); } SBAR(); }                                               \
        pv_tile<VB, SK>(o, vb0, pa0, pa1, pa2, pa3, ACT((t) - 1)); MASKT(PX0, PX1, (t)); partialSM(PX0, PX1, m_reg, mnX, alX);                                        \
        __syncthreads();                                                                                                      \
        if ((t) + 1 < NT) { VMW(); if constexpr (F32) { SWRITE_VF(SB); SBAR(); if ((t) + 2 < NT) SLOAD_F((const float*)Kh, KBASE((t) + 2)); } \
                            else { SWRITE_H(SB); } }                                                                          \
        RESC(alX); __syncthreads(); } while (0)
    for (int t = 1; t + 1 < NT; t += 2) {
        HALF_STEP(pB0, pB1, mnB, alB, pA0, pA1, alA, t, 1, 0, 0);
        HALF_STEP(pA0, pA1, mnA, alA, pB0, pB1, alB, t + 1, 0, 1, 1);
    }
    const bool even = (NT & 1) == 0;
    if (even) { SBAR(); qkt<1, SK>(pB0, pB1, K_lds, r32, hi, S.qr, ACT(NT - 1)); SBAR(); }
#define QROW(e) (nxt.Q + (size_t)(wid * QBLK + r32) * D + ((e) >> 1) * 16 + hi * 8 + ((e) & 1) * 4)
    if constexpr (F32) { SLOAD_F((const float*)nxt.K, kbn); SBAR();
#pragma unroll
        for (int e = 0; e < 8; ++e) S.tq[e] = *(const f32x4*)QROW(e); }
    else { SLOAD_H(nxt.K, nxt.V, kbn); SBAR();
#pragma unroll
        for (int d0 = 0; d0 < 8; ++d0) S.qr[d0] = load8<TIn>(nxt.Q + (size_t)(wid * QBLK + r32) * D + d0 * 16 + hi * 8); }
    SBAR();
    finishSM(pA0, pA1, alA, l_reg, pa0, pa1, pa2, pa3); SBAR();
    if constexpr (F32) {
#pragma unroll
        for (int e = 8; e < 16; ++e) S.tq[e] = *(const f32x4*)QROW(e); SBAR(); }
#undef QROW
    pv_tile<0, SK>(o, vb0, pa0, pa1, pa2, pa3, ACT(even ? NT - 2 : NT - 1));
    if (even) { MASKT(pB0, pB1, NT - 1); partialSM(pB0, pB1, m_reg, mnB, alB); __syncthreads(); RESC(alB);
        finishSM(pB0, pB1, alB, l_reg, pa0, pa1, pa2, pa3); SBAR(); pv_tile<1, SK>(o, vb0, pa0, pa1, pa2, pa3, ACT(NT - 1)); }
    SBAR(); SEAM_K0();
    if (hi == 0) li_l[r32] = l_reg; asm volatile("s_waitcnt lgkmcnt(0)" ::: "memory");
    float rli[16];
#pragma unroll
    for (int r = 0; r < 16; ++r) rli[r] = __builtin_amdgcn_rcpf(li_l[crow(r, hi)]);
    TOut* Ow = cur.O + (size_t)(wid * QBLK) * D;
#pragma unroll
    for (int r = 0; r < 16; ++r) { const int orow = crow(r, hi);
#pragma unroll
        for (int d0 = 0; d0 < 4; ++d0) { const float v = o[d0][r] * rli[r];
            if constexpr (same_t<TOut, float>::v) { Ow[(size_t)orow * D + d0 * 32 + r32] = v; }
            else { const float vn = __shfl_xor(v, 1);
                   if ((r32 & 1) == 0) *(unsigned*)(Ow + (size_t)orow * D + d0 * 32 + r32) = cvtpk(v, vn); } } }
    if constexpr (F32) {
#pragma unroll
        for (int d0 = 0; d0 < 8; ++d0) S.qr[d0] = pack8(S.tq[2 * d0], S.tq[2 * d0 + 1]); }
    __syncthreads();
#undef RESC
#undef KBASE
#undef ACT
#undef MASKT
#undef SEAM_K0
#undef HALF_STEP
}
#undef ROW
#undef VMW
#undef VMWN
#undef SLOAD_H
#undef SWRITE_HK
#undef SWRITE_HV
#undef SWRITE_H
#undef SLOAD_F
#undef SWRITE_KF
#undef SWRITE_VF
#undef KSWZ
#undef SBAR
}

namespace att2 {
typedef short bf16x8 __attribute__((ext_vector_type(8)));
typedef short s16x4 __attribute__((ext_vector_type(4)));
typedef float f32x16 __attribute__((ext_vector_type(16)));
typedef unsigned u32x4 __attribute__((ext_vector_type(4)));
constexpr float SCALE = 0.08838834764831845f, THR = 8.f, C2 = 1.4426950408889634f * SCALE;
constexpr int V_OFF = 0, K_OFF = 65536, PX_OFF = 98304, MX_OFF = 114688, WS_OFF = 118784, LDS_NEED = 120832;
#define A2_KSWZ(row, colB) ((row) * 256 + ((colB) ^ (((row) & 7) << 4)))
#define A2_SBAR() __builtin_amdgcn_sched_barrier(0)
template <int KB>
__device__ __forceinline__ void qkt(f32x16& p, const char* Kl, int krow, int hi, const bf16x8* qr) {
    p = f32x16{};
    const char* kbp[4];
#pragma unroll
    for (int dd = 0; dd < 4; ++dd) kbp[dd] = Kl + KB * 16384 + A2_KSWZ(krow, (dd * 16 + hi * 8) * 2);
    bf16x8 b[8];
#pragma unroll
    for (int d0 = 0; d0 < 8; ++d0) b[d0] = *reinterpret_cast<const bf16x8*>(kbp[d0 & 3] + (d0 >> 2) * 128);
    __builtin_amdgcn_s_setprio(3);
#pragma unroll
    for (int d0 = 0; d0 < 8; ++d0) p = __builtin_amdgcn_mfma_f32_32x32x16_bf16(b[d0], qr[d0], p, 0, 0, 0);
    __builtin_amdgcn_s_setprio(0);
}
template <int VOFFB>
__device__ __forceinline__ void pv(f32x16* o, int vb0, bf16x8 pa0, bf16x8 pa1, bf16x8 pa2, bf16x8 pa3) {
#define A2_TRRD(dst, off) asm volatile("ds_read_b64_tr_b16 %0, %1 offset:%2" : "=&v"(dst) : "v"(vb0), "i"(off) : "memory")
#define A2_PV_D0(d0) do { s16x4 l0, l1, l2, l3, h0, h1, h2, h3; constexpr int b_ = VOFFB + att::v_rd_off(d0, 0, 0); \
        A2_TRRD(l0, b_); A2_TRRD(h0, b_ + 2048); A2_TRRD(l1, b_ + 4096); A2_TRRD(h1, b_ + 6144); A2_TRRD(l2, b_ + 8192); A2_TRRD(h2, b_ + 10240); A2_TRRD(l3, b_ + 12288); A2_TRRD(h3, b_ + 14336); \
        asm volatile("s_waitcnt lgkmcnt(0)" ::: "memory"); A2_SBAR(); \
        o[d0] = __builtin_amdgcn_mfma_f32_32x32x16_bf16(pa0, (bf16x8){l0[0], l0[1], l0[2], l0[3], h0[0], h0[1], h0[2], h0[3]}, o[d0], 0, 0, 0); \
        o[d0] = __builtin_amdgcn_mfma_f32_32x32x16_bf16(pa1, (bf16x8){l1[0], l1[1], l1[2], l1[3], h1[0], h1[1], h1[2], h1[3]}, o[d0], 0, 0, 0); \
        o[d0] = __builtin_amdgcn_mfma_f32_32x32x16_bf16(pa2, (bf16x8){l2[0], l2[1], l2[2], l2[3], h2[0], h2[1], h2[2], h2[3]}, o[d0], 0, 0, 0); \
        o[d0] = __builtin_amdgcn_mfma_f32_32x32x16_bf16(pa3, (bf16x8){l3[0], l3[1], l3[2], l3[3], h3[0], h3[1], h3[2], h3[3]}, o[d0], 0, 0, 0); } while (0)
    __builtin_amdgcn_s_setprio(3); A2_PV_D0(0); A2_PV_D0(1); A2_PV_D0(2); A2_PV_D0(3); __builtin_amdgcn_s_setprio(0);
#undef A2_PV_D0
#undef A2_TRRD
}
__device__ __forceinline__ float rowmax16(const f32x16& p) {
    float pm = p[0];
#pragma unroll
    for (int r = 1; r < 16; ++r) pm = fmaxf(pm, p[r]);
    auto rr = __builtin_amdgcn_permlane32_swap(__float_as_uint(pm), __float_as_uint(pm), false, false);
    return fmaxf(__uint_as_float(rr[0]), __uint_as_float(rr[1]));
}
template <bool DEG>
__device__ __forceinline__ void block(const unsigned short* Q, const unsigned short* K, const unsigned short* V0, const unsigned short* V1, float* O0, float* O1, int P0, char* lds) {
    const int tid = opaque_tid(), wid = __builtin_amdgcn_readfirstlane(tid >> 6), lane = tid & 63, r32 = lane & 31, hi = lane >> 5, rg = wid >> 1, kh = wid & 1, hf = wid >> 2;
    const int NT = P0 / 64 + 2, qlo = P0 + 32 * rg;
    const int sr = tid >> 4, sc = (tid & 15) * 8, kws = A2_KSWZ(sr, sc * 2), vst0 = att::v_st(sr, sc), vst1 = att::v_st(32 + sr, sc);
    char* Vl = lds + V_OFF; char* Kl = lds + K_OFF;
    const int vb0 = (int)(uintptr_t)Vl + att::v_rd_base(lane) + kh * 16384, krow = 32 * kh + r32;
    float* wsl = (float*)(lds + WS_OFF) + wid * 64; float* al_l = wsl; float* li_l = wsl + 32;
    const float* li_p = (const float*)(lds + WS_OFF) + (wid ^ 1) * 64 + 32;
    float* mxw = (float*)(lds + MX_OFF) + wid * 64 + lane; const float* mxr = (const float*)(lds + MX_OFF) + (wid ^ 1) * 64 + lane;
    char* pxw = lds + PX_OFF + ((rg * 4 + 2 * kh) * 64 + lane) * 16; const char* pxr = lds + PX_OFF + (rg * 4 * 64 + lane) * 16;
    bf16x8 qr[8];
#pragma unroll
    for (int d0 = 0; d0 < 8; ++d0) qr[d0] = *reinterpret_cast<const bf16x8*>(Q + (size_t)(32 * rg + r32) * 128 + d0 * 16 + hi * 8);
    bf16x8 sk0, sk1, sv0, sv1, sv2, sv3;
#define A2_LOADK(t) do { const size_t o0_ = (size_t)((DEG ? 0 : (t)) * 64 + sr) * 128 + sc, o1_ = o0_ + 32 * 128; sk0 = *reinterpret_cast<const bf16x8*>(K + o0_); sk1 = *reinterpret_cast<const bf16x8*>(K + o1_); } while (0)
#define A2_LOADV(t) do { const size_t o0_ = (size_t)((DEG ? 0 : (t)) * 64 + sr) * 128 + sc, o1_ = o0_ + 32 * 128; \
        sv0 = *reinterpret_cast<const bf16x8*>(V0 + o0_); sv1 = *reinterpret_cast<const bf16x8*>(V0 + o1_); sv2 = *reinterpret_cast<const bf16x8*>(V1 + o0_); sv3 = *reinterpret_cast<const bf16x8*>(V1 + o1_); } while (0)
#define A2_BAR() do { asm volatile("s_waitcnt lgkmcnt(0)" ::: "memory"); __builtin_amdgcn_s_barrier(); asm volatile("" ::: "memory"); } while (0)
#define A2_WRITEK(b) do { *(bf16x8*)(Kl + (b) * 16384 + kws) = sk0; *(bf16x8*)(Kl + (b) * 16384 + kws + 32 * 256) = sk1; } while (0)
#define A2_WRITEV(b) do { *(bf16x8*)(Vl + (b) * 32768 + vst0) = sv0; *(bf16x8*)(Vl + (b) * 32768 + vst1) = sv1; *(bf16x8*)(Vl + (b) * 32768 + 16384 + vst0) = sv2; *(bf16x8*)(Vl + (b) * 32768 + 16384 + vst1) = sv3; } while (0)
#define A2_VMW(n) asm volatile("s_waitcnt vmcnt(%0)" :: "i"(n) : "memory")
#define A2_MASKMAX(PX, pmX, t) do { const int kb_ = (t) * 64 + 32 * kh; \
        if (__builtin_expect(kb_ + 31 > qlo, 0)) { asm volatile("; diagonal tile: mask" ::: "memory");     \
            const int dq_ = qlo + r32 - kb_ - 4 * hi; const float NEG_ = -__builtin_inff(); \
            _Pragma("unroll") for (int r = 0; r < 16; ++r) { const int c_ = (r & 3) + 8 * (r >> 2); if (dq_ - c_ < 0) PX[r] = NEG_; } } \
        pmX = rowmax16(PX); mxw[((t) & 1) * 512] = pmX; } while (0)
#define A2_FINISH(PY, pmY, alY, u) do { const float pm_ = fmaxf(pmY, mxr[((u) & 1) * 512]); float mn_; \
        if (__builtin_expect(__all((pm_ - m_reg) * SCALE <= THR), 1)) { mn_ = m_reg; alY = 1.f; } \
        else { mn_ = fmaxf(m_reg, pm_); alY = __builtin_amdgcn_exp2f((m_reg - mn_) * C2); m_reg = mn_; } \
        const float mnL_ = -mn_ * C2; \
        _Pragma("unroll") for (int r = 0; r < 16; ++r) PY[r] = __builtin_amdgcn_exp2f(fmaf(PY[r], C2, mnL_)); \
        float ps_ = 0.f; _Pragma("unroll") for (int r = 0; r < 16; ++r) ps_ += PY[r]; \
        { auto rr_ = __builtin_amdgcn_permlane32_swap(__float_as_uint(ps_), __float_as_uint(ps_), false, false); ps_ = __uint_as_float(rr_[0]) + __uint_as_float(rr_[1]); } \
        l_reg = l_reg * alY + ps_; \
        A2_PK4(PY, 0, pxw); A2_PK4(PY, 8, pxw + 1024); } while (0)
#define A2_PK4(P, B_, DST) do { unsigned a0_ = att::cvtpk(P[B_ + 0], P[B_ + 1]), a1_ = att::cvtpk(P[B_ + 2], P[B_ + 3]), b0_ = att::cvtpk(P[B_ + 4], P[B_ + 5]), b1_ = att::cvtpk(P[B_ + 6], P[B_ + 7]); \
        auto r0_ = __builtin_amdgcn_permlane32_swap(a0_, b0_, false, false); auto r1_ = __builtin_amdgcn_permlane32_swap(a1_, b1_, false, false); \
        u32x4 w_ = {r0_[0], r1_[0], r0_[1], r1_[1]}; *(u32x4*)(DST) = w_; } while (0)
#define A2_PVSTEP(alY, VOFFB) do { const bf16x8 pa0_ = *reinterpret_cast<const bf16x8*>(pxr), pa1_ = *reinterpret_cast<const bf16x8*>(pxr + 1024), pa2_ = *reinterpret_cast<const bf16x8*>(pxr + 2048), pa3_ = *reinterpret_cast<const bf16x8*>(pxr + 3072); \
        if (__any((alY) < 1.f)) { if (hi == 0) al_l[r32] = (alY); asm volatile("s_waitcnt lgkmcnt(0)" ::: "memory"); \
            _Pragma("unroll") for (int d_ = 0; d_ < 4; ++d_) _Pragma("unroll") for (int r = 0; r < 16; ++r) o[d_][r] *= al_l[att::crow(r, hi)]; } \
        pv<VOFFB>(o, vb0, pa0_, pa1_, pa2_, pa3_); } while (0)
#define A2_STEP(PX, pmX, PY, pmY, alY, t, KB) do { \
        __builtin_amdgcn_s_setprio(2); A2_FINISH(PY, pmY, alY, (t) - 1); __builtin_amdgcn_s_setprio(0); A2_SBAR(); \
        qkt<KB>(PX, Kl, krow, hi, qr); A2_SBAR(); \
        __builtin_amdgcn_s_setprio(2); A2_MASKMAX(PX, pmX, t); __builtin_amdgcn_s_setprio(0); A2_SBAR(); \
        if ((t) + 1 < NT) { A2_VMW(4); A2_WRITEK(1 - KB); if ((t) + 2 < NT) A2_LOADK((t) + 2); } \
        A2_BAR(); \
        A2_PVSTEP(alY, (1 - KB) * 32768); A2_SBAR(); \
        if ((t) + 2 < NT) A2_VMW(2); else A2_VMW(0); \
        A2_WRITEV(KB); if ((t) + 1 < NT) A2_LOADV((t) + 1); \
        A2_BAR(); } while (0)
    float m_reg = -1e30f, l_reg = 0.f; f32x16 o[4] = {};
    f32x16 pA, pB; float pmA, pmB, alA = 1.f, alB = 1.f;
    A2_LOADK(0); A2_VMW(0); A2_WRITEK(0); A2_LOADK(1); A2_LOADV(0);
    A2_BAR();
    if (hf == 1) A2_BAR();
    qkt<0>(pA, Kl, krow, hi, qr); A2_SBAR();
    A2_MASKMAX(pA, pmA, 0); A2_SBAR();
    A2_VMW(4); A2_WRITEK(1); if (2 < NT) A2_LOADK(2);
    A2_BAR();
    if (2 < NT) A2_VMW(2); else A2_VMW(0);
    A2_WRITEV(0); A2_LOADV(1);
    A2_BAR();
    A2_STEP(pB, pmB, pA, pmA, alA, 1, 1);
    for (int t = 2; t < NT; t += 2) {
        A2_STEP(pA, pmA, pB, pmB, alB, t, 0);
        A2_STEP(pB, pmB, pA, pmA, alA, t + 1, 1);
    }
    A2_FINISH(pB, pmB, alB, NT - 1);
    A2_BAR();
    A2_PVSTEP(alB, 32768);
    if (hf == 0) A2_BAR();
    if (hi == 0) li_l[r32] = l_reg;
    A2_BAR();
    float rli[16];
#pragma unroll
    for (int r = 0; r < 16; ++r) rli[r] = __builtin_amdgcn_rcpf(li_l[att::crow(r, hi)] + li_p[att::crow(r, hi)]);
    float* Ow = (kh ? O1 : O0) + (size_t)(32 * rg) * 128;
#pragma unroll
    for (int r = 0; r < 16; ++r) { const int orow = att::crow(r, hi);
#pragma unroll
        for (int d0 = 0; d0 < 4; ++d0) Ow[(size_t)orow * 128 + d0 * 32 + r32] = o[d0][r] * rli[r]; }
    A2_BAR();
#undef A2_LOADK
#undef A2_LOADV
#undef A2_BAR
#undef A2_WRITEK
#undef A2_WRITEV
#undef A2_VMW
#undef A2_MASKMAX
#undef A2_FINISH
#undef A2_PK4
#undef A2_PVSTEP
#undef A2_STEP
}
#undef A2_KSWZ
#undef A2_SBAR
}

#ifndef MK_PER_PHASE
#define MK_PER_PHASE 0
#endif
constexpr int NWAVES = 8, NTHR = 512;
constexpr int SEQ = 16384, DM = 4096, FFH = 11008, DEPTH = 4, NMODV = 6 * DM;
#ifndef PADK
#define PADK 64
#endif
constexpr int LDD = DM + PADK, LDF = FFH + PADK;
constexpr int ZG = 96;
constexpr size_t GS = (size_t)SEQ * 128;
constexpr int S5T = 64, S5NC = SEQ / S5T;
constexpr int KSL = 16;
constexpr float NORM_EPS = 1e-6f, SUBLN_EPS = 1e-5f;
constexpr int N_PHASES = 35;

constexpr size_t MiB = 1u << 20;
constexpr size_t WS_CTL = 0, CTL_ZERO_BYTES = 64 * 1024;
constexpr size_t WS_MODP = 1 * MiB;
constexpr size_t WS_MODL = 3 * MiB;
constexpr size_t WS_LAM = 3 * MiB + 512 * 1024;
constexpr size_t WS_S5P = 4 * MiB, S5P_LAYER = 4 * MiB + 256 * 1024;
constexpr size_t S5P_ABR = 0, S5P_ABI = 64 * 1024, S5P_ATR = 128 * 1024, S5P_ATI = 192 * 1024, S5P_BBR = 256 * 1024, S5P_BBI = 256 * 1024 + MiB;
constexpr size_t S5P_BBOP = 256 * 1024 + 2 * MiB, S5P_COP = 256 * 1024 + 3 * MiB;
#ifndef S5_MFMA
#define S5_MFMA 1
#endif
constexpr size_t W_IN_B = (size_t)12288 * LDD * 2, W_OUT_B = (size_t)4096 * LDD * 2, W_GLU_B = (size_t)8192 * LDD * 2, W_GU_B = (size_t)22016 * LDD * 2, W_DN_B = (size_t)4096 * LDF * 2;
constexpr size_t WS_WIN = 16 * MiB, WS_WOUT = WS_WIN + 2 * W_IN_B, WS_WGLU = WS_WOUT + 2 * W_OUT_B, WS_WGU = WS_WGLU + 2 * W_GLU_B, WS_WDN = WS_WGU + 4 * W_GU_B;
constexpr size_t WS_H = WS_WDN + 4 * W_DN_B;
constexpr size_t WS_MIX = WS_H + (size_t)SEQ * LDD * 2;
constexpr size_t WS_Z = WS_MIX + (size_t)SEQ * LDD * 2;
constexpr size_t WS_OT = WS_Z + (size_t)ZG * GS * 2;
constexpr size_t WS_S5F = WS_OT + (size_t)32 * GS * 4;
constexpr size_t WS_S5H = WS_S5F + (size_t)S5NC * 256 * 128 * 4;
constexpr size_t WS_END = WS_S5H + (size_t)S5NC * 256 * 128 * 4;
static_assert((size_t)SEQ * LDF * 2 <= (size_t)ZG * GS * 2, "hidden overlays Z");
static_assert(WS_WIN % 256 == 0 && WS_H % 256 == 0 && WS_OT % 256 == 0 && WS_S5F % 256 == 0, "alignment");
constexpr int CW_BAR = 1024;

constexpr int RING_BYTES = 131072, MISC_OFF = RING_BYTES + 320, LDS_BYTES = 147456;

#define GAS __attribute__((address_space(1)))
#define LAS __attribute__((address_space(3)))
typedef unsigned short bf16;
typedef unsigned v4u __attribute__((ext_vector_type(4)));
typedef unsigned v2u __attribute__((ext_vector_type(2)));
typedef float f32x4 __attribute__((ext_vector_type(4)));
#define LDS_WAIT() asm volatile("s_waitcnt lgkmcnt(0)" ::: "memory")
#define VM_WAIT() asm volatile("s_waitcnt vmcnt(0)" ::: "memory")
__device__ __forceinline__ unsigned pk2(float lo, float hi) { unsigned r; asm volatile("v_cvt_pk_bf16_f32 %0, %1, %2" : "=v"(r) : "v"(lo), "v"(hi)); return r; }
__device__ __forceinline__ float bflo(unsigned w) { return __builtin_bit_cast(float, w << 16); }
__device__ __forceinline__ float bfhi(unsigned w) { return __builtin_bit_cast(float, w & 0xffff0000u); }

#define XB_TMO      128
#define XB_XCNT(j)  (256  + 64 * (j))
#define XB_XSUB(j)  (1280 + 64 * (j))
#define XB_XGEN(j)  (2304 + 64 * (j))
#define XB_TOP      3328
#define XB_TOPGEN   3392
#define XCD_BAR_WORDS 3456
#define XB_SPIN_CAP (1u << 22)

__device__ __forceinline__ unsigned xb_ld(unsigned* p)              { return __hip_atomic_load(p, __ATOMIC_RELAXED, __HIP_MEMORY_SCOPE_AGENT); }
__device__ __forceinline__ unsigned xb_add(unsigned* p, unsigned v) { return __hip_atomic_fetch_add(p, v, __ATOMIC_RELAXED, __HIP_MEMORY_SCOPE_AGENT); }
__device__ __forceinline__ unsigned xb_xcc_id() { return (unsigned)__builtin_amdgcn_s_getreg((3 << 11) | 20) & 0xFu; }
#define XB_SPIN(cond, bar) do { unsigned _sp = 0; while (cond) { __builtin_amdgcn_s_sleep(1); \
    if ((++_sp & 255u) == 0u) { if (xb_ld(&(bar)[XB_TMO])) break; if (_sp > XB_SPIN_CAP) { atomicAdd(&(bar)[XB_TMO], 1u); break; } } } } while (0)

struct XcdBarrier {
    unsigned* bar; unsigned x;
    volatile LAS unsigned* st;
};
__device__ __forceinline__ XcdBarrier xcd_barrier_post(unsigned* bar, volatile LAS unsigned* st) {
    XcdBarrier b; b.bar = bar; b.x = xb_xcc_id(); b.st = st;
    if (threadIdx.x == 0) (void)xb_add(&bar[XB_XCNT(b.x)], 1u);
    return b;
}
__device__ __forceinline__ void xcd_barrier_complete(unsigned* bar, unsigned x, unsigned& nloc, unsigned& nx) {
    const unsigned G = gridDim.x * gridDim.y * gridDim.z;
    unsigned sum, cnt, mine, sp = 0u;
    for (;;) {
        sum = 0u; cnt = 0u; mine = 0u;
#pragma unroll
        for (unsigned j = 0; j < 16; ++j) { const unsigned c = xb_ld(&bar[XB_XCNT(j)]); sum += c; cnt += (c > 0u) ? 1u : 0u; mine = (j == x) ? c : mine; }
        if (sum == G) break;
        __builtin_amdgcn_s_sleep(1);
        if ((++sp & 255u) == 0u) { if (xb_ld(&bar[XB_TMO])) break; if (sp > XB_SPIN_CAP) { atomicAdd(&bar[XB_TMO], 1u); break; } }
    }
    nloc = mine > 0u ? mine : 1u; nx = cnt > 0u ? cnt : 1u;
}
__device__ __forceinline__ void xcd_barrier(const XcdBarrier& b) {
    asm volatile("s_waitcnt vmcnt(0)" ::: "memory");
    __syncthreads();
    if (threadIdx.x == 0) {
        unsigned* bar = b.bar;
        __builtin_amdgcn_s_waitcnt(0);
        unsigned nloc = b.st[0], nx = b.st[1];
        if (nloc == 0u) { xcd_barrier_complete(bar, b.x, nloc, nx); b.st[0] = nloc; b.st[1] = nx; }
        const unsigned old = xb_add(&bar[XB_XSUB(b.x)], 1u);
        const unsigned gen = old / nloc;
        if (old + 1u == (gen + 1u) * nloc) {
            __builtin_amdgcn_fence(__ATOMIC_RELEASE, "agent");
            asm volatile("s_waitcnt vmcnt(0)" ::: "memory");
            const unsigned og = xb_add(&bar[XB_TOP], 1u);
            const unsigned tg = og / nx;
            if (og + 1u == (tg + 1u) * nx) xb_add(&bar[XB_TOPGEN], 1u);
            else XB_SPIN(xb_ld(&bar[XB_TOPGEN]) == tg, bar);
            __builtin_amdgcn_fence(__ATOMIC_ACQUIRE, "agent");
            xb_add(&bar[XB_XGEN(b.x)], 1u);
            asm volatile("s_waitcnt vmcnt(0)" ::: "memory");
        } else {
            XB_SPIN(xb_ld(&bar[XB_XGEN(b.x)]) == gen, bar);
            __builtin_amdgcn_fence(__ATOMIC_ACQUIRE, "agent");
            asm volatile("s_waitcnt vmcnt(0)" ::: "memory");
        }
    }
    __syncthreads();
}

__device__ __forceinline__ float wave_sum(float v) {
#pragma unroll
    for (int o = 1; o < 64; o <<= 1) v += __shfl_xor(v, o);
    return v;
}

__device__ __forceinline__ void transpose_item(const float* W, int K, int N, bf16* WT, int ldw, int mode, LAS float* scr, int item, int lane) {
    const int nblk = N / 32, kb = item / nblk, nb = item - kb * nblk, k0 = 64 * kb, n0 = 32 * nb;
    const int drow0 = mode == 0 ? n0 : ((n0 >> 7) * 256 + (n0 & 127) + (mode == 2 ? 128 : 0));
#pragma unroll 8
    for (int i = 0; i < 32; ++i) { const int kk = 2 * i + (lane >> 5); scr[kk * 33 + (lane & 31)] = W[(size_t)(k0 + kk) * N + n0 + (lane & 31)]; }
    LDS_WAIT(); asm volatile("" ::: "memory");
    const int c = lane & 7;
#pragma unroll
    for (int j = 0; j < 4; ++j) { const int n = (lane >> 3) + 8 * j; const LAS float* s = scr + (8 * c) * 33 + n;
        v4u o; o.x = pk2(s[0 * 33], s[1 * 33]); o.y = pk2(s[2 * 33], s[3 * 33]); o.z = pk2(s[4 * 33], s[5 * 33]); o.w = pk2(s[6 * 33], s[7 * 33]);
        *(v4u*)(WT + (size_t)(drow0 + n) * ldw + k0 + 8 * c) = o; }
    LDS_WAIT(); asm volatile("" ::: "memory");
}
__device__ __forceinline__ void dsincos(double x, double& s, double& c) {
    const double k = rint(x * 0.63661977236758134308);
    double r = fma(-k, 1.5707963267948966192, x); r = fma(-k, 6.1232339957367658860e-17, r);
    const double r2 = r * r;
    double ps = -1.0 / 1307674368000.0; ps = fma(ps, r2, 1.0 / 6227020800.0); ps = fma(ps, r2, -1.0 / 39916800.0); ps = fma(ps, r2, 1.0 / 362880.0); ps = fma(ps, r2, -1.0 / 5040.0);
    ps = fma(ps, r2, 1.0 / 120.0); ps = fma(ps, r2, -1.0 / 6.0); ps = fma(ps, r2, 1.0); const double sn = r * ps;
    double pc = 1.0 / 20922789888000.0; pc = fma(pc, r2, -1.0 / 87178291200.0); pc = fma(pc, r2, 1.0 / 479001600.0); pc = fma(pc, r2, -1.0 / 3628800.0); pc = fma(pc, r2, 1.0 / 40320.0);
    pc = fma(pc, r2, -1.0 / 720.0); pc = fma(pc, r2, 1.0 / 24.0); pc = fma(pc, r2, -0.5); const double cs = fma(pc, r2, 1.0);
    const int q = (int)k & 3;
    s = (q == 0) ? sn : (q == 1) ? cs : (q == 2) ? -sn : -cs;
    c = (q == 0) ? cs : (q == 1) ? -sn : (q == 2) ? -cs : sn;
}
__device__ __forceinline__ double dexp(double x) {
    const double k = rint(x * 1.4426950408889634074);
    double r = fma(-k, 0.69314718055994528623, x); r = fma(-k, 2.3190468138462995584e-17, r);
    double p = 1.0 / 87178291200.0; p = fma(p, r, 1.0 / 6227020800.0); p = fma(p, r, 1.0 / 479001600.0); p = fma(p, r, 1.0 / 39916800.0); p = fma(p, r, 1.0 / 3628800.0); p = fma(p, r, 1.0 / 362880.0);
    p = fma(p, r, 1.0 / 40320.0); p = fma(p, r, 1.0 / 5040.0); p = fma(p, r, 1.0 / 720.0); p = fma(p, r, 1.0 / 120.0); p = fma(p, r, 1.0 / 24.0); p = fma(p, r, 1.0 / 6.0); p = fma(p, r, 0.5); p = fma(p, r, 1.0); p = fma(p, r, 1.0);
    const long long bits = (long long)(1023 + (int)k) << 52;
    return p * __builtin_bit_cast(double, bits);
}

struct Args { const float* in[29]; float* out; unsigned char* ws; int ph_lo, ph_hi; };

__device__ __forceinline__ void p0_prologue(const Args& A, LAS unsigned char* lds, int gw, int NGW, int wave, int lane) {
    unsigned char* ws = A.ws;
    for (int w = gw; w < 96 * KSL + 512 + 2048; w += NGW) {
    if (w >= 96 * KSL + 512) {
        const int idx = (w - 96 * KSL - 512) * 64 + lane, o = idx >> 16, r = idx & 65535, g = r >> 8, mm = (r >> 6) & 3, o16 = lane & 15, kq = lane >> 4;
        const int tau = 2 * mm, p0 = 16 * (tau & 3) + 4 * kq;
        const float* cs = (tau < 4 ? A.in[21] : A.in[22]) + (size_t)o * 256 * 16 * 64 + (size_t)(g * 16 + o16) * 64 + p0; const float sg = tau < 4 ? 1.0f : -1.0f;
        const f32x4 a = *(const f32x4*)cs * sg, b = *(const f32x4*)(cs + 16) * sg;
        v4u q; q.x = pk2(a.x, a.y); q.y = pk2(a.z, a.w); q.z = pk2(b.x, b.y); q.w = pk2(b.z, b.w);
        *(v4u*)(ws + WS_S5P + (size_t)o * S5P_LAYER + S5P_COP + ((size_t)((g * 4 + mm) * 64 + lane)) * 16) = q;
    } else if (w < 96 * KSL) {
        const int nb = w % 96, ks = w / 96;
        const float* wp = A.in[2] + (size_t)(ks * 256) * NMODV + nb * 256 + lane * 4; const float* cp = A.in[1] + ks * 256;
        f32x4 a = {0.f, 0.f, 0.f, 0.f};
#pragma unroll 8
        for (int k = 0; k < 256; ++k) { const float cv = cp[k]; const float s = cv / (1.0f + expf(-cv)); const f32x4 w = *(const f32x4*)(wp + (size_t)k * NMODV); a += s * w; }
        *(f32x4*)((float*)(ws + WS_MODP) + (size_t)ks * NMODV + nb * 256 + lane * 4) = a;
    } else {
        const int idx = (w - 96 * KSL) * 64 + lane, o = idx >> 14, gp = idx & 16383, g = gp >> 6;
        const double lr = (double)fminf(A.in[16][idx], -1e-4f), li = (double)A.in[17][idx], dt = dexp((double)A.in[18][o * 256 + g]);
        const double mag = dexp(lr * dt); double sn, cs; dsincos(li * dt, sn, cs);
        const double abr = mag * cs, abi = mag * sn, den = lr * lr + li * li, nr = abr - 1.0, ni = abi;
        const double fre = (nr * lr + ni * li) / den, fim = (ni * lr - nr * li) / den;
        double tr = abr, ti = abi;
#pragma unroll
        for (int q = 0; q < 6; ++q) { const double t2 = tr * tr - ti * ti; ti = 2.0 * tr * ti; tr = t2; }
        unsigned char* pb = ws + WS_S5P + (size_t)o * S5P_LAYER;
        ((float*)(pb + S5P_ABR))[gp] = (float)abr; ((float*)(pb + S5P_ABI))[gp] = (float)abi; ((float*)(pb + S5P_ATR))[gp] = (float)tr; ((float*)(pb + S5P_ATI))[gp] = (float)ti;
        const float* bre = A.in[19] + (size_t)idx * 16; const float* bim = A.in[20] + (size_t)idx * 16;
        float* obr = (float*)(pb + S5P_BBR) + (size_t)gp * 16; float* obi = (float*)(pb + S5P_BBI) + (size_t)gp * 16;
#pragma unroll
        for (int h4 = 0; h4 < 4; ++h4) { const f32x4 br = *(const f32x4*)(bre + 4 * h4), bi = *(const f32x4*)(bim + 4 * h4); f32x4 r, i;
#pragma unroll
            for (int j = 0; j < 4; ++j) { r[j] = (float)(fre * (double)br[j] - fim * (double)bi[j]); i[j] = (float)(fre * (double)bi[j] + fim * (double)br[j]); }
            *(f32x4*)(obr + 4 * h4) = r; *(f32x4*)(obi + 4 * h4) = i; }
        { const int p = gp & 63, ti = p >> 4, i16 = p & 15;
#pragma unroll
          for (int kq = 0; kq < 4; ++kq) { const f32x4 r = *(const f32x4*)(obr + 4 * kq), i = *(const f32x4*)(obi + 4 * kq);
              v2u pr, pi; pr.x = pk2(r.x, r.y); pr.y = pk2(r.z, r.w); pi.x = pk2(i.x, i.y); pi.y = pk2(i.z, i.w);
              *(v2u*)(pb + S5P_BBOP + ((size_t)((g * 8 + ti) * 64 + kq * 16 + i16)) * 8) = pr; *(v2u*)(pb + S5P_BBOP + ((size_t)((g * 8 + 4 + ti) * 64 + kq * 16 + i16)) * 8) = pi; } }
    }
    }
    if (gw < 2) { const int e = gw;
        const float s1 = wave_sum(A.in[10][e * 128 + lane] * A.in[11][e * 128 + lane] + A.in[10][e * 128 + 64 + lane] * A.in[11][e * 128 + 64 + lane]);
        const float s2 = wave_sum(A.in[12][e * 128 + lane] * A.in[13][e * 128 + lane] + A.in[12][e * 128 + 64 + lane] * A.in[13][e * 128 + 64 + lane]);
        const float lam_init = e == 0 ? 0.2f : 0.4707130183435842f;
        if (lane == 0) ((float*)(ws + WS_LAM))[e] = expf(s1) - expf(s2) + lam_init; }
    LAS float* scr = (LAS float*)(lds + wave * 16384);
    constexpr int I_IN = 64 * 384, I_OUT = 64 * 128, I_GLU = 64 * 128, I_GU = 64 * 344, I_DN = 172 * 128;
    constexpr int NITEMS = 2 * I_IN + 2 * I_OUT + 4 * I_GLU + 8 * I_GU + 4 * I_DN;
    for (int it = gw; it < NITEMS; it += NGW) {
        int r = it;
        if (r < 2 * I_IN) { const int e = r / I_IN; transpose_item(A.in[8] + (size_t)e * DM * 12288, DM, 12288, (bf16*)(ws + WS_WIN + e * W_IN_B), LDD, 0, scr, r - e * I_IN, lane); continue; } r -= 2 * I_IN;
        if (r < 2 * I_OUT) { const int e = r / I_OUT; transpose_item(A.in[15] + (size_t)e * DM * DM, DM, DM, (bf16*)(ws + WS_WOUT + e * W_OUT_B), LDD, 0, scr, r - e * I_OUT, lane); continue; } r -= 2 * I_OUT;
        if (r < 4 * I_GLU) { const int q = r / I_GLU, o = q >> 1, s = q & 1; transpose_item(A.in[24 + s] + (size_t)o * DM * DM, DM, DM, (bf16*)(ws + WS_WGLU + o * W_GLU_B), LDD, 1 + s, scr, r - q * I_GLU, lane); continue; } r -= 4 * I_GLU;
        if (r < 8 * I_GU) { const int q = r / I_GU, l = q >> 1, s = q & 1; transpose_item(A.in[26 + s] + (size_t)l * DM * FFH, DM, FFH, (bf16*)(ws + WS_WGU + l * W_GU_B), LDD, 1 + s, scr, r - q * I_GU, lane); continue; } r -= 8 * I_GU;
        { const int l = r / I_DN; transpose_item(A.in[28] + (size_t)l * FFH * DM, FFH, DM, (bf16*)(ws + WS_WDN + l * W_DN_B), LDF, 0, scr, r - l * I_DN, lane); }
    }
}
__device__ __forceinline__ void p1_modvec(const Args& A, int gtid, int NGT) {
    const float* mp = (const float*)(A.ws + WS_MODP); float* ml = (float*)(A.ws + WS_MODL);
    for (int i = gtid; i < DEPTH * NMODV; i += NGT) { const int j = i % NMODV; float v = A.in[3][j] + A.in[4][i];
#pragma unroll
        for (int ks = 0; ks < KSL; ++ks) v += mp[(size_t)ks * NMODV + j];
        ml[i] = v; }
}
__device__ __forceinline__ void norm_mod_phase(const float* src, const float* nw, const float* sh, const float* sc, bf16* dst, LAS unsigned char* lds, int tid, int gw, int NGW, int lane) {
    LAS float* w1 = (LAS float*)lds; LAS float* bb = w1 + DM;
    for (int i = tid; i < DM; i += NTHR) { w1[i] = nw[i] * (1.0f + sc[i]); bb[i] = sh[i]; }
    __syncthreads();
    for (int m = gw; m < SEQ; m += NGW) {
        const f32x4* xr = (const f32x4*)(src + (size_t)m * DM) + lane;
        f32x4 v[16]; float ss = 0.f;
#pragma unroll
        for (int j = 0; j < 16; ++j) { v[j] = xr[64 * j]; ss += (v[j].x * v[j].x + v[j].y * v[j].y) + (v[j].z * v[j].z + v[j].w * v[j].w); }
        const float rstd = 1.0f / sqrtf(wave_sum(ss) * (1.0f / DM) + NORM_EPS);
        v2u* o8 = (v2u*)(dst + (size_t)m * LDD) + lane;
#pragma unroll
        for (int j = 0; j < 16; ++j) { const int col = j * 256 + lane * 4; const f32x4 w = *(const LAS f32x4*)(w1 + col), b = *(const LAS f32x4*)(bb + col);
            const f32x4 y = v[j] * rstd * w + b; v2u p; p.x = pk2(y.x, y.y); p.y = pk2(y.z, y.w); o8[64 * j] = p; }
    }
    __syncthreads();
}
__device__ __forceinline__ void final_norm_phase(const float* src, const float* nw, float* dst, int gw, int NGW, int lane) {
    for (int m = gw; m < SEQ; m += NGW) {
        const f32x4* xr = (const f32x4*)(src + (size_t)m * DM) + lane;
        f32x4 v[16]; float ss = 0.f;
#pragma unroll
        for (int j = 0; j < 16; ++j) { v[j] = xr[64 * j]; ss += (v[j].x * v[j].x + v[j].y * v[j].y) + (v[j].z * v[j].z + v[j].w * v[j].w); }
        const float rstd = 1.0f / sqrtf(wave_sum(ss) * (1.0f / DM) + NORM_EPS);
        f32x4* o = (f32x4*)(dst + (size_t)m * DM) + lane; const f32x4* wv = (const f32x4*)nw + lane;
#pragma unroll
        for (int j = 0; j < 16; ++j) o[64 * j] = v[j] * rstd * wv[64 * j];
    }
}
__device__ __forceinline__ void conv_phase(const bf16* Z, const float* cw, bf16* MIX, int gtid, int NGT) {
    for (int i = gtid; i < SEQ * 256; i += NGT) {
        const int t = i >> 8, r = i & 255, gi = r >> 4, c8 = (r & 15) * 8;
        const size_t o = (size_t)t * 128 + c8;
        const v4u zero = {0u, 0u, 0u, 0u};
        const v4u vb = *(const v4u*)(Z + (size_t)gi * GS + o);
        const bf16* zc = Z + (size_t)(16 + gi) * GS + o; const bf16* zx = Z + (size_t)(32 + gi) * GS + o;
        const v4u c0 = *(const v4u*)zc, x0 = *(const v4u*)zx;
        const v4u c1 = t >= 1 ? *(const v4u*)(zc - 128) : zero, x1 = t >= 1 ? *(const v4u*)(zx - 128) : zero;
        const v4u c2 = t >= 2 ? *(const v4u*)(zc - 256) : zero, x2 = t >= 2 ? *(const v4u*)(zx - 256) : zero;
        const float* wp = cw + gi * 128 + c8;
        float y[8];
#pragma unroll
        for (int q = 0; q < 4; ++q) {
            const float u0l = bflo(c0[q]) * bflo(x0[q]), u0h = bfhi(c0[q]) * bfhi(x0[q]);
            const float u1l = bflo(c1[q]) * bflo(x1[q]), u1h = bfhi(c1[q]) * bfhi(x1[q]);
            const float u2l = bflo(c2[q]) * bflo(x2[q]), u2h = bfhi(c2[q]) * bfhi(x2[q]);
            const int j = 2 * q;
            y[j]     = bflo(vb[q]) * (wp[2 * 2048 + j] * u0l + wp[2048 + j] * u1l + wp[j] * u2l);
            y[j + 1] = bfhi(vb[q]) * (wp[2 * 2048 + j + 1] * u0h + wp[2048 + j + 1] * u1h + wp[j + 1] * u2h);
        }
        v4u w; w.x = pk2(y[0], y[1]); w.y = pk2(y[2], y[3]); w.z = pk2(y[4], y[5]); w.w = pk2(y[6], y[7]);
        *(v4u*)(MIX + (size_t)t * LDD + gi * 128 + c8) = w;
    }
}
__device__ __forceinline__ void combine_phase(const float* OT, const float* lamp, const float* sg, float lam_init, bf16* MIX, int gw, int NGW, int lane) {
    const float lam = lamp[0], os = 1.0f - lam_init;
    const int j = lane >> 5, c4 = (lane & 31) * 4;
    const f32x4 gv = *(const f32x4*)(sg + 128 * j + c4);
    for (int it0 = gw * 4; it0 < SEQ * 8; it0 += NGW * 4) {
        f32x4 a[4], b[4];
#pragma unroll
        for (int q = 0; q < 4; ++q) { const int it = it0 + q, t = it >> 3, h = it & 7;
            a[q] = *(const f32x4*)(OT + (size_t)(h * 4 + j) * GS + (size_t)t * 128 + c4); b[q] = *(const f32x4*)(OT + (size_t)(h * 4 + 2 + j) * GS + (size_t)t * 128 + c4); }
#pragma unroll
        for (int q = 0; q < 4; ++q) { const int it = it0 + q, t = it >> 3, h = it & 7;
            const f32x4 o = a[q] - lam * b[q];
            const float rstd = 1.0f / sqrtf(wave_sum((o.x * o.x + o.y * o.y) + (o.z * o.z + o.w * o.w)) * (1.0f / 256.0f) + SUBLN_EPS);
            const f32x4 y = o * (rstd * os) * gv;
            v2u p; p.x = pk2(y.x, y.y); p.y = pk2(y.z, y.w);
            *(v2u*)(MIX + (size_t)t * LDD + 2048 + 256 * h + 128 * j + c4) = p; }
    }
}
__device__ __forceinline__ att::BlockRef<att::bf16, float> att_ref(const bf16* Z, float* OT, int item, int pass) {
    const int r = item >> 8, b = item & 255, vh = r * 8 + (b & 7), pair = b >> 3, qb = pass ? 63 - pair : pair;
    const int h = vh >> 2, m = (vh >> 1) & 1, j = vh & 1;
    att::BlockRef<att::bf16, float> R;
    R.Q = (const att::bf16*)(Z + (size_t)(48 + 2 * h + m) * GS + (size_t)qb * 256 * 128);
    R.K = (const att::bf16*)(Z + (size_t)(64 + 2 * h + m) * GS);
    R.V = (const att::bf16*)(Z + (size_t)(80 + 2 * h + j) * GS);
    R.O = OT + (size_t)vh * GS + (size_t)qb * 256 * 128; R.P0 = qb * 256;
    return R;
}
__device__ __forceinline__ void attn_phase(const bf16* Z, float* OT, char* lds, int bid, int G) {
    constexpr int TOTAL = 1024;
    int item = bid; if (item >= TOTAL) return;
    int pass = 0;
    att::BlockRef<att::bf16, float> cur = att_ref(Z, OT, item, 0);
    att::Seam<att::bf16> S;
    att::causal_swa_prime<att::bf16, float>(cur, SEQ, lds, S);
    for (;;) {
        const bool more_pass = pass == 0, more_item = item + G < TOTAL, last = !more_pass && !more_item;
        int itn = item, passn = 1;
        if (!more_pass) { passn = 0; itn = more_item ? item + G : item; }
        const att::BlockRef<att::bf16, float> nxt = last ? cur : att_ref(Z, OT, itn, passn);
        att::causal_swa_block<att::bf16, float>(cur, nxt, SEQ, SEQ, lds, S);
        if (last) break;
        cur = nxt; item = itn; pass = passn;
    }
}
#ifndef ATT2
#define ATT2 1
#endif
template <bool DEG>
__device__ __forceinline__ void attn2_phase(const bf16* Z, float* OT, char* lds, int bid, int G) {
    for (int item = bid; item < 1024; item += G) {
        const int r = item >> 8, b = item & 255, hm = 2 * (b & 7) + (r >> 1), pair = (r & 1) * 32 + (b >> 3), h = hm >> 1, m = hm & 1;
        for (int pass = 0; pass < 2; ++pass) { const int qb = pass ? 127 - pair : pair;
            att2::block<DEG>(Z + (size_t)(48 + 2 * h + m) * GS + (size_t)qb * 128 * 128, Z + (size_t)(64 + 2 * h + m) * GS, Z + (size_t)(80 + 2 * h) * GS, Z + (size_t)(81 + 2 * h) * GS,
                        OT + (size_t)(h * 4 + m * 2) * GS + (size_t)qb * 128 * 128, OT + (size_t)(h * 4 + m * 2 + 1) * GS + (size_t)qb * 128 * 128, qb * 128, lds); }
    }
}
__device__ __forceinline__ float gelu_tanh(float x) { const float z = 1.5957691216057308f * (x + 0.044715f * x * x * x); return x * __builtin_amdgcn_rcpf(1.0f + __builtin_amdgcn_exp2f(-1.4426950408889634f * z)); }
template <bool PASS2>
__device__ __forceinline__ void s5_pass(const bf16* Hin, const unsigned char* prm, const float* c_re, const float* c_im, const float* dsk, float* F, const float* HC, bf16* Gout,
                                        LAS unsigned char* lds, int gw, int NGW, int wave, int lane) {
    LAS float* lu = (LAS float*)(lds + wave * 4096);
    for (int item = gw; item < 256 * S5NC; item += NGW) {
        const int g = item & 255, c = item >> 8, gp = g * 64 + lane;
        { const bf16* up = Hin + (size_t)(c * S5T + lane) * LDD + 16 * g; const v4u a = *(const v4u*)up, b = *(const v4u*)(up + 8);
          LAS f32x4* ur = (LAS f32x4*)(lu + lane * 16);
          ur[0] = (f32x4){bflo(a.x), bfhi(a.x), bflo(a.y), bfhi(a.y)}; ur[1] = (f32x4){bflo(a.z), bfhi(a.z), bflo(a.w), bfhi(a.w)};
          ur[2] = (f32x4){bflo(b.x), bfhi(b.x), bflo(b.y), bfhi(b.y)}; ur[3] = (f32x4){bflo(b.z), bfhi(b.z), bflo(b.w), bfhi(b.w)}; }
        f32x4 bbr[4], bbi[4];
#pragma unroll
        for (int q = 0; q < 4; ++q) { bbr[q] = *(const f32x4*)((const float*)(prm + S5P_BBR) + (size_t)gp * 16 + 4 * q); bbi[q] = *(const f32x4*)((const float*)(prm + S5P_BBI) + (size_t)gp * 16 + 4 * q); }
        const float abr = ((const float*)(prm + S5P_ABR))[gp], abi = ((const float*)(prm + S5P_ABI))[gp];
        float hr = 0.f, hi = 0.f, cr[16], ci[16], dk = 0.f;
        if (PASS2) {
#pragma unroll
            for (int o = 0; o < 16; ++o) { cr[o] = c_re[(size_t)(g * 16 + o) * 64 + lane]; ci[o] = c_im[(size_t)(g * 16 + o) * 64 + lane]; }
            hr = HC[(size_t)(c * 256 + g) * 128 + lane]; hi = HC[(size_t)(c * 256 + g) * 128 + 64 + lane]; dk = dsk[16 * g + (lane >> 2)];
        }
        LDS_WAIT(); asm volatile("" ::: "memory");
#pragma unroll 2
        for (int t = 0; t < S5T; ++t) {
            const LAS f32x4* ut = (const LAS f32x4*)(lu + t * 16);
            float bur = 0.f, bui = 0.f;
#pragma unroll
            for (int q = 0; q < 4; ++q) { const f32x4 u = ut[q];
                bur += (bbr[q].x * u.x + bbr[q].y * u.y) + (bbr[q].z * u.z + bbr[q].w * u.w); bui += (bbi[q].x * u.x + bbi[q].y * u.y) + (bbi[q].z * u.z + bbi[q].w * u.w); }
            const float nr = abr * hr - abi * hi + bur, ni = abr * hi + abi * hr + bui; hr = nr; hi = ni;
            if (PASS2) {
                float v[16];
#pragma unroll
                for (int o = 0; o < 16; ++o) v[o] = hr * cr[o] - hi * ci[o];
#pragma unroll
                for (int i = 0; i < 8; ++i) { const float send = (lane & 32) ? v[i] : v[i + 8], keep = (lane & 32) ? v[i + 8] : v[i]; v[i] = keep + __shfl_xor(send, 32); }
#pragma unroll
                for (int i = 0; i < 4; ++i) { const float send = (lane & 16) ? v[i] : v[i + 4], keep = (lane & 16) ? v[i + 4] : v[i]; v[i] = keep + __shfl_xor(send, 16); }
#pragma unroll
                for (int i = 0; i < 2; ++i) { const float send = (lane & 8) ? v[i] : v[i + 2], keep = (lane & 8) ? v[i + 2] : v[i]; v[i] = keep + __shfl_xor(send, 8); }
                { const float send = (lane & 4) ? v[0] : v[1], keep = (lane & 4) ? v[1] : v[0]; v[0] = keep + __shfl_xor(send, 4); }
                v[0] += __shfl_xor(v[0], 2); v[0] += __shfl_xor(v[0], 1);
                const float yy = v[0] + dk * lu[t * 16 + (lane >> 2)];
                const float gl = gelu_tanh(yy);
                if ((lane & 3) == 0) Gout[(size_t)(c * S5T + t) * LDD + 16 * g + (lane >> 2)] = (bf16)(pk2(gl, gl) & 0xffffu);
            }
        }
        if (!PASS2) { F[(size_t)(c * 256 + g) * 128 + lane] = hr; F[(size_t)(c * 256 + g) * 128 + 64 + lane] = hi; }
        LDS_WAIT(); asm volatile("" ::: "memory");
    }
}

constexpr int S5TS = 8, S5SB = S5TS * 256 + 16;
typedef short s5_bf16x8 __attribute__((ext_vector_type(8)));
template <bool PASS2>
__device__ __forceinline__ void s5m_pass(const bf16* Hin, const unsigned char* prm, const float* dsk, float* F, const float* HC, bf16* Gout, LAS unsigned char* lds, int bid, int G) {
    const int tid = opaque_tid(), lane = tid & 63, w = __builtin_amdgcn_readfirstlane(tid >> 6), j = lane & 15, rq = lane >> 4;
    const int rowslot = tid >> 4, piece = tid & 15;
    constexpr int NST = S5T / S5TS, NQ = 16 * S5TS / 32;
    for (int unit = bid; unit < 32 * (S5NC / 16); unit += G) {
        const int gb = unit & 31, cs = unit >> 5, g = gb * 8 + w;
        v2u bb[8];
#pragma unroll
        for (int t8 = 0; t8 < 8; ++t8) bb[t8] = *(const v2u*)(prm + S5P_BBOP + ((size_t)((g * 8 + t8) * 64 + lane)) * 8);
        v4u cop[4];
        f32x4 ar[4], ai[4], sr[4], si[4], dk = {0.f, 0.f, 0.f, 0.f};
#pragma unroll
        for (int q = 0; q < 4; ++q) { ar[q] = *(const f32x4*)((const float*)(prm + S5P_ABR) + g * 64 + 16 * q + 4 * rq); ai[q] = *(const f32x4*)((const float*)(prm + S5P_ABI) + g * 64 + 16 * q + 4 * rq); }
        if (PASS2) {
#pragma unroll
            for (int mm = 0; mm < 4; ++mm) cop[mm] = *(const v4u*)(prm + S5P_COP + ((size_t)((g * 4 + mm) * 64 + lane)) * 16);
            const float* hc = HC + ((size_t)(cs * 16 + j) * 256 + g) * 128 + 4 * rq;
#pragma unroll
            for (int q = 0; q < 4; ++q) { sr[q] = *(const f32x4*)(hc + 16 * q); si[q] = *(const f32x4*)(hc + 64 + 16 * q); }
            dk = *(const f32x4*)(dsk + 16 * g + 4 * rq);
        } else {
#pragma unroll
            for (int q = 0; q < 4; ++q) { sr[q] = (f32x4){0.f, 0.f, 0.f, 0.f}; si[q] = (f32x4){0.f, 0.f, 0.f, 0.f}; }
        }
        const bf16* src = Hin + (size_t)(cs * 16 * S5T) * LDD + gb * 128 + piece * 8;
        bf16* dstp = PASS2 ? Gout + (size_t)(cs * 16 * S5T) * LDD + gb * 128 + piece * 8 : nullptr;
        v4u pre[NQ];
#pragma unroll
        for (int q = 0; q < NQ; ++q) { const int ri = q * 32 + rowslot, jj = ri / S5TS, tt = ri % S5TS; pre[q] = *(const v4u*)(src + (size_t)(jj * S5T + tt) * LDD); }
        for (int s = 0; s < NST; ++s) {
#pragma unroll
            for (int q = 0; q < NQ; ++q) { const int ri = q * 32 + rowslot, jj = ri / S5TS, tt = ri % S5TS; LAS v4u* lp = (LAS v4u*)(lds + jj * S5SB + tt * 256 + piece * 16);
                if (PASS2 && s > 0) { const v4u y = *lp; *(v4u*)(dstp + (size_t)(jj * S5T + (s - 1) * S5TS + tt) * LDD) = y; }
                *lp = pre[q]; }
            if (s + 1 < NST) {
#pragma unroll
                for (int q = 0; q < NQ; ++q) { const int ri = q * 32 + rowslot, jj = ri / S5TS, tt = ri % S5TS; pre[q] = *(const v4u*)(src + (size_t)(jj * S5T + (s + 1) * S5TS + tt) * LDD); } }
            LDS_WAIT(); __syncthreads();
            LAS unsigned char* up = lds + j * S5SB + w * 32 + rq * 8;
            v2u uu[S5TS];
#pragma unroll
            for (int tt = 0; tt < S5TS; ++tt) uu[tt] = *(const LAS v2u*)(up + tt * 256);
#pragma unroll
            for (int tt = 0; tt < S5TS; ++tt) {
                v4u ub; ub.x = uu[tt].x; ub.y = uu[tt].y; ub.z = 0u; ub.w = 0u;
                const s5_bf16x8 U = __builtin_bit_cast(s5_bf16x8, ub);
#pragma unroll
                for (int q = 0; q < 4; ++q) {
                    const f32x4 tr = ar[q] * sr[q] - ai[q] * si[q], ti = ar[q] * si[q] + ai[q] * sr[q];
                    v4u a0; a0.x = bb[q].x; a0.y = bb[q].y; a0.z = 0u; a0.w = 0u; v4u a1; a1.x = bb[4 + q].x; a1.y = bb[4 + q].y; a1.z = 0u; a1.w = 0u;
                    sr[q] = __builtin_amdgcn_mfma_f32_16x16x32_bf16(__builtin_bit_cast(s5_bf16x8, a0), U, tr, 0, 0, 0);
                    si[q] = __builtin_amdgcn_mfma_f32_16x16x32_bf16(__builtin_bit_cast(s5_bf16x8, a1), U, ti, 0, 0, 0);
                }
                if (PASS2) {
                    f32x4 y = {0.f, 0.f, 0.f, 0.f};
#pragma unroll
                    for (int mm = 0; mm < 4; ++mm) { const f32x4 t0 = mm < 2 ? sr[2 * mm] : si[2 * mm - 4], t1 = mm < 2 ? sr[2 * mm + 1] : si[2 * mm - 3];
                        v4u sb; sb.x = pk2(t0.x, t0.y); sb.y = pk2(t0.z, t0.w); sb.z = pk2(t1.x, t1.y); sb.w = pk2(t1.z, t1.w);
                        y = __builtin_amdgcn_mfma_f32_16x16x32_bf16(__builtin_bit_cast(s5_bf16x8, cop[mm]), __builtin_bit_cast(s5_bf16x8, sb), y, 0, 0, 0); }
                    const f32x4 uf = {bflo(uu[tt].x), bfhi(uu[tt].x), bflo(uu[tt].y), bfhi(uu[tt].y)};
                    const f32x4 yy = y + dk * uf;
                    v2u o; o.x = pk2(gelu_tanh(yy.x), gelu_tanh(yy.y)); o.y = pk2(gelu_tanh(yy.z), gelu_tanh(yy.w));
                    *(LAS v2u*)(up + tt * 256) = o;
                }
            }
            LDS_WAIT(); __syncthreads();
        }
        if (PASS2) {
#pragma unroll
            for (int q = 0; q < NQ; ++q) { const int ri = q * 32 + rowslot, jj = ri / S5TS, tt = ri % S5TS; const v4u y = *(const LAS v4u*)(lds + jj * S5SB + tt * 256 + piece * 16);
                *(v4u*)(dstp + (size_t)(jj * S5T + (NST - 1) * S5TS + tt) * LDD) = y; }
            LDS_WAIT();
        } else {
            float* fo = F + ((size_t)(cs * 16 + j) * 256 + g) * 128 + 4 * rq;
#pragma unroll
            for (int q = 0; q < 4; ++q) { *(f32x4*)(fo + 16 * q) = sr[q]; *(f32x4*)(fo + 64 + 16 * q) = si[q]; }
        }
    }
}
__device__ __forceinline__ void s5_carry(const unsigned char* prm, const float* F, float* HC, int bid, int G, int wave, int lane) {
    if (wave != 0) return;
    for (int g = bid; g < 256; g += G) {
        const int p = lane, gp = g * 64 + p;
        const float atr = ((const float*)(prm + S5P_ATR))[gp], ati = ((const float*)(prm + S5P_ATI))[gp];
        float hr = 0.f, hi = 0.f;
        for (int c0 = 0; c0 < S5NC; c0 += 32) {
            float fr[32], fi[32];
#pragma unroll
            for (int q = 0; q < 32; ++q) { const size_t o = (size_t)((c0 + q) * 256 + g) * 128 + p; fr[q] = F[o]; fi[q] = F[o + 64]; }
#pragma unroll
            for (int q = 0; q < 32; ++q) { const size_t o = (size_t)((c0 + q) * 256 + g) * 128 + p;
                HC[o] = hr; HC[o + 64] = hi;
                const float nr = atr * hr - ati * hi + fr[q], ni = atr * hi + ati * hr + fi[q]; hr = nr; hi = ni; }
        }
    }
}

struct Ctx { int lo, hi, tid, lane, wave, gw, NGW, gtid, NGT, G, bid; };
#ifndef WGM_IN
#define WGM_IN 8
#endif
#ifndef WGM_OUT
#define WGM_OUT 2
#endif
#ifndef WGM_GLU
#define WGM_GLU 4
#endif
#ifndef WGM_F1
#define WGM_F1 8
#endif
#ifndef WGM_F2
#define WGM_F2 2
#endif
#ifndef DUP_ATTN
#define DUP_ATTN 0
#endif
#ifndef DUP_S5
#define DUP_S5 0
#endif
#ifndef DUP_FFN1
#define DUP_FFN1 0
#endif
#ifndef DUP_FFN2
#define DUP_FFN2 0
#endif
#ifndef DUP_INP
#define DUP_INP 0
#endif
#ifndef DUP_PRO
#define DUP_PRO 0
#endif
#define IN(k) (lo <= (k) && (k) < hi)
#define SEAM(k) do { if (IN(k) && IN((k) + 1)) xcd_barrier(bar); } while (0)
#define FFN_PHASES(l, pb) do { \
    const float* ml_ = MODL + (size_t)(l) * NMODV; \
    if (IN((pb) + 5)) norm_mod_phase(XR, args.in[6] + (size_t)(l) * DM, ml_ + 3 * DM, ml_ + 4 * DM, Hb, lds, tid, gw, NGW, lane); \
    SEAM((pb) + 5); \
    if (IN((pb) + 6)) { pg8::Gemm g{Hb, (const bf16*)(ws + WS_WGU + (size_t)(l) * W_GU_B), SEQ, 2 * FFH, DM, LDD, LDD}; pg8::StaticOrder S; S.init(SEQ, 2 * FFH, G, bid, WGM_F1); \
        pg8::EpiSwiGLU E{HID, LDF}; pg8::gemm_phase<pg8::EpiSwiGLU, pg8::StaticOrder, true, true>(lds, g, S, E); } \
    if (DUP_FFN1 && IN((pb) + 6)) { xcd_barrier(bar); pg8::Gemm g{Hb, (const bf16*)(ws + WS_WGU + (size_t)(l) * W_GU_B), SEQ, 2 * FFH, DM, LDD, LDD}; pg8::StaticOrder S; S.init(SEQ, 2 * FFH, G, bid, WGM_F1); \
        pg8::EpiSwiGLU E{HID, LDF}; pg8::gemm_phase<pg8::EpiSwiGLU, pg8::StaticOrder, true, true>(lds, g, S, E); } \
    SEAM((pb) + 6); \
    if (DUP_FFN2 && IN((pb) + 7)) { xcd_barrier(bar); pg8::Gemm g{HID, (const bf16*)(ws + WS_WDN + (size_t)(l) * W_DN_B), SEQ, DM, FFH, LDF, LDF}; pg8::StaticOrder S; S.init(SEQ, DM, G, bid, WGM_F2); \
        pg8::EpiResid E{XR, (float*)(ws + WS_OT), ml_ + 5 * DM, DM}; pg8::gemm_phase<pg8::EpiResid, pg8::StaticOrder, true, true>(lds, g, S, E); } \
    if (IN((pb) + 7)) { pg8::Gemm g{HID, (const bf16*)(ws + WS_WDN + (size_t)(l) * W_DN_B), SEQ, DM, FFH, LDF, LDF}; pg8::StaticOrder S; S.init(SEQ, DM, G, bid, WGM_F2); \
        pg8::EpiResid E{XR, XR, ml_ + 5 * DM, DM}; pg8::gemm_phase<pg8::EpiResid, pg8::StaticOrder, true, true>(lds, g, S, E); } \
    SEAM((pb) + 7); } while (0)
template <int lp>
__device__ __forceinline__ void layer_pair(const Args& args, const Ctx& C, LAS unsigned char* lds, unsigned char* lds_raw, const XcdBarrier& bar) {
    const int lo = C.lo, hi = C.hi, tid = C.tid, lane = C.lane, wave = C.wave, gw = C.gw, NGW = C.NGW, gtid = C.gtid, NGT = C.NGT, G = C.G, bid = C.bid;
    unsigned char* ws = args.ws;
    bf16* const Hb = (bf16*)(ws + WS_H); bf16* const MIX = (bf16*)(ws + WS_MIX); bf16* const Z = (bf16*)(ws + WS_Z); bf16* const HID = (bf16*)(ws + WS_Z);
    float* const OT = (float*)(ws + WS_OT); float* const XR = args.out;
    const float* const MODL = (const float*)(ws + WS_MODL);
        { const int l = 2 * lp, pb = 2 + 8 * l; const float* ml = MODL + (size_t)l * NMODV;
          const float* xin = (l == 0) ? args.in[0] : XR;
          if (IN(pb)) norm_mod_phase(xin, args.in[5] + (size_t)l * DM, ml, ml + DM, Hb, lds, tid, gw, NGW, lane);
          SEAM(pb);
          if (IN(pb + 1)) { pg8::Gemm g{Hb, (const bf16*)(ws + WS_WIN + (size_t)lp * W_IN_B), SEQ, 12288, DM, LDD, LDD}; pg8::StaticOrder S; S.init(SEQ, 12288, G, bid, WGM_IN);
              pg8::EpiHeadMajor E{Z, GS}; pg8::gemm_phase<pg8::EpiHeadMajor, pg8::StaticOrder, true, true>(lds, g, S, E); }
          if (DUP_INP && IN(pb + 1)) { xcd_barrier(bar); pg8::Gemm g{Hb, (const bf16*)(ws + WS_WIN + (size_t)lp * W_IN_B), SEQ, 12288, DM, LDD, LDD}; pg8::StaticOrder S; S.init(SEQ, 12288, G, bid, WGM_IN);
              pg8::EpiHeadMajor E{Z, GS}; pg8::gemm_phase<pg8::EpiHeadMajor, pg8::StaticOrder, true, true>(lds, g, S, E); }
          SEAM(pb + 1);
          if (IN(pb + 2)) { conv_phase(Z, args.in[9] + (size_t)lp * 3 * 2048, MIX, gtid, NGT); if (ATT2) attn2_phase<false>(Z, OT, (char*)lds_raw, bid, G); else attn_phase(Z, OT, (char*)lds_raw, bid, G); if (DUP_ATTN == 1) { xcd_barrier(bar); attn2_phase<false>(Z, (float*)(ws + WS_END), (char*)lds_raw, bid, G); } if (DUP_ATTN == 2) { xcd_barrier(bar); attn2_phase<true>(Z, (float*)(ws + WS_END), (char*)lds_raw, bid, G); } }
          SEAM(pb + 2);
          if (IN(pb + 3)) combine_phase(OT, (const float*)(ws + WS_LAM) + lp, args.in[14] + lp * 256, lp == 0 ? 0.2f : 0.4707130183435842f, MIX, gw, NGW, lane);
          SEAM(pb + 3);
          if (IN(pb + 4)) { pg8::Gemm g{MIX, (const bf16*)(ws + WS_WOUT + (size_t)lp * W_OUT_B), SEQ, DM, DM, LDD, LDD}; pg8::StaticOrder S; S.init(SEQ, DM, G, bid, WGM_OUT);
              pg8::EpiResid E{xin, XR, ml + 2 * DM, DM}; pg8::gemm_phase<pg8::EpiResid, pg8::StaticOrder, true, true>(lds, g, S, E); }
          SEAM(pb + 4);
          FFN_PHASES(l, pb);
        }
        { const int l = 2 * lp + 1, pb = 2 + 8 * l; const float* ml = MODL + (size_t)l * NMODV;
          const unsigned char* prm = ws + WS_S5P + (size_t)lp * S5P_LAYER;
          float* const S5F = (float*)(ws + WS_S5F); float* const S5H = (float*)(ws + WS_S5H);
          if (IN(pb)) norm_mod_phase(XR, args.in[5] + (size_t)l * DM, ml, ml + DM, Hb, lds, tid, gw, NGW, lane);
          SEAM(pb);
          if (IN(pb + 1)) { if (S5_MFMA) s5m_pass<false>(Hb, prm, nullptr, S5F, nullptr, nullptr, lds, bid, G); else s5_pass<false>(Hb, prm, nullptr, nullptr, nullptr, S5F, nullptr, nullptr, lds, gw, NGW, wave, lane); }
          SEAM(pb + 1);
          if (IN(pb + 2)) s5_carry(prm, S5F, S5H, bid, G, wave, lane);
          SEAM(pb + 2);
          if (IN(pb + 3)) { if (S5_MFMA) s5m_pass<true>(Hb, prm, args.in[23] + (size_t)lp * DM, nullptr, S5H, MIX, lds, bid, G); else s5_pass<true>(Hb, prm, args.in[21] + (size_t)lp * 256 * 16 * 64, args.in[22] + (size_t)lp * 256 * 16 * 64, args.in[23] + (size_t)lp * DM, nullptr, S5H, MIX, lds, gw, NGW, wave, lane); }
          if (DUP_S5) { xcd_barrier(bar);
          if (IN(pb + 1)) { if (S5_MFMA) s5m_pass<false>(Hb, prm, nullptr, S5F, nullptr, nullptr, lds, bid, G); else s5_pass<false>(Hb, prm, nullptr, nullptr, nullptr, S5F, nullptr, nullptr, lds, gw, NGW, wave, lane); }
          SEAM(pb + 1);
          if (IN(pb + 2)) s5_carry(prm, S5F, S5H, bid, G, wave, lane);
          SEAM(pb + 2);
          if (IN(pb + 3)) { if (S5_MFMA) s5m_pass<true>(Hb, prm, args.in[23] + (size_t)lp * DM, nullptr, S5H, MIX, lds, bid, G); else s5_pass<true>(Hb, prm, args.in[21] + (size_t)lp * 256 * 16 * 64, args.in[22] + (size_t)lp * 256 * 16 * 64, args.in[23] + (size_t)lp * DM, nullptr, S5H, MIX, lds, gw, NGW, wave, lane); }
          }
          SEAM(pb + 3);
          if (IN(pb + 4)) { pg8::Gemm g{MIX, (const bf16*)(ws + WS_WGLU + (size_t)lp * W_GLU_B), SEQ, 2 * DM, DM, LDD, LDD}; pg8::StaticOrder S; S.init(SEQ, 2 * DM, G, bid, WGM_GLU);
              pg8::EpiGluResid E{XR, XR, ml + 2 * DM, DM}; pg8::gemm_phase<pg8::EpiGluResid, pg8::StaticOrder, true, true>(lds, g, S, E); }
          SEAM(pb + 4);
          FFN_PHASES(l, pb);
        }
    }
#undef FFN_PHASES
#undef IN
#undef SEAM

__global__ void __launch_bounds__(NTHR, 2) trunk_fwd(Args args) {
    extern __shared__ __attribute__((aligned(16))) unsigned char lds_raw[];
    LAS unsigned char* lds = (LAS unsigned char*)lds_raw;
    volatile LAS unsigned* MISC = (volatile LAS unsigned*)(lds + MISC_OFF);
    const int tid = opaque_tid(), lane = tid & 63, wave = __builtin_amdgcn_readfirstlane(tid >> 6);
    const int G = gridDim.x, bid = blockIdx.x;
    const int vcu = (G % 8 == 0) ? (bid % 8) * (G / 8) + bid / 8 : bid;
    const int gw = vcu * NWAVES + wave, NGW = G * NWAVES, gtid = vcu * NTHR + tid, NGT = G * NTHR;
    unsigned char* ws = args.ws;
    const int lo = args.ph_lo, hi = args.ph_hi;
    for (int u = tid; u < (LDS_BYTES - RING_BYTES) / 4; u += NTHR) ((LAS unsigned*)(lds + RING_BYTES))[u] = 0u;
    __syncthreads();
    XcdBarrier bar; bar.bar = (unsigned*)(ws + WS_CTL) + CW_BAR; bar.x = 0; bar.st = MISC + 8;
    if (hi - lo > 1) bar = xcd_barrier_post((unsigned*)(ws + WS_CTL) + CW_BAR, MISC + 8);
    const Ctx C{lo, hi, tid, lane, wave, gw, NGW, gtid, NGT, G, bid};
#define IN(k) (lo <= (k) && (k) < hi)
#define SEAM(k) do { if (IN(k) && IN((k) + 1)) xcd_barrier(bar); } while (0)

    bf16* const Hb = (bf16*)(ws + WS_H); bf16* const MIX = (bf16*)(ws + WS_MIX); bf16* const Z = (bf16*)(ws + WS_Z); bf16* const HID = (bf16*)(ws + WS_Z);
    float* const OT = (float*)(ws + WS_OT); float* const XR = args.out;
    const float* const MODL = (const float*)(ws + WS_MODL);

    if (IN(0)) { p0_prologue(args, lds, gw, NGW, wave, lane); if (DUP_PRO) { xcd_barrier(bar); p0_prologue(args, lds, gw, NGW, wave, lane); } }
    SEAM(0);
    if (IN(1)) p1_modvec(args, gtid, NGT);
    SEAM(1);


    layer_pair<0>(args, C, lds, lds_raw, bar);
    layer_pair<1>(args, C, lds, lds_raw, bar);
    if (IN(34)) final_norm_phase(XR, args.in[7], XR, gw, NGW, lane);
#undef IN
#undef SEAM
}

extern "C" void kernel_launch(void* const* d_in, const int* in_sizes, int n_in, void* d_out, int out_size, void* d_ws, size_t ws_size, hipStream_t stream) {
    static int grid = 0;
    if (grid == 0) {
        if (n_in != 29 || in_sizes[0] != SEQ * DM || out_size != SEQ * DM || ws_size < WS_END + (DUP_ATTN ? (size_t)32 * GS * 4 : 0)) {
            fprintf(stderr, "kernel_launch: built for 29 inputs, x/out of %d floats, >= %zu bytes of workspace; got n_in %d, in0 %d, out %d, ws %zu; nothing launched\n", SEQ * DM, (size_t)WS_END, n_in, n_in > 0 ? in_sizes[0] : -1, out_size, ws_size); grid = -1; return; }
        int dev = 0, cus = 0, per_cu = 0;
        if (hipGetDevice(&dev) != hipSuccess || hipDeviceGetAttribute(&cus, hipDeviceAttributeMultiprocessorCount, dev) != hipSuccess) { fprintf(stderr, "kernel_launch: device query failed\n"); grid = -1; return; }
        if (hipFuncSetAttribute((const void*)trunk_fwd, hipFuncAttributeMaxDynamicSharedMemorySize, LDS_BYTES) != hipSuccess) { fprintf(stderr, "kernel_launch: hipFuncSetAttribute failed\n"); grid = -1; return; }
        if (hipOccupancyMaxActiveBlocksPerMultiprocessor(&per_cu, (const void*)trunk_fwd, NTHR, LDS_BYTES) != hipSuccess || per_cu < 1) { fprintf(stderr, "kernel_launch: occupancy query reports %d workgroups per CU\n", per_cu); }
        (void)hipGetLastError();
        grid = cus;
        fprintf(stderr, "kernel_launch: grid %d, occupancy %d, ws %zu (need %zu)\n", grid, per_cu, ws_size, (size_t)WS_END);
    }
    if (grid < 0) return;
    if (hipMemsetAsync((char*)d_ws + WS_CTL, 0, CTL_ZERO_BYTES, stream) != hipSuccess) { fprintf(stderr, "kernel_launch: memset failed\n"); return; }
    Args a{};
    for (int i = 0; i < 29; ++i) a.in[i] = (const float*)d_in[i];
    a.out = (float*)d_out; a.ws = (unsigned char*)d_ws;
#if MK_PER_PHASE
    for (int p = 0; p < N_PHASES; ++p) { a.ph_lo = p; a.ph_hi = p + 1; hipLaunchKernelGGL(trunk_fwd, dim3(grid), dim3(NTHR), LDS_BYTES, stream, a); }
#else
    a.ph_lo = 0; a.ph_hi = N_PHASES;
    hipLaunchKernelGGL(trunk_fwd, dim3(grid), dim3(NTHR), LDS_BYTES, stream, a);
#endif
    const hipError_t le = hipPeekAtLastError();
    if (le != hipSuccess) fprintf(stderr, "kernel_launch: launch failed: %s\n", hipGetErrorName(le));
}
```

```cpp
#include <hip/hip_runtime.h>
#include <hip/hip_bf16.h>
#include <cstdio>
#include <cstdint>
__device__ __forceinline__ int opaque_tid() { int t; asm volatile("v_mov_b32 %0, %1" : "=v"(t) : "v"((int)threadIdx.x)); return t; }
namespace pg8 {
#define PG8_LAS __attribute__((address_space(3)))
typedef unsigned short bf16_t;
typedef short bf16x8 __attribute__((ext_vector_type(8)));
typedef float f32x4 __attribute__((ext_vector_type(4)));
typedef unsigned u32x4 __attribute__((ext_vector_type(4)));
constexpr int BM = 256, BK = 64, HALF = 128, HTB = HALF * BK * 2  , STAGE_BYTES = 8 * HTB, NXCD = 8, WGM = 8;

__host__ __device__ __forceinline__ int lds_byte(int r, int c) { const int st = (r >> 4) * 2 + (c >> 5), rr = r & 15, cc = c & 31, ob = rr * 64 + cc * 2; return st * 1024 + (ob ^ (((ob >> 9) & 1) << 5)); }
__host__ __device__ __forceinline__ void stage_rc(int b, int& R, int& C) { const int st = b / 1024, sb = b % 1024, swz = sb ^ (((sb >> 9) & 1) << 5); R = (st >> 1) * 16 + swz / 64; C = (st & 1) * 32 + (swz % 64) / 2; }
__host__ __device__ __forceinline__ int perm32(int rho) { const int n = rho >> 4, i = rho & 15; return 8 * (i >> 2) + 4 * n + (i & 3); }

struct Unit { int pm, pn; };
struct Gemm { const bf16_t* A; const bf16_t* Bt; int M, N, K, lda, ldb; };

struct StaticOrder {
    int nM, nN, nwg, G, c, wgm;
    __host__ __device__ void init(int M, int N, int G_, int c_, int wgm_ = WGM) { nM = M / BM; nN = N / BM; nwg = nM * nN; G = G_; c = c_; wgm = wgm_; }
    __host__ __device__ bool next(int i, Unit& u) const {
        const long L = (long)i * G + c; if (L >= nwg) return false;
        int wgid = (int)L; { const int q = nwg / NXCD, r = nwg % NXCD, xcd = wgid % NXCD, off = wgid / NXCD; wgid = (xcd < r ? xcd * (q + 1) : r * (q + 1) + (xcd - r) * q) + off; }
        const int nig = wgm * nN, gid = wgid / nig, fm = gid * wgm, gsz = (nM - fm) < wgm ? (nM - fm) : wgm;
        u.pm = fm + ((wgid % nig) % gsz); u.pn = (wgid % nig) / gsz; return true;
    }
    __device__ __forceinline__ void a_ready(const Unit&) const {}
    __device__ __forceinline__ void done(const Unit&) const {}
};

__device__ __forceinline__ unsigned cvt_pk_bf16(float lo, float hi) { unsigned r; asm volatile("v_cvt_pk_bf16_f32 %0, %1, %2" : "=v"(r) : "v"(lo), "v"(hi)); return r; }
__device__ __forceinline__ float fast_sigmoid(float x) { return __builtin_amdgcn_rcpf(1.0f + __builtin_amdgcn_exp2f(-1.4426950408889634f * x)); }

struct EpiHeadMajor {
    static constexpr bool PERM = true, AFTER_DRAIN = false;
    bf16_t* O; size_t gstride;
    __device__ __forceinline__ void operator()(const f32x4 (&acc)[2][2][4][2], const Unit& u, int wr, int wc, int fr, int fq) const {
        const int row0 = u.pm * BM + wr * 64 + fr, col0 = wc * 32 + 8 * fq;
#pragma unroll
        for (int ai = 0; ai < 2; ++ai)
#pragma unroll
            for (int m = 0; m < 4; ++m) { const size_t ro = (size_t)(row0 + ai * HALF + m * 16) * 128 + col0;
#pragma unroll
                for (int bj = 0; bj < 2; ++bj) { const f32x4 v0 = acc[ai][bj][m][0], v1 = acc[ai][bj][m][1];
                    u32x4 w; w.x = cvt_pk_bf16(v0[0], v0[1]); w.y = cvt_pk_bf16(v0[2], v0[3]); w.z = cvt_pk_bf16(v1[0], v1[1]); w.w = cvt_pk_bf16(v1[2], v1[3]);
                    *(u32x4*)(O + (size_t)(2 * u.pn + bj) * gstride + ro) = w; } }
    }
};
template <bool BASE_F32> struct EpiResid {
    static constexpr bool PERM = true, AFTER_DRAIN = false;
    const void* base; bf16_t* out; const float* gate; int ldb, ldo;
    __device__ __forceinline__ void operator()(const f32x4 (&acc)[2][2][4][2], const Unit& u, int wr, int wc, int fr, int fq) const {
        const int row0 = u.pm * BM + wr * 64 + fr, col0 = u.pn * BM + wc * 32 + 8 * fq;
        f32x4 gv[2][2];
#pragma unroll
        for (int bj = 0; bj < 2; ++bj)
#pragma unroll
            for (int n = 0; n < 2; ++n) gv[bj][n] = *(const f32x4*)(gate + col0 + bj * HALF + 4 * n);
#pragma unroll
        for (int ai = 0; ai < 2; ++ai) {
            f32x4 b[4][2][2];
#pragma unroll
            for (int m = 0; m < 4; ++m) { const size_t off = (size_t)(row0 + ai * HALF + m * 16) * ldb + col0;
#pragma unroll
                for (int bj = 0; bj < 2; ++bj) {
                    if constexpr (BASE_F32) { b[m][bj][0] = *(const f32x4*)((const float*)base + off + bj * HALF); b[m][bj][1] = *(const f32x4*)((const float*)base + off + bj * HALF + 4); }
                    else { const u32x4 r = *(const u32x4*)((const bf16_t*)base + off + bj * HALF);
                        b[m][bj][0] = (f32x4){__builtin_bit_cast(float, r.x << 16), __builtin_bit_cast(float, r.x & 0xffff0000u), __builtin_bit_cast(float, r.y << 16), __builtin_bit_cast(float, r.y & 0xffff0000u)};
                        b[m][bj][1] = (f32x4){__builtin_bit_cast(float, r.z << 16), __builtin_bit_cast(float, r.z & 0xffff0000u), __builtin_bit_cast(float, r.w << 16), __builtin_bit_cast(float, r.w & 0xffff0000u)}; } } }
            asm volatile("" ::: "memory");
#pragma unroll
            for (int m = 0; m < 4; ++m) { const size_t off = (size_t)(row0 + ai * HALF + m * 16) * ldo + col0;
#pragma unroll
                for (int bj = 0; bj < 2; ++bj) { const f32x4 x0 = b[m][bj][0] + gv[bj][0] * acc[ai][bj][m][0], x1 = b[m][bj][1] + gv[bj][1] * acc[ai][bj][m][1];
                    u32x4 w; w.x = cvt_pk_bf16(x0[0], x0[1]); w.y = cvt_pk_bf16(x0[2], x0[3]); w.z = cvt_pk_bf16(x1[0], x1[1]); w.w = cvt_pk_bf16(x1[2], x1[3]);
                    *(u32x4*)(out + off + bj * HALF) = w; } }
            asm volatile("" ::: "memory"); }
    }
};
struct EpiSwiGLU {
    static constexpr bool PERM = true, AFTER_DRAIN = false;
    bf16_t* O; int ldc;
    __device__ __forceinline__ void operator()(const f32x4 (&acc)[2][2][4][2], const Unit& u, int wr, int wc, int fr, int fq) const {
        const int row0 = u.pm * BM + wr * 64 + fr, col0 = u.pn * HALF + wc * 32 + 8 * fq;
#pragma unroll
        for (int ai = 0; ai < 2; ++ai)
#pragma unroll
            for (int m = 0; m < 4; ++m) { bf16_t* rowp = O + (size_t)(row0 + ai * HALF + m * 16) * ldc + col0;
                float r[8];
#pragma unroll
                for (int n = 0; n < 2; ++n)
#pragma unroll
                    for (int j = 0; j < 4; ++j) { const float g = acc[ai][0][m][n][j], up = acc[ai][1][m][n][j]; r[n * 4 + j] = g * fast_sigmoid(g) * up; }
                u32x4 w; w.x = cvt_pk_bf16(r[0], r[1]); w.y = cvt_pk_bf16(r[2], r[3]); w.z = cvt_pk_bf16(r[4], r[5]); w.w = cvt_pk_bf16(r[6], r[7]);
                *(u32x4*)rowp = w; }
    }
};
struct EpiGluResid {
    static constexpr bool PERM = true, AFTER_DRAIN = false;
    const bf16_t* base; bf16_t* out; const float* gate; int ldc;
    __device__ __forceinline__ void operator()(const f32x4 (&acc)[2][2][4][2], const Unit& u, int wr, int wc, int fr, int fq) const {
        const int row0 = u.pm * BM + wr * 64 + fr, col0 = u.pn * HALF + wc * 32 + 8 * fq;
        f32x4 gv[2];
#pragma unroll
        for (int n = 0; n < 2; ++n) gv[n] = *(const f32x4*)(gate + col0 + 4 * n);
        u32x4 rb[2][4];
#pragma unroll
        for (int ai = 0; ai < 2; ++ai)
#pragma unroll
            for (int m = 0; m < 4; ++m) rb[ai][m] = *(const u32x4*)(base + (size_t)(row0 + ai * HALF + m * 16) * ldc + col0);
        asm volatile("" ::: "memory");
#pragma unroll
        for (int ai = 0; ai < 2; ++ai)
#pragma unroll
            for (int m = 0; m < 4; ++m) { const u32x4 r = rb[ai][m];
                const f32x4 b0 = {__builtin_bit_cast(float, r.x << 16), __builtin_bit_cast(float, r.x & 0xffff0000u), __builtin_bit_cast(float, r.y << 16), __builtin_bit_cast(float, r.y & 0xffff0000u)};
                const f32x4 b1 = {__builtin_bit_cast(float, r.z << 16), __builtin_bit_cast(float, r.z & 0xffff0000u), __builtin_bit_cast(float, r.w << 16), __builtin_bit_cast(float, r.w & 0xffff0000u)};
                f32x4 y0, y1;
#pragma unroll
                for (int j = 0; j < 4; ++j) { y0[j] = acc[ai][0][m][0][j] * fast_sigmoid(acc[ai][1][m][0][j]); y1[j] = acc[ai][0][m][1][j] * fast_sigmoid(acc[ai][1][m][1][j]); }
                const f32x4 x0 = b0 + gv[0] * y0, x1 = b1 + gv[1] * y1;
                u32x4 w; w.x = cvt_pk_bf16(x0[0], x0[1]); w.y = cvt_pk_bf16(x0[2], x0[3]); w.z = cvt_pk_bf16(x1[0], x1[1]); w.w = cvt_pk_bf16(x1[2], x1[3]);
                *(u32x4*)(out + (size_t)(row0 + ai * HALF + m * 16) * ldc + col0) = w; }
        asm volatile("" ::: "memory");
    }
};

template <class Epi, class Sched, bool ALIGN_EPI = false, bool SP2 = false>
__device__ __forceinline__ void gemm_phase(PG8_LAS unsigned char* lds, const Gemm g, const Sched& S, const Epi& E) {
    const int tid = opaque_tid(), wid = __builtin_amdgcn_readfirstlane(tid >> 6), lane = tid & 63, wr = wid >> 2, wc = wid & 3, fr = lane & 15, fq = lane >> 4;
    const int K = g.K, nt = K / BK;
    unsigned voffA[2], voffB[2];
#pragma unroll
    for (int i = 0; i < 2; ++i) { int R, C; stage_rc(tid * 16 + i * 8192, R, C); const int Rb = Epi::PERM ? ((R & ~31) + perm32(R & 31)) : R;
        voffA[i] = (unsigned)(R * g.lda + C) * 2u; voffB[i] = (unsigned)(Rb * g.ldb + C) * 2u; }
    const size_t kstep = (size_t)(BK * 2);
    const size_t hstepA = (size_t)HALF * g.lda * 2, hstepB = (size_t)HALF * g.ldb * 2;
    const size_t tstepA = 2 * hstepA, tstepB = 2 * hstepB;
    const unsigned ldsw = (unsigned)wid * 1024u;
    const int aoff = lds_byte(wr * 64 + fr, fq * 8), boff = lds_byte(wc * 32 + fr, fq * 8);
#define PG8_SA(b, h) (((b) * 2 + (h)) * HTB)
#define PG8_SB(b, h) ((4 + (b) * 2 + (h)) * HTB)
#define PG8_STAGE(bufoff, gbase, voff) do { _Pragma("unroll") for (int _i = 0; _i < 2; ++_i) \
        __builtin_amdgcn_global_load_lds((const unsigned*)((const char*)(gbase) + (voff)[_i]), (PG8_LAS unsigned*)(lds + (bufoff) + ldsw + _i * 8192), 16, 0, 0); } while (0)
#define PG8_LDA(dst, b, h) do { _Pragma("unroll") for (int m = 0; m < 4; ++m) _Pragma("unroll") for (int k = 0; k < 2; ++k) dst[m][k] = *(const PG8_LAS bf16x8*)(lds + PG8_SA(b, h) + aoff + m * 2048 + k * 1024); } while (0)
#define PG8_LDB(dst, b, h) do { _Pragma("unroll") for (int n = 0; n < 2; ++n) _Pragma("unroll") for (int k = 0; k < 2; ++k) dst[n][k] = *(const PG8_LAS bf16x8*)(lds + PG8_SB(b, h) + boff + n * 2048 + k * 1024); } while (0)
#define PG8_MMA(ai, bj, At, Bt) do { __builtin_amdgcn_s_setprio(3); _Pragma("unroll") for (int m = 0; m < 4; ++m) _Pragma("unroll") for (int n = 0; n < 2; ++n) _Pragma("unroll") for (int k = 0; k < 2; ++k) \
        acc[ai][bj][m][n] = __builtin_amdgcn_mfma_f32_16x16x32_bf16(Bt[n][k], At[m][k], acc[ai][bj][m][n], 0, 0, 0); __builtin_amdgcn_s_setprio(0); } while (0)
#define PG8_WAIT_V(n) asm volatile("s_waitcnt vmcnt(" #n ")" ::: "memory")
#define PG8_WAIT_L(n) asm volatile("s_waitcnt lgkmcnt(" #n ")" ::: "memory")
#define PG8_BAR __builtin_amdgcn_s_barrier()
#define PG8_SCHED __builtin_amdgcn_sched_barrier(0)
    Unit cur, nxt; int ui = 0;
    if (!S.next(0, cur)) return;
    f32x4 acc[2][2][4][2];
#pragma unroll
    for (int a = 0; a < 2; ++a)
#pragma unroll
        for (int b = 0; b < 2; ++b)
#pragma unroll
            for (int m = 0; m < 4; ++m)
#pragma unroll
                for (int n = 0; n < 2; ++n) acc[a][b][m][n] = (f32x4){0.f, 0.f, 0.f, 0.f};
    bf16x8 At[4][2], B0[2][2], B1[2][2];
    const char* cA = (const char*)g.A + (size_t)cur.pm * tstepA; const char* cB = (const char*)g.Bt + (size_t)cur.pn * tstepB;
    S.a_ready(cur);
    if constexpr (SP2) {
        PG8_STAGE(PG8_SB(0, 0), cB, voffB); PG8_STAGE(PG8_SB(0, 1), cB + hstepB, voffB); PG8_STAGE(PG8_SA(0, 0), cA, voffA); PG8_STAGE(PG8_SA(0, 1), cA + hstepA, voffA);
        if (wr == 1) PG8_BAR;
        PG8_WAIT_V(2); PG8_BAR;
        PG8_STAGE(PG8_SB(1, 0), cB + kstep, voffB); PG8_STAGE(PG8_SB(1, 1), cB + hstepB + kstep, voffB);
        PG8_WAIT_V(4); PG8_BAR;
    } else {
        PG8_STAGE(PG8_SB(0, 0), cB, voffB); PG8_STAGE(PG8_SA(0, 0), cA, voffA); PG8_STAGE(PG8_SB(0, 1), cB + hstepB, voffB); PG8_STAGE(PG8_SA(0, 1), cA + hstepA, voffA);
        if (wr == 1) PG8_BAR;
        PG8_WAIT_V(4); PG8_BAR;
        PG8_STAGE(PG8_SB(1, 0), cB + kstep, voffB); PG8_STAGE(PG8_SA(1, 0), cA + kstep, voffA); PG8_STAGE(PG8_SB(1, 1), cB + hstepB + kstep, voffB);
        PG8_WAIT_V(6); PG8_BAR;
    }
    for (;;) {
        const bool has_next = S.next(ui + 1, nxt);
        const char* nA = has_next ? (const char*)g.A + (size_t)nxt.pm * tstepA : cA; const char* nB = has_next ? (const char*)g.Bt + (size_t)nxt.pn * tstepB : cB;
        for (int t = 0; t < nt; t += 2) {
            const bool last = (t == nt - 2);
            const char* a1 = cA + (size_t)(t + 1) * kstep;
            const char* a2 = last ? nA : cA + (size_t)(t + 2) * kstep; const char* b2 = last ? nB : cB + (size_t)(t + 2) * kstep;
            const char* a3 = a2 + kstep; const char* b3 = b2 + kstep;
            if (last && has_next) S.a_ready(nxt);
            if constexpr (SP2) {
            PG8_LDB(B0, 0, 0); PG8_LDB(B1, 0, 1); PG8_SCHED; PG8_LDA(At, 0, 0); PG8_STAGE(PG8_SA(1, 0), a1, voffA); PG8_STAGE(PG8_SA(1, 1), a1 + hstepA, voffA);
            PG8_WAIT_V(8); PG8_WAIT_L(0); PG8_BAR; PG8_MMA(0, 0, At, B0); PG8_MMA(0, 1, At, B1); PG8_BAR; PG8_SCHED;
            PG8_LDA(At, 0, 1); PG8_STAGE(PG8_SB(0, 0), b2, voffB); PG8_STAGE(PG8_SB(0, 1), b2 + hstepB, voffB);
            PG8_WAIT_V(6); PG8_WAIT_L(0); PG8_BAR; PG8_MMA(1, 0, At, B0); PG8_MMA(1, 1, At, B1); PG8_BAR; PG8_SCHED;
            PG8_LDB(B0, 1, 0); PG8_LDB(B1, 1, 1); PG8_SCHED; PG8_LDA(At, 1, 0); PG8_STAGE(PG8_SA(0, 0), a2, voffA); PG8_STAGE(PG8_SA(0, 1), a2 + hstepA, voffA);
            PG8_WAIT_V(8); PG8_WAIT_L(0); PG8_BAR; PG8_MMA(0, 0, At, B0); PG8_MMA(0, 1, At, B1); PG8_BAR; PG8_SCHED;
            PG8_LDA(At, 1, 1); PG8_STAGE(PG8_SB(1, 0), b3, voffB); PG8_STAGE(PG8_SB(1, 1), b3 + hstepB, voffB);
            PG8_WAIT_V(6); PG8_WAIT_L(0); PG8_BAR; PG8_MMA(1, 0, At, B0); PG8_MMA(1, 1, At, B1); PG8_BAR; PG8_SCHED;
            } else {
            PG8_LDB(B0, 0, 0); PG8_SCHED; PG8_LDA(At, 0, 0); PG8_STAGE(PG8_SA(1, 1), a1 + hstepA, voffA);
            PG8_WAIT_L(8); PG8_BAR; PG8_WAIT_L(0); PG8_MMA(0, 0, At, B0); PG8_BAR; PG8_SCHED;
            PG8_LDB(B1, 0, 1); PG8_STAGE(PG8_SB(0, 0), b2, voffB);
            PG8_BAR; PG8_WAIT_L(0); PG8_MMA(0, 1, At, B1); PG8_BAR;
            PG8_LDA(At, 0, 1); PG8_STAGE(PG8_SA(0, 0), a2, voffA);
            PG8_BAR; PG8_WAIT_L(0); PG8_MMA(1, 0, At, B0); PG8_BAR; PG8_SCHED;
            PG8_STAGE(PG8_SB(0, 1), b2 + hstepB, voffB);
            PG8_WAIT_V(6); PG8_BAR; PG8_MMA(1, 1, At, B1); PG8_BAR;
            PG8_LDB(B0, 1, 0); PG8_SCHED; PG8_LDA(At, 1, 0); PG8_STAGE(PG8_SA(0, 1), a2 + hstepA, voffA);
            PG8_WAIT_L(8); PG8_BAR; PG8_WAIT_L(0); PG8_MMA(0, 0, At, B0); PG8_BAR; PG8_SCHED;
            PG8_LDB(B1, 1, 1); PG8_STAGE(PG8_SB(1, 0), b3, voffB);
            PG8_BAR; PG8_WAIT_L(0); PG8_MMA(0, 1, At, B1); PG8_BAR;
            PG8_LDA(At, 1, 1); PG8_STAGE(PG8_SA(1, 0), a3, voffA);
            PG8_BAR; PG8_WAIT_L(0); PG8_MMA(1, 0, At, B0); PG8_BAR; PG8_SCHED;
            PG8_STAGE(PG8_SB(1, 1), b3 + hstepB, voffB);
            PG8_WAIT_V(6); PG8_BAR; PG8_MMA(1, 1, At, B1); PG8_BAR;
            }
        }
        if constexpr (ALIGN_EPI) { if (wr == 0) PG8_BAR; }
        if constexpr (!Epi::AFTER_DRAIN) { E(acc, cur, wr, wc, fr, fq); S.done(cur); }
        if (!has_next) break;
#pragma unroll
        for (int a = 0; a < 2; ++a)
#pragma unroll
            for (int b = 0; b < 2; ++b)
#pragma unroll
                for (int m = 0; m < 4; ++m)
#pragma unroll
                    for (int n = 0; n < 2; ++n) acc[a][b][m][n] = (f32x4){0.f, 0.f, 0.f, 0.f};
        cur = nxt; cA = nA; cB = nB; ++ui;
        if constexpr (ALIGN_EPI) { if (wr == 1) PG8_BAR; }
    }
    PG8_WAIT_V(0);
    if constexpr (!ALIGN_EPI) { if (wr == 0) PG8_BAR; }
    PG8_BAR;
    if constexpr (Epi::AFTER_DRAIN) { E.fused(acc, cur, wr, wc, fr, fq, lds, wid, lane); S.done(cur); }
#undef PG8_SA
#undef PG8_SB
#undef PG8_STAGE
#undef PG8_LDA
#undef PG8_LDB
#undef PG8_MMA
#undef PG8_WAIT_V
#undef PG8_WAIT_L
#undef PG8_BAR
#undef PG8_SCHED
}
}

namespace att {
constexpr int D = 128;
constexpr float THR = 8.f;
constexpr bool WSKIP = false;
constexpr float SCALE = 0.08838834764831845f;
constexpr int NW = 8, QBLK = 32, KVBLK = 64, QB = NW * QBLK;
constexpr int SHM_V = KVBLK * D * 2, SHM_K = KVBLK * D * 2;
constexpr int LDS_BYTES = 2 * SHM_V + 2 * SHM_K + NW * 64 * 4;

using bf16 = __hip_bfloat16;
typedef short bf16x8 __attribute__((ext_vector_type(8)));
typedef short s16x4 __attribute__((ext_vector_type(4)));
typedef float f32x16 __attribute__((ext_vector_type(16)));
typedef float f32x4 __attribute__((ext_vector_type(4)));
typedef unsigned u32x4 __attribute__((ext_vector_type(4)));
template <class A, class Bt> struct same_t { static constexpr bool v = false; };
template <class A> struct same_t<A, A> { static constexpr bool v = true; };

#define KSWZ(row, colB) ((row) * 256 + ((colB) ^ (((row) & 7) << 4)))
#define SBAR() __builtin_amdgcn_sched_barrier(0)
__device__ __forceinline__ int v_st(int k, int c) { const int kk = (k & ~0xC) | ((k & 4) << 1) | ((k & 8) >> 1); return ((kk >> 3) * 4 + (c >> 5)) * 512 + ((kk & 7) * 32 + (c & 31)) * 2; }
__device__ __forceinline__ int v_rd_base(int lane) { return ((lane & 3) << 3) | (((lane >> 2) & 3) << 6) | (((lane >> 4) & 1) << 5) | (((lane >> 5) & 1) << 8); }
constexpr int v_rd_off(int d0, int ks, int half) { return d0 * 512 + ks * 4096 + half * 2048; }
__device__ __forceinline__ int crow(int r, int hi) { return (r & 3) + 8 * (r >> 2) + 4 * hi; }
__device__ __forceinline__ unsigned cvtpk(float lo, float hi) {
    unsigned r; asm volatile("v_cvt_pk_bf16_f32 %0, %1, %2" : "=v"(r) : "v"(lo), "v"(hi)); return r;
}
__device__ __forceinline__ bf16x8 pack8(f32x4 a, f32x4 b) {
    u32x4 w = {cvtpk(a[0], a[1]), cvtpk(a[2], a[3]), cvtpk(b[0], b[1]), cvtpk(b[2], b[3])};
    return *reinterpret_cast<bf16x8*>(&w);
}
template <class T> __device__ __forceinline__ bf16x8 load8(const T* p) {
    if constexpr (same_t<T, float>::v) { return pack8(*(const f32x4*)p, *(const f32x4*)(p + 4)); }
    else { return *reinterpret_cast<const bf16x8*>(p); }
}
__device__ __forceinline__ void mask_tile(f32x16& p0, f32x16& p1, int dq, unsigned W) {
    const float NEG = -__builtin_inff();
#pragma unroll
    for (int r = 0; r < 16; ++r) {
        const int c = (r & 3) + 8 * (r >> 2);
        if ((unsigned)(dq - c) >= W) p0[r] = NEG;
        if ((unsigned)(dq - c - 32) >= W) p1[r] = NEG;
    }
}
__device__ __forceinline__ void partialSM(f32x16& p0, f32x16& p1, float& m_reg, float& mn, float& alpha) {
    float pmax = p0[0]; for (int r = 1; r < 16; ++r) pmax = fmaxf(pmax, p0[r]); for (int r = 0; r < 16; ++r) pmax = fmaxf(pmax, p1[r]);
    { auto rr = __builtin_amdgcn_permlane32_swap(__float_as_uint(pmax), __float_as_uint(pmax), false, false);
      pmax = fmaxf(__uint_as_float(rr[0]), __uint_as_float(rr[1])); }
    constexpr float C2 = 1.4426950408889634f * SCALE;
    if (__builtin_expect(__all((pmax - m_reg) * SCALE <= THR), 1)) { mn = m_reg; alpha = 1.f; }
    else { mn = fmaxf(m_reg, pmax); alpha = __builtin_amdgcn_exp2f((m_reg - mn) * C2); m_reg = mn; }
    const float mnL = -mn * C2;
    for (int r = 0; r < 16; ++r) p0[r] = fmaf(p0[r], C2, mnL); for (int r = 0; r < 16; ++r) p1[r] = fmaf(p1[r], C2, mnL);
    for (int r = 0; r < 16; ++r) p0[r] = __builtin_amdgcn_exp2f(p0[r]);
}
__device__ __forceinline__ void finishSM(f32x16& p0, f32x16& p1, float alpha, float& l_reg, bf16x8& pa0, bf16x8& pa1, bf16x8& pa2, bf16x8& pa3) {
    for (int r = 0; r < 16; ++r) p1[r] = __builtin_amdgcn_exp2f(p1[r]);
    float ps = 0; for (int r = 0; r < 16; ++r) ps += p0[r]; for (int r = 0; r < 16; ++r) ps += p1[r];
    { auto rr = __builtin_amdgcn_permlane32_swap(__float_as_uint(ps), __float_as_uint(ps), false, false);
      ps = __uint_as_float(rr[0]) + __uint_as_float(rr[1]); }
    l_reg = l_reg * alpha + ps;
#define PK4(P, B_, OUT) do { unsigned a0 = cvtpk(P[B_+0], P[B_+1]), a1 = cvtpk(P[B_+2], P[B_+3]);                          \
        unsigned b0 = cvtpk(P[B_+4], P[B_+5]), b1 = cvtpk(P[B_+6], P[B_+7]);                                             \
        auto r0 = __builtin_amdgcn_permlane32_swap(a0, b0, false, false); auto r1 = __builtin_amdgcn_permlane32_swap(a1, b1, false, false); \
        u32x4 w = {r0[0], r1[0], r0[1], r1[1]}; OUT = *reinterpret_cast<bf16x8*>(&w); } while (0)
    PK4(p0, 0, pa0); PK4(p0, 8, pa1); PK4(p1, 0, pa2); PK4(p1, 8, pa3);
#undef PK4
}
template <int KB, bool SK>
__device__ __forceinline__ void qkt(f32x16& p0, f32x16& p1, const char* K_lds, int r32, int hi, const bf16x8* qr, bool act) {
    if (SK && !act) { const float NEG = -__builtin_inff();
#pragma unroll
        for (int r = 0; r < 16; ++r) { p0[r] = NEG; p1[r] = NEG; } return; }
    p0 = f32x16{}; p1 = f32x16{};
    const char* kb[4];
#pragma unroll
    for (int dd = 0; dd < 4; ++dd) kb[dd] = K_lds + KB * SHM_K + KSWZ(r32, (dd * 16 + hi * 8) * 2);
#pragma unroll
    for (int d0 = 0; d0 < 8; ++d0) { const char* a = kb[d0 & 3] + (d0 >> 2) * 128;
        bf16x8 b0 = *reinterpret_cast<const bf16x8*>(a);
        bf16x8 b1 = *reinterpret_cast<const bf16x8*>(a + 32 * 256);
        p0 = __builtin_amdgcn_mfma_f32_32x32x16_bf16(b0, qr[d0], p0, 0, 0, 0);
        p1 = __builtin_amdgcn_mfma_f32_32x32x16_bf16(b1, qr[d0], p1, 0, 0, 0); }
}
template <int VB, bool SK>
__device__ __forceinline__ void pv_tile(f32x16* o, int vb0, bf16x8 pa0, bf16x8 pa1, bf16x8 pa2, bf16x8 pa3, bool act) {
    if (SK && !act) return;
#define TRRD(dst, off) asm volatile("ds_read_b64_tr_b16 %0, %1 offset:%2" : "=&v"(dst) : "v"(vb0), "i"(off) : "memory")
#define PV_D0(d0) do { s16x4 l0, l1, l2, l3, h0, h1, h2, h3; constexpr int b_ = VB * SHM_V + v_rd_off(d0, 0, 0);     \
        TRRD(l0, b_); TRRD(h0, b_ + 2048); TRRD(l1, b_ + 4096); TRRD(h1, b_ + 6144); TRRD(l2, b_ + 8192); TRRD(h2, b_ + 10240); TRRD(l3, b_ + 12288); TRRD(h3, b_ + 14336); \
        asm volatile("s_waitcnt lgkmcnt(0)" ::: "memory"); SBAR();                 \
        o[d0] = __builtin_amdgcn_mfma_f32_32x32x16_bf16(pa0, (bf16x8){l0[0], l0[1], l0[2], l0[3], h0[0], h0[1], h0[2], h0[3]}, o[d0], 0, 0, 0);   \
        o[d0] = __builtin_amdgcn_mfma_f32_32x32x16_bf16(pa1, (bf16x8){l1[0], l1[1], l1[2], l1[3], h1[0], h1[1], h1[2], h1[3]}, o[d0], 0, 0, 0);   \
        o[d0] = __builtin_amdgcn_mfma_f32_32x32x16_bf16(pa2, (bf16x8){l2[0], l2[1], l2[2], l2[3], h2[0], h2[1], h2[2], h2[3]}, o[d0], 0, 0, 0);   \
        o[d0] = __builtin_amdgcn_mfma_f32_32x32x16_bf16(pa3, (bf16x8){l3[0], l3[1], l3[2], l3[3], h3[0], h3[1], h3[2], h3[3]}, o[d0], 0, 0, 0); } while (0)
    PV_D0(0); PV_D0(1); PV_D0(2); PV_D0(3);
#undef PV_D0
#undef TRRD
}

template <class TIn, class TOut> struct BlockRef { const TIn* Q; const TIn* K; const TIn* V; TOut* O; int P0; };
template <class TIn> struct Seam {
    bf16x8 qr[8];
    bf16x8 st_v0, st_v1, st_k0, st_k1; f32x4 sf0, sf1, sf2, sf3;
    f32x4 tq[16];
};
__device__ __forceinline__ int swa_jlo(int P0, int W) { const int lowk = P0 - W + 1; return lowk > 0 ? lowk / KVBLK : 0; }
#define ROW(p, k0, rr) ((p) + (size_t)((k0) + (rr)) * D + sc)
#define VMW() asm volatile("s_waitcnt vmcnt(0)" ::: "memory")
#define VMWN(n) asm volatile("s_waitcnt vmcnt(%0)" :: "i"(n) : "memory")
#define SLOAD_H(Kp, Vp, k0) do { S.st_v0 = load8<TIn>(ROW(Vp, k0, sr)); S.st_v1 = load8<TIn>(ROW(Vp, k0, 32 + sr));              \
                         S.st_k0 = load8<TIn>(ROW(Kp, k0, sr)); S.st_k1 = load8<TIn>(ROW(Kp, k0, 32 + sr)); } while (0)
#define SWRITE_HK(bf) do { *(bf16x8*)(K_lds + (bf) * SHM_K + kws) = S.st_k0; *(bf16x8*)(K_lds + (bf) * SHM_K + kws + 32 * 256) = S.st_k1; } while (0)
#define SWRITE_HV(bf) do { *(bf16x8*)(V_lds + (bf) * SHM_V + vst0) = S.st_v0; *(bf16x8*)(V_lds + (bf) * SHM_V + vst1) = S.st_v1; } while (0)
#define SWRITE_H(bf) do { SWRITE_HV(bf); SWRITE_HK(bf); } while (0)
#define SLOAD_F(p, k0) do { S.sf0 = *(const f32x4*)ROW(p, k0, sr); S.sf1 = *(const f32x4*)(ROW(p, k0, sr) + 4);                \
                            S.sf2 = *(const f32x4*)ROW(p, k0, 32 + sr); S.sf3 = *(const f32x4*)(ROW(p, k0, 32 + sr) + 4); } while (0)
#define SWRITE_KF(bf) do { *(bf16x8*)(K_lds + (bf) * SHM_K + kws) = pack8(S.sf0, S.sf1); *(bf16x8*)(K_lds + (bf) * SHM_K + kws + 32 * 256) = pack8(S.sf2, S.sf3); } while (0)
#define SWRITE_VF(bf) do { *(bf16x8*)(V_lds + (bf) * SHM_V + vst0) = pack8(S.sf0, S.sf1); *(bf16x8*)(V_lds + (bf) * SHM_V + vst1) = pack8(S.sf2, S.sf3); } while (0)
template <class TIn, class TOut>
__device__ __forceinline__ void causal_swa_prime(const BlockRef<TIn, TOut>& cur, int W, char* lds, Seam<TIn>& S) {
    constexpr bool F32 = same_t<TIn, float>::v;
    const int tid = opaque_tid(), wid = __builtin_amdgcn_readfirstlane(tid >> 6), lane = tid & 63, r32 = lane & 31, hi = lane >> 5;
    const int sr = tid >> 4, sc = (tid & 15) * 8, kws = KSWZ(sr, sc * 2); char* K_lds = lds + 2 * SHM_V;
    const int kb0 = swa_jlo(cur.P0, W) * KVBLK;
    for (int d0 = 0; d0 < 8; ++d0) S.qr[d0] = load8<TIn>(cur.Q + (size_t)(wid * QBLK + r32) * D + d0 * 16 + hi * 8);
    if constexpr (F32) { SLOAD_F((const float*)cur.K, kb0); VMW(); SWRITE_KF(0); SBAR(); SLOAD_F((const float*)cur.V, kb0); }
    else { SLOAD_H(cur.K, cur.V, kb0); VMW(); SWRITE_HK(0); }
    __syncthreads();
}
template <class TIn, class TOut>
__device__ __forceinline__ void causal_swa_block(const BlockRef<TIn, TOut>& cur, const BlockRef<TIn, TOut>& nxt, int skv, int W, char* lds, Seam<TIn>& S) {
    constexpr bool F32 = same_t<TIn, float>::v;
    const int tid = opaque_tid(), wid = __builtin_amdgcn_readfirstlane(tid >> 6), lane = tid & 63, r32 = lane & 31, hi = lane >> 5;
    const int j_lo = swa_jlo(cur.P0, W);
    int j_hi = (cur.P0 + QB - 1) / KVBLK + 1; if (j_hi > skv / KVBLK) j_hi = skv / KVBLK;
    const int NT = j_hi - j_lo;
    const int kbn = swa_jlo(nxt.P0, W) * KVBLK;
    const int qlo = cur.P0 + wid * QBLK, qm = qlo + r32 - 4 * hi;
    char* V_lds = lds; char* K_lds = lds + 2 * SHM_V;
    float* ws = (float*)(lds + 2 * SHM_V + 2 * SHM_K) + wid * 64; float* li_l = ws, * al_l = ws + 32;
    float m_reg = -1e30f, l_reg = 0; f32x16 o[4] = {};
    const int sr = tid >> 4, sc = (tid & 15) * 8, vst0 = v_st(sr, sc), vst1 = v_st(32 + sr, sc), kws = KSWZ(sr, sc * 2);
    const int vb0 = (int)(uintptr_t)V_lds + v_rd_base(lane);
    const TIn* Kh = cur.K; const TIn* Vh = cur.V;
#define RESC(a) do { if (__any((a) < 1.f)) { if (hi == 0) al_l[r32] = (a); asm volatile("s_waitcnt lgkmcnt(0)" ::: "memory");              \
                     for (int d_ = 0; d_ < 4; ++d_) for (int r = 0; r < 16; ++r) o[d_][r] *= al_l[crow(r, hi)]; } } while (0)
#define KBASE(t) ((j_lo + (t)) * KVBLK)
#define ACT(t) (KBASE(t) <= qlo + QBLK - 1 && KBASE(t) + KVBLK - 1 >= qlo - W + 1)
#define MASKT(P0_, P1_, t) do { const int kb_ = KBASE(t); if ((!SK || ACT(t)) && (kb_ + KVBLK - 1 > qlo || kb_ <= qlo + QBLK - 1 - W)) mask_tile(P0_, P1_, qm - kb_, (unsigned)W); } while (0)
    constexpr int NQL = F32 ? 16 : 8;
    constexpr bool SK = WSKIP && !F32;
#define SEAM_K0() do { VMWN(NQL); if constexpr (F32) { SWRITE_KF(0); SBAR(); SLOAD_F((const float*)nxt.V, kbn); } else { SWRITE_HK(0); } SBAR(); } while (0)
    f32x16 pA0, pA1, pB0, pB1; float mnA, mnB, alA, alB; bf16x8 pa0, pa1, pa2, pa3;
    if constexpr (F32) { VMW(); SWRITE_VF(0); SBAR(); } else { SWRITE_HV(0); SBAR(); }
    if (NT > 1) { if constexpr (F32) SLOAD_F((const float*)Kh, KBASE(1)); else SLOAD_H(Kh, Vh, KBASE(1)); }
    SBAR(); qkt<0, SK>(pA0, pA1, K_lds, r32, hi, S.qr, ACT(0));
    if constexpr (F32) { if (NT > 1) { VMW(); SWRITE_KF(1); SBAR(); SLOAD_F((const float*)Vh, KBASE(1)); } }
    MASKT(pA0, pA1, 0); partialSM(pA0, pA1, m_reg, mnA, alA);
    if (NT > 1) { VMW(); if constexpr (F32) { SWRITE_VF(1); SBAR(); if (NT > 2) SLOAD_F((const float*)Kh, KBASE(2)); } else SWRITE_H(1); }
    __syncthreads();
#define HALF_STEP(PX0, PX1, mnX, alX, PY0, PY1, alY, t, KB, VB, SB) do {                                                      \
        SBAR(); qkt<KB, SK>(PX0, PX1, K_lds, r32, hi, S.qr, ACT(t));                                             \
        finishSM(PY0, PY1, alY, l_reg, pa0, pa1, pa2, pa3); SBAR();                                                           \
        if ((t) + 1 < NT) { if constexpr (F32) { VMW(); SWRITE_KF(SB); SBAR(); SLOAD_F((const float*)Vh, KBASE((t) + 1)); }  \
                            else { SLOAD_H(Kh, Vh, KBASE((t) + 1)); } SBAR(); }                                               \
        pv_tile<VB, SK>(o, vb0, pa0, pa1, pa2, pa3, ACT((t) - 1)); MASKT(PX0, PX1, (t)); partialSM(PX0, PX1, m_reg, mnX, alX);                                        \
        __syncthreads();                                                                                                      \
        if ((t) + 1 < NT) { VMW(); if constexpr (F32) { SWRITE_VF(SB); SBAR(); if ((t) + 2 < NT) SLOAD_F((const float*)Kh, KBASE((t) + 2)); } \
                            else { SWRITE_H(SB); } }                                                                          \
        RESC(alX); __syncthreads(); } while (0)
    for (int t = 1; t + 1 < NT; t += 2) {
        HALF_STEP(pB0, pB1, mnB, alB, pA0, pA1, alA, t, 1, 0, 0);
        HALF_STEP(pA0, pA1, mnA, alA, pB0, pB1, alB, t + 1, 0, 1, 1);
    }
    const bool even = (NT & 1) == 0;
    if (even) { SBAR(); qkt<1, SK>(pB0, pB1, K_lds, r32, hi, S.qr, ACT(NT - 1)); SBAR(); }
#define QROW(e) (nxt.Q + (size_t)(wid * QBLK + r32) * D + ((e) >> 1) * 16 + hi * 8 + ((e) & 1) * 4)
    if constexpr (F32) { SLOAD_F((const float*)nxt.K, kbn); SBAR();
#pragma unroll
        for (int e = 0; e < 8; ++e) S.tq[e] = *(const f32x4*)QROW(e); }
    else { SLOAD_H(nxt.K, nxt.V, kbn); SBAR();
#pragma unroll
        for (int d0 = 0; d0 < 8; ++d0) S.qr[d0] = load8<TIn>(nxt.Q + (size_t)(wid * QBLK + r32) * D + d0 * 16 + hi * 8); }
    SBAR();
    finishSM(pA0, pA1, alA, l_reg, pa0, pa1, pa2, pa3); SBAR();
    if constexpr (F32) {
#pragma unroll
        for (int e = 8; e < 16; ++e) S.tq[e] = *(const f32x4*)QROW(e); SBAR(); }
#undef QROW
    pv_tile<0, SK>(o, vb0, pa0, pa1, pa2, pa3, ACT(even ? NT - 2 : NT - 1));
    if (even) { MASKT(pB0, pB1, NT - 1); partialSM(pB0, pB1, m_reg, mnB, alB); __syncthreads(); RESC(alB);
        finishSM(pB0, pB1, alB, l_reg, pa0, pa1, pa2, pa3); SBAR(); pv_tile<1, SK>(o, vb0, pa0, pa1, pa2, pa3, ACT(NT - 1)); }
    SBAR(); SEAM_K0();
    if (hi == 0) li_l[r32] = l_reg; asm volatile("s_waitcnt lgkmcnt(0)" ::: "memory");
    float rli[16];
#pragma unroll
    for (int r = 0; r < 16; ++r) rli[r] = __builtin_amdgcn_rcpf(li_l[crow(r, hi)]);
    TOut* Ow = cur.O + (size_t)(wid * QBLK) * D;
#pragma unroll
    for (int r = 0; r < 16; ++r) { const int orow = crow(r, hi);
#pragma unroll
        for (int d0 = 0; d0 < 4; ++d0) { const float v = o[d0][r] * rli[r];
            if constexpr (same_t<TOut, float>::v) { Ow[(size_t)orow * D + d0 * 32 + r32] = v; }
            else { const float vn = __shfl_xor(v, 1);
                   if ((r32 & 1) == 0) *(unsigned*)(Ow + (size_t)orow * D + d0 * 32 + r32) = cvtpk(v, vn); } } }
    if constexpr (F32) {
#pragma unroll
        for (int d0 = 0; d0 < 8; ++d0) S.qr[d0] = pack8(S.tq[2 * d0], S.tq[2 * d0 + 1]); }
    __syncthreads();
#undef RESC
#undef KBASE
#undef ACT
#undef MASKT
#undef SEAM_K0
#undef HALF_STEP
}
#undef ROW
#undef VMW
#undef VMWN
#undef SLOAD_H
#undef SWRITE_HK
#undef SWRITE_HV
#undef SWRITE_H
#undef SLOAD_F
#undef SWRITE_KF
#undef SWRITE_VF
#undef KSWZ
#undef SBAR
}

namespace att2 {
typedef short bf16x8 __attribute__((ext_vector_type(8)));
typedef short s16x4 __attribute__((ext_vector_type(4)));
typedef float f32x16 __attribute__((ext_vector_type(16)));
typedef unsigned u32x4 __attribute__((ext_vector_type(4)));
constexpr float SCALE = 0.08838834764831845f, THR = 8.f, C2 = 1.4426950408889634f * SCALE;
constexpr int V_OFF = 0, K_OFF = 65536, PX_OFF = 98304, MX_OFF = 114688, WS_OFF = 118784, LDS_NEED = 120832;
#define A2_KSWZ(row, colB) ((row) * 256 + ((colB) ^ (((row) & 7) << 4)))
#define A2_SBAR() __builtin_amdgcn_sched_barrier(0)
template <int KB>
__device__ __forceinline__ void qkt(f32x16& p, const char* Kl, int krow, int hi, const bf16x8* qr) {
    p = f32x16{};
    const char* kbp[4];
#pragma unroll
    for (int dd = 0; dd < 4; ++dd) kbp[dd] = Kl + KB * 16384 + A2_KSWZ(krow, (dd * 16 + hi * 8) * 2);
    bf16x8 b[8];
#pragma unroll
    for (int d0 = 0; d0 < 8; ++d0) b[d0] = *reinterpret_cast<const bf16x8*>(kbp[d0 & 3] + (d0 >> 2) * 128);
    __builtin_amdgcn_s_setprio(3);
#pragma unroll
    for (int d0 = 0; d0 < 8; ++d0) p = __builtin_amdgcn_mfma_f32_32x32x16_bf16(b[d0], qr[d0], p, 0, 0, 0);
    __builtin_amdgcn_s_setprio(0);
}
template <int VOFFB>
__device__ __forceinline__ void pv(f32x16* o, int vb0, bf16x8 pa0, bf16x8 pa1, bf16x8 pa2, bf16x8 pa3) {
#define A2_TRRD(dst, off) asm volatile("ds_read_b64_tr_b16 %0, %1 offset:%2" : "=&v"(dst) : "v"(vb0), "i"(off) : "memory")
#define A2_PV_D0(d0) do { s16x4 l0, l1, l2, l3, h0, h1, h2, h3; constexpr int b_ = VOFFB + att::v_rd_off(d0, 0, 0); \
        A2_TRRD(l0, b_); A2_TRRD(h0, b_ + 2048); A2_TRRD(l1, b_ + 4096); A2_TRRD(h1, b_ + 6144); A2_TRRD(l2, b_ + 8192); A2_TRRD(h2, b_ + 10240); A2_TRRD(l3, b_ + 12288); A2_TRRD(h3, b_ + 14336); \
        asm volatile("s_waitcnt lgkmcnt(0)" ::: "memory"); A2_SBAR(); \
        o[d0] = __builtin_amdgcn_mfma_f32_32x32x16_bf16(pa0, (bf16x8){l0[0], l0[1], l0[2], l0[3], h0[0], h0[1], h0[2], h0[3]}, o[d0], 0, 0, 0); \
        o[d0] = __builtin_amdgcn_mfma_f32_32x32x16_bf16(pa1, (bf16x8){l1[0], l1[1], l1[2], l1[3], h1[0], h1[1], h1[2], h1[3]}, o[d0], 0, 0, 0); \
        o[d0] = __builtin_amdgcn_mfma_f32_32x32x16_bf16(pa2, (bf16x8){l2[0], l2[1], l2[2], l2[3], h2[0], h2[1], h2[2], h2[3]}, o[d0], 0, 0, 0); \
        o[d0] = __builtin_amdgcn_mfma_f32_32x32x16_bf16(pa3, (bf16x8){l3[0], l3[1], l3[2], l3[3], h3[0], h3[1], h3[2], h3[3]}, o[d0], 0, 0, 0); } while (0)
    __builtin_amdgcn_s_setprio(3); A2_PV_D0(0); A2_PV_D0(1); A2_PV_D0(2); A2_PV_D0(3); __builtin_amdgcn_s_setprio(0);
#undef A2_PV_D0
#undef A2_TRRD
}
__device__ __forceinline__ float rowmax16(const f32x16& p) {
    float pm = p[0];
#pragma unroll
    for (int r = 1; r < 16; ++r) pm = fmaxf(pm, p[r]);
    auto rr = __builtin_amdgcn_permlane32_swap(__float_as_uint(pm), __float_as_uint(pm), false, false);
    return fmaxf(__uint_as_float(rr[0]), __uint_as_float(rr[1]));
}
template <bool DEG>
__device__ __forceinline__ void block(const unsigned short* Q, const unsigned short* K, const unsigned short* V0, const unsigned short* V1, float* O0, float* O1, int P0, char* lds) {
    const int tid = opaque_tid(), wid = __builtin_amdgcn_readfirstlane(tid >> 6), lane = tid & 63, r32 = lane & 31, hi = lane >> 5, rg = wid >> 1, kh = wid & 1, hf = wid >> 2;
    const int NT = P0 / 64 + 2, qlo = P0 + 32 * rg;
    const int sr = tid >> 4, sc = (tid & 15) * 8, kws = A2_KSWZ(sr, sc * 2), vst0 = att::v_st(sr, sc), vst1 = att::v_st(32 + sr, sc);
    char* Vl = lds + V_OFF; char* Kl = lds + K_OFF;
    const int vb0 = (int)(uintptr_t)Vl + att::v_rd_base(lane) + kh * 16384, krow = 32 * kh + r32;
    float* wsl = (float*)(lds + WS_OFF) + wid * 64; float* al_l = wsl; float* li_l = wsl + 32;
    const float* li_p = (const float*)(lds + WS_OFF) + (wid ^ 1) * 64 + 32;
    float* mxw = (float*)(lds + MX_OFF) + wid * 64 + lane; const float* mxr = (const float*)(lds + MX_OFF) + (wid ^ 1) * 64 + lane;
    char* pxw = lds + PX_OFF + ((rg * 4 + 2 * kh) * 64 + lane) * 16; const char* pxr = lds + PX_OFF + (rg * 4 * 64 + lane) * 16;
    bf16x8 qr[8];
#pragma unroll
    for (int d0 = 0; d0 < 8; ++d0) qr[d0] = *reinterpret_cast<const bf16x8*>(Q + (size_t)(32 * rg + r32) * 128 + d0 * 16 + hi * 8);
    bf16x8 sk0, sk1, sv0, sv1, sv2, sv3;
#define A2_LOADK(t) do { const size_t o0_ = (size_t)((DEG ? 0 : (t)) * 64 + sr) * 128 + sc, o1_ = o0_ + 32 * 128; sk0 = *reinterpret_cast<const bf16x8*>(K + o0_); sk1 = *reinterpret_cast<const bf16x8*>(K + o1_); } while (0)
#define A2_LOADV(t) do { const size_t o0_ = (size_t)((DEG ? 0 : (t)) * 64 + sr) * 128 + sc, o1_ = o0_ + 32 * 128; \
        sv0 = *reinterpret_cast<const bf16x8*>(V0 + o0_); sv1 = *reinterpret_cast<const bf16x8*>(V0 + o1_); sv2 = *reinterpret_cast<const bf16x8*>(V1 + o0_); sv3 = *reinterpret_cast<const bf16x8*>(V1 + o1_); } while (0)
#define A2_BAR() do { asm volatile("s_waitcnt lgkmcnt(0)" ::: "memory"); __builtin_amdgcn_s_barrier(); asm volatile("" ::: "memory"); } while (0)
#define A2_WRITEK(b) do { *(bf16x8*)(Kl + (b) * 16384 + kws) = sk0; *(bf16x8*)(Kl + (b) * 16384 + kws + 32 * 256) = sk1; } while (0)
#define A2_WRITEV(b) do { *(bf16x8*)(Vl + (b) * 32768 + vst0) = sv0; *(bf16x8*)(Vl + (b) * 32768 + vst1) = sv1; *(bf16x8*)(Vl + (b) * 32768 + 16384 + vst0) = sv2; *(bf16x8*)(Vl + (b) * 32768 + 16384 + vst1) = sv3; } while (0)
#define A2_VMW(n) asm volatile("s_waitcnt vmcnt(%0)" :: "i"(n) : "memory")
#define A2_MASKMAX(PX, pmX, t) do { const int kb_ = (t) * 64 + 32 * kh; \
        if (__builtin_expect(kb_ + 31 > qlo, 0)) { asm volatile("; diagonal tile: mask" ::: "memory");     \
            const int dq_ = qlo + r32 - kb_ - 4 * hi; const float NEG_ = -__builtin_inff(); \
            _Pragma("unroll") for (int r = 0; r < 16; ++r) { const int c_ = (r & 3) + 8 * (r >> 2); if (dq_ - c_ < 0) PX[r] = NEG_; } } \
        pmX = rowmax16(PX); mxw[((t) & 1) * 512] = pmX; } while (0)
#define A2_FINISH(PY, pmY, alY, u) do { const float pm_ = fmaxf(pmY, mxr[((u) & 1) * 512]); float mn_; \
        if (__builtin_expect(__all((pm_ - m_reg) * SCALE <= THR), 1)) { mn_ = m_reg; alY = 1.f; } \
        else { mn_ = fmaxf(m_reg, pm_); alY = __builtin_amdgcn_exp2f((m_reg - mn_) * C2); m_reg = mn_; } \
        const float mnL_ = -mn_ * C2; \
        _Pragma("unroll") for (int r = 0; r < 16; ++r) PY[r] = __builtin_amdgcn_exp2f(fmaf(PY[r], C2, mnL_)); \
        float ps_ = 0.f; _Pragma("unroll") for (int r = 0; r < 16; ++r) ps_ += PY[r]; \
        { auto rr_ = __builtin_amdgcn_permlane32_swap(__float_as_uint(ps_), __float_as_uint(ps_), false, false); ps_ = __uint_as_float(rr_[0]) + __uint_as_float(rr_[1]); } \
        l_reg = l_reg * alY + ps_; \
        A2_PK4(PY, 0, pxw); A2_PK4(PY, 8, pxw + 1024); } while (0)
#define A2_PK4(P, B_, DST) do { unsigned a0_ = att::cvtpk(P[B_ + 0], P[B_ + 1]), a1_ = att::cvtpk(P[B_ + 2], P[B_ + 3]), b0_ = att::cvtpk(P[B_ + 4], P[B_ + 5]), b1_ = att::cvtpk(P[B_ + 6], P[B_ + 7]); \
        auto r0_ = __builtin_amdgcn_permlane32_swap(a0_, b0_, false, false); auto r1_ = __builtin_amdgcn_permlane32_swap(a1_, b1_, false, false); \
        u32x4 w_ = {r0_[0], r1_[0], r0_[1], r1_[1]}; *(u32x4*)(DST) = w_; } while (0)
#define A2_PVSTEP(alY, VOFFB) do { const bf16x8 pa0_ = *reinterpret_cast<const bf16x8*>(pxr), pa1_ = *reinterpret_cast<const bf16x8*>(pxr + 1024), pa2_ = *reinterpret_cast<const bf16x8*>(pxr + 2048), pa3_ = *reinterpret_cast<const bf16x8*>(pxr + 3072); \
        if (__any((alY) < 1.f)) { if (hi == 0) al_l[r32] = (alY); asm volatile("s_waitcnt lgkmcnt(0)" ::: "memory"); \
            _Pragma("unroll") for (int d_ = 0; d_ < 4; ++d_) _Pragma("unroll") for (int r = 0; r < 16; ++r) o[d_][r] *= al_l[att::crow(r, hi)]; } \
        pv<VOFFB>(o, vb0, pa0_, pa1_, pa2_, pa3_); } while (0)
#define A2_STEP(PX, pmX, PY, pmY, alY, t, KB) do { \
        __builtin_amdgcn_s_setprio(2); A2_FINISH(PY, pmY, alY, (t) - 1); __builtin_amdgcn_s_setprio(0); A2_SBAR(); \
        qkt<KB>(PX, Kl, krow, hi, qr); A2_SBAR(); \
        __builtin_amdgcn_s_setprio(2); A2_MASKMAX(PX, pmX, t); __builtin_amdgcn_s_setprio(0); A2_SBAR(); \
        if ((t) + 1 < NT) { A2_VMW(4); A2_WRITEK(1 - KB); if ((t) + 2 < NT) A2_LOADK((t) + 2); } \
        A2_BAR(); \
        A2_PVSTEP(alY, (1 - KB) * 32768); A2_SBAR(); \
        if ((t) + 2 < NT) A2_VMW(2); else A2_VMW(0); \
        A2_WRITEV(KB); if ((t) + 1 < NT) A2_LOADV((t) + 1); \
        A2_BAR(); } while (0)
    float m_reg = -1e30f, l_reg = 0.f; f32x16 o[4] = {};
    f32x16 pA, pB; float pmA, pmB, alA = 1.f, alB = 1.f;
    A2_LOADK(0); A2_VMW(0); A2_WRITEK(0); A2_LOADK(1); A2_LOADV(0);
    A2_BAR();
    if (hf == 1) A2_BAR();
    qkt<0>(pA, Kl, krow, hi, qr); A2_SBAR();
    A2_MASKMAX(pA, pmA, 0); A2_SBAR();
    A2_VMW(4); A2_WRITEK(1); if (2 < NT) A2_LOADK(2);
    A2_BAR();
    if (2 < NT) A2_VMW(2); else A2_VMW(0);
    A2_WRITEV(0); A2_LOADV(1);
    A2_BAR();
    A2_STEP(pB, pmB, pA, pmA, alA, 1, 1);
    for (int t = 2; t < NT; t += 2) {
        A2_STEP(pA, pmA, pB, pmB, alB, t, 0);
        A2_STEP(pB, pmB, pA, pmA, alA, t + 1, 1);
    }
    A2_FINISH(pB, pmB, alB, NT - 1);
    A2_BAR();
    A2_PVSTEP(alB, 32768);
    if (hf == 0) A2_BAR();
    if (hi == 0) li_l[r32] = l_reg;
    A2_BAR();
    float rli[16];
#pragma unroll
    for (int r = 0; r < 16; ++r) rli[r] = __builtin_amdgcn_rcpf(li_l[att::crow(r, hi)] + li_p[att::crow(r, hi)]);
    float* Ow = (kh ? O1 : O0) + (size_t)(32 * rg) * 128;
#pragma unroll
    for (int r = 0; r < 16; ++r) { const int orow = att::crow(r, hi);
#pragma unroll
        for (int d0 = 0; d0 < 4; ++d0) Ow[(size_t)orow * 128 + d0 * 32 + r32] = o[d0][r] * rli[r]; }
    A2_BAR();
#undef A2_LOADK
#undef A2_LOADV
#undef A2_BAR
#undef A2_WRITEK
#undef A2_WRITEV
#undef A2_VMW
#undef A2_MASKMAX
#undef A2_FINISH
#undef A2_PK4
#undef A2_PVSTEP
#undef A2_STEP
}
#undef A2_KSWZ
#undef A2_SBAR
}

#ifndef MK_PER_PHASE
#define MK_PER_PHASE 0
#endif
constexpr int NWAVES = 8, NTHR = 512;
constexpr int SEQ = 16384, DM = 4096, FFH = 11008, DEPTH = 4, NMODV = 6 * DM;
#ifndef PADK
#define PADK 64
#endif
constexpr int LDD = DM + PADK, LDF = FFH + PADK;
constexpr int ZG = 96;
constexpr size_t GS = (size_t)SEQ * 128;
constexpr int S5T = 64, S5NC = SEQ / S5T;
constexpr int KSL = 16;
constexpr float NORM_EPS = 1e-6f, SUBLN_EPS = 1e-5f;
constexpr int N_PHASES = 35;

constexpr size_t MiB = 1u << 20;
constexpr size_t WS_CTL = 0, CTL_ZERO_BYTES = 64 * 1024;
constexpr size_t WS_MODP = 1 * MiB;
constexpr size_t WS_MODL = 3 * MiB;
constexpr size_t WS_LAM = 3 * MiB + 512 * 1024;
constexpr size_t WS_S5P = 4 * MiB, S5P_LAYER = 4 * MiB + 256 * 1024;
constexpr size_t S5P_ABR = 0, S5P_ABI = 64 * 1024, S5P_ATR = 128 * 1024, S5P_ATI = 192 * 1024, S5P_BBR = 256 * 1024, S5P_BBI = 256 * 1024 + MiB;
constexpr size_t S5P_BBOP = 256 * 1024 + 2 * MiB, S5P_COP = 256 * 1024 + 3 * MiB;
#ifndef S5_MFMA
#define S5_MFMA 1
#endif
constexpr size_t W_IN_B = (size_t)12288 * LDD * 2, W_OUT_B = (size_t)4096 * LDD * 2, W_GLU_B = (size_t)8192 * LDD * 2, W_GU_B = (size_t)22016 * LDD * 2, W_DN_B = (size_t)4096 * LDF * 2;
constexpr size_t WS_WIN = 16 * MiB, WS_WOUT = WS_WIN + 2 * W_IN_B, WS_WGLU = WS_WOUT + 2 * W_OUT_B, WS_WGU = WS_WGLU + 2 * W_GLU_B, WS_WDN = WS_WGU + 4 * W_GU_B;
constexpr size_t WS_H = WS_WDN + 4 * W_DN_B;
constexpr size_t WS_MIX = WS_H + (size_t)SEQ * LDD * 2;
constexpr size_t WS_Z = WS_MIX + (size_t)SEQ * LDD * 2;
constexpr size_t WS_OT = WS_Z + (size_t)ZG * GS * 2;
constexpr size_t WS_S5F = WS_OT + (size_t)32 * GS * 4;
constexpr size_t WS_S5H = WS_S5F + (size_t)S5NC * 256 * 128 * 4;
constexpr size_t WS_XR = WS_S5H + (size_t)S5NC * 256 * 128 * 4;
constexpr size_t WS_END = WS_XR + (size_t)SEQ * DM * 2;
static_assert((size_t)SEQ * LDF * 2 <= (size_t)ZG * GS * 2, "hidden overlays Z");
static_assert(WS_WIN % 256 == 0 && WS_H % 256 == 0 && WS_OT % 256 == 0 && WS_S5F % 256 == 0, "alignment");
constexpr int CW_BAR = 1024;

constexpr int RING_BYTES = 131072, MISC_OFF = RING_BYTES + 320, LDS_BYTES = 147456;

#define GAS __attribute__((address_space(1)))
#define LAS __attribute__((address_space(3)))
typedef unsigned short bf16;
typedef unsigned v4u __attribute__((ext_vector_type(4)));
typedef unsigned v2u __attribute__((ext_vector_type(2)));
typedef float f32x4 __attribute__((ext_vector_type(4)));
#define LDS_WAIT() asm volatile("s_waitcnt lgkmcnt(0)" ::: "memory")
#define VM_WAIT() asm volatile("s_waitcnt vmcnt(0)" ::: "memory")
__device__ __forceinline__ unsigned pk2(float lo, float hi) { unsigned r; asm volatile("v_cvt_pk_bf16_f32 %0, %1, %2" : "=v"(r) : "v"(lo), "v"(hi)); return r; }
typedef float pk_f32x2 __attribute__((ext_vector_type(2)));
typedef __bf16 pk_bf16x2 __attribute__((ext_vector_type(2)));
__device__ __forceinline__ unsigned pk2c(float lo, float hi) { const pk_f32x2 v = {lo, hi}; return __builtin_bit_cast(unsigned, __builtin_convertvector(v, pk_bf16x2)); }
__device__ __forceinline__ float bflo(unsigned w) { return __builtin_bit_cast(float, w << 16); }
__device__ __forceinline__ float bfhi(unsigned w) { return __builtin_bit_cast(float, w & 0xffff0000u); }

#define XB_TMO      128
#define XB_XCNT(j)  (256  + 64 * (j))
#define XB_XSUB(j)  (1280 + 64 * (j))
#define XB_XGEN(j)  (2304 + 64 * (j))
#define XB_TOP      3328
#define XB_TOPGEN   3392
#define XCD_BAR_WORDS 3456
#define XB_SPIN_CAP (1u << 22)

__device__ __forceinline__ unsigned xb_ld(unsigned* p)              { return __hip_atomic_load(p, __ATOMIC_RELAXED, __HIP_MEMORY_SCOPE_AGENT); }
__device__ __forceinline__ unsigned xb_add(unsigned* p, unsigned v) { return __hip_atomic_fetch_add(p, v, __ATOMIC_RELAXED, __HIP_MEMORY_SCOPE_AGENT); }
__device__ __forceinline__ unsigned xb_xcc_id() { return (unsigned)__builtin_amdgcn_s_getreg((3 << 11) | 20) & 0xFu; }
#define XB_SPIN(cond, bar) do { unsigned _sp = 0; while (cond) { __builtin_amdgcn_s_sleep(1); \
    if ((++_sp & 255u) == 0u) { if (xb_ld(&(bar)[XB_TMO])) break; if (_sp > XB_SPIN_CAP) { atomicAdd(&(bar)[XB_TMO], 1u); break; } } } } while (0)

struct XcdBarrier {
    unsigned* bar; unsigned x;
    volatile LAS unsigned* st;
};
__device__ __forceinline__ XcdBarrier xcd_barrier_post(unsigned* bar, volatile LAS unsigned* st) {
    XcdBarrier b; b.bar = bar; b.x = xb_xcc_id(); b.st = st;
    if (threadIdx.x == 0) (void)xb_add(&bar[XB_XCNT(b.x)], 1u);
    return b;
}
__device__ __forceinline__ void xcd_barrier_complete(unsigned* bar, unsigned x, unsigned& nloc, unsigned& nx) {
    const unsigned G = gridDim.x * gridDim.y * gridDim.z;
    unsigned sum, cnt, mine, sp = 0u;
    for (;;) {
        sum = 0u; cnt = 0u; mine = 0u;
#pragma unroll
        for (unsigned j = 0; j < 16; ++j) { const unsigned c = xb_ld(&bar[XB_XCNT(j)]); sum += c; cnt += (c > 0u) ? 1u : 0u; mine = (j == x) ? c : mine; }
        if (sum == G) break;
        __builtin_amdgcn_s_sleep(1);
        if ((++sp & 255u) == 0u) { if (xb_ld(&bar[XB_TMO])) break; if (sp > XB_SPIN_CAP) { atomicAdd(&bar[XB_TMO], 1u); break; } }
    }
    nloc = mine > 0u ? mine : 1u; nx = cnt > 0u ? cnt : 1u;
}
__device__ __forceinline__ void xcd_barrier(const XcdBarrier& b) {
    asm volatile("s_waitcnt vmcnt(0)" ::: "memory");
    __syncthreads();
    if (threadIdx.x == 0) {
        unsigned* bar = b.bar;
        __builtin_amdgcn_s_waitcnt(0);
        unsigned nloc = b.st[0], nx = b.st[1];
        if (nloc == 0u) { xcd_barrier_complete(bar, b.x, nloc, nx); b.st[0] = nloc; b.st[1] = nx; }
        const unsigned old = xb_add(&bar[XB_XSUB(b.x)], 1u);
        const unsigned gen = old / nloc;
        if (old + 1u == (gen + 1u) * nloc) {
            __builtin_amdgcn_fence(__ATOMIC_RELEASE, "agent");
            asm volatile("s_waitcnt vmcnt(0)" ::: "memory");
            const unsigned og = xb_add(&bar[XB_TOP], 1u);
            const unsigned tg = og / nx;
            if (og + 1u == (tg + 1u) * nx) xb_add(&bar[XB_TOPGEN], 1u);
            else XB_SPIN(xb_ld(&bar[XB_TOPGEN]) == tg, bar);
            __builtin_amdgcn_fence(__ATOMIC_ACQUIRE, "agent");
            xb_add(&bar[XB_XGEN(b.x)], 1u);
            asm volatile("s_waitcnt vmcnt(0)" ::: "memory");
        } else {
            XB_SPIN(xb_ld(&bar[XB_XGEN(b.x)]) == gen, bar);
            __builtin_amdgcn_fence(__ATOMIC_ACQUIRE, "agent");
            asm volatile("s_waitcnt vmcnt(0)" ::: "memory");
        }
    }
    __syncthreads();
}

__device__ __forceinline__ float wave_sum(float v) {
#pragma unroll
    for (int o = 1; o < 64; o <<= 1) v += __shfl_xor(v, o);
    return v;
}

__device__ __forceinline__ void transpose_item(const float* W, int K, int N, bf16* WT, int ldw, int mode, LAS float* scr, int item, int lane) {
    const int nblk = N / 32, kb = item / nblk, nb = item - kb * nblk, k0 = 64 * kb, n0 = 32 * nb;
    const int drow0 = mode == 0 ? n0 : ((n0 >> 7) * 256 + (n0 & 127) + (mode == 2 ? 128 : 0));
#pragma unroll 8
    for (int i = 0; i < 32; ++i) { const int kk = 2 * i + (lane >> 5); scr[kk * 33 + (lane & 31)] = W[(size_t)(k0 + kk) * N + n0 + (lane & 31)]; }
    LDS_WAIT(); asm volatile("" ::: "memory");
    const int c = lane & 7;
#pragma unroll
    for (int j = 0; j < 4; ++j) { const int n = (lane >> 3) + 8 * j; const LAS float* s = scr + (8 * c) * 33 + n;
        v4u o; o.x = pk2(s[0 * 33], s[1 * 33]); o.y = pk2(s[2 * 33], s[3 * 33]); o.z = pk2(s[4 * 33], s[5 * 33]); o.w = pk2(s[6 * 33], s[7 * 33]);
        *(v4u*)(WT + (size_t)(drow0 + n) * ldw + k0 + 8 * c) = o; }
    LDS_WAIT(); asm volatile("" ::: "memory");
}
__device__ __forceinline__ void dsincos(double x, double& s, double& c) {
    const double k = rint(x * 0.63661977236758134308);
    double r = fma(-k, 1.5707963267948966192, x); r = fma(-k, 6.1232339957367658860e-17, r);
    const double r2 = r * r;
    double ps = -1.0 / 1307674368000.0; ps = fma(ps, r2, 1.0 / 6227020800.0); ps = fma(ps, r2, -1.0 / 39916800.0); ps = fma(ps, r2, 1.0 / 362880.0); ps = fma(ps, r2, -1.0 / 5040.0);
    ps = fma(ps, r2, 1.0 / 120.0); ps = fma(ps, r2, -1.0 / 6.0); ps = fma(ps, r2, 1.0); const double sn = r * ps;
    double pc = 1.0 / 20922789888000.0; pc = fma(pc, r2, -1.0 / 87178291200.0); pc = fma(pc, r2, 1.0 / 479001600.0); pc = fma(pc, r2, -1.0 / 3628800.0); pc = fma(pc, r2, 1.0 / 40320.0);
    pc = fma(pc, r2, -1.0 / 720.0); pc = fma(pc, r2, 1.0 / 24.0); pc = fma(pc, r2, -0.5); const double cs = fma(pc, r2, 1.0);
    const int q = (int)k & 3;
    s = (q == 0) ? sn : (q == 1) ? cs : (q == 2) ? -sn : -cs;
    c = (q == 0) ? cs : (q == 1) ? -sn : (q == 2) ? -cs : sn;
}
__device__ __forceinline__ double dexp(double x) {
    const double k = rint(x * 1.4426950408889634074);
    double r = fma(-k, 0.69314718055994528623, x); r = fma(-k, 2.3190468138462995584e-17, r);
    double p = 1.0 / 87178291200.0; p = fma(p, r, 1.0 / 6227020800.0); p = fma(p, r, 1.0 / 479001600.0); p = fma(p, r, 1.0 / 39916800.0); p = fma(p, r, 1.0 / 3628800.0); p = fma(p, r, 1.0 / 362880.0);
    p = fma(p, r, 1.0 / 40320.0); p = fma(p, r, 1.0 / 5040.0); p = fma(p, r, 1.0 / 720.0); p = fma(p, r, 1.0 / 120.0); p = fma(p, r, 1.0 / 24.0); p = fma(p, r, 1.0 / 6.0); p = fma(p, r, 0.5); p = fma(p, r, 1.0); p = fma(p, r, 1.0);
    const long long bits = (long long)(1023 + (int)k) << 52;
    return p * __builtin_bit_cast(double, bits);
}

struct Args { const float* in[29]; float* out; unsigned char* ws; int ph_lo, ph_hi; };

__device__ __forceinline__ void p0_prologue(const Args& A, LAS unsigned char* lds, int gw, int NGW, int wave, int lane) {
    unsigned char* ws = A.ws;
    for (int w = gw; w < 96 * KSL + 512 + 2048; w += NGW) {
    if (w >= 96 * KSL + 512) {
        const int idx = (w - 96 * KSL - 512) * 64 + lane, o = idx >> 16, r = idx & 65535, g = r >> 8, mm = (r >> 6) & 3, o16 = lane & 15, kq = lane >> 4;
        const int tau = 2 * mm, p0 = 16 * (tau & 3) + 4 * kq;
        const float* cs = (tau < 4 ? A.in[21] : A.in[22]) + (size_t)o * 256 * 16 * 64 + (size_t)(g * 16 + o16) * 64 + p0; const float sg = tau < 4 ? 1.0f : -1.0f;
        const f32x4 a = *(const f32x4*)cs * sg, b = *(const f32x4*)(cs + 16) * sg;
        v4u q; q.x = pk2(a.x, a.y); q.y = pk2(a.z, a.w); q.z = pk2(b.x, b.y); q.w = pk2(b.z, b.w);
        *(v4u*)(ws + WS_S5P + (size_t)o * S5P_LAYER + S5P_COP + ((size_t)((g * 4 + mm) * 64 + lane)) * 16) = q;
    } else if (w < 96 * KSL) {
        const int nb = w % 96, ks = w / 96;
        const float* wp = A.in[2] + (size_t)(ks * 256) * NMODV + nb * 256 + lane * 4; const float* cp = A.in[1] + ks * 256;
        f32x4 a = {0.f, 0.f, 0.f, 0.f};
#pragma unroll 8
        for (int k = 0; k < 256; ++k) { const float cv = cp[k]; const float s = cv / (1.0f + expf(-cv)); const f32x4 w = *(const f32x4*)(wp + (size_t)k * NMODV); a += s * w; }
        *(f32x4*)((float*)(ws + WS_MODP) + (size_t)ks * NMODV + nb * 256 + lane * 4) = a;
    } else {
        const int idx = (w - 96 * KSL) * 64 + lane, o = idx >> 14, gp = idx & 16383, g = gp >> 6;
        const double lr = (double)fminf(A.in[16][idx], -1e-4f), li = (double)A.in[17][idx], dt = dexp((double)A.in[18][o * 256 + g]);
        const double mag = dexp(lr * dt); double sn, cs; dsincos(li * dt, sn, cs);
        const double abr = mag * cs, abi = mag * sn, den = lr * lr + li * li, nr = abr - 1.0, ni = abi;
        const double fre = (nr * lr + ni * li) / den, fim = (ni * lr - nr * li) / den;
        double tr = abr, ti = abi;
#pragma unroll
        for (int q = 0; q < 6; ++q) { const double t2 = tr * tr - ti * ti; ti = 2.0 * tr * ti; tr = t2; }
        unsigned char* pb = ws + WS_S5P + (size_t)o * S5P_LAYER;
        ((float*)(pb + S5P_ABR))[gp] = (float)abr; ((float*)(pb + S5P_ABI))[gp] = (float)abi; ((float*)(pb + S5P_ATR))[gp] = (float)tr; ((float*)(pb + S5P_ATI))[gp] = (float)ti;
        const float* bre = A.in[19] + (size_t)idx * 16; const float* bim = A.in[20] + (size_t)idx * 16;
        float* obr = (float*)(pb + S5P_BBR) + (size_t)gp * 16; float* obi = (float*)(pb + S5P_BBI) + (size_t)gp * 16;
#pragma unroll
        for (int h4 = 0; h4 < 4; ++h4) { const f32x4 br = *(const f32x4*)(bre + 4 * h4), bi = *(const f32x4*)(bim + 4 * h4); f32x4 r, i;
#pragma unroll
            for (int j = 0; j < 4; ++j) { r[j] = (float)(fre * (double)br[j] - fim * (double)bi[j]); i[j] = (float)(fre * (double)bi[j] + fim * (double)br[j]); }
            *(f32x4*)(obr + 4 * h4) = r; *(f32x4*)(obi + 4 * h4) = i; }
        { const int p = gp & 63, ti = p >> 4, i16 = p & 15;
#pragma unroll
          for (int kq = 0; kq < 4; ++kq) { const f32x4 r = *(const f32x4*)(obr + 4 * kq), i = *(const f32x4*)(obi + 4 * kq);
              v2u pr, pi; pr.x = pk2(r.x, r.y); pr.y = pk2(r.z, r.w); pi.x = pk2(i.x, i.y); pi.y = pk2(i.z, i.w);
              *(v2u*)(pb + S5P_BBOP + ((size_t)((g * 8 + ti) * 64 + kq * 16 + i16)) * 8) = pr; *(v2u*)(pb + S5P_BBOP + ((size_t)((g * 8 + 4 + ti) * 64 + kq * 16 + i16)) * 8) = pi; } }
    }
    }
    if (gw < 2) { const int e = gw;
        const float s1 = wave_sum(A.in[10][e * 128 + lane] * A.in[11][e * 128 + lane] + A.in[10][e * 128 + 64 + lane] * A.in[11][e * 128 + 64 + lane]);
        const float s2 = wave_sum(A.in[12][e * 128 + lane] * A.in[13][e * 128 + lane] + A.in[12][e * 128 + 64 + lane] * A.in[13][e * 128 + 64 + lane]);
        const float lam_init = e == 0 ? 0.2f : 0.4707130183435842f;
        if (lane == 0) ((float*)(ws + WS_LAM))[e] = expf(s1) - expf(s2) + lam_init; }
    LAS float* scr = (LAS float*)(lds + wave * 16384);
    constexpr int I_IN = 64 * 384, I_OUT = 64 * 128, I_GLU = 64 * 128, I_GU = 64 * 344, I_DN = 172 * 128;
    constexpr int NITEMS = 2 * I_IN + 2 * I_OUT + 4 * I_GLU + 8 * I_GU + 4 * I_DN;
    for (int it = gw; it < NITEMS; it += NGW) {
        int r = it;
        if (r < 2 * I_IN) { const int e = r / I_IN; transpose_item(A.in[8] + (size_t)e * DM * 12288, DM, 12288, (bf16*)(ws + WS_WIN + e * W_IN_B), LDD, 0, scr, r - e * I_IN, lane); continue; } r -= 2 * I_IN;
        if (r < 2 * I_OUT) { const int e = r / I_OUT; transpose_item(A.in[15] + (size_t)e * DM * DM, DM, DM, (bf16*)(ws + WS_WOUT + e * W_OUT_B), LDD, 0, scr, r - e * I_OUT, lane); continue; } r -= 2 * I_OUT;
        if (r < 4 * I_GLU) { const int q = r / I_GLU, o = q >> 1, s = q & 1; transpose_item(A.in[24 + s] + (size_t)o * DM * DM, DM, DM, (bf16*)(ws + WS_WGLU + o * W_GLU_B), LDD, 1 + s, scr, r - q * I_GLU, lane); continue; } r -= 4 * I_GLU;
        if (r < 8 * I_GU) { const int q = r / I_GU, l = q >> 1, s = q & 1; transpose_item(A.in[26 + s] + (size_t)l * DM * FFH, DM, FFH, (bf16*)(ws + WS_WGU + l * W_GU_B), LDD, 1 + s, scr, r - q * I_GU, lane); continue; } r -= 8 * I_GU;
        { const int l = r / I_DN; transpose_item(A.in[28] + (size_t)l * FFH * DM, FFH, DM, (bf16*)(ws + WS_WDN + l * W_DN_B), LDF, 0, scr, r - l * I_DN, lane); }
    }
}
__device__ __forceinline__ void p1_modvec(const Args& A, int gtid, int NGT) {
    const float* mp = (const float*)(A.ws + WS_MODP); float* ml = (float*)(A.ws + WS_MODL);
    for (int i = gtid; i < DEPTH * NMODV; i += NGT) { const int j = i % NMODV; float v = A.in[3][j] + A.in[4][i];
#pragma unroll
        for (int ks = 0; ks < KSL; ++ks) v += mp[(size_t)ks * NMODV + j];
        ml[i] = v; }
}
template <bool IN_BF16>
__device__ __forceinline__ void norm_mod_phase(const void* srcv, const float* nw, const float* sh, const float* sc, bf16* dst, LAS unsigned char* lds, int tid, int gw, int NGW, int lane) {
    LAS float* w1 = (LAS float*)lds; LAS float* bb = w1 + DM;
    for (int i = tid; i < DM; i += NTHR) { w1[i] = nw[i] * (1.0f + sc[i]); bb[i] = sh[i]; }
    __syncthreads();
    for (int m = gw; m < SEQ; m += NGW) {
        if constexpr (IN_BF16) {
            const v4u* xr = (const v4u*)((const bf16*)srcv + (size_t)m * DM) + lane;
            v4u r[8]; float ss = 0.f;
#pragma unroll
            for (int j = 0; j < 8; ++j) r[j] = xr[64 * j];
            f32x4 v[8][2];
#pragma unroll
            for (int j = 0; j < 8; ++j) { v[j][0] = (f32x4){bflo(r[j].x), bfhi(r[j].x), bflo(r[j].y), bfhi(r[j].y)}; v[j][1] = (f32x4){bflo(r[j].z), bfhi(r[j].z), bflo(r[j].w), bfhi(r[j].w)};
#pragma unroll
                for (int h = 0; h < 2; ++h) ss += (v[j][h].x * v[j][h].x + v[j][h].y * v[j][h].y) + (v[j][h].z * v[j][h].z + v[j][h].w * v[j][h].w); }
            const float rstd = 1.0f / sqrtf(wave_sum(ss) * (1.0f / DM) + NORM_EPS);
            v4u* o16 = (v4u*)(dst + (size_t)m * LDD) + lane;
#pragma unroll
            for (int j = 0; j < 8; ++j) { const int col = j * 512 + lane * 8;
                const f32x4 y0 = v[j][0] * rstd * *(const LAS f32x4*)(w1 + col) + *(const LAS f32x4*)(bb + col), y1 = v[j][1] * rstd * *(const LAS f32x4*)(w1 + col + 4) + *(const LAS f32x4*)(bb + col + 4);
                v4u p; p.x = pk2(y0.x, y0.y); p.y = pk2(y0.z, y0.w); p.z = pk2(y1.x, y1.y); p.w = pk2(y1.z, y1.w); o16[64 * j] = p; }
        } else {
            const f32x4* xr = (const f32x4*)((const float*)srcv + (size_t)m * DM) + lane;
            f32x4 v[16]; float ss = 0.f;
#pragma unroll
            for (int j = 0; j < 16; ++j) { v[j] = xr[64 * j]; ss += (v[j].x * v[j].x + v[j].y * v[j].y) + (v[j].z * v[j].z + v[j].w * v[j].w); }
            const float rstd = 1.0f / sqrtf(wave_sum(ss) * (1.0f / DM) + NORM_EPS);
            v2u* o8 = (v2u*)(dst + (size_t)m * LDD) + lane;
#pragma unroll
            for (int j = 0; j < 16; ++j) { const int col = j * 256 + lane * 4; const f32x4 w = *(const LAS f32x4*)(w1 + col), b = *(const LAS f32x4*)(bb + col);
                const f32x4 y = v[j] * rstd * w + b; v2u p; p.x = pk2(y.x, y.y); p.y = pk2(y.z, y.w); o8[64 * j] = p; }
        }
    }
    __syncthreads();
}
__device__ __forceinline__ void final_norm_phase(const bf16* src, const float* nw, float* dst, int gw, int NGW, int lane) {
    for (int m = gw; m < SEQ; m += NGW) {
        const v4u* xr = (const v4u*)(src + (size_t)m * DM) + lane;
        v4u r[8]; float ss = 0.f;
#pragma unroll
        for (int j = 0; j < 8; ++j) r[j] = xr[64 * j];
        f32x4 v[8][2];
#pragma unroll
        for (int j = 0; j < 8; ++j) { v[j][0] = (f32x4){bflo(r[j].x), bfhi(r[j].x), bflo(r[j].y), bfhi(r[j].y)}; v[j][1] = (f32x4){bflo(r[j].z), bfhi(r[j].z), bflo(r[j].w), bfhi(r[j].w)};
#pragma unroll
            for (int h = 0; h < 2; ++h) ss += (v[j][h].x * v[j][h].x + v[j][h].y * v[j][h].y) + (v[j][h].z * v[j][h].z + v[j][h].w * v[j][h].w); }
        const float rstd = 1.0f / sqrtf(wave_sum(ss) * (1.0f / DM) + NORM_EPS);
        float* orow = dst + (size_t)m * DM;
#pragma unroll
        for (int j = 0; j < 8; ++j) { const int col = j * 512 + lane * 8;
            *(f32x4*)(orow + col) = v[j][0] * rstd * *(const f32x4*)(nw + col); *(f32x4*)(orow + col + 4) = v[j][1] * rstd * *(const f32x4*)(nw + col + 4); }
    }
}
__device__ __forceinline__ void conv_phase(const bf16* Z, const float* cw, bf16* MIX, int gtid, int NGT) {
    for (int i = gtid; i < SEQ * 256; i += NGT) {
        const int t = i >> 8, r = i & 255, gi = r >> 4, c8 = (r & 15) * 8;
        const size_t o = (size_t)t * 128 + c8;
        const v4u zero = {0u, 0u, 0u, 0u};
        const v4u vb = *(const v4u*)(Z + (size_t)gi * GS + o);
        const bf16* zc = Z + (size_t)(16 + gi) * GS + o; const bf16* zx = Z + (size_t)(32 + gi) * GS + o;
        const v4u c0 = *(const v4u*)zc, x0 = *(const v4u*)zx;
        const v4u c1 = t >= 1 ? *(const v4u*)(zc - 128) : zero, x1 = t >= 1 ? *(const v4u*)(zx - 128) : zero;
        const v4u c2 = t >= 2 ? *(const v4u*)(zc - 256) : zero, x2 = t >= 2 ? *(const v4u*)(zx - 256) : zero;
        const float* wp = cw + gi * 128 + c8;
        float y[8];
#pragma unroll
        for (int q = 0; q < 4; ++q) {
            const float u0l = bflo(c0[q]) * bflo(x0[q]), u0h = bfhi(c0[q]) * bfhi(x0[q]);
            const float u1l = bflo(c1[q]) * bflo(x1[q]), u1h = bfhi(c1[q]) * bfhi(x1[q]);
            const float u2l = bflo(c2[q]) * bflo(x2[q]), u2h = bfhi(c2[q]) * bfhi(x2[q]);
            const int j = 2 * q;
            y[j]     = bflo(vb[q]) * (wp[2 * 2048 + j] * u0l + wp[2048 + j] * u1l + wp[j] * u2l);
            y[j + 1] = bfhi(vb[q]) * (wp[2 * 2048 + j + 1] * u0h + wp[2048 + j + 1] * u1h + wp[j + 1] * u2h);
        }
        v4u w; w.x = pk2(y[0], y[1]); w.y = pk2(y[2], y[3]); w.z = pk2(y[4], y[5]); w.w = pk2(y[6], y[7]);
        *(v4u*)(MIX + (size_t)t * LDD + gi * 128 + c8) = w;
    }
}
__device__ __forceinline__ void combine_phase(const float* OT, const float* lamp, const float* sg, float lam_init, bf16* MIX, int gw, int NGW, int lane) {
    const float lam = lamp[0], os = 1.0f - lam_init;
    const int j = lane >> 5, c4 = (lane & 31) * 4;
    const f32x4 gv = *(const f32x4*)(sg + 128 * j + c4);
    for (int it0 = gw * 4; it0 < SEQ * 8; it0 += NGW * 4) {
        f32x4 a[4], b[4];
#pragma unroll
        for (int q = 0; q < 4; ++q) { const int it = it0 + q, t = it >> 3, h = it & 7;
            a[q] = *(const f32x4*)(OT + (size_t)(h * 4 + j) * GS + (size_t)t * 128 + c4); b[q] = *(const f32x4*)(OT + (size_t)(h * 4 + 2 + j) * GS + (size_t)t * 128 + c4); }
#pragma unroll
        for (int q = 0; q < 4; ++q) { const int it = it0 + q, t = it >> 3, h = it & 7;
            const f32x4 o = a[q] - lam * b[q];
            const float rstd = 1.0f / sqrtf(wave_sum((o.x * o.x + o.y * o.y) + (o.z * o.z + o.w * o.w)) * (1.0f / 256.0f) + SUBLN_EPS);
            const f32x4 y = o * (rstd * os) * gv;
            v2u p; p.x = pk2(y.x, y.y); p.y = pk2(y.z, y.w);
            *(v2u*)(MIX + (size_t)t * LDD + 2048 + 256 * h + 128 * j + c4) = p; }
    }
}
__device__ __forceinline__ att::BlockRef<att::bf16, float> att_ref(const bf16* Z, float* OT, int item, int pass) {
    const int r = item >> 8, b = item & 255, vh = r * 8 + (b & 7), pair = b >> 3, qb = pass ? 63 - pair : pair;
    const int h = vh >> 2, m = (vh >> 1) & 1, j = vh & 1;
    att::BlockRef<att::bf16, float> R;
    R.Q = (const att::bf16*)(Z + (size_t)(48 + 2 * h + m) * GS + (size_t)qb * 256 * 128);
    R.K = (const att::bf16*)(Z + (size_t)(64 + 2 * h + m) * GS);
    R.V = (const att::bf16*)(Z + (size_t)(80 + 2 * h + j) * GS);
    R.O = OT + (size_t)vh * GS + (size_t)qb * 256 * 128; R.P0 = qb * 256;
    return R;
}
__device__ __forceinline__ void attn_phase(const bf16* Z, float* OT, char* lds, int bid, int G) {
    constexpr int TOTAL = 1024;
    int item = bid; if (item >= TOTAL) return;
    int pass = 0;
    att::BlockRef<att::bf16, float> cur = att_ref(Z, OT, item, 0);
    att::Seam<att::bf16> S;
    att::causal_swa_prime<att::bf16, float>(cur, SEQ, lds, S);
    for (;;) {
        const bool more_pass = pass == 0, more_item = item + G < TOTAL, last = !more_pass && !more_item;
        int itn = item, passn = 1;
        if (!more_pass) { passn = 0; itn = more_item ? item + G : item; }
        const att::BlockRef<att::bf16, float> nxt = last ? cur : att_ref(Z, OT, itn, passn);
        att::causal_swa_block<att::bf16, float>(cur, nxt, SEQ, SEQ, lds, S);
        if (last) break;
        cur = nxt; item = itn; pass = passn;
    }
}
#ifndef ATT2
#define ATT2 1
#endif
template <bool DEG>
__device__ __forceinline__ void attn2_phase(const bf16* Z, float* OT, char* lds, int bid, int G) {
    for (int item = bid; item < 1024; item += G) {
        const int r = item >> 8, b = item & 255, hm = 2 * (b & 7) + (r >> 1), pair = (r & 1) * 32 + (b >> 3), h = hm >> 1, m = hm & 1;
        for (int pass = 0; pass < 2; ++pass) { const int qb = pass ? 127 - pair : pair;
            att2::block<DEG>(Z + (size_t)(48 + 2 * h + m) * GS + (size_t)qb * 128 * 128, Z + (size_t)(64 + 2 * h + m) * GS, Z + (size_t)(80 + 2 * h) * GS, Z + (size_t)(81 + 2 * h) * GS,
                        OT + (size_t)(h * 4 + m * 2) * GS + (size_t)qb * 128 * 128, OT + (size_t)(h * 4 + m * 2 + 1) * GS + (size_t)qb * 128 * 128, qb * 128, lds); }
    }
}
__device__ __forceinline__ float gelu_tanh(float x) { const float z = 1.5957691216057308f * (x + 0.044715f * x * x * x); return x * __builtin_amdgcn_rcpf(1.0f + __builtin_amdgcn_exp2f(-1.4426950408889634f * z)); }
template <bool PASS2>
__device__ __forceinline__ void s5_pass(const bf16* Hin, const unsigned char* prm, const float* c_re, const float* c_im, const float* dsk, float* F, const float* HC, bf16* Gout,
                                        LAS unsigned char* lds, int gw, int NGW, int wave, int lane) {
    LAS float* lu = (LAS float*)(lds + wave * 4096);
    for (int item = gw; item < 256 * S5NC; item += NGW) {
        const int g = item & 255, c = item >> 8, gp = g * 64 + lane;
        { const bf16* up = Hin + (size_t)(c * S5T + lane) * LDD + 16 * g; const v4u a = *(const v4u*)up, b = *(const v4u*)(up + 8);
          LAS f32x4* ur = (LAS f32x4*)(lu + lane * 16);
          ur[0] = (f32x4){bflo(a.x), bfhi(a.x), bflo(a.y), bfhi(a.y)}; ur[1] = (f32x4){bflo(a.z), bfhi(a.z), bflo(a.w), bfhi(a.w)};
          ur[2] = (f32x4){bflo(b.x), bfhi(b.x), bflo(b.y), bfhi(b.y)}; ur[3] = (f32x4){bflo(b.z), bfhi(b.z), bflo(b.w), bfhi(b.w)}; }
        f32x4 bbr[4], bbi[4];
#pragma unroll
        for (int q = 0; q < 4; ++q) { bbr[q] = *(const f32x4*)((const float*)(prm + S5P_BBR) + (size_t)gp * 16 + 4 * q); bbi[q] = *(const f32x4*)((const float*)(prm + S5P_BBI) + (size_t)gp * 16 + 4 * q); }
        const float abr = ((const float*)(prm + S5P_ABR))[gp], abi = ((const float*)(prm + S5P_ABI))[gp];
        float hr = 0.f, hi = 0.f, cr[16], ci[16], dk = 0.f;
        if (PASS2) {
#pragma unroll
            for (int o = 0; o < 16; ++o) { cr[o] = c_re[(size_t)(g * 16 + o) * 64 + lane]; ci[o] = c_im[(size_t)(g * 16 + o) * 64 + lane]; }
            hr = HC[(size_t)(c * 256 + g) * 128 + lane]; hi = HC[(size_t)(c * 256 + g) * 128 + 64 + lane]; dk = dsk[16 * g + (lane >> 2)];
        }
        LDS_WAIT(); asm volatile("" ::: "memory");
#pragma unroll 2
        for (int t = 0; t < S5T; ++t) {
            const LAS f32x4* ut = (const LAS f32x4*)(lu + t * 16);
            float bur = 0.f, bui = 0.f;
#pragma unroll
            for (int q = 0; q < 4; ++q) { const f32x4 u = ut[q];
                bur += (bbr[q].x * u.x + bbr[q].y * u.y) + (bbr[q].z * u.z + bbr[q].w * u.w); bui += (bbi[q].x * u.x + bbi[q].y * u.y) + (bbi[q].z * u.z + bbi[q].w * u.w); }
            const float nr = abr * hr - abi * hi + bur, ni = abr * hi + abi * hr + bui; hr = nr; hi = ni;
            if (PASS2) {
                float v[16];
#pragma unroll
                for (int o = 0; o < 16; ++o) v[o] = hr * cr[o] - hi * ci[o];
#pragma unroll
                for (int i = 0; i < 8; ++i) { const float send = (lane & 32) ? v[i] : v[i + 8], keep = (lane & 32) ? v[i + 8] : v[i]; v[i] = keep + __shfl_xor(send, 32); }
#pragma unroll
                for (int i = 0; i < 4; ++i) { const float send = (lane & 16) ? v[i] : v[i + 4], keep = (lane & 16) ? v[i + 4] : v[i]; v[i] = keep + __shfl_xor(send, 16); }
#pragma unroll
                for (int i = 0; i < 2; ++i) { const float send = (lane & 8) ? v[i] : v[i + 2], keep = (lane & 8) ? v[i + 2] : v[i]; v[i] = keep + __shfl_xor(send, 8); }
                { const float send = (lane & 4) ? v[0] : v[1], keep = (lane & 4) ? v[1] : v[0]; v[0] = keep + __shfl_xor(send, 4); }
                v[0] += __shfl_xor(v[0], 2); v[0] += __shfl_xor(v[0], 1);
                const float yy = v[0] + dk * lu[t * 16 + (lane >> 2)];
                const float gl = gelu_tanh(yy);
                if ((lane & 3) == 0) Gout[(size_t)(c * S5T + t) * LDD + 16 * g + (lane >> 2)] = (bf16)(pk2(gl, gl) & 0xffffu);
            }
        }
        if (!PASS2) { F[(size_t)(c * 256 + g) * 128 + lane] = hr; F[(size_t)(c * 256 + g) * 128 + 64 + lane] = hi; }
        LDS_WAIT(); asm volatile("" ::: "memory");
    }
}

constexpr int S5TS = 8, S5SB = S5TS * 256 + 16;
typedef short s5_bf16x8 __attribute__((ext_vector_type(8)));
template <bool PASS2>
__device__ __forceinline__ void s5m_pass(const bf16* Hin, const unsigned char* prm, const float* dsk, float* F, const float* HC, bf16* Gout, LAS unsigned char* lds, int bid, int G) {
    const int tid = opaque_tid(), lane = tid & 63, w = __builtin_amdgcn_readfirstlane(tid >> 6), j = lane & 15, rq = lane >> 4;
    const int rowslot = tid >> 4, piece = tid & 15;
    constexpr int NST = S5T / S5TS, NQ = 16 * S5TS / 32;
    for (int unit = bid; unit < 32 * (S5NC / 16); unit += G) {
        const int gb = unit & 31, cs = unit >> 5, g = gb * 8 + w;
        v2u bb[8];
#pragma unroll
        for (int t8 = 0; t8 < 8; ++t8) bb[t8] = *(const v2u*)(prm + S5P_BBOP + ((size_t)((g * 8 + t8) * 64 + lane)) * 8);
        v4u cop[4];
        f32x4 ar[4], ai[4], sr[4], si[4], dk = {0.f, 0.f, 0.f, 0.f};
#pragma unroll
        for (int q = 0; q < 4; ++q) { ar[q] = *(const f32x4*)((const float*)(prm + S5P_ABR) + g * 64 + 16 * q + 4 * rq); ai[q] = *(const f32x4*)((const float*)(prm + S5P_ABI) + g * 64 + 16 * q + 4 * rq); }
        if (PASS2) {
#pragma unroll
            for (int mm = 0; mm < 4; ++mm) cop[mm] = *(const v4u*)(prm + S5P_COP + ((size_t)((g * 4 + mm) * 64 + lane)) * 16);
            const float* hc = HC + ((size_t)(cs * 16 + j) * 256 + g) * 128 + 4 * rq;
#pragma unroll
            for (int q = 0; q < 4; ++q) { sr[q] = *(const f32x4*)(hc + 16 * q); si[q] = *(const f32x4*)(hc + 64 + 16 * q); }
            dk = *(const f32x4*)(dsk + 16 * g + 4 * rq);
        } else {
#pragma unroll
            for (int q = 0; q < 4; ++q) { sr[q] = (f32x4){0.f, 0.f, 0.f, 0.f}; si[q] = (f32x4){0.f, 0.f, 0.f, 0.f}; }
        }
        const bf16* src = Hin + (size_t)(cs * 16 * S5T) * LDD + gb * 128 + piece * 8;
        bf16* dstp = PASS2 ? Gout + (size_t)(cs * 16 * S5T) * LDD + gb * 128 + piece * 8 : nullptr;
        v4u pre[NQ];
#pragma unroll
        for (int q = 0; q < NQ; ++q) { const int ri = q * 32 + rowslot, jj = ri / S5TS, tt = ri % S5TS; pre[q] = *(const v4u*)(src + (size_t)(jj * S5T + tt) * LDD); }
        for (int s = 0; s < NST; ++s) {
#pragma unroll
            for (int q = 0; q < NQ; ++q) { const int ri = q * 32 + rowslot, jj = ri / S5TS, tt = ri % S5TS; LAS v4u* lp = (LAS v4u*)(lds + jj * S5SB + tt * 256 + piece * 16);
                if (PASS2 && s > 0) { const v4u y = *lp; *(v4u*)(dstp + (size_t)(jj * S5T + (s - 1) * S5TS + tt) * LDD) = y; }
                *lp = pre[q]; }
            if (s + 1 < NST) {
#pragma unroll
                for (int q = 0; q < NQ; ++q) { const int ri = q * 32 + rowslot, jj = ri / S5TS, tt = ri % S5TS; pre[q] = *(const v4u*)(src + (size_t)(jj * S5T + (s + 1) * S5TS + tt) * LDD); } }
            LDS_WAIT(); __syncthreads();
            LAS unsigned char* up = lds + j * S5SB + w * 32 + rq * 8;
            v2u uu[S5TS];
#pragma unroll
            for (int tt = 0; tt < S5TS; ++tt) uu[tt] = *(const LAS v2u*)(up + tt * 256);
#pragma unroll
            for (int tt = 0; tt < S5TS; ++tt) {
                v4u ub; ub.x = uu[tt].x; ub.y = uu[tt].y; ub.z = 0u; ub.w = 0u;
                const s5_bf16x8 U = __builtin_bit_cast(s5_bf16x8, ub);
#pragma unroll
                for (int q = 0; q < 4; ++q) {
                    const f32x4 tr = ar[q] * sr[q] - ai[q] * si[q], ti = ar[q] * si[q] + ai[q] * sr[q];
                    v4u a0; a0.x = bb[q].x; a0.y = bb[q].y; a0.z = 0u; a0.w = 0u; v4u a1; a1.x = bb[4 + q].x; a1.y = bb[4 + q].y; a1.z = 0u; a1.w = 0u;
                    sr[q] = __builtin_amdgcn_mfma_f32_16x16x32_bf16(__builtin_bit_cast(s5_bf16x8, a0), U, tr, 0, 0, 0);
                    si[q] = __builtin_amdgcn_mfma_f32_16x16x32_bf16(__builtin_bit_cast(s5_bf16x8, a1), U, ti, 0, 0, 0);
                }
                if (PASS2) {
                    f32x4 y = {0.f, 0.f, 0.f, 0.f};
#pragma unroll
                    for (int mm = 0; mm < 4; ++mm) { const f32x4 t0 = mm < 2 ? sr[2 * mm] : si[2 * mm - 4], t1 = mm < 2 ? sr[2 * mm + 1] : si[2 * mm - 3];
                        v4u sb; sb.x = pk2c(t0.x, t0.y); sb.y = pk2c(t0.z, t0.w); sb.z = pk2c(t1.x, t1.y); sb.w = pk2c(t1.z, t1.w);
                        y = __builtin_amdgcn_mfma_f32_16x16x32_bf16(__builtin_bit_cast(s5_bf16x8, cop[mm]), __builtin_bit_cast(s5_bf16x8, sb), y, 0, 0, 0); }
                    const f32x4 uf = {bflo(uu[tt].x), bfhi(uu[tt].x), bflo(uu[tt].y), bfhi(uu[tt].y)};
                    const f32x4 yy = y + dk * uf;
                    v2u o; o.x = pk2(gelu_tanh(yy.x), gelu_tanh(yy.y)); o.y = pk2(gelu_tanh(yy.z), gelu_tanh(yy.w));
                    *(LAS v2u*)(up + tt * 256) = o;
                }
            }
            LDS_WAIT(); __syncthreads();
        }
        if (PASS2) {
#pragma unroll
            for (int q = 0; q < NQ; ++q) { const int ri = q * 32 + rowslot, jj = ri / S5TS, tt = ri % S5TS; const v4u y = *(const LAS v4u*)(lds + jj * S5SB + tt * 256 + piece * 16);
                *(v4u*)(dstp + (size_t)(jj * S5T + (NST - 1) * S5TS + tt) * LDD) = y; }
            LDS_WAIT();
        } else {
            float* fo = F + ((size_t)(cs * 16 + j) * 256 + g) * 128 + 4 * rq;
#pragma unroll
            for (int q = 0; q < 4; ++q) { *(f32x4*)(fo + 16 * q) = sr[q]; *(f32x4*)(fo + 64 + 16 * q) = si[q]; }
        }
    }
}
__device__ __forceinline__ void s5_carry(const unsigned char* prm, const float* F, float* HC, int bid, int G, int wave, int lane) {
    if (wave != 0) return;
    for (int g = bid; g < 256; g += G) {
        const int p = lane, gp = g * 64 + p;
        const float atr = ((const float*)(prm + S5P_ATR))[gp], ati = ((const float*)(prm + S5P_ATI))[gp];
        float hr = 0.f, hi = 0.f;
        for (int c0 = 0; c0 < S5NC; c0 += 32) {
            float fr[32], fi[32];
#pragma unroll
            for (int q = 0; q < 32; ++q) { const size_t o = (size_t)((c0 + q) * 256 + g) * 128 + p; fr[q] = F[o]; fi[q] = F[o + 64]; }
#pragma unroll
            for (int q = 0; q < 32; ++q) { const size_t o = (size_t)((c0 + q) * 256 + g) * 128 + p;
                HC[o] = hr; HC[o + 64] = hi;
                const float nr = atr * hr - ati * hi + fr[q], ni = atr * hi + ati * hr + fi[q]; hr = nr; hi = ni; }
        }
    }
}

struct Ctx { int lo, hi, tid, lane, wave, gw, NGW, gtid, NGT, G, bid; };
#ifndef WGM_IN
#define WGM_IN 8
#endif
#ifndef WGM_OUT
#define WGM_OUT 2
#endif
#ifndef WGM_GLU
#define WGM_GLU 4
#endif
#ifndef WGM_F1
#define WGM_F1 8
#endif
#ifndef WGM_F2
#define WGM_F2 2
#endif
#ifndef DUP_ATTN
#define DUP_ATTN 0
#endif
#ifndef DUP_S5
#define DUP_S5 0
#endif
#ifndef DUP_FFN1
#define DUP_FFN1 0
#endif
#ifndef DUP_FFN2
#define DUP_FFN2 0
#endif
#ifndef DUP_INP
#define DUP_INP 0
#endif
#ifndef DUP_PRO
#define DUP_PRO 0
#endif
#define IN(k) (lo <= (k) && (k) < hi)
#define SEAM(k) do { if (IN(k) && IN((k) + 1)) xcd_barrier(bar); } while (0)
#define FFN_PHASES(l, pb) do { \
    const float* ml_ = MODL + (size_t)(l) * NMODV; \
    if (IN((pb) + 5)) norm_mod_phase<true>(XR, args.in[6] + (size_t)(l) * DM, ml_ + 3 * DM, ml_ + 4 * DM, Hb, lds, tid, gw, NGW, lane); \
    SEAM((pb) + 5); \
    if (IN((pb) + 6)) { pg8::Gemm g{Hb, (const bf16*)(ws + WS_WGU + (size_t)(l) * W_GU_B), SEQ, 2 * FFH, DM, LDD, LDD}; pg8::StaticOrder S; S.init(SEQ, 2 * FFH, G, bid, WGM_F1); \
        pg8::EpiSwiGLU E{HID, LDF}; pg8::gemm_phase<pg8::EpiSwiGLU, pg8::StaticOrder, true, true>(lds, g, S, E); } \
    if (DUP_FFN1 && IN((pb) + 6)) { xcd_barrier(bar); pg8::Gemm g{Hb, (const bf16*)(ws + WS_WGU + (size_t)(l) * W_GU_B), SEQ, 2 * FFH, DM, LDD, LDD}; pg8::StaticOrder S; S.init(SEQ, 2 * FFH, G, bid, WGM_F1); \
        pg8::EpiSwiGLU E{HID, LDF}; pg8::gemm_phase<pg8::EpiSwiGLU, pg8::StaticOrder, true, true>(lds, g, S, E); } \
    SEAM((pb) + 6); \
    if (DUP_FFN2 && IN((pb) + 7)) { xcd_barrier(bar); pg8::Gemm g{HID, (const bf16*)(ws + WS_WDN + (size_t)(l) * W_DN_B), SEQ, DM, FFH, LDF, LDF}; pg8::StaticOrder S; S.init(SEQ, DM, G, bid, WGM_F2); \
        pg8::EpiResid<false> E{XR, (bf16*)(ws + WS_OT), ml_ + 5 * DM, DM, DM}; pg8::gemm_phase<pg8::EpiResid<false>, pg8::StaticOrder, true, true>(lds, g, S, E); } \
    if (IN((pb) + 7)) { pg8::Gemm g{HID, (const bf16*)(ws + WS_WDN + (size_t)(l) * W_DN_B), SEQ, DM, FFH, LDF, LDF}; pg8::StaticOrder S; S.init(SEQ, DM, G, bid, WGM_F2); \
        pg8::EpiResid<false> E{XR, XR, ml_ + 5 * DM, DM, DM}; pg8::gemm_phase<pg8::EpiResid<false>, pg8::StaticOrder, true, true>(lds, g, S, E); } \
    SEAM((pb) + 7); } while (0)
template <int lp>
__device__ __forceinline__ void layer_pair(const Args& args, const Ctx& C, LAS unsigned char* lds, unsigned char* lds_raw, const XcdBarrier& bar) {
    const int lo = C.lo, hi = C.hi, tid = C.tid, lane = C.lane, wave = C.wave, gw = C.gw, NGW = C.NGW, gtid = C.gtid, NGT = C.NGT, G = C.G, bid = C.bid;
    unsigned char* ws = args.ws;
    bf16* const Hb = (bf16*)(ws + WS_H); bf16* const MIX = (bf16*)(ws + WS_MIX); bf16* const Z = (bf16*)(ws + WS_Z); bf16* const HID = (bf16*)(ws + WS_Z);
    float* const OT = (float*)(ws + WS_OT); bf16* const XR = (bf16*)(ws + WS_XR);
    const float* const MODL = (const float*)(ws + WS_MODL);
        { const int l = 2 * lp, pb = 2 + 8 * l; const float* ml = MODL + (size_t)l * NMODV;
          if (IN(pb)) { if (l == 0) norm_mod_phase<false>(args.in[0], args.in[5] + (size_t)l * DM, ml, ml + DM, Hb, lds, tid, gw, NGW, lane); else norm_mod_phase<true>(XR, args.in[5] + (size_t)l * DM, ml, ml + DM, Hb, lds, tid, gw, NGW, lane); }
          SEAM(pb);
          if (IN(pb + 1)) { pg8::Gemm g{Hb, (const bf16*)(ws + WS_WIN + (size_t)lp * W_IN_B), SEQ, 12288, DM, LDD, LDD}; pg8::StaticOrder S; S.init(SEQ, 12288, G, bid, WGM_IN);
              pg8::EpiHeadMajor E{Z, GS}; pg8::gemm_phase<pg8::EpiHeadMajor, pg8::StaticOrder, true, true>(lds, g, S, E); }
          if (DUP_INP && IN(pb + 1)) { xcd_barrier(bar); pg8::Gemm g{Hb, (const bf16*)(ws + WS_WIN + (size_t)lp * W_IN_B), SEQ, 12288, DM, LDD, LDD}; pg8::StaticOrder S; S.init(SEQ, 12288, G, bid, WGM_IN);
              pg8::EpiHeadMajor E{Z, GS}; pg8::gemm_phase<pg8::EpiHeadMajor, pg8::StaticOrder, true, true>(lds, g, S, E); }
          SEAM(pb + 1);
          if (IN(pb + 2)) { conv_phase(Z, args.in[9] + (size_t)lp * 3 * 2048, MIX, gtid, NGT); if (ATT2) attn2_phase<false>(Z, OT, (char*)lds_raw, bid, G); else attn_phase(Z, OT, (char*)lds_raw, bid, G); if (DUP_ATTN == 1) { xcd_barrier(bar); attn2_phase<false>(Z, (float*)(ws + WS_END), (char*)lds_raw, bid, G); } if (DUP_ATTN == 2) { xcd_barrier(bar); attn2_phase<true>(Z, (float*)(ws + WS_END), (char*)lds_raw, bid, G); } }
          SEAM(pb + 2);
          if (IN(pb + 3)) combine_phase(OT, (const float*)(ws + WS_LAM) + lp, args.in[14] + lp * 256, lp == 0 ? 0.2f : 0.4707130183435842f, MIX, gw, NGW, lane);
          SEAM(pb + 3);
          if (IN(pb + 4)) { pg8::Gemm g{MIX, (const bf16*)(ws + WS_WOUT + (size_t)lp * W_OUT_B), SEQ, DM, DM, LDD, LDD}; pg8::StaticOrder S; S.init(SEQ, DM, G, bid, WGM_OUT);
              if (l == 0) { pg8::EpiResid<true> E{args.in[0], XR, ml + 2 * DM, DM, DM}; pg8::gemm_phase<pg8::EpiResid<true>, pg8::StaticOrder, true, true>(lds, g, S, E); }
              else { pg8::EpiResid<false> E{XR, XR, ml + 2 * DM, DM, DM}; pg8::gemm_phase<pg8::EpiResid<false>, pg8::StaticOrder, true, true>(lds, g, S, E); } }
          SEAM(pb + 4);
          FFN_PHASES(l, pb);
        }
        { const int l = 2 * lp + 1, pb = 2 + 8 * l; const float* ml = MODL + (size_t)l * NMODV;
          const unsigned char* prm = ws + WS_S5P + (size_t)lp * S5P_LAYER;
          float* const S5F = (float*)(ws + WS_S5F); float* const S5H = (float*)(ws + WS_S5H);
          if (IN(pb)) norm_mod_phase<true>(XR, args.in[5] + (size_t)l * DM, ml, ml + DM, Hb, lds, tid, gw, NGW, lane);
          SEAM(pb);
          if (IN(pb + 1)) { if (S5_MFMA) s5m_pass<false>(Hb, prm, nullptr, S5F, nullptr, nullptr, lds, bid, G); else s5_pass<false>(Hb, prm, nullptr, nullptr, nullptr, S5F, nullptr, nullptr, lds, gw, NGW, wave, lane); }
          SEAM(pb + 1);
          if (IN(pb + 2)) s5_carry(prm, S5F, S5H, bid, G, wave, lane);
          SEAM(pb + 2);
          if (IN(pb + 3)) { if (S5_MFMA) s5m_pass<true>(Hb, prm, args.in[23] + (size_t)lp * DM, nullptr, S5H, MIX, lds, bid, G); else s5_pass<true>(Hb, prm, args.in[21] + (size_t)lp * 256 * 16 * 64, args.in[22] + (size_t)lp * 256 * 16 * 64, args.in[23] + (size_t)lp * DM, nullptr, S5H, MIX, lds, gw, NGW, wave, lane); }
          if (DUP_S5) { xcd_barrier(bar);
          if (IN(pb + 1)) { if (S5_MFMA) s5m_pass<false>(Hb, prm, nullptr, S5F, nullptr, nullptr, lds, bid, G); else s5_pass<false>(Hb, prm, nullptr, nullptr, nullptr, S5F, nullptr, nullptr, lds, gw, NGW, wave, lane); }
          SEAM(pb + 1);
          if (IN(pb + 2)) s5_carry(prm, S5F, S5H, bid, G, wave, lane);
          SEAM(pb + 2);
          if (IN(pb + 3)) { if (S5_MFMA) s5m_pass<true>(Hb, prm, args.in[23] + (size_t)lp * DM, nullptr, S5H, MIX, lds, bid, G); else s5_pass<true>(Hb, prm, args.in[21] + (size_t)lp * 256 * 16 * 64, args.in[22] + (size_t)lp * 256 * 16 * 64, args.in[23] + (size_t)lp * DM, nullptr, S5H, MIX, lds, gw, NGW, wave, lane); }
          }
          SEAM(pb + 3);
          if (IN(pb + 4)) { pg8::Gemm g{MIX, (const bf16*)(ws + WS_WGLU + (size_t)lp * W_GLU_B), SEQ, 2 * DM, DM, LDD, LDD}; pg8::StaticOrder S; S.init(SEQ, 2 * DM, G, bid, WGM_GLU);
              pg8::EpiGluResid E{XR, XR, ml + 2 * DM, DM}; pg8::gemm_phase<pg8::EpiGluResid, pg8::StaticOrder, true, true>(lds, g, S, E); }
          SEAM(pb + 4);
          FFN_PHASES(l, pb);
        }
    }
#undef FFN_PHASES
#undef IN
#undef SEAM

__global__ void __launch_bounds__(NTHR, 2) trunk_fwd(Args args) {
    extern __shared__ __attribute__((aligned(16))) unsigned char lds_raw[];
    LAS unsigned char* lds = (LAS unsigned char*)lds_raw;
    volatile LAS unsigned* MISC = (volatile LAS unsigned*)(lds + MISC_OFF);
    const int tid = opaque_tid(), lane = tid & 63, wave = __builtin_amdgcn_readfirstlane(tid >> 6);
    const int G = gridDim.x, bid = blockIdx.x;
    const int vcu = (G % 8 == 0) ? (bid % 8) * (G / 8) + bid / 8 : bid;
    const int gw = vcu * NWAVES + wave, NGW = G * NWAVES, gtid = vcu * NTHR + tid, NGT = G * NTHR;
    unsigned char* ws = args.ws;
    const int lo = args.ph_lo, hi = args.ph_hi;
    for (int u = tid; u < (LDS_BYTES - RING_BYTES) / 4; u += NTHR) ((LAS unsigned*)(lds + RING_BYTES))[u] = 0u;
    __syncthreads();
    XcdBarrier bar; bar.bar = (unsigned*)(ws + WS_CTL) + CW_BAR; bar.x = 0; bar.st = MISC + 8;
    if (hi - lo > 1) bar = xcd_barrier_post((unsigned*)(ws + WS_CTL) + CW_BAR, MISC + 8);
    const Ctx C{lo, hi, tid, lane, wave, gw, NGW, gtid, NGT, G, bid};
#define IN(k) (lo <= (k) && (k) < hi)
#define SEAM(k) do { if (IN(k) && IN((k) + 1)) xcd_barrier(bar); } while (0)

    bf16* const Hb = (bf16*)(ws + WS_H); bf16* const MIX = (bf16*)(ws + WS_MIX); bf16* const Z = (bf16*)(ws + WS_Z); bf16* const HID = (bf16*)(ws + WS_Z);
    float* const OT = (float*)(ws + WS_OT); bf16* const XR = (bf16*)(ws + WS_XR);
    const float* const MODL = (const float*)(ws + WS_MODL);

    if (IN(0)) { p0_prologue(args, lds, gw, NGW, wave, lane); if (DUP_PRO) { xcd_barrier(bar); p0_prologue(args, lds, gw, NGW, wave, lane); } }
    SEAM(0);
    if (IN(1)) p1_modvec(args, gtid, NGT);
    SEAM(1);


    layer_pair<0>(args, C, lds, lds_raw, bar);
    layer_pair<1>(args, C, lds, lds_raw, bar);
    if (IN(34)) final_norm_phase(XR, args.in[7], args.out, gw, NGW, lane);
#undef IN
#undef SEAM
}

extern "C" void kernel_launch(void* const* d_in, const int* in_sizes, int n_in, void* d_out, int out_size, void* d_ws, size_t ws_size, hipStream_t stream) {
    static int grid = 0;
    if (grid == 0) {
        if (n_in != 29 || in_sizes[0] != SEQ * DM || out_size != SEQ * DM || ws_size < WS_END + (DUP_ATTN ? (size_t)32 * GS * 4 : 0)) {
            fprintf(stderr, "kernel_launch: built for 29 inputs, x/out of %d floats, >= %zu bytes of workspace; got n_in %d, in0 %d, out %d, ws %zu; nothing launched\n", SEQ * DM, (size_t)WS_END, n_in, n_in > 0 ? in_sizes[0] : -1, out_size, ws_size); grid = -1; return; }
        int dev = 0, cus = 0, per_cu = 0;
        if (hipGetDevice(&dev) != hipSuccess || hipDeviceGetAttribute(&cus, hipDeviceAttributeMultiprocessorCount, dev) != hipSuccess) { fprintf(stderr, "kernel_launch: device query failed\n"); grid = -1; return; }
        if (hipFuncSetAttribute((const void*)trunk_fwd, hipFuncAttributeMaxDynamicSharedMemorySize, LDS_BYTES) != hipSuccess) { fprintf(stderr, "kernel_launch: hipFuncSetAttribute failed\n"); grid = -1; return; }
        if (hipOccupancyMaxActiveBlocksPerMultiprocessor(&per_cu, (const void*)trunk_fwd, NTHR, LDS_BYTES) != hipSuccess || per_cu < 1) { fprintf(stderr, "kernel_launch: occupancy query reports %d workgroups per CU\n", per_cu); }
        (void)hipGetLastError();
        grid = cus;
        fprintf(stderr, "kernel_launch: grid %d, occupancy %d, ws %zu (need %zu)\n", grid, per_cu, ws_size, (size_t)WS_END);
    }
    if (grid < 0) return;
    if (hipMemsetAsync((char*)d_ws + WS_CTL, 0, CTL_ZERO_BYTES, stream) != hipSuccess) { fprintf(stderr, "kernel_launch: memset failed\n"); return; }
    Args a{};
    for (int i = 0; i < 29; ++i) a.in[i] = (const float*)d_in[i];
    a.out = (float*)d_out; a.ws = (unsigned char*)d_ws;
#if MK_PER_PHASE
    for (int p = 0; p < N_PHASES; ++p) { a.ph_lo = p; a.ph_hi = p + 1; hipLaunchKernelGGL(trunk_fwd, dim3(grid), dim3(NTHR), LDS_BYTES, stream, a); }
#else
    a.ph_lo = 0; a.ph_hi = N_PHASES;
    hipLaunchKernelGGL(trunk_fwd, dim3(grid), dim3(NTHR), LDS_BYTES, stream, a);
#endif
    const hipError_t le = hipPeekAtLastError();
    if (le != hipSuccess) fprintf(stderr, "kernel_launch: launch failed: %s\n", hipGetErrorName(le));
}
```
